# Optimizing an MI355X kernel written in HIP

```python
import jax, jax.numpy as jnp
from jax import lax
import numpy as np

D_MODEL = 1024
BATCH = 4
SEQ = 4096
DEPTH = 1

ATT_HEADS = 8
ATT_HEAD_DIM = 64
IDX_HEADS = 8
IDX_HEAD_DIM = 64
TOPK_MAX = 256
Q_BLOCK = 128
RET_HEADS = 4
RET_HEAD_DIM = 128
RET_CHUNK = 128
ROPE_THETA = 10000.0
ATT_WIDTH = ATT_HEADS * ATT_HEAD_DIM
RET_WIDTH = RET_HEADS * RET_HEAD_DIM
MIX_WIDTH = ATT_WIDTH + RET_WIDTH
IN_SPLITS = (ATT_WIDTH, ATT_WIDTH, ATT_WIDTH, IDX_HEADS * IDX_HEAD_DIM, IDX_HEAD_DIM, IDX_HEADS,
             RET_WIDTH, RET_WIDTH, RET_WIDTH, RET_WIDTH)
IN_WIDTH = sum(IN_SPLITS)
N_GROUPS = 4
EXPERTS_PER_GROUP = 8
N_EXPERTS = N_GROUPS * EXPERTS_PER_GROUP
EXPERT_TOPK = 2
D_EXPERT = 256
N_MOD = 6
EPS = 1e-6

kernel_name = 'hybrid_dsa_retention_hmoe_block'


def _rms_norm(x, g=None):
    xf = x.astype(jnp.float32)
    y = xf * lax.rsqrt(jnp.mean(xf * xf, axis=-1, keepdims=True) + EPS)
    if g is not None:
        y = y * g.astype(jnp.float32)
    return y.astype(x.dtype)


def _rope(x, positions):
    d = x.shape[-1]
    half = d // 2
    freqs = ROPE_THETA ** (-jnp.arange(half, dtype=jnp.float32) / half)
    ang = positions.astype(jnp.float32)[..., None] * freqs
    cos = jnp.cos(ang)[:, :, None, :]
    sin = jnp.sin(ang)[:, :, None, :]
    xf = x.astype(jnp.float32)
    x1, x2 = xf[..., :half], xf[..., half:]
    return jnp.concatenate([x1 * cos - x2 * sin, x2 * cos + x1 * sin], axis=-1).astype(x.dtype)


def _dsa_sparse_attention(q, k, v, q_idx, k_idx, w_idx):
    B, S, H, dh = q.shape
    topk = min(TOPK_MAX, S // 4)
    nblk = S // Q_BLOCK
    key_pos = jnp.arange(S)
    bidx = jnp.arange(B)[:, None, None]
    k_idx_f = k_idx.astype(jnp.float32)

    def to_blocks(a):
        return a.reshape(B, nblk, Q_BLOCK, *a.shape[2:]).swapaxes(0, 1)

    def block_fn(args):
        qb, qib, wb, blk = args
        qpos = blk * Q_BLOCK + jnp.arange(Q_BLOCK)
        logits = jnp.einsum('bqhd,bsd->bqhs', qib.astype(jnp.float32), k_idx_f)
        score = jnp.einsum('bqh,bqhs->bqs', wb.astype(jnp.float32), jax.nn.relu(logits))
        causal = key_pos[None, :] <= qpos[:, None]
        score = jnp.where(causal[None], score, -jnp.inf)
        _, sel = lax.top_k(score, topk)
        valid = sel <= qpos[None, :, None]
        k_sel = k[bidx, sel].astype(jnp.float32)
        v_sel = v[bidx, sel].astype(jnp.float32)
        att = jnp.einsum('bqhd,bqkhd->bqhk', qb.astype(jnp.float32), k_sel) * (dh ** -0.5)
        att = jnp.where(valid[:, :, None, :], att, -jnp.inf)
        p = jax.nn.softmax(att, axis=-1)
        return jnp.einsum('bqhk,bqkhd->bqhd', p, v_sel).astype(q.dtype)

    out = lax.map(block_fn, (to_blocks(q), to_blocks(q_idx), to_blocks(w_idx), jnp.arange(nblk)))
    return out.swapaxes(0, 1).reshape(B, S, H, dh)


def _retention(q, k, v):
    B, S, H, d = q.shape
    C = RET_CHUNK
    N = S // C
    log_gamma = jnp.log(1.0 - 2.0 ** (-5.0 - jnp.arange(H, dtype=jnp.float32)))
    qf = q.astype(jnp.float32).reshape(B, N, C, H, d)
    kf = (k.astype(jnp.float32) * (d ** -0.5)).reshape(B, N, C, H, d)
    vf = v.astype(jnp.float32).reshape(B, N, C, H, d)
    idx = jnp.arange(C, dtype=jnp.float32)
    diff = idx[:, None] - idx[None, :]
    causal = diff >= 0
    decay = jnp.where(causal[None], jnp.exp(log_gamma[:, None, None] * jnp.where(causal, diff, 0.0)[None]), 0.0)
    inner = jnp.einsum('bnihd,bnjhd->bnhij', qf, kf) * decay[None, None]
    o_inner = jnp.einsum('bnhij,bnjhe->bnihe', inner, vf)
    k_decay = jnp.exp(log_gamma[None, :] * (C - 1 - idx)[:, None])
    kv = jnp.einsum('bnjhd,bnjhe->nbhde', kf * k_decay[:, :, None], vf)
    chunk_decay = jnp.exp(log_gamma * C)[None, :, None, None]

    def step(R, kv_n):
        return R * chunk_decay + kv_n, R

    _, R_prev = lax.scan(step, jnp.zeros((B, H, d, d), jnp.float32), kv)
    q_decay = jnp.exp(log_gamma[None, :] * (idx + 1.0)[:, None])
    o_cross = jnp.einsum('bnihd,nbhde->bnihe', qf * q_decay[:, :, None], R_prev)
    return (o_inner + o_cross).reshape(B, S, H, d)


def _hybrid_mixer(h, positions, w_in, w_out):
    B, S, _ = h.shape
    proj = jnp.einsum('bsd,de->bse', h, w_in)
    offsets = [int(o) for o in np.cumsum(IN_SPLITS)[:-1]]
    q_a, k_a, v_a, q_i, k_i, w_i, q_r, k_r, v_r, g_r = jnp.split(proj, offsets, axis=-1)
    q_a = _rope(q_a.reshape(B, S, ATT_HEADS, ATT_HEAD_DIM), positions)
    k_a = _rope(k_a.reshape(B, S, ATT_HEADS, ATT_HEAD_DIM), positions)
    v_a = v_a.reshape(B, S, ATT_HEADS, ATT_HEAD_DIM)
    q_i = _rope(q_i.reshape(B, S, IDX_HEADS, IDX_HEAD_DIM), positions)
    k_i = _rope(k_i[:, :, None, :], positions)[:, :, 0, :]
    w_i = w_i * ((IDX_HEADS ** -0.5) * (IDX_HEAD_DIM ** -0.5))
    att = _dsa_sparse_attention(q_a, k_a, v_a, q_i, k_i, w_i).reshape(B, S, ATT_WIDTH)
    q_r = _rope(q_r.reshape(B, S, RET_HEADS, RET_HEAD_DIM), positions)
    k_r = _rope(k_r.reshape(B, S, RET_HEADS, RET_HEAD_DIM), positions)
    v_r = v_r.reshape(B, S, RET_HEADS, RET_HEAD_DIM)
    ret = _rms_norm(_retention(q_r, k_r, v_r)).reshape(B, S, RET_WIDTH)
    ret = (jax.nn.silu(g_r.astype(jnp.float32)) * ret).astype(h.dtype)
    mixed = jnp.concatenate([att.astype(h.dtype), ret], axis=-1)
    return jnp.einsum('bse,ed->bsd', mixed, w_out)


def _hier_moe(h, w_group, b_group, w_expert, b_expert, w_gate_exp, w_up_exp, w_down_exp):
    B, S, D = h.shape
    T = B * S
    t = h.reshape(T, D)
    g_prob = jax.nn.softmax((t @ w_group + b_group).astype(jnp.float32), axis=-1)
    g_top, g_sel = lax.top_k(g_prob, 1)
    e_logits = (t @ w_expert + b_expert).astype(jnp.float32).reshape(T, N_GROUPS, EXPERTS_PER_GROUP)
    e_logits = jnp.take_along_axis(e_logits, g_sel[:, :, None], axis=1)[:, 0]
    e_top, e_sel = lax.top_k(jax.nn.softmax(e_logits, axis=-1), EXPERT_TOPK)
    weights = g_top * e_top / jnp.sum(e_top, axis=-1, keepdims=True)
    expert_id = g_sel * EXPERTS_PER_GROUP + e_sel
    combine = jnp.einsum('tk,tke->te', weights, jax.nn.one_hot(expert_id, N_EXPERTS, dtype=jnp.float32))
    y = jnp.zeros((T, D), jnp.float32)
    for e in range(N_EXPERTS):
        hid = jax.nn.silu(t @ w_gate_exp[e]) * (t @ w_up_exp[e])
        y = y + combine[:, e:e + 1] * (hid @ w_down_exp[e]).astype(jnp.float32)
    return y.astype(h.dtype).reshape(B, S, D)


def setup_inputs(seed: int = 0) -> dict:
    key = jax.random.key(seed)
    ks = jax.random.split(key, 20)
    f32 = jnp.float32
    nrm = lambda k, shape, s: jax.random.normal(k, shape, f32) * s
    L = DEPTH
    x = jax.random.normal(ks[0], (BATCH, SEQ, D_MODEL), f32)
    c = jax.random.normal(ks[1], (BATCH, D_MODEL), f32)
    positions = (jax.random.randint(ks[2], (BATCH, 1), 0, 1024) + jnp.arange(SEQ)[None, :]).astype(jnp.int32)
    return {
        'x': x,
        'c': c,
        'positions': positions,
        'g_pre_mix': 1.0 + nrm(ks[3], (L, D_MODEL), 0.05),
        'w_ada': nrm(ks[4], (L, D_MODEL, N_MOD * D_MODEL), 0.5 * D_MODEL ** -0.5),
        'b_ada': nrm(ks[5], (L, N_MOD * D_MODEL), 0.02),
        'w_in': nrm(ks[6], (L, D_MODEL, IN_WIDTH), D_MODEL ** -0.5),
        'w_out': nrm(ks[7], (L, MIX_WIDTH, D_MODEL), MIX_WIDTH ** -0.5),
        'g_post_mix': 1.0 + nrm(ks[8], (L, D_MODEL), 0.05),
        'g_pre_ffn': 1.0 + nrm(ks[9], (L, D_MODEL), 0.05),
        'w_group': nrm(ks[10], (L, D_MODEL, N_GROUPS), D_MODEL ** -0.5),
        'b_group': nrm(ks[11], (L, N_GROUPS), 0.01),
        'w_expert': nrm(ks[12], (L, D_MODEL, N_EXPERTS), D_MODEL ** -0.5),
        'b_expert': nrm(ks[13], (L, N_EXPERTS), 0.01),
        'w_gate_exp': nrm(ks[14], (L, N_EXPERTS, D_MODEL, D_EXPERT), D_MODEL ** -0.5),
        'w_up_exp': nrm(ks[15], (L, N_EXPERTS, D_MODEL, D_EXPERT), D_MODEL ** -0.5),
        'w_down_exp': nrm(ks[16], (L, N_EXPERTS, D_EXPERT, D_MODEL), D_EXPERT ** -0.5),
        'g_post_ffn': 1.0 + nrm(ks[17], (L, D_MODEL), 0.05),
    }


def reference(x, c, positions, g_pre_mix, w_ada, b_ada, w_in, w_out, g_post_mix, g_pre_ffn,
              w_group, b_group, w_expert, b_expert, w_gate_exp, w_up_exp, w_down_exp, g_post_ffn):
    h_res = x
    for l in range(DEPTH):
        mod = jax.nn.silu(c) @ w_ada[l] + b_ada[l]
        shift1, scale1, gate1, shift2, scale2, gate2 = [m[:, None, :] for m in jnp.split(mod, N_MOD, axis=-1)]
        h = _rms_norm(h_res, g_pre_mix[l]) * (1.0 + scale1) + shift1
        mix = _hybrid_mixer(h, positions, w_in[l], w_out[l])
        h_res = (h_res + gate1 * _rms_norm(mix, g_post_mix[l])).astype(x.dtype)
        h2 = _rms_norm(h_res, g_pre_ffn[l]) * (1.0 + scale2) + shift2
        ffn = _hier_moe(h2, w_group[l], b_group[l], w_expert[l], b_expert[l],
                        w_gate_exp[l], w_up_exp[l], w_down_exp[l])
        h_res = (h_res + gate2 * _rms_norm(ffn, g_post_ffn[l])).astype(x.dtype)
    return h_res
```

```cpp
#include <hip/hip_runtime.h>
#include <cstdio>
#include <cstdint>
#define MK_SLOTMAP_OFF (163840 - 256)
__device__ __forceinline__ unsigned mk_hwslot() { return (unsigned)__builtin_amdgcn_s_getreg((5 << 11) | 4) & 63u; }
__device__ __forceinline__ int mk_wave() { return __builtin_amdgcn_readfirstlane((int)((const __attribute__((address_space(3))) unsigned char*)(unsigned)MK_SLOTMAP_OFF)[mk_hwslot()]); }
__device__ __forceinline__ int mk_lane() { return (int)__builtin_amdgcn_mbcnt_hi(~0u, __builtin_amdgcn_mbcnt_lo(~0u, 0u)); }
__device__ __forceinline__ int mk_tidx() { return mk_wave() * 64 + mk_lane(); }
namespace pg8 {
#define PG8_LAS __attribute__((address_space(3)))
typedef unsigned short bf16_t;
typedef short bf16x8 __attribute__((ext_vector_type(8)));
typedef float f32x4 __attribute__((ext_vector_type(4)));
typedef unsigned u32x4 __attribute__((ext_vector_type(4)));
constexpr int BM = 256, BK = 64, HALF = 128, HTB = HALF * BK * 2  , STAGE_BYTES = 8 * HTB, NXCD = 8, WGM = 8;

__host__ __device__ __forceinline__ int lds_byte(int r, int c) { const int st = (r >> 4) * 2 + (c >> 5), rr = r & 15, cc = c & 31, ob = rr * 64 + cc * 2; return st * 1024 + (ob ^ (((ob >> 9) & 1) << 5)); }
__host__ __device__ __forceinline__ void stage_rc(int b, int& R, int& C) { const int st = b / 1024, sb = b % 1024, swz = sb ^ (((sb >> 9) & 1) << 5); R = (st >> 1) * 16 + swz / 64; C = (st & 1) * 32 + (swz % 64) / 2; }
__host__ __device__ __forceinline__ int perm32(int rho) { const int n = rho >> 4, i = rho & 15; return 8 * (i >> 2) + 4 * n + (i & 3); }

struct Unit { int pm, pn; };
struct Gemm { const bf16_t* A; const bf16_t* Bt; int M, N, K; };

struct StaticOrder {
    int nM, nN, nwg, G, c;
    __host__ __device__ void init(int M, int N, int G_, int c_) { nM = M / BM; nN = N / BM; nwg = nM * nN; G = G_; c = c_; }
    __host__ __device__ bool next(int i, Unit& u) const {
        const long L = (long)i * G + c; if (L >= nwg) return false;
        int wgid = (int)L; { const int q = nwg / NXCD, r = nwg % NXCD, xcd = wgid % NXCD, off = wgid / NXCD; wgid = (xcd < r ? xcd * (q + 1) : r * (q + 1) + (xcd - r) * q) + off; }
        const int nig = WGM * nN, gid = wgid / nig, fm = gid * WGM, gsz = (nM - fm) < WGM ? (nM - fm) : WGM;
        u.pm = fm + ((wgid % nig) % gsz); u.pn = (wgid % nig) / gsz; return true;
    }
    __device__ __forceinline__ void a_ready(const Unit&) const {}
    __device__ __forceinline__ void done(const Unit&) const {}
};
template <class Epi, class Sched, bool ALIGN_EPI = false, bool SP2 = false>
__device__ __forceinline__ void gemm_phase(PG8_LAS unsigned char* lds, const Gemm g, const Sched& S, const Epi& E) {
    const int tid = mk_tidx(), wid = __builtin_amdgcn_readfirstlane(tid >> 6), lane = tid & 63, wr = wid >> 2, wc = wid & 3, fr = lane & 15, fq = lane >> 4;
    const int K = g.K, nt = K / BK;
    unsigned voffA[2], voffB[2];
#pragma unroll
    for (int i = 0; i < 2; ++i) { int R, C; stage_rc(tid * 16 + i * 8192, R, C); const int Rb = Epi::PERM ? ((R & ~31) + perm32(R & 31)) : R;
        voffA[i] = (unsigned)(R * K + C) * 2u; voffB[i] = (unsigned)(Rb * K + C) * 2u; }
    const size_t kstep = (size_t)(BK * 2);
    const size_t hstep = (size_t)HALF * K * 2;
    const size_t tstep = 2 * hstep;
    const unsigned ldsw = (unsigned)wid * 1024u;
    const int aoff = lds_byte(wr * 64 + fr, fq * 8), boff = lds_byte(wc * 32 + fr, fq * 8);
#define PG8_SA(b, h) (((b) * 2 + (h)) * HTB)
#define PG8_SB(b, h) ((4 + (b) * 2 + (h)) * HTB)
#define PG8_STAGE(bufoff, gbase, voff) do { _Pragma("unroll") for (int _i = 0; _i < 2; ++_i) \
        __builtin_amdgcn_global_load_lds((const unsigned*)((const char*)(gbase) + (voff)[_i]), (PG8_LAS unsigned*)(lds + (bufoff) + ldsw + _i * 8192), 16, 0, 0); } while (0)
#define PG8_LDA(dst, b, h) do { _Pragma("unroll") for (int m = 0; m < 4; ++m) _Pragma("unroll") for (int k = 0; k < 2; ++k) dst[m][k] = *(const PG8_LAS bf16x8*)(lds + PG8_SA(b, h) + aoff + m * 2048 + k * 1024); } while (0)
#define PG8_LDB(dst, b, h) do { _Pragma("unroll") for (int n = 0; n < 2; ++n) _Pragma("unroll") for (int k = 0; k < 2; ++k) dst[n][k] = *(const PG8_LAS bf16x8*)(lds + PG8_SB(b, h) + boff + n * 2048 + k * 1024); } while (0)
#define PG8_MMA(ai, bj, At, Bt) do { __builtin_amdgcn_s_setprio(1); _Pragma("unroll") for (int m = 0; m < 4; ++m) _Pragma("unroll") for (int n = 0; n < 2; ++n) _Pragma("unroll") for (int k = 0; k < 2; ++k) \
        acc[ai][bj][m][n] = __builtin_amdgcn_mfma_f32_16x16x32_bf16(Bt[n][k], At[m][k], acc[ai][bj][m][n], 0, 0, 0); __builtin_amdgcn_s_setprio(0); } while (0)
#define PG8_WAIT_V(n) asm volatile("s_waitcnt vmcnt(" #n ")" ::: "memory")
#define PG8_WAIT_L(n) asm volatile("s_waitcnt lgkmcnt(" #n ")" ::: "memory")
#define PG8_BAR __builtin_amdgcn_s_barrier()
#define PG8_SCHED __builtin_amdgcn_sched_barrier(0)
    Unit cur, nxt; int ui = 0;
    if (!S.next(0, cur)) return;
    f32x4 acc[2][2][4][2];
#pragma unroll
    for (int a = 0; a < 2; ++a)
#pragma unroll
        for (int b = 0; b < 2; ++b)
#pragma unroll
            for (int m = 0; m < 4; ++m)
#pragma unroll
                for (int n = 0; n < 2; ++n) acc[a][b][m][n] = (f32x4){0.f, 0.f, 0.f, 0.f};
    bf16x8 At[4][2], B0[2][2], B1[2][2];
    const char* cA = (const char*)g.A + (size_t)cur.pm * tstep; const char* cB = (const char*)g.Bt + (size_t)cur.pn * tstep;
    S.a_ready(cur);
    if constexpr (SP2) {
        PG8_STAGE(PG8_SB(0, 0), cB, voffB); PG8_STAGE(PG8_SB(0, 1), cB + hstep, voffB); PG8_STAGE(PG8_SA(0, 0), cA, voffA); PG8_STAGE(PG8_SA(0, 1), cA + hstep, voffA);
        if (wr == 1) PG8_BAR;
        PG8_WAIT_V(2); PG8_BAR;
        PG8_STAGE(PG8_SB(1, 0), cB + kstep, voffB); PG8_STAGE(PG8_SA(1, 0), cA + kstep, voffA); PG8_STAGE(PG8_SB(1, 1), cB + hstep + kstep, voffB);
        PG8_WAIT_V(6); PG8_BAR;
    } else {
        PG8_STAGE(PG8_SB(0, 0), cB, voffB); PG8_STAGE(PG8_SA(0, 0), cA, voffA); PG8_STAGE(PG8_SB(0, 1), cB + hstep, voffB); PG8_STAGE(PG8_SA(0, 1), cA + hstep, voffA);
        if (wr == 1) PG8_BAR;
        PG8_WAIT_V(4); PG8_BAR;
        PG8_STAGE(PG8_SB(1, 0), cB + kstep, voffB); PG8_STAGE(PG8_SA(1, 0), cA + kstep, voffA); PG8_STAGE(PG8_SB(1, 1), cB + hstep + kstep, voffB);
        PG8_WAIT_V(6); PG8_BAR;
    }
    for (;;) {
        const bool has_next = S.next(ui + 1, nxt);
        const char* nA = has_next ? (const char*)g.A + (size_t)nxt.pm * tstep : cA; const char* nB = has_next ? (const char*)g.Bt + (size_t)nxt.pn * tstep : cB;
        for (int t = 0; t < nt; t += 2) {
            const bool last = (t == nt - 2);
            const char* a1 = cA + (size_t)(t + 1) * kstep;
            const char* a2 = last ? nA : cA + (size_t)(t + 2) * kstep; const char* b2 = last ? nB : cB + (size_t)(t + 2) * kstep;
            const char* a3 = a2 + kstep; const char* b3 = b2 + kstep;
            if (last && has_next) S.a_ready(nxt);
            if constexpr (SP2) {
            PG8_LDB(B0, 0, 0); PG8_LDB(B1, 0, 1); PG8_SCHED; PG8_LDA(At, 0, 0); PG8_STAGE(PG8_SA(1, 1), a1 + hstep, voffA);
            PG8_WAIT_V(8); PG8_WAIT_L(0); PG8_BAR; PG8_MMA(0, 0, At, B0); PG8_MMA(0, 1, At, B1); PG8_BAR; PG8_SCHED;
            PG8_LDA(At, 0, 1); PG8_STAGE(PG8_SB(0, 0), b2, voffB); PG8_STAGE(PG8_SB(0, 1), b2 + hstep, voffB); PG8_STAGE(PG8_SA(0, 0), a2, voffA);
            PG8_WAIT_V(8); PG8_WAIT_L(0); PG8_BAR; PG8_MMA(1, 0, At, B0); PG8_MMA(1, 1, At, B1); PG8_BAR; PG8_SCHED;
            PG8_LDB(B0, 1, 0); PG8_LDB(B1, 1, 1); PG8_SCHED; PG8_LDA(At, 1, 0); PG8_STAGE(PG8_SA(0, 1), a2 + hstep, voffA);
            PG8_WAIT_V(8); PG8_WAIT_L(0); PG8_BAR; PG8_MMA(0, 0, At, B0); PG8_MMA(0, 1, At, B1); PG8_BAR; PG8_SCHED;
            PG8_LDA(At, 1, 1); PG8_STAGE(PG8_SB(1, 0), b3, voffB); PG8_STAGE(PG8_SB(1, 1), b3 + hstep, voffB); PG8_STAGE(PG8_SA(1, 0), a3, voffA);
            PG8_WAIT_V(8); PG8_WAIT_L(0); PG8_BAR; PG8_MMA(1, 0, At, B0); PG8_MMA(1, 1, At, B1); PG8_BAR; PG8_SCHED;
            } else {
            PG8_LDB(B0, 0, 0); PG8_SCHED; PG8_LDA(At, 0, 0); PG8_STAGE(PG8_SA(1, 1), a1 + hstep, voffA);
            PG8_WAIT_L(8); PG8_BAR; PG8_WAIT_L(0); PG8_MMA(0, 0, At, B0); PG8_BAR; PG8_SCHED;
            PG8_LDB(B1, 0, 1); PG8_STAGE(PG8_SB(0, 0), b2, voffB);
            PG8_BAR; PG8_WAIT_L(0); PG8_MMA(0, 1, At, B1); PG8_BAR;
            PG8_LDA(At, 0, 1); PG8_STAGE(PG8_SA(0, 0), a2, voffA);
            PG8_BAR; PG8_WAIT_L(0); PG8_MMA(1, 0, At, B0); PG8_BAR; PG8_SCHED;
            PG8_STAGE(PG8_SB(0, 1), b2 + hstep, voffB);
            PG8_WAIT_V(6); PG8_BAR; PG8_MMA(1, 1, At, B1); PG8_BAR;
            PG8_LDB(B0, 1, 0); PG8_SCHED; PG8_LDA(At, 1, 0); PG8_STAGE(PG8_SA(0, 1), a2 + hstep, voffA);
            PG8_WAIT_L(8); PG8_BAR; PG8_WAIT_L(0); PG8_MMA(0, 0, At, B0); PG8_BAR; PG8_SCHED;
            PG8_LDB(B1, 1, 1); PG8_STAGE(PG8_SB(1, 0), b3, voffB);
            PG8_BAR; PG8_WAIT_L(0); PG8_MMA(0, 1, At, B1); PG8_BAR;
            PG8_LDA(At, 1, 1); PG8_STAGE(PG8_SA(1, 0), a3, voffA);
            PG8_BAR; PG8_WAIT_L(0); PG8_MMA(1, 0, At, B0); PG8_BAR; PG8_SCHED;
            PG8_STAGE(PG8_SB(1, 1), b3 + hstep, voffB);
            PG8_WAIT_V(6); PG8_BAR; PG8_MMA(1, 1, At, B1); PG8_BAR;
            }
        }
        if constexpr (ALIGN_EPI) { if (wr == 0) PG8_BAR; }
        if constexpr (!Epi::AFTER_DRAIN) { E(acc, cur, wr, wc, fr, fq); S.done(cur); }
        if (!has_next) break;
#pragma unroll
        for (int a = 0; a < 2; ++a)
#pragma unroll
            for (int b = 0; b < 2; ++b)
#pragma unroll
                for (int m = 0; m < 4; ++m)
#pragma unroll
                    for (int n = 0; n < 2; ++n) acc[a][b][m][n] = (f32x4){0.f, 0.f, 0.f, 0.f};
        cur = nxt; cA = nA; cB = nB; ++ui;
        if constexpr (ALIGN_EPI) { if (wr == 1) PG8_BAR; }
    }
    PG8_WAIT_V(0);
    if constexpr (!ALIGN_EPI) { if (wr == 0) PG8_BAR; }
    PG8_BAR;
    if constexpr (Epi::AFTER_DRAIN) { E.fused(acc, cur, wr, wc, fr, fq, lds, wid, lane); S.done(cur); }
#undef PG8_SA
#undef PG8_SB
#undef PG8_STAGE
#undef PG8_LDA
#undef PG8_LDB
#undef PG8_MMA
#undef PG8_WAIT_V
#undef PG8_WAIT_L
#undef PG8_BAR
#undef PG8_SCHED
}
}
#define XB_TMO      128
#define XB_XCNT(j)  (256  + 64 * (j))
#define XB_XSUB(j)  (1280 + 64 * (j))
#define XB_XGEN(j)  (2304 + 64 * (j))
#define XB_TOP      3328
#define XB_TOPGEN   3392
#define XCD_BAR_WORDS 3456
#define XB_SPIN_CAP (1u << 18)
#define LAS __attribute__((address_space(3)))

__device__ __forceinline__ unsigned xb_ld(unsigned* p)              { return __hip_atomic_load(p, __ATOMIC_RELAXED, __HIP_MEMORY_SCOPE_AGENT); }
__device__ __forceinline__ unsigned xb_add(unsigned* p, unsigned v) { return __hip_atomic_fetch_add(p, v, __ATOMIC_RELAXED, __HIP_MEMORY_SCOPE_AGENT); }
__device__ __forceinline__ unsigned xb_xcc_id() { return (unsigned)__builtin_amdgcn_s_getreg((3 << 11) | 20) & 0xFu; }
#define XB_SPIN(cond, bar) do { unsigned _sp = 0; while (cond) { __builtin_amdgcn_s_sleep(1); \
    if ((++_sp & 255u) == 0u) { if (xb_ld(&(bar)[XB_TMO])) break; if (_sp > XB_SPIN_CAP) { atomicAdd(&(bar)[XB_TMO], 1u); break; } } } } while (0)

struct XcdBarrier {
    unsigned* bar; unsigned x;
    volatile LAS unsigned* st;
};

__device__ __forceinline__ XcdBarrier xcd_barrier_post(unsigned* bar, volatile LAS unsigned* st) {
    XcdBarrier b; b.bar = bar; b.x = xb_xcc_id(); b.st = st;
    if (mk_tidx() == 0) (void)xb_add(&bar[XB_XCNT(b.x)], 1u);
    return b;
}
__device__ __forceinline__ void xcd_barrier_complete(unsigned* bar, unsigned x, unsigned& nloc, unsigned& nx) {
    const unsigned G = gridDim.x * gridDim.y * gridDim.z;
    unsigned sum, cnt, mine, sp = 0u;
    for (;;) {
        sum = 0u; cnt = 0u; mine = 0u;
#pragma unroll
        for (unsigned j = 0; j < 16; ++j) { const unsigned c = xb_ld(&bar[XB_XCNT(j)]); sum += c; cnt += (c > 0u) ? 1u : 0u; mine = (j == x) ? c : mine; }
        if (sum == G) break;
        __builtin_amdgcn_s_sleep(1);
        if ((++sp & 255u) == 0u) { if (xb_ld(&bar[XB_TMO])) break; if (sp > XB_SPIN_CAP) { atomicAdd(&bar[XB_TMO], 1u); break; } }
    }
    nloc = mine > 0u ? mine : 1u; nx = cnt > 0u ? cnt : 1u;
}

__device__ __forceinline__ void xcd_barrier(const XcdBarrier& b) {
    asm volatile("s_waitcnt vmcnt(0)" ::: "memory");
    __syncthreads();
    if (mk_tidx() == 0) {
        unsigned* bar = b.bar;
        __builtin_amdgcn_s_waitcnt(0);
        unsigned nloc = b.st[0], nx = b.st[1];
        if (nloc == 0u) { xcd_barrier_complete(bar, b.x, nloc, nx); b.st[0] = nloc; b.st[1] = nx; }
        const unsigned old = xb_add(&bar[XB_XSUB(b.x)], 1u);
        const unsigned gen = old / nloc;
        if (old + 1u == (gen + 1u) * nloc) {
            __builtin_amdgcn_fence(__ATOMIC_RELEASE, "agent");
            asm volatile("s_waitcnt vmcnt(0)" ::: "memory");
            const unsigned og = xb_add(&bar[XB_TOP], 1u);
            const unsigned tg = og / nx;
            if (og + 1u == (tg + 1u) * nx) xb_add(&bar[XB_TOPGEN], 1u);
            else XB_SPIN(xb_ld(&bar[XB_TOPGEN]) == tg, bar);
            __builtin_amdgcn_fence(__ATOMIC_ACQUIRE, "agent");
            xb_add(&bar[XB_XGEN(b.x)], 1u);
            asm volatile("s_waitcnt vmcnt(0)" ::: "memory");
        } else {
            XB_SPIN(xb_ld(&bar[XB_XGEN(b.x)]) == gen, bar);
            __builtin_amdgcn_fence(__ATOMIC_ACQUIRE, "agent");
            asm volatile("s_waitcnt vmcnt(0)" ::: "memory");
        }
    }
    __syncthreads();
}
namespace pg8 {
template <class Epi, class Sched>
__device__ __forceinline__ void gemm_phase_ga(PG8_LAS unsigned char* lds, const Gemm g, const Sched& S, const Epi& E) {
    const int tid = mk_tidx(), wid = __builtin_amdgcn_readfirstlane(tid >> 6), lane = tid & 63, wr = wid >> 2, wc = wid & 3, fr = lane & 15, fq = lane >> 4;
    const int K = g.K, nt = K / BK;
    unsigned voffB[2]; int RA[2], CA[2];
#pragma unroll
    for (int i = 0; i < 2; ++i) { int R, C; stage_rc(tid * 16 + i * 8192, R, C); const int Rb = Epi::PERM ? ((R & ~31) + perm32(R & 31)) : R;
        RA[i] = R; CA[i] = C; voffB[i] = (unsigned)(Rb * K + C) * 2u; }
    const size_t kstep = (size_t)(BK * 2);
    const size_t hstep = (size_t)HALF * K * 2;
    const size_t tstep = 2 * hstep;
    const unsigned ldsw = (unsigned)wid * 1024u;
    const int aoff = lds_byte(wr * 64 + fr, fq * 8), boff = lds_byte(wc * 32 + fr, fq * 8);
#define PG8_SA(b, h) (((b) * 2 + (h)) * HTB)
#define PG8_SB(b, h) ((4 + (b) * 2 + (h)) * HTB)
#define PG8_STAGE(bufoff, gbase, voff) do { _Pragma("unroll") for (int _i = 0; _i < 2; ++_i) \
        __builtin_amdgcn_global_load_lds((const unsigned*)((const char*)(gbase) + (voff)[_i]), (PG8_LAS unsigned*)(lds + (bufoff) + ldsw + _i * 8192), 16, 0, 0); } while (0)
#define PG8_LDA(dst, b, h) do { _Pragma("unroll") for (int m = 0; m < 4; ++m) _Pragma("unroll") for (int k = 0; k < 2; ++k) dst[m][k] = *(const PG8_LAS bf16x8*)(lds + PG8_SA(b, h) + aoff + m * 2048 + k * 1024); } while (0)
#define PG8_LDB(dst, b, h) do { _Pragma("unroll") for (int n = 0; n < 2; ++n) _Pragma("unroll") for (int k = 0; k < 2; ++k) dst[n][k] = *(const PG8_LAS bf16x8*)(lds + PG8_SB(b, h) + boff + n * 2048 + k * 1024); } while (0)
#define PG8_MMA(ai, bj, At, Bt) do { __builtin_amdgcn_s_setprio(1); _Pragma("unroll") for (int m = 0; m < 4; ++m) _Pragma("unroll") for (int n = 0; n < 2; ++n) _Pragma("unroll") for (int k = 0; k < 2; ++k) \
        acc[ai][bj][m][n] = __builtin_amdgcn_mfma_f32_16x16x32_bf16(Bt[n][k], At[m][k], acc[ai][bj][m][n], 0, 0, 0); __builtin_amdgcn_s_setprio(0); } while (0)
#define PG8_WAIT_V(n) asm volatile("s_waitcnt vmcnt(" #n ")" ::: "memory")
#define PG8_WAIT_L(n) asm volatile("s_waitcnt lgkmcnt(0)" ::: "memory")
#define PG8_BAR __builtin_amdgcn_s_barrier()
#define PG8_SCHED __builtin_amdgcn_sched_barrier(0)
#define PG8_AOFF(dst, u) do { _Pragma("unroll") for (int _h = 0; _h < 2; ++_h) _Pragma("unroll") for (int _i = 0; _i < 2; ++_i) \
        dst[_h][_i] = (unsigned)S.arow(u, _h * HALF + RA[_i]) * (unsigned)(K * 2) + (unsigned)(CA[_i] * 2); } while (0)
    Unit cur, nxt; int ui = 0;
    if (!S.next(0, cur)) return;
    f32x4 acc[2][2][4][2];
#pragma unroll
    for (int a = 0; a < 2; ++a)
#pragma unroll
        for (int b = 0; b < 2; ++b)
#pragma unroll
            for (int m = 0; m < 4; ++m)
#pragma unroll
                for (int n = 0; n < 2; ++n) acc[a][b][m][n] = (f32x4){0.f, 0.f, 0.f, 0.f};
    bf16x8 At[4][2], B0[2][2], B1[2][2];
    unsigned offC[2][2], offN[2][2];
    PG8_AOFF(offC, cur);
    const char* gA = (const char*)g.A;
    const char* cB = (const char*)g.Bt + (size_t)cur.pn * tstep;
    S.a_ready(cur);
    PG8_STAGE(PG8_SB(0, 0), cB, voffB); PG8_STAGE(PG8_SB(0, 1), cB + hstep, voffB); PG8_STAGE(PG8_SA(0, 0), gA, offC[0]); PG8_STAGE(PG8_SA(0, 1), gA, offC[1]);
    if (wr == 1) PG8_BAR;
    PG8_WAIT_V(2); PG8_BAR;
    PG8_STAGE(PG8_SB(1, 0), cB + kstep, voffB); PG8_STAGE(PG8_SA(1, 0), gA + kstep, offC[0]); PG8_STAGE(PG8_SB(1, 1), cB + hstep + kstep, voffB);
    PG8_WAIT_V(6); PG8_BAR;
    for (;;) {
        const bool has_next = S.next(ui + 1, nxt);
        if (has_next) { PG8_AOFF(offN, nxt); } else {
#pragma unroll
            for (int h_ = 0; h_ < 2; ++h_)
#pragma unroll
                for (int i_ = 0; i_ < 2; ++i_) offN[h_][i_] = offC[h_][i_]; }
        const char* nB = has_next ? (const char*)g.Bt + (size_t)nxt.pn * tstep : cB;
        for (int t = 0; t < nt; t += 2) {
            const bool last = (t == nt - 2);
            const char* a1 = gA + (size_t)(t + 1) * kstep;
            const char* a2 = last ? gA : gA + (size_t)(t + 2) * kstep; const char* b2 = last ? nB : cB + (size_t)(t + 2) * kstep;
            const char* a3 = a2 + kstep; const char* b3 = b2 + kstep;
            unsigned o2[2][2];
#pragma unroll
            for (int h_ = 0; h_ < 2; ++h_)
#pragma unroll
                for (int i_ = 0; i_ < 2; ++i_) o2[h_][i_] = last ? offN[h_][i_] : offC[h_][i_];
            if (last && has_next) S.a_ready(nxt);
            PG8_LDB(B0, 0, 0); PG8_LDB(B1, 0, 1); PG8_SCHED; PG8_LDA(At, 0, 0); PG8_STAGE(PG8_SA(1, 1), a1, offC[1]);
            PG8_WAIT_V(8); PG8_WAIT_L(0); PG8_BAR; PG8_MMA(0, 0, At, B0); PG8_MMA(0, 1, At, B1); PG8_BAR; PG8_SCHED;
            PG8_LDA(At, 0, 1); PG8_STAGE(PG8_SB(0, 0), b2, voffB); PG8_STAGE(PG8_SB(0, 1), b2 + hstep, voffB); PG8_STAGE(PG8_SA(0, 0), a2, o2[0]);
            PG8_WAIT_V(8); PG8_WAIT_L(0); PG8_BAR; PG8_MMA(1, 0, At, B0); PG8_MMA(1, 1, At, B1); PG8_BAR; PG8_SCHED;
            PG8_LDB(B0, 1, 0); PG8_LDB(B1, 1, 1); PG8_SCHED; PG8_LDA(At, 1, 0); PG8_STAGE(PG8_SA(0, 1), a2, o2[1]);
            PG8_WAIT_V(8); PG8_WAIT_L(0); PG8_BAR; PG8_MMA(0, 0, At, B0); PG8_MMA(0, 1, At, B1); PG8_BAR; PG8_SCHED;
            PG8_LDA(At, 1, 1); PG8_STAGE(PG8_SB(1, 0), b3, voffB); PG8_STAGE(PG8_SB(1, 1), b3 + hstep, voffB); PG8_STAGE(PG8_SA(1, 0), a3, o2[0]);
            PG8_WAIT_V(8); PG8_WAIT_L(0); PG8_BAR; PG8_MMA(1, 0, At, B0); PG8_MMA(1, 1, At, B1); PG8_BAR; PG8_SCHED;
        }
        if (wr == 0) PG8_BAR;
        E(acc, cur, wr, wc, fr, fq); S.done(cur);
        if (!has_next) break;
#pragma unroll
        for (int a = 0; a < 2; ++a)
#pragma unroll
            for (int b = 0; b < 2; ++b)
#pragma unroll
                for (int m = 0; m < 4; ++m)
#pragma unroll
                    for (int n = 0; n < 2; ++n) acc[a][b][m][n] = (f32x4){0.f, 0.f, 0.f, 0.f};
        cur = nxt; cB = nB; ++ui;
#pragma unroll
        for (int h_ = 0; h_ < 2; ++h_)
#pragma unroll
            for (int i_ = 0; i_ < 2; ++i_) offC[h_][i_] = offN[h_][i_];
        if (wr == 1) PG8_BAR;
    }
    PG8_WAIT_V(0);
    PG8_BAR;
#undef PG8_SA
#undef PG8_SB
#undef PG8_STAGE
#undef PG8_LDA
#undef PG8_LDB
#undef PG8_MMA
#undef PG8_WAIT_V
#undef PG8_WAIT_L
#undef PG8_BAR
#undef PG8_SCHED
#undef PG8_AOFF
}
}
namespace attn_body {
using bf16=unsigned short;
using bf16x8=__attribute__((ext_vector_type(8)))short;
using s16x4=__attribute__((ext_vector_type(4)))short;
using f32x16=__attribute__((ext_vector_type(16)))float;
using u32x4=__attribute__((ext_vector_type(4)))unsigned;
constexpr int BATCH=4,NHEAD=8,SEQ=4096,D=64,DM=NHEAD*D,ODM=1024;
constexpr int NW=8,QBLK=32,QB=QBLK*NW,KVBLK=64,NQB=SEQ/QB;
constexpr int ATTN_PITCH=DM, ATTN_UNIT_ROWS=QB;
__device__ __forceinline__ int crow(int r,int hi){return (r&3)+8*(r>>2)+4*hi;}
#define SBAR() __builtin_amdgcn_sched_barrier(0)
__device__ __forceinline__ void cmask(f32x16&p0,f32x16&p1,int jb,int qrel,int hi){
  const float NEG=-INFINITY; int kb=64*jb+4*hi;
  #pragma unroll
  for(int r=0;r<16;++r){int kv=kb+(r&3)+8*(r>>2); if(kv>qrel)p0[r]=NEG; if(kv+32>qrel)p1[r]=NEG;}
}

constexpr int NSLOT=3, SLOTB=8192;
constexpr int LDS_K=0, LDS_V=NSLOT*SLOTB, LDS_WS=2*NSLOT*SLOTB, LDS_OST=LDS_WS+NW*64*4, LDS_MSK=LDS_OST+NW*4096, LDS_BYTES=LDS_MSK+NW*768;
constexpr float C2=0.125f*1.4426950408889634f;
__device__ __forceinline__ void glds16(const void*gsrc,unsigned lds_dst){unsigned keep;
  asm volatile("s_mov_b32 %0, m0\n\ts_mov_b32 m0, %2\n\ts_nop 0\n\tglobal_load_lds_dwordx4 %1, off\n\ts_mov_b32 m0, %0":"=&s"(keep):"v"(gsrc),"s"(lds_dst):"memory");}
__device__ __forceinline__ void glds4(const void*gsrc,unsigned lds_dst){unsigned keep;
  asm volatile("s_mov_b32 %0, m0\n\ts_mov_b32 m0, %2\n\ts_nop 0\n\tglobal_load_lds_dword %1, off\n\ts_mov_b32 m0, %0":"=&s"(keep):"v"(gsrc),"s"(lds_dst):"memory");}
template<int BIT> __device__ __forceinline__ float mand(float x,unsigned w){ int m; asm("v_bfe_i32 %0, %1, %2, 1":"=v"(m):"v"(w),"n"(BIT)); return __uint_as_float(__float_as_uint(x)&(unsigned)m); }
__device__ __forceinline__ float max3f(float a,float b,float c){float r;asm("v_max3_f32 %0, %1, %2, %3":"=v"(r):"v"(a),"v"(b),"v"(c));return r;}
__device__ __forceinline__ float max2f(float a,float b){float r;asm("v_max_f32_e32 %0, %1, %2":"=v"(r):"v"(a),"v"(b));return r;}
__device__ __forceinline__ float fadd_s(float a,float b){float r;asm("v_add_f32_e32 %0, %1, %2":"=v"(r):"v"(a),"v"(b));return r;}
__device__ __forceinline__ float fsub_s(float a,float b){float r;asm("v_sub_f32_e32 %0, %1, %2":"=v"(r):"v"(a),"v"(b));return r;}
typedef float f32x2_t __attribute__((ext_vector_type(2))); typedef __bf16 bf16x2_t __attribute__((ext_vector_type(2)));
__device__ __forceinline__ unsigned cvtpk_s(float lo,float hi){f32x2_t v={lo,hi};bf16x2_t b=__builtin_convertvector(v,bf16x2_t);return __builtin_bit_cast(unsigned,b);}
#define WAIT_BAR(N) asm volatile("s_waitcnt vmcnt(" #N ") lgkmcnt(0)\n\ts_barrier":::"memory")

__device__ __forceinline__ void qkt(f32x16&p0,f32x16&p1,const char*Kslot,const bf16x8*qr,const f32x16&negm,int r32,int hi){
  const char*kb=Kslot+hi*1024+r32*16;
  #pragma unroll
  for(int d0=0;d0<4;++d0){
    const bf16x8 b0=*reinterpret_cast<const bf16x8*>(kb+d0*2048);
    const bf16x8 b1=*reinterpret_cast<const bf16x8*>(kb+d0*2048+512);
    if(d0==0){p0=__builtin_amdgcn_mfma_f32_32x32x16_bf16(b0,qr[0],negm,0,0,0);p1=__builtin_amdgcn_mfma_f32_32x32x16_bf16(b1,qr[0],negm,0,0,0);}
    else{p0=__builtin_amdgcn_mfma_f32_32x32x16_bf16(b0,qr[d0],p0,0,0,0);p1=__builtin_amdgcn_mfma_f32_32x32x16_bf16(b1,qr[d0],p1,0,0,0);}}
}
typedef __attribute__((address_space(3))) const char* lds_cptr;
typedef short v4i16_t __attribute__((ext_vector_type(4)));
__device__ __forceinline__ void kload8(bf16x8*kf,lds_cptr kp){
  kf[0]=*(const __attribute__((address_space(3))) bf16x8*)(kp);      kf[1]=*(const __attribute__((address_space(3))) bf16x8*)(kp+512);
  kf[2]=*(const __attribute__((address_space(3))) bf16x8*)(kp+2048); kf[3]=*(const __attribute__((address_space(3))) bf16x8*)(kp+2560);
  kf[4]=*(const __attribute__((address_space(3))) bf16x8*)(kp+4096); kf[5]=*(const __attribute__((address_space(3))) bf16x8*)(kp+4608);
  kf[6]=*(const __attribute__((address_space(3))) bf16x8*)(kp+6144); kf[7]=*(const __attribute__((address_space(3))) bf16x8*)(kp+6656);
}
__device__ __forceinline__ void kload2(bf16x8*kf,lds_cptr kp,int j){ kf[2*j]=*(const __attribute__((address_space(3))) bf16x8*)(kp+j*2048); kf[2*j+1]=*(const __attribute__((address_space(3))) bf16x8*)(kp+j*2048+512); }
__device__ __forceinline__ s16x4 vtr(lds_cptr p){ return __builtin_bit_cast(s16x4,__builtin_amdgcn_ds_read_tr16_b64_v4i16((__attribute__((address_space(3))) v4i16_t*)p)); }
__device__ __forceinline__ float rowmax(const f32x16&p0,const f32x16&p1){
  float a=max3f(p0[0],p0[1],p1[0]),b=max3f(p0[2],p0[3],p1[1]);a=max3f(a,p1[2],p1[3]);
  #pragma unroll
  for(int r=4;r<16;r+=4){a=max3f(a,p0[r],p0[r+1]);b=max3f(b,p0[r+2],p0[r+3]);a=max3f(a,p1[r],p1[r+1]);b=max3f(b,p1[r+2],p1[r+3]);}
  const float m=max2f(a,b);
  auto rr=__builtin_amdgcn_permlane32_swap(__float_as_uint(m),__float_as_uint(m),false,false);
  return max2f(__uint_as_float(rr[0]),__uint_as_float(rr[1]));
}
__device__ __forceinline__ void pv(f32x16*o,int vb,bf16x8 pa0,bf16x8 pa1,bf16x8 pa2,bf16x8 pa3){
  #pragma unroll
  for(int d0=0;d0<2;++d0){s16x4 lo[4],hi[4];
    #pragma unroll
    for(int ks=0;ks<4;++ks){
      asm volatile("ds_read_b64_tr_b16 %0,%1 offset:%c2":"=&v"(lo[ks]):"v"(vb),"i"(d0*4096+ks*1024):"memory");
      asm volatile("ds_read_b64_tr_b16 %0,%1 offset:%c2":"=&v"(hi[ks]):"v"(vb),"i"(d0*4096+ks*1024+512):"memory");}
    asm volatile("s_waitcnt lgkmcnt(0)":::"memory");SBAR();
    #define PK(k) (bf16x8){lo[k][0],lo[k][1],lo[k][2],lo[k][3],hi[k][0],hi[k][1],hi[k][2],hi[k][3]}
    o[d0]=__builtin_amdgcn_mfma_f32_32x32x16_bf16(pa0,PK(0),o[d0],0,0,0);
    o[d0]=__builtin_amdgcn_mfma_f32_32x32x16_bf16(pa1,PK(1),o[d0],0,0,0);
    o[d0]=__builtin_amdgcn_mfma_f32_32x32x16_bf16(pa2,PK(2),o[d0],0,0,0);
    o[d0]=__builtin_amdgcn_mfma_f32_32x32x16_bf16(pa3,PK(3),o[d0],0,0,0);
    #undef PK
  }
}

#ifndef ATTN_STORE16
#define ATTN_STORE16(p,v) (*(u32x4*)(p)=(v))
#endif
template<int THRL> __device__ __forceinline__ void attn_unit(int b,int h,int qb,const bf16*Q,const bf16*__restrict__ K,const bf16*__restrict__ V,bf16*O,const unsigned*__restrict__ MK,char*shm){
  const int tid=mk_tidx(),lane=tid&63,r32=lane&31,hi=lane>>5; const int wid=__builtin_amdgcn_readfirstlane(tid>>6);
  const long rowbase=(long)b*SEQ; const int q0=qb*QB;
  const bf16*Qw=Q+(rowbase+q0+wid*QBLK)*DM+h*D;
  const bf16*Kh=K+rowbase*DM+h*D,*Vh=V+rowbase*DM+h*D;
  const unsigned lds0=(unsigned)(uintptr_t)shm;
  float*wsf=(float*)(shm+LDS_WS)+wid*64;
  const bf16*ksrc=Kh+(long)lane*DM+wid*8;
  const bf16*vsrc=Vh+(long)(16*(wid&3)+(lane>>2))*DM+(wid>>2)*32+(lane&3)*8;
  const unsigned kdst=lds0+LDS_K+wid*1024, vdst=lds0+LDS_V+wid*1024;
  const unsigned*msrc=MK+((size_t)(b*128+8*qb+wid)*64)*64+lane; const unsigned mdst=lds0+LDS_MSK+wid*768;
  const __attribute__((address_space(3))) char*mrd=(__attribute__((address_space(3))) const char*)shm+LDS_MSK+wid*768+lane*4;
  int mq_cur=0,mq_n1=256,mq_n2=512;
  #define DMA_M(t,slot) glds4(msrc+(size_t)(t)*64,(unsigned)__builtin_amdgcn_readfirstlane(mdst+(slot)))
  #define MWORD() (*(const __attribute__((address_space(3))) unsigned*)(mrd+mq_cur))
  #define DMA_K(t,slot) glds16(ksrc+(long)(t)*KVBLK*DM,(unsigned)__builtin_amdgcn_readfirstlane(kdst+(slot)))
  #define DMA_V(t,slot) glds16(vsrc+(long)(t)*KVBLK*DM,(unsigned)__builtin_amdgcn_readfirstlane(vdst+(slot)))
  const int vb0=(int)(lds0+LDS_V)+((lane>>4)&1)*32+(lane&3)*8+(4*hi+((lane&15)>>2))*64;
  const char*Kbase=shm+LDS_K; bf16x8 kf[8];
  const lds_cptr shm3=(lds_cptr)shm; const lds_cptr kp0=shm3+LDS_K+hi*1024+r32*16; const lds_cptr vp0=shm3+LDS_V+((lane>>4)&1)*32+(lane&3)*8+(4*hi+((lane&15)>>2))*64;
  const int NT=(q0+QB)/KVBLK;
  DMA_M(0,0);DMA_M(1,256);DMA_K(0,0);DMA_V(0,0);DMA_K(1,SLOTB);
  bf16x8 qr[4];
  #pragma unroll
  for(int d0=0;d0<4;++d0)qr[d0]=*reinterpret_cast<const bf16x8*>(&Qw[(long)r32*DM+d0*16+hi*8]);
  float mhat=0.f,l_reg=0.f;f32x16 o[2];o[0]=f32x16{};o[1]=f32x16{};f32x16 negm=f32x16{};asm volatile("":"+v"(negm));
  const int qrel=wid*QBLK+r32;
  #define CMASK(P0,P1,t) do{}while(0)
  bool resc=false;
  #define START(P0,P1) do{ const float rm=rowmax(P0,P1); resc=false; \
    { const float dl=(rm>-1e30f)?rm:0.f; mhat=fadd_s(mhat,dl); \
      _Pragma("unroll") for(int r=0;r<16;++r){P0[r]=fsub_s(P0[r],dl);P1[r]=fsub_s(P1[r],dl);} \
      _Pragma("unroll") for(int r=0;r<16;++r)negm[r]=-mhat; asm volatile("":"+v"(negm)); } \
    _Pragma("unroll") for(int r=0;r<16;++r)P0[r]=__builtin_amdgcn_exp2f(P0[r]); }while(0)
  #define RESC() do{ if(resc){ asm volatile("s_waitcnt lgkmcnt(0)":::"memory"); \
      _Pragma("unroll") for(int d_=0;d_<2;++d_) _Pragma("unroll") for(int r=0;r<16;++r)o[d_][r]*=wsf[crow(r,hi)]; } }while(0)
  f32x16 pA0,pA1,pB0,pB1;
  int sl_prev=0,sl_cur=0,sl_next=SLOTB;
  #define ROT() do{sl_prev=sl_cur;sl_cur=sl_next;sl_next=(sl_next==(NSLOT-1)*SLOTB)?0:sl_next+SLOTB; const int mt_=mq_cur;mq_cur=mq_n1;mq_n1=mq_n2;mq_n2=mt_;}while(0)
  DMA_K(2,2*SLOTB);
  WAIT_BAR(3);
  qkt(pA0,pA1,Kbase,qr,negm,r32,hi);asm volatile("s_nop 15\n\ts_nop 7":"+v"(pA0),"+v"(pA1));CMASK(pA0,pA1,0);
  START(pA0,pA1);
  _Pragma("unroll") for(int r=0;r<16;++r)pA1[r]=__builtin_amdgcn_exp2f(pA1[r]);
  { const unsigned mw0=MWORD(); pA0[0]=mand<0>(pA0[0],mw0);pA1[0]=mand<16>(pA1[0],mw0);pA0[1]=mand<1>(pA0[1],mw0);pA1[1]=mand<17>(pA1[1],mw0);pA0[2]=mand<2>(pA0[2],mw0);pA1[2]=mand<18>(pA1[2],mw0);pA0[3]=mand<3>(pA0[3],mw0);pA1[3]=mand<19>(pA1[3],mw0);pA0[4]=mand<4>(pA0[4],mw0);pA1[4]=mand<20>(pA1[4],mw0);pA0[5]=mand<5>(pA0[5],mw0);pA1[5]=mand<21>(pA1[5],mw0);pA0[6]=mand<6>(pA0[6],mw0);pA1[6]=mand<22>(pA1[6],mw0);pA0[7]=mand<7>(pA0[7],mw0);pA1[7]=mand<23>(pA1[7],mw0);pA0[8]=mand<8>(pA0[8],mw0);pA1[8]=mand<24>(pA1[8],mw0);pA0[9]=mand<9>(pA0[9],mw0);pA1[9]=mand<25>(pA1[9],mw0);pA0[10]=mand<10>(pA0[10],mw0);pA1[10]=mand<26>(pA1[10],mw0);pA0[11]=mand<11>(pA0[11],mw0);pA1[11]=mand<27>(pA1[11],mw0);pA0[12]=mand<12>(pA0[12],mw0);pA1[12]=mand<28>(pA1[12],mw0);pA0[13]=mand<13>(pA0[13],mw0);pA1[13]=mand<29>(pA1[13],mw0);pA0[14]=mand<14>(pA0[14],mw0);pA1[14]=mand<30>(pA1[14],mw0);pA0[15]=mand<15>(pA0[15],mw0);pA1[15]=mand<31>(pA1[15],mw0); }
  WAIT_BAR(0);
  DMA_M(2,512);DMA_K(3,0);DMA_V(1,SLOTB);
  ROT();
  kload8(kf,kp0+sl_cur);
  WAIT_BAR(3);
  s16x4 vlo[8],vhi[8]; u32x4 pw0,pw1,pw2,pw3;
  #define PKW(P,B) cvtpk_s(P[B],P[B+1])
  #define PAF(k) __builtin_bit_cast(bf16x8,pw##k)
  #define VFR(i) (bf16x8){vlo[i][0],vlo[i][1],vlo[i][2],vlo[i][3],vhi[i][0],vhi[i][1],vhi[i][2],vhi[i][3]}
  #define PIN(x) asm volatile("":"+v"(x))
  #define MX3(a,b,c) __builtin_fmaxf(__builtin_fmaxf((a),(b)),(c))
  #define GAPA(MF,A0,A1,A2,A3,W0,W1,PW) do{ MF; sacc+=A0; sacc+=A1; sacc+=A2; sacc+=A3; PIN(sacc); W0; W1; PIN(PW); SBAR(); }while(0)
  #define EX(v) __builtin_amdgcn_exp2f(v)
  #define GAPB(MF,X,B,MO) do{ MF; X[B]=mand<MO+B>(EX(X[B]),mw_); X[B+1]=mand<MO+B+1>(EX(X[B+1]),mw_); X[B+2]=mand<MO+B+2>(EX(X[B+2]),mw_); X[B+3]=mand<MO+B+3>(EX(X[B+3]),mw_); PIN(X); SBAR(); }while(0)
  #define VRD(i) do{ vlo[i]=vtr(vp_+(((i)>>2)*4096+((i)&3)*1024)); vhi[i]=vtr(vp_+(((i)>>2)*4096+((i)&3)*1024+512)); }while(0)
  #define KRD(G,j) do{ if(G){ kload2(kf,kp0+sl_next,j); SBAR(); } }while(0)
  #define STEP(C0,C1,P0,P1,t,GK,GV,GL,GM) do{ SBAR(); \
    const lds_cptr vp_=vp0+sl_prev; \
    VRD(0); SBAR(); float sacc=(P0[0]+P0[1]); \
    GAPA(C0=__builtin_amdgcn_mfma_f32_32x32x16_bf16(kf[0],qr[0],negm,0,0,0), P0[2],P0[3],P0[4],P0[5],     pw0[0]=PKW(P0,0), pw0[1]=PKW(P0,2), pw0); \
    VRD(4); SBAR(); GAPA(C1=__builtin_amdgcn_mfma_f32_32x32x16_bf16(kf[1],qr[0],negm,0,0,0), P0[6],P0[7],P0[8],P0[9],     pw0[2]=PKW(P0,4), pw0[3]=PKW(P0,6), pw0); \
    VRD(1); SBAR(); GAPA(C0=__builtin_amdgcn_mfma_f32_32x32x16_bf16(kf[2],qr[1],C0,0,0,0),   P0[10],P0[11],P0[12],P0[13], pw1[0]=PKW(P0,8), pw1[1]=PKW(P0,10), pw1); \
    VRD(5); SBAR(); GAPA(C1=__builtin_amdgcn_mfma_f32_32x32x16_bf16(kf[3],qr[1],C1,0,0,0),   P0[14],P0[15],P1[0],P1[1],   pw1[2]=PKW(P0,12),pw1[3]=PKW(P0,14), pw1); \
    VRD(2); SBAR(); GAPA(C0=__builtin_amdgcn_mfma_f32_32x32x16_bf16(kf[4],qr[2],C0,0,0,0),   P1[2],P1[3],P1[4],P1[5],     pw2[0]=PKW(P1,0), pw2[1]=PKW(P1,2), pw2); \
    VRD(6); SBAR(); GAPA(C1=__builtin_amdgcn_mfma_f32_32x32x16_bf16(kf[5],qr[2],C1,0,0,0),   P1[6],P1[7],P1[8],P1[9],     pw2[2]=PKW(P1,4), pw2[3]=PKW(P1,6), pw2); \
    VRD(3); SBAR(); GAPA(C0=__builtin_amdgcn_mfma_f32_32x32x16_bf16(kf[6],qr[3],C0,0,0,0),   P1[10],P1[11],P1[12],P1[13], pw3[0]=PKW(P1,8), pw3[1]=PKW(P1,10), pw3); \
    VRD(7); SBAR(); GAPA(C1=__builtin_amdgcn_mfma_f32_32x32x16_bf16(kf[7],qr[3],C1,0,0,0),   P1[14],P1[15],0.f,0.f,       pw3[2]=PKW(P1,12),pw3[3]=PKW(P1,14), pw3); \
    l_reg+=sacc; \
    if(GM){DMA_M((t)+2,mq_n2);} if(GK){DMA_K((t)+3,sl_cur);} if(GV){DMA_V((t)+1,sl_next);} \
    const unsigned mw_=MWORD(); \
    CMASK(C0,C1,t); \
    { float a=MX3(C0[0],C0[1],C1[0]),b=MX3(C0[2],C0[3],C1[1]); a=MX3(a,C1[2],C1[3]); \
      _Pragma("unroll") for(int r=4;r<16;r+=4){a=MX3(a,C0[r],C0[r+1]);b=MX3(b,C0[r+2],C0[r+3]);a=MX3(a,C1[r],C1[r+1]);b=MX3(b,C1[r+2],C1[r+3]);} \
      float rm=__builtin_fmaxf(a,b); { auto rr=__builtin_amdgcn_permlane32_swap(__float_as_uint(rm),__float_as_uint(rm),false,false); rm=__builtin_fmaxf(__uint_as_float(rr[0]),__uint_as_float(rr[1])); } \
      resc=false; \
      if(__builtin_expect(__any(rm>(float)THRL),0)){ const float dl=__builtin_fmaxf(rm,0.f); mhat+=dl; \
        _Pragma("unroll") for(int r=0;r<16;++r){C0[r]-=dl;C1[r]-=dl;} \
        _Pragma("unroll") for(int r=0;r<16;++r)negm[r]=-mhat; asm volatile("":"+v"(negm)); \
        const float f=__builtin_amdgcn_exp2f(-dl); l_reg*=f; if(hi==0)wsf[r32]=f; resc=true; } } \
    SBAR(); \
    GAPB(o[0]=__builtin_amdgcn_mfma_f32_32x32x16_bf16(PAF(0),VFR(0),o[0],0,0,0), C0,0,0); \
    GAPB(o[1]=__builtin_amdgcn_mfma_f32_32x32x16_bf16(PAF(0),VFR(4),o[1],0,0,0), C0,4,0); \
    KRD(GL,0); GAPB(o[0]=__builtin_amdgcn_mfma_f32_32x32x16_bf16(PAF(1),VFR(1),o[0],0,0,0), C0,8,0); \
    KRD(GL,1); GAPB(o[1]=__builtin_amdgcn_mfma_f32_32x32x16_bf16(PAF(1),VFR(5),o[1],0,0,0), C0,12,0); \
    KRD(GL,2); GAPB(o[0]=__builtin_amdgcn_mfma_f32_32x32x16_bf16(PAF(2),VFR(2),o[0],0,0,0), C1,0,16); \
    KRD(GL,3); GAPB(o[1]=__builtin_amdgcn_mfma_f32_32x32x16_bf16(PAF(2),VFR(6),o[1],0,0,0), C1,4,16); \
    GAPB(o[0]=__builtin_amdgcn_mfma_f32_32x32x16_bf16(PAF(3),VFR(3),o[0],0,0,0), C1,8,16); \
    GAPB(o[1]=__builtin_amdgcn_mfma_f32_32x32x16_bf16(PAF(3),VFR(7),o[1],0,0,0), C1,12,16); \
    }while(0)
  int t=1;
  #undef CMASK
  #define CMASK(P0,P1,t) do{}while(0)
  for(;t+5<NT;t+=2){
    STEP(pB0,pB1,pA0,pA1,t,true,true,true,true);     WAIT_BAR(3); RESC(); ROT();
    STEP(pA0,pA1,pB0,pB1,t+1,true,true,true,true);   WAIT_BAR(3); RESC(); ROT();
  }
  #undef CMASK
  #define CMASK(P0,P1,t) do{}while(0)
  #define ENDW(tt) do{ if((tt)+3<NT){WAIT_BAR(3);} else if((tt)+2<NT){WAIT_BAR(2);} else {WAIT_BAR(0);} }while(0)
  for(;t+1<NT;t+=2){
    STEP(pB0,pB1,pA0,pA1,t,(t+3<NT),(t+1<NT),(t+1<NT),(t+2<NT));       ENDW(t);   RESC(); ROT();
    STEP(pA0,pA1,pB0,pB1,t+1,(t+4<NT),(t+2<NT),(t+2<NT),(t+3<NT));     ENDW(t+1); RESC(); ROT();
  }
  STEP(pB0,pB1,pA0,pA1,NT-1,false,false,false,false); RESC();
  { float sacc=pB0[0]+pB0[1]; _Pragma("unroll") for(int r=2;r<16;++r)sacc+=pB0[r]; _Pragma("unroll") for(int r=0;r<16;++r)sacc+=pB1[r]; l_reg+=sacc;
    pw0=(u32x4){PKW(pB0,0),PKW(pB0,2),PKW(pB0,4),PKW(pB0,6)};pw1=(u32x4){PKW(pB0,8),PKW(pB0,10),PKW(pB0,12),PKW(pB0,14)};pw2=(u32x4){PKW(pB1,0),PKW(pB1,2),PKW(pB1,4),PKW(pB1,6)};pw3=(u32x4){PKW(pB1,8),PKW(pB1,10),PKW(pB1,12),PKW(pB1,14)};
    SBAR(); pv(o,vb0+sl_cur,PAF(0),PAF(1),PAF(2),PAF(3)); }
  #undef PKW
  #undef PAF
  #undef VFR
  #undef PIN
  #undef MX3
  #undef GAPA
  #undef GAPB
  #undef EX
  #undef VRD
  #undef KRD
  #undef STEP
  #undef ENDW
  {auto rr=__builtin_amdgcn_permlane32_swap(__float_as_uint(l_reg),__float_as_uint(l_reg),false,false);l_reg=__uint_as_float(rr[0])+__uint_as_float(rr[1]);}
  if(hi==0)wsf[32+r32]=l_reg;asm volatile("s_waitcnt lgkmcnt(0)":::"memory");
  float rli[16];
  #pragma unroll
  for(int r=0;r<16;++r)rli[r]=__builtin_amdgcn_rcpf(wsf[32+crow(r,hi)]);
  bf16*Ow=O+(rowbase+q0+wid*QBLK)*ODM+h*D;
  { bf16*stg=(bf16*)(shm+LDS_OST)+wid*2048;
    #pragma unroll
    for(int r=0;r<16;++r){const int orow=crow(r,hi);
      #pragma unroll
      for(int d0=0;d0<2;++d0)stg[orow*64+d0*32+r32]=(bf16)(cvtpk_s(o[d0][r]*rli[r],0.f)&0xffffu);}
    asm volatile("s_waitcnt lgkmcnt(0)":::"memory");
    #pragma unroll
    for(int i=0;i<4;++i){const int row=i*8+(lane>>3),ch=lane&7; const u32x4 v=*(const u32x4*)(stg+row*64+ch*8); ATTN_STORE16(Ow+(long)row*ODM+ch*8,v);} }
  asm volatile("s_waitcnt lgkmcnt(0)\n\ts_barrier":::"memory");
  #undef DMA_K
  #undef DMA_V
  #undef DMA_M
  #undef MWORD
  #undef CMASK
  #undef START
  #undef RESC
  #undef ROT
}
constexpr int ATTN_LDS_BYTES=LDS_BYTES;
struct AttnTensors { const bf16* Q; const bf16* K; const bf16* V; bf16* O; const unsigned* MK; };
struct AttnUnit { int bh; int qb; };
struct StaticOrder {
  int vcu;
  __device__ __forceinline__ explicit StaticOrder(int grid,int block):vcu((block%8)*(grid/8)+block/8){}
  __device__ __forceinline__ bool next(int i,AttnUnit&u)const{ if(i>=2)return false; const int s=vcu&7; u.bh=vcu>>3; u.qb=(i==0)?15-s:s; return true; }
  __device__ __forceinline__ void a_ready(const AttnUnit&)const{}
  __device__ __forceinline__ void done(const AttnUnit&)const{}
};
template<class Sched,int THRL=8> __device__ __forceinline__ void attn_phase(char*lds,const AttnTensors&T,const Sched&S){
  AttnUnit u;
  for(int i=0;S.next(i,u);++i){ S.a_ready(u); attn_unit<THRL>(u.bh/NHEAD,u.bh%NHEAD,u.qb,T.Q,T.K,T.V,T.O,T.MK,lds); S.done(u); }
}
#undef SBAR
#undef WAIT_BAR
}
namespace mk {
#define GAS __attribute__((address_space(1)))
typedef unsigned short bf16_t;
typedef float f32x4 __attribute__((ext_vector_type(4)));
typedef float f32x2 __attribute__((ext_vector_type(2)));
typedef float f32x16 __attribute__((ext_vector_type(16)));
typedef unsigned u32x4 __attribute__((ext_vector_type(4)));
typedef unsigned u32x2 __attribute__((ext_vector_type(2)));
typedef short bf16x8 __attribute__((ext_vector_type(8)));
constexpr int NB = 4, S = 4096, T = NB * S, D = 1024;
constexpr int NWAVES = 8, NTHR = 512;
constexpr int INW = 4168;
constexpr int NPHYS = 4352;
constexpr float C2 = 0.125f * 1.4426950408889634f;
constexpr float WI_SCALE = 0.04419417382415922f;
constexpr float KR_SCALE = 0.08838834764831845f;
constexpr size_t MiB = 1u << 20;
#ifndef WS_RT_MIB
#define WS_RT_MIB 65
#endif
constexpr size_t WS_CTL = 0, CTL_BYTES = 131072;
constexpr size_t WS_MOD = 1 * MiB;
constexpr size_t WS_THR = 2 * MiB;
constexpr size_t WS_R128 = 3 * MiB;
constexpr size_t WS_R64 = 11 * MiB;
constexpr size_t WS_WOUT = 15 * MiB;
constexpr size_t WS_QA = 17 * MiB, WS_KA = 33 * MiB, WS_VA = 49 * MiB, WS_QI = 65 * MiB, WS_KI = 81 * MiB, WS_WI = 83 * MiB;
constexpr size_t WS_QR = 84 * MiB, WS_KR = 100 * MiB, WS_VR = 116 * MiB, WS_GR = 132 * MiB;
constexpr size_t WS_H = 148 * MiB;
constexpr size_t WS_WIN = 180 * MiB;
constexpr size_t WS_SCORES = 148 * MiB, WS_KVS = 214 * MiB, WS_MASKT = 246 * MiB, WS_RT = WS_RT_MIB * MiB, WS_MIXED = 148 * MiB;
constexpr int CW_BAR = 1024, CW_Q = 14400, CW_TMO = 14600;
constexpr int RING_BYTES = 131072;
constexpr int LDS_BYTES = 163840;
constexpr int MISC_OFF = LDS_BYTES - 1024;

typedef __bf16 bf16x2_t __attribute__((ext_vector_type(2)));
__device__ __forceinline__ unsigned cvt_pk(float lo, float hi) { const f32x2 v = {lo, hi}; const bf16x2_t b = __builtin_convertvector(v, bf16x2_t); return __builtin_bit_cast(unsigned, b); }
__device__ __forceinline__ float bf2f(bf16_t v) { return __uint_as_float((unsigned)v << 16); }
__device__ __forceinline__ float silu_f(float x) { return x / (1.f + __expf(-x)); }
#define MK_DPP_ADD(v, ctrl) v += __uint_as_float((unsigned)__builtin_amdgcn_update_dpp(0, (int)__float_as_uint(v), ctrl, 0xf, 0xf, false))
__device__ __forceinline__ float wave_sum(float v) {
    MK_DPP_ADD(v, 0xB1);
    MK_DPP_ADD(v, 0x4E);
    MK_DPP_ADD(v, 0x141);
    MK_DPP_ADD(v, 0x140);
    { const unsigned u = __float_as_uint(v); auto r = __builtin_amdgcn_permlane16_swap(u, u, false, false); v = __uint_as_float(r[0]) + __uint_as_float(r[1]); }
    { const unsigned u = __float_as_uint(v); auto r = __builtin_amdgcn_permlane32_swap(u, u, false, false); v = __uint_as_float(r[0]) + __uint_as_float(r[1]); }
    return v;
}
__host__ __device__ __forceinline__ int perm_fwd(int o, int half) { const int hi = o >= half ? 1 : 0, oo = o - hi * half; return 8 * (oo >> 2) + 4 * hi + (oo & 3); }
__host__ __device__ __forceinline__ int perm_inv(int p, int half) { const int g = p >> 3, r = p & 7; return (r < 4) ? 4 * g + r : half + 4 * g + (r - 4); }
__device__ __forceinline__ int in_src_col(int n) {
    const int tile = n >> 8;
    if (tile < 2) { const int s = n; return 0 + (s & ~63) + perm_inv(s & 63, 32); }
    if (tile < 4) { const int s = n - 512; return 512 + (s & ~63) + perm_inv(s & 63, 32); }
    if (tile < 6) return n;
    if (tile < 8) { const int s = n - 1536; return 1536 + (s & ~63) + perm_inv(s & 63, 32); }
    if (tile == 8) { const int s = n - 2048; if (s < 64) return 2048 + perm_inv(s, 32); if (s < 72) return 2112 + (s - 64); return -1; }
    const int s = n - 2304;
    if (tile < 11) return 2120 + (s & ~127) + perm_inv(s & 127, 64);
    if (tile < 13) { const int q = s - 512; return 2632 + (q & ~127) + perm_inv(q & 127, 64); }
    if (tile < 15) return 3144 + (s - 1024);
    return 3656 + (s - 1536);
}
__device__ __forceinline__ void p0_item_ada(LAS unsigned char* lds, const float* c, const float* w_ada, const float* b_ada, float* mod, int j, int tid) {
    LAS float* sc = (LAS float*)lds; LAS float* part = (LAS float*)(lds + 16384);
    __syncthreads();
    for (int i = tid; i < 4096; i += NTHR) sc[i] = silu_f(c[i]);
    __syncthreads();
    const int col = tid & 31, kg = tid >> 5;
    float a0 = 0.f, a1 = 0.f, a2 = 0.f, a3 = 0.f;
    const float* w = w_ada + 32 * j + col;
#pragma unroll 1
    for (int k0 = kg; k0 < 1024; k0 += 256) {
        float wv[16];
#pragma unroll
        for (int i = 0; i < 16; ++i) wv[i] = w[(size_t)(k0 + 16 * i) * 6144];
#pragma unroll
        for (int i = 0; i < 16; ++i) { const int k = k0 + 16 * i; a0 += sc[k] * wv[i]; a1 += sc[1024 + k] * wv[i]; a2 += sc[2048 + k] * wv[i]; a3 += sc[3072 + k] * wv[i]; }
    }
    part[(kg * 32 + col) * 4 + 0] = a0; part[(kg * 32 + col) * 4 + 1] = a1; part[(kg * 32 + col) * 4 + 2] = a2; part[(kg * 32 + col) * 4 + 3] = a3;
    __syncthreads();
    if (tid < 128) {
        const int cc = tid >> 2, b = tid & 3; float s = 0.f;
#pragma unroll
        for (int g = 0; g < 16; ++g) s += part[(g * 32 + cc) * 4 + b];
        mod[b * 6144 + 32 * j + cc] = s + b_ada[32 * j + cc];
    }
}
__device__ __forceinline__ void p0_item_rope(const int* pos, float* R128, float* R64, int r, int lane) {
    const float f128 = powf(10000.f, -(float)lane / 64.f), f64 = powf(10000.f, -(float)(lane & 31) / 32.f);
    for (int tt = 0; tt < 16; ++tt) {
        const int t = 16 * r + tt;
        float sn, cs; sincosf((float)pos[t] * f128, &sn, &cs);
        *(f32x2*)(R128 + ((size_t)t * 64 + lane) * 2) = (f32x2){cs, sn};
    }
    for (int tt = 0; tt < 16; tt += 2) {
        const int t = 16 * r + tt + (lane >> 5);
        float sn, cs; sincosf((float)pos[t] * f64, &sn, &cs);
        *(f32x2*)(R64 + ((size_t)t * 32 + (lane & 31)) * 2) = (f32x2){cs, sn};
    }
}
template <int MODE> struct TrItem { const float* sp; int ldw, Kdim, n0, k0; bf16_t* WT; bool valid; };
template <int MODE> __device__ __forceinline__ void p0_tr_setup(TrItem<MODE>& it, const float* W, const float* W2, int ldw, int Kdim, bf16_t* WT, int n0, int k0, int lane) {
    const int nl = lane & 31, n = n0 + nl;
    int src = n; const float* Ws = W;
    if (MODE == 0) src = in_src_col(n);
    if (MODE == 2) { const int g = n >> 3, r = n & 7; src = 4 * g + (r & 3); Ws = (r < 4) ? W : W2; }
    it.sp = Ws + (size_t)(k0 + (lane >> 5)) * ldw + (src >= 0 ? src : 0); it.ldw = ldw; it.Kdim = Kdim; it.n0 = n0; it.k0 = k0; it.WT = WT; it.valid = (src >= 0);
}
template <int MODE> __device__ __forceinline__ void p0_tr_load(const TrItem<MODE>& it, float (&tv)[32]) {
#pragma unroll
    for (int i = 0; i < 32; ++i) tv[i] = it.sp[(size_t)(2 * i) * it.ldw];
}
template <int MODE> __device__ __forceinline__ void p0_tr_emit(const TrItem<MODE>& it, const float (&tv)[32], LAS float* scr, int lane) {
    const int nl = lane & 31;
#pragma unroll
    for (int i = 0; i < 32; ++i) scr[(2 * i + (lane >> 5)) * 33 + nl] = it.valid ? tv[i] : 0.f;
    asm volatile("s_waitcnt lgkmcnt(0)" ::: "memory");
    const int c = lane & 7;
#pragma unroll
    for (int j = 0; j < 4; ++j) {
        const int nn = (lane >> 3) + 8 * j; const LAS float* q = scr + (8 * c) * 33 + nn;
        u32x4 o; o.x = cvt_pk(q[0 * 33], q[1 * 33]); o.y = cvt_pk(q[2 * 33], q[3 * 33]); o.z = cvt_pk(q[4 * 33], q[5 * 33]); o.w = cvt_pk(q[6 * 33], q[7 * 33]);
        *(u32x4*)(it.WT + (size_t)(it.n0 + nn) * it.Kdim + it.k0 + 8 * c) = o;
    }
    asm volatile("s_waitcnt lgkmcnt(0)" ::: "memory");
}
template <int MODE> __device__ __forceinline__ void p0_tr_item(const float* W, const float* W2, int ldw, int Kdim, bf16_t* WT, int n0, int k0, LAS float* scr, int lane) {
    TrItem<MODE> it; p0_tr_setup<MODE>(it, W, W2, ldw, Kdim, WT, n0, k0, lane);
    float tv[32]; p0_tr_load<MODE>(it, tv); p0_tr_emit<MODE>(it, tv, scr, lane);
}
struct P0Args { const float *c, *w_ada, *b_ada, *w_in, *w_out, *w_gate, *w_up, *w_down; const int* pos; float *mod, *R128, *R64; bf16_t *WIN, *WOUT, *WGU, *WD; };
__device__ __forceinline__ void p0_prologue(LAS unsigned char* lds, const P0Args& a, int bid, int G, int tid) {
    const int lane = tid & 63, wave = tid >> 6;
    if (bid < 192) p0_item_ada(lds, a.c, a.w_ada, a.b_ada, a.mod, bid, tid);
    __syncthreads();
    LAS float* scr = (LAS float*)(lds + wave * 8448);
    constexpr int I_ROPE = 1024, I_WIN = 16 * (NPHYS / 32), I_WOUT = 16 * 32;
    for (int it = bid * NWAVES + wave; it < I_ROPE + I_WIN + I_WOUT; it += G * NWAVES) {
        int r = it;
        if (r < I_ROPE) { p0_item_rope(a.pos, a.R128, a.R64, r, lane); continue; } r -= I_ROPE;
        if (r < I_WIN) { const int kb = r / (NPHYS / 32), nb = r - kb * (NPHYS / 32); p0_tr_item<0>(a.w_in, nullptr, INW, 1024, a.WIN, 32 * nb, 64 * kb, scr, lane); continue; } r -= I_WIN;
        { const int kb = r >> 5, nb = r & 31; p0_tr_item<1>(a.w_out, nullptr, 1024, 1024, a.WOUT, 32 * nb, 64 * kb, scr, lane); }
    }
}
__device__ __forceinline__ void p0_expert_items(LAS unsigned char* lds, const P0Args& a, int gw, int ngw, int tid) {
    const int lane = tid & 63, wave = tid >> 6;
    LAS float* scr = (LAS float*)(lds + wave * 8448);
    constexpr int I_WGU = 32 * 256, I_WD = 32 * 128;
    {
        TrItem<2> cur, nxt; float tv[32], tn[32];
        int it = gw;
        if (it < I_WGU) { const int e = it >> 8, q = it & 255, kb = q >> 4, nb = q & 15;
            p0_tr_setup<2>(cur, a.w_gate + (size_t)e * 262144, a.w_up + (size_t)e * 262144, 256, 1024, a.WGU + (size_t)e * 524288, 32 * nb, 64 * kb, lane); p0_tr_load<2>(cur, tv); }
#pragma unroll 1
        for (; it < I_WGU; it += ngw) {
            const int i2 = it + ngw; const bool has = i2 < I_WGU;
            if (has) { const int e = i2 >> 8, q = i2 & 255, kb = q >> 4, nb = q & 15;
                p0_tr_setup<2>(nxt, a.w_gate + (size_t)e * 262144, a.w_up + (size_t)e * 262144, 256, 1024, a.WGU + (size_t)e * 524288, 32 * nb, 64 * kb, lane); p0_tr_load<2>(nxt, tn); }
            p0_tr_emit<2>(cur, tv, scr, lane);
            if (has) { cur = nxt;
#pragma unroll
                for (int i = 0; i < 32; ++i) tv[i] = tn[i]; }
        }
    }
    {
        TrItem<1> cur, nxt; float tv[32], tn[32];
        int it = gw;
        if (it < I_WD) { const int e = it >> 7, q = it & 127, kb = q >> 5, nb = q & 31;
            p0_tr_setup<1>(cur, a.w_down + (size_t)e * 262144, nullptr, 1024, 256, a.WD + (size_t)e * 262144, 32 * nb, 64 * kb, lane); p0_tr_load<1>(cur, tv); }
#pragma unroll 1
        for (; it < I_WD; it += ngw) {
            const int i2 = it + ngw; const bool has = i2 < I_WD;
            if (has) { const int e = i2 >> 7, q = i2 & 127, kb = q >> 5, nb = q & 31;
                p0_tr_setup<1>(nxt, a.w_down + (size_t)e * 262144, nullptr, 1024, 256, a.WD + (size_t)e * 262144, 32 * nb, 64 * kb, lane); p0_tr_load<1>(nxt, tn); }
            p0_tr_emit<1>(cur, tv, scr, lane);
            if (has) { cur = nxt;
#pragma unroll
                for (int i = 0; i < 32; ++i) tv[i] = tn[i]; }
        }
    }
}
__device__ __forceinline__ void p1_rows(const float* x, const float* g, const float* mod, bf16_t* H, int gw, int NGW, int lane) {
    for (int m = gw; m < T; m += NGW) {
        const int b = m / S;
        const f32x4* xr = (const f32x4*)(x + (size_t)m * D) + lane;
        f32x4 v[4]; float s = 0.f;
#pragma unroll
        for (int j = 0; j < 4; ++j) { v[j] = xr[64 * j]; s += (v[j].x * v[j].x + v[j].y * v[j].y) + (v[j].z * v[j].z + v[j].w * v[j].w); }
        const float rs = 1.0f / sqrtf(wave_sum(s) * (1.f / 1024.f) + 1e-6f);
        const float* sh = mod + b * 6144; const float* sc = sh + 1024;
        bf16_t* orow = H + (size_t)m * D;
#pragma unroll
        for (int j = 0; j < 4; ++j) {
            const int col = 4 * lane + 256 * j;
            const f32x4 gg = *(const f32x4*)(g + col), a = *(const f32x4*)(sc + col), bb = *(const f32x4*)(sh + col);
            const f32x4 o = v[j] * rs * gg * (a + 1.0f) + bb;
            u32x2 w; w.x = cvt_pk(o.x, o.y); w.y = cvt_pk(o.z, o.w);
            *(u32x2*)(orow + col) = w;
        }
    }
}
struct EpiInProj {
    static constexpr bool PERM = true, AFTER_DRAIN = false;
    bf16_t *QA, *KA, *VA, *QI, *KI, *QR, *KR, *VR, *GR; float* WI; const float* R64; const float* R128;
    template <int ROPE, int ACT> __device__ __forceinline__ void emit(const pg8::f32x4 (&acc)[2][2][4][2], bf16_t* dst, int ld, int segbase, float scale, int row0, int wc, int fq, int bjmask) const {
#pragma unroll
        for (int bj = 0; bj < 2; ++bj) {
            if (!((bjmask >> bj) & 1)) continue;
            const int cg = segbase + 128 * bj + 32 * wc + 8 * fq;
            const int fi = (ROPE == 1) ? ((cg & 63) >> 1) : ((cg & 127) >> 1);
#pragma unroll
            for (int ai = 0; ai < 2; ++ai)
#pragma unroll
                for (int m = 0; m < 4; ++m) {
                    const int row = row0 + ai * 128 + m * 16;
                    pg8::f32x4 v0 = acc[ai][bj][m][0], v1 = acc[ai][bj][m][1];
                    if (ROPE != 0) {
                        const float* tp = (ROPE == 1) ? (R64 + ((size_t)row * 32 + fi) * 2) : (R128 + ((size_t)row * 64 + fi) * 2);
                        const pg8::f32x4 t0 = *(const pg8::f32x4*)tp, t1 = *(const pg8::f32x4*)(tp + 4);
                        pg8::f32x4 o1, o2;
                        o1[0] = v0[0] * t0[0] - v1[0] * t0[1]; o2[0] = v1[0] * t0[0] + v0[0] * t0[1];
                        o1[1] = v0[1] * t0[2] - v1[1] * t0[3]; o2[1] = v1[1] * t0[2] + v0[1] * t0[3];
                        o1[2] = v0[2] * t1[0] - v1[2] * t1[1]; o2[2] = v1[2] * t1[0] + v0[2] * t1[1];
                        o1[3] = v0[3] * t1[2] - v1[3] * t1[3]; o2[3] = v1[3] * t1[2] + v0[3] * t1[3];
                        v0 = o1; v1 = o2;
                    }
                    if (ACT == 1) {
#pragma unroll
                        for (int e = 0; e < 4; ++e) { v0[e] = silu_f(v0[e]); v1[e] = silu_f(v1[e]); }
                    }
                    v0 = v0 * scale; v1 = v1 * scale;
                    u32x4 w; w.x = cvt_pk(v0[0], v0[1]); w.y = cvt_pk(v0[2], v0[3]); w.z = cvt_pk(v1[0], v1[1]); w.w = cvt_pk(v1[2], v1[3]);
                    *(u32x4*)(dst + (size_t)row * ld + cg) = w;
                }
        }
    }
    __device__ __forceinline__ void operator()(const pg8::f32x4 (&acc)[2][2][4][2], const pg8::Unit& u, int wr, int wc, int fr, int fq) const {
        const int row0 = u.pm * 256 + wr * 64 + fr;
        const int pn = u.pn;
        if (pn < 2) emit<1, 0>(acc, QA, 512, pn * 256, C2, row0, wc, fq, 3);
        else if (pn < 4) emit<1, 0>(acc, KA, 512, (pn - 2) * 256, 1.f, row0, wc, fq, 3);
        else if (pn < 6) emit<0, 0>(acc, VA, 512, (pn - 4) * 256, 1.f, row0, wc, fq, 3);
        else if (pn < 8) emit<1, 0>(acc, QI, 512, (pn - 6) * 256, 1.f, row0, wc, fq, 3);
        else if (pn == 8) {
            if (wc < 2) emit<1, 0>(acc, KI, 64, 0, 1.f, row0, wc, fq, 1);
            else if (wc == 2 && fq == 0) {
#pragma unroll
                for (int ai = 0; ai < 2; ++ai)
#pragma unroll
                    for (int m = 0; m < 4; ++m) {
                        const int row = row0 + ai * 128 + m * 16;
                        *(pg8::f32x4*)(WI + (size_t)row * 8) = acc[ai][0][m][0] * WI_SCALE;
                        *(pg8::f32x4*)(WI + (size_t)row * 8 + 4) = acc[ai][0][m][1] * WI_SCALE;
                    }
            }
        }
        else if (pn < 11) emit<2, 0>(acc, QR, 512, (pn - 9) * 256, 1.f, row0, wc, fq, 3);
        else if (pn < 13) emit<2, 0>(acc, KR, 512, (pn - 11) * 256, KR_SCALE, row0, wc, fq, 3);
        else if (pn < 15) emit<0, 0>(acc, VR, 512, (pn - 13) * 256, 1.f, row0, wc, fq, 3);
        else emit<0, 1>(acc, GR, 512, (pn - 15) * 256, 1.f, row0, wc, fq, 3);
    }
};
typedef short v4i16_t __attribute__((ext_vector_type(4)));
__device__ __forceinline__ unsigned off_b(unsigned row, unsigned ch) { return 256u * row + 16u * (ch ^ (((row & 3u) << 2) | ((row >> 2) & 3u))); }
__device__ __forceinline__ int crow(int r, int hi) { return (r & 3) + 8 * (r >> 2) + 4 * hi; }
__device__ __forceinline__ v4i16_t tr_rd(LAS unsigned char* p) { return __builtin_amdgcn_ds_read_tr16_b64_v4i16((LAS v4i16_t*)p); }
__device__ __forceinline__ bf16x8 tr_frag_nat(LAS unsigned char* img, int lane, int c, int ks) {
    const unsigned h = lane >> 5, blk = (lane >> 4) & 1, q = (lane & 15) >> 2, p = lane & 3;
    const v4i16_t lo = tr_rd(img + off_b(16 * ks + 8 * h + q, 4 * c + 2 * blk + (p >> 1)) + 8 * (p & 1));
    const v4i16_t hi = tr_rd(img + off_b(16 * ks + 8 * h + 4 + q, 4 * c + 2 * blk + (p >> 1)) + 8 * (p & 1));
    return (bf16x8){lo[0], lo[1], lo[2], lo[3], hi[0], hi[1], hi[2], hi[3]};
}
__device__ __forceinline__ bf16x8 tr_frag_acc(LAS unsigned char* img, int lane, int c, int rowbase) {
    const unsigned h = lane >> 5, blk = (lane >> 4) & 1, q = (lane & 15) >> 2, p = lane & 3;
    const v4i16_t lo = tr_rd(img + off_b(rowbase + 4 * h + q, 4 * c + 2 * blk + (p >> 1)) + 8 * (p & 1));
    const v4i16_t hi = tr_rd(img + off_b(rowbase + 8 + 4 * h + q, 4 * c + 2 * blk + (p >> 1)) + 8 * (p & 1));
    return (bf16x8){lo[0], lo[1], lo[2], lo[3], hi[0], hi[1], hi[2], hi[3]};
}
__device__ __forceinline__ float ret_lgam(int h) { return logf(1.0f - exp2f(-5.0f - (float)h)); }
template <bool SCALE> __device__ __forceinline__ void ret_stage(LAS unsigned char* img, const bf16_t* src  , float sc, int tl) {
#pragma unroll
    for (int it = 0; it < 8; ++it) {
        const int idx = tl + 256 * it, row = idx >> 4, ch = idx & 15;
        u32x4 v = *(const u32x4*)(src + (size_t)row * 512 + ch * 8);
        if (SCALE) {
            const float f = expf(sc * (float)row);
#pragma unroll
            for (int e = 0; e < 4; ++e) { const unsigned w = v[e]; v[e] = cvt_pk(__uint_as_float(w << 16) * f, __uint_as_float(w & 0xffff0000u) * f); }
        }
        *(LAS u32x4*)(img + off_b(row, ch)) = v;
    }
}
__device__ __forceinline__ void ret_kv_pair(LAS unsigned char* lds, const bf16_t* KR, const bf16_t* VR, float* KVS, int pair, int tid) {
    const int uh = tid >> 8, tl = tid & 255, lane = tid & 63, w4 = __builtin_amdgcn_readfirstlane((tid >> 6) & 3), hi = lane >> 5, r32 = lane & 31;
    const int unit = pair * 2 + uh, n = unit & 31, bh = unit >> 5, b = bh >> 2, h = bh & 3;
    const size_t tok0 = (size_t)b * S + (size_t)n * 128;
    LAS unsigned char* kimg = lds + uh * 65536; LAS unsigned char* vimg = kimg + 32768;
    const float lgam = ret_lgam(h);
    __syncthreads();
    ret_stage<false>(kimg, KR + tok0 * 512 + h * 128, 0.f, tl);
    ret_stage<true>(vimg, VR + tok0 * 512 + h * 128, -lgam, tl);
    __syncthreads();
    f32x16 acc[4];
#pragma unroll
    for (int c = 0; c < 4; ++c) acc[c] = (f32x16){};
#pragma unroll
    for (int ks = 0; ks < 8; ++ks) {
        const bf16x8 a = tr_frag_nat(vimg, lane, w4, ks);
#pragma unroll
        for (int nt = 0; nt < 4; ++nt) { const bf16x8 bb = tr_frag_nat(kimg, lane, nt, ks); acc[nt] = __builtin_amdgcn_mfma_f32_32x32x16_bf16(a, bb, acc[nt], 0, 0, 0); }
    }
    const float sc = expf(lgam * 127.f);
    float* o = KVS + (size_t)unit * 16384;
#pragma unroll
    for (int nt = 0; nt < 4; ++nt)
#pragma unroll
        for (int r = 0; r < 16; ++r) o[(32 * w4 + crow(r, hi)) * 128 + 32 * nt + r32] = acc[nt][r] * sc;
}
__device__ __forceinline__ void ret_scan(const float* __restrict__ KVS, bf16_t* __restrict__ RT, int gtid, int nthreads) {
    for (int idx = gtid; idx < 16 * 16384; idx += nthreads) {
        const int bh = idx >> 14, el = idx & 16383, h = bh & 3;
        const float g = 1.0f - exp2f(-5.0f - (float)h), g128 = expf(128.f * ret_lgam(h));
        const size_t o0 = ((size_t)(bh * 32) << 14) + el;
        float kv[31];
#pragma unroll
        for (int n = 0; n < 31; ++n) kv[n] = KVS[o0 + ((size_t)n << 14)];
        float R = 0.f;
#pragma unroll
        for (int n = 0; n < 32; ++n) {
            RT[o0 + ((size_t)n << 14)] = (bf16_t)(cvt_pk(g * R, 0.f) & 0xffffu);
            if (n < 31) R = g128 * R + kv[n];
        }
    }
}
__device__ __forceinline__ void ret_out_pair(LAS unsigned char* lds, const bf16_t* QR, const bf16_t* KR, const bf16_t* VR, const bf16_t* GR, const bf16_t* RT, bf16_t* MIXED, int pair, int tid) {
    const int uh = tid >> 8, tl = tid & 255, lane = tid & 63, w4 = __builtin_amdgcn_readfirstlane((tid >> 6) & 3), hi = lane >> 5, r32 = lane & 31;
    const int unit = pair * 2 + uh, n = unit & 31, bh = unit >> 5, b = bh >> 2, h = bh & 3;
    const size_t tok0 = (size_t)b * S + (size_t)n * 128;
    LAS unsigned char* vimg = lds + uh * 32768;
    const float lgam = ret_lgam(h);
    __syncthreads();
    ret_stage<true>(vimg, VR + tok0 * 512 + h * 128, -lgam, tl);
    __syncthreads();
    bf16x8 qf[8];
    {
        const bf16_t* qp = QR + (tok0 + 32 * w4 + r32) * 512 + h * 128 + 8 * hi;
#pragma unroll
        for (int ks = 0; ks < 8; ++ks) qf[ks] = *(const bf16x8*)(qp + 16 * ks);
    }
    f32x16 acc[4];
#pragma unroll
    for (int c = 0; c < 4; ++c) acc[c] = (f32x16){};
    if (n > 0) {
        const bf16_t* rp = RT + (size_t)unit * 16384 + r32 * 128 + 8 * hi;
#pragma unroll
        for (int c = 0; c < 4; ++c)
#pragma unroll
            for (int ks = 0; ks < 8; ++ks) { const bf16x8 a = *(const bf16x8*)(rp + c * 32 * 128 + 16 * ks); acc[c] = __builtin_amdgcn_mfma_f32_32x32x16_bf16(a, qf[ks], acc[c], 0, 0, 0); }
    }
    for (int jt = 0; jt <= w4; ++jt) {
        const bf16_t* kp = KR + (tok0 + 32 * jt + r32) * 512 + h * 128 + 8 * hi;
        f32x16 st = (f32x16){};
#pragma unroll
        for (int ks = 0; ks < 8; ++ks) { const bf16x8 kf = *(const bf16x8*)(kp + 16 * ks); st = __builtin_amdgcn_mfma_f32_32x32x16_bf16(kf, qf[ks], st, 0, 0, 0); }
        if (jt == w4) {
#pragma unroll
            for (int r = 0; r < 16; ++r) if (crow(r, hi) > r32) st[r] = 0.f;
        }
#pragma unroll
        for (int s = 0; s < 2; ++s) {
            u32x4 pw; pw.x = cvt_pk(st[8 * s + 0], st[8 * s + 1]); pw.y = cvt_pk(st[8 * s + 2], st[8 * s + 3]); pw.z = cvt_pk(st[8 * s + 4], st[8 * s + 5]); pw.w = cvt_pk(st[8 * s + 6], st[8 * s + 7]);
            const bf16x8 pb = __builtin_bit_cast(bf16x8, pw);
#pragma unroll
            for (int c = 0; c < 4; ++c) { const bf16x8 vf = tr_frag_acc(vimg, lane, c, 32 * jt + 16 * s); acc[c] = __builtin_amdgcn_mfma_f32_32x32x16_bf16(vf, pb, acc[c], 0, 0, 0); }
        }
    }
    float ss = 0.f;
#pragma unroll
    for (int c = 0; c < 4; ++c)
#pragma unroll
        for (int r = 0; r < 16; ++r) ss += acc[c][r] * acc[c][r];
    ss += __shfl_xor(ss, 32);
    const float gi = expf(lgam * (float)(32 * w4 + r32));
    const float fac = gi / sqrtf(gi * gi * ss * (1.0f / 128.f) + 1e-6f);
    const size_t tok = tok0 + 32 * w4 + r32;
    const bf16_t* gp = GR + tok * 512 + h * 128 + 4 * hi;
    bf16_t* op = MIXED + tok * 1024 + 512 + h * 128 + 4 * hi;
#pragma unroll
    for (int c = 0; c < 4; ++c)
#pragma unroll
        for (int g4 = 0; g4 < 4; ++g4) {
            const u32x2 gv = *(const u32x2*)(gp + 32 * c + 8 * g4);
            const float g0 = __uint_as_float(gv.x << 16), g1 = __uint_as_float(gv.x & 0xffff0000u), g2 = __uint_as_float(gv.y << 16), g3 = __uint_as_float(gv.y & 0xffff0000u);
            u32x2 w; w.x = cvt_pk(acc[c][4 * g4 + 0] * fac * g0, acc[c][4 * g4 + 1] * fac * g1); w.y = cvt_pk(acc[c][4 * g4 + 2] * fac * g2, acc[c][4 * g4 + 3] * fac * g3);
            *(u32x2*)(op + 32 * c + 8 * g4) = w;
        }
}
constexpr size_t WS_MIX = 17 * MiB;
constexpr size_t WS_H2 = 49 * MiB;
constexpr size_t WS_LIST = 81 * MiB;
constexpr size_t WS_HID = 85 * MiB;
constexpr size_t WS_Y = 105 * MiB;
constexpr size_t WS_HRES = 180 * MiB;
constexpr int CW_CNT = 12288;
constexpr int CW_TILE = 16384;
constexpr int TB_OFF = MISC_OFF + 64;

struct EpiStore {
    static constexpr bool PERM = true, AFTER_DRAIN = false;
    bf16_t* O; int ld;
    __device__ __forceinline__ void operator()(const pg8::f32x4 (&acc)[2][2][4][2], const pg8::Unit& u, int wr, int wc, int fr, int fq) const {
        const int row0 = u.pm * 256 + wr * 64 + fr, col0 = u.pn * 256 + wc * 32 + 8 * fq;
#pragma unroll
        for (int ai = 0; ai < 2; ++ai)
#pragma unroll
            for (int m = 0; m < 4; ++m)
#pragma unroll
                for (int bj = 0; bj < 2; ++bj) {
                    const pg8::f32x4 v0 = acc[ai][bj][m][0], v1 = acc[ai][bj][m][1];
                    u32x4 w; w.x = cvt_pk(v0[0], v0[1]); w.y = cvt_pk(v0[2], v0[3]); w.z = cvt_pk(v1[0], v1[1]); w.w = cvt_pk(v1[2], v1[3]);
                    *(u32x4*)(O + (size_t)(row0 + ai * 128 + m * 16) * ld + col0 + bj * 128) = w;
                }
    }
};
struct P6bArgs { const bf16_t* MIX; const float *x, *g_post, *g_pre2, *mod, *w_group, *b_group, *w_expert, *b_expert; float* HRES; bf16_t* H2; unsigned* cnt; u32x2* LIST; };
constexpr int P6B_NR = 4;
constexpr int RT_WL_OFF = 147456;
__device__ __forceinline__ void p6b_load_weights(LAS unsigned char* lds, const float* w_group, const float* w_expert, int tid) {
    __syncthreads();
    for (int idx = tid; idx < 1024 * 9; idx += NTHR) {
        const int d = idx / 9, cc = idx - 9 * d, pos = ((d >> 2) & 63) + 64 * ((d & 3) + 4 * (d >> 8));
        const f32x4 v = (cc == 0) ? *(const f32x4*)(w_group + d * 4) : *(const f32x4*)(w_expert + d * 32 + 4 * (cc - 1));
        *(LAS f32x4*)(lds + pos * 144 + 16 * cc) = v;
    }
    __syncthreads();
}
__device__ __forceinline__ void p6b_rows8(const P6bArgs& a, const LAS unsigned char* wtab, LAS float* wl  , int gw, int lane, bool dry = false) {
    const int m0 = gw * P6B_NR, b = m0 / S;
    const float* md = a.mod + b * 6144;
    float hv[P6B_NR][16];
#pragma unroll
    for (int r = 0; r < P6B_NR; ++r) {
        const size_t row = (size_t)(m0 + r);
        float v[16]; float s = 0.f;
#pragma unroll
        for (int j = 0; j < 4; ++j) {
            const u32x2 w = *(const u32x2*)(a.MIX + row * 1024 + 4 * lane + 256 * j);
            v[4 * j + 0] = __uint_as_float(w.x << 16); v[4 * j + 1] = __uint_as_float(w.x & 0xffff0000u); v[4 * j + 2] = __uint_as_float(w.y << 16); v[4 * j + 3] = __uint_as_float(w.y & 0xffff0000u);
#pragma unroll
            for (int k = 0; k < 4; ++k) s += v[4 * j + k] * v[4 * j + k];
        }
        const float rs = 1.0f / sqrtf(wave_sum(s) * (1.f / 1024.f) + 1e-6f);
        float s2 = 0.f;
#pragma unroll
        for (int j = 0; j < 4; ++j) {
            const int col = 4 * lane + 256 * j;
            const f32x4 xx = *(const f32x4*)(a.x + row * 1024 + col), gp = *(const f32x4*)(a.g_post + col), g1 = *(const f32x4*)(md + 2 * 1024 + col);
            f32x4 hr;
#pragma unroll
            for (int k = 0; k < 4; ++k) { hr[k] = xx[k] + g1[k] * (v[4 * j + k] * rs * gp[k]); v[4 * j + k] = hr[k]; s2 += hr[k] * hr[k]; }
        }
        const float rs2 = 1.0f / sqrtf(wave_sum(s2) * (1.f / 1024.f) + 1e-6f);
#pragma unroll
        for (int j = 0; j < 4; ++j) {
            const int col = 4 * lane + 256 * j;
            const f32x4 g2 = *(const f32x4*)(a.g_pre2 + col), sc = *(const f32x4*)(md + 4 * 1024 + col), sh = *(const f32x4*)(md + 3 * 1024 + col);
#pragma unroll
            for (int k = 0; k < 4; ++k) hv[r][4 * j + k] = v[4 * j + k] * rs2 * g2[k] * (1.f + sc[k]) + sh[k];
            u32x2 w; w.x = cvt_pk(hv[r][4 * j + 0], hv[r][4 * j + 1]); w.y = cvt_pk(hv[r][4 * j + 2], hv[r][4 * j + 3]);
            *(u32x2*)(a.H2 + row * 1024 + col) = w;
            hv[r][4 * j + 0] = __uint_as_float(w.x << 16); hv[r][4 * j + 1] = __uint_as_float(w.x & 0xffff0000u); hv[r][4 * j + 2] = __uint_as_float(w.y << 16); hv[r][4 * j + 3] = __uint_as_float(w.y & 0xffff0000u);
        }
    }
#pragma unroll 1
    for (int c = 0; c < 9; ++c) {
        float acc[P6B_NR][4];
#pragma unroll
        for (int r = 0; r < P6B_NR; ++r)
#pragma unroll
            for (int o = 0; o < 4; ++o) acc[r][o] = 0.f;
#pragma unroll
        for (int j = 0; j < 4; ++j)
#pragma unroll
            for (int k = 0; k < 4; ++k) {
                const f32x4 w4 = *(const LAS f32x4*)(wtab + (lane + 64 * (k + 4 * j)) * 144 + 16 * c);
#pragma unroll
                for (int r = 0; r < P6B_NR; ++r)
#pragma unroll
                    for (int o = 0; o < 4; ++o) acc[r][o] += hv[r][4 * j + k] * w4[o];
            }
#pragma unroll
        for (int r = 0; r < P6B_NR; ++r)
#pragma unroll
            for (int o = 0; o < 4; ++o) { const float t = wave_sum(acc[r][o]); if (lane == 0) wl[r * 36 + 4 * c + o] = t; }
    }
    asm volatile("s_waitcnt lgkmcnt(0)" ::: "memory");
    if (lane < P6B_NR && !dry) {
        const LAS float* lg = wl + lane * 36;
        float gm = lg[0] + a.b_group[0]; int gs = 0; float l1 = lg[1] + a.b_group[1], l2 = lg[2] + a.b_group[2], l3 = lg[3] + a.b_group[3];
        const float l0 = gm;
        if (l1 > gm) { gm = l1; gs = 1; } if (l2 > gm) { gm = l2; gs = 2; } if (l3 > gm) { gm = l3; gs = 3; }
        const float gtop = 1.0f / (expf(l0 - gm) + expf(l1 - gm) + expf(l2 - gm) + expf(l3 - gm));
        float el[8];
#pragma unroll
        for (int i = 0; i < 8; ++i) el[i] = lg[4 + gs * 8 + i] + a.b_expert[gs * 8 + i];
        float b1 = el[0]; int i1 = 0;
#pragma unroll
        for (int i = 1; i < 8; ++i) if (el[i] > b1) { b1 = el[i]; i1 = i; }
        float b2 = -INFINITY; int i2 = 0;
#pragma unroll
        for (int i = 0; i < 8; ++i) if (i != i1 && el[i] > b2) { b2 = el[i]; i2 = i; }
        const float p2 = expf(b2 - b1), den = 1.0f + p2;
        const float w0 = gtop / den, w1 = gtop * p2 / den;
        const int e0 = gs * 8 + i1, e1 = gs * 8 + i2;
        const unsigned tok = (unsigned)(m0 + lane);
        const unsigned pos0 = atomicAdd(a.cnt + 64 * e0, 1u), pos1 = atomicAdd(a.cnt + 64 * e1, 1u);
        a.LIST[(size_t)e0 * 16384 + pos0] = (u32x2){tok, __float_as_uint(w0)};
        a.LIST[(size_t)e1 * 16384 + pos1] = (u32x2){tok | 0x80000000u, __float_as_uint(w1)};
    }
}
template <int ROLE> struct MoeSched {
    const u32x2* LIST; LAS int* tb; int G, c, NJ;
    unsigned* tilecnt;
    unsigned* tmo;
    int tlo, thi;
    __device__ __forceinline__ bool next(int i, pg8::Unit& u) const {
        if (c < 0) return false;
        const int L = i * G + c, TT = (thi < tb[32]) ? thi : tb[32];
        const int tg = tlo + L / NJ, j = L % NJ;
        if (tg >= TT) return false;
        int e = 0;
#pragma unroll 1
        for (int k = 1; k < 32; ++k) e += (tb[k] <= tg) ? 1 : 0;
        u.pm = tg; u.pn = e * NJ + j; return true;
    }
    __device__ __forceinline__ int arow(const pg8::Unit& u, int r) const {
        const int e = u.pn / NJ, idx = (u.pm - tb[e]) * 256 + r;
        return (idx < tb[33 + e]) ? (int)(LIST[(size_t)e * 16384 + idx].x & 0x7fffffffu) : 0;
    }
    __device__ __forceinline__ void a_ready(const pg8::Unit&) const {}
    __device__ __forceinline__ void done(const pg8::Unit& u) const {
        if (ROLE != 1) return;
        asm volatile("s_waitcnt vmcnt(0)" ::: "memory");
        if (mk_lane() == 0) __hip_atomic_fetch_add(tilecnt + 64 * u.pm, 1u, __ATOMIC_RELAXED, __HIP_MEMORY_SCOPE_AGENT);
    }
};
__device__ __forceinline__ void moe_wait(const MoeSched<2>& S) {
    if (mk_wave() == 0) {
        pg8::Unit u;
        for (int i = 0; S.next(i, u); ++i) {
            unsigned sp = 0;
            while ((unsigned)__builtin_amdgcn_readfirstlane(__hip_atomic_load(S.tilecnt + 64 * u.pm, __ATOMIC_RELAXED, __HIP_MEMORY_SCOPE_AGENT)) < 16u) {
                __builtin_amdgcn_s_sleep(2);
                if (++sp > (1u << 22)) { __hip_atomic_store(S.tmo, 1u, __ATOMIC_RELAXED, __HIP_MEMORY_SCOPE_AGENT); break; }
            }
        }
        __builtin_amdgcn_fence(__ATOMIC_ACQUIRE, "agent");
        asm volatile("s_waitcnt vmcnt(0)" ::: "memory");
    }
    __syncthreads();
}
__device__ __forceinline__ void moe_table(LAS int* tb, const unsigned* cnt, int tid) {
    __syncthreads();
    if (tid < 32) tb[33 + tid] = (int)__hip_atomic_load(cnt + 64 * tid, __ATOMIC_RELAXED, __HIP_MEMORY_SCOPE_AGENT);
    __syncthreads();
    if (tid == 0) { int s = 0; for (int e = 0; e < 32; ++e) { tb[e] = s; s += (tb[33 + e] + 255) >> 8; } tb[32] = s; }
    __syncthreads();
}
struct EpiGU {
    static constexpr bool PERM = true, AFTER_DRAIN = false;
    bf16_t* HID;
    __device__ __forceinline__ void operator()(const pg8::f32x4 (&acc)[2][2][4][2], const pg8::Unit& u, int wr, int wc, int fr, int fq) const {
        const int row0 = u.pm * 256 + wr * 64 + fr, hc0 = (u.pn & 1) * 128 + 16 * wc + 4 * fq;
#pragma unroll
        for (int ai = 0; ai < 2; ++ai)
#pragma unroll
            for (int m = 0; m < 4; ++m)
#pragma unroll
                for (int bj = 0; bj < 2; ++bj) {
                    const pg8::f32x4 g = acc[ai][bj][m][0], up = acc[ai][bj][m][1];
                    u32x2 w; w.x = cvt_pk(silu_f(g[0]) * up[0], silu_f(g[1]) * up[1]); w.y = cvt_pk(silu_f(g[2]) * up[2], silu_f(g[3]) * up[3]);
                    __hip_atomic_store((unsigned long long*)(HID + (size_t)(row0 + ai * 128 + m * 16) * 256 + hc0 + bj * 64), (unsigned long long)w.x | ((unsigned long long)w.y << 32), __ATOMIC_RELAXED, __HIP_MEMORY_SCOPE_AGENT);
                }
    }
};
struct EpiDown {
    static constexpr bool PERM = true, AFTER_DRAIN = false;
    bf16_t* Y; const u32x2* LIST; LAS int* tb;
    __device__ __forceinline__ void operator()(const pg8::f32x4 (&acc)[2][2][4][2], const pg8::Unit& u, int wr, int wc, int fr, int fq) const {
        const int e = u.pn >> 2, j = u.pn & 3, ti = u.pm - tb[e], cn = tb[33 + e];
        const int col0 = 256 * j + 32 * wc + 8 * fq;
        const int idx0 = ti * 256 + wr * 64 + fr;
#pragma unroll
        for (int ai = 0; ai < 2; ++ai) {
            u32x2 ent[4];
#pragma unroll
            for (int m = 0; m < 4; ++m) { const int idx = idx0 + ai * 128 + m * 16; ent[m] = (idx < cn) ? LIST[(size_t)e * 16384 + idx] : (u32x2){0xffffffffu, 0u}; }
#pragma unroll
            for (int m = 0; m < 4; ++m) {
                const u32x2 en = ent[m];
                if (en.x != 0xffffffffu) {
                    const float w = __uint_as_float(en.y);
                    bf16_t* dst = Y + ((size_t)(en.x >> 31) * T + (en.x & 0x7fffffffu)) * 1024 + col0;
#pragma unroll
                    for (int bj = 0; bj < 2; ++bj) {
                        const pg8::f32x4 v0 = acc[ai][bj][m][0] * w, v1 = acc[ai][bj][m][1] * w;
                        u32x4 o; o.x = cvt_pk(v0[0], v0[1]); o.y = cvt_pk(v0[2], v0[3]); o.z = cvt_pk(v1[0], v1[1]); o.w = cvt_pk(v1[2], v1[3]);
                        *(u32x4*)(dst + bj * 128) = o;
                    }
                }
            }
            asm volatile("" ::: "memory");
        }
    }
};
__device__ __forceinline__ void p8_rows(const bf16_t* Y, const bf16_t* MIX, const float* x, const float* g_post_mix, const float* g_post, const float* mod, float* out, int gw, int NGW, int lane) {
    for (int m = gw; m < T; m += NGW) {
        const int b = m / S;
        float v[16], mx[16]; float s = 0.f, sm = 0.f;
#pragma unroll
        for (int j = 0; j < 4; ++j) {
            const u32x2 w0 = *(const u32x2*)(Y + (size_t)m * 1024 + 4 * lane + 256 * j), w1 = *(const u32x2*)(Y + ((size_t)T + m) * 1024 + 4 * lane + 256 * j), wm = *(const u32x2*)(MIX + (size_t)m * 1024 + 4 * lane + 256 * j);
            v[4 * j + 0] = __uint_as_float(w0.x << 16) + __uint_as_float(w1.x << 16); v[4 * j + 1] = __uint_as_float(w0.x & 0xffff0000u) + __uint_as_float(w1.x & 0xffff0000u);
            v[4 * j + 2] = __uint_as_float(w0.y << 16) + __uint_as_float(w1.y << 16); v[4 * j + 3] = __uint_as_float(w0.y & 0xffff0000u) + __uint_as_float(w1.y & 0xffff0000u);
            mx[4 * j + 0] = __uint_as_float(wm.x << 16); mx[4 * j + 1] = __uint_as_float(wm.x & 0xffff0000u); mx[4 * j + 2] = __uint_as_float(wm.y << 16); mx[4 * j + 3] = __uint_as_float(wm.y & 0xffff0000u);
#pragma unroll
            for (int k = 0; k < 4; ++k) { s += v[4 * j + k] * v[4 * j + k]; sm += mx[4 * j + k] * mx[4 * j + k]; }
        }
        const float rs = 1.0f / sqrtf(wave_sum(s) * (1.f / 1024.f) + 1e-6f), rsm = 1.0f / sqrtf(wave_sum(sm) * (1.f / 1024.f) + 1e-6f);
        const float* md = mod + b * 6144;
#pragma unroll
        for (int j = 0; j < 4; ++j) {
            const int col = 4 * lane + 256 * j;
            const f32x4 xx = *(const f32x4*)(x + (size_t)m * 1024 + col), gpm = *(const f32x4*)(g_post_mix + col), g1 = *(const f32x4*)(md + 2 * 1024 + col), gp = *(const f32x4*)(g_post + col), gg = *(const f32x4*)(md + 5 * 1024 + col);
            f32x4 o;
#pragma unroll
            for (int k = 0; k < 4; ++k) { const float hr = xx[k] + g1[k] * (mx[4 * j + k] * rsm * gpm[k]); o[k] = hr + gg[k] * (v[4 * j + k] * rs * gp[k]); }
            *(f32x4*)(out + (size_t)m * 1024 + col) = o;
        }
    }
}
constexpr size_t SC_BSTRIDE = (size_t)4096 * 64 * 65 / 2;
constexpr int SC_CHUNK = 8;
constexpr int SC_NUNITS = 4 * (1 * 8 + 2 * 8 + 3 * 8 + 4 * 8 + 5 * 8 + 6 * 8 + 7 * 8 + 8 * 8);
__device__ __forceinline__ size_t sc_off(int b, int qb) { return (size_t)b * SC_BSTRIDE + (size_t)4096 * (qb * (qb + 1) / 2); }
__device__ __forceinline__ void sc_build_units(unsigned* tab) {
    int n = 0;
    for (int pass = 0; pass < 2; ++pass)
        for (int sz = SC_CHUNK; sz >= 1; --sz)
            for (int b = 0; b < 4; ++b)
                for (int qb = 0; qb < 64; ++qb) {
                    const int nt = qb + 1, nc = (nt + SC_CHUNK - 1) / SC_CHUNK;
                    for (int c = 0; c < nc; ++c) {
                        const int t0 = c * SC_CHUNK, cnt = (nt - t0 < SC_CHUNK) ? nt - t0 : SC_CHUNK;
                        const bool full = (cnt == SC_CHUNK);
                        if ((pass == 0 && full && sz == SC_CHUNK) || (pass == 1 && !full && cnt == sz)) tab[n++] = (unsigned)b | ((unsigned)qb << 2) | ((unsigned)c << 8) | ((unsigned)cnt << 12);
                    }
                }
}
__device__ __forceinline__ unsigned key16_of(float sc) { sc += 0.0f; const unsigned u = __float_as_uint(sc); return ((u & 0x80000000u) ? ~u : (u | 0x80000000u)) >> 16; }
__device__ __forceinline__ void sc_decode(unsigned u, int& b, int& qb, int& c, int& nt) {
    b = u & 3; const int v = u >> 2;
    if (v < 232) { c = 0; int base = 0; while (v >= base + (57 - 8 * c)) { base += 57 - 8 * c; ++c; } qb = 8 * c + 7 + (v - base); nt = 8; }
    else { const int p = v - 232, size = 7 - (p >> 3); c = p & 7; qb = 8 * c + size - 1; nt = size; }
}
struct ScStage { u32x4 v[8]; };
__device__ __forceinline__ void sc_stage_load(ScStage& st, const bf16_t* KI, int b, int c, int nt, int tid) {
    const bf16_t* kbase = KI + ((size_t)b * S + (size_t)c * SC_CHUNK * 64 + (tid >> 3)) * 64 + (tid & 7) * 8;
#pragma unroll
    for (int t = 0; t < 8; ++t) if (t < nt) st.v[t] = *(const u32x4*)(kbase + (size_t)t * 64 * 64);
}
__device__ __forceinline__ void sc_stage_store(const ScStage& st, LAS unsigned char* buf, int nt, int tid) {
    const int skey = tid >> 3, sch = tid & 7;
    const unsigned st_off = (unsigned)(skey * 128 + ((sch ^ (skey & 7)) * 16));
#pragma unroll
    for (int t = 0; t < 8; ++t) if (t < nt) *(LAS u32x4*)(buf + t * 8192 + st_off) = st.v[t];
}
__device__ __forceinline__ void sc_compute(const LAS unsigned char* buf, const bf16_t* QI, const float* WI, unsigned short* SC, int b, int qb, int c, int ntile, int tid) {
    const int lane = tid & 63, w = __builtin_amdgcn_readfirstlane(tid >> 6), hh = lane >> 5, n32 = lane & 31;
    const int L = 64 * (qb + 1);
    const size_t tokq0 = (size_t)b * S + 64 * qb + 8 * w;
    bf16x8 af[2][4]; float wv[2][2][8];
    {
        const int u = 2 * ((n32 >> 2) & 1) + (n32 >> 4), h = (n32 & 3) + 4 * ((n32 >> 3) & 1);
#pragma unroll
        for (int mt = 0; mt < 2; ++mt) {
            const bf16_t* qp = QI + (tokq0 + 4 * mt + u) * 512 + h * 64 + 8 * hh;
#pragma unroll
            for (int ks = 0; ks < 4; ++ks) af[mt][ks] = *(const bf16x8*)(qp + 16 * ks);
#pragma unroll
            for (int j = 0; j < 2; ++j) {
                const float* wp = WI + (tokq0 + 4 * mt + 2 * hh + j) * 8;
                const f32x4 w0 = *(const f32x4*)wp, w1 = *(const f32x4*)(wp + 4);
                wv[mt][j][0] = w0[0]; wv[mt][j][1] = w0[1]; wv[mt][j][2] = w0[2]; wv[mt][j][3] = w0[3]; wv[mt][j][4] = w1[0]; wv[mt][j][5] = w1[1]; wv[mt][j][6] = w1[2]; wv[mt][j][7] = w1[3];
            }
        }
    }
    unsigned short* srow = SC + sc_off(b, qb) + (size_t)(8 * w) * L;
#pragma unroll 1
    for (int t = 0; t < ntile; ++t) {
        const LAS unsigned char* tb_ = buf + t * 8192;
        const int s0 = (c * SC_CHUNK + t) * 64;
#pragma unroll
        for (int nt = 0; nt < 2; ++nt) {
            bf16x8 bfr[4];
            const int key = 32 * nt + n32;
#pragma unroll
            for (int ks = 0; ks < 4; ++ks) bfr[ks] = *(const LAS bf16x8*)(tb_ + key * 128 + (((2 * ks + hh) ^ (key & 7)) * 16));
#pragma unroll
            for (int mt = 0; mt < 2; ++mt) {
                f32x16 acc = (f32x16){};
#pragma unroll
                for (int ks = 0; ks < 4; ++ks) acc = __builtin_amdgcn_mfma_f32_32x32x16_bf16(af[mt][ks], bfr[ks], acc, 0, 0, 0);
#pragma unroll
                for (int j = 0; j < 2; ++j) {
                    float sc = 0.f;
#pragma unroll
                    for (int h = 0; h < 8; ++h) { const int xi = (int)__float_as_uint(acc[8 * j + h]); sc = __builtin_fmaf(wv[mt][j][h], __uint_as_float((unsigned)(xi > 0 ? xi : 0)), sc); }
                    asm volatile("" : "+v"(sc));
                    srow[(size_t)(4 * mt + 2 * hh + j) * L + s0 + key] = (unsigned short)key16_of(sc);
                }
            }
        }
    }
}
__device__ __forceinline__ void sc_phase(LAS unsigned char* lds, volatile LAS unsigned* qslot, unsigned* qhead, const bf16_t* QI, const bf16_t* KI, const float* WI, unsigned short* SC, int tid) {
    __syncthreads();
    if (tid == 0) qslot[0] = atomicAdd(qhead, 1u);
    __syncthreads();
    unsigned ucur = qslot[0];
    if (ucur >= (unsigned)SC_NUNITS) return;
    int b, qb, c, nt; sc_decode(ucur, b, qb, c, nt);
    ScStage st;
    sc_stage_load(st, KI, b, c, nt, tid);
    sc_stage_store(st, lds, nt, tid);
    int p = 0;
    for (;;) {
        __syncthreads();
        if (tid == 0) qslot[0] = atomicAdd(qhead, 1u);
        __syncthreads();
        const unsigned unext = qslot[0];
        const bool has = unext < (unsigned)SC_NUNITS;
        int b2 = 0, qb2 = 0, c2 = 0, nt2 = 0;
        if (has) { sc_decode(unext, b2, qb2, c2, nt2); sc_stage_load(st, KI, b2, c2, nt2, tid); }
        sc_compute(lds + p * 65536, QI, WI, SC, b, qb, c, nt, tid);
        if (!has) break;
        sc_stage_store(st, lds + (p ^ 1) * 65536, nt2, tid);
        b = b2; qb = qb2; c = c2; nt = nt2; p ^= 1;
    }
}
__device__ __forceinline__ unsigned wave_sum_u32(unsigned x) {
    x += (unsigned)__builtin_amdgcn_update_dpp(0, (int)x, 0xB1, 0xf, 0xf, false);
    x += (unsigned)__builtin_amdgcn_update_dpp(0, (int)x, 0x4E, 0xf, 0xf, false);
    x += (unsigned)__builtin_amdgcn_update_dpp(0, (int)x, 0x141, 0xf, 0xf, false);
    x += (unsigned)__builtin_amdgcn_update_dpp(0, (int)x, 0x140, 0xf, 0xf, false);
    return (unsigned)__builtin_amdgcn_readlane((int)x, 0) + (unsigned)__builtin_amdgcn_readlane((int)x, 16) + (unsigned)__builtin_amdgcn_readlane((int)x, 32) + (unsigned)__builtin_amdgcn_readlane((int)x, 48);
}
__device__ __forceinline__ unsigned pk_subsat(unsigned w, unsigned c) { unsigned d; asm("v_pk_sub_u16 %0, %1, %2 clamp" : "=v"(d) : "v"(w), "v"(c)); return d; }
__device__ __forceinline__ unsigned pk_min(unsigned a, unsigned b) { unsigned d; asm("v_pk_min_u16 %0, %1, %2" : "=v"(d) : "v"(a), "v"(b)); return d; }
__device__ __forceinline__ unsigned pk_add(unsigned a, unsigned b) { unsigned d; asm("v_pk_add_u16 %0, %1, %2" : "=v"(d) : "v"(a), "v"(b)); return d; }
template <int NW> __device__ __forceinline__ unsigned cnt_ge(const unsigned (&kw)[32], unsigned cm1) {
    const unsigned one = 0x00010001u;
    unsigned a0 = 0u, a1 = 0u, a2 = 0u, a3 = 0u;
#pragma unroll
    for (int j = 0; j < NW; j += 4) {
        a0 = pk_add(a0, pk_min(pk_subsat(kw[j], cm1), one)); a1 = pk_add(a1, pk_min(pk_subsat(kw[j + 1], cm1), one));
        a2 = pk_add(a2, pk_min(pk_subsat(kw[j + 2], cm1), one)); a3 = pk_add(a3, pk_min(pk_subsat(kw[j + 3], cm1), one));
    }
    const unsigned a = pk_add(pk_add(a0, a1), pk_add(a2, a3));
    return wave_sum_u32((a & 0xffffu) + (a >> 16));
}
__device__ __forceinline__ unsigned pk_max(unsigned a, unsigned b) { unsigned d; asm("v_pk_max_u16 %0, %1, %2" : "=v"(d) : "v"(a), "v"(b)); return d; }
__device__ __forceinline__ unsigned wave_max_u32(unsigned x) {
    x = max(x, (unsigned)__builtin_amdgcn_update_dpp(0, (int)x, 0xB1, 0xf, 0xf, false));
    x = max(x, (unsigned)__builtin_amdgcn_update_dpp(0, (int)x, 0x4E, 0xf, 0xf, false));
    x = max(x, (unsigned)__builtin_amdgcn_update_dpp(0, (int)x, 0x141, 0xf, 0xf, false));
    x = max(x, (unsigned)__builtin_amdgcn_update_dpp(0, (int)x, 0x140, 0xf, 0xf, false));
    return max(max((unsigned)__builtin_amdgcn_readlane((int)x, 0), (unsigned)__builtin_amdgcn_readlane((int)x, 16)), max((unsigned)__builtin_amdgcn_readlane((int)x, 32), (unsigned)__builtin_amdgcn_readlane((int)x, 48)));
}
template <int NW> __device__ __forceinline__ unsigned sel_query(const unsigned (&kw)[32], int lane) {
    unsigned mx = 0u;
#pragma unroll
    for (int j = 0; j < NW; ++j) mx = pk_max(mx, kw[j]);
    unsigned hi = wave_max_u32(max(mx & 0xffffu, mx >> 16)) + 1u;
    unsigned width = 384u, lo = (hi > width) ? hi - width : 1u;
#pragma unroll 1
    while (cnt_ge<NW>(kw, (lo - 1u) * 0x00010001u) < 256u) { hi = lo; width *= 8u; lo = (hi > width) ? hi - width : 1u; }
#pragma unroll 1
    while (hi - lo > 1u) {
        const unsigned mid = (lo + hi) >> 1;
        if (cnt_ge<NW>(kw, (mid - 1u) * 0x00010001u) >= 256u) lo = mid; else hi = mid;
    }
    const unsigned T = lo;
    const unsigned need = 256u - cnt_ge<NW>(kw, T * 0x00010001u);
    unsigned run = 0u, cidx = 0xffffu; bool found = false;
#pragma unroll
    for (int j = 0; j < NW; ++j) {
        if (!found) {
            const bool e0 = (kw[j] & 0xffffu) == T, e1 = (kw[j] >> 16) == T;
            const unsigned long long m0 = __ballot(e0), m1 = __ballot(e1);
            const unsigned cm = (unsigned)__builtin_popcountll(m0) + (unsigned)__builtin_popcountll(m1);
            if (run + cm >= need) {
                const unsigned rank = __builtin_amdgcn_mbcnt_hi((unsigned)(m0 >> 32), __builtin_amdgcn_mbcnt_lo((unsigned)m0, 0u)) + __builtin_amdgcn_mbcnt_hi((unsigned)(m1 >> 32), __builtin_amdgcn_mbcnt_lo((unsigned)m1, 0u));
                const unsigned tg = need - run - 1u;
                const unsigned long long h0 = __ballot(e0 && rank == tg), h1 = __ballot(e1 && rank + (e0 ? 1u : 0u) == tg);
                cidx = (unsigned)(128 * j) + (h0 ? 2u * (unsigned)__builtin_ctzll(h0) : 2u * (unsigned)__builtin_ctzll(h1) + 1u);
                found = true;
            }
            run += cm;
        }
    }
    return T | (cidx << 16);
}
template <int NW> __device__ __forceinline__ unsigned sel_row(const unsigned* row32, int n, int lane) {
    unsigned kw[32];
#pragma unroll
    for (int j = 0; j < 32; ++j) {
        unsigned v = 0u;
        if (j < NW) { const int s = 128 * j + 2 * lane; v = (s < n) ? row32[64 * j + lane] : 0u; if (s + 1 >= n) v &= 0xffffu; }
        kw[j] = v;
    }
    return sel_query<NW>(kw, lane);
}
__device__ __forceinline__ void sel_block(LAS unsigned char* lds, const unsigned short* SC, unsigned* THR, unsigned* MASKT, int blk, int tid, int mode = 3) {
    const int b = blk >> 6, qb = blk & 63, lane = tid & 63, w = __builtin_amdgcn_readfirstlane(tid >> 6);
    const int L = 64 * (qb + 1);
    const unsigned short* slab = SC + sc_off(b, qb);
    LAS unsigned* thr_l = (LAS unsigned*)lds;
    __syncthreads();
    if (mode & 1)
#pragma unroll 1
    for (int qi = 0; qi < 8; ++qi) {
        const int ql = 8 * w + qi, tq = 64 * qb + ql, n = tq + 1;
        const unsigned short* row = slab + (size_t)ql * L;
        const int nw = (n + 127) >> 7;
        const unsigned* row32 = (const unsigned*)row;
        unsigned th = 0u;
        if (n > 256) { if (nw <= 8) th = sel_row<8>(row32, n, lane); else if (nw <= 16) th = sel_row<16>(row32, n, lane); else if (nw <= 24) th = sel_row<24>(row32, n, lane); else th = sel_row<32>(row32, n, lane); }
        if (lane == 0) { thr_l[ql] = th; THR[(size_t)b * S + tq] = th; }
    }
    __syncthreads();
    const int ntl = 4 * ((2 * qb) >> 3) + 4;
    if (mode & 2)
    for (int it = w; it < 2 * ntl; it += NWAVES) {
        const int g = it / ntl, t = it - g * ntl, qg = 2 * qb + g;
        unsigned W = 0u;
        if (t <= qb) {
            const int ii = lane & 15, cc = (lane >> 4) & 1, hh = lane >> 5;
            const int s = 64 * t + 32 * cc + (ii & 3) + 8 * (ii >> 2) + 4 * hh;
            unsigned kk[32];
#pragma unroll
            for (int q = 0; q < 32; ++q) kk[q] = (unsigned)slab[(size_t)(32 * g + q) * L + s];
#pragma unroll
            for (int q = 0; q < 32; ++q) {
                const int ql = 32 * g + q, tq = 64 * qb + ql;
                const unsigned th = thr_l[ql], T = th & 0xffffu, cidx = th >> 16;
                const unsigned k = kk[q];
                const bool p = (s <= tq) && (k > T || (k == T && (unsigned)s <= cidx));
                const unsigned long long m = __ballot(p);
                W = (lane == q) ? (unsigned)m : ((lane == 32 + q) ? (unsigned)(m >> 32) : W);
            }
        }
        MASKT[(((size_t)b * 128 + qg) * 64 + t) * 64 + lane] = W;
    }
}

__device__ __forceinline__ void sel_queries_balanced(const unsigned short* SC, unsigned* THR, int gw, int lane) {
#pragma unroll 1
    for (int k = 0; k < 8; ++k) {
        const int b = k >> 1, tq = (k & 1) ? (S - 1 - gw) : gw, n = tq + 1, qb = tq >> 6, L = 64 * (qb + 1);
        const unsigned* row32 = (const unsigned*)(SC + sc_off(b, qb) + (size_t)(tq & 63) * L);
        const int nw = (n + 127) >> 7;
        unsigned th = 0u;
        if (n > 256) { if (nw <= 8) th = sel_row<8>(row32, n, lane); else if (nw <= 16) th = sel_row<16>(row32, n, lane); else if (nw <= 24) th = sel_row<24>(row32, n, lane); else th = sel_row<32>(row32, n, lane); }
        if (lane == 0) THR[(size_t)b * S + tq] = th;
    }
}
constexpr int MSK_PER_B = 4352, MSK_UNITS = 4 * MSK_PER_B;
struct MskUnit { int b, qg, t; unsigned thv; unsigned kk[32]; };
__device__ __forceinline__ void mask_unit_load(MskUnit& m, const unsigned short* SC, const unsigned* THR, int u, int lane) {
    m.b = u / MSK_PER_B; const int v = u - m.b * MSK_PER_B;
    int g8 = 0;
#pragma unroll 1
    for (int j = 1; j < 16; ++j) g8 += (16 * j * (j + 1) <= v) ? 1 : 0;
    const int rem = v - 16 * g8 * (g8 + 1), per = 4 * g8 + 4, q7 = rem / per;
    m.t = rem - q7 * per; m.qg = 8 * g8 + q7;
    const int qb = m.qg >> 1, g = m.qg & 1;
    if (m.t <= qb) {
        const int L = 64 * (qb + 1);
        const unsigned short* slab = SC + sc_off(m.b, qb);
        const int ii = lane & 15, cc = (lane >> 4) & 1, hh = lane >> 5;
        const int s = 64 * m.t + 32 * cc + (ii & 3) + 8 * (ii >> 2) + 4 * hh;
        m.thv = THR[(size_t)m.b * S + 32 * m.qg + (lane & 31)];
#pragma unroll
        for (int q = 0; q < 32; ++q) m.kk[q] = (unsigned)slab[(size_t)(32 * g + q) * L + s];
    }
}
__device__ __forceinline__ void mask_unit_emit(const MskUnit& m, unsigned* MASKT, int lane) {
    const int qb = m.qg >> 1;
    unsigned W = 0u;
    if (m.t <= qb) {
        const int ii = lane & 15, cc = (lane >> 4) & 1, hh = lane >> 5;
        const int s = 64 * m.t + 32 * cc + (ii & 3) + 8 * (ii >> 2) + 4 * hh;
#pragma unroll
        for (int q = 0; q < 32; ++q) {
            const int tq = 32 * m.qg + q;
            const unsigned th = (unsigned)__builtin_amdgcn_readlane((int)m.thv, q), T = th & 0xffffu, cidx = th >> 16;
            const unsigned k = m.kk[q];
            const bool p = (s <= tq) && (k > T || (k == T && (unsigned)s <= cidx));
            const unsigned long long mm = __ballot(p);
            W = (lane == q) ? (unsigned)mm : ((lane == 32 + q) ? (unsigned)(mm >> 32) : W);
        }
    }
    MASKT[(((size_t)m.b * 128 + m.qg) * 64 + m.t) * 64 + lane] = W;
}
__device__ __forceinline__ void mask_units(const unsigned short* SC, const unsigned* THR, unsigned* MASKT, int u0, int stride, int lane) {
    if (u0 >= MSK_UNITS) return;
    MskUnit a, bnext;
    mask_unit_load(a, SC, THR, u0, lane);
#pragma unroll 1
    for (int u = u0; u < MSK_UNITS; u += stride) {
        const bool has = u + stride < MSK_UNITS;
        if (has) mask_unit_load(bnext, SC, THR, u + stride, lane);
        mask_unit_emit(a, MASKT, lane);
        if (has) a = bnext;
    }
}
struct Args { const void* in[18]; float* out; unsigned char* ws; int ph_lo, ph_hi, li, pad; };
constexpr int N_PHASES = 12;
__global__ void __launch_bounds__(NTHR, 2) mega(Args args) {
    extern __shared__ __attribute__((aligned(16))) unsigned char lds_raw[];
    LAS unsigned char* lds = (LAS unsigned char*)lds_raw;
    const int G = gridDim.x, bid = blockIdx.x;
#define MK_IDS() const int wave = mk_wave(), lane = mk_lane(), tid = wave * 64 + lane; (void)lane; (void)tid; (void)wave
    unsigned char* ws = args.ws;
    unsigned* ctl = (unsigned*)(ws + WS_CTL);
    volatile LAS unsigned* MISC = (volatile LAS unsigned*)(lds + MISC_OFF);
    { const int t0 = (int)threadIdx.x;
      for (int u = t0; u < (LDS_BYTES - RING_BYTES) / 4; u += NTHR) ((LAS unsigned*)(lds + RING_BYTES))[u] = 0u;
      __syncthreads();
      if ((t0 & 63) == 0) ((LAS unsigned char*)(lds + MK_SLOTMAP_OFF))[mk_hwslot()] = (unsigned char)(t0 >> 6); }
    __syncthreads();
    XcdBarrier bar = xcd_barrier_post(ctl + CW_BAR + args.li * XCD_BAR_WORDS, MISC + 8);
    const int lo = args.ph_lo, hi = args.ph_hi;
#ifndef DUP_MASK
#define DUP_MASK 0
#endif
#define REP(k) for (int rep_ = 0; rep_ < (((DUP_MASK) >> (k)) & 1) + 1; ++rep_)
#define IN(k) (lo <= (k) && (k) < hi)
#define BOTH(k) (IN(k) && IN((k) + 1))
    const float* x = (const float*)args.in[0];
    float* mod = (float*)(ws + WS_MOD);
    bf16_t* Hb = (bf16_t*)(ws + WS_H);
    bf16_t* WIN = (bf16_t*)(ws + WS_WIN);
    bf16_t* WOUT = (bf16_t*)(ws + WS_WOUT);
    float* R128 = (float*)(ws + WS_R128);
    float* R64 = (float*)(ws + WS_R64);
    bf16_t* WGU = (bf16_t*)args.out; bf16_t* WD = WGU + (size_t)32 * 512 * 1024;

    const P0Args p0a{(const float*)args.in[1], (const float*)args.in[4], (const float*)args.in[5], (const float*)args.in[6], (const float*)args.in[7], (const float*)args.in[14], (const float*)args.in[15], (const float*)args.in[16],
                 (const int*)args.in[2], mod, R128, R64, WIN, WOUT, WGU, WD};
    if (IN(0)) {
        MK_IDS();
        REP(0) p0_prologue(lds, p0a, bid, G, tid);
        if (BOTH(0)) xcd_barrier(bar);
    }
    if (IN(1)) {
        MK_IDS();
        REP(1) p1_rows(x, (const float*)args.in[3], mod, Hb, bid * NWAVES + wave, G * NWAVES, lane);
        if ((DUP_MASK >> 15) & 1) { for (int k = 0; k < 10; ++k) xcd_barrier(bar); }
        if (BOTH(1)) xcd_barrier(bar);
    }
    if (IN(2)) {
        MK_IDS();
#ifdef PROBE_SKIP_TILE8
        struct Skip8 : pg8::StaticOrder { __device__ bool next(int i, pg8::Unit& u) const { if (!pg8::StaticOrder::next(i, u)) return false; if (u.pn >= 8) ++u.pn; return true; } };
        pg8::Gemm g{Hb, WIN, T, NPHYS, 1024}; Skip8 So; So.init(T, NPHYS - 256, G, bid);
#define PG8_P2_SCHED Skip8
#else
        pg8::Gemm g{Hb, WIN, T, NPHYS, 1024}; pg8::StaticOrder So; So.init(T, NPHYS, G, bid);
#define PG8_P2_SCHED pg8::StaticOrder
#endif
        EpiInProj E{(bf16_t*)(ws + WS_QA), (bf16_t*)(ws + WS_KA), (bf16_t*)(ws + WS_VA), (bf16_t*)(ws + WS_QI), (bf16_t*)(ws + WS_KI), (bf16_t*)(ws + WS_QR), (bf16_t*)(ws + WS_KR),
                    (bf16_t*)(ws + WS_VR), (bf16_t*)(ws + WS_GR), (float*)(ws + WS_WI), R64, R128};
        pg8::gemm_phase<EpiInProj, PG8_P2_SCHED, true, true>(lds, g, So, E);
        if ((DUP_MASK >> 2) & 1) { __syncthreads(); pg8::gemm_phase<EpiInProj, PG8_P2_SCHED, true, true>(lds, g, So, E); }
        if (args.li != 0) {   }
        else if (G == 256) { if (bid >= 64) { __syncthreads(); p0_expert_items(lds, p0a, (bid - 64) * NWAVES + wave, 192 * NWAVES, tid); } }
        else { __syncthreads(); p0_expert_items(lds, p0a, bid * NWAVES + wave, G * NWAVES, tid); }
        if (BOTH(2)) xcd_barrier(bar);
    }
    bf16_t* QR = (bf16_t*)(ws + WS_QR); bf16_t* KR = (bf16_t*)(ws + WS_KR); bf16_t* VR = (bf16_t*)(ws + WS_VR); bf16_t* GR = (bf16_t*)(ws + WS_GR);
    const bf16_t* QI = (const bf16_t*)(ws + WS_QI); const bf16_t* KI = (const bf16_t*)(ws + WS_KI); const float* WI = (const float*)(ws + WS_WI);
    unsigned short* SCORES = (unsigned short*)(ws + WS_SCORES); unsigned* THR = (unsigned*)(ws + WS_THR); unsigned* MASKT = (unsigned*)(ws + WS_MASKT);
    float* KVS = (float*)(ws + WS_KVS); bf16_t* RT = WD + (size_t)32 * 1024 * 256;
    bf16_t* MIXED = (bf16_t*)(ws + WS_MIXED);
    if (IN(3)) {
        MK_IDS();
        REP(3) {
        for (int p = bid; p < 256; p += G) ret_kv_pair(lds, KR, VR, KVS, p, tid);
        sc_phase(lds, MISC + 16, ctl + CW_Q + 64 * rep_, QI, KI, WI, SCORES, tid);
        }
        if (BOTH(3)) xcd_barrier(bar);
    }
    if (IN(4)) {
        MK_IDS();
        ret_scan(KVS, RT, bid * NTHR + tid, G * NTHR);
        for (int gw = bid * NWAVES + wave; gw < 2048; gw += G * NWAVES) sel_queries_balanced(SCORES, THR, gw, lane);
        if ((DUP_MASK >> 12) & 1) for (int gw = bid * NWAVES + wave; gw < 2048; gw += G * NWAVES) sel_queries_balanced(SCORES, THR, gw, lane);
        if (BOTH(4)) xcd_barrier(bar);
    }
    if (IN(5)) {
        MK_IDS();
        mask_units(SCORES, THR, MASKT, bid * NWAVES + wave, G * NWAVES, lane);
        if ((DUP_MASK >> 13) & 1) mask_units(SCORES, THR, MASKT, bid * NWAVES + wave, G * NWAVES, lane);
        if (BOTH(5)) xcd_barrier(bar);
    }
    if (IN(6)) {
        MK_IDS();
        {
        for (int p = bid; p < 256; p += G) ret_out_pair(lds, QR, KR, VR, GR, RT, MIXED, p, tid);
        if ((DUP_MASK >> 14) & 1) for (int p = bid; p < 256; p += G) ret_out_pair(lds, QR, KR, VR, GR, RT, MIXED, p, tid);
        asm volatile("s_waitcnt vmcnt(0) lgkmcnt(0)" ::: "memory");
        __syncthreads();
        {
            const attn_body::AttnTensors AT{(const attn_body::bf16*)(ws + WS_QA), (const attn_body::bf16*)(ws + WS_KA), (const attn_body::bf16*)(ws + WS_VA), (attn_body::bf16*)MIXED, (const unsigned*)MASKT};
            const attn_body::StaticOrder So((int)G, (int)bid);
            attn_body::attn_phase<attn_body::StaticOrder>((char*)lds_raw, AT, So);
        }
        __syncthreads();
        }
        if ((DUP_MASK >> 5) & 1) {
        for (int p = bid; p < 256; p += G) ret_out_pair(lds, QR, KR, VR, GR, RT, MIXED, p, tid);
        asm volatile("s_waitcnt vmcnt(0) lgkmcnt(0)" ::: "memory");
        __syncthreads();
        {
            const attn_body::AttnTensors AT{(const attn_body::bf16*)(ws + WS_QA), (const attn_body::bf16*)(ws + WS_KA), (const attn_body::bf16*)(ws + WS_VA), (attn_body::bf16*)MIXED, (const unsigned*)MASKT};
            const attn_body::StaticOrder So((int)G, (int)bid);
            attn_body::attn_phase<attn_body::StaticOrder>((char*)lds_raw, AT, So);
        }
        __syncthreads();
        }
        if (BOTH(6)) xcd_barrier(bar);
    }
    bf16_t* MIX = (bf16_t*)(ws + WS_MIX); bf16_t* H2 = (bf16_t*)(ws + WS_H2); u32x2* LIST = (u32x2*)(ws + WS_LIST); bf16_t* HID = (bf16_t*)(ws + WS_HID);
    bf16_t* Y = (bf16_t*)(ws + WS_Y); float* HRES = (float*)(ws + WS_HRES);
    LAS int* tb = (LAS int*)(lds + TB_OFF);
    if (IN(7)) {
        MK_IDS();
        pg8::Gemm g{MIXED, WOUT, T, 1024, 1024}; pg8::StaticOrder So; So.init(T, 1024, G, bid);
        EpiStore E{MIX, 1024};
        pg8::gemm_phase<EpiStore, pg8::StaticOrder, true, true>(lds, g, So, E);
        if ((DUP_MASK >> 6) & 1) { __syncthreads(); pg8::gemm_phase<EpiStore, pg8::StaticOrder, true, true>(lds, g, So, E); }
        if (BOTH(7)) xcd_barrier(bar);
    }
    if (IN(8)) {
        MK_IDS();
        P6bArgs a{MIX, x, (const float*)args.in[8], (const float*)args.in[9], mod, (const float*)args.in[10], (const float*)args.in[11], (const float*)args.in[12], (const float*)args.in[13], HRES, H2, ctl + CW_CNT, LIST};
        p6b_load_weights(lds, a.w_group, a.w_expert, tid);
        REP(8) for (int gw = bid * NWAVES + wave; gw < T / P6B_NR; gw += G * NWAVES) p6b_rows8(a, lds, (LAS float*)(lds + RT_WL_OFF + wave * 576), gw, lane, rep_ != 0);
        if (BOTH(8)) xcd_barrier(bar);
    }
    if (IN(9)) {
        MK_IDS();
        moe_table(tb, ctl + CW_CNT, tid);
        pg8::Gemm g{H2, WGU, T, 32 * 512, 1024}; MoeSched<1> So{LIST, tb, G, bid, 2, ctl + CW_TILE, ctl + CW_TMO, 0, 1 << 20};
        EpiGU E{HID};
        pg8::gemm_phase_ga<EpiGU, MoeSched<1>>(lds, g, So, E);
        if ((DUP_MASK >> 8) & 1) { __syncthreads(); pg8::gemm_phase_ga<EpiGU, MoeSched<1>>(lds, g, So, E); }
        __syncthreads();
    }
    if (IN(10)) {
        MK_IDS();
        moe_table(tb, ctl + CW_CNT, tid);
        const int n2 = (tb[32] * 2 > G && tb[32] * 2 < 2 * G) ? tb[32] * 2 - G : 0;
        const int t1 = G / 2;
        pg8::Gemm g{HID, WD, T, 32 * 1024, 256};
        EpiDown E{Y, LIST, tb};
        { MoeSched<2> So{LIST, tb, G - n2, bid - n2, 4, ctl + CW_TILE, ctl + CW_TMO, 0, t1}; moe_wait(So); pg8::gemm_phase<EpiDown, MoeSched<2>, true, true>(lds, g, So, E); }
        { MoeSched<2> So{LIST, tb, G - n2, bid - n2, 4, ctl + CW_TILE, ctl + CW_TMO, t1, 1 << 20}; moe_wait(So); pg8::gemm_phase<EpiDown, MoeSched<2>, true, true>(lds, g, So, E); }
        if (BOTH(10)) xcd_barrier(bar);
    }
    if (IN(11)) {
        MK_IDS();
        REP(11) p8_rows(Y, MIX, x, (const float*)args.in[8], (const float*)args.in[17], mod, args.out, bid * NWAVES + wave, G * NWAVES, lane);
    }
#undef IN
#undef BOTH
}
}
extern "C" void kernel_launch(void* const* d_in, const int* in_sizes, int n_in, void* d_out, int out_size, void* d_ws, size_t ws_size, hipStream_t stream) {
    using namespace mk;
    static int grid = 0;
    if (grid == 0) {
        int dev = 0, cus = 0, per_cu = 0;
        if (n_in != 18 || out_size != T * D || ws_size < (size_t)256 * MiB) { fprintf(stderr, "kernel_launch: unexpected problem shape (n_in %d, out %d, ws %zu)\n", n_in, out_size, ws_size); grid = -1; return; }
        if (hipGetDevice(&dev) != hipSuccess || hipDeviceGetAttribute(&cus, hipDeviceAttributeMultiprocessorCount, dev) != hipSuccess) { fprintf(stderr, "kernel_launch: device query failed\n"); grid = -1; return; }
        if (hipFuncSetAttribute((const void*)mega, hipFuncAttributeMaxDynamicSharedMemorySize, LDS_BYTES) != hipSuccess) { fprintf(stderr, "kernel_launch: hipFuncSetAttribute failed\n"); grid = -1; return; }
        if (hipOccupancyMaxActiveBlocksPerMultiprocessor(&per_cu, (const void*)mega, NTHR, LDS_BYTES) != hipSuccess || per_cu < 1) fprintf(stderr, "kernel_launch: occupancy query reports %d\n", per_cu);
        (void)hipGetLastError();
        grid = cus;
    }
    if (grid < 0) return;
    unsigned char* ws = (unsigned char*)d_ws;
    (void)hipMemsetAsync(ws + WS_CTL, 0, CTL_BYTES, stream);
    Args a{};
    for (int i = 0; i < 18; ++i) a.in[i] = d_in[i];
    a.out = (float*)d_out; a.ws = ws; a.ph_lo = 0; a.ph_hi = N_PHASES; a.li = 0; a.pad = 0;
    hipLaunchKernelGGL(mega, dim3(grid), dim3(NTHR), LDS_BYTES, stream, a);
#ifdef EXTRA_PHASE
#ifndef EXTRA_HI
#define EXTRA_HI (EXTRA_PHASE + 1)
#endif
    a.ph_lo = EXTRA_PHASE; a.ph_hi = EXTRA_HI; a.li = 1;
    hipLaunchKernelGGL(mega, dim3(grid), dim3(NTHR), LDS_BYTES, stream, a);
#endif
}
```

```cpp
#include <hip/hip_runtime.h>
#include <cstdio>
#include <cstdint>
#define DUP_MASK 0
#define MK_SLOTMAP_OFF (163840 - 256)
__device__ __forceinline__ unsigned mk_hwslot() { return (unsigned)__builtin_amdgcn_s_getreg((5 << 11) | 4) & 63u; }
__device__ __forceinline__ int mk_wave() { return __builtin_amdgcn_readfirstlane((int)((const __attribute__((address_space(3))) unsigned char*)(unsigned)MK_SLOTMAP_OFF)[mk_hwslot()]); }
__device__ __forceinline__ int mk_lane() { return (int)__builtin_amdgcn_mbcnt_hi(~0u, __builtin_amdgcn_mbcnt_lo(~0u, 0u)); }
__device__ __forceinline__ int mk_tidx() { return mk_wave() * 64 + mk_lane(); }
namespace pg8 {
#define PG8_LAS __attribute__((address_space(3)))
typedef unsigned short bf16_t;
typedef short bf16x8 __attribute__((ext_vector_type(8)));
typedef float f32x4 __attribute__((ext_vector_type(4)));
typedef unsigned u32x4 __attribute__((ext_vector_type(4)));
constexpr int BM = 256, BK = 64, HALF = 128, HTB = HALF * BK * 2  , STAGE_BYTES = 8 * HTB, NXCD = 8, WGM = 8;

__host__ __device__ __forceinline__ int lds_byte(int r, int c) { const int st = (r >> 4) * 2 + (c >> 5), rr = r & 15, cc = c & 31, ob = rr * 64 + cc * 2; return st * 1024 + (ob ^ (((ob >> 9) & 1) << 5)); }
__host__ __device__ __forceinline__ void stage_rc(int b, int& R, int& C) { const int st = b / 1024, sb = b % 1024, swz = sb ^ (((sb >> 9) & 1) << 5); R = (st >> 1) * 16 + swz / 64; C = (st & 1) * 32 + (swz % 64) / 2; }
__host__ __device__ __forceinline__ int perm32(int rho) { const int n = rho >> 4, i = rho & 15; return 8 * (i >> 2) + 4 * n + (i & 3); }

struct Unit { int pm, pn; };
struct Gemm { const bf16_t* A; const bf16_t* Bt; int M, N, K; };

struct StaticOrder {
    int nM, nN, nwg, G, c;
    __host__ __device__ void init(int M, int N, int G_, int c_) { nM = M / BM; nN = N / BM; nwg = nM * nN; G = G_; c = c_; }
    __host__ __device__ bool next(int i, Unit& u) const {
        const long L = (long)i * G + c; if (L >= nwg) return false;
        int wgid = (int)L; { const int q = nwg / NXCD, r = nwg % NXCD, xcd = wgid % NXCD, off = wgid / NXCD; wgid = (xcd < r ? xcd * (q + 1) : r * (q + 1) + (xcd - r) * q) + off; }
        const int nig = WGM * nN, gid = wgid / nig, fm = gid * WGM, gsz = (nM - fm) < WGM ? (nM - fm) : WGM;
        u.pm = fm + ((wgid % nig) % gsz); u.pn = (wgid % nig) / gsz; return true;
    }
    __device__ __forceinline__ void a_ready(const Unit&) const {}
    __device__ __forceinline__ void done(const Unit&) const {}
};
template <class Epi, class Sched, bool ALIGN_EPI = false, bool SP2 = false>
__device__ __forceinline__ void gemm_phase(PG8_LAS unsigned char* lds, const Gemm g, const Sched& S, const Epi& E) {
    const int tid = mk_tidx(), wid = __builtin_amdgcn_readfirstlane(tid >> 6), lane = tid & 63, wr = wid >> 2, wc = wid & 3, fr = lane & 15, fq = lane >> 4;
    const int K = g.K, nt = K / BK;
    unsigned voffA[2], voffB[2];
#pragma unroll
    for (int i = 0; i < 2; ++i) { int R, C; stage_rc(tid * 16 + i * 8192, R, C); const int Rb = Epi::PERM ? ((R & ~31) + perm32(R & 31)) : R;
        voffA[i] = (unsigned)(R * K + C) * 2u; voffB[i] = (unsigned)(Rb * K + C) * 2u; }
    const size_t kstep = (size_t)(BK * 2);
    const size_t hstep = (size_t)HALF * K * 2;
    const size_t tstep = 2 * hstep;
    const unsigned ldsw = (unsigned)wid * 1024u;
    const int aoff = lds_byte(wr * 64 + fr, fq * 8), boff = lds_byte(wc * 32 + fr, fq * 8);
#define PG8_SA(b, h) (((b) * 2 + (h)) * HTB)
#define PG8_SB(b, h) ((4 + (b) * 2 + (h)) * HTB)
#define PG8_STAGE(bufoff, gbase, voff) do { _Pragma("unroll") for (int _i = 0; _i < 2; ++_i) \
        __builtin_amdgcn_global_load_lds((const unsigned*)((const char*)(gbase) + (voff)[_i]), (PG8_LAS unsigned*)(lds + (bufoff) + ldsw + _i * 8192), 16, 0, 0); } while (0)
#define PG8_LDA(dst, b, h) do { _Pragma("unroll") for (int m = 0; m < 4; ++m) _Pragma("unroll") for (int k = 0; k < 2; ++k) dst[m][k] = *(const PG8_LAS bf16x8*)(lds + PG8_SA(b, h) + aoff + m * 2048 + k * 1024); } while (0)
#define PG8_LDB(dst, b, h) do { _Pragma("unroll") for (int n = 0; n < 2; ++n) _Pragma("unroll") for (int k = 0; k < 2; ++k) dst[n][k] = *(const PG8_LAS bf16x8*)(lds + PG8_SB(b, h) + boff + n * 2048 + k * 1024); } while (0)
#define PG8_MMA(ai, bj, At, Bt) do { __builtin_amdgcn_s_setprio(1); _Pragma("unroll") for (int m = 0; m < 4; ++m) _Pragma("unroll") for (int n = 0; n < 2; ++n) _Pragma("unroll") for (int k = 0; k < 2; ++k) \
        acc[ai][bj][m][n] = __builtin_amdgcn_mfma_f32_16x16x32_bf16(Bt[n][k], At[m][k], acc[ai][bj][m][n], 0, 0, 0); __builtin_amdgcn_s_setprio(0); } while (0)
#define PG8_WAIT_V(n) asm volatile("s_waitcnt vmcnt(" #n ")" ::: "memory")
#define PG8_WAIT_L(n) asm volatile("s_waitcnt lgkmcnt(" #n ")" ::: "memory")
#define PG8_BAR __builtin_amdgcn_s_barrier()
#define PG8_SCHED __builtin_amdgcn_sched_barrier(0)
    Unit cur, nxt; int ui = 0;
    if (!S.next(0, cur)) return;
    f32x4 acc[2][2][4][2];
#pragma unroll
    for (int a = 0; a < 2; ++a)
#pragma unroll
        for (int b = 0; b < 2; ++b)
#pragma unroll
            for (int m = 0; m < 4; ++m)
#pragma unroll
                for (int n = 0; n < 2; ++n) acc[a][b][m][n] = (f32x4){0.f, 0.f, 0.f, 0.f};
    bf16x8 At[4][2], B0[2][2], B1[2][2];
    const char* cA = (const char*)g.A + (size_t)cur.pm * tstep; const char* cB = (const char*)g.Bt + (size_t)cur.pn * tstep;
    S.a_ready(cur);
    if constexpr (SP2) {
        PG8_STAGE(PG8_SB(0, 0), cB, voffB); PG8_STAGE(PG8_SB(0, 1), cB + hstep, voffB); PG8_STAGE(PG8_SA(0, 0), cA, voffA); PG8_STAGE(PG8_SA(0, 1), cA + hstep, voffA);
        if (wr == 1) PG8_BAR;
        PG8_WAIT_V(2); PG8_BAR;
        PG8_STAGE(PG8_SB(1, 0), cB + kstep, voffB); PG8_STAGE(PG8_SA(1, 0), cA + kstep, voffA); PG8_STAGE(PG8_SB(1, 1), cB + hstep + kstep, voffB);
        PG8_WAIT_V(6); PG8_BAR;
    } else {
        PG8_STAGE(PG8_SB(0, 0), cB, voffB); PG8_STAGE(PG8_SA(0, 0), cA, voffA); PG8_STAGE(PG8_SB(0, 1), cB + hstep, voffB); PG8_STAGE(PG8_SA(0, 1), cA + hstep, voffA);
        if (wr == 1) PG8_BAR;
        PG8_WAIT_V(4); PG8_BAR;
        PG8_STAGE(PG8_SB(1, 0), cB + kstep, voffB); PG8_STAGE(PG8_SA(1, 0), cA + kstep, voffA); PG8_STAGE(PG8_SB(1, 1), cB + hstep + kstep, voffB);
        PG8_WAIT_V(6); PG8_BAR;
    }
    for (;;) {
        const bool has_next = S.next(ui + 1, nxt);
        const char* nA = has_next ? (const char*)g.A + (size_t)nxt.pm * tstep : cA; const char* nB = has_next ? (const char*)g.Bt + (size_t)nxt.pn * tstep : cB;
        for (int t = 0; t < nt; t += 2) {
            const bool last = (t == nt - 2);
            const char* a1 = cA + (size_t)(t + 1) * kstep;
            const char* a2 = last ? nA : cA + (size_t)(t + 2) * kstep; const char* b2 = last ? nB : cB + (size_t)(t + 2) * kstep;
            const char* a3 = a2 + kstep; const char* b3 = b2 + kstep;
            if (last && has_next) S.a_ready(nxt);
            if constexpr (SP2) {
            PG8_LDB(B0, 0, 0); PG8_LDB(B1, 0, 1); PG8_SCHED; PG8_LDA(At, 0, 0); PG8_STAGE(PG8_SA(1, 1), a1 + hstep, voffA);
            PG8_WAIT_V(8); PG8_WAIT_L(0); PG8_BAR; PG8_MMA(0, 0, At, B0); PG8_MMA(0, 1, At, B1); PG8_BAR; PG8_SCHED;
            PG8_LDA(At, 0, 1); PG8_STAGE(PG8_SB(0, 0), b2, voffB); PG8_STAGE(PG8_SB(0, 1), b2 + hstep, voffB); PG8_STAGE(PG8_SA(0, 0), a2, voffA);
            PG8_WAIT_V(8); PG8_WAIT_L(0); PG8_BAR; PG8_MMA(1, 0, At, B0); PG8_MMA(1, 1, At, B1); PG8_BAR; PG8_SCHED;
            PG8_LDB(B0, 1, 0); PG8_LDB(B1, 1, 1); PG8_SCHED; PG8_LDA(At, 1, 0); PG8_STAGE(PG8_SA(0, 1), a2 + hstep, voffA);
            PG8_WAIT_V(8); PG8_WAIT_L(0); PG8_BAR; PG8_MMA(0, 0, At, B0); PG8_MMA(0, 1, At, B1); PG8_BAR; PG8_SCHED;
            PG8_LDA(At, 1, 1); PG8_STAGE(PG8_SB(1, 0), b3, voffB); PG8_STAGE(PG8_SB(1, 1), b3 + hstep, voffB); PG8_STAGE(PG8_SA(1, 0), a3, voffA);
            PG8_WAIT_V(8); PG8_WAIT_L(0); PG8_BAR; PG8_MMA(1, 0, At, B0); PG8_MMA(1, 1, At, B1); PG8_BAR; PG8_SCHED;
            } else {
            PG8_LDB(B0, 0, 0); PG8_SCHED; PG8_LDA(At, 0, 0); PG8_STAGE(PG8_SA(1, 1), a1 + hstep, voffA);
            PG8_WAIT_L(8); PG8_BAR; PG8_WAIT_L(0); PG8_MMA(0, 0, At, B0); PG8_BAR; PG8_SCHED;
            PG8_LDB(B1, 0, 1); PG8_STAGE(PG8_SB(0, 0), b2, voffB);
            PG8_BAR; PG8_WAIT_L(0); PG8_MMA(0, 1, At, B1); PG8_BAR;
            PG8_LDA(At, 0, 1); PG8_STAGE(PG8_SA(0, 0), a2, voffA);
            PG8_BAR; PG8_WAIT_L(0); PG8_MMA(1, 0, At, B0); PG8_BAR; PG8_SCHED;
            PG8_STAGE(PG8_SB(0, 1), b2 + hstep, voffB);
            PG8_WAIT_V(6); PG8_BAR; PG8_MMA(1, 1, At, B1); PG8_BAR;
            PG8_LDB(B0, 1, 0); PG8_SCHED; PG8_LDA(At, 1, 0); PG8_STAGE(PG8_SA(0, 1), a2 + hstep, voffA);
            PG8_WAIT_L(8); PG8_BAR; PG8_WAIT_L(0); PG8_MMA(0, 0, At, B0); PG8_BAR; PG8_SCHED;
            PG8_LDB(B1, 1, 1); PG8_STAGE(PG8_SB(1, 0), b3, voffB);
            PG8_BAR; PG8_WAIT_L(0); PG8_MMA(0, 1, At, B1); PG8_BAR;
            PG8_LDA(At, 1, 1); PG8_STAGE(PG8_SA(1, 0), a3, voffA);
            PG8_BAR; PG8_WAIT_L(0); PG8_MMA(1, 0, At, B0); PG8_BAR; PG8_SCHED;
            PG8_STAGE(PG8_SB(1, 1), b3 + hstep, voffB);
            PG8_WAIT_V(6); PG8_BAR; PG8_MMA(1, 1, At, B1); PG8_BAR;
            }
        }
        if constexpr (ALIGN_EPI) { if (wr == 0) PG8_BAR; }
        if constexpr (!Epi::AFTER_DRAIN) { E(acc, cur, wr, wc, fr, fq); S.done(cur); }
        if (!has_next) break;
#pragma unroll
        for (int a = 0; a < 2; ++a)
#pragma unroll
            for (int b = 0; b < 2; ++b)
#pragma unroll
                for (int m = 0; m < 4; ++m)
#pragma unroll
                    for (int n = 0; n < 2; ++n) acc[a][b][m][n] = (f32x4){0.f, 0.f, 0.f, 0.f};
        cur = nxt; cA = nA; cB = nB; ++ui;
        if constexpr (ALIGN_EPI) { if (wr == 1) PG8_BAR; }
    }
    PG8_WAIT_V(0);
    if constexpr (!ALIGN_EPI) { if (wr == 0) PG8_BAR; }
    PG8_BAR;
    if constexpr (Epi::AFTER_DRAIN) { E.fused(acc, cur, wr, wc, fr, fq, lds, wid, lane); S.done(cur); }
#undef PG8_SA
#undef PG8_SB
#undef PG8_STAGE
#undef PG8_LDA
#undef PG8_LDB
#undef PG8_MMA
#undef PG8_WAIT_V
#undef PG8_WAIT_L
#undef PG8_BAR
#undef PG8_SCHED
}
}
#define XB_TMO      128
#define XB_XCNT(j)  (256  + 64 * (j))
#define XB_XSUB(j)  (1280 + 64 * (j))
#define XB_XGEN(j)  (2304 + 64 * (j))
#define XB_TOP      3328
#define XB_TOPGEN   3392
#define XCD_BAR_WORDS 3456
#define XB_SPIN_CAP (1u << 18)
#define LAS __attribute__((address_space(3)))

__device__ __forceinline__ unsigned xb_ld(unsigned* p)              { return __hip_atomic_load(p, __ATOMIC_RELAXED, __HIP_MEMORY_SCOPE_AGENT); }
__device__ __forceinline__ unsigned xb_add(unsigned* p, unsigned v) { return __hip_atomic_fetch_add(p, v, __ATOMIC_RELAXED, __HIP_MEMORY_SCOPE_AGENT); }
__device__ __forceinline__ unsigned xb_xcc_id() { return (unsigned)__builtin_amdgcn_s_getreg((3 << 11) | 20) & 0xFu; }
#define XB_SPIN(cond, bar) do { unsigned _sp = 0; while (cond) { __builtin_amdgcn_s_sleep(1); \
    if ((++_sp & 255u) == 0u) { if (xb_ld(&(bar)[XB_TMO])) break; if (_sp > XB_SPIN_CAP) { atomicAdd(&(bar)[XB_TMO], 1u); break; } } } } while (0)

struct XcdBarrier {
    unsigned* bar; unsigned x;
    volatile LAS unsigned* st;
};

__device__ __forceinline__ XcdBarrier xcd_barrier_post(unsigned* bar, volatile LAS unsigned* st) {
    XcdBarrier b; b.bar = bar; b.x = xb_xcc_id(); b.st = st;
    if (mk_tidx() == 0) (void)xb_add(&bar[XB_XCNT(b.x)], 1u);
    return b;
}
__device__ __forceinline__ void xcd_barrier_complete(unsigned* bar, unsigned x, unsigned& nloc, unsigned& nx) {
    const unsigned G = gridDim.x * gridDim.y * gridDim.z;
    unsigned sum, cnt, mine, sp = 0u;
    for (;;) {
        sum = 0u; cnt = 0u; mine = 0u;
#pragma unroll
        for (unsigned j = 0; j < 16; ++j) { const unsigned c = xb_ld(&bar[XB_XCNT(j)]); sum += c; cnt += (c > 0u) ? 1u : 0u; mine = (j == x) ? c : mine; }
        if (sum == G) break;
        __builtin_amdgcn_s_sleep(1);
        if ((++sp & 255u) == 0u) { if (xb_ld(&bar[XB_TMO])) break; if (sp > XB_SPIN_CAP) { atomicAdd(&bar[XB_TMO], 1u); break; } }
    }
    nloc = mine > 0u ? mine : 1u; nx = cnt > 0u ? cnt : 1u;
}

__device__ __forceinline__ void xcd_barrier(const XcdBarrier& b) {
    asm volatile("s_waitcnt vmcnt(0)" ::: "memory");
    __syncthreads();
    if (mk_tidx() == 0) {
        unsigned* bar = b.bar;
        __builtin_amdgcn_s_waitcnt(0);
        unsigned nloc = b.st[0], nx = b.st[1];
        if (nloc == 0u) { xcd_barrier_complete(bar, b.x, nloc, nx); b.st[0] = nloc; b.st[1] = nx; }
        const unsigned old = xb_add(&bar[XB_XSUB(b.x)], 1u);
        const unsigned gen = old / nloc;
        if (old + 1u == (gen + 1u) * nloc) {
            __builtin_amdgcn_fence(__ATOMIC_RELEASE, "agent");
            asm volatile("s_waitcnt vmcnt(0)" ::: "memory");
            const unsigned og = xb_add(&bar[XB_TOP], 1u);
            const unsigned tg = og / nx;
            if (og + 1u == (tg + 1u) * nx) xb_add(&bar[XB_TOPGEN], 1u);
            else XB_SPIN(xb_ld(&bar[XB_TOPGEN]) == tg, bar);
            __builtin_amdgcn_fence(__ATOMIC_ACQUIRE, "agent");
            xb_add(&bar[XB_XGEN(b.x)], 1u);
            asm volatile("s_waitcnt vmcnt(0)" ::: "memory");
        } else {
            XB_SPIN(xb_ld(&bar[XB_XGEN(b.x)]) == gen, bar);
            __builtin_amdgcn_fence(__ATOMIC_ACQUIRE, "agent");
            asm volatile("s_waitcnt vmcnt(0)" ::: "memory");
        }
    }
    __syncthreads();
}
namespace pg8 {
template <class Epi, class Sched>
__device__ __forceinline__ void gemm_phase_ga(PG8_LAS unsigned char* lds, const Gemm g, const Sched& S, const Epi& E) {
    const int tid = mk_tidx(), wid = __builtin_amdgcn_readfirstlane(tid >> 6), lane = tid & 63, wr = wid >> 2, wc = wid & 3, fr = lane & 15, fq = lane >> 4;
    const int K = g.K, nt = K / BK;
    unsigned voffB[2]; int RA[2], CA[2];
#pragma unroll
    for (int i = 0; i < 2; ++i) { int R, C; stage_rc(tid * 16 + i * 8192, R, C); const int Rb = Epi::PERM ? ((R & ~31) + perm32(R & 31)) : R;
        RA[i] = R; CA[i] = C; voffB[i] = (unsigned)(Rb * K + C) * 2u; }
    const size_t kstep = (size_t)(BK * 2);
    const size_t hstep = (size_t)HALF * K * 2;
    const size_t tstep = 2 * hstep;
    const unsigned ldsw = (unsigned)wid * 1024u;
    const int aoff = lds_byte(wr * 64 + fr, fq * 8), boff = lds_byte(wc * 32 + fr, fq * 8);
#define PG8_SA(b, h) (((b) * 2 + (h)) * HTB)
#define PG8_SB(b, h) ((4 + (b) * 2 + (h)) * HTB)
#define PG8_STAGE(bufoff, gbase, voff) do { _Pragma("unroll") for (int _i = 0; _i < 2; ++_i) \
        __builtin_amdgcn_global_load_lds((const unsigned*)((const char*)(gbase) + (voff)[_i]), (PG8_LAS unsigned*)(lds + (bufoff) + ldsw + _i * 8192), 16, 0, 0); } while (0)
#define PG8_LDA(dst, b, h) do { _Pragma("unroll") for (int m = 0; m < 4; ++m) _Pragma("unroll") for (int k = 0; k < 2; ++k) dst[m][k] = *(const PG8_LAS bf16x8*)(lds + PG8_SA(b, h) + aoff + m * 2048 + k * 1024); } while (0)
#define PG8_LDB(dst, b, h) do { _Pragma("unroll") for (int n = 0; n < 2; ++n) _Pragma("unroll") for (int k = 0; k < 2; ++k) dst[n][k] = *(const PG8_LAS bf16x8*)(lds + PG8_SB(b, h) + boff + n * 2048 + k * 1024); } while (0)
#define PG8_MMA(ai, bj, At, Bt) do { __builtin_amdgcn_s_setprio(1); _Pragma("unroll") for (int m = 0; m < 4; ++m) _Pragma("unroll") for (int n = 0; n < 2; ++n) _Pragma("unroll") for (int k = 0; k < 2; ++k) \
        acc[ai][bj][m][n] = __builtin_amdgcn_mfma_f32_16x16x32_bf16(Bt[n][k], At[m][k], acc[ai][bj][m][n], 0, 0, 0); __builtin_amdgcn_s_setprio(0); } while (0)
#define PG8_WAIT_V(n) asm volatile("s_waitcnt vmcnt(" #n ")" ::: "memory")
#define PG8_WAIT_L(n) asm volatile("s_waitcnt lgkmcnt(0)" ::: "memory")
#define PG8_BAR __builtin_amdgcn_s_barrier()
#define PG8_SCHED __builtin_amdgcn_sched_barrier(0)
#define PG8_AOFF(dst, u) do { _Pragma("unroll") for (int _h = 0; _h < 2; ++_h) _Pragma("unroll") for (int _i = 0; _i < 2; ++_i) \
        dst[_h][_i] = (unsigned)S.arow(u, _h * HALF + RA[_i]) * (unsigned)(K * 2) + (unsigned)(CA[_i] * 2); } while (0)
    Unit cur, nxt; int ui = 0;
    if (!S.next(0, cur)) return;
    f32x4 acc[2][2][4][2];
#pragma unroll
    for (int a = 0; a < 2; ++a)
#pragma unroll
        for (int b = 0; b < 2; ++b)
#pragma unroll
            for (int m = 0; m < 4; ++m)
#pragma unroll
                for (int n = 0; n < 2; ++n) acc[a][b][m][n] = (f32x4){0.f, 0.f, 0.f, 0.f};
    bf16x8 At[4][2], B0[2][2], B1[2][2];
    unsigned offC[2][2], offN[2][2];
    PG8_AOFF(offC, cur);
    const char* gA = (const char*)g.A;
    const char* cB = (const char*)g.Bt + (size_t)cur.pn * tstep;
    S.a_ready(cur);
    PG8_STAGE(PG8_SB(0, 0), cB, voffB); PG8_STAGE(PG8_SB(0, 1), cB + hstep, voffB); PG8_STAGE(PG8_SA(0, 0), gA, offC[0]); PG8_STAGE(PG8_SA(0, 1), gA, offC[1]);
    if (wr == 1) PG8_BAR;
    PG8_WAIT_V(2); PG8_BAR;
    PG8_STAGE(PG8_SB(1, 0), cB + kstep, voffB); PG8_STAGE(PG8_SA(1, 0), gA + kstep, offC[0]); PG8_STAGE(PG8_SB(1, 1), cB + hstep + kstep, voffB);
    PG8_WAIT_V(6); PG8_BAR;
    for (;;) {
        const bool has_next = S.next(ui + 1, nxt);
        if (has_next) { PG8_AOFF(offN, nxt); } else {
#pragma unroll
            for (int h_ = 0; h_ < 2; ++h_)
#pragma unroll
                for (int i_ = 0; i_ < 2; ++i_) offN[h_][i_] = offC[h_][i_]; }
        const char* nB = has_next ? (const char*)g.Bt + (size_t)nxt.pn * tstep : cB;
        for (int t = 0; t < nt; t += 2) {
            const bool last = (t == nt - 2);
            const char* a1 = gA + (size_t)(t + 1) * kstep;
            const char* a2 = last ? gA : gA + (size_t)(t + 2) * kstep; const char* b2 = last ? nB : cB + (size_t)(t + 2) * kstep;
            const char* a3 = a2 + kstep; const char* b3 = b2 + kstep;
            unsigned o2[2][2];
#pragma unroll
            for (int h_ = 0; h_ < 2; ++h_)
#pragma unroll
                for (int i_ = 0; i_ < 2; ++i_) o2[h_][i_] = last ? offN[h_][i_] : offC[h_][i_];
            if (last && has_next) S.a_ready(nxt);
            PG8_LDB(B0, 0, 0); PG8_LDB(B1, 0, 1); PG8_SCHED; PG8_LDA(At, 0, 0); PG8_STAGE(PG8_SA(1, 1), a1, offC[1]);
            PG8_WAIT_V(8); PG8_WAIT_L(0); PG8_BAR; PG8_MMA(0, 0, At, B0); PG8_MMA(0, 1, At, B1); PG8_BAR; PG8_SCHED;
            PG8_LDA(At, 0, 1); PG8_STAGE(PG8_SB(0, 0), b2, voffB); PG8_STAGE(PG8_SB(0, 1), b2 + hstep, voffB); PG8_STAGE(PG8_SA(0, 0), a2, o2[0]);
            PG8_WAIT_V(8); PG8_WAIT_L(0); PG8_BAR; PG8_MMA(1, 0, At, B0); PG8_MMA(1, 1, At, B1); PG8_BAR; PG8_SCHED;
            PG8_LDB(B0, 1, 0); PG8_LDB(B1, 1, 1); PG8_SCHED; PG8_LDA(At, 1, 0); PG8_STAGE(PG8_SA(0, 1), a2, o2[1]);
            PG8_WAIT_V(8); PG8_WAIT_L(0); PG8_BAR; PG8_MMA(0, 0, At, B0); PG8_MMA(0, 1, At, B1); PG8_BAR; PG8_SCHED;
            PG8_LDA(At, 1, 1); PG8_STAGE(PG8_SB(1, 0), b3, voffB); PG8_STAGE(PG8_SB(1, 1), b3 + hstep, voffB); PG8_STAGE(PG8_SA(1, 0), a3, o2[0]);
            PG8_WAIT_V(8); PG8_WAIT_L(0); PG8_BAR; PG8_MMA(1, 0, At, B0); PG8_MMA(1, 1, At, B1); PG8_BAR; PG8_SCHED;
        }
        if (wr == 0) PG8_BAR;
        E(acc, cur, wr, wc, fr, fq); S.done(cur);
        if (!has_next) break;
#pragma unroll
        for (int a = 0; a < 2; ++a)
#pragma unroll
            for (int b = 0; b < 2; ++b)
#pragma unroll
                for (int m = 0; m < 4; ++m)
#pragma unroll
                    for (int n = 0; n < 2; ++n) acc[a][b][m][n] = (f32x4){0.f, 0.f, 0.f, 0.f};
        cur = nxt; cB = nB; ++ui;
#pragma unroll
        for (int h_ = 0; h_ < 2; ++h_)
#pragma unroll
            for (int i_ = 0; i_ < 2; ++i_) offC[h_][i_] = offN[h_][i_];
        if (wr == 1) PG8_BAR;
    }
    PG8_WAIT_V(0);
    PG8_BAR;
#undef PG8_SA
#undef PG8_SB
#undef PG8_STAGE
#undef PG8_LDA
#undef PG8_LDB
#undef PG8_MMA
#undef PG8_WAIT_V
#undef PG8_WAIT_L
#undef PG8_BAR
#undef PG8_SCHED
#undef PG8_AOFF
}
}
namespace attn_body {
using bf16=unsigned short;
using bf16x8=__attribute__((ext_vector_type(8)))short;
using s16x4=__attribute__((ext_vector_type(4)))short;
using f32x16=__attribute__((ext_vector_type(16)))float;
using u32x4=__attribute__((ext_vector_type(4)))unsigned;
constexpr int BATCH=4,NHEAD=8,SEQ=4096,D=64,DM=NHEAD*D,ODM=1024;
constexpr int NW=8,QBLK=32,QB=QBLK*NW,KVBLK=64,NQB=SEQ/QB;
constexpr int ATTN_PITCH=DM, ATTN_UNIT_ROWS=QB;
__device__ __forceinline__ int crow(int r,int hi){return (r&3)+8*(r>>2)+4*hi;}
#define SBAR() __builtin_amdgcn_sched_barrier(0)
__device__ __forceinline__ void cmask(f32x16&p0,f32x16&p1,int jb,int qrel,int hi){
  const float NEG=-INFINITY; int kb=64*jb+4*hi;
  #pragma unroll
  for(int r=0;r<16;++r){int kv=kb+(r&3)+8*(r>>2); if(kv>qrel)p0[r]=NEG; if(kv+32>qrel)p1[r]=NEG;}
}

constexpr int NSLOT=3, SLOTB=8192;
constexpr int LDS_K=0, LDS_V=NSLOT*SLOTB, LDS_WS=2*NSLOT*SLOTB, LDS_OST=LDS_WS+NW*64*4, LDS_MSK=LDS_OST+NW*4096, LDS_BYTES=LDS_MSK+NW*768;
constexpr float C2=0.125f*1.4426950408889634f;
__device__ __forceinline__ void glds16(const void*gsrc,unsigned lds_dst){unsigned keep;
  asm volatile("s_mov_b32 %0, m0\n\ts_mov_b32 m0, %2\n\ts_nop 0\n\tglobal_load_lds_dwordx4 %1, off\n\ts_mov_b32 m0, %0":"=&s"(keep):"v"(gsrc),"s"(lds_dst):"memory");}
__device__ __forceinline__ void glds4(const void*gsrc,unsigned lds_dst){unsigned keep;
  asm volatile("s_mov_b32 %0, m0\n\ts_mov_b32 m0, %2\n\ts_nop 0\n\tglobal_load_lds_dword %1, off\n\ts_mov_b32 m0, %0":"=&s"(keep):"v"(gsrc),"s"(lds_dst):"memory");}
template<int BIT> __device__ __forceinline__ float mand(float x,unsigned w){ int m; asm("v_bfe_i32 %0, %1, %2, 1":"=v"(m):"v"(w),"n"(BIT)); return __uint_as_float(__float_as_uint(x)&(unsigned)m); }
__device__ __forceinline__ float max3f(float a,float b,float c){float r;asm("v_max3_f32 %0, %1, %2, %3":"=v"(r):"v"(a),"v"(b),"v"(c));return r;}
__device__ __forceinline__ float max2f(float a,float b){float r;asm("v_max_f32_e32 %0, %1, %2":"=v"(r):"v"(a),"v"(b));return r;}
__device__ __forceinline__ float fadd_s(float a,float b){float r;asm("v_add_f32_e32 %0, %1, %2":"=v"(r):"v"(a),"v"(b));return r;}
__device__ __forceinline__ float fsub_s(float a,float b){float r;asm("v_sub_f32_e32 %0, %1, %2":"=v"(r):"v"(a),"v"(b));return r;}
typedef float f32x2_t __attribute__((ext_vector_type(2))); typedef __bf16 bf16x2_t __attribute__((ext_vector_type(2)));
__device__ __forceinline__ unsigned cvtpk_s(float lo,float hi){f32x2_t v={lo,hi};bf16x2_t b=__builtin_convertvector(v,bf16x2_t);return __builtin_bit_cast(unsigned,b);}
#define WAIT_BAR(N) asm volatile("s_waitcnt vmcnt(" #N ") lgkmcnt(0)\n\ts_barrier":::"memory")

__device__ __forceinline__ void qkt(f32x16&p0,f32x16&p1,const char*Kslot,const bf16x8*qr,const f32x16&negm,int r32,int hi){
  const char*kb=Kslot+hi*1024+r32*16;
  #pragma unroll
  for(int d0=0;d0<4;++d0){
    const bf16x8 b0=*reinterpret_cast<const bf16x8*>(kb+d0*2048);
    const bf16x8 b1=*reinterpret_cast<const bf16x8*>(kb+d0*2048+512);
    if(d0==0){p0=__builtin_amdgcn_mfma_f32_32x32x16_bf16(b0,qr[0],negm,0,0,0);p1=__builtin_amdgcn_mfma_f32_32x32x16_bf16(b1,qr[0],negm,0,0,0);}
    else{p0=__builtin_amdgcn_mfma_f32_32x32x16_bf16(b0,qr[d0],p0,0,0,0);p1=__builtin_amdgcn_mfma_f32_32x32x16_bf16(b1,qr[d0],p1,0,0,0);}}
}
typedef __attribute__((address_space(3))) const char* lds_cptr;
typedef short v4i16_t __attribute__((ext_vector_type(4)));
__device__ __forceinline__ void kload8(bf16x8*kf,lds_cptr kp){
  kf[0]=*(const __attribute__((address_space(3))) bf16x8*)(kp);      kf[1]=*(const __attribute__((address_space(3))) bf16x8*)(kp+512);
  kf[2]=*(const __attribute__((address_space(3))) bf16x8*)(kp+2048); kf[3]=*(const __attribute__((address_space(3))) bf16x8*)(kp+2560);
  kf[4]=*(const __attribute__((address_space(3))) bf16x8*)(kp+4096); kf[5]=*(const __attribute__((address_space(3))) bf16x8*)(kp+4608);
  kf[6]=*(const __attribute__((address_space(3))) bf16x8*)(kp+6144); kf[7]=*(const __attribute__((address_space(3))) bf16x8*)(kp+6656);
}
__device__ __forceinline__ void kload2(bf16x8*kf,lds_cptr kp,int j){ kf[2*j]=*(const __attribute__((address_space(3))) bf16x8*)(kp+j*2048); kf[2*j+1]=*(const __attribute__((address_space(3))) bf16x8*)(kp+j*2048+512); }
__device__ __forceinline__ s16x4 vtr(lds_cptr p){ return __builtin_bit_cast(s16x4,__builtin_amdgcn_ds_read_tr16_b64_v4i16((__attribute__((address_space(3))) v4i16_t*)p)); }
__device__ __forceinline__ float rowmax(const f32x16&p0,const f32x16&p1){
  float a=max3f(p0[0],p0[1],p1[0]),b=max3f(p0[2],p0[3],p1[1]);a=max3f(a,p1[2],p1[3]);
  #pragma unroll
  for(int r=4;r<16;r+=4){a=max3f(a,p0[r],p0[r+1]);b=max3f(b,p0[r+2],p0[r+3]);a=max3f(a,p1[r],p1[r+1]);b=max3f(b,p1[r+2],p1[r+3]);}
  const float m=max2f(a,b);
  auto rr=__builtin_amdgcn_permlane32_swap(__float_as_uint(m),__float_as_uint(m),false,false);
  return max2f(__uint_as_float(rr[0]),__uint_as_float(rr[1]));
}
__device__ __forceinline__ void pv(f32x16*o,int vb,bf16x8 pa0,bf16x8 pa1,bf16x8 pa2,bf16x8 pa3){
  #pragma unroll
  for(int d0=0;d0<2;++d0){s16x4 lo[4],hi[4];
    #pragma unroll
    for(int ks=0;ks<4;++ks){
      asm volatile("ds_read_b64_tr_b16 %0,%1 offset:%c2":"=&v"(lo[ks]):"v"(vb),"i"(d0*4096+ks*1024):"memory");
      asm volatile("ds_read_b64_tr_b16 %0,%1 offset:%c2":"=&v"(hi[ks]):"v"(vb),"i"(d0*4096+ks*1024+512):"memory");}
    asm volatile("s_waitcnt lgkmcnt(0)":::"memory");SBAR();
    #define PK(k) (bf16x8){lo[k][0],lo[k][1],lo[k][2],lo[k][3],hi[k][0],hi[k][1],hi[k][2],hi[k][3]}
    o[d0]=__builtin_amdgcn_mfma_f32_32x32x16_bf16(pa0,PK(0),o[d0],0,0,0);
    o[d0]=__builtin_amdgcn_mfma_f32_32x32x16_bf16(pa1,PK(1),o[d0],0,0,0);
    o[d0]=__builtin_amdgcn_mfma_f32_32x32x16_bf16(pa2,PK(2),o[d0],0,0,0);
    o[d0]=__builtin_amdgcn_mfma_f32_32x32x16_bf16(pa3,PK(3),o[d0],0,0,0);
    #undef PK
  }
}

#ifndef ATTN_STORE16
#define ATTN_STORE16(p,v) (*(u32x4*)(p)=(v))
#endif
template<int THRL> __device__ __forceinline__ void attn_unit(int b,int h,int qb,const bf16*Q,const bf16*__restrict__ K,const bf16*__restrict__ V,bf16*O,const unsigned*__restrict__ MK,char*shm){
  const int tid=mk_tidx(),lane=tid&63,r32=lane&31,hi=lane>>5; const int wid=__builtin_amdgcn_readfirstlane(tid>>6);
  const long rowbase=(long)b*SEQ; const int q0=qb*QB;
  const bf16*Qw=Q+(rowbase+q0+wid*QBLK)*DM+h*D;
  const bf16*Kh=K+rowbase*DM+h*D,*Vh=V+rowbase*DM+h*D;
  const unsigned lds0=(unsigned)(uintptr_t)shm;
  float*wsf=(float*)(shm+LDS_WS)+wid*64;
  const bf16*ksrc=Kh+(long)lane*DM+wid*8;
  const bf16*vsrc=Vh+(long)(16*(wid&3)+(lane>>2))*DM+(wid>>2)*32+(lane&3)*8;
  const unsigned kdst=lds0+LDS_K+wid*1024, vdst=lds0+LDS_V+wid*1024;
  const unsigned*msrc=MK+((size_t)(b*128+8*qb+wid)*64)*64+lane; const unsigned mdst=lds0+LDS_MSK+wid*768;
  const __attribute__((address_space(3))) char*mrd=(__attribute__((address_space(3))) const char*)shm+LDS_MSK+wid*768+lane*4;
  int mq_cur=0,mq_n1=256,mq_n2=512;
  #define DMA_M(t,slot) glds4(msrc+(size_t)(t)*64,(unsigned)__builtin_amdgcn_readfirstlane(mdst+(slot)))
  #define MWORD() (*(const __attribute__((address_space(3))) unsigned*)(mrd+mq_cur))
  #define DMA_K(t,slot) glds16(ksrc+(long)(t)*KVBLK*DM,(unsigned)__builtin_amdgcn_readfirstlane(kdst+(slot)))
  #define DMA_V(t,slot) glds16(vsrc+(long)(t)*KVBLK*DM,(unsigned)__builtin_amdgcn_readfirstlane(vdst+(slot)))
  const int vb0=(int)(lds0+LDS_V)+((lane>>4)&1)*32+(lane&3)*8+(4*hi+((lane&15)>>2))*64;
  const char*Kbase=shm+LDS_K; bf16x8 kf[8];
  const lds_cptr shm3=(lds_cptr)shm; const lds_cptr kp0=shm3+LDS_K+hi*1024+r32*16; const lds_cptr vp0=shm3+LDS_V+((lane>>4)&1)*32+(lane&3)*8+(4*hi+((lane&15)>>2))*64;
  const int NT=(q0+QB)/KVBLK;
  DMA_M(0,0);DMA_M(1,256);DMA_K(0,0);DMA_V(0,0);DMA_K(1,SLOTB);
  bf16x8 qr[4];
  #pragma unroll
  for(int d0=0;d0<4;++d0)qr[d0]=*reinterpret_cast<const bf16x8*>(&Qw[(long)r32*DM+d0*16+hi*8]);
  float mhat=0.f,l_reg=0.f;f32x16 o[2];o[0]=f32x16{};o[1]=f32x16{};f32x16 negm=f32x16{};asm volatile("":"+v"(negm));
  const int qrel=wid*QBLK+r32;
  #define CMASK(P0,P1,t) do{}while(0)
  bool resc=false;
  #define START(P0,P1) do{ const float rm=rowmax(P0,P1); resc=false; \
    { const float dl=(rm>-1e30f)?rm:0.f; mhat=fadd_s(mhat,dl); \
      _Pragma("unroll") for(int r=0;r<16;++r){P0[r]=fsub_s(P0[r],dl);P1[r]=fsub_s(P1[r],dl);} \
      _Pragma("unroll") for(int r=0;r<16;++r)negm[r]=-mhat; asm volatile("":"+v"(negm)); } \
    _Pragma("unroll") for(int r=0;r<16;++r)P0[r]=__builtin_amdgcn_exp2f(P0[r]); }while(0)
  #define RESC() do{ if(resc){ asm volatile("s_waitcnt lgkmcnt(0)":::"memory"); \
      _Pragma("unroll") for(int d_=0;d_<2;++d_) _Pragma("unroll") for(int r=0;r<16;++r)o[d_][r]*=wsf[crow(r,hi)]; } }while(0)
  f32x16 pA0,pA1,pB0,pB1;
  int sl_prev=0,sl_cur=0,sl_next=SLOTB;
  #define ROT() do{sl_prev=sl_cur;sl_cur=sl_next;sl_next=(sl_next==(NSLOT-1)*SLOTB)?0:sl_next+SLOTB; const int mt_=mq_cur;mq_cur=mq_n1;mq_n1=mq_n2;mq_n2=mt_;}while(0)
  DMA_K(2,2*SLOTB);
  WAIT_BAR(3);
  qkt(pA0,pA1,Kbase,qr,negm,r32,hi);asm volatile("s_nop 15\n\ts_nop 7":"+v"(pA0),"+v"(pA1));CMASK(pA0,pA1,0);
  START(pA0,pA1);
  _Pragma("unroll") for(int r=0;r<16;++r)pA1[r]=__builtin_amdgcn_exp2f(pA1[r]);
  { const unsigned mw0=MWORD(); pA0[0]=mand<0>(pA0[0],mw0);pA1[0]=mand<16>(pA1[0],mw0);pA0[1]=mand<1>(pA0[1],mw0);pA1[1]=mand<17>(pA1[1],mw0);pA0[2]=mand<2>(pA0[2],mw0);pA1[2]=mand<18>(pA1[2],mw0);pA0[3]=mand<3>(pA0[3],mw0);pA1[3]=mand<19>(pA1[3],mw0);pA0[4]=mand<4>(pA0[4],mw0);pA1[4]=mand<20>(pA1[4],mw0);pA0[5]=mand<5>(pA0[5],mw0);pA1[5]=mand<21>(pA1[5],mw0);pA0[6]=mand<6>(pA0[6],mw0);pA1[6]=mand<22>(pA1[6],mw0);pA0[7]=mand<7>(pA0[7],mw0);pA1[7]=mand<23>(pA1[7],mw0);pA0[8]=mand<8>(pA0[8],mw0);pA1[8]=mand<24>(pA1[8],mw0);pA0[9]=mand<9>(pA0[9],mw0);pA1[9]=mand<25>(pA1[9],mw0);pA0[10]=mand<10>(pA0[10],mw0);pA1[10]=mand<26>(pA1[10],mw0);pA0[11]=mand<11>(pA0[11],mw0);pA1[11]=mand<27>(pA1[11],mw0);pA0[12]=mand<12>(pA0[12],mw0);pA1[12]=mand<28>(pA1[12],mw0);pA0[13]=mand<13>(pA0[13],mw0);pA1[13]=mand<29>(pA1[13],mw0);pA0[14]=mand<14>(pA0[14],mw0);pA1[14]=mand<30>(pA1[14],mw0);pA0[15]=mand<15>(pA0[15],mw0);pA1[15]=mand<31>(pA1[15],mw0); }
  WAIT_BAR(0);
  DMA_M(2,512);DMA_K(3,0);DMA_V(1,SLOTB);
  ROT();
  kload8(kf,kp0+sl_cur);
  WAIT_BAR(3);
  s16x4 vlo[8],vhi[8]; u32x4 pw0,pw1,pw2,pw3;
  #define PKW(P,B) cvtpk_s(P[B],P[B+1])
  #define PAF(k) __builtin_bit_cast(bf16x8,pw##k)
  #define VFR(i) (bf16x8){vlo[i][0],vlo[i][1],vlo[i][2],vlo[i][3],vhi[i][0],vhi[i][1],vhi[i][2],vhi[i][3]}
  #define PIN(x) asm volatile("":"+v"(x))
  #define MX3(a,b,c) __builtin_fmaxf(__builtin_fmaxf((a),(b)),(c))
  #define GAPA(MF,A0,A1,A2,A3,W0,W1,PW) do{ MF; sacc+=A0; sacc+=A1; sacc+=A2; sacc+=A3; PIN(sacc); W0; W1; PIN(PW); SBAR(); }while(0)
  #define EX(v) __builtin_amdgcn_exp2f(v)
  #define GAPB(MF,X,B,MO) do{ MF; X[B]=mand<MO+B>(EX(X[B]),mw_); X[B+1]=mand<MO+B+1>(EX(X[B+1]),mw_); X[B+2]=mand<MO+B+2>(EX(X[B+2]),mw_); X[B+3]=mand<MO+B+3>(EX(X[B+3]),mw_); PIN(X); SBAR(); }while(0)
  #define VRD(i) do{ vlo[i]=vtr(vp_+(((i)>>2)*4096+((i)&3)*1024)); vhi[i]=vtr(vp_+(((i)>>2)*4096+((i)&3)*1024+512)); }while(0)
  #define KRD(G,j) do{ if(G){ kload2(kf,kp0+sl_next,j); SBAR(); } }while(0)
  #define STEP(C0,C1,P0,P1,t,GK,GV,GL,GM) do{ SBAR(); \
    const lds_cptr vp_=vp0+sl_prev; \
    VRD(0); SBAR(); float sacc=(P0[0]+P0[1]); \
    GAPA(C0=__builtin_amdgcn_mfma_f32_32x32x16_bf16(kf[0],qr[0],negm,0,0,0), P0[2],P0[3],P0[4],P0[5],     pw0[0]=PKW(P0,0), pw0[1]=PKW(P0,2), pw0); \
    VRD(4); SBAR(); GAPA(C1=__builtin_amdgcn_mfma_f32_32x32x16_bf16(kf[1],qr[0],negm,0,0,0), P0[6],P0[7],P0[8],P0[9],     pw0[2]=PKW(P0,4), pw0[3]=PKW(P0,6), pw0); \
    VRD(1); SBAR(); GAPA(C0=__builtin_amdgcn_mfma_f32_32x32x16_bf16(kf[2],qr[1],C0,0,0,0),   P0[10],P0[11],P0[12],P0[13], pw1[0]=PKW(P0,8), pw1[1]=PKW(P0,10), pw1); \
    VRD(5); SBAR(); GAPA(C1=__builtin_amdgcn_mfma_f32_32x32x16_bf16(kf[3],qr[1],C1,0,0,0),   P0[14],P0[15],P1[0],P1[1],   pw1[2]=PKW(P0,12),pw1[3]=PKW(P0,14), pw1); \
    VRD(2); SBAR(); GAPA(C0=__builtin_amdgcn_mfma_f32_32x32x16_bf16(kf[4],qr[2],C0,0,0,0),   P1[2],P1[3],P1[4],P1[5],     pw2[0]=PKW(P1,0), pw2[1]=PKW(P1,2), pw2); \
    VRD(6); SBAR(); GAPA(C1=__builtin_amdgcn_mfma_f32_32x32x16_bf16(kf[5],qr[2],C1,0,0,0),   P1[6],P1[7],P1[8],P1[9],     pw2[2]=PKW(P1,4), pw2[3]=PKW(P1,6), pw2); \
    VRD(3); SBAR(); GAPA(C0=__builtin_amdgcn_mfma_f32_32x32x16_bf16(kf[6],qr[3],C0,0,0,0),   P1[10],P1[11],P1[12],P1[13], pw3[0]=PKW(P1,8), pw3[1]=PKW(P1,10), pw3); \
    VRD(7); SBAR(); GAPA(C1=__builtin_amdgcn_mfma_f32_32x32x16_bf16(kf[7],qr[3],C1,0,0,0),   P1[14],P1[15],0.f,0.f,       pw3[2]=PKW(P1,12),pw3[3]=PKW(P1,14), pw3); \
    l_reg+=sacc; \
    if(GM){DMA_M((t)+2,mq_n2);} if(GK){DMA_K((t)+3,sl_cur);} if(GV){DMA_V((t)+1,sl_next);} \
    const unsigned mw_=MWORD(); \
    CMASK(C0,C1,t); \
    { float a=MX3(C0[0],C0[1],C1[0]),b=MX3(C0[2],C0[3],C1[1]); a=MX3(a,C1[2],C1[3]); \
      _Pragma("unroll") for(int r=4;r<16;r+=4){a=MX3(a,C0[r],C0[r+1]);b=MX3(b,C0[r+2],C0[r+3]);a=MX3(a,C1[r],C1[r+1]);b=MX3(b,C1[r+2],C1[r+3]);} \
      float rm=__builtin_fmaxf(a,b); { auto rr=__builtin_amdgcn_permlane32_swap(__float_as_uint(rm),__float_as_uint(rm),false,false); rm=__builtin_fmaxf(__uint_as_float(rr[0]),__uint_as_float(rr[1])); } \
      resc=false; \
      if(__builtin_expect(__any(rm>(float)THRL),0)){ const float dl=__builtin_fmaxf(rm,0.f); mhat+=dl; \
        _Pragma("unroll") for(int r=0;r<16;++r){C0[r]-=dl;C1[r]-=dl;} \
        _Pragma("unroll") for(int r=0;r<16;++r)negm[r]=-mhat; asm volatile("":"+v"(negm)); \
        const float f=__builtin_amdgcn_exp2f(-dl); l_reg*=f; if(hi==0)wsf[r32]=f; resc=true; } } \
    SBAR(); \
    GAPB(o[0]=__builtin_amdgcn_mfma_f32_32x32x16_bf16(PAF(0),VFR(0),o[0],0,0,0), C0,0,0); \
    GAPB(o[1]=__builtin_amdgcn_mfma_f32_32x32x16_bf16(PAF(0),VFR(4),o[1],0,0,0), C0,4,0); \
    KRD(GL,0); GAPB(o[0]=__builtin_amdgcn_mfma_f32_32x32x16_bf16(PAF(1),VFR(1),o[0],0,0,0), C0,8,0); \
    KRD(GL,1); GAPB(o[1]=__builtin_amdgcn_mfma_f32_32x32x16_bf16(PAF(1),VFR(5),o[1],0,0,0), C0,12,0); \
    KRD(GL,2); GAPB(o[0]=__builtin_amdgcn_mfma_f32_32x32x16_bf16(PAF(2),VFR(2),o[0],0,0,0), C1,0,16); \
    KRD(GL,3); GAPB(o[1]=__builtin_amdgcn_mfma_f32_32x32x16_bf16(PAF(2),VFR(6),o[1],0,0,0), C1,4,16); \
    GAPB(o[0]=__builtin_amdgcn_mfma_f32_32x32x16_bf16(PAF(3),VFR(3),o[0],0,0,0), C1,8,16); \
    GAPB(o[1]=__builtin_amdgcn_mfma_f32_32x32x16_bf16(PAF(3),VFR(7),o[1],0,0,0), C1,12,16); \
    }while(0)
  int t=1;
  #undef CMASK
  #define CMASK(P0,P1,t) do{}while(0)
  for(;t+5<NT;t+=2){
    STEP(pB0,pB1,pA0,pA1,t,true,true,true,true);     WAIT_BAR(3); RESC(); ROT();
    STEP(pA0,pA1,pB0,pB1,t+1,true,true,true,true);   WAIT_BAR(3); RESC(); ROT();
  }
  #undef CMASK
  #define CMASK(P0,P1,t) do{}while(0)
  #define ENDW(tt) do{ if((tt)+3<NT){WAIT_BAR(3);} else if((tt)+2<NT){WAIT_BAR(2);} else {WAIT_BAR(0);} }while(0)
  for(;t+1<NT;t+=2){
    STEP(pB0,pB1,pA0,pA1,t,(t+3<NT),(t+1<NT),(t+1<NT),(t+2<NT));       ENDW(t);   RESC(); ROT();
    STEP(pA0,pA1,pB0,pB1,t+1,(t+4<NT),(t+2<NT),(t+2<NT),(t+3<NT));     ENDW(t+1); RESC(); ROT();
  }
  STEP(pB0,pB1,pA0,pA1,NT-1,false,false,false,false); RESC();
  { float sacc=pB0[0]+pB0[1]; _Pragma("unroll") for(int r=2;r<16;++r)sacc+=pB0[r]; _Pragma("unroll") for(int r=0;r<16;++r)sacc+=pB1[r]; l_reg+=sacc;
    pw0=(u32x4){PKW(pB0,0),PKW(pB0,2),PKW(pB0,4),PKW(pB0,6)};pw1=(u32x4){PKW(pB0,8),PKW(pB0,10),PKW(pB0,12),PKW(pB0,14)};pw2=(u32x4){PKW(pB1,0),PKW(pB1,2),PKW(pB1,4),PKW(pB1,6)};pw3=(u32x4){PKW(pB1,8),PKW(pB1,10),PKW(pB1,12),PKW(pB1,14)};
    SBAR(); pv(o,vb0+sl_cur,PAF(0),PAF(1),PAF(2),PAF(3)); }
  #undef PKW
  #undef PAF
  #undef VFR
  #undef PIN
  #undef MX3
  #undef GAPA
  #undef GAPB
  #undef EX
  #undef VRD
  #undef KRD
  #undef STEP
  #undef ENDW
  {auto rr=__builtin_amdgcn_permlane32_swap(__float_as_uint(l_reg),__float_as_uint(l_reg),false,false);l_reg=__uint_as_float(rr[0])+__uint_as_float(rr[1]);}
  if(hi==0)wsf[32+r32]=l_reg;asm volatile("s_waitcnt lgkmcnt(0)":::"memory");
  float rli[16];
  #pragma unroll
  for(int r=0;r<16;++r)rli[r]=__builtin_amdgcn_rcpf(wsf[32+crow(r,hi)]);
  bf16*Ow=O+(rowbase+q0+wid*QBLK)*ODM+h*D;
  { bf16*stg=(bf16*)(shm+LDS_OST)+wid*2048;
    #pragma unroll
    for(int r=0;r<16;++r){const int orow=crow(r,hi);
      #pragma unroll
      for(int d0=0;d0<2;++d0)stg[orow*64+d0*32+r32]=(bf16)(cvtpk_s(o[d0][r]*rli[r],0.f)&0xffffu);}
    asm volatile("s_waitcnt lgkmcnt(0)":::"memory");
    #pragma unroll
    for(int i=0;i<4;++i){const int row=i*8+(lane>>3),ch=lane&7; const u32x4 v=*(const u32x4*)(stg+row*64+ch*8); ATTN_STORE16(Ow+(long)row*ODM+ch*8,v);} }
  asm volatile("s_waitcnt lgkmcnt(0)\n\ts_barrier":::"memory");
  #undef DMA_K
  #undef DMA_V
  #undef DMA_M
  #undef MWORD
  #undef CMASK
  #undef START
  #undef RESC
  #undef ROT
}
constexpr int ATTN_LDS_BYTES=LDS_BYTES;
struct AttnTensors { const bf16* Q; const bf16* K; const bf16* V; bf16* O; const unsigned* MK; };
struct AttnUnit { int bh; int qb; };
struct StaticOrder {
  int vcu;
  __device__ __forceinline__ explicit StaticOrder(int grid,int block):vcu((block%8)*(grid/8)+block/8){}
  __device__ __forceinline__ bool next(int i,AttnUnit&u)const{ if(i>=2)return false; const int s=vcu&7; u.bh=vcu>>3; u.qb=(i==0)?15-s:s; return true; }
  __device__ __forceinline__ void a_ready(const AttnUnit&)const{}
  __device__ __forceinline__ void done(const AttnUnit&)const{}
};
template<class Sched,int THRL=8> __device__ __forceinline__ void attn_phase(char*lds,const AttnTensors&T,const Sched&S){
  AttnUnit u;
  for(int i=0;S.next(i,u);++i){ S.a_ready(u); attn_unit<THRL>(u.bh/NHEAD,u.bh%NHEAD,u.qb,T.Q,T.K,T.V,T.O,T.MK,lds); S.done(u); }
}
#undef SBAR
#undef WAIT_BAR
}
namespace mk {
#define GAS __attribute__((address_space(1)))
typedef unsigned short bf16_t;
typedef float f32x4 __attribute__((ext_vector_type(4)));
typedef float f32x2 __attribute__((ext_vector_type(2)));
typedef float f32x16 __attribute__((ext_vector_type(16)));
typedef unsigned u32x4 __attribute__((ext_vector_type(4)));
typedef unsigned u32x2 __attribute__((ext_vector_type(2)));
typedef short bf16x8 __attribute__((ext_vector_type(8)));
constexpr int NB = 4, S = 4096, T = NB * S, D = 1024;
constexpr int NWAVES = 8, NTHR = 512;
constexpr int INW = 4168;
constexpr int NPHYS = 4352;
constexpr float C2 = 0.125f * 1.4426950408889634f;
constexpr float WI_SCALE = 0.04419417382415922f;
constexpr float KR_SCALE = 0.08838834764831845f;
constexpr size_t MiB = 1u << 20;
#ifndef WS_RT_MIB
#define WS_RT_MIB 65
#endif
constexpr size_t WS_CTL = 0, CTL_BYTES = 131072;
constexpr size_t WS_MOD = 1 * MiB;
constexpr size_t WS_THR = 2 * MiB;
constexpr size_t WS_R128 = 3 * MiB;
constexpr size_t WS_R64 = 11 * MiB;
constexpr size_t WS_WOUT = 15 * MiB;
constexpr size_t WS_QA = 17 * MiB, WS_KA = 33 * MiB, WS_VA = 49 * MiB, WS_QI = 65 * MiB, WS_KI = 81 * MiB, WS_WI = 83 * MiB;
constexpr size_t WS_QR = 84 * MiB, WS_KR = 100 * MiB, WS_VR = 116 * MiB, WS_GR = 132 * MiB;
constexpr size_t WS_H = 148 * MiB;
constexpr size_t WS_WIN = 180 * MiB;
constexpr size_t WS_SCORES = 148 * MiB, WS_KVS = 214 * MiB, WS_MASKT = 246 * MiB, WS_RT = WS_RT_MIB * MiB, WS_MIXED = 148 * MiB;
constexpr int CW_BAR = 1024, CW_Q = 14400, CW_TMO = 14600;
constexpr int RING_BYTES = 131072;
constexpr int LDS_BYTES = 163840;
constexpr int MISC_OFF = LDS_BYTES - 1024;

typedef __bf16 bf16x2_t __attribute__((ext_vector_type(2)));
__device__ __forceinline__ unsigned cvt_pk(float lo, float hi) { const f32x2 v = {lo, hi}; const bf16x2_t b = __builtin_convertvector(v, bf16x2_t); return __builtin_bit_cast(unsigned, b); }
__device__ __forceinline__ float bf2f(bf16_t v) { return __uint_as_float((unsigned)v << 16); }
__device__ __forceinline__ float silu_f(float x) { return x / (1.f + __expf(-x)); }
#define MK_DPP_ADD(v, ctrl) v += __uint_as_float((unsigned)__builtin_amdgcn_update_dpp(0, (int)__float_as_uint(v), ctrl, 0xf, 0xf, false))
__device__ __forceinline__ float wave_sum(float v) {
    MK_DPP_ADD(v, 0xB1);
    MK_DPP_ADD(v, 0x4E);
    MK_DPP_ADD(v, 0x141);
    MK_DPP_ADD(v, 0x140);
    { const unsigned u = __float_as_uint(v); auto r = __builtin_amdgcn_permlane16_swap(u, u, false, false); v = __uint_as_float(r[0]) + __uint_as_float(r[1]); }
    { const unsigned u = __float_as_uint(v); auto r = __builtin_amdgcn_permlane32_swap(u, u, false, false); v = __uint_as_float(r[0]) + __uint_as_float(r[1]); }
    return v;
}
__host__ __device__ __forceinline__ int perm_fwd(int o, int half) { const int hi = o >= half ? 1 : 0, oo = o - hi * half; return 8 * (oo >> 2) + 4 * hi + (oo & 3); }
__host__ __device__ __forceinline__ int perm_inv(int p, int half) { const int g = p >> 3, r = p & 7; return (r < 4) ? 4 * g + r : half + 4 * g + (r - 4); }
__device__ __forceinline__ int in_src_col(int n) {
    const int tile = n >> 8;
    if (tile < 2) { const int s = n; return 0 + (s & ~63) + perm_inv(s & 63, 32); }
    if (tile < 4) { const int s = n - 512; return 512 + (s & ~63) + perm_inv(s & 63, 32); }
    if (tile < 6) return n;
    if (tile < 8) { const int s = n - 1536; return 1536 + (s & ~63) + perm_inv(s & 63, 32); }
    if (tile == 8) { const int s = n - 2048; if (s < 64) return 2048 + perm_inv(s, 32); if (s < 72) return 2112 + (s - 64); return -1; }
    const int s = n - 2304;
    if (tile < 11) return 2120 + (s & ~127) + perm_inv(s & 127, 64);
    if (tile < 13) { const int q = s - 512; return 2632 + (q & ~127) + perm_inv(q & 127, 64); }
    if (tile < 15) return 3144 + (s - 1024);
    return 3656 + (s - 1536);
}
__device__ __forceinline__ void p0_item_ada(LAS unsigned char* lds, const float* c, const float* w_ada, const float* b_ada, float* mod, int j, int tid) {
    LAS float* sc = (LAS float*)lds; LAS float* part = (LAS float*)(lds + 16384);
    __syncthreads();
    for (int i = tid; i < 4096; i += NTHR) sc[i] = silu_f(c[i]);
    __syncthreads();
    const int col = tid & 31, kg = tid >> 5;
    float a0 = 0.f, a1 = 0.f, a2 = 0.f, a3 = 0.f;
    const float* w = w_ada + 32 * j + col;
#pragma unroll 1
    for (int k0 = kg; k0 < 1024; k0 += 256) {
        float wv[16];
#pragma unroll
        for (int i = 0; i < 16; ++i) wv[i] = w[(size_t)(k0 + 16 * i) * 6144];
#pragma unroll
        for (int i = 0; i < 16; ++i) { const int k = k0 + 16 * i; a0 += sc[k] * wv[i]; a1 += sc[1024 + k] * wv[i]; a2 += sc[2048 + k] * wv[i]; a3 += sc[3072 + k] * wv[i]; }
    }
    part[(kg * 32 + col) * 4 + 0] = a0; part[(kg * 32 + col) * 4 + 1] = a1; part[(kg * 32 + col) * 4 + 2] = a2; part[(kg * 32 + col) * 4 + 3] = a3;
    __syncthreads();
    if (tid < 128) {
        const int cc = tid >> 2, b = tid & 3; float s = 0.f;
#pragma unroll
        for (int g = 0; g < 16; ++g) s += part[(g * 32 + cc) * 4 + b];
        mod[b * 6144 + 32 * j + cc] = s + b_ada[32 * j + cc];
    }
}
__device__ __forceinline__ void p0_item_rope(const int* pos, float* R128, float* R64, int r, int lane) {
    const float f128 = powf(10000.f, -(float)lane / 64.f), f64 = powf(10000.f, -(float)(lane & 31) / 32.f);
    for (int tt = 0; tt < 16; ++tt) {
        const int t = 16 * r + tt;
        float sn, cs; sincosf((float)pos[t] * f128, &sn, &cs);
        *(f32x2*)(R128 + ((size_t)t * 64 + lane) * 2) = (f32x2){cs, sn};
    }
    for (int tt = 0; tt < 16; tt += 2) {
        const int t = 16 * r + tt + (lane >> 5);
        float sn, cs; sincosf((float)pos[t] * f64, &sn, &cs);
        *(f32x2*)(R64 + ((size_t)t * 32 + (lane & 31)) * 2) = (f32x2){cs, sn};
    }
}
template <int MODE> struct TrItem { const float* sp; int ldw, Kdim, n0, k0; bf16_t* WT; bool valid; };
template <int MODE> __device__ __forceinline__ void p0_tr_setup(TrItem<MODE>& it, const float* W, const float* W2, int ldw, int Kdim, bf16_t* WT, int n0, int k0, int lane) {
    const int nl = lane & 31, n = n0 + nl;
    int src = n; const float* Ws = W;
    if (MODE == 0) src = in_src_col(n);
    if (MODE == 2) { const int g = n >> 3, r = n & 7; src = 4 * g + (r & 3); Ws = (r < 4) ? W : W2; }
    it.sp = Ws + (size_t)(k0 + (lane >> 5)) * ldw + (src >= 0 ? src : 0); it.ldw = ldw; it.Kdim = Kdim; it.n0 = n0; it.k0 = k0; it.WT = WT; it.valid = (src >= 0);
}
template <int MODE> __device__ __forceinline__ void p0_tr_load(const TrItem<MODE>& it, float (&tv)[32]) {
#pragma unroll
    for (int i = 0; i < 32; ++i) tv[i] = it.sp[(size_t)(2 * i) * it.ldw];
}
template <int MODE> __device__ __forceinline__ void p0_tr_emit(const TrItem<MODE>& it, const float (&tv)[32], LAS float* scr, int lane) {
    const int nl = lane & 31;
#pragma unroll
    for (int i = 0; i < 32; ++i) scr[(2 * i + (lane >> 5)) * 33 + nl] = it.valid ? tv[i] : 0.f;
    asm volatile("s_waitcnt lgkmcnt(0)" ::: "memory");
    const int c = lane & 7;
#pragma unroll
    for (int j = 0; j < 4; ++j) {
        const int nn = (lane >> 3) + 8 * j; const LAS float* q = scr + (8 * c) * 33 + nn;
        u32x4 o; o.x = cvt_pk(q[0 * 33], q[1 * 33]); o.y = cvt_pk(q[2 * 33], q[3 * 33]); o.z = cvt_pk(q[4 * 33], q[5 * 33]); o.w = cvt_pk(q[6 * 33], q[7 * 33]);
        *(u32x4*)(it.WT + (size_t)(it.n0 + nn) * it.Kdim + it.k0 + 8 * c) = o;
    }
    asm volatile("s_waitcnt lgkmcnt(0)" ::: "memory");
}
template <int MODE> __device__ __forceinline__ void p0_tr_item(const float* W, const float* W2, int ldw, int Kdim, bf16_t* WT, int n0, int k0, LAS float* scr, int lane) {
    TrItem<MODE> it; p0_tr_setup<MODE>(it, W, W2, ldw, Kdim, WT, n0, k0, lane);
    float tv[32]; p0_tr_load<MODE>(it, tv); p0_tr_emit<MODE>(it, tv, scr, lane);
}
struct P0Args { const float *c, *w_ada, *b_ada, *w_in, *w_out, *w_gate, *w_up, *w_down; const int* pos; float *mod, *R128, *R64; bf16_t *WIN, *WOUT, *WGU, *WD; };
__device__ __forceinline__ void p0_prologue(LAS unsigned char* lds, const P0Args& a, int bid, int G, int tid) {
    const int lane = tid & 63, wave = tid >> 6;
    if (bid < 192) p0_item_ada(lds, a.c, a.w_ada, a.b_ada, a.mod, bid, tid);
    __syncthreads();
    LAS float* scr = (LAS float*)(lds + wave * 8448);
    constexpr int I_ROPE = 1024, I_WIN = 16 * (NPHYS / 32), I_WOUT = 16 * 32;
    for (int it = bid * NWAVES + wave; it < I_ROPE + I_WIN + I_WOUT; it += G * NWAVES) {
        int r = it;
        if (r < I_ROPE) { p0_item_rope(a.pos, a.R128, a.R64, r, lane); continue; } r -= I_ROPE;
        if (r < I_WIN) { const int kb = r / (NPHYS / 32), nb = r - kb * (NPHYS / 32); p0_tr_item<0>(a.w_in, nullptr, INW, 1024, a.WIN, 32 * nb, 64 * kb, scr, lane); continue; } r -= I_WIN;
        { const int kb = r >> 5, nb = r & 31; p0_tr_item<1>(a.w_out, nullptr, 1024, 1024, a.WOUT, 32 * nb, 64 * kb, scr, lane); }
    }
}
__device__ __forceinline__ void p0_expert_items(LAS unsigned char* lds, const P0Args& a, int gw, int ngw, int tid) {
    const int lane = tid & 63, wave = tid >> 6;
    LAS float* scr = (LAS float*)(lds + wave * 8448);
    constexpr int I_WGU = 32 * 256, I_WD = 32 * 128;
    {
        TrItem<2> cur, nxt; float tv[32], tn[32];
        int it = gw;
        if (it < I_WGU) { const int e = it >> 8, q = it & 255, kb = q >> 4, nb = q & 15;
            p0_tr_setup<2>(cur, a.w_gate + (size_t)e * 262144, a.w_up + (size_t)e * 262144, 256, 1024, a.WGU + (size_t)e * 524288, 32 * nb, 64 * kb, lane); p0_tr_load<2>(cur, tv); }
#pragma unroll 1
        for (; it < I_WGU; it += ngw) {
            const int i2 = it + ngw; const bool has = i2 < I_WGU;
            if (has) { const int e = i2 >> 8, q = i2 & 255, kb = q >> 4, nb = q & 15;
                p0_tr_setup<2>(nxt, a.w_gate + (size_t)e * 262144, a.w_up + (size_t)e * 262144, 256, 1024, a.WGU + (size_t)e * 524288, 32 * nb, 64 * kb, lane); p0_tr_load<2>(nxt, tn); }
            p0_tr_emit<2>(cur, tv, scr, lane);
            if (has) { cur = nxt;
#pragma unroll
                for (int i = 0; i < 32; ++i) tv[i] = tn[i]; }
        }
    }
    {
        TrItem<1> cur, nxt; float tv[32], tn[32];
        int it = gw;
        if (it < I_WD) { const int e = it >> 7, q = it & 127, kb = q >> 5, nb = q & 31;
            p0_tr_setup<1>(cur, a.w_down + (size_t)e * 262144, nullptr, 1024, 256, a.WD + (size_t)e * 262144, 32 * nb, 64 * kb, lane); p0_tr_load<1>(cur, tv); }
#pragma unroll 1
        for (; it < I_WD; it += ngw) {
            const int i2 = it + ngw; const bool has = i2 < I_WD;
            if (has) { const int e = i2 >> 7, q = i2 & 127, kb = q >> 5, nb = q & 31;
                p0_tr_setup<1>(nxt, a.w_down + (size_t)e * 262144, nullptr, 1024, 256, a.WD + (size_t)e * 262144, 32 * nb, 64 * kb, lane); p0_tr_load<1>(nxt, tn); }
            p0_tr_emit<1>(cur, tv, scr, lane);
            if (has) { cur = nxt;
#pragma unroll
                for (int i = 0; i < 32; ++i) tv[i] = tn[i]; }
        }
    }
}
__device__ __forceinline__ void p1_rows(const float* x, const float* g, const float* mod, bf16_t* H, int gw, int NGW, int lane) {
    for (int m = gw; m < T; m += NGW) {
        const int b = m / S;
        const f32x4* xr = (const f32x4*)(x + (size_t)m * D) + lane;
        f32x4 v[4]; float s = 0.f;
#pragma unroll
        for (int j = 0; j < 4; ++j) { v[j] = xr[64 * j]; s += (v[j].x * v[j].x + v[j].y * v[j].y) + (v[j].z * v[j].z + v[j].w * v[j].w); }
        const float rs = 1.0f / sqrtf(wave_sum(s) * (1.f / 1024.f) + 1e-6f);
        const float* sh = mod + b * 6144; const float* sc = sh + 1024;
        bf16_t* orow = H + (size_t)m * D;
#pragma unroll
        for (int j = 0; j < 4; ++j) {
            const int col = 4 * lane + 256 * j;
            const f32x4 gg = *(const f32x4*)(g + col), a = *(const f32x4*)(sc + col), bb = *(const f32x4*)(sh + col);
            const f32x4 o = v[j] * rs * gg * (a + 1.0f) + bb;
            u32x2 w; w.x = cvt_pk(o.x, o.y); w.y = cvt_pk(o.z, o.w);
            *(u32x2*)(orow + col) = w;
        }
    }
}
struct EpiInProj {
    static constexpr bool PERM = true, AFTER_DRAIN = false;
    bf16_t *QA, *KA, *VA, *QI, *KI, *QR, *KR, *VR, *GR; float* WI; const float* R64; const float* R128;
    template <int ROPE, int ACT> __device__ __forceinline__ void emit(const pg8::f32x4 (&acc)[2][2][4][2], bf16_t* dst, int ld, int segbase, float scale, int row0, int wc, int fq, int bjmask) const {
#pragma unroll
        for (int bj = 0; bj < 2; ++bj) {
            if (!((bjmask >> bj) & 1)) continue;
            const int cg = segbase + 128 * bj + 32 * wc + 8 * fq;
            const int fi = (ROPE == 1) ? ((cg & 63) >> 1) : ((cg & 127) >> 1);
#pragma unroll
            for (int ai = 0; ai < 2; ++ai)
#pragma unroll
                for (int m = 0; m < 4; ++m) {
                    const int row = row0 + ai * 128 + m * 16;
                    pg8::f32x4 v0 = acc[ai][bj][m][0], v1 = acc[ai][bj][m][1];
                    if (ROPE != 0) {
                        const float* tp = (ROPE == 1) ? (R64 + ((size_t)row * 32 + fi) * 2) : (R128 + ((size_t)row * 64 + fi) * 2);
                        const pg8::f32x4 t0 = *(const pg8::f32x4*)tp, t1 = *(const pg8::f32x4*)(tp + 4);
                        pg8::f32x4 o1, o2;
                        o1[0] = v0[0] * t0[0] - v1[0] * t0[1]; o2[0] = v1[0] * t0[0] + v0[0] * t0[1];
                        o1[1] = v0[1] * t0[2] - v1[1] * t0[3]; o2[1] = v1[1] * t0[2] + v0[1] * t0[3];
                        o1[2] = v0[2] * t1[0] - v1[2] * t1[1]; o2[2] = v1[2] * t1[0] + v0[2] * t1[1];
                        o1[3] = v0[3] * t1[2] - v1[3] * t1[3]; o2[3] = v1[3] * t1[2] + v0[3] * t1[3];
                        v0 = o1; v1 = o2;
                    }
                    if (ACT == 1) {
#pragma unroll
                        for (int e = 0; e < 4; ++e) { v0[e] = silu_f(v0[e]); v1[e] = silu_f(v1[e]); }
                    }
                    v0 = v0 * scale; v1 = v1 * scale;
                    u32x4 w; w.x = cvt_pk(v0[0], v0[1]); w.y = cvt_pk(v0[2], v0[3]); w.z = cvt_pk(v1[0], v1[1]); w.w = cvt_pk(v1[2], v1[3]);
                    *(u32x4*)(dst + (size_t)row * ld + cg) = w;
                }
        }
    }
    __device__ __forceinline__ void operator()(const pg8::f32x4 (&acc)[2][2][4][2], const pg8::Unit& u, int wr, int wc, int fr, int fq) const {
        const int row0 = u.pm * 256 + wr * 64 + fr;
        const int pn = u.pn;
        if (pn < 2) emit<1, 0>(acc, QA, 512, pn * 256, C2, row0, wc, fq, 3);
        else if (pn < 4) emit<1, 0>(acc, KA, 512, (pn - 2) * 256, 1.f, row0, wc, fq, 3);
        else if (pn < 6) emit<0, 0>(acc, VA, 512, (pn - 4) * 256, 1.f, row0, wc, fq, 3);
        else if (pn < 8) emit<1, 0>(acc, QI, 512, (pn - 6) * 256, 1.f, row0, wc, fq, 3);
        else if (pn == 8) {
            if (wc < 2) emit<1, 0>(acc, KI, 64, 0, 1.f, row0, wc, fq, 1);
            else if (wc == 2 && fq == 0) {
#pragma unroll
                for (int ai = 0; ai < 2; ++ai)
#pragma unroll
                    for (int m = 0; m < 4; ++m) {
                        const int row = row0 + ai * 128 + m * 16;
                        *(pg8::f32x4*)(WI + (size_t)row * 8) = acc[ai][0][m][0] * WI_SCALE;
                        *(pg8::f32x4*)(WI + (size_t)row * 8 + 4) = acc[ai][0][m][1] * WI_SCALE;
                    }
            }
        }
        else if (pn < 11) emit<2, 0>(acc, QR, 512, (pn - 9) * 256, 1.f, row0, wc, fq, 3);
        else if (pn < 13) emit<2, 0>(acc, KR, 512, (pn - 11) * 256, KR_SCALE, row0, wc, fq, 3);
        else if (pn < 15) emit<0, 0>(acc, VR, 512, (pn - 13) * 256, 1.f, row0, wc, fq, 3);
        else emit<0, 1>(acc, GR, 512, (pn - 15) * 256, 1.f, row0, wc, fq, 3);
    }
};
typedef short v4i16_t __attribute__((ext_vector_type(4)));
__device__ __forceinline__ unsigned off_b(unsigned row, unsigned ch) { return 256u * row + 16u * (ch ^ (((row & 3u) << 2) | ((row >> 2) & 3u))); }
__device__ __forceinline__ int crow(int r, int hi) { return (r & 3) + 8 * (r >> 2) + 4 * hi; }
__device__ __forceinline__ v4i16_t tr_rd(LAS unsigned char* p) { return __builtin_amdgcn_ds_read_tr16_b64_v4i16((LAS v4i16_t*)p); }
__device__ __forceinline__ bf16x8 tr_frag_nat(LAS unsigned char* img, int lane, int c, int ks) {
    const unsigned h = lane >> 5, blk = (lane >> 4) & 1, q = (lane & 15) >> 2, p = lane & 3;
    const v4i16_t lo = tr_rd(img + off_b(16 * ks + 8 * h + q, 4 * c + 2 * blk + (p >> 1)) + 8 * (p & 1));
    const v4i16_t hi = tr_rd(img + off_b(16 * ks + 8 * h + 4 + q, 4 * c + 2 * blk + (p >> 1)) + 8 * (p & 1));
    return (bf16x8){lo[0], lo[1], lo[2], lo[3], hi[0], hi[1], hi[2], hi[3]};
}
__device__ __forceinline__ bf16x8 tr_frag_acc(LAS unsigned char* img, int lane, int c, int rowbase) {
    const unsigned h = lane >> 5, blk = (lane >> 4) & 1, q = (lane & 15) >> 2, p = lane & 3;
    const v4i16_t lo = tr_rd(img + off_b(rowbase + 4 * h + q, 4 * c + 2 * blk + (p >> 1)) + 8 * (p & 1));
    const v4i16_t hi = tr_rd(img + off_b(rowbase + 8 + 4 * h + q, 4 * c + 2 * blk + (p >> 1)) + 8 * (p & 1));
    return (bf16x8){lo[0], lo[1], lo[2], lo[3], hi[0], hi[1], hi[2], hi[3]};
}
__device__ __forceinline__ float ret_lgam(int h) { return logf(1.0f - exp2f(-5.0f - (float)h)); }
template <bool SCALE> __device__ __forceinline__ void ret_stage(LAS unsigned char* img, const bf16_t* src  , float sc, int tl) {
#pragma unroll
    for (int it = 0; it < 8; ++it) {
        const int idx = tl + 256 * it, row = idx >> 4, ch = idx & 15;
        u32x4 v = *(const u32x4*)(src + (size_t)row * 512 + ch * 8);
        if (SCALE) {
            const float f = expf(sc * (float)row);
#pragma unroll
            for (int e = 0; e < 4; ++e) { const unsigned w = v[e]; v[e] = cvt_pk(__uint_as_float(w << 16) * f, __uint_as_float(w & 0xffff0000u) * f); }
        }
        *(LAS u32x4*)(img + off_b(row, ch)) = v;
    }
}
__device__ __forceinline__ void ret_kv_pair(LAS unsigned char* lds, const bf16_t* KR, const bf16_t* VR, float* KVS, int pair, int tid) {
    const int uh = tid >> 8, tl = tid & 255, lane = tid & 63, w4 = __builtin_amdgcn_readfirstlane((tid >> 6) & 3), hi = lane >> 5, r32 = lane & 31;
    const int unit = pair * 2 + uh, n = unit & 31, bh = unit >> 5, b = bh >> 2, h = bh & 3;
    const size_t tok0 = (size_t)b * S + (size_t)n * 128;
    LAS unsigned char* kimg = lds + uh * 65536; LAS unsigned char* vimg = kimg + 32768;
    const float lgam = ret_lgam(h);
    __syncthreads();
    ret_stage<false>(kimg, KR + tok0 * 512 + h * 128, 0.f, tl);
    ret_stage<true>(vimg, VR + tok0 * 512 + h * 128, -lgam, tl);
    __syncthreads();
    f32x16 acc[4];
#pragma unroll
    for (int c = 0; c < 4; ++c) acc[c] = (f32x16){};
#pragma unroll
    for (int ks = 0; ks < 8; ++ks) {
        const bf16x8 a = tr_frag_nat(vimg, lane, w4, ks);
#pragma unroll
        for (int nt = 0; nt < 4; ++nt) { const bf16x8 bb = tr_frag_nat(kimg, lane, nt, ks); acc[nt] = __builtin_amdgcn_mfma_f32_32x32x16_bf16(a, bb, acc[nt], 0, 0, 0); }
    }
    const float sc = expf(lgam * 127.f);
    float* o = KVS + (size_t)unit * 16384;
#pragma unroll
    for (int nt = 0; nt < 4; ++nt)
#pragma unroll
        for (int r = 0; r < 16; ++r) o[(32 * w4 + crow(r, hi)) * 128 + 32 * nt + r32] = acc[nt][r] * sc;
}
__device__ __forceinline__ void ret_scan(const float* __restrict__ KVS, bf16_t* __restrict__ RT, int gtid, int nthreads) {
    for (int idx = gtid; idx < 16 * 16384; idx += nthreads) {
        const int bh = idx >> 14, el = idx & 16383, h = bh & 3;
        const float g = 1.0f - exp2f(-5.0f - (float)h), g128 = expf(128.f * ret_lgam(h));
        const size_t o0 = ((size_t)(bh * 32) << 14) + el;
        float kv[31];
#pragma unroll
        for (int n = 0; n < 31; ++n) kv[n] = KVS[o0 + ((size_t)n << 14)];
        float R = 0.f;
#pragma unroll
        for (int n = 0; n < 32; ++n) {
            RT[o0 + ((size_t)n << 14)] = (bf16_t)(cvt_pk(g * R, 0.f) & 0xffffu);
            if (n < 31) R = g128 * R + kv[n];
        }
    }
}
__device__ __forceinline__ void ret_out_pair(LAS unsigned char* lds, const bf16_t* QR, const bf16_t* KR, const bf16_t* VR, const bf16_t* GR, const bf16_t* RT, bf16_t* MIXED, int pair, int tid) {
    const int uh = tid >> 8, tl = tid & 255, lane = tid & 63, w4 = __builtin_amdgcn_readfirstlane((tid >> 6) & 3), hi = lane >> 5, r32 = lane & 31;
    const int unit = pair * 2 + uh, n = unit & 31, bh = unit >> 5, b = bh >> 2, h = bh & 3;
    const size_t tok0 = (size_t)b * S + (size_t)n * 128;
    LAS unsigned char* vimg = lds + uh * 32768;
    const float lgam = ret_lgam(h);
    __syncthreads();
    ret_stage<true>(vimg, VR + tok0 * 512 + h * 128, -lgam, tl);
    __syncthreads();
    bf16x8 qf[8];
    {
        const bf16_t* qp = QR + (tok0 + 32 * w4 + r32) * 512 + h * 128 + 8 * hi;
#pragma unroll
        for (int ks = 0; ks < 8; ++ks) qf[ks] = *(const bf16x8*)(qp + 16 * ks);
    }
    f32x16 acc[4];
#pragma unroll
    for (int c = 0; c < 4; ++c) acc[c] = (f32x16){};
    if (n > 0) {
        const bf16_t* rp = RT + (size_t)unit * 16384 + r32 * 128 + 8 * hi;
#pragma unroll
        for (int c = 0; c < 4; ++c)
#pragma unroll
            for (int ks = 0; ks < 8; ++ks) { const bf16x8 a = *(const bf16x8*)(rp + c * 32 * 128 + 16 * ks); acc[c] = __builtin_amdgcn_mfma_f32_32x32x16_bf16(a, qf[ks], acc[c], 0, 0, 0); }
    }
    for (int jt = 0; jt <= w4; ++jt) {
        const bf16_t* kp = KR + (tok0 + 32 * jt + r32) * 512 + h * 128 + 8 * hi;
        f32x16 st = (f32x16){};
#pragma unroll
        for (int ks = 0; ks < 8; ++ks) { const bf16x8 kf = *(const bf16x8*)(kp + 16 * ks); st = __builtin_amdgcn_mfma_f32_32x32x16_bf16(kf, qf[ks], st, 0, 0, 0); }
        if (jt == w4) {
#pragma unroll
            for (int r = 0; r < 16; ++r) if (crow(r, hi) > r32) st[r] = 0.f;
        }
#pragma unroll
        for (int s = 0; s < 2; ++s) {
            u32x4 pw; pw.x = cvt_pk(st[8 * s + 0], st[8 * s + 1]); pw.y = cvt_pk(st[8 * s + 2], st[8 * s + 3]); pw.z = cvt_pk(st[8 * s + 4], st[8 * s + 5]); pw.w = cvt_pk(st[8 * s + 6], st[8 * s + 7]);
            const bf16x8 pb = __builtin_bit_cast(bf16x8, pw);
#pragma unroll
            for (int c = 0; c < 4; ++c) { const bf16x8 vf = tr_frag_acc(vimg, lane, c, 32 * jt + 16 * s); acc[c] = __builtin_amdgcn_mfma_f32_32x32x16_bf16(vf, pb, acc[c], 0, 0, 0); }
        }
    }
    float ss = 0.f;
#pragma unroll
    for (int c = 0; c < 4; ++c)
#pragma unroll
        for (int r = 0; r < 16; ++r) ss += acc[c][r] * acc[c][r];
    ss += __shfl_xor(ss, 32);
    const float gi = expf(lgam * (float)(32 * w4 + r32));
    const float fac = gi / sqrtf(gi * gi * ss * (1.0f / 128.f) + 1e-6f);
    const size_t tok = tok0 + 32 * w4 + r32;
    const bf16_t* gp = GR + tok * 512 + h * 128 + 4 * hi;
    bf16_t* op = MIXED + tok * 1024 + 512 + h * 128 + 4 * hi;
#pragma unroll
    for (int c = 0; c < 4; ++c)
#pragma unroll
        for (int g4 = 0; g4 < 4; ++g4) {
            const u32x2 gv = *(const u32x2*)(gp + 32 * c + 8 * g4);
            const float g0 = __uint_as_float(gv.x << 16), g1 = __uint_as_float(gv.x & 0xffff0000u), g2 = __uint_as_float(gv.y << 16), g3 = __uint_as_float(gv.y & 0xffff0000u);
            u32x2 w; w.x = cvt_pk(acc[c][4 * g4 + 0] * fac * g0, acc[c][4 * g4 + 1] * fac * g1); w.y = cvt_pk(acc[c][4 * g4 + 2] * fac * g2, acc[c][4 * g4 + 3] * fac * g3);
            *(u32x2*)(op + 32 * c + 8 * g4) = w;
        }
}
constexpr size_t WS_MIX = 17 * MiB;
constexpr size_t WS_H2 = 49 * MiB;
constexpr size_t WS_LIST = 81 * MiB;
constexpr size_t WS_HID = 85 * MiB;
constexpr size_t WS_Y = 105 * MiB;
constexpr size_t WS_HRES = 180 * MiB;
constexpr int CW_CNT = 12288;
constexpr int CW_TILE = 16384;
constexpr int TB_OFF = MISC_OFF + 64;

struct EpiStore {
    static constexpr bool PERM = true, AFTER_DRAIN = false;
    bf16_t* O; int ld;
    __device__ __forceinline__ void operator()(const pg8::f32x4 (&acc)[2][2][4][2], const pg8::Unit& u, int wr, int wc, int fr, int fq) const {
        const int row0 = u.pm * 256 + wr * 64 + fr, col0 = u.pn * 256 + wc * 32 + 8 * fq;
#pragma unroll
        for (int ai = 0; ai < 2; ++ai)
#pragma unroll
            for (int m = 0; m < 4; ++m)
#pragma unroll
                for (int bj = 0; bj < 2; ++bj) {
                    const pg8::f32x4 v0 = acc[ai][bj][m][0], v1 = acc[ai][bj][m][1];
                    u32x4 w; w.x = cvt_pk(v0[0], v0[1]); w.y = cvt_pk(v0[2], v0[3]); w.z = cvt_pk(v1[0], v1[1]); w.w = cvt_pk(v1[2], v1[3]);
                    *(u32x4*)(O + (size_t)(row0 + ai * 128 + m * 16) * ld + col0 + bj * 128) = w;
                }
    }
};
struct P6bArgs { const bf16_t* MIX; const float *x, *g_post, *g_pre2, *mod, *w_group, *b_group, *w_expert, *b_expert; float* HRES; bf16_t* H2; unsigned* cnt; u32x2* LIST; };
constexpr int P6B_NR = 4;
constexpr int RT_WL_OFF = 147456;
__device__ __forceinline__ void p6b_load_weights(LAS unsigned char* lds, const float* w_group, const float* w_expert, int tid) {
    __syncthreads();
    for (int idx = tid; idx < 1024 * 9; idx += NTHR) {
        const int d = idx / 9, cc = idx - 9 * d, pos = ((d >> 2) & 63) + 64 * ((d & 3) + 4 * (d >> 8));
        const f32x4 v = (cc == 0) ? *(const f32x4*)(w_group + d * 4) : *(const f32x4*)(w_expert + d * 32 + 4 * (cc - 1));
        *(LAS f32x4*)(lds + pos * 144 + 16 * cc) = v;
    }
    __syncthreads();
}
__device__ __forceinline__ void p6b_rows8(const P6bArgs& a, const LAS unsigned char* wtab, LAS float* wl  , int gw, int lane, bool dry = false) {
    const int m0 = gw * P6B_NR, b = m0 / S;
    const float* md = a.mod + b * 6144;
    float hv[P6B_NR][16];
#pragma unroll
    for (int r = 0; r < P6B_NR; ++r) {
        const size_t row = (size_t)(m0 + r);
        float v[16]; float s = 0.f;
#pragma unroll
        for (int j = 0; j < 4; ++j) {
            const u32x2 w = *(const u32x2*)(a.MIX + row * 1024 + 4 * lane + 256 * j);
            v[4 * j + 0] = __uint_as_float(w.x << 16); v[4 * j + 1] = __uint_as_float(w.x & 0xffff0000u); v[4 * j + 2] = __uint_as_float(w.y << 16); v[4 * j + 3] = __uint_as_float(w.y & 0xffff0000u);
#pragma unroll
            for (int k = 0; k < 4; ++k) s += v[4 * j + k] * v[4 * j + k];
        }
        const float rs = 1.0f / sqrtf(wave_sum(s) * (1.f / 1024.f) + 1e-6f);
        float s2 = 0.f;
#pragma unroll
        for (int j = 0; j < 4; ++j) {
            const int col = 4 * lane + 256 * j;
            const f32x4 xx = *(const f32x4*)(a.x + row * 1024 + col), gp = *(const f32x4*)(a.g_post + col), g1 = *(const f32x4*)(md + 2 * 1024 + col);
            f32x4 hr;
#pragma unroll
            for (int k = 0; k < 4; ++k) { hr[k] = xx[k] + g1[k] * (v[4 * j + k] * rs * gp[k]); v[4 * j + k] = hr[k]; s2 += hr[k] * hr[k]; }
        }
        const float rs2 = 1.0f / sqrtf(wave_sum(s2) * (1.f / 1024.f) + 1e-6f);
#pragma unroll
        for (int j = 0; j < 4; ++j) {
            const int col = 4 * lane + 256 * j;
            const f32x4 g2 = *(const f32x4*)(a.g_pre2 + col), sc = *(const f32x4*)(md + 4 * 1024 + col), sh = *(const f32x4*)(md + 3 * 1024 + col);
#pragma unroll
            for (int k = 0; k < 4; ++k) hv[r][4 * j + k] = v[4 * j + k] * rs2 * g2[k] * (1.f + sc[k]) + sh[k];
            u32x2 w; w.x = cvt_pk(hv[r][4 * j + 0], hv[r][4 * j + 1]); w.y = cvt_pk(hv[r][4 * j + 2], hv[r][4 * j + 3]);
            *(u32x2*)(a.H2 + row * 1024 + col) = w;
            hv[r][4 * j + 0] = __uint_as_float(w.x << 16); hv[r][4 * j + 1] = __uint_as_float(w.x & 0xffff0000u); hv[r][4 * j + 2] = __uint_as_float(w.y << 16); hv[r][4 * j + 3] = __uint_as_float(w.y & 0xffff0000u);
        }
    }
#pragma unroll 1
    for (int c = 0; c < 9; ++c) {
        f32x2 acc[P6B_NR][2];
#pragma unroll
        for (int r = 0; r < P6B_NR; ++r) { acc[r][0] = (f32x2){0.f, 0.f}; acc[r][1] = (f32x2){0.f, 0.f}; }
#pragma unroll
        for (int j = 0; j < 4; ++j)
#pragma unroll
            for (int k = 0; k < 4; ++k) {
                const f32x4 w4 = *(const LAS f32x4*)(wtab + (lane + 64 * (k + 4 * j)) * 144 + 16 * c);
                const f32x2 wa = {w4[0], w4[1]}, wb = {w4[2], w4[3]};
#pragma unroll
                for (int r = 0; r < P6B_NR; ++r) {
                    const f32x2 hh = {hv[r][4 * j + k], hv[r][4 * j + k]};
                    acc[r][0] = __builtin_elementwise_fma(wa, hh, acc[r][0]); acc[r][1] = __builtin_elementwise_fma(wb, hh, acc[r][1]);
                }
            }
        float v[16];
#pragma unroll
        for (int r = 0; r < P6B_NR; ++r) { v[4 * r + 0] = acc[r][0][0]; v[4 * r + 1] = acc[r][0][1]; v[4 * r + 2] = acc[r][1][0]; v[4 * r + 3] = acc[r][1][1]; }
        float s8[8], t4[4];
#pragma unroll
        for (int i = 0; i < 8; ++i) { auto q = __builtin_amdgcn_permlane32_swap(__float_as_uint(v[i]), __float_as_uint(v[i + 8]), false, false); s8[i] = __uint_as_float(q[0]) + __uint_as_float(q[1]); }
#pragma unroll
        for (int i = 0; i < 4; ++i) { auto q = __builtin_amdgcn_permlane16_swap(__float_as_uint(s8[i]), __float_as_uint(s8[i + 4]), false, false); t4[i] = __uint_as_float(q[0]) + __uint_as_float(q[1]); }
#pragma unroll
        for (int i = 0; i < 4; ++i) MK_DPP_ADD(t4[i], 0x128);
        float u0 = (lane & 8) ? t4[1] : t4[0], u1 = (lane & 8) ? t4[3] : t4[2];
        MK_DPP_ADD(u0, 0x141); MK_DPP_ADD(u1, 0x141);
        float w = (lane & 4) ? u1 : u0;
        MK_DPP_ADD(w, 0x1B);
        MK_DPP_ADD(w, 0xB1);
        if ((lane & 3) == 0) wl[(lane >> 4) * 36 + 4 * c + 2 * ((lane >> 2) & 1) + ((lane >> 3) & 1)] = w;
    }
    asm volatile("s_waitcnt lgkmcnt(0)" ::: "memory");
    if (lane < P6B_NR && !dry) {
        const LAS float* lg = wl + lane * 36;
        float gm = lg[0] + a.b_group[0]; int gs = 0; float l1 = lg[1] + a.b_group[1], l2 = lg[2] + a.b_group[2], l3 = lg[3] + a.b_group[3];
        const float l0 = gm;
        if (l1 > gm) { gm = l1; gs = 1; } if (l2 > gm) { gm = l2; gs = 2; } if (l3 > gm) { gm = l3; gs = 3; }
        const float gtop = 1.0f / (expf(l0 - gm) + expf(l1 - gm) + expf(l2 - gm) + expf(l3 - gm));
        float el[8];
#pragma unroll
        for (int i = 0; i < 8; ++i) el[i] = lg[4 + gs * 8 + i] + a.b_expert[gs * 8 + i];
        float b1 = el[0]; int i1 = 0;
#pragma unroll
        for (int i = 1; i < 8; ++i) if (el[i] > b1) { b1 = el[i]; i1 = i; }
        float b2 = -INFINITY; int i2 = 0;
#pragma unroll
        for (int i = 0; i < 8; ++i) if (i != i1 && el[i] > b2) { b2 = el[i]; i2 = i; }
        const float p2 = expf(b2 - b1), den = 1.0f + p2;
        const float w0 = gtop / den, w1 = gtop * p2 / den;
        const int e0 = gs * 8 + i1, e1 = gs * 8 + i2;
        const unsigned tok = (unsigned)(m0 + lane);
        const unsigned pos0 = atomicAdd(a.cnt + 64 * e0, 1u), pos1 = atomicAdd(a.cnt + 64 * e1, 1u);
        a.LIST[(size_t)e0 * 16384 + pos0] = (u32x2){tok, __float_as_uint(w0)};
        a.LIST[(size_t)e1 * 16384 + pos1] = (u32x2){tok | 0x80000000u, __float_as_uint(w1)};
    }
}
template <int ROLE> struct MoeSched {
    const u32x2* LIST; LAS int* tb; int G, c, NJ;
    unsigned* tilecnt;
    unsigned* tmo;
    int tlo, thi;
    __device__ __forceinline__ bool next(int i, pg8::Unit& u) const {
        if (c < 0) return false;
        const int L = i * G + c, TT = (thi < tb[32]) ? thi : tb[32];
        const int tg = tlo + L / NJ, j = L % NJ;
        if (tg >= TT) return false;
        int e = 0;
#pragma unroll 1
        for (int k = 1; k < 32; ++k) e += (tb[k] <= tg) ? 1 : 0;
        u.pm = tg; u.pn = e * NJ + j; return true;
    }
    __device__ __forceinline__ int arow(const pg8::Unit& u, int r) const {
        const int e = u.pn / NJ, idx = (u.pm - tb[e]) * 256 + r;
        return (idx < tb[33 + e]) ? (int)(LIST[(size_t)e * 16384 + idx].x & 0x7fffffffu) : 0;
    }
    __device__ __forceinline__ void a_ready(const pg8::Unit&) const {}
    __device__ __forceinline__ void done(const pg8::Unit& u) const {
        if (ROLE != 1) return;
        asm volatile("s_waitcnt vmcnt(0)" ::: "memory");
        if (mk_lane() == 0) __hip_atomic_fetch_add(tilecnt + 64 * u.pm, 1u, __ATOMIC_RELAXED, __HIP_MEMORY_SCOPE_AGENT);
    }
};
__device__ __forceinline__ void moe_wait(const MoeSched<2>& S) {
    if (mk_wave() == 0) {
        pg8::Unit u;
        for (int i = 0; S.next(i, u); ++i) {
            unsigned sp = 0;
            while ((unsigned)__builtin_amdgcn_readfirstlane(__hip_atomic_load(S.tilecnt + 64 * u.pm, __ATOMIC_RELAXED, __HIP_MEMORY_SCOPE_AGENT)) < 16u) {
                __builtin_amdgcn_s_sleep(2);
                if (++sp > (1u << 22)) { __hip_atomic_store(S.tmo, 1u, __ATOMIC_RELAXED, __HIP_MEMORY_SCOPE_AGENT); break; }
            }
        }
        __builtin_amdgcn_fence(__ATOMIC_ACQUIRE, "agent");
        asm volatile("s_waitcnt vmcnt(0)" ::: "memory");
    }
    __syncthreads();
}
__device__ __forceinline__ void moe_table(LAS int* tb, const unsigned* cnt, int tid) {
    __syncthreads();
    if (tid < 32) tb[33 + tid] = (int)__hip_atomic_load(cnt + 64 * tid, __ATOMIC_RELAXED, __HIP_MEMORY_SCOPE_AGENT);
    __syncthreads();
    if (tid == 0) { int s = 0; for (int e = 0; e < 32; ++e) { tb[e] = s; s += (tb[33 + e] + 255) >> 8; } tb[32] = s; }
    __syncthreads();
}
struct EpiGU {
    static constexpr bool PERM = true, AFTER_DRAIN = false;
    bf16_t* HID;
    __device__ __forceinline__ void operator()(const pg8::f32x4 (&acc)[2][2][4][2], const pg8::Unit& u, int wr, int wc, int fr, int fq) const {
        const int row0 = u.pm * 256 + wr * 64 + fr, hc0 = (u.pn & 1) * 128 + 16 * wc + 4 * fq;
#pragma unroll
        for (int ai = 0; ai < 2; ++ai)
#pragma unroll
            for (int m = 0; m < 4; ++m)
#pragma unroll
                for (int bj = 0; bj < 2; ++bj) {
                    const pg8::f32x4 g = acc[ai][bj][m][0], up = acc[ai][bj][m][1];
                    u32x2 w; w.x = cvt_pk(silu_f(g[0]) * up[0], silu_f(g[1]) * up[1]); w.y = cvt_pk(silu_f(g[2]) * up[2], silu_f(g[3]) * up[3]);
                    __hip_atomic_store((unsigned long long*)(HID + (size_t)(row0 + ai * 128 + m * 16) * 256 + hc0 + bj * 64), (unsigned long long)w.x | ((unsigned long long)w.y << 32), __ATOMIC_RELAXED, __HIP_MEMORY_SCOPE_AGENT);
                }
    }
};
struct EpiDown {
    static constexpr bool PERM = true, AFTER_DRAIN = false;
    bf16_t* Y; const u32x2* LIST; LAS int* tb;
    __device__ __forceinline__ void operator()(const pg8::f32x4 (&acc)[2][2][4][2], const pg8::Unit& u, int wr, int wc, int fr, int fq) const {
        const int e = u.pn >> 2, j = u.pn & 3, ti = u.pm - tb[e], cn = tb[33 + e];
        const int col0 = 256 * j + 32 * wc + 8 * fq;
        const int idx0 = ti * 256 + wr * 64 + fr;
#pragma unroll
        for (int ai = 0; ai < 2; ++ai) {
            u32x2 ent[4];
#pragma unroll
            for (int m = 0; m < 4; ++m) { const int idx = idx0 + ai * 128 + m * 16; ent[m] = (idx < cn) ? LIST[(size_t)e * 16384 + idx] : (u32x2){0xffffffffu, 0u}; }
#pragma unroll
            for (int m = 0; m < 4; ++m) {
                const u32x2 en = ent[m];
                if (en.x != 0xffffffffu) {
                    const float w = __uint_as_float(en.y);
                    bf16_t* dst = Y + ((size_t)(en.x >> 31) * T + (en.x & 0x7fffffffu)) * 1024 + col0;
#pragma unroll
                    for (int bj = 0; bj < 2; ++bj) {
                        const pg8::f32x4 v0 = acc[ai][bj][m][0] * w, v1 = acc[ai][bj][m][1] * w;
                        u32x4 o; o.x = cvt_pk(v0[0], v0[1]); o.y = cvt_pk(v0[2], v0[3]); o.z = cvt_pk(v1[0], v1[1]); o.w = cvt_pk(v1[2], v1[3]);
                        *(u32x4*)(dst + bj * 128) = o;
                    }
                }
            }
            asm volatile("" ::: "memory");
        }
    }
};
__device__ __forceinline__ void p8_rows(const bf16_t* Y, const bf16_t* MIX, const float* x, const float* g_post_mix, const float* g_post, const float* mod, float* out, int gw, int NGW, int lane) {
    for (int m = gw; m < T; m += NGW) {
        const int b = m / S;
        float v[16], mx[16]; float s = 0.f, sm = 0.f;
#pragma unroll
        for (int j = 0; j < 4; ++j) {
            const u32x2 w0 = *(const u32x2*)(Y + (size_t)m * 1024 + 4 * lane + 256 * j), w1 = *(const u32x2*)(Y + ((size_t)T + m) * 1024 + 4 * lane + 256 * j), wm = *(const u32x2*)(MIX + (size_t)m * 1024 + 4 * lane + 256 * j);
            v[4 * j + 0] = __uint_as_float(w0.x << 16) + __uint_as_float(w1.x << 16); v[4 * j + 1] = __uint_as_float(w0.x & 0xffff0000u) + __uint_as_float(w1.x & 0xffff0000u);
            v[4 * j + 2] = __uint_as_float(w0.y << 16) + __uint_as_float(w1.y << 16); v[4 * j + 3] = __uint_as_float(w0.y & 0xffff0000u) + __uint_as_float(w1.y & 0xffff0000u);
            mx[4 * j + 0] = __uint_as_float(wm.x << 16); mx[4 * j + 1] = __uint_as_float(wm.x & 0xffff0000u); mx[4 * j + 2] = __uint_as_float(wm.y << 16); mx[4 * j + 3] = __uint_as_float(wm.y & 0xffff0000u);
#pragma unroll
            for (int k = 0; k < 4; ++k) { s += v[4 * j + k] * v[4 * j + k]; sm += mx[4 * j + k] * mx[4 * j + k]; }
        }
        const float rs = 1.0f / sqrtf(wave_sum(s) * (1.f / 1024.f) + 1e-6f), rsm = 1.0f / sqrtf(wave_sum(sm) * (1.f / 1024.f) + 1e-6f);
        const float* md = mod + b * 6144;
#pragma unroll
        for (int j = 0; j < 4; ++j) {
            const int col = 4 * lane + 256 * j;
            const f32x4 xx = *(const f32x4*)(x + (size_t)m * 1024 + col), gpm = *(const f32x4*)(g_post_mix + col), g1 = *(const f32x4*)(md + 2 * 1024 + col), gp = *(const f32x4*)(g_post + col), gg = *(const f32x4*)(md + 5 * 1024 + col);
            f32x4 o;
#pragma unroll
            for (int k = 0; k < 4; ++k) { const float hr = xx[k] + g1[k] * (mx[4 * j + k] * rsm * gpm[k]); o[k] = hr + gg[k] * (v[4 * j + k] * rs * gp[k]); }
            *(f32x4*)(out + (size_t)m * 1024 + col) = o;
        }
    }
}
constexpr size_t SC_BSTRIDE = (size_t)4096 * 64 * 65 / 2;
constexpr int SC_CHUNK = 8;
constexpr int SC_NUNITS = 4 * (1 * 8 + 2 * 8 + 3 * 8 + 4 * 8 + 5 * 8 + 6 * 8 + 7 * 8 + 8 * 8);
__device__ __forceinline__ size_t sc_off(int b, int qb) { return (size_t)b * SC_BSTRIDE + (size_t)4096 * (qb * (qb + 1) / 2); }
__device__ __forceinline__ void sc_build_units(unsigned* tab) {
    int n = 0;
    for (int pass = 0; pass < 2; ++pass)
        for (int sz = SC_CHUNK; sz >= 1; --sz)
            for (int b = 0; b < 4; ++b)
                for (int qb = 0; qb < 64; ++qb) {
                    const int nt = qb + 1, nc = (nt + SC_CHUNK - 1) / SC_CHUNK;
                    for (int c = 0; c < nc; ++c) {
                        const int t0 = c * SC_CHUNK, cnt = (nt - t0 < SC_CHUNK) ? nt - t0 : SC_CHUNK;
                        const bool full = (cnt == SC_CHUNK);
                        if ((pass == 0 && full && sz == SC_CHUNK) || (pass == 1 && !full && cnt == sz)) tab[n++] = (unsigned)b | ((unsigned)qb << 2) | ((unsigned)c << 8) | ((unsigned)cnt << 12);
                    }
                }
}
__device__ __forceinline__ unsigned key16_of(float sc) { sc += 0.0f; const unsigned u = __float_as_uint(sc); return ((u & 0x80000000u) ? ~u : (u | 0x80000000u)) >> 16; }
__device__ __forceinline__ void sc_decode(unsigned u, int& b, int& qb, int& c, int& nt) {
    b = u & 3; const int v = u >> 2;
    if (v < 232) { c = 0; int base = 0; while (v >= base + (57 - 8 * c)) { base += 57 - 8 * c; ++c; } qb = 8 * c + 7 + (v - base); nt = 8; }
    else { const int p = v - 232, size = 7 - (p >> 3); c = p & 7; qb = 8 * c + size - 1; nt = size; }
}
struct ScStage { u32x4 v[8]; };
__device__ __forceinline__ void sc_stage_load(ScStage& st, const bf16_t* KI, int b, int c, int nt, int tid) {
    const bf16_t* kbase = KI + ((size_t)b * S + (size_t)c * SC_CHUNK * 64 + (tid >> 3)) * 64 + (tid & 7) * 8;
#pragma unroll
    for (int t = 0; t < 8; ++t) if (t < nt) st.v[t] = *(const u32x4*)(kbase + (size_t)t * 64 * 64);
}
__device__ __forceinline__ void sc_stage_store(const ScStage& st, LAS unsigned char* buf, int nt, int tid) {
    const int skey = tid >> 3, sch = tid & 7;
    const unsigned st_off = (unsigned)(skey * 128 + ((sch ^ (skey & 7)) * 16));
#pragma unroll
    for (int t = 0; t < 8; ++t) if (t < nt) *(LAS u32x4*)(buf + t * 8192 + st_off) = st.v[t];
}
__device__ __forceinline__ void sc_compute(const LAS unsigned char* buf, const bf16_t* QI, const float* WI, unsigned short* SC, int b, int qb, int c, int ntile, int tid) {
    const int lane = tid & 63, w = __builtin_amdgcn_readfirstlane(tid >> 6), hh = lane >> 5, n32 = lane & 31;
    const int L = 64 * (qb + 1);
    const size_t tokq0 = (size_t)b * S + 64 * qb + 8 * w;
    bf16x8 af[2][4]; float wv[2][2][8];
    {
        const int u = 2 * ((n32 >> 2) & 1) + (n32 >> 4), h = (n32 & 3) + 4 * ((n32 >> 3) & 1);
#pragma unroll
        for (int mt = 0; mt < 2; ++mt) {
            const bf16_t* qp = QI + (tokq0 + 4 * mt + u) * 512 + h * 64 + 8 * hh;
#pragma unroll
            for (int ks = 0; ks < 4; ++ks) af[mt][ks] = *(const bf16x8*)(qp + 16 * ks);
#pragma unroll
            for (int j = 0; j < 2; ++j) {
                const float* wp = WI + (tokq0 + 4 * mt + 2 * hh + j) * 8;
                const f32x4 w0 = *(const f32x4*)wp, w1 = *(const f32x4*)(wp + 4);
                wv[mt][j][0] = w0[0]; wv[mt][j][1] = w0[1]; wv[mt][j][2] = w0[2]; wv[mt][j][3] = w0[3]; wv[mt][j][4] = w1[0]; wv[mt][j][5] = w1[1]; wv[mt][j][6] = w1[2]; wv[mt][j][7] = w1[3];
            }
        }
    }
    unsigned short* srow = SC + sc_off(b, qb) + (size_t)(8 * w) * L;
#pragma unroll 1
    for (int t = 0; t < ntile; ++t) {
        const LAS unsigned char* tb_ = buf + t * 8192;
        const int s0 = (c * SC_CHUNK + t) * 64;
#pragma unroll
        for (int nt = 0; nt < 2; ++nt) {
            bf16x8 bfr[4];
            const int key = 32 * nt + n32;
#pragma unroll
            for (int ks = 0; ks < 4; ++ks) bfr[ks] = *(const LAS bf16x8*)(tb_ + key * 128 + (((2 * ks + hh) ^ (key & 7)) * 16));
#pragma unroll
            for (int mt = 0; mt < 2; ++mt) {
                f32x16 acc = (f32x16){};
#pragma unroll
                for (int ks = 0; ks < 4; ++ks) acc = __builtin_amdgcn_mfma_f32_32x32x16_bf16(af[mt][ks], bfr[ks], acc, 0, 0, 0);
#pragma unroll
                for (int j = 0; j < 2; ++j) {
                    float sc = 0.f;
#pragma unroll
                    for (int h = 0; h < 8; ++h) { const int xi = (int)__float_as_uint(acc[8 * j + h]); sc = __builtin_fmaf(wv[mt][j][h], __uint_as_float((unsigned)(xi > 0 ? xi : 0)), sc); }
                    asm volatile("" : "+v"(sc));
                    srow[(size_t)(4 * mt + 2 * hh + j) * L + s0 + key] = (unsigned short)key16_of(sc);
                }
            }
        }
    }
}
__device__ __forceinline__ void sc_phase(LAS unsigned char* lds, volatile LAS unsigned* qslot, unsigned* qhead, const bf16_t* QI, const bf16_t* KI, const float* WI, unsigned short* SC, int tid) {
    __syncthreads();
    if (tid == 0) qslot[0] = atomicAdd(qhead, 1u);
    __syncthreads();
    unsigned ucur = qslot[0];
    if (ucur >= (unsigned)SC_NUNITS) return;
    int b, qb, c, nt; sc_decode(ucur, b, qb, c, nt);
    ScStage st;
    sc_stage_load(st, KI, b, c, nt, tid);
    sc_stage_store(st, lds, nt, tid);
    int p = 0;
    for (;;) {
        __syncthreads();
        if (tid == 0) qslot[0] = atomicAdd(qhead, 1u);
        __syncthreads();
        const unsigned unext = qslot[0];
        const bool has = unext < (unsigned)SC_NUNITS;
        int b2 = 0, qb2 = 0, c2 = 0, nt2 = 0;
        if (has) { sc_decode(unext, b2, qb2, c2, nt2); sc_stage_load(st, KI, b2, c2, nt2, tid); }
        sc_compute(lds + p * 65536, QI, WI, SC, b, qb, c, nt, tid);
        if (!has) break;
        sc_stage_store(st, lds + (p ^ 1) * 65536, nt2, tid);
        b = b2; qb = qb2; c = c2; nt = nt2; p ^= 1;
    }
}
__device__ __forceinline__ unsigned wave_sum_u32(unsigned x) {
    x += (unsigned)__builtin_amdgcn_update_dpp(0, (int)x, 0xB1, 0xf, 0xf, false);
    x += (unsigned)__builtin_amdgcn_update_dpp(0, (int)x, 0x4E, 0xf, 0xf, false);
    x += (unsigned)__builtin_amdgcn_update_dpp(0, (int)x, 0x141, 0xf, 0xf, false);
    x += (unsigned)__builtin_amdgcn_update_dpp(0, (int)x, 0x140, 0xf, 0xf, false);
    return (unsigned)__builtin_amdgcn_readlane((int)x, 0) + (unsigned)__builtin_amdgcn_readlane((int)x, 16) + (unsigned)__builtin_amdgcn_readlane((int)x, 32) + (unsigned)__builtin_amdgcn_readlane((int)x, 48);
}
__device__ __forceinline__ unsigned pk_subsat(unsigned w, unsigned c) { unsigned d; asm("v_pk_sub_u16 %0, %1, %2 clamp" : "=v"(d) : "v"(w), "v"(c)); return d; }
__device__ __forceinline__ unsigned pk_min(unsigned a, unsigned b) { unsigned d; asm("v_pk_min_u16 %0, %1, %2" : "=v"(d) : "v"(a), "v"(b)); return d; }
__device__ __forceinline__ unsigned pk_add(unsigned a, unsigned b) { unsigned d; asm("v_pk_add_u16 %0, %1, %2" : "=v"(d) : "v"(a), "v"(b)); return d; }
template <int NW> __device__ __forceinline__ unsigned cnt_ge(const unsigned (&kw)[32], unsigned cm1) {
    const unsigned one = 0x00010001u;
    unsigned a0 = 0u, a1 = 0u, a2 = 0u, a3 = 0u;
#pragma unroll
    for (int j = 0; j < NW; j += 4) {
        a0 = pk_add(a0, pk_min(pk_subsat(kw[j], cm1), one)); a1 = pk_add(a1, pk_min(pk_subsat(kw[j + 1], cm1), one));
        a2 = pk_add(a2, pk_min(pk_subsat(kw[j + 2], cm1), one)); a3 = pk_add(a3, pk_min(pk_subsat(kw[j + 3], cm1), one));
    }
    const unsigned a = pk_add(pk_add(a0, a1), pk_add(a2, a3));
    return wave_sum_u32((a & 0xffffu) + (a >> 16));
}
__device__ __forceinline__ unsigned pk_max(unsigned a, unsigned b) { unsigned d; asm("v_pk_max_u16 %0, %1, %2" : "=v"(d) : "v"(a), "v"(b)); return d; }
__device__ __forceinline__ unsigned wave_max_u32(unsigned x) {
    x = max(x, (unsigned)__builtin_amdgcn_update_dpp(0, (int)x, 0xB1, 0xf, 0xf, false));
    x = max(x, (unsigned)__builtin_amdgcn_update_dpp(0, (int)x, 0x4E, 0xf, 0xf, false));
    x = max(x, (unsigned)__builtin_amdgcn_update_dpp(0, (int)x, 0x141, 0xf, 0xf, false));
    x = max(x, (unsigned)__builtin_amdgcn_update_dpp(0, (int)x, 0x140, 0xf, 0xf, false));
    return max(max((unsigned)__builtin_amdgcn_readlane((int)x, 0), (unsigned)__builtin_amdgcn_readlane((int)x, 16)), max((unsigned)__builtin_amdgcn_readlane((int)x, 32), (unsigned)__builtin_amdgcn_readlane((int)x, 48)));
}
template <int NW> __device__ __forceinline__ unsigned sel_query(const unsigned (&kw)[32], int lane) {
    unsigned mx = 0u;
#pragma unroll
    for (int j = 0; j < NW; ++j) mx = pk_max(mx, kw[j]);
    unsigned hi = wave_max_u32(max(mx & 0xffffu, mx >> 16)) + 1u;
    unsigned width = 384u, lo = (hi > width) ? hi - width : 1u;
#pragma unroll 1
    while (cnt_ge<NW>(kw, (lo - 1u) * 0x00010001u) < 256u) { hi = lo; width *= 8u; lo = (hi > width) ? hi - width : 1u; }
#pragma unroll 1
    while (hi - lo > 1u) {
        const unsigned mid = (lo + hi) >> 1;
        if (cnt_ge<NW>(kw, (mid - 1u) * 0x00010001u) >= 256u) lo = mid; else hi = mid;
    }
    const unsigned T = lo;
    const unsigned need = 256u - cnt_ge<NW>(kw, T * 0x00010001u);
    unsigned run = 0u, cidx = 0xffffu; bool found = false;
#pragma unroll
    for (int j = 0; j < NW; ++j) {
        if (!found) {
            const bool e0 = (kw[j] & 0xffffu) == T, e1 = (kw[j] >> 16) == T;
            const unsigned long long m0 = __ballot(e0), m1 = __ballot(e1);
            const unsigned cm = (unsigned)__builtin_popcountll(m0) + (unsigned)__builtin_popcountll(m1);
            if (run + cm >= need) {
                const unsigned rank = __builtin_amdgcn_mbcnt_hi((unsigned)(m0 >> 32), __builtin_amdgcn_mbcnt_lo((unsigned)m0, 0u)) + __builtin_amdgcn_mbcnt_hi((unsigned)(m1 >> 32), __builtin_amdgcn_mbcnt_lo((unsigned)m1, 0u));
                const unsigned tg = need - run - 1u;
                const unsigned long long h0 = __ballot(e0 && rank == tg), h1 = __ballot(e1 && rank + (e0 ? 1u : 0u) == tg);
                cidx = (unsigned)(128 * j) + (h0 ? 2u * (unsigned)__builtin_ctzll(h0) : 2u * (unsigned)__builtin_ctzll(h1) + 1u);
                found = true;
            }
            run += cm;
        }
    }
    return T | (cidx << 16);
}
template <int NW> __device__ __forceinline__ unsigned sel_row(const unsigned* row32, int n, int lane) {
    unsigned kw[32];
#pragma unroll
    for (int j = 0; j < 32; ++j) {
        unsigned v = 0u;
        if (j < NW) { const int s = 128 * j + 2 * lane; v = (s < n) ? row32[64 * j + lane] : 0u; if (s + 1 >= n) v &= 0xffffu; }
        kw[j] = v;
    }
    return sel_query<NW>(kw, lane);
}
__device__ __forceinline__ void sel_block(LAS unsigned char* lds, const unsigned short* SC, unsigned* THR, unsigned* MASKT, int blk, int tid, int mode = 3) {
    const int b = blk >> 6, qb = blk & 63, lane = tid & 63, w = __builtin_amdgcn_readfirstlane(tid >> 6);
    const int L = 64 * (qb + 1);
    const unsigned short* slab = SC + sc_off(b, qb);
    LAS unsigned* thr_l = (LAS unsigned*)lds;
    __syncthreads();
    if (mode & 1)
#pragma unroll 1
    for (int qi = 0; qi < 8; ++qi) {
        const int ql = 8 * w + qi, tq = 64 * qb + ql, n = tq + 1;
        const unsigned short* row = slab + (size_t)ql * L;
        const int nw = (n + 127) >> 7;
        const unsigned* row32 = (const unsigned*)row;
        unsigned th = 0u;
        if (n > 256) { if (nw <= 8) th = sel_row<8>(row32, n, lane); else if (nw <= 16) th = sel_row<16>(row32, n, lane); else if (nw <= 24) th = sel_row<24>(row32, n, lane); else th = sel_row<32>(row32, n, lane); }
        if (lane == 0) { thr_l[ql] = th; THR[(size_t)b * S + tq] = th; }
    }
    __syncthreads();
    const int ntl = 4 * ((2 * qb) >> 3) + 4;
    if (mode & 2)
    for (int it = w; it < 2 * ntl; it += NWAVES) {
        const int g = it / ntl, t = it - g * ntl, qg = 2 * qb + g;
        unsigned W = 0u;
        if (t <= qb) {
            const int ii = lane & 15, cc = (lane >> 4) & 1, hh = lane >> 5;
            const int s = 64 * t + 32 * cc + (ii & 3) + 8 * (ii >> 2) + 4 * hh;
            unsigned kk[32];
#pragma unroll
            for (int q = 0; q < 32; ++q) kk[q] = (unsigned)slab[(size_t)(32 * g + q) * L + s];
#pragma unroll
            for (int q = 0; q < 32; ++q) {
                const int ql = 32 * g + q, tq = 64 * qb + ql;
                const unsigned th = thr_l[ql], T = th & 0xffffu, cidx = th >> 16;
                const unsigned k = kk[q];
                const bool p = (s <= tq) && (k > T || (k == T && (unsigned)s <= cidx));
                const unsigned long long m = __ballot(p);
                W = (lane == q) ? (unsigned)m : ((lane == 32 + q) ? (unsigned)(m >> 32) : W);
            }
        }
        MASKT[(((size_t)b * 128 + qg) * 64 + t) * 64 + lane] = W;
    }
}

__device__ __forceinline__ void sel_queries_balanced(const unsigned short* SC, unsigned* THR, int gw, int lane) {
#pragma unroll 1
    for (int k = 0; k < 8; ++k) {
        const int b = k >> 1, tq = (k & 1) ? (S - 1 - gw) : gw, n = tq + 1, qb = tq >> 6, L = 64 * (qb + 1);
        const unsigned* row32 = (const unsigned*)(SC + sc_off(b, qb) + (size_t)(tq & 63) * L);
        const int nw = (n + 127) >> 7;
        unsigned th = 0u;
        if (n > 256) { if (nw <= 8) th = sel_row<8>(row32, n, lane); else if (nw <= 16) th = sel_row<16>(row32, n, lane); else if (nw <= 24) th = sel_row<24>(row32, n, lane); else th = sel_row<32>(row32, n, lane); }
        if (lane == 0) THR[(size_t)b * S + tq] = th;
    }
}
constexpr int MSK_PER_B = 4352, MSK_UNITS = 4 * MSK_PER_B;
struct MskUnit { int b, qg, t; unsigned thv; unsigned kk[32]; };
__device__ __forceinline__ void mask_unit_load(MskUnit& m, const unsigned short* SC, const unsigned* THR, int u, int lane) {
    m.b = u / MSK_PER_B; const int v = u - m.b * MSK_PER_B;
    int g8 = 0;
#pragma unroll 1
    for (int j = 1; j < 16; ++j) g8 += (16 * j * (j + 1) <= v) ? 1 : 0;
    const int rem = v - 16 * g8 * (g8 + 1), per = 4 * g8 + 4, q7 = rem / per;
    m.t = rem - q7 * per; m.qg = 8 * g8 + q7;
    const int qb = m.qg >> 1, g = m.qg & 1;
    if (m.t <= qb) {
        const int L = 64 * (qb + 1);
        const unsigned short* slab = SC + sc_off(m.b, qb);
        const int ii = lane & 15, cc = (lane >> 4) & 1, hh = lane >> 5;
        const int s = 64 * m.t + 32 * cc + (ii & 3) + 8 * (ii >> 2) + 4 * hh;
        m.thv = THR[(size_t)m.b * S + 32 * m.qg + (lane & 31)];
#pragma unroll
        for (int q = 0; q < 32; ++q) m.kk[q] = (unsigned)slab[(size_t)(32 * g + q) * L + s];
    }
}
__device__ __forceinline__ void mask_unit_emit(const MskUnit& m, unsigned* MASKT, int lane) {
    const int qb = m.qg >> 1;
    unsigned W = 0u;
    if (m.t <= qb) {
        const int ii = lane & 15, cc = (lane >> 4) & 1, hh = lane >> 5;
        const int s = 64 * m.t + 32 * cc + (ii & 3) + 8 * (ii >> 2) + 4 * hh;
#pragma unroll
        for (int q = 0; q < 32; ++q) {
            const int tq = 32 * m.qg + q;
            const unsigned th = (unsigned)__builtin_amdgcn_readlane((int)m.thv, q), T = th & 0xffffu, cidx = th >> 16;
            const unsigned k = m.kk[q];
            const bool p = (s <= tq) && (k > T || (k == T && (unsigned)s <= cidx));
            const unsigned long long mm = __ballot(p);
            W = (lane == q) ? (unsigned)mm : ((lane == 32 + q) ? (unsigned)(mm >> 32) : W);
        }
    }
    MASKT[(((size_t)m.b * 128 + m.qg) * 64 + m.t) * 64 + lane] = W;
}
__device__ __forceinline__ void mask_units(const unsigned short* SC, const unsigned* THR, unsigned* MASKT, int u0, int stride, int lane) {
    if (u0 >= MSK_UNITS) return;
    MskUnit a, bnext;
    mask_unit_load(a, SC, THR, u0, lane);
#pragma unroll 1
    for (int u = u0; u < MSK_UNITS; u += stride) {
        const bool has = u + stride < MSK_UNITS;
        if (has) mask_unit_load(bnext, SC, THR, u + stride, lane);
        mask_unit_emit(a, MASKT, lane);
        if (has) a = bnext;
    }
}
struct Args { const void* in[18]; float* out; unsigned char* ws; int ph_lo, ph_hi, li, pad; };
constexpr int N_PHASES = 12;
__global__ void __launch_bounds__(NTHR, 2) mega(Args args) {
    extern __shared__ __attribute__((aligned(16))) unsigned char lds_raw[];
    LAS unsigned char* lds = (LAS unsigned char*)lds_raw;
    const int G = gridDim.x, bid = blockIdx.x;
#define MK_IDS() const int wave = mk_wave(), lane = mk_lane(), tid = wave * 64 + lane; (void)lane; (void)tid; (void)wave
    unsigned char* ws = args.ws;
    unsigned* ctl = (unsigned*)(ws + WS_CTL);
    volatile LAS unsigned* MISC = (volatile LAS unsigned*)(lds + MISC_OFF);
    { const int t0 = (int)threadIdx.x;
      for (int u = t0; u < (LDS_BYTES - RING_BYTES) / 4; u += NTHR) ((LAS unsigned*)(lds + RING_BYTES))[u] = 0u;
      __syncthreads();
      if ((t0 & 63) == 0) ((LAS unsigned char*)(lds + MK_SLOTMAP_OFF))[mk_hwslot()] = (unsigned char)(t0 >> 6); }
    __syncthreads();
    XcdBarrier bar = xcd_barrier_post(ctl + CW_BAR + args.li * XCD_BAR_WORDS, MISC + 8);
    const int lo = args.ph_lo, hi = args.ph_hi;
#ifndef DUP_MASK
#define DUP_MASK 0
#endif
#define REP(k) for (int rep_ = 0; rep_ < (((DUP_MASK) >> (k)) & 1) + 1; ++rep_)
#define IN(k) (lo <= (k) && (k) < hi)
#define BOTH(k) (IN(k) && IN((k) + 1))
    const float* x = (const float*)args.in[0];
    float* mod = (float*)(ws + WS_MOD);
    bf16_t* Hb = (bf16_t*)(ws + WS_H);
    bf16_t* WIN = (bf16_t*)(ws + WS_WIN);
    bf16_t* WOUT = (bf16_t*)(ws + WS_WOUT);
    float* R128 = (float*)(ws + WS_R128);
    float* R64 = (float*)(ws + WS_R64);
    bf16_t* WGU = (bf16_t*)args.out; bf16_t* WD = WGU + (size_t)32 * 512 * 1024;

    const P0Args p0a{(const float*)args.in[1], (const float*)args.in[4], (const float*)args.in[5], (const float*)args.in[6], (const float*)args.in[7], (const float*)args.in[14], (const float*)args.in[15], (const float*)args.in[16],
                 (const int*)args.in[2], mod, R128, R64, WIN, WOUT, WGU, WD};
    if (IN(0)) {
        MK_IDS();
        REP(0) p0_prologue(lds, p0a, bid, G, tid);
        if (BOTH(0)) xcd_barrier(bar);
    }
    if (IN(1)) {
        MK_IDS();
        REP(1) p1_rows(x, (const float*)args.in[3], mod, Hb, bid * NWAVES + wave, G * NWAVES, lane);
        if ((DUP_MASK >> 15) & 1) { for (int k = 0; k < 10; ++k) xcd_barrier(bar); }
        if (BOTH(1)) xcd_barrier(bar);
    }
    if (IN(2)) {
        MK_IDS();
#ifdef PROBE_SKIP_TILE8
        struct Skip8 : pg8::StaticOrder { __device__ bool next(int i, pg8::Unit& u) const { if (!pg8::StaticOrder::next(i, u)) return false; if (u.pn >= 8) ++u.pn; return true; } };
        pg8::Gemm g{Hb, WIN, T, NPHYS, 1024}; Skip8 So; So.init(T, NPHYS - 256, G, bid);
#define PG8_P2_SCHED Skip8
#else
        pg8::Gemm g{Hb, WIN, T, NPHYS, 1024}; pg8::StaticOrder So; So.init(T, NPHYS, G, bid);
#define PG8_P2_SCHED pg8::StaticOrder
#endif
        EpiInProj E{(bf16_t*)(ws + WS_QA), (bf16_t*)(ws + WS_KA), (bf16_t*)(ws + WS_VA), (bf16_t*)(ws + WS_QI), (bf16_t*)(ws + WS_KI), (bf16_t*)(ws + WS_QR), (bf16_t*)(ws + WS_KR),
                    (bf16_t*)(ws + WS_VR), (bf16_t*)(ws + WS_GR), (float*)(ws + WS_WI), R64, R128};
        pg8::gemm_phase<EpiInProj, PG8_P2_SCHED, true, true>(lds, g, So, E);
        if ((DUP_MASK >> 2) & 1) { __syncthreads(); pg8::gemm_phase<EpiInProj, PG8_P2_SCHED, true, true>(lds, g, So, E); }
        if (args.li != 0) {   }
        else if (G == 256) { if (bid >= 64) { __syncthreads(); p0_expert_items(lds, p0a, (bid - 64) * NWAVES + wave, 192 * NWAVES, tid); } }
        else { __syncthreads(); p0_expert_items(lds, p0a, bid * NWAVES + wave, G * NWAVES, tid); }
        if (BOTH(2)) xcd_barrier(bar);
    }
    bf16_t* QR = (bf16_t*)(ws + WS_QR); bf16_t* KR = (bf16_t*)(ws + WS_KR); bf16_t* VR = (bf16_t*)(ws + WS_VR); bf16_t* GR = (bf16_t*)(ws + WS_GR);
    const bf16_t* QI = (const bf16_t*)(ws + WS_QI); const bf16_t* KI = (const bf16_t*)(ws + WS_KI); const float* WI = (const float*)(ws + WS_WI);
    unsigned short* SCORES = (unsigned short*)(ws + WS_SCORES); unsigned* THR = (unsigned*)(ws + WS_THR); unsigned* MASKT = (unsigned*)(ws + WS_MASKT);
    float* KVS = (float*)(ws + WS_KVS); bf16_t* RT = WD + (size_t)32 * 1024 * 256;
    bf16_t* MIXED = (bf16_t*)(ws + WS_MIXED);
    if (IN(3)) {
        MK_IDS();
        REP(3) {
        for (int p = bid; p < 256; p += G) ret_kv_pair(lds, KR, VR, KVS, p, tid);
        sc_phase(lds, MISC + 16, ctl + CW_Q + 64 * rep_, QI, KI, WI, SCORES, tid);
        }
        if (BOTH(3)) xcd_barrier(bar);
    }
    if (IN(4)) {
        MK_IDS();
        ret_scan(KVS, RT, bid * NTHR + tid, G * NTHR);
        for (int gw = bid * NWAVES + wave; gw < 2048; gw += G * NWAVES) sel_queries_balanced(SCORES, THR, gw, lane);
        if ((DUP_MASK >> 12) & 1) for (int gw = bid * NWAVES + wave; gw < 2048; gw += G * NWAVES) sel_queries_balanced(SCORES, THR, gw, lane);
        if (BOTH(4)) xcd_barrier(bar);
    }
    if (IN(5)) {
        MK_IDS();
        mask_units(SCORES, THR, MASKT, bid * NWAVES + wave, G * NWAVES, lane);
        if ((DUP_MASK >> 13) & 1) mask_units(SCORES, THR, MASKT, bid * NWAVES + wave, G * NWAVES, lane);
        if (BOTH(5)) xcd_barrier(bar);
    }
    if (IN(6)) {
        MK_IDS();
        {
        for (int p = bid; p < 256; p += G) ret_out_pair(lds, QR, KR, VR, GR, RT, MIXED, p, tid);
        if ((DUP_MASK >> 14) & 1) for (int p = bid; p < 256; p += G) ret_out_pair(lds, QR, KR, VR, GR, RT, MIXED, p, tid);
        asm volatile("s_waitcnt vmcnt(0) lgkmcnt(0)" ::: "memory");
        __syncthreads();
        {
            const attn_body::AttnTensors AT{(const attn_body::bf16*)(ws + WS_QA), (const attn_body::bf16*)(ws + WS_KA), (const attn_body::bf16*)(ws + WS_VA), (attn_body::bf16*)MIXED, (const unsigned*)MASKT};
            const attn_body::StaticOrder So((int)G, (int)bid);
            attn_body::attn_phase<attn_body::StaticOrder>((char*)lds_raw, AT, So);
        }
        __syncthreads();
        }
        if ((DUP_MASK >> 5) & 1) {
        for (int p = bid; p < 256; p += G) ret_out_pair(lds, QR, KR, VR, GR, RT, MIXED, p, tid);
        asm volatile("s_waitcnt vmcnt(0) lgkmcnt(0)" ::: "memory");
        __syncthreads();
        {
            const attn_body::AttnTensors AT{(const attn_body::bf16*)(ws + WS_QA), (const attn_body::bf16*)(ws + WS_KA), (const attn_body::bf16*)(ws + WS_VA), (attn_body::bf16*)MIXED, (const unsigned*)MASKT};
            const attn_body::StaticOrder So((int)G, (int)bid);
            attn_body::attn_phase<attn_body::StaticOrder>((char*)lds_raw, AT, So);
        }
        __syncthreads();
        }
        if (BOTH(6)) xcd_barrier(bar);
    }
    bf16_t* MIX = (bf16_t*)(ws + WS_MIX); bf16_t* H2 = (bf16_t*)(ws + WS_H2); u32x2* LIST = (u32x2*)(ws + WS_LIST); bf16_t* HID = (bf16_t*)(ws + WS_HID);
    bf16_t* Y = (bf16_t*)(ws + WS_Y); float* HRES = (float*)(ws + WS_HRES);
    LAS int* tb = (LAS int*)(lds + TB_OFF);
    if (IN(7)) {
        MK_IDS();
        pg8::Gemm g{MIXED, WOUT, T, 1024, 1024}; pg8::StaticOrder So; So.init(T, 1024, G, bid);
        EpiStore E{MIX, 1024};
        pg8::gemm_phase<EpiStore, pg8::StaticOrder, true, true>(lds, g, So, E);
        if ((DUP_MASK >> 6) & 1) { __syncthreads(); pg8::gemm_phase<EpiStore, pg8::StaticOrder, true, true>(lds, g, So, E); }
        if (BOTH(7)) xcd_barrier(bar);
    }
    if (IN(8)) {
        MK_IDS();
        P6bArgs a{MIX, x, (const float*)args.in[8], (const float*)args.in[9], mod, (const float*)args.in[10], (const float*)args.in[11], (const float*)args.in[12], (const float*)args.in[13], HRES, H2, ctl + CW_CNT, LIST};
        p6b_load_weights(lds, a.w_group, a.w_expert, tid);
        REP(8) for (int gw = bid * NWAVES + wave; gw < T / P6B_NR; gw += G * NWAVES) p6b_rows8(a, lds, (LAS float*)(lds + RT_WL_OFF + wave * 576), gw, lane, rep_ != 0);
        if (BOTH(8)) xcd_barrier(bar);
    }
    if (IN(9)) {
        MK_IDS();
        moe_table(tb, ctl + CW_CNT, tid);
        pg8::Gemm g{H2, WGU, T, 32 * 512, 1024}; MoeSched<1> So{LIST, tb, G, bid, 2, ctl + CW_TILE, ctl + CW_TMO, 0, 1 << 20};
        EpiGU E{HID};
        pg8::gemm_phase_ga<EpiGU, MoeSched<1>>(lds, g, So, E);
        if ((DUP_MASK >> 8) & 1) { __syncthreads(); pg8::gemm_phase_ga<EpiGU, MoeSched<1>>(lds, g, So, E); }
        __syncthreads();
    }
    if (IN(10)) {
        MK_IDS();
        moe_table(tb, ctl + CW_CNT, tid);
        const int n2 = (tb[32] * 2 > G && tb[32] * 2 < 2 * G) ? tb[32] * 2 - G : 0;
        const int t1 = G / 2;
        pg8::Gemm g{HID, WD, T, 32 * 1024, 256};
        EpiDown E{Y, LIST, tb};
        { MoeSched<2> So{LIST, tb, G - n2, bid - n2, 4, ctl + CW_TILE, ctl + CW_TMO, 0, t1}; moe_wait(So); pg8::gemm_phase<EpiDown, MoeSched<2>, true, true>(lds, g, So, E); }
        { MoeSched<2> So{LIST, tb, G - n2, bid - n2, 4, ctl + CW_TILE, ctl + CW_TMO, t1, 1 << 20}; moe_wait(So); pg8::gemm_phase<EpiDown, MoeSched<2>, true, true>(lds, g, So, E); }
        if (BOTH(10)) xcd_barrier(bar);
    }
    if (IN(11)) {
        MK_IDS();
        REP(11) p8_rows(Y, MIX, x, (const float*)args.in[8], (const float*)args.in[17], mod, args.out, bid * NWAVES + wave, G * NWAVES, lane);
    }
#undef IN
#undef BOTH
}
}
extern "C" void kernel_launch(void* const* d_in, const int* in_sizes, int n_in, void* d_out, int out_size, void* d_ws, size_t ws_size, hipStream_t stream) {
    using namespace mk;
    static int grid = 0;
    if (grid == 0) {
        int dev = 0, cus = 0, per_cu = 0;
        if (n_in != 18 || out_size != T * D || ws_size < (size_t)256 * MiB) { fprintf(stderr, "kernel_launch: unexpected problem shape (n_in %d, out %d, ws %zu)\n", n_in, out_size, ws_size); grid = -1; return; }
        if (hipGetDevice(&dev) != hipSuccess || hipDeviceGetAttribute(&cus, hipDeviceAttributeMultiprocessorCount, dev) != hipSuccess) { fprintf(stderr, "kernel_launch: device query failed\n"); grid = -1; return; }
        if (hipFuncSetAttribute((const void*)mega, hipFuncAttributeMaxDynamicSharedMemorySize, LDS_BYTES) != hipSuccess) { fprintf(stderr, "kernel_launch: hipFuncSetAttribute failed\n"); grid = -1; return; }
        if (hipOccupancyMaxActiveBlocksPerMultiprocessor(&per_cu, (const void*)mega, NTHR, LDS_BYTES) != hipSuccess || per_cu < 1) fprintf(stderr, "kernel_launch: occupancy query reports %d\n", per_cu);
        (void)hipGetLastError();
        grid = cus;
    }
    if (grid < 0) return;
    unsigned char* ws = (unsigned char*)d_ws;
    (void)hipMemsetAsync(ws + WS_CTL, 0, CTL_BYTES, stream);
    Args a{};
    for (int i = 0; i < 18; ++i) a.in[i] = d_in[i];
    a.out = (float*)d_out; a.ws = ws; a.ph_lo = 0; a.ph_hi = N_PHASES; a.li = 0; a.pad = 0;
    hipLaunchKernelGGL(mega, dim3(grid), dim3(NTHR), LDS_BYTES, stream, a);
#ifdef EXTRA_PHASE
#ifndef EXTRA_HI
#define EXTRA_HI (EXTRA_PHASE + 1)
#endif
    a.ph_lo = EXTRA_PHASE; a.ph_hi = EXTRA_HI; a.li = 1;
    hipLaunchKernelGGL(mega, dim3(grid), dim3(NTHR), LDS_BYTES, stream, a);
#endif
}
```

```cpp
#include <hip/hip_runtime.h>
#include <cstdio>
#include <cstdint>
#define DUP_MASK 0
#define MK_SLOTMAP_OFF (163840 - 256)
__device__ __forceinline__ unsigned mk_hwslot() { return (unsigned)__builtin_amdgcn_s_getreg((5 << 11) | 4) & 63u; }
__device__ __forceinline__ int mk_wave() { return __builtin_amdgcn_readfirstlane((int)((const __attribute__((address_space(3))) unsigned char*)(unsigned)MK_SLOTMAP_OFF)[mk_hwslot()]); }
__device__ __forceinline__ int mk_lane() { return (int)__builtin_amdgcn_mbcnt_hi(~0u, __builtin_amdgcn_mbcnt_lo(~0u, 0u)); }
__device__ __forceinline__ int mk_tidx() { return mk_wave() * 64 + mk_lane(); }
namespace pg8 {
#define PG8_LAS __attribute__((address_space(3)))
typedef unsigned short bf16_t;
typedef short bf16x8 __attribute__((ext_vector_type(8)));
typedef float f32x4 __attribute__((ext_vector_type(4)));
typedef unsigned u32x4 __attribute__((ext_vector_type(4)));
constexpr int BM = 256, BK = 64, HALF = 128, HTB = HALF * BK * 2  , STAGE_BYTES = 8 * HTB, NXCD = 8, WGM = 8;

__host__ __device__ __forceinline__ int lds_byte(int r, int c) { const int st = (r >> 4) * 2 + (c >> 5), rr = r & 15, cc = c & 31, ob = rr * 64 + cc * 2; return st * 1024 + (ob ^ (((ob >> 9) & 1) << 5)); }
__host__ __device__ __forceinline__ void stage_rc(int b, int& R, int& C) { const int st = b / 1024, sb = b % 1024, swz = sb ^ (((sb >> 9) & 1) << 5); R = (st >> 1) * 16 + swz / 64; C = (st & 1) * 32 + (swz % 64) / 2; }
__host__ __device__ __forceinline__ int perm32(int rho) { const int n = rho >> 4, i = rho & 15; return 8 * (i >> 2) + 4 * n + (i & 3); }

struct Unit { int pm, pn; };
struct Gemm { const bf16_t* A; const bf16_t* Bt; int M, N, K; };

struct StaticOrder {
    int nM, nN, nwg, G, c;
    __host__ __device__ void init(int M, int N, int G_, int c_) { nM = M / BM; nN = N / BM; nwg = nM * nN; G = G_; c = c_; }
    __host__ __device__ bool next(int i, Unit& u) const {
        const long L = (long)i * G + c; if (L >= nwg) return false;
        int wgid = (int)L; { const int q = nwg / NXCD, r = nwg % NXCD, xcd = wgid % NXCD, off = wgid / NXCD; wgid = (xcd < r ? xcd * (q + 1) : r * (q + 1) + (xcd - r) * q) + off; }
        const int nig = WGM * nN, gid = wgid / nig, fm = gid * WGM, gsz = (nM - fm) < WGM ? (nM - fm) : WGM;
        u.pm = fm + ((wgid % nig) % gsz); u.pn = (wgid % nig) / gsz; return true;
    }
    __device__ __forceinline__ void a_ready(const Unit&) const {}
    __device__ __forceinline__ void done(const Unit&) const {}
};
template <class Epi, class Sched, bool ALIGN_EPI = false, bool SP2 = false>
__device__ __forceinline__ void gemm_phase(PG8_LAS unsigned char* lds, const Gemm g, const Sched& S, const Epi& E) {
    const int tid = mk_tidx(), wid = __builtin_amdgcn_readfirstlane(tid >> 6), lane = tid & 63, wr = wid >> 2, wc = wid & 3, fr = lane & 15, fq = lane >> 4;
    const int K = g.K, nt = K / BK;
    unsigned voffA[2], voffB[2];
#pragma unroll
    for (int i = 0; i < 2; ++i) { int R, C; stage_rc(tid * 16 + i * 8192, R, C); const int Rb = Epi::PERM ? ((R & ~31) + perm32(R & 31)) : R;
        voffA[i] = (unsigned)(R * K + C) * 2u; voffB[i] = (unsigned)(Rb * K + C) * 2u; }
    const size_t kstep = (size_t)(BK * 2);
    const size_t hstep = (size_t)HALF * K * 2;
    const size_t tstep = 2 * hstep;
    const unsigned ldsw = (unsigned)wid * 1024u;
    const int aoff = lds_byte(wr * 64 + fr, fq * 8), boff = lds_byte(wc * 32 + fr, fq * 8);
#define PG8_SA(b, h) (((b) * 2 + (h)) * HTB)
#define PG8_SB(b, h) ((4 + (b) * 2 + (h)) * HTB)
#define PG8_STAGE(bufoff, gbase, voff) do { _Pragma("unroll") for (int _i = 0; _i < 2; ++_i) \
        __builtin_amdgcn_global_load_lds((const unsigned*)((const char*)(gbase) + (voff)[_i]), (PG8_LAS unsigned*)(lds + (bufoff) + ldsw + _i * 8192), 16, 0, 0); } while (0)
#define PG8_LDA(dst, b, h) do { _Pragma("unroll") for (int m = 0; m < 4; ++m) _Pragma("unroll") for (int k = 0; k < 2; ++k) dst[m][k] = *(const PG8_LAS bf16x8*)(lds + PG8_SA(b, h) + aoff + m * 2048 + k * 1024); } while (0)
#define PG8_LDB(dst, b, h) do { _Pragma("unroll") for (int n = 0; n < 2; ++n) _Pragma("unroll") for (int k = 0; k < 2; ++k) dst[n][k] = *(const PG8_LAS bf16x8*)(lds + PG8_SB(b, h) + boff + n * 2048 + k * 1024); } while (0)
#define PG8_MMA(ai, bj, At, Bt) do { __builtin_amdgcn_s_setprio(1); _Pragma("unroll") for (int m = 0; m < 4; ++m) _Pragma("unroll") for (int n = 0; n < 2; ++n) _Pragma("unroll") for (int k = 0; k < 2; ++k) \
        acc[ai][bj][m][n] = __builtin_amdgcn_mfma_f32_16x16x32_bf16(Bt[n][k], At[m][k], acc[ai][bj][m][n], 0, 0, 0); __builtin_amdgcn_s_setprio(0); } while (0)
#define PG8_WAIT_V(n) asm volatile("s_waitcnt vmcnt(" #n ")" ::: "memory")
#define PG8_WAIT_L(n) asm volatile("s_waitcnt lgkmcnt(" #n ")" ::: "memory")
#define PG8_BAR __builtin_amdgcn_s_barrier()
#define PG8_SCHED __builtin_amdgcn_sched_barrier(0)
    Unit cur, nxt; int ui = 0;
    if (!S.next(0, cur)) return;
    f32x4 acc[2][2][4][2];
#pragma unroll
    for (int a = 0; a < 2; ++a)
#pragma unroll
        for (int b = 0; b < 2; ++b)
#pragma unroll
            for (int m = 0; m < 4; ++m)
#pragma unroll
                for (int n = 0; n < 2; ++n) acc[a][b][m][n] = (f32x4){0.f, 0.f, 0.f, 0.f};
    bf16x8 At[4][2], B0[2][2], B1[2][2];
    const char* cA = (const char*)g.A + (size_t)cur.pm * tstep; const char* cB = (const char*)g.Bt + (size_t)cur.pn * tstep;
    S.a_ready(cur);
    if constexpr (SP2) {
        PG8_STAGE(PG8_SB(0, 0), cB, voffB); PG8_STAGE(PG8_SB(0, 1), cB + hstep, voffB); PG8_STAGE(PG8_SA(0, 0), cA, voffA); PG8_STAGE(PG8_SA(0, 1), cA + hstep, voffA);
        if (wr == 1) PG8_BAR;
        PG8_WAIT_V(2); PG8_BAR;
        PG8_STAGE(PG8_SB(1, 0), cB + kstep, voffB); PG8_STAGE(PG8_SA(1, 0), cA + kstep, voffA); PG8_STAGE(PG8_SB(1, 1), cB + hstep + kstep, voffB);
        PG8_WAIT_V(6); PG8_BAR;
    } else {
        PG8_STAGE(PG8_SB(0, 0), cB, voffB); PG8_STAGE(PG8_SA(0, 0), cA, voffA); PG8_STAGE(PG8_SB(0, 1), cB + hstep, voffB); PG8_STAGE(PG8_SA(0, 1), cA + hstep, voffA);
        if (wr == 1) PG8_BAR;
        PG8_WAIT_V(4); PG8_BAR;
        PG8_STAGE(PG8_SB(1, 0), cB + kstep, voffB); PG8_STAGE(PG8_SA(1, 0), cA + kstep, voffA); PG8_STAGE(PG8_SB(1, 1), cB + hstep + kstep, voffB);
        PG8_WAIT_V(6); PG8_BAR;
    }
    for (;;) {
        const bool has_next = S.next(ui + 1, nxt);
        const char* nA = has_next ? (const char*)g.A + (size_t)nxt.pm * tstep : cA; const char* nB = has_next ? (const char*)g.Bt + (size_t)nxt.pn * tstep : cB;
        for (int t = 0; t < nt; t += 2) {
            const bool last = (t == nt - 2);
            const char* a1 = cA + (size_t)(t + 1) * kstep;
            const char* a2 = last ? nA : cA + (size_t)(t + 2) * kstep; const char* b2 = last ? nB : cB + (size_t)(t + 2) * kstep;
            const char* a3 = a2 + kstep; const char* b3 = b2 + kstep;
            if (last && has_next) S.a_ready(nxt);
            if constexpr (SP2) {
            PG8_LDB(B0, 0, 0); PG8_LDB(B1, 0, 1); PG8_SCHED; PG8_LDA(At, 0, 0); PG8_STAGE(PG8_SA(1, 1), a1 + hstep, voffA);
            PG8_WAIT_V(8); PG8_WAIT_L(0); PG8_BAR; PG8_MMA(0, 0, At, B0); PG8_MMA(0, 1, At, B1); PG8_BAR; PG8_SCHED;
            PG8_LDA(At, 0, 1); PG8_STAGE(PG8_SB(0, 0), b2, voffB); PG8_STAGE(PG8_SB(0, 1), b2 + hstep, voffB); PG8_STAGE(PG8_SA(0, 0), a2, voffA);
            PG8_WAIT_V(8); PG8_WAIT_L(0); PG8_BAR; PG8_MMA(1, 0, At, B0); PG8_MMA(1, 1, At, B1); PG8_BAR; PG8_SCHED;
            PG8_LDB(B0, 1, 0); PG8_LDB(B1, 1, 1); PG8_SCHED; PG8_LDA(At, 1, 0); PG8_STAGE(PG8_SA(0, 1), a2 + hstep, voffA);
            PG8_WAIT_V(8); PG8_WAIT_L(0); PG8_BAR; PG8_MMA(0, 0, At, B0); PG8_MMA(0, 1, At, B1); PG8_BAR; PG8_SCHED;
            PG8_LDA(At, 1, 1); PG8_STAGE(PG8_SB(1, 0), b3, voffB); PG8_STAGE(PG8_SB(1, 1), b3 + hstep, voffB); PG8_STAGE(PG8_SA(1, 0), a3, voffA);
            PG8_WAIT_V(8); PG8_WAIT_L(0); PG8_BAR; PG8_MMA(1, 0, At, B0); PG8_MMA(1, 1, At, B1); PG8_BAR; PG8_SCHED;
            } else {
            PG8_LDB(B0, 0, 0); PG8_SCHED; PG8_LDA(At, 0, 0); PG8_STAGE(PG8_SA(1, 1), a1 + hstep, voffA);
            PG8_WAIT_L(8); PG8_BAR; PG8_WAIT_L(0); PG8_MMA(0, 0, At, B0); PG8_BAR; PG8_SCHED;
            PG8_LDB(B1, 0, 1); PG8_STAGE(PG8_SB(0, 0), b2, voffB);
            PG8_BAR; PG8_WAIT_L(0); PG8_MMA(0, 1, At, B1); PG8_BAR;
            PG8_LDA(At, 0, 1); PG8_STAGE(PG8_SA(0, 0), a2, voffA);
            PG8_BAR; PG8_WAIT_L(0); PG8_MMA(1, 0, At, B0); PG8_BAR; PG8_SCHED;
            PG8_STAGE(PG8_SB(0, 1), b2 + hstep, voffB);
            PG8_WAIT_V(6); PG8_BAR; PG8_MMA(1, 1, At, B1); PG8_BAR;
            PG8_LDB(B0, 1, 0); PG8_SCHED; PG8_LDA(At, 1, 0); PG8_STAGE(PG8_SA(0, 1), a2 + hstep, voffA);
            PG8_WAIT_L(8); PG8_BAR; PG8_WAIT_L(0); PG8_MMA(0, 0, At, B0); PG8_BAR; PG8_SCHED;
            PG8_LDB(B1, 1, 1); PG8_STAGE(PG8_SB(1, 0), b3, voffB);
            PG8_BAR; PG8_WAIT_L(0); PG8_MMA(0, 1, At, B1); PG8_BAR;
            PG8_LDA(At, 1, 1); PG8_STAGE(PG8_SA(1, 0), a3, voffA);
            PG8_BAR; PG8_WAIT_L(0); PG8_MMA(1, 0, At, B0); PG8_BAR; PG8_SCHED;
            PG8_STAGE(PG8_SB(1, 1), b3 + hstep, voffB);
            PG8_WAIT_V(6); PG8_BAR; PG8_MMA(1, 1, At, B1); PG8_BAR;
            }
        }
        if constexpr (ALIGN_EPI) { if (wr == 0) PG8_BAR; }
        if constexpr (!Epi::AFTER_DRAIN) { E(acc, cur, wr, wc, fr, fq); S.done(cur); }
        if (!has_next) break;
#pragma unroll
        for (int a = 0; a < 2; ++a)
#pragma unroll
            for (int b = 0; b < 2; ++b)
#pragma unroll
                for (int m = 0; m < 4; ++m)
#pragma unroll
                    for (int n = 0; n < 2; ++n) acc[a][b][m][n] = (f32x4){0.f, 0.f, 0.f, 0.f};
        cur = nxt; cA = nA; cB = nB; ++ui;
        if constexpr (ALIGN_EPI) { if (wr == 1) PG8_BAR; }
    }
    PG8_WAIT_V(0);
    if constexpr (!ALIGN_EPI) { if (wr == 0) PG8_BAR; }
    PG8_BAR;
    if constexpr (Epi::AFTER_DRAIN) { E.fused(acc, cur, wr, wc, fr, fq, lds, wid, lane); S.done(cur); }
#undef PG8_SA
#undef PG8_SB
#undef PG8_STAGE
#undef PG8_LDA
#undef PG8_LDB
#undef PG8_MMA
#undef PG8_WAIT_V
#undef PG8_WAIT_L
#undef PG8_BAR
#undef PG8_SCHED
}
}
#define XB_TMO      128
#define XB_XCNT(j)  (256  + 64 * (j))
#define XB_XSUB(j)  (1280 + 64 * (j))
#define XB_XGEN(j)  (2304 + 64 * (j))
#define XB_TOP      3328
#define XB_TOPGEN   3392
#define XCD_BAR_WORDS 3456
#define XB_SPIN_CAP (1u << 18)
#define LAS __attribute__((address_space(3)))

__device__ __forceinline__ unsigned xb_ld(unsigned* p)              { return __hip_atomic_load(p, __ATOMIC_RELAXED, __HIP_MEMORY_SCOPE_AGENT); }
__device__ __forceinline__ unsigned xb_add(unsigned* p, unsigned v) { return __hip_atomic_fetch_add(p, v, __ATOMIC_RELAXED, __HIP_MEMORY_SCOPE_AGENT); }
__device__ __forceinline__ unsigned xb_xcc_id() { return (unsigned)__builtin_amdgcn_s_getreg((3 << 11) | 20) & 0xFu; }
#define XB_SPIN(cond, bar) do { unsigned _sp = 0; while (cond) { __builtin_amdgcn_s_sleep(1); \
    if ((++_sp & 255u) == 0u) { if (xb_ld(&(bar)[XB_TMO])) break; if (_sp > XB_SPIN_CAP) { atomicAdd(&(bar)[XB_TMO], 1u); break; } } } } while (0)

struct XcdBarrier {
    unsigned* bar; unsigned x;
    volatile LAS unsigned* st;
};

__device__ __forceinline__ XcdBarrier xcd_barrier_post(unsigned* bar, volatile LAS unsigned* st) {
    XcdBarrier b; b.bar = bar; b.x = xb_xcc_id(); b.st = st;
    if (mk_tidx() == 0) (void)xb_add(&bar[XB_XCNT(b.x)], 1u);
    return b;
}
__device__ __forceinline__ void xcd_barrier_complete(unsigned* bar, unsigned x, unsigned& nloc, unsigned& nx) {
    const unsigned G = gridDim.x * gridDim.y * gridDim.z;
    unsigned sum, cnt, mine, sp = 0u;
    for (;;) {
        sum = 0u; cnt = 0u; mine = 0u;
#pragma unroll
        for (unsigned j = 0; j < 16; ++j) { const unsigned c = xb_ld(&bar[XB_XCNT(j)]); sum += c; cnt += (c > 0u) ? 1u : 0u; mine = (j == x) ? c : mine; }
        if (sum == G) break;
        __builtin_amdgcn_s_sleep(1);
        if ((++sp & 255u) == 0u) { if (xb_ld(&bar[XB_TMO])) break; if (sp > XB_SPIN_CAP) { atomicAdd(&bar[XB_TMO], 1u); break; } }
    }
    nloc = mine > 0u ? mine : 1u; nx = cnt > 0u ? cnt : 1u;
}

__device__ __forceinline__ void xcd_barrier(const XcdBarrier& b) {
    asm volatile("s_waitcnt vmcnt(0)" ::: "memory");
    __syncthreads();
    if (mk_tidx() == 0) {
        unsigned* bar = b.bar;
        __builtin_amdgcn_s_waitcnt(0);
        unsigned nloc = b.st[0], nx = b.st[1];
        if (nloc == 0u) { xcd_barrier_complete(bar, b.x, nloc, nx); b.st[0] = nloc; b.st[1] = nx; }
        const unsigned old = xb_add(&bar[XB_XSUB(b.x)], 1u);
        const unsigned gen = old / nloc;
        if (old + 1u == (gen + 1u) * nloc) {
            __builtin_amdgcn_fence(__ATOMIC_RELEASE, "agent");
            asm volatile("s_waitcnt vmcnt(0)" ::: "memory");
            const unsigned og = xb_add(&bar[XB_TOP], 1u);
            const unsigned tg = og / nx;
            if (og + 1u == (tg + 1u) * nx) xb_add(&bar[XB_TOPGEN], 1u);
            else XB_SPIN(xb_ld(&bar[XB_TOPGEN]) == tg, bar);
            __builtin_amdgcn_fence(__ATOMIC_ACQUIRE, "agent");
            xb_add(&bar[XB_XGEN(b.x)], 1u);
            asm volatile("s_waitcnt vmcnt(0)" ::: "memory");
        } else {
            XB_SPIN(xb_ld(&bar[XB_XGEN(b.x)]) == gen, bar);
            __builtin_amdgcn_fence(__ATOMIC_ACQUIRE, "agent");
            asm volatile("s_waitcnt vmcnt(0)" ::: "memory");
        }
    }
    __syncthreads();
}
namespace pg8 {
template <class Epi, class Sched>
__device__ __forceinline__ void gemm_phase_ga(PG8_LAS unsigned char* lds, const Gemm g, const Sched& S, const Epi& E) {
    const int tid = mk_tidx(), wid = __builtin_amdgcn_readfirstlane(tid >> 6), lane = tid & 63, wr = wid >> 2, wc = wid & 3, fr = lane & 15, fq = lane >> 4;
    const int K = g.K, nt = K / BK;
    unsigned voffB[2]; int RA[2], CA[2];
#pragma unroll
    for (int i = 0; i < 2; ++i) { int R, C; stage_rc(tid * 16 + i * 8192, R, C); const int Rb = Epi::PERM ? ((R & ~31) + perm32(R & 31)) : R;
        RA[i] = R; CA[i] = C; voffB[i] = (unsigned)(Rb * K + C) * 2u; }
    const size_t kstep = (size_t)(BK * 2);
    const size_t hstep = (size_t)HALF * K * 2;
    const size_t tstep = 2 * hstep;
    const unsigned ldsw = (unsigned)wid * 1024u;
    const int aoff = lds_byte(wr * 64 + fr, fq * 8), boff = lds_byte(wc * 32 + fr, fq * 8);
#define PG8_SA(b, h) (((b) * 2 + (h)) * HTB)
#define PG8_SB(b, h) ((4 + (b) * 2 + (h)) * HTB)
#define PG8_STAGE(bufoff, gbase, voff) do { _Pragma("unroll") for (int _i = 0; _i < 2; ++_i) \
        __builtin_amdgcn_global_load_lds((const unsigned*)((const char*)(gbase) + (voff)[_i]), (PG8_LAS unsigned*)(lds + (bufoff) + ldsw + _i * 8192), 16, 0, 0); } while (0)
#define PG8_LDA(dst, b, h) do { _Pragma("unroll") for (int m = 0; m < 4; ++m) _Pragma("unroll") for (int k = 0; k < 2; ++k) dst[m][k] = *(const PG8_LAS bf16x8*)(lds + PG8_SA(b, h) + aoff + m * 2048 + k * 1024); } while (0)
#define PG8_LDB(dst, b, h) do { _Pragma("unroll") for (int n = 0; n < 2; ++n) _Pragma("unroll") for (int k = 0; k < 2; ++k) dst[n][k] = *(const PG8_LAS bf16x8*)(lds + PG8_SB(b, h) + boff + n * 2048 + k * 1024); } while (0)
#define PG8_MMA(ai, bj, At, Bt) do { __builtin_amdgcn_s_setprio(1); _Pragma("unroll") for (int m = 0; m < 4; ++m) _Pragma("unroll") for (int n = 0; n < 2; ++n) _Pragma("unroll") for (int k = 0; k < 2; ++k) \
        acc[ai][bj][m][n] = __builtin_amdgcn_mfma_f32_16x16x32_bf16(Bt[n][k], At[m][k], acc[ai][bj][m][n], 0, 0, 0); __builtin_amdgcn_s_setprio(0); } while (0)
#define PG8_WAIT_V(n) asm volatile("s_waitcnt vmcnt(" #n ")" ::: "memory")
#define PG8_WAIT_L(n) asm volatile("s_waitcnt lgkmcnt(0)" ::: "memory")
#define PG8_BAR __builtin_amdgcn_s_barrier()
#define PG8_SCHED __builtin_amdgcn_sched_barrier(0)
#define PG8_AOFF(dst, u) do { _Pragma("unroll") for (int _h = 0; _h < 2; ++_h) _Pragma("unroll") for (int _i = 0; _i < 2; ++_i) \
        dst[_h][_i] = (unsigned)S.arow(u, _h * HALF + RA[_i]) * (unsigned)(K * 2) + (unsigned)(CA[_i] * 2); } while (0)
    Unit cur, nxt; int ui = 0;
    if (!S.next(0, cur)) return;
    f32x4 acc[2][2][4][2];
#pragma unroll
    for (int a = 0; a < 2; ++a)
#pragma unroll
        for (int b = 0; b < 2; ++b)
#pragma unroll
            for (int m = 0; m < 4; ++m)
#pragma unroll
                for (int n = 0; n < 2; ++n) acc[a][b][m][n] = (f32x4){0.f, 0.f, 0.f, 0.f};
    bf16x8 At[4][2], B0[2][2], B1[2][2];
    unsigned offC[2][2], offN[2][2];
    PG8_AOFF(offC, cur);
    const char* gA = (const char*)g.A;
    const char* cB = (const char*)g.Bt + (size_t)cur.pn * tstep;
    S.a_ready(cur);
    PG8_STAGE(PG8_SB(0, 0), cB, voffB); PG8_STAGE(PG8_SB(0, 1), cB + hstep, voffB); PG8_STAGE(PG8_SA(0, 0), gA, offC[0]); PG8_STAGE(PG8_SA(0, 1), gA, offC[1]);
    if (wr == 1) PG8_BAR;
    PG8_WAIT_V(2); PG8_BAR;
    PG8_STAGE(PG8_SB(1, 0), cB + kstep, voffB); PG8_STAGE(PG8_SA(1, 0), gA + kstep, offC[0]); PG8_STAGE(PG8_SB(1, 1), cB + hstep + kstep, voffB);
    PG8_WAIT_V(6); PG8_BAR;
    for (;;) {
        const bool has_next = S.next(ui + 1, nxt);
        if (has_next) { PG8_AOFF(offN, nxt); } else {
#pragma unroll
            for (int h_ = 0; h_ < 2; ++h_)
#pragma unroll
                for (int i_ = 0; i_ < 2; ++i_) offN[h_][i_] = offC[h_][i_]; }
        const char* nB = has_next ? (const char*)g.Bt + (size_t)nxt.pn * tstep : cB;
        for (int t = 0; t < nt; t += 2) {
            const bool last = (t == nt - 2);
            const char* a1 = gA + (size_t)(t + 1) * kstep;
            const char* a2 = last ? gA : gA + (size_t)(t + 2) * kstep; const char* b2 = last ? nB : cB + (size_t)(t + 2) * kstep;
            const char* a3 = a2 + kstep; const char* b3 = b2 + kstep;
            unsigned o2[2][2];
#pragma unroll
            for (int h_ = 0; h_ < 2; ++h_)
#pragma unroll
                for (int i_ = 0; i_ < 2; ++i_) o2[h_][i_] = last ? offN[h_][i_] : offC[h_][i_];
            if (last && has_next) S.a_ready(nxt);
            PG8_LDB(B0, 0, 0); PG8_LDB(B1, 0, 1); PG8_SCHED; PG8_LDA(At, 0, 0); PG8_STAGE(PG8_SA(1, 1), a1, offC[1]);
            PG8_WAIT_V(8); PG8_WAIT_L(0); PG8_BAR; PG8_MMA(0, 0, At, B0); PG8_MMA(0, 1, At, B1); PG8_BAR; PG8_SCHED;
            PG8_LDA(At, 0, 1); PG8_STAGE(PG8_SB(0, 0), b2, voffB); PG8_STAGE(PG8_SB(0, 1), b2 + hstep, voffB); PG8_STAGE(PG8_SA(0, 0), a2, o2[0]);
            PG8_WAIT_V(8); PG8_WAIT_L(0); PG8_BAR; PG8_MMA(1, 0, At, B0); PG8_MMA(1, 1, At, B1); PG8_BAR; PG8_SCHED;
            PG8_LDB(B0, 1, 0); PG8_LDB(B1, 1, 1); PG8_SCHED; PG8_LDA(At, 1, 0); PG8_STAGE(PG8_SA(0, 1), a2, o2[1]);
            PG8_WAIT_V(8); PG8_WAIT_L(0); PG8_BAR; PG8_MMA(0, 0, At, B0); PG8_MMA(0, 1, At, B1); PG8_BAR; PG8_SCHED;
            PG8_LDA(At, 1, 1); PG8_STAGE(PG8_SB(1, 0), b3, voffB); PG8_STAGE(PG8_SB(1, 1), b3 + hstep, voffB); PG8_STAGE(PG8_SA(1, 0), a3, o2[0]);
            PG8_WAIT_V(8); PG8_WAIT_L(0); PG8_BAR; PG8_MMA(1, 0, At, B0); PG8_MMA(1, 1, At, B1); PG8_BAR; PG8_SCHED;
        }
        if (wr == 0) PG8_BAR;
        E(acc, cur, wr, wc, fr, fq); S.done(cur);
        if (!has_next) break;
#pragma unroll
        for (int a = 0; a < 2; ++a)
#pragma unroll
            for (int b = 0; b < 2; ++b)
#pragma unroll
                for (int m = 0; m < 4; ++m)
#pragma unroll
                    for (int n = 0; n < 2; ++n) acc[a][b][m][n] = (f32x4){0.f, 0.f, 0.f, 0.f};
        cur = nxt; cB = nB; ++ui;
#pragma unroll
        for (int h_ = 0; h_ < 2; ++h_)
#pragma unroll
            for (int i_ = 0; i_ < 2; ++i_) offC[h_][i_] = offN[h_][i_];
        if (wr == 1) PG8_BAR;
    }
    PG8_WAIT_V(0);
    PG8_BAR;
#undef PG8_SA
#undef PG8_SB
#undef PG8_STAGE
#undef PG8_LDA
#undef PG8_LDB
#undef PG8_MMA
#undef PG8_WAIT_V
#undef PG8_WAIT_L
#undef PG8_BAR
#undef PG8_SCHED
#undef PG8_AOFF
}
}
namespace attn_body {
using bf16=unsigned short;
using bf16x8=__attribute__((ext_vector_type(8)))short;
using s16x4=__attribute__((ext_vector_type(4)))short;
using f32x16=__attribute__((ext_vector_type(16)))float;
using u32x4=__attribute__((ext_vector_type(4)))unsigned;
constexpr int BATCH=4,NHEAD=8,SEQ=4096,D=64,DM=NHEAD*D,ODM=1024;
constexpr int NW=8,QBLK=32,QB=QBLK*NW,KVBLK=64,NQB=SEQ/QB;
constexpr int ATTN_PITCH=DM, ATTN_UNIT_ROWS=QB;
__device__ __forceinline__ int crow(int r,int hi){return (r&3)+8*(r>>2)+4*hi;}
#define SBAR() __builtin_amdgcn_sched_barrier(0)
__device__ __forceinline__ void cmask(f32x16&p0,f32x16&p1,int jb,int qrel,int hi){
  const float NEG=-INFINITY; int kb=64*jb+4*hi;
  #pragma unroll
  for(int r=0;r<16;++r){int kv=kb+(r&3)+8*(r>>2); if(kv>qrel)p0[r]=NEG; if(kv+32>qrel)p1[r]=NEG;}
}

constexpr int NSLOT=3, SLOTB=8192;
constexpr int LDS_K=0, LDS_V=NSLOT*SLOTB, LDS_WS=2*NSLOT*SLOTB, LDS_OST=LDS_WS+NW*64*4, LDS_MSK=LDS_OST+NW*4096, LDS_BYTES=LDS_MSK+NW*768;
constexpr float C2=0.125f*1.4426950408889634f;
__device__ __forceinline__ void glds16(const void*gsrc,unsigned lds_dst){unsigned keep;
  asm volatile("s_mov_b32 %0, m0\n\ts_mov_b32 m0, %2\n\ts_nop 0\n\tglobal_load_lds_dwordx4 %1, off\n\ts_mov_b32 m0, %0":"=&s"(keep):"v"(gsrc),"s"(lds_dst):"memory");}
__device__ __forceinline__ void glds4(const void*gsrc,unsigned lds_dst){unsigned keep;
  asm volatile("s_mov_b32 %0, m0\n\ts_mov_b32 m0, %2\n\ts_nop 0\n\tglobal_load_lds_dword %1, off\n\ts_mov_b32 m0, %0":"=&s"(keep):"v"(gsrc),"s"(lds_dst):"memory");}
template<int BIT> __device__ __forceinline__ float mand(float x,unsigned w){ int m; asm("v_bfe_i32 %0, %1, %2, 1":"=v"(m):"v"(w),"n"(BIT)); return __uint_as_float(__float_as_uint(x)&(unsigned)m); }
__device__ __forceinline__ float max3f(float a,float b,float c){float r;asm("v_max3_f32 %0, %1, %2, %3":"=v"(r):"v"(a),"v"(b),"v"(c));return r;}
__device__ __forceinline__ float max2f(float a,float b){float r;asm("v_max_f32_e32 %0, %1, %2":"=v"(r):"v"(a),"v"(b));return r;}
__device__ __forceinline__ float fadd_s(float a,float b){float r;asm("v_add_f32_e32 %0, %1, %2":"=v"(r):"v"(a),"v"(b));return r;}
__device__ __forceinline__ float fsub_s(float a,float b){float r;asm("v_sub_f32_e32 %0, %1, %2":"=v"(r):"v"(a),"v"(b));return r;}
typedef float f32x2_t __attribute__((ext_vector_type(2))); typedef __bf16 bf16x2_t __attribute__((ext_vector_type(2)));
__device__ __forceinline__ unsigned cvtpk_s(float lo,float hi){f32x2_t v={lo,hi};bf16x2_t b=__builtin_convertvector(v,bf16x2_t);return __builtin_bit_cast(unsigned,b);}
#define WAIT_BAR(N) asm volatile("s_waitcnt vmcnt(" #N ") lgkmcnt(0)\n\ts_barrier":::"memory")

__device__ __forceinline__ void qkt(f32x16&p0,f32x16&p1,const char*Kslot,const bf16x8*qr,const f32x16&negm,int r32,int hi){
  const char*kb=Kslot+hi*1024+r32*16;
  #pragma unroll
  for(int d0=0;d0<4;++d0){
    const bf16x8 b0=*reinterpret_cast<const bf16x8*>(kb+d0*2048);
    const bf16x8 b1=*reinterpret_cast<const bf16x8*>(kb+d0*2048+512);
    if(d0==0){p0=__builtin_amdgcn_mfma_f32_32x32x16_bf16(b0,qr[0],negm,0,0,0);p1=__builtin_amdgcn_mfma_f32_32x32x16_bf16(b1,qr[0],negm,0,0,0);}
    else{p0=__builtin_amdgcn_mfma_f32_32x32x16_bf16(b0,qr[d0],p0,0,0,0);p1=__builtin_amdgcn_mfma_f32_32x32x16_bf16(b1,qr[d0],p1,0,0,0);}}
}
typedef __attribute__((address_space(3))) const char* lds_cptr;
typedef short v4i16_t __attribute__((ext_vector_type(4)));
__device__ __forceinline__ void kload8(bf16x8*kf,lds_cptr kp){
  kf[0]=*(const __attribute__((address_space(3))) bf16x8*)(kp);      kf[1]=*(const __attribute__((address_space(3))) bf16x8*)(kp+512);
  kf[2]=*(const __attribute__((address_space(3))) bf16x8*)(kp+2048); kf[3]=*(const __attribute__((address_space(3))) bf16x8*)(kp+2560);
  kf[4]=*(const __attribute__((address_space(3))) bf16x8*)(kp+4096); kf[5]=*(const __attribute__((address_space(3))) bf16x8*)(kp+4608);
  kf[6]=*(const __attribute__((address_space(3))) bf16x8*)(kp+6144); kf[7]=*(const __attribute__((address_space(3))) bf16x8*)(kp+6656);
}
__device__ __forceinline__ void kload2(bf16x8*kf,lds_cptr kp,int j){ kf[2*j]=*(const __attribute__((address_space(3))) bf16x8*)(kp+j*2048); kf[2*j+1]=*(const __attribute__((address_space(3))) bf16x8*)(kp+j*2048+512); }
__device__ __forceinline__ s16x4 vtr(lds_cptr p){ return __builtin_bit_cast(s16x4,__builtin_amdgcn_ds_read_tr16_b64_v4i16((__attribute__((address_space(3))) v4i16_t*)p)); }
__device__ __forceinline__ float rowmax(const f32x16&p0,const f32x16&p1){
  float a=max3f(p0[0],p0[1],p1[0]),b=max3f(p0[2],p0[3],p1[1]);a=max3f(a,p1[2],p1[3]);
  #pragma unroll
  for(int r=4;r<16;r+=4){a=max3f(a,p0[r],p0[r+1]);b=max3f(b,p0[r+2],p0[r+3]);a=max3f(a,p1[r],p1[r+1]);b=max3f(b,p1[r+2],p1[r+3]);}
  const float m=max2f(a,b);
  auto rr=__builtin_amdgcn_permlane32_swap(__float_as_uint(m),__float_as_uint(m),false,false);
  return max2f(__uint_as_float(rr[0]),__uint_as_float(rr[1]));
}
__device__ __forceinline__ void pv(f32x16*o,int vb,bf16x8 pa0,bf16x8 pa1,bf16x8 pa2,bf16x8 pa3){
  #pragma unroll
  for(int d0=0;d0<2;++d0){s16x4 lo[4],hi[4];
    #pragma unroll
    for(int ks=0;ks<4;++ks){
      asm volatile("ds_read_b64_tr_b16 %0,%1 offset:%c2":"=&v"(lo[ks]):"v"(vb),"i"(d0*4096+ks*1024):"memory");
      asm volatile("ds_read_b64_tr_b16 %0,%1 offset:%c2":"=&v"(hi[ks]):"v"(vb),"i"(d0*4096+ks*1024+512):"memory");}
    asm volatile("s_waitcnt lgkmcnt(0)":::"memory");SBAR();
    #define PK(k) (bf16x8){lo[k][0],lo[k][1],lo[k][2],lo[k][3],hi[k][0],hi[k][1],hi[k][2],hi[k][3]}
    o[d0]=__builtin_amdgcn_mfma_f32_32x32x16_bf16(pa0,PK(0),o[d0],0,0,0);
    o[d0]=__builtin_amdgcn_mfma_f32_32x32x16_bf16(pa1,PK(1),o[d0],0,0,0);
    o[d0]=__builtin_amdgcn_mfma_f32_32x32x16_bf16(pa2,PK(2),o[d0],0,0,0);
    o[d0]=__builtin_amdgcn_mfma_f32_32x32x16_bf16(pa3,PK(3),o[d0],0,0,0);
    #undef PK
  }
}

#ifndef ATTN_STORE16
#define ATTN_STORE16(p,v) (*(u32x4*)(p)=(v))
#endif
template<int THRL> __device__ __forceinline__ void attn_unit(int b,int h,int qb,const bf16*Q,const bf16*__restrict__ K,const bf16*__restrict__ V,bf16*O,const unsigned*__restrict__ MK,char*shm){
  const int tid=mk_tidx(),lane=tid&63,r32=lane&31,hi=lane>>5; const int wid=__builtin_amdgcn_readfirstlane(tid>>6);
  const long rowbase=(long)b*SEQ; const int q0=qb*QB;
  const bf16*Qw=Q+(rowbase+q0+wid*QBLK)*DM+h*D;
  const bf16*Kh=K+rowbase*DM+h*D,*Vh=V+rowbase*DM+h*D;
  const unsigned lds0=(unsigned)(uintptr_t)shm;
  float*wsf=(float*)(shm+LDS_WS)+wid*64;
  const bf16*ksrc=Kh+(long)lane*DM+wid*8;
  const bf16*vsrc=Vh+(long)(16*(wid&3)+(lane>>2))*DM+(wid>>2)*32+(lane&3)*8;
  const unsigned kdst=lds0+LDS_K+wid*1024, vdst=lds0+LDS_V+wid*1024;
  const unsigned*msrc=MK+((size_t)(b*128+8*qb+wid)*64)*64+lane; const unsigned mdst=lds0+LDS_MSK+wid*768;
  const __attribute__((address_space(3))) char*mrd=(__attribute__((address_space(3))) const char*)shm+LDS_MSK+wid*768+lane*4;
  int mq_cur=0,mq_n1=256,mq_n2=512;
  #define DMA_M(t,slot) glds4(msrc+(size_t)(t)*64,(unsigned)__builtin_amdgcn_readfirstlane(mdst+(slot)))
  #define MWORD() (*(const __attribute__((address_space(3))) unsigned*)(mrd+mq_cur))
  #define DMA_K(t,slot) glds16(ksrc+(long)(t)*KVBLK*DM,(unsigned)__builtin_amdgcn_readfirstlane(kdst+(slot)))
  #define DMA_V(t,slot) glds16(vsrc+(long)(t)*KVBLK*DM,(unsigned)__builtin_amdgcn_readfirstlane(vdst+(slot)))
  const int vb0=(int)(lds0+LDS_V)+((lane>>4)&1)*32+(lane&3)*8+(4*hi+((lane&15)>>2))*64;
  const char*Kbase=shm+LDS_K; bf16x8 kf[8];
  const lds_cptr shm3=(lds_cptr)shm; const lds_cptr kp0=shm3+LDS_K+hi*1024+r32*16; const lds_cptr vp0=shm3+LDS_V+((lane>>4)&1)*32+(lane&3)*8+(4*hi+((lane&15)>>2))*64;
  const int NT=(q0+QB)/KVBLK;
  DMA_M(0,0);DMA_M(1,256);DMA_K(0,0);DMA_V(0,0);DMA_K(1,SLOTB);
  bf16x8 qr[4];
  #pragma unroll
  for(int d0=0;d0<4;++d0)qr[d0]=*reinterpret_cast<const bf16x8*>(&Qw[(long)r32*DM+d0*16+hi*8]);
  float mhat=0.f,l_reg=0.f;f32x16 o[2];o[0]=f32x16{};o[1]=f32x16{};f32x16 negm=f32x16{};asm volatile("":"+v"(negm));
  const int qrel=wid*QBLK+r32;
  #define CMASK(P0,P1,t) do{}while(0)
  bool resc=false;
  #define START(P0,P1) do{ const float rm=rowmax(P0,P1); resc=false; \
    { const float dl=(rm>-1e30f)?rm:0.f; mhat=fadd_s(mhat,dl); \
      _Pragma("unroll") for(int r=0;r<16;++r){P0[r]=fsub_s(P0[r],dl);P1[r]=fsub_s(P1[r],dl);} \
      _Pragma("unroll") for(int r=0;r<16;++r)negm[r]=-mhat; asm volatile("":"+v"(negm)); } \
    _Pragma("unroll") for(int r=0;r<16;++r)P0[r]=__builtin_amdgcn_exp2f(P0[r]); }while(0)
  #define RESC() do{ if(resc){ asm volatile("s_waitcnt lgkmcnt(0)":::"memory"); \
      _Pragma("unroll") for(int d_=0;d_<2;++d_) _Pragma("unroll") for(int r=0;r<16;++r)o[d_][r]*=wsf[crow(r,hi)]; } }while(0)
  f32x16 pA0,pA1,pB0,pB1;
  int sl_prev=0,sl_cur=0,sl_next=SLOTB;
  #define ROT() do{sl_prev=sl_cur;sl_cur=sl_next;sl_next=(sl_next==(NSLOT-1)*SLOTB)?0:sl_next+SLOTB; const int mt_=mq_cur;mq_cur=mq_n1;mq_n1=mq_n2;mq_n2=mt_;}while(0)
  DMA_K(2,2*SLOTB);
  WAIT_BAR(3);
  qkt(pA0,pA1,Kbase,qr,negm,r32,hi);asm volatile("s_nop 15\n\ts_nop 7":"+v"(pA0),"+v"(pA1));CMASK(pA0,pA1,0);
  START(pA0,pA1);
  _Pragma("unroll") for(int r=0;r<16;++r)pA1[r]=__builtin_amdgcn_exp2f(pA1[r]);
  { const unsigned mw0=MWORD(); pA0[0]=mand<0>(pA0[0],mw0);pA1[0]=mand<16>(pA1[0],mw0);pA0[1]=mand<1>(pA0[1],mw0);pA1[1]=mand<17>(pA1[1],mw0);pA0[2]=mand<2>(pA0[2],mw0);pA1[2]=mand<18>(pA1[2],mw0);pA0[3]=mand<3>(pA0[3],mw0);pA1[3]=mand<19>(pA1[3],mw0);pA0[4]=mand<4>(pA0[4],mw0);pA1[4]=mand<20>(pA1[4],mw0);pA0[5]=mand<5>(pA0[5],mw0);pA1[5]=mand<21>(pA1[5],mw0);pA0[6]=mand<6>(pA0[6],mw0);pA1[6]=mand<22>(pA1[6],mw0);pA0[7]=mand<7>(pA0[7],mw0);pA1[7]=mand<23>(pA1[7],mw0);pA0[8]=mand<8>(pA0[8],mw0);pA1[8]=mand<24>(pA1[8],mw0);pA0[9]=mand<9>(pA0[9],mw0);pA1[9]=mand<25>(pA1[9],mw0);pA0[10]=mand<10>(pA0[10],mw0);pA1[10]=mand<26>(pA1[10],mw0);pA0[11]=mand<11>(pA0[11],mw0);pA1[11]=mand<27>(pA1[11],mw0);pA0[12]=mand<12>(pA0[12],mw0);pA1[12]=mand<28>(pA1[12],mw0);pA0[13]=mand<13>(pA0[13],mw0);pA1[13]=mand<29>(pA1[13],mw0);pA0[14]=mand<14>(pA0[14],mw0);pA1[14]=mand<30>(pA1[14],mw0);pA0[15]=mand<15>(pA0[15],mw0);pA1[15]=mand<31>(pA1[15],mw0); }
  WAIT_BAR(0);
  DMA_M(2,512);DMA_K(3,0);DMA_V(1,SLOTB);
  ROT();
  kload8(kf,kp0+sl_cur);
  WAIT_BAR(3);
  s16x4 vlo[8],vhi[8]; u32x4 pw0,pw1,pw2,pw3;
  #define PKW(P,B) cvtpk_s(P[B],P[B+1])
  #define PAF(k) __builtin_bit_cast(bf16x8,pw##k)
  #define VFR(i) (bf16x8){vlo[i][0],vlo[i][1],vlo[i][2],vlo[i][3],vhi[i][0],vhi[i][1],vhi[i][2],vhi[i][3]}
  #define PIN(x) asm volatile("":"+v"(x))
  #define MX3(a,b,c) __builtin_fmaxf(__builtin_fmaxf((a),(b)),(c))
  #define GAPA(MF,A0,A1,A2,A3,W0,W1,PW) do{ MF; sacc+=A0; sacc+=A1; sacc+=A2; sacc+=A3; PIN(sacc); W0; W1; PIN(PW); SBAR(); }while(0)
  #define EX(v) __builtin_amdgcn_exp2f(v)
  #define GAPB(MF,X,B,MO) do{ MF; X[B]=mand<MO+B>(EX(X[B]),mw_); X[B+1]=mand<MO+B+1>(EX(X[B+1]),mw_); X[B+2]=mand<MO+B+2>(EX(X[B+2]),mw_); X[B+3]=mand<MO+B+3>(EX(X[B+3]),mw_); PIN(X); SBAR(); }while(0)
  #define VRD(i) do{ vlo[i]=vtr(vp_+(((i)>>2)*4096+((i)&3)*1024)); vhi[i]=vtr(vp_+(((i)>>2)*4096+((i)&3)*1024+512)); }while(0)
  #define KRD(G,j) do{ if(G){ kload2(kf,kp0+sl_next,j); SBAR(); } }while(0)
  #define STEP(C0,C1,P0,P1,t,GK,GV,GL,GM) do{ SBAR(); \
    const lds_cptr vp_=vp0+sl_prev; \
    VRD(0); SBAR(); float sacc=(P0[0]+P0[1]); \
    GAPA(C0=__builtin_amdgcn_mfma_f32_32x32x16_bf16(kf[0],qr[0],negm,0,0,0), P0[2],P0[3],P0[4],P0[5],     pw0[0]=PKW(P0,0), pw0[1]=PKW(P0,2), pw0); \
    VRD(4); SBAR(); GAPA(C1=__builtin_amdgcn_mfma_f32_32x32x16_bf16(kf[1],qr[0],negm,0,0,0), P0[6],P0[7],P0[8],P0[9],     pw0[2]=PKW(P0,4), pw0[3]=PKW(P0,6), pw0); \
    VRD(1); SBAR(); GAPA(C0=__builtin_amdgcn_mfma_f32_32x32x16_bf16(kf[2],qr[1],C0,0,0,0),   P0[10],P0[11],P0[12],P0[13], pw1[0]=PKW(P0,8), pw1[1]=PKW(P0,10), pw1); \
    VRD(5); SBAR(); GAPA(C1=__builtin_amdgcn_mfma_f32_32x32x16_bf16(kf[3],qr[1],C1,0,0,0),   P0[14],P0[15],P1[0],P1[1],   pw1[2]=PKW(P0,12),pw1[3]=PKW(P0,14), pw1); \
    VRD(2); SBAR(); GAPA(C0=__builtin_amdgcn_mfma_f32_32x32x16_bf16(kf[4],qr[2],C0,0,0,0),   P1[2],P1[3],P1[4],P1[5],     pw2[0]=PKW(P1,0), pw2[1]=PKW(P1,2), pw2); \
    VRD(6); SBAR(); GAPA(C1=__builtin_amdgcn_mfma_f32_32x32x16_bf16(kf[5],qr[2],C1,0,0,0),   P1[6],P1[7],P1[8],P1[9],     pw2[2]=PKW(P1,4), pw2[3]=PKW(P1,6), pw2); \
    VRD(3); SBAR(); GAPA(C0=__builtin_amdgcn_mfma_f32_32x32x16_bf16(kf[6],qr[3],C0,0,0,0),   P1[10],P1[11],P1[12],P1[13], pw3[0]=PKW(P1,8), pw3[1]=PKW(P1,10), pw3); \
    VRD(7); SBAR(); GAPA(C1=__builtin_amdgcn_mfma_f32_32x32x16_bf16(kf[7],qr[3],C1,0,0,0),   P1[14],P1[15],0.f,0.f,       pw3[2]=PKW(P1,12),pw3[3]=PKW(P1,14), pw3); \
    l_reg+=sacc; \
    if(GM){DMA_M((t)+2,mq_n2);} if(GK){DMA_K((t)+3,sl_cur);} if(GV){DMA_V((t)+1,sl_next);} \
    const unsigned mw_=MWORD(); \
    CMASK(C0,C1,t); \
    { float a=MX3(C0[0],C0[1],C1[0]),b=MX3(C0[2],C0[3],C1[1]); a=MX3(a,C1[2],C1[3]); \
      _Pragma("unroll") for(int r=4;r<16;r+=4){a=MX3(a,C0[r],C0[r+1]);b=MX3(b,C0[r+2],C0[r+3]);a=MX3(a,C1[r],C1[r+1]);b=MX3(b,C1[r+2],C1[r+3]);} \
      float rm=__builtin_fmaxf(a,b); { auto rr=__builtin_amdgcn_permlane32_swap(__float_as_uint(rm),__float_as_uint(rm),false,false); rm=__builtin_fmaxf(__uint_as_float(rr[0]),__uint_as_float(rr[1])); } \
      resc=false; \
      if(__builtin_expect(__any(rm>(float)THRL),0)){ const float dl=__builtin_fmaxf(rm,0.f); mhat+=dl; \
        _Pragma("unroll") for(int r=0;r<16;++r){C0[r]-=dl;C1[r]-=dl;} \
        _Pragma("unroll") for(int r=0;r<16;++r)negm[r]=-mhat; asm volatile("":"+v"(negm)); \
        const float f=__builtin_amdgcn_exp2f(-dl); l_reg*=f; if(hi==0)wsf[r32]=f; resc=true; } } \
    SBAR(); \
    GAPB(o[0]=__builtin_amdgcn_mfma_f32_32x32x16_bf16(PAF(0),VFR(0),o[0],0,0,0), C0,0,0); \
    GAPB(o[1]=__builtin_amdgcn_mfma_f32_32x32x16_bf16(PAF(0),VFR(4),o[1],0,0,0), C0,4,0); \
    KRD(GL,0); GAPB(o[0]=__builtin_amdgcn_mfma_f32_32x32x16_bf16(PAF(1),VFR(1),o[0],0,0,0), C0,8,0); \
    KRD(GL,1); GAPB(o[1]=__builtin_amdgcn_mfma_f32_32x32x16_bf16(PAF(1),VFR(5),o[1],0,0,0), C0,12,0); \
    KRD(GL,2); GAPB(o[0]=__builtin_amdgcn_mfma_f32_32x32x16_bf16(PAF(2),VFR(2),o[0],0,0,0), C1,0,16); \
    KRD(GL,3); GAPB(o[1]=__builtin_amdgcn_mfma_f32_32x32x16_bf16(PAF(2),VFR(6),o[1],0,0,0), C1,4,16); \
    GAPB(o[0]=__builtin_amdgcn_mfma_f32_32x32x16_bf16(PAF(3),VFR(3),o[0],0,0,0), C1,8,16); \
    GAPB(o[1]=__builtin_amdgcn_mfma_f32_32x32x16_bf16(PAF(3),VFR(7),o[1],0,0,0), C1,12,16); \
    }while(0)
  int t=1;
  #undef CMASK
  #define CMASK(P0,P1,t) do{}while(0)
  for(;t+5<NT;t+=2){
    STEP(pB0,pB1,pA0,pA1,t,true,true,true,true);     WAIT_BAR(3); RESC(); ROT();
    STEP(pA0,pA1,pB0,pB1,t+1,true,true,true,true);   WAIT_BAR(3); RESC(); ROT();
  }
  #undef CMASK
  #define CMASK(P0,P1,t) do{}while(0)
  #define ENDW(tt) do{ if((tt)+3<NT){WAIT_BAR(3);} else if((tt)+2<NT){WAIT_BAR(2);} else {WAIT_BAR(0);} }while(0)
  for(;t+1<NT;t+=2){
    STEP(pB0,pB1,pA0,pA1,t,(t+3<NT),(t+1<NT),(t+1<NT),(t+2<NT));       ENDW(t);   RESC(); ROT();
    STEP(pA0,pA1,pB0,pB1,t+1,(t+4<NT),(t+2<NT),(t+2<NT),(t+3<NT));     ENDW(t+1); RESC(); ROT();
  }
  STEP(pB0,pB1,pA0,pA1,NT-1,false,false,false,false); RESC();
  { float sacc=pB0[0]+pB0[1]; _Pragma("unroll") for(int r=2;r<16;++r)sacc+=pB0[r]; _Pragma("unroll") for(int r=0;r<16;++r)sacc+=pB1[r]; l_reg+=sacc;
    pw0=(u32x4){PKW(pB0,0),PKW(pB0,2),PKW(pB0,4),PKW(pB0,6)};pw1=(u32x4){PKW(pB0,8),PKW(pB0,10),PKW(pB0,12),PKW(pB0,14)};pw2=(u32x4){PKW(pB1,0),PKW(pB1,2),PKW(pB1,4),PKW(pB1,6)};pw3=(u32x4){PKW(pB1,8),PKW(pB1,10),PKW(pB1,12),PKW(pB1,14)};
    SBAR(); pv(o,vb0+sl_cur,PAF(0),PAF(1),PAF(2),PAF(3)); }
  #undef PKW
  #undef PAF
  #undef VFR
  #undef PIN
  #undef MX3
  #undef GAPA
  #undef GAPB
  #undef EX
  #undef VRD
  #undef KRD
  #undef STEP
  #undef ENDW
  {auto rr=__builtin_amdgcn_permlane32_swap(__float_as_uint(l_reg),__float_as_uint(l_reg),false,false);l_reg=__uint_as_float(rr[0])+__uint_as_float(rr[1]);}
  if(hi==0)wsf[32+r32]=l_reg;asm volatile("s_waitcnt lgkmcnt(0)":::"memory");
  float rli[16];
  #pragma unroll
  for(int r=0;r<16;++r)rli[r]=__builtin_amdgcn_rcpf(wsf[32+crow(r,hi)]);
  bf16*Ow=O+(rowbase+q0+wid*QBLK)*ODM+h*D;
  { bf16*stg=(bf16*)(shm+LDS_OST)+wid*2048;
    #pragma unroll
    for(int r=0;r<16;++r){const int orow=crow(r,hi);
      #pragma unroll
      for(int d0=0;d0<2;++d0)stg[orow*64+d0*32+r32]=(bf16)(cvtpk_s(o[d0][r]*rli[r],0.f)&0xffffu);}
    asm volatile("s_waitcnt lgkmcnt(0)":::"memory");
    #pragma unroll
    for(int i=0;i<4;++i){const int row=i*8+(lane>>3),ch=lane&7; const u32x4 v=*(const u32x4*)(stg+row*64+ch*8); ATTN_STORE16(Ow+(long)row*ODM+ch*8,v);} }
  asm volatile("s_waitcnt lgkmcnt(0)\n\ts_barrier":::"memory");
  #undef DMA_K
  #undef DMA_V
  #undef DMA_M
  #undef MWORD
  #undef CMASK
  #undef START
  #undef RESC
  #undef ROT
}
constexpr int ATTN_LDS_BYTES=LDS_BYTES;
struct AttnTensors { const bf16* Q; const bf16* K; const bf16* V; bf16* O; const unsigned* MK; };
struct AttnUnit { int bh; int qb; };
struct StaticOrder {
  int vcu;
  __device__ __forceinline__ explicit StaticOrder(int grid,int block):vcu((block%8)*(grid/8)+block/8){}
  __device__ __forceinline__ bool next(int i,AttnUnit&u)const{ if(i>=2)return false; const int s=vcu&7; u.bh=vcu>>3; u.qb=(i==0)?15-s:s; return true; }
  __device__ __forceinline__ void a_ready(const AttnUnit&)const{}
  __device__ __forceinline__ void done(const AttnUnit&)const{}
};
template<class Sched,int THRL=8> __device__ __forceinline__ void attn_phase(char*lds,const AttnTensors&T,const Sched&S){
  AttnUnit u;
  for(int i=0;S.next(i,u);++i){ S.a_ready(u); attn_unit<THRL>(u.bh/NHEAD,u.bh%NHEAD,u.qb,T.Q,T.K,T.V,T.O,T.MK,lds); S.done(u); }
}
#undef SBAR
#undef WAIT_BAR
}
namespace mk {
#define GAS __attribute__((address_space(1)))
typedef unsigned short bf16_t;
typedef float f32x4 __attribute__((ext_vector_type(4)));
typedef float f32x2 __attribute__((ext_vector_type(2)));
typedef float f32x16 __attribute__((ext_vector_type(16)));
typedef unsigned u32x4 __attribute__((ext_vector_type(4)));
typedef unsigned u32x2 __attribute__((ext_vector_type(2)));
typedef short bf16x8 __attribute__((ext_vector_type(8)));
constexpr int NB = 4, S = 4096, T = NB * S, D = 1024;
constexpr int NWAVES = 8, NTHR = 512;
constexpr int INW = 4168;
constexpr int NPHYS = 4352;
constexpr float C2 = 0.125f * 1.4426950408889634f;
constexpr float WI_SCALE = 0.04419417382415922f;
constexpr float KR_SCALE = 0.08838834764831845f;
constexpr size_t MiB = 1u << 20;
#ifndef WS_RT_MIB
#define WS_RT_MIB 65
#endif
constexpr size_t WS_CTL = 0, CTL_BYTES = 131072;
constexpr size_t WS_MOD = 1 * MiB;
constexpr size_t WS_THR = 2 * MiB;
constexpr size_t WS_R128 = 3 * MiB;
constexpr size_t WS_R64 = 11 * MiB;
constexpr size_t WS_WOUT = 15 * MiB;
constexpr size_t WS_QA = 17 * MiB, WS_KA = 33 * MiB, WS_VA = 49 * MiB, WS_QI = 65 * MiB, WS_KI = 81 * MiB, WS_WI = 83 * MiB;
constexpr size_t WS_QR = 84 * MiB, WS_KR = 100 * MiB, WS_VR = 116 * MiB, WS_GR = 132 * MiB;
constexpr size_t WS_H = 148 * MiB;
constexpr size_t WS_WIN = 180 * MiB;
constexpr size_t WS_SCORES = 148 * MiB, WS_KVS = 214 * MiB, WS_MASKT = 246 * MiB, WS_RT = WS_RT_MIB * MiB, WS_MIXED = 148 * MiB;
constexpr int CW_BAR = 1024, CW_Q = 14400, CW_TMO = 14600;
constexpr int RING_BYTES = 131072;
constexpr int LDS_BYTES = 163840;
constexpr int MISC_OFF = LDS_BYTES - 1024;

typedef __bf16 bf16x2_t __attribute__((ext_vector_type(2)));
__device__ __forceinline__ unsigned cvt_pk(float lo, float hi) { const f32x2 v = {lo, hi}; const bf16x2_t b = __builtin_convertvector(v, bf16x2_t); return __builtin_bit_cast(unsigned, b); }
__device__ __forceinline__ float bf2f(bf16_t v) { return __uint_as_float((unsigned)v << 16); }
__device__ __forceinline__ float silu_f(float x) { return x / (1.f + __expf(-x)); }
#define MK_DPP_ADD(v, ctrl) v += __uint_as_float((unsigned)__builtin_amdgcn_update_dpp(0, (int)__float_as_uint(v), ctrl, 0xf, 0xf, false))
__device__ __forceinline__ float wave_sum(float v) {
    MK_DPP_ADD(v, 0xB1);
    MK_DPP_ADD(v, 0x4E);
    MK_DPP_ADD(v, 0x141);
    MK_DPP_ADD(v, 0x140);
    { const unsigned u = __float_as_uint(v); auto r = __builtin_amdgcn_permlane16_swap(u, u, false, false); v = __uint_as_float(r[0]) + __uint_as_float(r[1]); }
    { const unsigned u = __float_as_uint(v); auto r = __builtin_amdgcn_permlane32_swap(u, u, false, false); v = __uint_as_float(r[0]) + __uint_as_float(r[1]); }
    return v;
}
__host__ __device__ __forceinline__ int perm_fwd(int o, int half) { const int hi = o >= half ? 1 : 0, oo = o - hi * half; return 8 * (oo >> 2) + 4 * hi + (oo & 3); }
__host__ __device__ __forceinline__ int perm_inv(int p, int half) { const int g = p >> 3, r = p & 7; return (r < 4) ? 4 * g + r : half + 4 * g + (r - 4); }
__device__ __forceinline__ int in_src_col(int n) {
    const int tile = n >> 8;
    if (tile < 2) { const int s = n; return 0 + (s & ~63) + perm_inv(s & 63, 32); }
    if (tile < 4) { const int s = n - 512; return 512 + (s & ~63) + perm_inv(s & 63, 32); }
    if (tile < 6) return n;
    if (tile < 8) { const int s = n - 1536; return 1536 + (s & ~63) + perm_inv(s & 63, 32); }
    if (tile == 8) { const int s = n - 2048; if (s < 64) return 2048 + perm_inv(s, 32); if (s < 72) return 2112 + (s - 64); return -1; }
    const int s = n - 2304;
    if (tile < 11) return 2120 + (s & ~127) + perm_inv(s & 127, 64);
    if (tile < 13) { const int q = s - 512; return 2632 + (q & ~127) + perm_inv(q & 127, 64); }
    if (tile < 15) return 3144 + (s - 1024);
    return 3656 + (s - 1536);
}
__device__ __forceinline__ void p0_item_ada(LAS unsigned char* lds, const float* c, const float* w_ada, const float* b_ada, float* mod, int j, int tid) {
    LAS float* sc = (LAS float*)lds; LAS float* part = (LAS float*)(lds + 16384);
    __syncthreads();
    for (int i = tid; i < 4096; i += NTHR) sc[i] = silu_f(c[i]);
    __syncthreads();
    const int col = tid & 31, kg = tid >> 5;
    float a0 = 0.f, a1 = 0.f, a2 = 0.f, a3 = 0.f;
    const float* w = w_ada + 32 * j + col;
#pragma unroll 1
    for (int k0 = kg; k0 < 1024; k0 += 256) {
        float wv[16];
#pragma unroll
        for (int i = 0; i < 16; ++i) wv[i] = w[(size_t)(k0 + 16 * i) * 6144];
#pragma unroll
        for (int i = 0; i < 16; ++i) { const int k = k0 + 16 * i; a0 += sc[k] * wv[i]; a1 += sc[1024 + k] * wv[i]; a2 += sc[2048 + k] * wv[i]; a3 += sc[3072 + k] * wv[i]; }
    }
    part[(kg * 32 + col) * 4 + 0] = a0; part[(kg * 32 + col) * 4 + 1] = a1; part[(kg * 32 + col) * 4 + 2] = a2; part[(kg * 32 + col) * 4 + 3] = a3;
    __syncthreads();
    if (tid < 128) {
        const int cc = tid >> 2, b = tid & 3; float s = 0.f;
#pragma unroll
        for (int g = 0; g < 16; ++g) s += part[(g * 32 + cc) * 4 + b];
        mod[b * 6144 + 32 * j + cc] = s + b_ada[32 * j + cc];
    }
}
__device__ __forceinline__ void p0_item_rope(const int* pos, float* R128, float* R64, int r, int lane) {
    const float f128 = powf(10000.f, -(float)lane / 64.f), f64 = powf(10000.f, -(float)(lane & 31) / 32.f);
    for (int tt = 0; tt < 16; ++tt) {
        const int t = 16 * r + tt;
        float sn, cs; sincosf((float)pos[t] * f128, &sn, &cs);
        *(f32x2*)(R128 + ((size_t)t * 64 + lane) * 2) = (f32x2){cs, sn};
    }
    for (int tt = 0; tt < 16; tt += 2) {
        const int t = 16 * r + tt + (lane >> 5);
        float sn, cs; sincosf((float)pos[t] * f64, &sn, &cs);
        *(f32x2*)(R64 + ((size_t)t * 32 + (lane & 31)) * 2) = (f32x2){cs, sn};
    }
}
template <int MODE> struct TrItem { const float* sp; int ldw, Kdim, n0, k0; bf16_t* WT; bool valid; };
template <int MODE> __device__ __forceinline__ void p0_tr_setup(TrItem<MODE>& it, const float* W, const float* W2, int ldw, int Kdim, bf16_t* WT, int n0, int k0, int lane) {
    const int nl = lane & 31, n = n0 + nl;
    int src = n; const float* Ws = W;
    if (MODE == 0) src = in_src_col(n);
    if (MODE == 2) { const int g = n >> 3, r = n & 7; src = 4 * g + (r & 3); Ws = (r < 4) ? W : W2; }
    it.sp = Ws + (size_t)(k0 + (lane >> 5)) * ldw + (src >= 0 ? src : 0); it.ldw = ldw; it.Kdim = Kdim; it.n0 = n0; it.k0 = k0; it.WT = WT; it.valid = (src >= 0);
}
template <int MODE> __device__ __forceinline__ void p0_tr_load(const TrItem<MODE>& it, float (&tv)[32]) {
#pragma unroll
    for (int i = 0; i < 32; ++i) tv[i] = it.sp[(size_t)(2 * i) * it.ldw];
}
template <int MODE> __device__ __forceinline__ void p0_tr_emit(const TrItem<MODE>& it, const float (&tv)[32], LAS float* scr, int lane) {
    const int nl = lane & 31;
#pragma unroll
    for (int i = 0; i < 32; ++i) scr[(2 * i + (lane >> 5)) * 33 + nl] = it.valid ? tv[i] : 0.f;
    asm volatile("s_waitcnt lgkmcnt(0)" ::: "memory");
    const int c = lane & 7;
#pragma unroll
    for (int j = 0; j < 4; ++j) {
        const int nn = (lane >> 3) + 8 * j; const LAS float* q = scr + (8 * c) * 33 + nn;
        u32x4 o; o.x = cvt_pk(q[0 * 33], q[1 * 33]); o.y = cvt_pk(q[2 * 33], q[3 * 33]); o.z = cvt_pk(q[4 * 33], q[5 * 33]); o.w = cvt_pk(q[6 * 33], q[7 * 33]);
        *(u32x4*)(it.WT + (size_t)(it.n0 + nn) * it.Kdim + it.k0 + 8 * c) = o;
    }
    asm volatile("s_waitcnt lgkmcnt(0)" ::: "memory");
}
template <int MODE> __device__ __forceinline__ void p0_tr_item(const float* W, const float* W2, int ldw, int Kdim, bf16_t* WT, int n0, int k0, LAS float* scr, int lane) {
    TrItem<MODE> it; p0_tr_setup<MODE>(it, W, W2, ldw, Kdim, WT, n0, k0, lane);
    float tv[32]; p0_tr_load<MODE>(it, tv); p0_tr_emit<MODE>(it, tv, scr, lane);
}
struct P0Args { const float *c, *w_ada, *b_ada, *w_in, *w_out, *w_gate, *w_up, *w_down; const int* pos; float *mod, *R128, *R64; bf16_t *WIN, *WOUT, *WGU, *WD; };
__device__ __forceinline__ void p0_prologue(LAS unsigned char* lds, const P0Args& a, int bid, int G, int tid) {
    const int lane = tid & 63, wave = tid >> 6;
    if (bid < 192) p0_item_ada(lds, a.c, a.w_ada, a.b_ada, a.mod, bid, tid);
    __syncthreads();
    LAS float* scr = (LAS float*)(lds + wave * 8448);
    constexpr int I_ROPE = 1024, I_WIN = 16 * (NPHYS / 32), I_WOUT = 16 * 32;
    for (int it = bid * NWAVES + wave; it < I_ROPE + I_WIN + I_WOUT; it += G * NWAVES) {
        int r = it;
        if (r < I_ROPE) { p0_item_rope(a.pos, a.R128, a.R64, r, lane); continue; } r -= I_ROPE;
        if (r < I_WIN) { const int kb = r / (NPHYS / 32), nb = r - kb * (NPHYS / 32); p0_tr_item<0>(a.w_in, nullptr, INW, 1024, a.WIN, 32 * nb, 64 * kb, scr, lane); continue; } r -= I_WIN;
        { const int kb = r >> 5, nb = r & 31; p0_tr_item<1>(a.w_out, nullptr, 1024, 1024, a.WOUT, 32 * nb, 64 * kb, scr, lane); }
    }
}
__device__ __forceinline__ void p0_expert_items(LAS unsigned char* lds, const P0Args& a, int gw, int ngw, int tid) {
    const int lane = tid & 63, wave = tid >> 6;
    LAS float* scr = (LAS float*)(lds + wave * 8448);
    constexpr int I_WGU = 32 * 256, I_WD = 32 * 128;
    {
        TrItem<2> cur, nxt; float tv[32], tn[32];
        int it = gw;
        if (it < I_WGU) { const int e = it >> 8, q = it & 255, kb = q >> 4, nb = q & 15;
            p0_tr_setup<2>(cur, a.w_gate + (size_t)e * 262144, a.w_up + (size_t)e * 262144, 256, 1024, a.WGU + (size_t)e * 524288, 32 * nb, 64 * kb, lane); p0_tr_load<2>(cur, tv); }
#pragma unroll 1
        for (; it < I_WGU; it += ngw) {
            const int i2 = it + ngw; const bool has = i2 < I_WGU;
            if (has) { const int e = i2 >> 8, q = i2 & 255, kb = q >> 4, nb = q & 15;
                p0_tr_setup<2>(nxt, a.w_gate + (size_t)e * 262144, a.w_up + (size_t)e * 262144, 256, 1024, a.WGU + (size_t)e * 524288, 32 * nb, 64 * kb, lane); p0_tr_load<2>(nxt, tn); }
            p0_tr_emit<2>(cur, tv, scr, lane);
            if (has) { cur = nxt;
#pragma unroll
                for (int i = 0; i < 32; ++i) tv[i] = tn[i]; }
        }
    }
    {
        TrItem<1> cur, nxt; float tv[32], tn[32];
        int it = gw;
        if (it < I_WD) { const int e = it >> 7, q = it & 127, kb = q >> 5, nb = q & 31;
            p0_tr_setup<1>(cur, a.w_down + (size_t)e * 262144, nullptr, 1024, 256, a.WD + (size_t)e * 262144, 32 * nb, 64 * kb, lane); p0_tr_load<1>(cur, tv); }
#pragma unroll 1
        for (; it < I_WD; it += ngw) {
            const int i2 = it + ngw; const bool has = i2 < I_WD;
            if (has) { const int e = i2 >> 7, q = i2 & 127, kb = q >> 5, nb = q & 31;
                p0_tr_setup<1>(nxt, a.w_down + (size_t)e * 262144, nullptr, 1024, 256, a.WD + (size_t)e * 262144, 32 * nb, 64 * kb, lane); p0_tr_load<1>(nxt, tn); }
            p0_tr_emit<1>(cur, tv, scr, lane);
            if (has) { cur = nxt;
#pragma unroll
                for (int i = 0; i < 32; ++i) tv[i] = tn[i]; }
        }
    }
}
__device__ __forceinline__ void p1_rows(const float* x, const float* g, const float* mod, bf16_t* H, int gw, int NGW, int lane) {
    for (int m = gw; m < T; m += NGW) {
        const int b = m / S;
        const f32x4* xr = (const f32x4*)(x + (size_t)m * D) + lane;
        f32x4 v[4]; float s = 0.f;
#pragma unroll
        for (int j = 0; j < 4; ++j) { v[j] = xr[64 * j]; s += (v[j].x * v[j].x + v[j].y * v[j].y) + (v[j].z * v[j].z + v[j].w * v[j].w); }
        const float rs = 1.0f / sqrtf(wave_sum(s) * (1.f / 1024.f) + 1e-6f);
        const float* sh = mod + b * 6144; const float* sc = sh + 1024;
        bf16_t* orow = H + (size_t)m * D;
#pragma unroll
        for (int j = 0; j < 4; ++j) {
            const int col = 4 * lane + 256 * j;
            const f32x4 gg = *(const f32x4*)(g + col), a = *(const f32x4*)(sc + col), bb = *(const f32x4*)(sh + col);
            const f32x4 o = v[j] * rs * gg * (a + 1.0f) + bb;
            u32x2 w; w.x = cvt_pk(o.x, o.y); w.y = cvt_pk(o.z, o.w);
            *(u32x2*)(orow + col) = w;
        }
    }
}
struct EpiInProj {
    static constexpr bool PERM = true, AFTER_DRAIN = false;
    bf16_t *QA, *KA, *VA, *QI, *KI, *QR, *KR, *VR, *GR; float* WI; const float* R64; const float* R128;
    template <int ROPE, int ACT> __device__ __forceinline__ void emit(const pg8::f32x4 (&acc)[2][2][4][2], bf16_t* dst, int ld, int segbase, float scale, int row0, int wc, int fq, int bjmask) const {
#pragma unroll
        for (int bj = 0; bj < 2; ++bj) {
            if (!((bjmask >> bj) & 1)) continue;
            const int cg = segbase + 128 * bj + 32 * wc + 8 * fq;
            const int fi = (ROPE == 1) ? ((cg & 63) >> 1) : ((cg & 127) >> 1);
#pragma unroll
            for (int ai = 0; ai < 2; ++ai)
#pragma unroll
                for (int m = 0; m < 4; ++m) {
                    const int row = row0 + ai * 128 + m * 16;
                    pg8::f32x4 v0 = acc[ai][bj][m][0], v1 = acc[ai][bj][m][1];
                    if (ROPE != 0) {
                        const float* tp = (ROPE == 1) ? (R64 + ((size_t)row * 32 + fi) * 2) : (R128 + ((size_t)row * 64 + fi) * 2);
                        const pg8::f32x4 t0 = *(const pg8::f32x4*)tp, t1 = *(const pg8::f32x4*)(tp + 4);
                        pg8::f32x4 o1, o2;
                        o1[0] = v0[0] * t0[0] - v1[0] * t0[1]; o2[0] = v1[0] * t0[0] + v0[0] * t0[1];
                        o1[1] = v0[1] * t0[2] - v1[1] * t0[3]; o2[1] = v1[1] * t0[2] + v0[1] * t0[3];
                        o1[2] = v0[2] * t1[0] - v1[2] * t1[1]; o2[2] = v1[2] * t1[0] + v0[2] * t1[1];
                        o1[3] = v0[3] * t1[2] - v1[3] * t1[3]; o2[3] = v1[3] * t1[2] + v0[3] * t1[3];
                        v0 = o1; v1 = o2;
                    }
                    if (ACT == 1) {
#pragma unroll
                        for (int e = 0; e < 4; ++e) { v0[e] = silu_f(v0[e]); v1[e] = silu_f(v1[e]); }
                    }
                    v0 = v0 * scale; v1 = v1 * scale;
                    u32x4 w; w.x = cvt_pk(v0[0], v0[1]); w.y = cvt_pk(v0[2], v0[3]); w.z = cvt_pk(v1[0], v1[1]); w.w = cvt_pk(v1[2], v1[3]);
                    *(u32x4*)(dst + (size_t)row * ld + cg) = w;
                }
        }
    }
    __device__ __forceinline__ void operator()(const pg8::f32x4 (&acc)[2][2][4][2], const pg8::Unit& u, int wr, int wc, int fr, int fq) const {
        const int row0 = u.pm * 256 + wr * 64 + fr;
        const int pn = u.pn;
        if (pn < 2) emit<1, 0>(acc, QA, 512, pn * 256, C2, row0, wc, fq, 3);
        else if (pn < 4) emit<1, 0>(acc, KA, 512, (pn - 2) * 256, 1.f, row0, wc, fq, 3);
        else if (pn < 6) emit<0, 0>(acc, VA, 512, (pn - 4) * 256, 1.f, row0, wc, fq, 3);
        else if (pn < 8) emit<1, 0>(acc, QI, 512, (pn - 6) * 256, 1.f, row0, wc, fq, 3);
        else if (pn == 8) {
            if (wc < 2) emit<1, 0>(acc, KI, 64, 0, 1.f, row0, wc, fq, 1);
            else if (wc == 2 && fq == 0) {
#pragma unroll
                for (int ai = 0; ai < 2; ++ai)
#pragma unroll
                    for (int m = 0; m < 4; ++m) {
                        const int row = row0 + ai * 128 + m * 16;
                        *(pg8::f32x4*)(WI + (size_t)row * 8) = acc[ai][0][m][0] * WI_SCALE;
                        *(pg8::f32x4*)(WI + (size_t)row * 8 + 4) = acc[ai][0][m][1] * WI_SCALE;
                    }
            }
        }
        else if (pn < 11) emit<2, 0>(acc, QR, 512, (pn - 9) * 256, 1.f, row0, wc, fq, 3);
        else if (pn < 13) emit<2, 0>(acc, KR, 512, (pn - 11) * 256, KR_SCALE, row0, wc, fq, 3);
        else if (pn < 15) emit<0, 0>(acc, VR, 512, (pn - 13) * 256, 1.f, row0, wc, fq, 3);
        else emit<0, 1>(acc, GR, 512, (pn - 15) * 256, 1.f, row0, wc, fq, 3);
    }
};
typedef short v4i16_t __attribute__((ext_vector_type(4)));
__device__ __forceinline__ unsigned off_b(unsigned row, unsigned ch) { return 256u * row + 16u * (ch ^ (((row & 3u) << 2) | ((row >> 2) & 3u))); }
__device__ __forceinline__ int crow(int r, int hi) { return (r & 3) + 8 * (r >> 2) + 4 * hi; }
__device__ __forceinline__ v4i16_t tr_rd(LAS unsigned char* p) { return __builtin_amdgcn_ds_read_tr16_b64_v4i16((LAS v4i16_t*)p); }
__device__ __forceinline__ bf16x8 tr_frag_nat(LAS unsigned char* img, int lane, int c, int ks) {
    const unsigned h = lane >> 5, blk = (lane >> 4) & 1, q = (lane & 15) >> 2, p = lane & 3;
    const v4i16_t lo = tr_rd(img + off_b(16 * ks + 8 * h + q, 4 * c + 2 * blk + (p >> 1)) + 8 * (p & 1));
    const v4i16_t hi = tr_rd(img + off_b(16 * ks + 8 * h + 4 + q, 4 * c + 2 * blk + (p >> 1)) + 8 * (p & 1));
    return (bf16x8){lo[0], lo[1], lo[2], lo[3], hi[0], hi[1], hi[2], hi[3]};
}
__device__ __forceinline__ bf16x8 tr_frag_acc(LAS unsigned char* img, int lane, int c, int rowbase) {
    const unsigned h = lane >> 5, blk = (lane >> 4) & 1, q = (lane & 15) >> 2, p = lane & 3;
    const v4i16_t lo = tr_rd(img + off_b(rowbase + 4 * h + q, 4 * c + 2 * blk + (p >> 1)) + 8 * (p & 1));
    const v4i16_t hi = tr_rd(img + off_b(rowbase + 8 + 4 * h + q, 4 * c + 2 * blk + (p >> 1)) + 8 * (p & 1));
    return (bf16x8){lo[0], lo[1], lo[2], lo[3], hi[0], hi[1], hi[2], hi[3]};
}
__device__ __forceinline__ float ret_lgam(int h) { return logf(1.0f - exp2f(-5.0f - (float)h)); }
template <bool SCALE> __device__ __forceinline__ void ret_stage(LAS unsigned char* img, const bf16_t* src  , float sc, int tl) {
#pragma unroll
    for (int it = 0; it < 8; ++it) {
        const int idx = tl + 256 * it, row = idx >> 4, ch = idx & 15;
        u32x4 v = *(const u32x4*)(src + (size_t)row * 512 + ch * 8);
        if (SCALE) {
            const float f = expf(sc * (float)row);
#pragma unroll
            for (int e = 0; e < 4; ++e) { const unsigned w = v[e]; v[e] = cvt_pk(__uint_as_float(w << 16) * f, __uint_as_float(w & 0xffff0000u) * f); }
        }
        *(LAS u32x4*)(img + off_b(row, ch)) = v;
    }
}
__device__ __forceinline__ void ret_kv_pair(LAS unsigned char* lds, const bf16_t* KR, const bf16_t* VR, float* KVS, int pair, int tid) {
    const int uh = tid >> 8, tl = tid & 255, lane = tid & 63, w4 = __builtin_amdgcn_readfirstlane((tid >> 6) & 3), hi = lane >> 5, r32 = lane & 31;
    const int unit = pair * 2 + uh, n = unit & 31, bh = unit >> 5, b = bh >> 2, h = bh & 3;
    const size_t tok0 = (size_t)b * S + (size_t)n * 128;
    LAS unsigned char* kimg = lds + uh * 65536; LAS unsigned char* vimg = kimg + 32768;
    const float lgam = ret_lgam(h);
    __syncthreads();
    ret_stage<false>(kimg, KR + tok0 * 512 + h * 128, 0.f, tl);
    ret_stage<true>(vimg, VR + tok0 * 512 + h * 128, -lgam, tl);
    __syncthreads();
    f32x16 acc[4];
#pragma unroll
    for (int c = 0; c < 4; ++c) acc[c] = (f32x16){};
#pragma unroll
    for (int ks = 0; ks < 8; ++ks) {
        const bf16x8 a = tr_frag_nat(vimg, lane, w4, ks);
#pragma unroll
        for (int nt = 0; nt < 4; ++nt) { const bf16x8 bb = tr_frag_nat(kimg, lane, nt, ks); acc[nt] = __builtin_amdgcn_mfma_f32_32x32x16_bf16(a, bb, acc[nt], 0, 0, 0); }
    }
    const float sc = expf(lgam * 127.f);
    float* o = KVS + (size_t)unit * 16384;
#pragma unroll
    for (int nt = 0; nt < 4; ++nt)
#pragma unroll
        for (int r = 0; r < 16; ++r) o[(32 * w4 + crow(r, hi)) * 128 + 32 * nt + r32] = acc[nt][r] * sc;
}
__device__ __forceinline__ void ret_scan(const float* __restrict__ KVS, bf16_t* __restrict__ RT, int gtid, int nthreads) {
    for (int idx = gtid; idx < 16 * 16384; idx += nthreads) {
        const int bh = idx >> 14, el = idx & 16383, h = bh & 3;
        const float g = 1.0f - exp2f(-5.0f - (float)h), g128 = expf(128.f * ret_lgam(h));
        const size_t o0 = ((size_t)(bh * 32) << 14) + el;
        float kv[31];
#pragma unroll
        for (int n = 0; n < 31; ++n) kv[n] = KVS[o0 + ((size_t)n << 14)];
        float R = 0.f;
#pragma unroll
        for (int n = 0; n < 32; ++n) {
            RT[o0 + ((size_t)n << 14)] = (bf16_t)(cvt_pk(g * R, 0.f) & 0xffffu);
            if (n < 31) R = g128 * R + kv[n];
        }
    }
}
__device__ __forceinline__ void ret_out_pair(LAS unsigned char* lds, const bf16_t* QR, const bf16_t* KR, const bf16_t* VR, const bf16_t* GR, const bf16_t* RT, bf16_t* MIXED, int pair, int tid) {
    const int uh = tid >> 8, tl = tid & 255, lane = tid & 63, w4 = __builtin_amdgcn_readfirstlane((tid >> 6) & 3), hi = lane >> 5, r32 = lane & 31;
    const int unit = pair * 2 + uh, n = unit & 31, bh = unit >> 5, b = bh >> 2, h = bh & 3;
    const size_t tok0 = (size_t)b * S + (size_t)n * 128;
    LAS unsigned char* vimg = lds + uh * 32768;
    const float lgam = ret_lgam(h);
    __syncthreads();
    ret_stage<true>(vimg, VR + tok0 * 512 + h * 128, -lgam, tl);
    __syncthreads();
    bf16x8 qf[8];
    {
        const bf16_t* qp = QR + (tok0 + 32 * w4 + r32) * 512 + h * 128 + 8 * hi;
#pragma unroll
        for (int ks = 0; ks < 8; ++ks) qf[ks] = *(const bf16x8*)(qp + 16 * ks);
    }
    f32x16 acc[4];
#pragma unroll
    for (int c = 0; c < 4; ++c) acc[c] = (f32x16){};
    if (n > 0) {
        const bf16_t* rp = RT + (size_t)unit * 16384 + r32 * 128 + 8 * hi;
#pragma unroll
        for (int c = 0; c < 4; ++c)
#pragma unroll
            for (int ks = 0; ks < 8; ++ks) { const bf16x8 a = *(const bf16x8*)(rp + c * 32 * 128 + 16 * ks); acc[c] = __builtin_amdgcn_mfma_f32_32x32x16_bf16(a, qf[ks], acc[c], 0, 0, 0); }
    }
    for (int jt = 0; jt <= w4; ++jt) {
        const bf16_t* kp = KR + (tok0 + 32 * jt + r32) * 512 + h * 128 + 8 * hi;
        f32x16 st = (f32x16){};
#pragma unroll
        for (int ks = 0; ks < 8; ++ks) { const bf16x8 kf = *(const bf16x8*)(kp + 16 * ks); st = __builtin_amdgcn_mfma_f32_32x32x16_bf16(kf, qf[ks], st, 0, 0, 0); }
        if (jt == w4) {
#pragma unroll
            for (int r = 0; r < 16; ++r) if (crow(r, hi) > r32) st[r] = 0.f;
        }
#pragma unroll
        for (int s = 0; s < 2; ++s) {
            u32x4 pw; pw.x = cvt_pk(st[8 * s + 0], st[8 * s + 1]); pw.y = cvt_pk(st[8 * s + 2], st[8 * s + 3]); pw.z = cvt_pk(st[8 * s + 4], st[8 * s + 5]); pw.w = cvt_pk(st[8 * s + 6], st[8 * s + 7]);
            const bf16x8 pb = __builtin_bit_cast(bf16x8, pw);
#pragma unroll
            for (int c = 0; c < 4; ++c) { const bf16x8 vf = tr_frag_acc(vimg, lane, c, 32 * jt + 16 * s); acc[c] = __builtin_amdgcn_mfma_f32_32x32x16_bf16(vf, pb, acc[c], 0, 0, 0); }
        }
    }
    float ss = 0.f;
#pragma unroll
    for (int c = 0; c < 4; ++c)
#pragma unroll
        for (int r = 0; r < 16; ++r) ss += acc[c][r] * acc[c][r];
    ss += __shfl_xor(ss, 32);
    const float gi = expf(lgam * (float)(32 * w4 + r32));
    const float fac = gi / sqrtf(gi * gi * ss * (1.0f / 128.f) + 1e-6f);
    const size_t tok = tok0 + 32 * w4 + r32;
    const bf16_t* gp = GR + tok * 512 + h * 128 + 4 * hi;
    bf16_t* op = MIXED + tok * 1024 + 512 + h * 128 + 4 * hi;
#pragma unroll
    for (int c = 0; c < 4; ++c)
#pragma unroll
        for (int g4 = 0; g4 < 4; ++g4) {
            const u32x2 gv = *(const u32x2*)(gp + 32 * c + 8 * g4);
            const float g0 = __uint_as_float(gv.x << 16), g1 = __uint_as_float(gv.x & 0xffff0000u), g2 = __uint_as_float(gv.y << 16), g3 = __uint_as_float(gv.y & 0xffff0000u);
            u32x2 w; w.x = cvt_pk(acc[c][4 * g4 + 0] * fac * g0, acc[c][4 * g4 + 1] * fac * g1); w.y = cvt_pk(acc[c][4 * g4 + 2] * fac * g2, acc[c][4 * g4 + 3] * fac * g3);
            *(u32x2*)(op + 32 * c + 8 * g4) = w;
        }
}
constexpr size_t WS_MIX = 17 * MiB;
constexpr size_t WS_H2 = 49 * MiB;
constexpr size_t WS_LIST = 81 * MiB;
constexpr size_t WS_HID = 85 * MiB;
constexpr size_t WS_Y = 105 * MiB;
constexpr size_t WS_HRES = 180 * MiB;
constexpr int CW_CNT = 12288;
constexpr int CW_TILE = 16384;
constexpr int TB_OFF = MISC_OFF + 64;

struct EpiStore {
    static constexpr bool PERM = true, AFTER_DRAIN = false;
    bf16_t* O; int ld;
    __device__ __forceinline__ void operator()(const pg8::f32x4 (&acc)[2][2][4][2], const pg8::Unit& u, int wr, int wc, int fr, int fq) const {
        const int row0 = u.pm * 256 + wr * 64 + fr, col0 = u.pn * 256 + wc * 32 + 8 * fq;
#pragma unroll
        for (int ai = 0; ai < 2; ++ai)
#pragma unroll
            for (int m = 0; m < 4; ++m)
#pragma unroll
                for (int bj = 0; bj < 2; ++bj) {
                    const pg8::f32x4 v0 = acc[ai][bj][m][0], v1 = acc[ai][bj][m][1];
                    u32x4 w; w.x = cvt_pk(v0[0], v0[1]); w.y = cvt_pk(v0[2], v0[3]); w.z = cvt_pk(v1[0], v1[1]); w.w = cvt_pk(v1[2], v1[3]);
                    *(u32x4*)(O + (size_t)(row0 + ai * 128 + m * 16) * ld + col0 + bj * 128) = w;
                }
    }
};
struct P6bArgs { const bf16_t* MIX; const float *x, *g_post, *g_pre2, *mod, *w_group, *b_group, *w_expert, *b_expert; float* HRES; bf16_t* H2; unsigned* cnt; u32x2* LIST; };
constexpr int P6B_NR = 4;
constexpr int RT_WL_OFF = 147456;
__device__ __forceinline__ void p6b_load_weights(LAS unsigned char* lds, const float* w_group, const float* w_expert, int tid) {
    __syncthreads();
    for (int idx = tid; idx < 1024 * 9; idx += NTHR) {
        const int d = idx / 9, cc = idx - 9 * d, pos = ((d >> 2) & 63) + 64 * ((d & 3) + 4 * (d >> 8));
        const f32x4 v = (cc == 0) ? *(const f32x4*)(w_group + d * 4) : *(const f32x4*)(w_expert + d * 32 + 4 * (cc - 1));
        *(LAS f32x4*)(lds + pos * 144 + 16 * cc) = v;
    }
    __syncthreads();
}
__device__ __forceinline__ void p6b_rows8(const P6bArgs& a, const LAS unsigned char* wtab, LAS float* wl  , int gw, int lane, bool dry = false) {
    const int m0 = gw * P6B_NR, b = m0 / S;
    const float* md = a.mod + b * 6144;
    float hv[P6B_NR][16];
    u32x2 mw[P6B_NR][4]; f32x4 xv[P6B_NR][4];
#pragma unroll
    for (int r = 0; r < P6B_NR; ++r)
#pragma unroll
        for (int j = 0; j < 4; ++j) mw[r][j] = *(const u32x2*)(a.MIX + (size_t)(m0 + r) * 1024 + 4 * lane + 256 * j);
#pragma unroll
    for (int r = 0; r < P6B_NR; ++r)
#pragma unroll
        for (int j = 0; j < 4; ++j) xv[r][j] = *(const f32x4*)(a.x + (size_t)(m0 + r) * 1024 + 4 * lane + 256 * j);
#pragma unroll
    for (int r = 0; r < P6B_NR; ++r) {
        const size_t row = (size_t)(m0 + r);
        float v[16]; float s = 0.f;
#pragma unroll
        for (int j = 0; j < 4; ++j) {
            const u32x2 w = mw[r][j];
            v[4 * j + 0] = __uint_as_float(w.x << 16); v[4 * j + 1] = __uint_as_float(w.x & 0xffff0000u); v[4 * j + 2] = __uint_as_float(w.y << 16); v[4 * j + 3] = __uint_as_float(w.y & 0xffff0000u);
#pragma unroll
            for (int k = 0; k < 4; ++k) s += v[4 * j + k] * v[4 * j + k];
        }
        const float rs = 1.0f / sqrtf(wave_sum(s) * (1.f / 1024.f) + 1e-6f);
        float s2 = 0.f;
#pragma unroll
        for (int j = 0; j < 4; ++j) {
            const int col = 4 * lane + 256 * j;
            const f32x4 xx = xv[r][j], gp = *(const f32x4*)(a.g_post + col), g1 = *(const f32x4*)(md + 2 * 1024 + col);
            f32x4 hr;
#pragma unroll
            for (int k = 0; k < 4; ++k) { hr[k] = xx[k] + g1[k] * (v[4 * j + k] * rs * gp[k]); v[4 * j + k] = hr[k]; s2 += hr[k] * hr[k]; }
        }
        const float rs2 = 1.0f / sqrtf(wave_sum(s2) * (1.f / 1024.f) + 1e-6f);
#pragma unroll
        for (int j = 0; j < 4; ++j) {
            const int col = 4 * lane + 256 * j;
            const f32x4 g2 = *(const f32x4*)(a.g_pre2 + col), sc = *(const f32x4*)(md + 4 * 1024 + col), sh = *(const f32x4*)(md + 3 * 1024 + col);
#pragma unroll
            for (int k = 0; k < 4; ++k) hv[r][4 * j + k] = v[4 * j + k] * rs2 * g2[k] * (1.f + sc[k]) + sh[k];
            u32x2 w; w.x = cvt_pk(hv[r][4 * j + 0], hv[r][4 * j + 1]); w.y = cvt_pk(hv[r][4 * j + 2], hv[r][4 * j + 3]);
            *(u32x2*)(a.H2 + row * 1024 + col) = w;
            hv[r][4 * j + 0] = __uint_as_float(w.x << 16); hv[r][4 * j + 1] = __uint_as_float(w.x & 0xffff0000u); hv[r][4 * j + 2] = __uint_as_float(w.y << 16); hv[r][4 * j + 3] = __uint_as_float(w.y & 0xffff0000u);
        }
    }
#pragma unroll 1
    for (int c = 0; c < 9; ++c) {
        f32x2 acc[P6B_NR][2];
#pragma unroll
        for (int r = 0; r < P6B_NR; ++r) { acc[r][0] = (f32x2){0.f, 0.f}; acc[r][1] = (f32x2){0.f, 0.f}; }
#pragma unroll
        for (int j = 0; j < 4; ++j)
#pragma unroll
            for (int k = 0; k < 4; ++k) {
                const f32x4 w4 = *(const LAS f32x4*)(wtab + (lane + 64 * (k + 4 * j)) * 144 + 16 * c);
                const f32x2 wa = {w4[0], w4[1]}, wb = {w4[2], w4[3]};
#pragma unroll
                for (int r = 0; r < P6B_NR; ++r) {
                    const f32x2 hh = {hv[r][4 * j + k], hv[r][4 * j + k]};
                    acc[r][0] = __builtin_elementwise_fma(wa, hh, acc[r][0]); acc[r][1] = __builtin_elementwise_fma(wb, hh, acc[r][1]);
                }
            }
        float v[16];
#pragma unroll
        for (int r = 0; r < P6B_NR; ++r) { v[4 * r + 0] = acc[r][0][0]; v[4 * r + 1] = acc[r][0][1]; v[4 * r + 2] = acc[r][1][0]; v[4 * r + 3] = acc[r][1][1]; }
        float s8[8], t4[4];
#pragma unroll
        for (int i = 0; i < 8; ++i) { auto q = __builtin_amdgcn_permlane32_swap(__float_as_uint(v[i]), __float_as_uint(v[i + 8]), false, false); s8[i] = __uint_as_float(q[0]) + __uint_as_float(q[1]); }
#pragma unroll
        for (int i = 0; i < 4; ++i) { auto q = __builtin_amdgcn_permlane16_swap(__float_as_uint(s8[i]), __float_as_uint(s8[i + 4]), false, false); t4[i] = __uint_as_float(q[0]) + __uint_as_float(q[1]); }
#pragma unroll
        for (int i = 0; i < 4; ++i) MK_DPP_ADD(t4[i], 0x128);
        float u0 = (lane & 8) ? t4[1] : t4[0], u1 = (lane & 8) ? t4[3] : t4[2];
        MK_DPP_ADD(u0, 0x141); MK_DPP_ADD(u1, 0x141);
        float w = (lane & 4) ? u1 : u0;
        MK_DPP_ADD(w, 0x1B);
        MK_DPP_ADD(w, 0xB1);
        if ((lane & 3) == 0) wl[(lane >> 4) * 36 + 4 * c + 2 * ((lane >> 2) & 1) + ((lane >> 3) & 1)] = w;
    }
    asm volatile("s_waitcnt lgkmcnt(0)" ::: "memory");
    if (lane < P6B_NR && !dry) {
        const LAS float* lg = wl + lane * 36;
        float gm = lg[0] + a.b_group[0]; int gs = 0; float l1 = lg[1] + a.b_group[1], l2 = lg[2] + a.b_group[2], l3 = lg[3] + a.b_group[3];
        const float l0 = gm;
        if (l1 > gm) { gm = l1; gs = 1; } if (l2 > gm) { gm = l2; gs = 2; } if (l3 > gm) { gm = l3; gs = 3; }
        const float gtop = 1.0f / (expf(l0 - gm) + expf(l1 - gm) + expf(l2 - gm) + expf(l3 - gm));
        float el[8];
#pragma unroll
        for (int i = 0; i < 8; ++i) el[i] = lg[4 + gs * 8 + i] + a.b_expert[gs * 8 + i];
        float b1 = el[0]; int i1 = 0;
#pragma unroll
        for (int i = 1; i < 8; ++i) if (el[i] > b1) { b1 = el[i]; i1 = i; }
        float b2 = -INFINITY; int i2 = 0;
#pragma unroll
        for (int i = 0; i < 8; ++i) if (i != i1 && el[i] > b2) { b2 = el[i]; i2 = i; }
        const float p2 = expf(b2 - b1), den = 1.0f + p2;
        const float w0 = gtop / den, w1 = gtop * p2 / den;
        const int e0 = gs * 8 + i1, e1 = gs * 8 + i2;
        const unsigned tok = (unsigned)(m0 + lane);
        const unsigned pos0 = atomicAdd(a.cnt + 64 * e0, 1u), pos1 = atomicAdd(a.cnt + 64 * e1, 1u);
        a.LIST[(size_t)e0 * 16384 + pos0] = (u32x2){tok, __float_as_uint(w0)};
        a.LIST[(size_t)e1 * 16384 + pos1] = (u32x2){tok | 0x80000000u, __float_as_uint(w1)};
    }
}
template <int ROLE> struct MoeSched {
    const u32x2* LIST; LAS int* tb; int G, c, NJ;
    unsigned* tilecnt;
    unsigned* tmo;
    int tlo, thi;
    __device__ __forceinline__ bool next(int i, pg8::Unit& u) const {
        if (c < 0) return false;
        const int L = i * G + c, TT = (thi < tb[32]) ? thi : tb[32];
        const int tg = tlo + L / NJ, j = L % NJ;
        if (tg >= TT) return false;
        int e = 0;
#pragma unroll 1
        for (int k = 1; k < 32; ++k) e += (tb[k] <= tg) ? 1 : 0;
        u.pm = tg; u.pn = e * NJ + j; return true;
    }
    __device__ __forceinline__ int arow(const pg8::Unit& u, int r) const {
        const int e = u.pn / NJ, idx = (u.pm - tb[e]) * 256 + r;
        return (idx < tb[33 + e]) ? (int)(LIST[(size_t)e * 16384 + idx].x & 0x7fffffffu) : 0;
    }
    __device__ __forceinline__ void a_ready(const pg8::Unit&) const {}
    __device__ __forceinline__ void done(const pg8::Unit& u) const {
        if (ROLE != 1) return;
        asm volatile("s_waitcnt vmcnt(0)" ::: "memory");
        if (mk_lane() == 0) __hip_atomic_fetch_add(tilecnt + 64 * u.pm, 1u, __ATOMIC_RELAXED, __HIP_MEMORY_SCOPE_AGENT);
    }
};
__device__ __forceinline__ void moe_wait(const MoeSched<2>& S) {
    if (mk_wave() == 0) {
        pg8::Unit u;
        for (int i = 0; S.next(i, u); ++i) {
            unsigned sp = 0;
            while ((unsigned)__builtin_amdgcn_readfirstlane(__hip_atomic_load(S.tilecnt + 64 * u.pm, __ATOMIC_RELAXED, __HIP_MEMORY_SCOPE_AGENT)) < 16u) {
                __builtin_amdgcn_s_sleep(2);
                if (++sp > (1u << 22)) { __hip_atomic_store(S.tmo, 1u, __ATOMIC_RELAXED, __HIP_MEMORY_SCOPE_AGENT); break; }
            }
        }
        __builtin_amdgcn_fence(__ATOMIC_ACQUIRE, "agent");
        asm volatile("s_waitcnt vmcnt(0)" ::: "memory");
    }
    __syncthreads();
}
__device__ __forceinline__ void moe_table(LAS int* tb, const unsigned* cnt, int tid) {
    __syncthreads();
    if (tid < 32) tb[33 + tid] = (int)__hip_atomic_load(cnt + 64 * tid, __ATOMIC_RELAXED, __HIP_MEMORY_SCOPE_AGENT);
    __syncthreads();
    if (tid == 0) { int s = 0; for (int e = 0; e < 32; ++e) { tb[e] = s; s += (tb[33 + e] + 255) >> 8; } tb[32] = s; }
    __syncthreads();
}
struct EpiGU {
    static constexpr bool PERM = true, AFTER_DRAIN = false;
    bf16_t* HID;
    __device__ __forceinline__ void operator()(const pg8::f32x4 (&acc)[2][2][4][2], const pg8::Unit& u, int wr, int wc, int fr, int fq) const {
        const int row0 = u.pm * 256 + wr * 64 + fr, hc0 = (u.pn & 1) * 128 + 16 * wc + 4 * fq;
#pragma unroll
        for (int ai = 0; ai < 2; ++ai)
#pragma unroll
            for (int m = 0; m < 4; ++m)
#pragma unroll
                for (int bj = 0; bj < 2; ++bj) {
                    const pg8::f32x4 g = acc[ai][bj][m][0], up = acc[ai][bj][m][1];
                    u32x2 w; w.x = cvt_pk(silu_f(g[0]) * up[0], silu_f(g[1]) * up[1]); w.y = cvt_pk(silu_f(g[2]) * up[2], silu_f(g[3]) * up[3]);
                    __hip_atomic_store((unsigned long long*)(HID + (size_t)(row0 + ai * 128 + m * 16) * 256 + hc0 + bj * 64), (unsigned long long)w.x | ((unsigned long long)w.y << 32), __ATOMIC_RELAXED, __HIP_MEMORY_SCOPE_AGENT);
                }
    }
};
struct EpiDown {
    static constexpr bool PERM = true, AFTER_DRAIN = false;
    bf16_t* Y; const u32x2* LIST; LAS int* tb;
    __device__ __forceinline__ void operator()(const pg8::f32x4 (&acc)[2][2][4][2], const pg8::Unit& u, int wr, int wc, int fr, int fq) const {
        const int e = u.pn >> 2, j = u.pn & 3, ti = u.pm - tb[e], cn = tb[33 + e];
        const int col0 = 256 * j + 32 * wc + 8 * fq;
        const int idx0 = ti * 256 + wr * 64 + fr;
#pragma unroll
        for (int ai = 0; ai < 2; ++ai) {
            u32x2 ent[4];
#pragma unroll
            for (int m = 0; m < 4; ++m) { const int idx = idx0 + ai * 128 + m * 16; ent[m] = (idx < cn) ? LIST[(size_t)e * 16384 + idx] : (u32x2){0xffffffffu, 0u}; }
#pragma unroll
            for (int m = 0; m < 4; ++m) {
                const u32x2 en = ent[m];
                if (en.x != 0xffffffffu) {
                    const float w = __uint_as_float(en.y);
                    bf16_t* dst = Y + ((size_t)(en.x >> 31) * T + (en.x & 0x7fffffffu)) * 1024 + col0;
#pragma unroll
                    for (int bj = 0; bj < 2; ++bj) {
                        const pg8::f32x4 v0 = acc[ai][bj][m][0] * w, v1 = acc[ai][bj][m][1] * w;
                        u32x4 o; o.x = cvt_pk(v0[0], v0[1]); o.y = cvt_pk(v0[2], v0[3]); o.z = cvt_pk(v1[0], v1[1]); o.w = cvt_pk(v1[2], v1[3]);
                        *(u32x4*)(dst + bj * 128) = o;
                    }
                }
            }
            asm volatile("" ::: "memory");
        }
    }
};
struct P8Row { u32x2 w0[4], w1[4], wm[4]; f32x4 xx[4]; };
__device__ __forceinline__ void p8_row_load(P8Row& R, const bf16_t* Y, const bf16_t* MIX, const float* x, int m, int lane) {
#pragma unroll
    for (int j = 0; j < 4; ++j) {
        R.w0[j] = *(const u32x2*)(Y + (size_t)m * 1024 + 4 * lane + 256 * j); R.w1[j] = *(const u32x2*)(Y + ((size_t)T + m) * 1024 + 4 * lane + 256 * j);
        R.wm[j] = *(const u32x2*)(MIX + (size_t)m * 1024 + 4 * lane + 256 * j);
    }
#pragma unroll
    for (int j = 0; j < 4; ++j) R.xx[j] = *(const f32x4*)(x + (size_t)m * 1024 + 4 * lane + 256 * j);
}
__device__ __forceinline__ void p8_rows(const bf16_t* Y, const bf16_t* MIX, const float* x, const float* g_post_mix, const float* g_post, const float* mod, float* out, int gw, int NGW, int lane) {
    if (gw >= T) return;
    P8Row R, Rn;
    p8_row_load(R, Y, MIX, x, gw, lane);
#pragma unroll 1
    for (int m = gw; m < T; m += NGW) {
        const bool has = m + NGW < T;
        if (has) p8_row_load(Rn, Y, MIX, x, m + NGW, lane);
        const int b = m / S;
        float v[16], mx[16]; float s = 0.f, sm = 0.f;
#pragma unroll
        for (int j = 0; j < 4; ++j) {
            const u32x2 w0 = R.w0[j], w1 = R.w1[j], wm = R.wm[j];
            v[4 * j + 0] = __uint_as_float(w0.x << 16) + __uint_as_float(w1.x << 16); v[4 * j + 1] = __uint_as_float(w0.x & 0xffff0000u) + __uint_as_float(w1.x & 0xffff0000u);
            v[4 * j + 2] = __uint_as_float(w0.y << 16) + __uint_as_float(w1.y << 16); v[4 * j + 3] = __uint_as_float(w0.y & 0xffff0000u) + __uint_as_float(w1.y & 0xffff0000u);
            mx[4 * j + 0] = __uint_as_float(wm.x << 16); mx[4 * j + 1] = __uint_as_float(wm.x & 0xffff0000u); mx[4 * j + 2] = __uint_as_float(wm.y << 16); mx[4 * j + 3] = __uint_as_float(wm.y & 0xffff0000u);
#pragma unroll
            for (int k = 0; k < 4; ++k) { s += v[4 * j + k] * v[4 * j + k]; sm += mx[4 * j + k] * mx[4 * j + k]; }
        }
        const float rs = 1.0f / sqrtf(wave_sum(s) * (1.f / 1024.f) + 1e-6f), rsm = 1.0f / sqrtf(wave_sum(sm) * (1.f / 1024.f) + 1e-6f);
        const float* md = mod + b * 6144;
#pragma unroll
        for (int j = 0; j < 4; ++j) {
            const int col = 4 * lane + 256 * j;
            const f32x4 xx = R.xx[j], gpm = *(const f32x4*)(g_post_mix + col), g1 = *(const f32x4*)(md + 2 * 1024 + col), gp = *(const f32x4*)(g_post + col), gg = *(const f32x4*)(md + 5 * 1024 + col);
            f32x4 o;
#pragma unroll
            for (int k = 0; k < 4; ++k) { const float hr = xx[k] + g1[k] * (mx[4 * j + k] * rsm * gpm[k]); o[k] = hr + gg[k] * (v[4 * j + k] * rs * gp[k]); }
            *(f32x4*)(out + (size_t)m * 1024 + col) = o;
        }
        if (has) R = Rn;
    }
}
constexpr size_t SC_BSTRIDE = (size_t)4096 * 64 * 65 / 2;
constexpr int SC_CHUNK = 8;
constexpr int SC_NUNITS = 4 * (1 * 8 + 2 * 8 + 3 * 8 + 4 * 8 + 5 * 8 + 6 * 8 + 7 * 8 + 8 * 8);
__device__ __forceinline__ size_t sc_off(int b, int qb) { return (size_t)b * SC_BSTRIDE + (size_t)4096 * (qb * (qb + 1) / 2); }
__device__ __forceinline__ void sc_build_units(unsigned* tab) {
    int n = 0;
    for (int pass = 0; pass < 2; ++pass)
        for (int sz = SC_CHUNK; sz >= 1; --sz)
            for (int b = 0; b < 4; ++b)
                for (int qb = 0; qb < 64; ++qb) {
                    const int nt = qb + 1, nc = (nt + SC_CHUNK - 1) / SC_CHUNK;
                    for (int c = 0; c < nc; ++c) {
                        const int t0 = c * SC_CHUNK, cnt = (nt - t0 < SC_CHUNK) ? nt - t0 : SC_CHUNK;
                        const bool full = (cnt == SC_CHUNK);
                        if ((pass == 0 && full && sz == SC_CHUNK) || (pass == 1 && !full && cnt == sz)) tab[n++] = (unsigned)b | ((unsigned)qb << 2) | ((unsigned)c << 8) | ((unsigned)cnt << 12);
                    }
                }
}
__device__ __forceinline__ unsigned key16_of(float sc) { sc += 0.0f; const unsigned u = __float_as_uint(sc); return ((u & 0x80000000u) ? ~u : (u | 0x80000000u)) >> 16; }
__device__ __forceinline__ void sc_decode(unsigned u, int& b, int& qb, int& c, int& nt) {
    b = u & 3; const int v = u >> 2;
    if (v < 232) { c = 0; int base = 0; while (v >= base + (57 - 8 * c)) { base += 57 - 8 * c; ++c; } qb = 8 * c + 7 + (v - base); nt = 8; }
    else { const int p = v - 232, size = 7 - (p >> 3); c = p & 7; qb = 8 * c + size - 1; nt = size; }
}
struct ScStage { u32x4 v[8]; };
__device__ __forceinline__ void sc_stage_load(ScStage& st, const bf16_t* KI, int b, int c, int nt, int tid) {
    const bf16_t* kbase = KI + ((size_t)b * S + (size_t)c * SC_CHUNK * 64 + (tid >> 3)) * 64 + (tid & 7) * 8;
#pragma unroll
    for (int t = 0; t < 8; ++t) if (t < nt) st.v[t] = *(const u32x4*)(kbase + (size_t)t * 64 * 64);
}
__device__ __forceinline__ void sc_stage_store(const ScStage& st, LAS unsigned char* buf, int nt, int tid) {
    const int skey = tid >> 3, sch = tid & 7;
    const unsigned st_off = (unsigned)(skey * 128 + ((sch ^ (skey & 7)) * 16));
#pragma unroll
    for (int t = 0; t < 8; ++t) if (t < nt) *(LAS u32x4*)(buf + t * 8192 + st_off) = st.v[t];
}
__device__ __forceinline__ void sc_compute(const LAS unsigned char* buf, const bf16_t* QI, const float* WI, unsigned short* SC, int b, int qb, int c, int ntile, int tid) {
    const int lane = tid & 63, w = __builtin_amdgcn_readfirstlane(tid >> 6), hh = lane >> 5, n32 = lane & 31;
    const int L = 64 * (qb + 1);
    const size_t tokq0 = (size_t)b * S + 64 * qb + 8 * w;
    bf16x8 af[2][4]; float wv[2][2][8];
    {
        const int u = 2 * ((n32 >> 2) & 1) + (n32 >> 4), h = (n32 & 3) + 4 * ((n32 >> 3) & 1);
#pragma unroll
        for (int mt = 0; mt < 2; ++mt) {
            const bf16_t* qp = QI + (tokq0 + 4 * mt + u) * 512 + h * 64 + 8 * hh;
#pragma unroll
            for (int ks = 0; ks < 4; ++ks) af[mt][ks] = *(const bf16x8*)(qp + 16 * ks);
#pragma unroll
            for (int j = 0; j < 2; ++j) {
                const float* wp = WI + (tokq0 + 4 * mt + 2 * hh + j) * 8;
                const f32x4 w0 = *(const f32x4*)wp, w1 = *(const f32x4*)(wp + 4);
                wv[mt][j][0] = w0[0]; wv[mt][j][1] = w0[1]; wv[mt][j][2] = w0[2]; wv[mt][j][3] = w0[3]; wv[mt][j][4] = w1[0]; wv[mt][j][5] = w1[1]; wv[mt][j][6] = w1[2]; wv[mt][j][7] = w1[3];
            }
        }
    }
    unsigned short* srow = SC + sc_off(b, qb) + (size_t)(8 * w) * L;
#pragma unroll 1
    for (int t = 0; t < ntile; ++t) {
        const LAS unsigned char* tb_ = buf + t * 8192;
        const int s0 = (c * SC_CHUNK + t) * 64;
#pragma unroll
        for (int nt = 0; nt < 2; ++nt) {
            bf16x8 bfr[4];
            const int key = 32 * nt + n32;
#pragma unroll
            for (int ks = 0; ks < 4; ++ks) bfr[ks] = *(const LAS bf16x8*)(tb_ + key * 128 + (((2 * ks + hh) ^ (key & 7)) * 16));
#pragma unroll
            for (int mt = 0; mt < 2; ++mt) {
                f32x16 acc = (f32x16){};
#pragma unroll
                for (int ks = 0; ks < 4; ++ks) acc = __builtin_amdgcn_mfma_f32_32x32x16_bf16(af[mt][ks], bfr[ks], acc, 0, 0, 0);
#pragma unroll
                for (int j = 0; j < 2; ++j) {
                    float sc = 0.f;
#pragma unroll
                    for (int h = 0; h < 8; ++h) { const int xi = (int)__float_as_uint(acc[8 * j + h]); sc = __builtin_fmaf(wv[mt][j][h], __uint_as_float((unsigned)(xi > 0 ? xi : 0)), sc); }
                    asm volatile("" : "+v"(sc));
                    srow[(size_t)(4 * mt + 2 * hh + j) * L + s0 + key] = (unsigned short)key16_of(sc);
                }
            }
        }
    }
}
__device__ __forceinline__ void sc_phase(LAS unsigned char* lds, volatile LAS unsigned* qslot, unsigned* qhead, const bf16_t* QI, const bf16_t* KI, const float* WI, unsigned short* SC, int tid) {
    __syncthreads();
    if (tid == 0) qslot[0] = atomicAdd(qhead, 1u);
    __syncthreads();
    unsigned ucur = qslot[0];
    if (ucur >= (unsigned)SC_NUNITS) return;
    int b, qb, c, nt; sc_decode(ucur, b, qb, c, nt);
    ScStage st;
    sc_stage_load(st, KI, b, c, nt, tid);
    sc_stage_store(st, lds, nt, tid);
    int p = 0;
    for (;;) {
        __syncthreads();
        if (tid == 0) qslot[0] = atomicAdd(qhead, 1u);
        __syncthreads();
        const unsigned unext = qslot[0];
        const bool has = unext < (unsigned)SC_NUNITS;
        int b2 = 0, qb2 = 0, c2 = 0, nt2 = 0;
        if (has) { sc_decode(unext, b2, qb2, c2, nt2); sc_stage_load(st, KI, b2, c2, nt2, tid); }
        sc_compute(lds + p * 65536, QI, WI, SC, b, qb, c, nt, tid);
        if (!has) break;
        sc_stage_store(st, lds + (p ^ 1) * 65536, nt2, tid);
        b = b2; qb = qb2; c = c2; nt = nt2; p ^= 1;
    }
}
__device__ __forceinline__ unsigned wave_sum_u32(unsigned x) {
    x += (unsigned)__builtin_amdgcn_update_dpp(0, (int)x, 0xB1, 0xf, 0xf, false);
    x += (unsigned)__builtin_amdgcn_update_dpp(0, (int)x, 0x4E, 0xf, 0xf, false);
    x += (unsigned)__builtin_amdgcn_update_dpp(0, (int)x, 0x141, 0xf, 0xf, false);
    x += (unsigned)__builtin_amdgcn_update_dpp(0, (int)x, 0x140, 0xf, 0xf, false);
    return (unsigned)__builtin_amdgcn_readlane((int)x, 0) + (unsigned)__builtin_amdgcn_readlane((int)x, 16) + (unsigned)__builtin_amdgcn_readlane((int)x, 32) + (unsigned)__builtin_amdgcn_readlane((int)x, 48);
}
__device__ __forceinline__ unsigned pk_subsat(unsigned w, unsigned c) { unsigned d; asm("v_pk_sub_u16 %0, %1, %2 clamp" : "=v"(d) : "v"(w), "v"(c)); return d; }
__device__ __forceinline__ unsigned pk_min(unsigned a, unsigned b) { unsigned d; asm("v_pk_min_u16 %0, %1, %2" : "=v"(d) : "v"(a), "v"(b)); return d; }
__device__ __forceinline__ unsigned pk_add(unsigned a, unsigned b) { unsigned d; asm("v_pk_add_u16 %0, %1, %2" : "=v"(d) : "v"(a), "v"(b)); return d; }
template <int NW> __device__ __forceinline__ unsigned cnt_ge(const unsigned (&kw)[32], unsigned cm1) {
    const unsigned one = 0x00010001u;
    unsigned a0 = 0u, a1 = 0u, a2 = 0u, a3 = 0u;
#pragma unroll
    for (int j = 0; j < NW; j += 4) {
        a0 = pk_add(a0, pk_min(pk_subsat(kw[j], cm1), one)); a1 = pk_add(a1, pk_min(pk_subsat(kw[j + 1], cm1), one));
        a2 = pk_add(a2, pk_min(pk_subsat(kw[j + 2], cm1), one)); a3 = pk_add(a3, pk_min(pk_subsat(kw[j + 3], cm1), one));
    }
    const unsigned a = pk_add(pk_add(a0, a1), pk_add(a2, a3));
    return wave_sum_u32((a & 0xffffu) + (a >> 16));
}
__device__ __forceinline__ unsigned pk_max(unsigned a, unsigned b) { unsigned d; asm("v_pk_max_u16 %0, %1, %2" : "=v"(d) : "v"(a), "v"(b)); return d; }
__device__ __forceinline__ unsigned wave_max_u32(unsigned x) {
    x = max(x, (unsigned)__builtin_amdgcn_update_dpp(0, (int)x, 0xB1, 0xf, 0xf, false));
    x = max(x, (unsigned)__builtin_amdgcn_update_dpp(0, (int)x, 0x4E, 0xf, 0xf, false));
    x = max(x, (unsigned)__builtin_amdgcn_update_dpp(0, (int)x, 0x141, 0xf, 0xf, false));
    x = max(x, (unsigned)__builtin_amdgcn_update_dpp(0, (int)x, 0x140, 0xf, 0xf, false));
    return max(max((unsigned)__builtin_amdgcn_readlane((int)x, 0), (unsigned)__builtin_amdgcn_readlane((int)x, 16)), max((unsigned)__builtin_amdgcn_readlane((int)x, 32), (unsigned)__builtin_amdgcn_readlane((int)x, 48)));
}
template <int NW> __device__ __forceinline__ unsigned sel_query(const unsigned (&kw)[32], int lane) {
    unsigned mx = 0u;
#pragma unroll
    for (int j = 0; j < NW; ++j) mx = pk_max(mx, kw[j]);
    unsigned hi = wave_max_u32(max(mx & 0xffffu, mx >> 16)) + 1u;
    unsigned width = 384u, lo = (hi > width) ? hi - width : 1u;
#pragma unroll 1
    while (cnt_ge<NW>(kw, (lo - 1u) * 0x00010001u) < 256u) { hi = lo; width *= 8u; lo = (hi > width) ? hi - width : 1u; }
#pragma unroll 1
    while (hi - lo > 1u) {
        const unsigned mid = (lo + hi) >> 1;
        if (cnt_ge<NW>(kw, (mid - 1u) * 0x00010001u) >= 256u) lo = mid; else hi = mid;
    }
    const unsigned T = lo;
    const unsigned need = 256u - cnt_ge<NW>(kw, T * 0x00010001u);
    unsigned run = 0u, cidx = 0xffffu; bool found = false;
#pragma unroll
    for (int j = 0; j < NW; ++j) {
        if (!found) {
            const bool e0 = (kw[j] & 0xffffu) == T, e1 = (kw[j] >> 16) == T;
            const unsigned long long m0 = __ballot(e0), m1 = __ballot(e1);
            const unsigned cm = (unsigned)__builtin_popcountll(m0) + (unsigned)__builtin_popcountll(m1);
            if (run + cm >= need) {
                const unsigned rank = __builtin_amdgcn_mbcnt_hi((unsigned)(m0 >> 32), __builtin_amdgcn_mbcnt_lo((unsigned)m0, 0u)) + __builtin_amdgcn_mbcnt_hi((unsigned)(m1 >> 32), __builtin_amdgcn_mbcnt_lo((unsigned)m1, 0u));
                const unsigned tg = need - run - 1u;
                const unsigned long long h0 = __ballot(e0 && rank == tg), h1 = __ballot(e1 && rank + (e0 ? 1u : 0u) == tg);
                cidx = (unsigned)(128 * j) + (h0 ? 2u * (unsigned)__builtin_ctzll(h0) : 2u * (unsigned)__builtin_ctzll(h1) + 1u);
                found = true;
            }
            run += cm;
        }
    }
    return T | (cidx << 16);
}
template <int NW> __device__ __forceinline__ unsigned sel_row(const unsigned* row32, int n, int lane) {
    unsigned kw[32];
#pragma unroll
    for (int j = 0; j < 32; ++j) {
        unsigned v = 0u;
        if (j < NW) { const int s = 128 * j + 2 * lane; v = (s < n) ? row32[64 * j + lane] : 0u; if (s + 1 >= n) v &= 0xffffu; }
        kw[j] = v;
    }
    return sel_query<NW>(kw, lane);
}
__device__ __forceinline__ void sel_block(LAS unsigned char* lds, const unsigned short* SC, unsigned* THR, unsigned* MASKT, int blk, int tid, int mode = 3) {
    const int b = blk >> 6, qb = blk & 63, lane = tid & 63, w = __builtin_amdgcn_readfirstlane(tid >> 6);
    const int L = 64 * (qb + 1);
    const unsigned short* slab = SC + sc_off(b, qb);
    LAS unsigned* thr_l = (LAS unsigned*)lds;
    __syncthreads();
    if (mode & 1)
#pragma unroll 1
    for (int qi = 0; qi < 8; ++qi) {
        const int ql = 8 * w + qi, tq = 64 * qb + ql, n = tq + 1;
        const unsigned short* row = slab + (size_t)ql * L;
        const int nw = (n + 127) >> 7;
        const unsigned* row32 = (const unsigned*)row;
        unsigned th = 0u;
        if (n > 256) { if (nw <= 8) th = sel_row<8>(row32, n, lane); else if (nw <= 16) th = sel_row<16>(row32, n, lane); else if (nw <= 24) th = sel_row<24>(row32, n, lane); else th = sel_row<32>(row32, n, lane); }
        if (lane == 0) { thr_l[ql] = th; THR[(size_t)b * S + tq] = th; }
    }
    __syncthreads();
    const int ntl = 4 * ((2 * qb) >> 3) + 4;
    if (mode & 2)
    for (int it = w; it < 2 * ntl; it += NWAVES) {
        const int g = it / ntl, t = it - g * ntl, qg = 2 * qb + g;
        unsigned W = 0u;
        if (t <= qb) {
            const int ii = lane & 15, cc = (lane >> 4) & 1, hh = lane >> 5;
            const int s = 64 * t + 32 * cc + (ii & 3) + 8 * (ii >> 2) + 4 * hh;
            unsigned kk[32];
#pragma unroll
            for (int q = 0; q < 32; ++q) kk[q] = (unsigned)slab[(size_t)(32 * g + q) * L + s];
#pragma unroll
            for (int q = 0; q < 32; ++q) {
                const int ql = 32 * g + q, tq = 64 * qb + ql;
                const unsigned th = thr_l[ql], T = th & 0xffffu, cidx = th >> 16;
                const unsigned k = kk[q];
                const bool p = (s <= tq) && (k > T || (k == T && (unsigned)s <= cidx));
                const unsigned long long m = __ballot(p);
                W = (lane == q) ? (unsigned)m : ((lane == 32 + q) ? (unsigned)(m >> 32) : W);
            }
        }
        MASKT[(((size_t)b * 128 + qg) * 64 + t) * 64 + lane] = W;
    }
}

__device__ __forceinline__ void sel_queries_balanced(const unsigned short* SC, unsigned* THR, int gw, int lane) {
#pragma unroll 1
    for (int k = 0; k < 8; ++k) {
        const int b = k >> 1, tq = (k & 1) ? (S - 1 - gw) : gw, n = tq + 1, qb = tq >> 6, L = 64 * (qb + 1);
        const unsigned* row32 = (const unsigned*)(SC + sc_off(b, qb) + (size_t)(tq & 63) * L);
        const int nw = (n + 127) >> 7;
        unsigned th = 0u;
        if (n > 256) { if (nw <= 8) th = sel_row<8>(row32, n, lane); else if (nw <= 16) th = sel_row<16>(row32, n, lane); else if (nw <= 24) th = sel_row<24>(row32, n, lane); else th = sel_row<32>(row32, n, lane); }
        if (lane == 0) THR[(size_t)b * S + tq] = th;
    }
}
constexpr int MSK_PER_B = 4352, MSK_UNITS = 4 * MSK_PER_B;
struct MskUnit { int b, qg, t; unsigned thv; unsigned kk[32]; };
__device__ __forceinline__ void mask_unit_load(MskUnit& m, const unsigned short* SC, const unsigned* THR, int u, int lane) {
    m.b = u / MSK_PER_B; const int v = u - m.b * MSK_PER_B;
    int g8 = 0;
#pragma unroll 1
    for (int j = 1; j < 16; ++j) g8 += (16 * j * (j + 1) <= v) ? 1 : 0;
    const int rem = v - 16 * g8 * (g8 + 1), per = 4 * g8 + 4, q7 = rem / per;
    m.t = rem - q7 * per; m.qg = 8 * g8 + q7;
    const int qb = m.qg >> 1, g = m.qg & 1;
    if (m.t <= qb) {
        const int L = 64 * (qb + 1);
        const unsigned short* slab = SC + sc_off(m.b, qb);
        const int ii = lane & 15, cc = (lane >> 4) & 1, hh = lane >> 5;
        const int s = 64 * m.t + 32 * cc + (ii & 3) + 8 * (ii >> 2) + 4 * hh;
        m.thv = THR[(size_t)m.b * S + 32 * m.qg + (lane & 31)];
#pragma unroll
        for (int q = 0; q < 32; ++q) m.kk[q] = (unsigned)slab[(size_t)(32 * g + q) * L + s];
    }
}
__device__ __forceinline__ void mask_unit_emit(const MskUnit& m, unsigned* MASKT, int lane) {
    const int qb = m.qg >> 1;
    unsigned W = 0u;
    if (m.t <= qb) {
        const int ii = lane & 15, cc = (lane >> 4) & 1, hh = lane >> 5;
        const int s = 64 * m.t + 32 * cc + (ii & 3) + 8 * (ii >> 2) + 4 * hh;
#pragma unroll
        for (int q = 0; q < 32; ++q) {
            const int tq = 32 * m.qg + q;
            const unsigned th = (unsigned)__builtin_amdgcn_readlane((int)m.thv, q), T = th & 0xffffu, cidx = th >> 16;
            const unsigned k = m.kk[q];
            const bool p = (s <= tq) && (k > T || (k == T && (unsigned)s <= cidx));
            const unsigned long long mm = __ballot(p);
            W = (lane == q) ? (unsigned)mm : ((lane == 32 + q) ? (unsigned)(mm >> 32) : W);
        }
    }
    MASKT[(((size_t)m.b * 128 + m.qg) * 64 + m.t) * 64 + lane] = W;
}
__device__ __forceinline__ void mask_units(const unsigned short* SC, const unsigned* THR, unsigned* MASKT, int u0, int stride, int lane) {
    if (u0 >= MSK_UNITS) return;
    MskUnit a, bnext;
    mask_unit_load(a, SC, THR, u0, lane);
#pragma unroll 1
    for (int u = u0; u < MSK_UNITS; u += stride) {
        const bool has = u + stride < MSK_UNITS;
        if (has) mask_unit_load(bnext, SC, THR, u + stride, lane);
        mask_unit_emit(a, MASKT, lane);
        if (has) a = bnext;
    }
}
struct Args { const void* in[18]; float* out; unsigned char* ws; int ph_lo, ph_hi, li, pad; };
constexpr int N_PHASES = 12;
__global__ void __launch_bounds__(NTHR, 2) mega(Args args) {
    extern __shared__ __attribute__((aligned(16))) unsigned char lds_raw[];
    LAS unsigned char* lds = (LAS unsigned char*)lds_raw;
    const int G = gridDim.x, bid = blockIdx.x;
#define MK_IDS() const int wave = mk_wave(), lane = mk_lane(), tid = wave * 64 + lane; (void)lane; (void)tid; (void)wave
    unsigned char* ws = args.ws;
    unsigned* ctl = (unsigned*)(ws + WS_CTL);
    volatile LAS unsigned* MISC = (volatile LAS unsigned*)(lds + MISC_OFF);
    { const int t0 = (int)threadIdx.x;
      for (int u = t0; u < (LDS_BYTES - RING_BYTES) / 4; u += NTHR) ((LAS unsigned*)(lds + RING_BYTES))[u] = 0u;
      __syncthreads();
      if ((t0 & 63) == 0) ((LAS unsigned char*)(lds + MK_SLOTMAP_OFF))[mk_hwslot()] = (unsigned char)(t0 >> 6); }
    __syncthreads();
    XcdBarrier bar = xcd_barrier_post(ctl + CW_BAR + args.li * XCD_BAR_WORDS, MISC + 8);
    const int lo = args.ph_lo, hi = args.ph_hi;
#ifndef DUP_MASK
#define DUP_MASK 0
#endif
#define REP(k) for (int rep_ = 0; rep_ < (((DUP_MASK) >> (k)) & 1) + 1; ++rep_)
#define IN(k) (lo <= (k) && (k) < hi)
#define BOTH(k) (IN(k) && IN((k) + 1))
    const float* x = (const float*)args.in[0];
    float* mod = (float*)(ws + WS_MOD);
    bf16_t* Hb = (bf16_t*)(ws + WS_H);
    bf16_t* WIN = (bf16_t*)(ws + WS_WIN);
    bf16_t* WOUT = (bf16_t*)(ws + WS_WOUT);
    float* R128 = (float*)(ws + WS_R128);
    float* R64 = (float*)(ws + WS_R64);
    bf16_t* WGU = (bf16_t*)args.out; bf16_t* WD = WGU + (size_t)32 * 512 * 1024;

    const P0Args p0a{(const float*)args.in[1], (const float*)args.in[4], (const float*)args.in[5], (const float*)args.in[6], (const float*)args.in[7], (const float*)args.in[14], (const float*)args.in[15], (const float*)args.in[16],
                 (const int*)args.in[2], mod, R128, R64, WIN, WOUT, WGU, WD};
    if (IN(0)) {
        MK_IDS();
        REP(0) p0_prologue(lds, p0a, bid, G, tid);
        if (BOTH(0)) xcd_barrier(bar);
    }
    if (IN(1)) {
        MK_IDS();
        REP(1) p1_rows(x, (const float*)args.in[3], mod, Hb, bid * NWAVES + wave, G * NWAVES, lane);
        if ((DUP_MASK >> 15) & 1) { for (int k = 0; k < 10; ++k) xcd_barrier(bar); }
        if (BOTH(1)) xcd_barrier(bar);
    }
    if (IN(2)) {
        MK_IDS();
#ifdef PROBE_SKIP_TILE8
        struct Skip8 : pg8::StaticOrder { __device__ bool next(int i, pg8::Unit& u) const { if (!pg8::StaticOrder::next(i, u)) return false; if (u.pn >= 8) ++u.pn; return true; } };
        pg8::Gemm g{Hb, WIN, T, NPHYS, 1024}; Skip8 So; So.init(T, NPHYS - 256, G, bid);
#define PG8_P2_SCHED Skip8
#else
        pg8::Gemm g{Hb, WIN, T, NPHYS, 1024}; pg8::StaticOrder So; So.init(T, NPHYS, G, bid);
#define PG8_P2_SCHED pg8::StaticOrder
#endif
        EpiInProj E{(bf16_t*)(ws + WS_QA), (bf16_t*)(ws + WS_KA), (bf16_t*)(ws + WS_VA), (bf16_t*)(ws + WS_QI), (bf16_t*)(ws + WS_KI), (bf16_t*)(ws + WS_QR), (bf16_t*)(ws + WS_KR),
                    (bf16_t*)(ws + WS_VR), (bf16_t*)(ws + WS_GR), (float*)(ws + WS_WI), R64, R128};
        pg8::gemm_phase<EpiInProj, PG8_P2_SCHED, true, true>(lds, g, So, E);
        if ((DUP_MASK >> 2) & 1) { __syncthreads(); pg8::gemm_phase<EpiInProj, PG8_P2_SCHED, true, true>(lds, g, So, E); }
        if (args.li != 0) {   }
        else if (G == 256) { if (bid >= 64) { __syncthreads(); p0_expert_items(lds, p0a, (bid - 64) * NWAVES + wave, 192 * NWAVES, tid); } }
        else { __syncthreads(); p0_expert_items(lds, p0a, bid * NWAVES + wave, G * NWAVES, tid); }
        if (BOTH(2)) xcd_barrier(bar);
    }
    bf16_t* QR = (bf16_t*)(ws + WS_QR); bf16_t* KR = (bf16_t*)(ws + WS_KR); bf16_t* VR = (bf16_t*)(ws + WS_VR); bf16_t* GR = (bf16_t*)(ws + WS_GR);
    const bf16_t* QI = (const bf16_t*)(ws + WS_QI); const bf16_t* KI = (const bf16_t*)(ws + WS_KI); const float* WI = (const float*)(ws + WS_WI);
    unsigned short* SCORES = (unsigned short*)(ws + WS_SCORES); unsigned* THR = (unsigned*)(ws + WS_THR); unsigned* MASKT = (unsigned*)(ws + WS_MASKT);
    float* KVS = (float*)(ws + WS_KVS); bf16_t* RT = WD + (size_t)32 * 1024 * 256;
    bf16_t* MIXED = (bf16_t*)(ws + WS_MIXED);
    if (IN(3)) {
        MK_IDS();
        REP(3) {
        for (int p = bid; p < 256; p += G) ret_kv_pair(lds, KR, VR, KVS, p, tid);
        sc_phase(lds, MISC + 16, ctl + CW_Q + 64 * rep_, QI, KI, WI, SCORES, tid);
        }
        if (BOTH(3)) xcd_barrier(bar);
    }
    if (IN(4)) {
        MK_IDS();
        ret_scan(KVS, RT, bid * NTHR + tid, G * NTHR);
        for (int gw = bid * NWAVES + wave; gw < 2048; gw += G * NWAVES) sel_queries_balanced(SCORES, THR, gw, lane);
        if ((DUP_MASK >> 12) & 1) for (int gw = bid * NWAVES + wave; gw < 2048; gw += G * NWAVES) sel_queries_balanced(SCORES, THR, gw, lane);
        if (BOTH(4)) xcd_barrier(bar);
    }
    if (IN(5)) {
        MK_IDS();
        mask_units(SCORES, THR, MASKT, bid * NWAVES + wave, G * NWAVES, lane);
        if ((DUP_MASK >> 13) & 1) mask_units(SCORES, THR, MASKT, bid * NWAVES + wave, G * NWAVES, lane);
        if (BOTH(5)) xcd_barrier(bar);
    }
    if (IN(6)) {
        MK_IDS();
        {
        for (int p = bid; p < 256; p += G) ret_out_pair(lds, QR, KR, VR, GR, RT, MIXED, p, tid);
        if ((DUP_MASK >> 14) & 1) for (int p = bid; p < 256; p += G) ret_out_pair(lds, QR, KR, VR, GR, RT, MIXED, p, tid);
        asm volatile("s_waitcnt vmcnt(0) lgkmcnt(0)" ::: "memory");
        __syncthreads();
        {
            const attn_body::AttnTensors AT{(const attn_body::bf16*)(ws + WS_QA), (const attn_body::bf16*)(ws + WS_KA), (const attn_body::bf16*)(ws + WS_VA), (attn_body::bf16*)MIXED, (const unsigned*)MASKT};
            const attn_body::StaticOrder So((int)G, (int)bid);
            attn_body::attn_phase<attn_body::StaticOrder>((char*)lds_raw, AT, So);
        }
        __syncthreads();
        }
        if ((DUP_MASK >> 5) & 1) {
        for (int p = bid; p < 256; p += G) ret_out_pair(lds, QR, KR, VR, GR, RT, MIXED, p, tid);
        asm volatile("s_waitcnt vmcnt(0) lgkmcnt(0)" ::: "memory");
        __syncthreads();
        {
            const attn_body::AttnTensors AT{(const attn_body::bf16*)(ws + WS_QA), (const attn_body::bf16*)(ws + WS_KA), (const attn_body::bf16*)(ws + WS_VA), (attn_body::bf16*)MIXED, (const unsigned*)MASKT};
            const attn_body::StaticOrder So((int)G, (int)bid);
            attn_body::attn_phase<attn_body::StaticOrder>((char*)lds_raw, AT, So);
        }
        __syncthreads();
        }
        if (BOTH(6)) xcd_barrier(bar);
    }
    bf16_t* MIX = (bf16_t*)(ws + WS_MIX); bf16_t* H2 = (bf16_t*)(ws + WS_H2); u32x2* LIST = (u32x2*)(ws + WS_LIST); bf16_t* HID = (bf16_t*)(ws + WS_HID);
    bf16_t* Y = (bf16_t*)(ws + WS_Y); float* HRES = (float*)(ws + WS_HRES);
    LAS int* tb = (LAS int*)(lds + TB_OFF);
    if (IN(7)) {
        MK_IDS();
        pg8::Gemm g{MIXED, WOUT, T, 1024, 1024}; pg8::StaticOrder So; So.init(T, 1024, G, bid);
        EpiStore E{MIX, 1024};
        pg8::gemm_phase<EpiStore, pg8::StaticOrder, true, true>(lds, g, So, E);
        if ((DUP_MASK >> 6) & 1) { __syncthreads(); pg8::gemm_phase<EpiStore, pg8::StaticOrder, true, true>(lds, g, So, E); }
        if (BOTH(7)) xcd_barrier(bar);
    }
    if (IN(8)) {
        MK_IDS();
        P6bArgs a{MIX, x, (const float*)args.in[8], (const float*)args.in[9], mod, (const float*)args.in[10], (const float*)args.in[11], (const float*)args.in[12], (const float*)args.in[13], HRES, H2, ctl + CW_CNT, LIST};
        p6b_load_weights(lds, a.w_group, a.w_expert, tid);
        REP(8) for (int gw = bid * NWAVES + wave; gw < T / P6B_NR; gw += G * NWAVES) p6b_rows8(a, lds, (LAS float*)(lds + RT_WL_OFF + wave * 576), gw, lane, rep_ != 0);
        if (BOTH(8)) xcd_barrier(bar);
    }
    if (IN(9)) {
        MK_IDS();
        moe_table(tb, ctl + CW_CNT, tid);
        pg8::Gemm g{H2, WGU, T, 32 * 512, 1024}; MoeSched<1> So{LIST, tb, G, bid, 2, ctl + CW_TILE, ctl + CW_TMO, 0, 1 << 20};
        EpiGU E{HID};
        pg8::gemm_phase_ga<EpiGU, MoeSched<1>>(lds, g, So, E);
        if ((DUP_MASK >> 8) & 1) { __syncthreads(); pg8::gemm_phase_ga<EpiGU, MoeSched<1>>(lds, g, So, E); }
        __syncthreads();
    }
    if (IN(10)) {
        MK_IDS();
        moe_table(tb, ctl + CW_CNT, tid);
        const int n2 = (tb[32] * 2 > G && tb[32] * 2 < 2 * G) ? tb[32] * 2 - G : 0;
        const int t1 = G / 2;
        pg8::Gemm g{HID, WD, T, 32 * 1024, 256};
        EpiDown E{Y, LIST, tb};
        { MoeSched<2> So{LIST, tb, G - n2, bid - n2, 4, ctl + CW_TILE, ctl + CW_TMO, 0, t1}; moe_wait(So); pg8::gemm_phase<EpiDown, MoeSched<2>, true, true>(lds, g, So, E); }
        { MoeSched<2> So{LIST, tb, G - n2, bid - n2, 4, ctl + CW_TILE, ctl + CW_TMO, t1, 1 << 20}; moe_wait(So); pg8::gemm_phase<EpiDown, MoeSched<2>, true, true>(lds, g, So, E); }
        if (BOTH(10)) xcd_barrier(bar);
    }
    if (IN(11)) {
        MK_IDS();
        REP(11) p8_rows(Y, MIX, x, (const float*)args.in[8], (const float*)args.in[17], mod, args.out, bid * NWAVES + wave, G * NWAVES, lane);
    }
#undef IN
#undef BOTH
}
}
extern "C" void kernel_launch(void* const* d_in, const int* in_sizes, int n_in, void* d_out, int out_size, void* d_ws, size_t ws_size, hipStream_t stream) {
    using namespace mk;
    static int grid = 0;
    if (grid == 0) {
        int dev = 0, cus = 0, per_cu = 0;
        if (n_in != 18 || out_size != T * D || ws_size < (size_t)256 * MiB) { fprintf(stderr, "kernel_launch: unexpected problem shape (n_in %d, out %d, ws %zu)\n", n_in, out_size, ws_size); grid = -1; return; }
        if (hipGetDevice(&dev) != hipSuccess || hipDeviceGetAttribute(&cus, hipDeviceAttributeMultiprocessorCount, dev) != hipSuccess) { fprintf(stderr, "kernel_launch: device query failed\n"); grid = -1; return; }
        if (hipFuncSetAttribute((const void*)mega, hipFuncAttributeMaxDynamicSharedMemorySize, LDS_BYTES) != hipSuccess) { fprintf(stderr, "kernel_launch: hipFuncSetAttribute failed\n"); grid = -1; return; }
        if (hipOccupancyMaxActiveBlocksPerMultiprocessor(&per_cu, (const void*)mega, NTHR, LDS_BYTES) != hipSuccess || per_cu < 1) fprintf(stderr, "kernel_launch: occupancy query reports %d\n", per_cu);
        (void)hipGetLastError();
        grid = cus;
    }
    if (grid < 0) return;
    unsigned char* ws = (unsigned char*)d_ws;
    (void)hipMemsetAsync(ws + WS_CTL, 0, CTL_BYTES, stream);
    Args a{};
    for (int i = 0; i < 18; ++i) a.in[i] = d_in[i];
    a.out = (float*)d_out; a.ws = ws; a.ph_lo = 0; a.ph_hi = N_PHASES; a.li = 0; a.pad = 0;
    hipLaunchKernelGGL(mega, dim3(grid), dim3(NTHR), LDS_BYTES, stream, a);
#ifdef EXTRA_PHASE
#ifndef EXTRA_HI
#define EXTRA_HI (EXTRA_PHASE + 1)
#endif
    a.ph_lo = EXTRA_PHASE; a.ph_hi = EXTRA_HI; a.li = 1;
    hipLaunchKernelGGL(mega, dim3(grid), dim3(NTHR), LDS_BYTES, stream, a);
#endif
}
```

```cpp
#include <hip/hip_runtime.h>
#include <cstdio>
#include <cstdint>
#define DUP_MASK 0
#define MK_SLOTMAP_OFF (163840 - 256)
__device__ __forceinline__ unsigned mk_hwslot() { return (unsigned)__builtin_amdgcn_s_getreg((5 << 11) | 4) & 63u; }
__device__ __forceinline__ int mk_wave() { return __builtin_amdgcn_readfirstlane((int)((const __attribute__((address_space(3))) unsigned char*)(unsigned)MK_SLOTMAP_OFF)[mk_hwslot()]); }
__device__ __forceinline__ int mk_lane() { return (int)__builtin_amdgcn_mbcnt_hi(~0u, __builtin_amdgcn_mbcnt_lo(~0u, 0u)); }
__device__ __forceinline__ int mk_tidx() { return mk_wave() * 64 + mk_lane(); }
namespace pg8 {
#define PG8_LAS __attribute__((address_space(3)))
typedef unsigned short bf16_t;
typedef short bf16x8 __attribute__((ext_vector_type(8)));
typedef float f32x4 __attribute__((ext_vector_type(4)));
typedef unsigned u32x4 __attribute__((ext_vector_type(4)));
constexpr int BM = 256, BK = 64, HALF = 128, HTB = HALF * BK * 2  , STAGE_BYTES = 8 * HTB, NXCD = 8, WGM = 8;

__host__ __device__ __forceinline__ int lds_byte(int r, int c) { const int st = (r >> 4) * 2 + (c >> 5), rr = r & 15, cc = c & 31, ob = rr * 64 + cc * 2; return st * 1024 + (ob ^ (((ob >> 9) & 1) << 5)); }
__host__ __device__ __forceinline__ void stage_rc(int b, int& R, int& C) { const int st = b / 1024, sb = b % 1024, swz = sb ^ (((sb >> 9) & 1) << 5); R = (st >> 1) * 16 + swz / 64; C = (st & 1) * 32 + (swz % 64) / 2; }
__host__ __device__ __forceinline__ int perm32(int rho) { const int n = rho >> 4, i = rho & 15; return 8 * (i >> 2) + 4 * n + (i & 3); }

struct Unit { int pm, pn; };
struct Gemm { const bf16_t* A; const bf16_t* Bt; int M, N, K; };

struct StaticOrder {
    int nM, nN, nwg, G, c;
    __host__ __device__ void init(int M, int N, int G_, int c_) { nM = M / BM; nN = N / BM; nwg = nM * nN; G = G_; c = c_; }
    __host__ __device__ bool next(int i, Unit& u) const {
        const long L = (long)i * G + c; if (L >= nwg) return false;
        int wgid = (int)L; { const int q = nwg / NXCD, r = nwg % NXCD, xcd = wgid % NXCD, off = wgid / NXCD; wgid = (xcd < r ? xcd * (q + 1) : r * (q + 1) + (xcd - r) * q) + off; }
        const int nig = WGM * nN, gid = wgid / nig, fm = gid * WGM, gsz = (nM - fm) < WGM ? (nM - fm) : WGM;
        u.pm = fm + ((wgid % nig) % gsz); u.pn = (wgid % nig) / gsz; return true;
    }
    __device__ __forceinline__ void a_ready(const Unit&) const {}
    __device__ __forceinline__ void done(const Unit&) const {}
};
template <class Epi, class Sched, bool ALIGN_EPI = false, bool SP2 = false>
__device__ __forceinline__ void gemm_phase(PG8_LAS unsigned char* lds, const Gemm g, const Sched& S, const Epi& E) {
    const int tid = mk_tidx(), wid = __builtin_amdgcn_readfirstlane(tid >> 6), lane = tid & 63, wr = wid >> 2, wc = wid & 3, fr = lane & 15, fq = lane >> 4;
    const int K = g.K, nt = K / BK;
    unsigned voffA[2], voffB[2];
#pragma unroll
    for (int i = 0; i < 2; ++i) { int R, C; stage_rc(tid * 16 + i * 8192, R, C); const int Rb = Epi::PERM ? ((R & ~31) + perm32(R & 31)) : R;
        voffA[i] = (unsigned)(R * K + C) * 2u; voffB[i] = (unsigned)(Rb * K + C) * 2u; }
    const size_t kstep = (size_t)(BK * 2);
    const size_t hstep = (size_t)HALF * K * 2;
    const size_t tstep = 2 * hstep;
    const unsigned ldsw = (unsigned)wid * 1024u;
    const int aoff = lds_byte(wr * 64 + fr, fq * 8), boff = lds_byte(wc * 32 + fr, fq * 8);
#define PG8_SA(b, h) (((b) * 2 + (h)) * HTB)
#define PG8_SB(b, h) ((4 + (b) * 2 + (h)) * HTB)
#define PG8_STAGE(bufoff, gbase, voff) do { _Pragma("unroll") for (int _i = 0; _i < 2; ++_i) \
        __builtin_amdgcn_global_load_lds((const unsigned*)((const char*)(gbase) + (voff)[_i]), (PG8_LAS unsigned*)(lds + (bufoff) + ldsw + _i * 8192), 16, 0, 0); } while (0)
#define PG8_LDA(dst, b, h) do { _Pragma("unroll") for (int m = 0; m < 4; ++m) _Pragma("unroll") for (int k = 0; k < 2; ++k) dst[m][k] = *(const PG8_LAS bf16x8*)(lds + PG8_SA(b, h) + aoff + m * 2048 + k * 1024); } while (0)
#define PG8_LDB(dst, b, h) do { _Pragma("unroll") for (int n = 0; n < 2; ++n) _Pragma("unroll") for (int k = 0; k < 2; ++k) dst[n][k] = *(const PG8_LAS bf16x8*)(lds + PG8_SB(b, h) + boff + n * 2048 + k * 1024); } while (0)
#define PG8_MMA(ai, bj, At, Bt) do { __builtin_amdgcn_s_setprio(1); _Pragma("unroll") for (int m = 0; m < 4; ++m) _Pragma("unroll") for (int n = 0; n < 2; ++n) _Pragma("unroll") for (int k = 0; k < 2; ++k) \
        acc[ai][bj][m][n] = __builtin_amdgcn_mfma_f32_16x16x32_bf16(Bt[n][k], At[m][k], acc[ai][bj][m][n], 0, 0, 0); __builtin_amdgcn_s_setprio(0); } while (0)
#define PG8_WAIT_V(n) asm volatile("s_waitcnt vmcnt(" #n ")" ::: "memory")
#define PG8_WAIT_L(n) asm volatile("s_waitcnt lgkmcnt(" #n ")" ::: "memory")
#define PG8_BAR __builtin_amdgcn_s_barrier()
#define PG8_SCHED __builtin_amdgcn_sched_barrier(0)
    Unit cur, nxt; int ui = 0;
    if (!S.next(0, cur)) return;
    f32x4 acc[2][2][4][2];
#pragma unroll
    for (int a = 0; a < 2; ++a)
#pragma unroll
        for (int b = 0; b < 2; ++b)
#pragma unroll
            for (int m = 0; m < 4; ++m)
#pragma unroll
                for (int n = 0; n < 2; ++n) acc[a][b][m][n] = (f32x4){0.f, 0.f, 0.f, 0.f};
    bf16x8 At[4][2], B0[2][2], B1[2][2];
    const char* cA = (const char*)g.A + (size_t)cur.pm * tstep; const char* cB = (const char*)g.Bt + (size_t)cur.pn * tstep;
    S.a_ready(cur);
    if constexpr (SP2) {
        PG8_STAGE(PG8_SB(0, 0), cB, voffB); PG8_STAGE(PG8_SB(0, 1), cB + hstep, voffB); PG8_STAGE(PG8_SA(0, 0), cA, voffA); PG8_STAGE(PG8_SA(0, 1), cA + hstep, voffA);
        if (wr == 1) PG8_BAR;
        PG8_WAIT_V(2); PG8_BAR;
        PG8_STAGE(PG8_SB(1, 0), cB + kstep, voffB); PG8_STAGE(PG8_SA(1, 0), cA + kstep, voffA); PG8_STAGE(PG8_SB(1, 1), cB + hstep + kstep, voffB);
        PG8_WAIT_V(6); PG8_BAR;
    } else {
        PG8_STAGE(PG8_SB(0, 0), cB, voffB); PG8_STAGE(PG8_SA(0, 0), cA, voffA); PG8_STAGE(PG8_SB(0, 1), cB + hstep, voffB); PG8_STAGE(PG8_SA(0, 1), cA + hstep, voffA);
        if (wr == 1) PG8_BAR;
        PG8_WAIT_V(4); PG8_BAR;
        PG8_STAGE(PG8_SB(1, 0), cB + kstep, voffB); PG8_STAGE(PG8_SA(1, 0), cA + kstep, voffA); PG8_STAGE(PG8_SB(1, 1), cB + hstep + kstep, voffB);
        PG8_WAIT_V(6); PG8_BAR;
    }
    for (;;) {
        const bool has_next = S.next(ui + 1, nxt);
        const char* nA = has_next ? (const char*)g.A + (size_t)nxt.pm * tstep : cA; const char* nB = has_next ? (const char*)g.Bt + (size_t)nxt.pn * tstep : cB;
        for (int t = 0; t < nt; t += 2) {
            const bool last = (t == nt - 2);
            const char* a1 = cA + (size_t)(t + 1) * kstep;
            const char* a2 = last ? nA : cA + (size_t)(t + 2) * kstep; const char* b2 = last ? nB : cB + (size_t)(t + 2) * kstep;
            const char* a3 = a2 + kstep; const char* b3 = b2 + kstep;
            if (last && has_next) S.a_ready(nxt);
            if constexpr (SP2) {
            PG8_LDB(B0, 0, 0); PG8_LDB(B1, 0, 1); PG8_SCHED; PG8_LDA(At, 0, 0); PG8_STAGE(PG8_SA(1, 1), a1 + hstep, voffA);
            PG8_WAIT_V(8); PG8_WAIT_L(0); PG8_BAR; PG8_MMA(0, 0, At, B0); PG8_MMA(0, 1, At, B1); PG8_BAR; PG8_SCHED;
            PG8_LDA(At, 0, 1); PG8_STAGE(PG8_SB(0, 0), b2, voffB); PG8_STAGE(PG8_SB(0, 1), b2 + hstep, voffB); PG8_STAGE(PG8_SA(0, 0), a2, voffA);
            PG8_WAIT_V(8); PG8_WAIT_L(0); PG8_BAR; PG8_MMA(1, 0, At, B0); PG8_MMA(1, 1, At, B1); PG8_BAR; PG8_SCHED;
            PG8_LDB(B0, 1, 0); PG8_LDB(B1, 1, 1); PG8_SCHED; PG8_LDA(At, 1, 0); PG8_STAGE(PG8_SA(0, 1), a2 + hstep, voffA);
            PG8_WAIT_V(8); PG8_WAIT_L(0); PG8_BAR; PG8_MMA(0, 0, At, B0); PG8_MMA(0, 1, At, B1); PG8_BAR; PG8_SCHED;
            PG8_LDA(At, 1, 1); PG8_STAGE(PG8_SB(1, 0), b3, voffB); PG8_STAGE(PG8_SB(1, 1), b3 + hstep, voffB); PG8_STAGE(PG8_SA(1, 0), a3, voffA);
            PG8_WAIT_V(8); PG8_WAIT_L(0); PG8_BAR; PG8_MMA(1, 0, At, B0); PG8_MMA(1, 1, At, B1); PG8_BAR; PG8_SCHED;
            } else {
            PG8_LDB(B0, 0, 0); PG8_SCHED; PG8_LDA(At, 0, 0); PG8_STAGE(PG8_SA(1, 1), a1 + hstep, voffA);
            PG8_WAIT_L(8); PG8_BAR; PG8_WAIT_L(0); PG8_MMA(0, 0, At, B0); PG8_BAR; PG8_SCHED;
            PG8_LDB(B1, 0, 1); PG8_STAGE(PG8_SB(0, 0), b2, voffB);
            PG8_BAR; PG8_WAIT_L(0); PG8_MMA(0, 1, At, B1); PG8_BAR;
            PG8_LDA(At, 0, 1); PG8_STAGE(PG8_SA(0, 0), a2, voffA);
            PG8_BAR; PG8_WAIT_L(0); PG8_MMA(1, 0, At, B0); PG8_BAR; PG8_SCHED;
            PG8_STAGE(PG8_SB(0, 1), b2 + hstep, voffB);
            PG8_WAIT_V(6); PG8_BAR; PG8_MMA(1, 1, At, B1); PG8_BAR;
            PG8_LDB(B0, 1, 0); PG8_SCHED; PG8_LDA(At, 1, 0); PG8_STAGE(PG8_SA(0, 1), a2 + hstep, voffA);
            PG8_WAIT_L(8); PG8_BAR; PG8_WAIT_L(0); PG8_MMA(0, 0, At, B0); PG8_BAR; PG8_SCHED;
            PG8_LDB(B1, 1, 1); PG8_STAGE(PG8_SB(1, 0), b3, voffB);
            PG8_BAR; PG8_WAIT_L(0); PG8_MMA(0, 1, At, B1); PG8_BAR;
            PG8_LDA(At, 1, 1); PG8_STAGE(PG8_SA(1, 0), a3, voffA);
            PG8_BAR; PG8_WAIT_L(0); PG8_MMA(1, 0, At, B0); PG8_BAR; PG8_SCHED;
            PG8_STAGE(PG8_SB(1, 1), b3 + hstep, voffB);
            PG8_WAIT_V(6); PG8_BAR; PG8_MMA(1, 1, At, B1); PG8_BAR;
            }
        }
        if constexpr (ALIGN_EPI) { if (wr == 0) PG8_BAR; }
        if constexpr (!Epi::AFTER_DRAIN) { E(acc, cur, wr, wc, fr, fq); S.done(cur); }
        if (!has_next) break;
#pragma unroll
        for (int a = 0; a < 2; ++a)
#pragma unroll
            for (int b = 0; b < 2; ++b)
#pragma unroll
                for (int m = 0; m < 4; ++m)
#pragma unroll
                    for (int n = 0; n < 2; ++n) acc[a][b][m][n] = (f32x4){0.f, 0.f, 0.f, 0.f};
        cur = nxt; cA = nA; cB = nB; ++ui;
        if constexpr (ALIGN_EPI) { if (wr == 1) PG8_BAR; }
    }
    PG8_WAIT_V(0);
    if constexpr (!ALIGN_EPI) { if (wr == 0) PG8_BAR; }
    PG8_BAR;
    if constexpr (Epi::AFTER_DRAIN) { E.fused(acc, cur, wr, wc, fr, fq, lds, wid, lane); S.done(cur); }
#undef PG8_SA
#undef PG8_SB
#undef PG8_STAGE
#undef PG8_LDA
#undef PG8_LDB
#undef PG8_MMA
#undef PG8_WAIT_V
#undef PG8_WAIT_L
#undef PG8_BAR
#undef PG8_SCHED
}
}
#define XB_TMO      128
#define XB_XCNT(j)  (256  + 64 * (j))
#define XB_XSUB(j)  (1280 + 64 * (j))
#define XB_XGEN(j)  (2304 + 64 * (j))
#define XB_TOP      3328
#define XB_TOPGEN   3392
#define XCD_BAR_WORDS 3456
#define XB_SPIN_CAP (1u << 18)
#define LAS __attribute__((address_space(3)))

__device__ __forceinline__ unsigned xb_ld(unsigned* p)              { return __hip_atomic_load(p, __ATOMIC_RELAXED, __HIP_MEMORY_SCOPE_AGENT); }
__device__ __forceinline__ unsigned xb_add(unsigned* p, unsigned v) { return __hip_atomic_fetch_add(p, v, __ATOMIC_RELAXED, __HIP_MEMORY_SCOPE_AGENT); }
__device__ __forceinline__ unsigned xb_xcc_id() { return (unsigned)__builtin_amdgcn_s_getreg((3 << 11) | 20) & 0xFu; }
#define XB_SPIN(cond, bar) do { unsigned _sp = 0; while (cond) { __builtin_amdgcn_s_sleep(1); \
    if ((++_sp & 255u) == 0u) { if (xb_ld(&(bar)[XB_TMO])) break; if (_sp > XB_SPIN_CAP) { atomicAdd(&(bar)[XB_TMO], 1u); break; } } } } while (0)

struct XcdBarrier {
    unsigned* bar; unsigned x;
    volatile LAS unsigned* st;
};

__device__ __forceinline__ XcdBarrier xcd_barrier_post(unsigned* bar, volatile LAS unsigned* st) {
    XcdBarrier b; b.bar = bar; b.x = xb_xcc_id(); b.st = st;
    if (mk_tidx() == 0) (void)xb_add(&bar[XB_XCNT(b.x)], 1u);
    return b;
}
__device__ __forceinline__ void xcd_barrier_complete(unsigned* bar, unsigned x, unsigned& nloc, unsigned& nx) {
    const unsigned G = gridDim.x * gridDim.y * gridDim.z;
    unsigned sum, cnt, mine, sp = 0u;
    for (;;) {
        sum = 0u; cnt = 0u; mine = 0u;
#pragma unroll
        for (unsigned j = 0; j < 16; ++j) { const unsigned c = xb_ld(&bar[XB_XCNT(j)]); sum += c; cnt += (c > 0u) ? 1u : 0u; mine = (j == x) ? c : mine; }
        if (sum == G) break;
        __builtin_amdgcn_s_sleep(1);
        if ((++sp & 255u) == 0u) { if (xb_ld(&bar[XB_TMO])) break; if (sp > XB_SPIN_CAP) { atomicAdd(&bar[XB_TMO], 1u); break; } }
    }
    nloc = mine > 0u ? mine : 1u; nx = cnt > 0u ? cnt : 1u;
}

__device__ __forceinline__ void xcd_barrier(const XcdBarrier& b) {
    asm volatile("s_waitcnt vmcnt(0)" ::: "memory");
    __syncthreads();
    if (mk_tidx() == 0) {
        unsigned* bar = b.bar;
        __builtin_amdgcn_s_waitcnt(0);
        unsigned nloc = b.st[0], nx = b.st[1];
        if (nloc == 0u) { xcd_barrier_complete(bar, b.x, nloc, nx); b.st[0] = nloc; b.st[1] = nx; }
        const unsigned old = xb_add(&bar[XB_XSUB(b.x)], 1u);
        const unsigned gen = old / nloc;
        if (old + 1u == (gen + 1u) * nloc) {
            __builtin_amdgcn_fence(__ATOMIC_RELEASE, "agent");
            asm volatile("s_waitcnt vmcnt(0)" ::: "memory");
            const unsigned og = xb_add(&bar[XB_TOP], 1u);
            const unsigned tg = og / nx;
            if (og + 1u == (tg + 1u) * nx) xb_add(&bar[XB_TOPGEN], 1u);
            else XB_SPIN(xb_ld(&bar[XB_TOPGEN]) == tg, bar);
            __builtin_amdgcn_fence(__ATOMIC_ACQUIRE, "agent");
            xb_add(&bar[XB_XGEN(b.x)], 1u);
            asm volatile("s_waitcnt vmcnt(0)" ::: "memory");
        } else {
            XB_SPIN(xb_ld(&bar[XB_XGEN(b.x)]) == gen, bar);
            __builtin_amdgcn_fence(__ATOMIC_ACQUIRE, "agent");
            asm volatile("s_waitcnt vmcnt(0)" ::: "memory");
        }
    }
    __syncthreads();
}
namespace pg8 {
template <class Epi, class Sched>
__device__ __forceinline__ void gemm_phase_ga(PG8_LAS unsigned char* lds, const Gemm g, const Sched& S, const Epi& E) {
    const int tid = mk_tidx(), wid = __builtin_amdgcn_readfirstlane(tid >> 6), lane = tid & 63, wr = wid >> 2, wc = wid & 3, fr = lane & 15, fq = lane >> 4;
    const int K = g.K, nt = K / BK;
    unsigned voffB[2]; int RA[2], CA[2];
#pragma unroll
    for (int i = 0; i < 2; ++i) { int R, C; stage_rc(tid * 16 + i * 8192, R, C); const int Rb = Epi::PERM ? ((R & ~31) + perm32(R & 31)) : R;
        RA[i] = R; CA[i] = C; voffB[i] = (unsigned)(Rb * K + C) * 2u; }
    const size_t kstep = (size_t)(BK * 2);
    const size_t hstep = (size_t)HALF * K * 2;
    const size_t tstep = 2 * hstep;
    const unsigned ldsw = (unsigned)wid * 1024u;
    const int aoff = lds_byte(wr * 64 + fr, fq * 8), boff = lds_byte(wc * 32 + fr, fq * 8);
#define PG8_SA(b, h) (((b) * 2 + (h)) * HTB)
#define PG8_SB(b, h) ((4 + (b) * 2 + (h)) * HTB)
#define PG8_STAGE(bufoff, gbase, voff) do { _Pragma("unroll") for (int _i = 0; _i < 2; ++_i) \
        __builtin_amdgcn_global_load_lds((const unsigned*)((const char*)(gbase) + (voff)[_i]), (PG8_LAS unsigned*)(lds + (bufoff) + ldsw + _i * 8192), 16, 0, 0); } while (0)
#define PG8_LDA(dst, b, h) do { _Pragma("unroll") for (int m = 0; m < 4; ++m) _Pragma("unroll") for (int k = 0; k < 2; ++k) dst[m][k] = *(const PG8_LAS bf16x8*)(lds + PG8_SA(b, h) + aoff + m * 2048 + k * 1024); } while (0)
#define PG8_LDB(dst, b, h) do { _Pragma("unroll") for (int n = 0; n < 2; ++n) _Pragma("unroll") for (int k = 0; k < 2; ++k) dst[n][k] = *(const PG8_LAS bf16x8*)(lds + PG8_SB(b, h) + boff + n * 2048 + k * 1024); } while (0)
#define PG8_MMA(ai, bj, At, Bt) do { __builtin_amdgcn_s_setprio(1); _Pragma("unroll") for (int m = 0; m < 4; ++m) _Pragma("unroll") for (int n = 0; n < 2; ++n) _Pragma("unroll") for (int k = 0; k < 2; ++k) \
        acc[ai][bj][m][n] = __builtin_amdgcn_mfma_f32_16x16x32_bf16(Bt[n][k], At[m][k], acc[ai][bj][m][n], 0, 0, 0); __builtin_amdgcn_s_setprio(0); } while (0)
#define PG8_WAIT_V(n) asm volatile("s_waitcnt vmcnt(" #n ")" ::: "memory")
#define PG8_WAIT_L(n) asm volatile("s_waitcnt lgkmcnt(0)" ::: "memory")
#define PG8_BAR __builtin_amdgcn_s_barrier()
#define PG8_SCHED __builtin_amdgcn_sched_barrier(0)
#define PG8_AOFF(dst, u) do { _Pragma("unroll") for (int _h = 0; _h < 2; ++_h) _Pragma("unroll") for (int _i = 0; _i < 2; ++_i) \
        dst[_h][_i] = (unsigned)S.arow(u, _h * HALF + RA[_i]) * (unsigned)(K * 2) + (unsigned)(CA[_i] * 2); } while (0)
    Unit cur, nxt; int ui = 0;
    if (!S.next(0, cur)) return;
    f32x4 acc[2][2][4][2];
#pragma unroll
    for (int a = 0; a < 2; ++a)
#pragma unroll
        for (int b = 0; b < 2; ++b)
#pragma unroll
            for (int m = 0; m < 4; ++m)
#pragma unroll
                for (int n = 0; n < 2; ++n) acc[a][b][m][n] = (f32x4){0.f, 0.f, 0.f, 0.f};
    bf16x8 At[4][2], B0[2][2], B1[2][2];
    unsigned offC[2][2], offN[2][2];
    PG8_AOFF(offC, cur);
    const char* gA = (const char*)g.A;
    const char* cB = (const char*)g.Bt + (size_t)cur.pn * tstep;
    S.a_ready(cur);
    PG8_STAGE(PG8_SB(0, 0), cB, voffB); PG8_STAGE(PG8_SB(0, 1), cB + hstep, voffB); PG8_STAGE(PG8_SA(0, 0), gA, offC[0]); PG8_STAGE(PG8_SA(0, 1), gA, offC[1]);
    if (wr == 1) PG8_BAR;
    PG8_WAIT_V(2); PG8_BAR;
    PG8_STAGE(PG8_SB(1, 0), cB + kstep, voffB); PG8_STAGE(PG8_SA(1, 0), gA + kstep, offC[0]); PG8_STAGE(PG8_SB(1, 1), cB + hstep + kstep, voffB);
    PG8_WAIT_V(6); PG8_BAR;
    for (;;) {
        const bool has_next = S.next(ui + 1, nxt);
        if (has_next) { PG8_AOFF(offN, nxt); } else {
#pragma unroll
            for (int h_ = 0; h_ < 2; ++h_)
#pragma unroll
                for (int i_ = 0; i_ < 2; ++i_) offN[h_][i_] = offC[h_][i_]; }
        const char* nB = has_next ? (const char*)g.Bt + (size_t)nxt.pn * tstep : cB;
        for (int t = 0; t < nt; t += 2) {
            const bool last = (t == nt - 2);
            const char* a1 = gA + (size_t)(t + 1) * kstep;
            const char* a2 = last ? gA : gA + (size_t)(t + 2) * kstep; const char* b2 = last ? nB : cB + (size_t)(t + 2) * kstep;
            const char* a3 = a2 + kstep; const char* b3 = b2 + kstep;
            unsigned o2[2][2];
#pragma unroll
            for (int h_ = 0; h_ < 2; ++h_)
#pragma unroll
                for (int i_ = 0; i_ < 2; ++i_) o2[h_][i_] = last ? offN[h_][i_] : offC[h_][i_];
            if (last && has_next) S.a_ready(nxt);
            PG8_LDB(B0, 0, 0); PG8_LDB(B1, 0, 1); PG8_SCHED; PG8_LDA(At, 0, 0); PG8_STAGE(PG8_SA(1, 1), a1, offC[1]);
            PG8_WAIT_V(8); PG8_WAIT_L(0); PG8_BAR; PG8_MMA(0, 0, At, B0); PG8_MMA(0, 1, At, B1); PG8_BAR; PG8_SCHED;
            PG8_LDA(At, 0, 1); PG8_STAGE(PG8_SB(0, 0), b2, voffB); PG8_STAGE(PG8_SB(0, 1), b2 + hstep, voffB); PG8_STAGE(PG8_SA(0, 0), a2, o2[0]);
            PG8_WAIT_V(8); PG8_WAIT_L(0); PG8_BAR; PG8_MMA(1, 0, At, B0); PG8_MMA(1, 1, At, B1); PG8_BAR; PG8_SCHED;
            PG8_LDB(B0, 1, 0); PG8_LDB(B1, 1, 1); PG8_SCHED; PG8_LDA(At, 1, 0); PG8_STAGE(PG8_SA(0, 1), a2, o2[1]);
            PG8_WAIT_V(8); PG8_WAIT_L(0); PG8_BAR; PG8_MMA(0, 0, At, B0); PG8_MMA(0, 1, At, B1); PG8_BAR; PG8_SCHED;
            PG8_LDA(At, 1, 1); PG8_STAGE(PG8_SB(1, 0), b3, voffB); PG8_STAGE(PG8_SB(1, 1), b3 + hstep, voffB); PG8_STAGE(PG8_SA(1, 0), a3, o2[0]);
            PG8_WAIT_V(8); PG8_WAIT_L(0); PG8_BAR; PG8_MMA(1, 0, At, B0); PG8_MMA(1, 1, At, B1); PG8_BAR; PG8_SCHED;
        }
        if (wr == 0) PG8_BAR;
        E(acc, cur, wr, wc, fr, fq); S.done(cur);
        if (!has_next) break;
#pragma unroll
        for (int a = 0; a < 2; ++a)
#pragma unroll
            for (int b = 0; b < 2; ++b)
#pragma unroll
                for (int m = 0; m < 4; ++m)
#pragma unroll
                    for (int n = 0; n < 2; ++n) acc[a][b][m][n] = (f32x4){0.f, 0.f, 0.f, 0.f};
        cur = nxt; cB = nB; ++ui;
#pragma unroll
        for (int h_ = 0; h_ < 2; ++h_)
#pragma unroll
            for (int i_ = 0; i_ < 2; ++i_) offC[h_][i_] = offN[h_][i_];
        if (wr == 1) PG8_BAR;
    }
    PG8_WAIT_V(0);
    PG8_BAR;
#undef PG8_SA
#undef PG8_SB
#undef PG8_STAGE
#undef PG8_LDA
#undef PG8_LDB
#undef PG8_MMA
#undef PG8_WAIT_V
#undef PG8_WAIT_L
#undef PG8_BAR
#undef PG8_SCHED
#undef PG8_AOFF
}
}
namespace attn_body {
using bf16=unsigned short;
using bf16x8=__attribute__((ext_vector_type(8)))short;
using s16x4=__attribute__((ext_vector_type(4)))short;
using f32x16=__attribute__((ext_vector_type(16)))float;
using u32x4=__attribute__((ext_vector_type(4)))unsigned;
constexpr int BATCH=4,NHEAD=8,SEQ=4096,D=64,DM=NHEAD*D,ODM=1024;
constexpr int NW=8,QBLK=32,QB=QBLK*NW,KVBLK=64,NQB=SEQ/QB;
constexpr int ATTN_PITCH=DM, ATTN_UNIT_ROWS=QB;
__device__ __forceinline__ int crow(int r,int hi){return (r&3)+8*(r>>2)+4*hi;}
#define SBAR() __builtin_amdgcn_sched_barrier(0)
__device__ __forceinline__ void cmask(f32x16&p0,f32x16&p1,int jb,int qrel,int hi){
  const float NEG=-INFINITY; int kb=64*jb+4*hi;
  #pragma unroll
  for(int r=0;r<16;++r){int kv=kb+(r&3)+8*(r>>2); if(kv>qrel)p0[r]=NEG; if(kv+32>qrel)p1[r]=NEG;}
}

constexpr int NSLOT=3, SLOTB=8192;
constexpr int LDS_K=0, LDS_V=NSLOT*SLOTB, LDS_WS=2*NSLOT*SLOTB, LDS_OST=LDS_WS+NW*64*4, LDS_MSK=LDS_OST+NW*4096, LDS_BYTES=LDS_MSK+NW*768;
constexpr float C2=0.125f*1.4426950408889634f;
__device__ __forceinline__ void glds16(const void*gsrc,unsigned lds_dst){unsigned keep;
  asm volatile("s_mov_b32 %0, m0\n\ts_mov_b32 m0, %2\n\ts_nop 0\n\tglobal_load_lds_dwordx4 %1, off\n\ts_mov_b32 m0, %0":"=&s"(keep):"v"(gsrc),"s"(lds_dst):"memory");}
__device__ __forceinline__ void glds4(const void*gsrc,unsigned lds_dst){unsigned keep;
  asm volatile("s_mov_b32 %0, m0\n\ts_mov_b32 m0, %2\n\ts_nop 0\n\tglobal_load_lds_dword %1, off\n\ts_mov_b32 m0, %0":"=&s"(keep):"v"(gsrc),"s"(lds_dst):"memory");}
template<int BIT> __device__ __forceinline__ float mand(float x,unsigned w){ int m; asm("v_bfe_i32 %0, %1, %2, 1":"=v"(m):"v"(w),"n"(BIT)); return __uint_as_float(__float_as_uint(x)&(unsigned)m); }
__device__ __forceinline__ float max3f(float a,float b,float c){float r;asm("v_max3_f32 %0, %1, %2, %3":"=v"(r):"v"(a),"v"(b),"v"(c));return r;}
__device__ __forceinline__ float max2f(float a,float b){float r;asm("v_max_f32_e32 %0, %1, %2":"=v"(r):"v"(a),"v"(b));return r;}
__device__ __forceinline__ float fadd_s(float a,float b){float r;asm("v_add_f32_e32 %0, %1, %2":"=v"(r):"v"(a),"v"(b));return r;}
__device__ __forceinline__ float fsub_s(float a,float b){float r;asm("v_sub_f32_e32 %0, %1, %2":"=v"(r):"v"(a),"v"(b));return r;}
typedef float f32x2_t __attribute__((ext_vector_type(2))); typedef __bf16 bf16x2_t __attribute__((ext_vector_type(2)));
__device__ __forceinline__ unsigned cvtpk_s(float lo,float hi){f32x2_t v={lo,hi};bf16x2_t b=__builtin_convertvector(v,bf16x2_t);return __builtin_bit_cast(unsigned,b);}
#define WAIT_BAR(N) asm volatile("s_waitcnt vmcnt(" #N ") lgkmcnt(0)\n\ts_barrier":::"memory")

__device__ __forceinline__ void qkt(f32x16&p0,f32x16&p1,const char*Kslot,const bf16x8*qr,const f32x16&negm,int r32,int hi){
  const char*kb=Kslot+hi*1024+r32*16;
  #pragma unroll
  for(int d0=0;d0<4;++d0){
    const bf16x8 b0=*reinterpret_cast<const bf16x8*>(kb+d0*2048);
    const bf16x8 b1=*reinterpret_cast<const bf16x8*>(kb+d0*2048+512);
    if(d0==0){p0=__builtin_amdgcn_mfma_f32_32x32x16_bf16(b0,qr[0],negm,0,0,0);p1=__builtin_amdgcn_mfma_f32_32x32x16_bf16(b1,qr[0],negm,0,0,0);}
    else{p0=__builtin_amdgcn_mfma_f32_32x32x16_bf16(b0,qr[d0],p0,0,0,0);p1=__builtin_amdgcn_mfma_f32_32x32x16_bf16(b1,qr[d0],p1,0,0,0);}}
}
typedef __attribute__((address_space(3))) const char* lds_cptr;
typedef short v4i16_t __attribute__((ext_vector_type(4)));
__device__ __forceinline__ void kload8(bf16x8*kf,lds_cptr kp){
  kf[0]=*(const __attribute__((address_space(3))) bf16x8*)(kp);      kf[1]=*(const __attribute__((address_space(3))) bf16x8*)(kp+512);
  kf[2]=*(const __attribute__((address_space(3))) bf16x8*)(kp+2048); kf[3]=*(const __attribute__((address_space(3))) bf16x8*)(kp+2560);
  kf[4]=*(const __attribute__((address_space(3))) bf16x8*)(kp+4096); kf[5]=*(const __attribute__((address_space(3))) bf16x8*)(kp+4608);
  kf[6]=*(const __attribute__((address_space(3))) bf16x8*)(kp+6144); kf[7]=*(const __attribute__((address_space(3))) bf16x8*)(kp+6656);
}
__device__ __forceinline__ void kload2(bf16x8*kf,lds_cptr kp,int j){ kf[2*j]=*(const __attribute__((address_space(3))) bf16x8*)(kp+j*2048); kf[2*j+1]=*(const __attribute__((address_space(3))) bf16x8*)(kp+j*2048+512); }
__device__ __forceinline__ s16x4 vtr(lds_cptr p){ return __builtin_bit_cast(s16x4,__builtin_amdgcn_ds_read_tr16_b64_v4i16((__attribute__((address_space(3))) v4i16_t*)p)); }
__device__ __forceinline__ float rowmax(const f32x16&p0,const f32x16&p1){
  float a=max3f(p0[0],p0[1],p1[0]),b=max3f(p0[2],p0[3],p1[1]);a=max3f(a,p1[2],p1[3]);
  #pragma unroll
  for(int r=4;r<16;r+=4){a=max3f(a,p0[r],p0[r+1]);b=max3f(b,p0[r+2],p0[r+3]);a=max3f(a,p1[r],p1[r+1]);b=max3f(b,p1[r+2],p1[r+3]);}
  const float m=max2f(a,b);
  auto rr=__builtin_amdgcn_permlane32_swap(__float_as_uint(m),__float_as_uint(m),false,false);
  return max2f(__uint_as_float(rr[0]),__uint_as_float(rr[1]));
}
__device__ __forceinline__ void pv(f32x16*o,int vb,bf16x8 pa0,bf16x8 pa1,bf16x8 pa2,bf16x8 pa3){
  #pragma unroll
  for(int d0=0;d0<2;++d0){s16x4 lo[4],hi[4];
    #pragma unroll
    for(int ks=0;ks<4;++ks){
      asm volatile("ds_read_b64_tr_b16 %0,%1 offset:%c2":"=&v"(lo[ks]):"v"(vb),"i"(d0*4096+ks*1024):"memory");
      asm volatile("ds_read_b64_tr_b16 %0,%1 offset:%c2":"=&v"(hi[ks]):"v"(vb),"i"(d0*4096+ks*1024+512):"memory");}
    asm volatile("s_waitcnt lgkmcnt(0)":::"memory");SBAR();
    #define PK(k) (bf16x8){lo[k][0],lo[k][1],lo[k][2],lo[k][3],hi[k][0],hi[k][1],hi[k][2],hi[k][3]}
    o[d0]=__builtin_amdgcn_mfma_f32_32x32x16_bf16(pa0,PK(0),o[d0],0,0,0);
    o[d0]=__builtin_amdgcn_mfma_f32_32x32x16_bf16(pa1,PK(1),o[d0],0,0,0);
    o[d0]=__builtin_amdgcn_mfma_f32_32x32x16_bf16(pa2,PK(2),o[d0],0,0,0);
    o[d0]=__builtin_amdgcn_mfma_f32_32x32x16_bf16(pa3,PK(3),o[d0],0,0,0);
    #undef PK
  }
}

#ifndef ATTN_STORE16
#define ATTN_STORE16(p,v) (*(u32x4*)(p)=(v))
#endif
template<int THRL> __device__ __forceinline__ void attn_unit(int b,int h,int qb,const bf16*Q,const bf16*__restrict__ K,const bf16*__restrict__ V,bf16*O,const unsigned*__restrict__ MK,char*shm){
  const int tid=mk_tidx(),lane=tid&63,r32=lane&31,hi=lane>>5; const int wid=__builtin_amdgcn_readfirstlane(tid>>6);
  const long rowbase=(long)b*SEQ; const int q0=qb*QB;
  const bf16*Qw=Q+(rowbase+q0+wid*QBLK)*DM+h*D;
  const bf16*Kh=K+rowbase*DM+h*D,*Vh=V+rowbase*DM+h*D;
  const unsigned lds0=(unsigned)(uintptr_t)shm;
  float*wsf=(float*)(shm+LDS_WS)+wid*64;
  const bf16*ksrc=Kh+(long)lane*DM+wid*8;
  const bf16*vsrc=Vh+(long)(16*(wid&3)+(lane>>2))*DM+(wid>>2)*32+(lane&3)*8;
  const unsigned kdst=lds0+LDS_K+wid*1024, vdst=lds0+LDS_V+wid*1024;
  const unsigned*msrc=MK+((size_t)(b*128+8*qb+wid)*64)*64+lane; const unsigned mdst=lds0+LDS_MSK+wid*768;
  const __attribute__((address_space(3))) char*mrd=(__attribute__((address_space(3))) const char*)shm+LDS_MSK+wid*768+lane*4;
  int mq_cur=0,mq_n1=256,mq_n2=512;
  #define DMA_M(t,slot) glds4(msrc+(size_t)(t)*64,(unsigned)__builtin_amdgcn_readfirstlane(mdst+(slot)))
  #define MWORD() (*(const __attribute__((address_space(3))) unsigned*)(mrd+mq_cur))
  #define DMA_K(t,slot) glds16(ksrc+(long)(t)*KVBLK*DM,(unsigned)__builtin_amdgcn_readfirstlane(kdst+(slot)))
  #define DMA_V(t,slot) glds16(vsrc+(long)(t)*KVBLK*DM,(unsigned)__builtin_amdgcn_readfirstlane(vdst+(slot)))
  const int vb0=(int)(lds0+LDS_V)+((lane>>4)&1)*32+(lane&3)*8+(4*hi+((lane&15)>>2))*64;
  const char*Kbase=shm+LDS_K; bf16x8 kf[8];
  const lds_cptr shm3=(lds_cptr)shm; const lds_cptr kp0=shm3+LDS_K+hi*1024+r32*16; const lds_cptr vp0=shm3+LDS_V+((lane>>4)&1)*32+(lane&3)*8+(4*hi+((lane&15)>>2))*64;
  const int NT=(q0+QB)/KVBLK;
  DMA_M(0,0);DMA_M(1,256);DMA_K(0,0);DMA_V(0,0);DMA_K(1,SLOTB);
  bf16x8 qr[4];
  #pragma unroll
  for(int d0=0;d0<4;++d0)qr[d0]=*reinterpret_cast<const bf16x8*>(&Qw[(long)r32*DM+d0*16+hi*8]);
  float mhat=0.f,l_reg=0.f;f32x16 o[2];o[0]=f32x16{};o[1]=f32x16{};f32x16 negm=f32x16{};asm volatile("":"+v"(negm));
  const int qrel=wid*QBLK+r32;
  #define CMASK(P0,P1,t) do{}while(0)
  bool resc=false;
  #define START(P0,P1) do{ const float rm=rowmax(P0,P1); resc=false; \
    { const float dl=(rm>-1e30f)?rm:0.f; mhat=fadd_s(mhat,dl); \
      _Pragma("unroll") for(int r=0;r<16;++r){P0[r]=fsub_s(P0[r],dl);P1[r]=fsub_s(P1[r],dl);} \
      _Pragma("unroll") for(int r=0;r<16;++r)negm[r]=-mhat; asm volatile("":"+v"(negm)); } \
    _Pragma("unroll") for(int r=0;r<16;++r)P0[r]=__builtin_amdgcn_exp2f(P0[r]); }while(0)
  #define RESC() do{ if(resc){ asm volatile("s_waitcnt lgkmcnt(0)":::"memory"); \
      _Pragma("unroll") for(int d_=0;d_<2;++d_) _Pragma("unroll") for(int r=0;r<16;++r)o[d_][r]*=wsf[crow(r,hi)]; } }while(0)
  f32x16 pA0,pA1,pB0,pB1;
  int sl_prev=0,sl_cur=0,sl_next=SLOTB;
  #define ROT() do{sl_prev=sl_cur;sl_cur=sl_next;sl_next=(sl_next==(NSLOT-1)*SLOTB)?0:sl_next+SLOTB; const int mt_=mq_cur;mq_cur=mq_n1;mq_n1=mq_n2;mq_n2=mt_;}while(0)
  DMA_K(2,2*SLOTB);
  WAIT_BAR(3);
  qkt(pA0,pA1,Kbase,qr,negm,r32,hi);asm volatile("s_nop 15\n\ts_nop 7":"+v"(pA0),"+v"(pA1));CMASK(pA0,pA1,0);
  START(pA0,pA1);
  _Pragma("unroll") for(int r=0;r<16;++r)pA1[r]=__builtin_amdgcn_exp2f(pA1[r]);
  { const unsigned mw0=MWORD(); pA0[0]=mand<0>(pA0[0],mw0);pA1[0]=mand<16>(pA1[0],mw0);pA0[1]=mand<1>(pA0[1],mw0);pA1[1]=mand<17>(pA1[1],mw0);pA0[2]=mand<2>(pA0[2],mw0);pA1[2]=mand<18>(pA1[2],mw0);pA0[3]=mand<3>(pA0[3],mw0);pA1[3]=mand<19>(pA1[3],mw0);pA0[4]=mand<4>(pA0[4],mw0);pA1[4]=mand<20>(pA1[4],mw0);pA0[5]=mand<5>(pA0[5],mw0);pA1[5]=mand<21>(pA1[5],mw0);pA0[6]=mand<6>(pA0[6],mw0);pA1[6]=mand<22>(pA1[6],mw0);pA0[7]=mand<7>(pA0[7],mw0);pA1[7]=mand<23>(pA1[7],mw0);pA0[8]=mand<8>(pA0[8],mw0);pA1[8]=mand<24>(pA1[8],mw0);pA0[9]=mand<9>(pA0[9],mw0);pA1[9]=mand<25>(pA1[9],mw0);pA0[10]=mand<10>(pA0[10],mw0);pA1[10]=mand<26>(pA1[10],mw0);pA0[11]=mand<11>(pA0[11],mw0);pA1[11]=mand<27>(pA1[11],mw0);pA0[12]=mand<12>(pA0[12],mw0);pA1[12]=mand<28>(pA1[12],mw0);pA0[13]=mand<13>(pA0[13],mw0);pA1[13]=mand<29>(pA1[13],mw0);pA0[14]=mand<14>(pA0[14],mw0);pA1[14]=mand<30>(pA1[14],mw0);pA0[15]=mand<15>(pA0[15],mw0);pA1[15]=mand<31>(pA1[15],mw0); }
  WAIT_BAR(0);
  DMA_M(2,512);DMA_K(3,0);DMA_V(1,SLOTB);
  ROT();
  kload8(kf,kp0+sl_cur);
  WAIT_BAR(3);
  s16x4 vlo[8],vhi[8]; u32x4 pw0,pw1,pw2,pw3;
  #define PKW(P,B) cvtpk_s(P[B],P[B+1])
  #define PAF(k) __builtin_bit_cast(bf16x8,pw##k)
  #define VFR(i) (bf16x8){vlo[i][0],vlo[i][1],vlo[i][2],vlo[i][3],vhi[i][0],vhi[i][1],vhi[i][2],vhi[i][3]}
  #define PIN(x) asm volatile("":"+v"(x))
  #define MX3(a,b,c) __builtin_fmaxf(__builtin_fmaxf((a),(b)),(c))
  #define GAPA(MF,A0,A1,A2,A3,W0,W1,PW) do{ MF; sacc+=A0; sacc+=A1; sacc+=A2; sacc+=A3; PIN(sacc); W0; W1; PIN(PW); SBAR(); }while(0)
  #define EX(v) __builtin_amdgcn_exp2f(v)
  #define GAPB(MF,X,B,MO) do{ MF; X[B]=mand<MO+B>(EX(X[B]),mw_); X[B+1]=mand<MO+B+1>(EX(X[B+1]),mw_); X[B+2]=mand<MO+B+2>(EX(X[B+2]),mw_); X[B+3]=mand<MO+B+3>(EX(X[B+3]),mw_); PIN(X); SBAR(); }while(0)
  #define VRD(i) do{ vlo[i]=vtr(vp_+(((i)>>2)*4096+((i)&3)*1024)); vhi[i]=vtr(vp_+(((i)>>2)*4096+((i)&3)*1024+512)); }while(0)
  #define KRD(G,j) do{ if(G){ kload2(kf,kp0+sl_next,j); SBAR(); } }while(0)
  #define STEP(C0,C1,P0,P1,t,GK,GV,GL,GM) do{ SBAR(); \
    const lds_cptr vp_=vp0+sl_prev; \
    VRD(0); SBAR(); float sacc=(P0[0]+P0[1]); \
    GAPA(C0=__builtin_amdgcn_mfma_f32_32x32x16_bf16(kf[0],qr[0],negm,0,0,0), P0[2],P0[3],P0[4],P0[5],     pw0[0]=PKW(P0,0), pw0[1]=PKW(P0,2), pw0); \
    VRD(4); SBAR(); GAPA(C1=__builtin_amdgcn_mfma_f32_32x32x16_bf16(kf[1],qr[0],negm,0,0,0), P0[6],P0[7],P0[8],P0[9],     pw0[2]=PKW(P0,4), pw0[3]=PKW(P0,6), pw0); \
    VRD(1); SBAR(); GAPA(C0=__builtin_amdgcn_mfma_f32_32x32x16_bf16(kf[2],qr[1],C0,0,0,0),   P0[10],P0[11],P0[12],P0[13], pw1[0]=PKW(P0,8), pw1[1]=PKW(P0,10), pw1); \
    VRD(5); SBAR(); GAPA(C1=__builtin_amdgcn_mfma_f32_32x32x16_bf16(kf[3],qr[1],C1,0,0,0),   P0[14],P0[15],P1[0],P1[1],   pw1[2]=PKW(P0,12),pw1[3]=PKW(P0,14), pw1); \
    VRD(2); SBAR(); GAPA(C0=__builtin_amdgcn_mfma_f32_32x32x16_bf16(kf[4],qr[2],C0,0,0,0),   P1[2],P1[3],P1[4],P1[5],     pw2[0]=PKW(P1,0), pw2[1]=PKW(P1,2), pw2); \
    VRD(6); SBAR(); GAPA(C1=__builtin_amdgcn_mfma_f32_32x32x16_bf16(kf[5],qr[2],C1,0,0,0),   P1[6],P1[7],P1[8],P1[9],     pw2[2]=PKW(P1,4), pw2[3]=PKW(P1,6), pw2); \
    VRD(3); SBAR(); GAPA(C0=__builtin_amdgcn_mfma_f32_32x32x16_bf16(kf[6],qr[3],C0,0,0,0),   P1[10],P1[11],P1[12],P1[13], pw3[0]=PKW(P1,8), pw3[1]=PKW(P1,10), pw3); \
    VRD(7); SBAR(); GAPA(C1=__builtin_amdgcn_mfma_f32_32x32x16_bf16(kf[7],qr[3],C1,0,0,0),   P1[14],P1[15],0.f,0.f,       pw3[2]=PKW(P1,12),pw3[3]=PKW(P1,14), pw3); \
    l_reg+=sacc; \
    if(GM){DMA_M((t)+2,mq_n2);} if(GK){DMA_K((t)+3,sl_cur);} if(GV){DMA_V((t)+1,sl_next);} \
    const unsigned mw_=MWORD(); \
    CMASK(C0,C1,t); \
    { float a=MX3(C0[0],C0[1],C1[0]),b=MX3(C0[2],C0[3],C1[1]); a=MX3(a,C1[2],C1[3]); \
      _Pragma("unroll") for(int r=4;r<16;r+=4){a=MX3(a,C0[r],C0[r+1]);b=MX3(b,C0[r+2],C0[r+3]);a=MX3(a,C1[r],C1[r+1]);b=MX3(b,C1[r+2],C1[r+3]);} \
      float rm=__builtin_fmaxf(a,b); { auto rr=__builtin_amdgcn_permlane32_swap(__float_as_uint(rm),__float_as_uint(rm),false,false); rm=__builtin_fmaxf(__uint_as_float(rr[0]),__uint_as_float(rr[1])); } \
      resc=false; \
      if(__builtin_expect(__any(rm>(float)THRL),0)){ const float dl=__builtin_fmaxf(rm,0.f); mhat+=dl; \
        _Pragma("unroll") for(int r=0;r<16;++r){C0[r]-=dl;C1[r]-=dl;} \
        _Pragma("unroll") for(int r=0;r<16;++r)negm[r]=-mhat; asm volatile("":"+v"(negm)); \
        const float f=__builtin_amdgcn_exp2f(-dl); l_reg*=f; if(hi==0)wsf[r32]=f; resc=true; } } \
    SBAR(); \
    GAPB(o[0]=__builtin_amdgcn_mfma_f32_32x32x16_bf16(PAF(0),VFR(0),o[0],0,0,0), C0,0,0); \
    GAPB(o[1]=__builtin_amdgcn_mfma_f32_32x32x16_bf16(PAF(0),VFR(4),o[1],0,0,0), C0,4,0); \
    KRD(GL,0); GAPB(o[0]=__builtin_amdgcn_mfma_f32_32x32x16_bf16(PAF(1),VFR(1),o[0],0,0,0), C0,8,0); \
    KRD(GL,1); GAPB(o[1]=__builtin_amdgcn_mfma_f32_32x32x16_bf16(PAF(1),VFR(5),o[1],0,0,0), C0,12,0); \
    KRD(GL,2); GAPB(o[0]=__builtin_amdgcn_mfma_f32_32x32x16_bf16(PAF(2),VFR(2),o[0],0,0,0), C1,0,16); \
    KRD(GL,3); GAPB(o[1]=__builtin_amdgcn_mfma_f32_32x32x16_bf16(PAF(2),VFR(6),o[1],0,0,0), C1,4,16); \
    GAPB(o[0]=__builtin_amdgcn_mfma_f32_32x32x16_bf16(PAF(3),VFR(3),o[0],0,0,0), C1,8,16); \
    GAPB(o[1]=__builtin_amdgcn_mfma_f32_32x32x16_bf16(PAF(3),VFR(7),o[1],0,0,0), C1,12,16); \
    }while(0)
  int t=1;
  #undef CMASK
  #define CMASK(P0,P1,t) do{}while(0)
  for(;t+5<NT;t+=2){
    STEP(pB0,pB1,pA0,pA1,t,true,true,true,true);     WAIT_BAR(3); RESC(); ROT();
    STEP(pA0,pA1,pB0,pB1,t+1,true,true,true,true);   WAIT_BAR(3); RESC(); ROT();
  }
  #undef CMASK
  #define CMASK(P0,P1,t) do{}while(0)
  #define ENDW(tt) do{ if((tt)+3<NT){WAIT_BAR(3);} else if((tt)+2<NT){WAIT_BAR(2);} else {WAIT_BAR(0);} }while(0)
  for(;t+1<NT;t+=2){
    STEP(pB0,pB1,pA0,pA1,t,(t+3<NT),(t+1<NT),(t+1<NT),(t+2<NT));       ENDW(t);   RESC(); ROT();
    STEP(pA0,pA1,pB0,pB1,t+1,(t+4<NT),(t+2<NT),(t+2<NT),(t+3<NT));     ENDW(t+1); RESC(); ROT();
  }
  STEP(pB0,pB1,pA0,pA1,NT-1,false,false,false,false); RESC();
  { float sacc=pB0[0]+pB0[1]; _Pragma("unroll") for(int r=2;r<16;++r)sacc+=pB0[r]; _Pragma("unroll") for(int r=0;r<16;++r)sacc+=pB1[r]; l_reg+=sacc;
    pw0=(u32x4){PKW(pB0,0),PKW(pB0,2),PKW(pB0,4),PKW(pB0,6)};pw1=(u32x4){PKW(pB0,8),PKW(pB0,10),PKW(pB0,12),PKW(pB0,14)};pw2=(u32x4){PKW(pB1,0),PKW(pB1,2),PKW(pB1,4),PKW(pB1,6)};pw3=(u32x4){PKW(pB1,8),PKW(pB1,10),PKW(pB1,12),PKW(pB1,14)};
    SBAR(); pv(o,vb0+sl_cur,PAF(0),PAF(1),PAF(2),PAF(3)); }
  #undef PKW
  #undef PAF
  #undef VFR
  #undef PIN
  #undef MX3
  #undef GAPA
  #undef GAPB
  #undef EX
  #undef VRD
  #undef KRD
  #undef STEP
  #undef ENDW
  {auto rr=__builtin_amdgcn_permlane32_swap(__float_as_uint(l_reg),__float_as_uint(l_reg),false,false);l_reg=__uint_as_float(rr[0])+__uint_as_float(rr[1]);}
  if(hi==0)wsf[32+r32]=l_reg;asm volatile("s_waitcnt lgkmcnt(0)":::"memory");
  float rli[16];
  #pragma unroll
  for(int r=0;r<16;++r)rli[r]=__builtin_amdgcn_rcpf(wsf[32+crow(r,hi)]);
  bf16*Ow=O+(rowbase+q0+wid*QBLK)*ODM+h*D;
  { bf16*stg=(bf16*)(shm+LDS_OST)+wid*2048;
    #pragma unroll
    for(int r=0;r<16;++r){const int orow=crow(r,hi);
      #pragma unroll
      for(int d0=0;d0<2;++d0)stg[orow*64+d0*32+r32]=(bf16)(cvtpk_s(o[d0][r]*rli[r],0.f)&0xffffu);}
    asm volatile("s_waitcnt lgkmcnt(0)":::"memory");
    #pragma unroll
    for(int i=0;i<4;++i){const int row=i*8+(lane>>3),ch=lane&7; const u32x4 v=*(const u32x4*)(stg+row*64+ch*8); ATTN_STORE16(Ow+(long)row*ODM+ch*8,v);} }
  asm volatile("s_waitcnt lgkmcnt(0)\n\ts_barrier":::"memory");
  #undef DMA_K
  #undef DMA_V
  #undef DMA_M
  #undef MWORD
  #undef CMASK
  #undef START
  #undef RESC
  #undef ROT
}
constexpr int ATTN_LDS_BYTES=LDS_BYTES;
struct AttnTensors { const bf16* Q; const bf16* K; const bf16* V; bf16* O; const unsigned* MK; };
struct AttnUnit { int bh; int qb; };
struct StaticOrder {
  int vcu;
  __device__ __forceinline__ explicit StaticOrder(int grid,int block):vcu((block%8)*(grid/8)+block/8){}
  __device__ __forceinline__ bool next(int i,AttnUnit&u)const{ if(i>=2)return false; const int s=vcu&7; u.bh=vcu>>3; u.qb=(i==0)?15-s:s; return true; }
  __device__ __forceinline__ void a_ready(const AttnUnit&)const{}
  __device__ __forceinline__ void done(const AttnUnit&)const{}
};
template<class Sched,int THRL=8> __device__ __forceinline__ void attn_phase(char*lds,const AttnTensors&T,const Sched&S){
  AttnUnit u;
  for(int i=0;S.next(i,u);++i){ S.a_ready(u); attn_unit<THRL>(u.bh/NHEAD,u.bh%NHEAD,u.qb,T.Q,T.K,T.V,T.O,T.MK,lds); S.done(u); }
}
#undef SBAR
#undef WAIT_BAR
}
namespace mk {
#define GAS __attribute__((address_space(1)))
typedef unsigned short bf16_t;
typedef float f32x4 __attribute__((ext_vector_type(4)));
typedef float f32x2 __attribute__((ext_vector_type(2)));
typedef float f32x16 __attribute__((ext_vector_type(16)));
typedef unsigned u32x4 __attribute__((ext_vector_type(4)));
typedef unsigned u32x2 __attribute__((ext_vector_type(2)));
typedef short bf16x8 __attribute__((ext_vector_type(8)));
constexpr int NB = 4, S = 4096, T = NB * S, D = 1024;
constexpr int NWAVES = 8, NTHR = 512;
constexpr int INW = 4168;
constexpr int NPHYS = 4352;
constexpr float C2 = 0.125f * 1.4426950408889634f;
constexpr float WI_SCALE = 0.04419417382415922f;
constexpr float KR_SCALE = 0.08838834764831845f;
constexpr size_t MiB = 1u << 20;
#ifndef WS_RT_MIB
#define WS_RT_MIB 65
#endif
constexpr size_t WS_CTL = 0, CTL_BYTES = 131072;
constexpr size_t WS_MOD = 1 * MiB;
constexpr size_t WS_THR = 2 * MiB;
constexpr size_t WS_R128 = 3 * MiB;
constexpr size_t WS_R64 = 11 * MiB;
constexpr size_t WS_WOUT = 15 * MiB;
constexpr size_t WS_QA = 17 * MiB, WS_KA = 33 * MiB, WS_VA = 49 * MiB, WS_QI = 65 * MiB, WS_KI = 81 * MiB, WS_WI = 83 * MiB;
constexpr size_t WS_QR = 84 * MiB, WS_KR = 100 * MiB, WS_VR = 116 * MiB, WS_GR = 132 * MiB;
constexpr size_t WS_H = 148 * MiB;
constexpr size_t WS_WIN = 180 * MiB;
constexpr size_t WS_SCORES = 148 * MiB, WS_KVS = 214 * MiB, WS_MASKT = 246 * MiB, WS_RT = WS_RT_MIB * MiB, WS_MIXED = 148 * MiB;
constexpr int CW_BAR = 1024, CW_Q = 14400, CW_TMO = 14600;
constexpr int RING_BYTES = 131072;
constexpr int LDS_BYTES = 163840;
constexpr int MISC_OFF = LDS_BYTES - 1024;

typedef __bf16 bf16x2_t __attribute__((ext_vector_type(2)));
__device__ __forceinline__ unsigned cvt_pk(float lo, float hi) { const f32x2 v = {lo, hi}; const bf16x2_t b = __builtin_convertvector(v, bf16x2_t); return __builtin_bit_cast(unsigned, b); }
__device__ __forceinline__ float bf2f(bf16_t v) { return __uint_as_float((unsigned)v << 16); }
__device__ __forceinline__ float silu_f(float x) { return x / (1.f + __expf(-x)); }
#define MK_DPP_ADD(v, ctrl) v += __uint_as_float((unsigned)__builtin_amdgcn_update_dpp(0, (int)__float_as_uint(v), ctrl, 0xf, 0xf, false))
__device__ __forceinline__ float wave_sum(float v) {
    MK_DPP_ADD(v, 0xB1);
    MK_DPP_ADD(v, 0x4E);
    MK_DPP_ADD(v, 0x141);
    MK_DPP_ADD(v, 0x140);
    { const unsigned u = __float_as_uint(v); auto r = __builtin_amdgcn_permlane16_swap(u, u, false, false); v = __uint_as_float(r[0]) + __uint_as_float(r[1]); }
    { const unsigned u = __float_as_uint(v); auto r = __builtin_amdgcn_permlane32_swap(u, u, false, false); v = __uint_as_float(r[0]) + __uint_as_float(r[1]); }
    return v;
}
__host__ __device__ __forceinline__ int perm_fwd(int o, int half) { const int hi = o >= half ? 1 : 0, oo = o - hi * half; return 8 * (oo >> 2) + 4 * hi + (oo & 3); }
__host__ __device__ __forceinline__ int perm_inv(int p, int half) { const int g = p >> 3, r = p & 7; return (r < 4) ? 4 * g + r : half + 4 * g + (r - 4); }
__device__ __forceinline__ int in_src_col(int n) {
    const int tile = n >> 8;
    if (tile < 2) { const int s = n; return 0 + (s & ~63) + perm_inv(s & 63, 32); }
    if (tile < 4) { const int s = n - 512; return 512 + (s & ~63) + perm_inv(s & 63, 32); }
    if (tile < 6) return n;
    if (tile < 8) { const int s = n - 1536; return 1536 + (s & ~63) + perm_inv(s & 63, 32); }
    if (tile == 8) { const int s = n - 2048; if (s < 64) return 2048 + perm_inv(s, 32); if (s < 72) return 2112 + (s - 64); return -1; }
    const int s = n - 2304;
    if (tile < 11) return 2120 + (s & ~127) + perm_inv(s & 127, 64);
    if (tile < 13) { const int q = s - 512; return 2632 + (q & ~127) + perm_inv(q & 127, 64); }
    if (tile < 15) return 3144 + (s - 1024);
    return 3656 + (s - 1536);
}
__device__ __forceinline__ void p0_item_ada(LAS unsigned char* lds, const float* c, const float* w_ada, const float* b_ada, float* mod, int j, int tid) {
    LAS float* sc = (LAS float*)lds; LAS float* part = (LAS float*)(lds + 16384);
    __syncthreads();
    for (int i = tid; i < 4096; i += NTHR) sc[i] = silu_f(c[i]);
    __syncthreads();
    const int col = tid & 31, kg = tid >> 5;
    float a0 = 0.f, a1 = 0.f, a2 = 0.f, a3 = 0.f;
    const float* w = w_ada + 32 * j + col;
#pragma unroll 1
    for (int k0 = kg; k0 < 1024; k0 += 256) {
        float wv[16];
#pragma unroll
        for (int i = 0; i < 16; ++i) wv[i] = w[(size_t)(k0 + 16 * i) * 6144];
#pragma unroll
        for (int i = 0; i < 16; ++i) { const int k = k0 + 16 * i; a0 += sc[k] * wv[i]; a1 += sc[1024 + k] * wv[i]; a2 += sc[2048 + k] * wv[i]; a3 += sc[3072 + k] * wv[i]; }
    }
    part[(kg * 32 + col) * 4 + 0] = a0; part[(kg * 32 + col) * 4 + 1] = a1; part[(kg * 32 + col) * 4 + 2] = a2; part[(kg * 32 + col) * 4 + 3] = a3;
    __syncthreads();
    if (tid < 128) {
        const int cc = tid >> 2, b = tid & 3; float s = 0.f;
#pragma unroll
        for (int g = 0; g < 16; ++g) s += part[(g * 32 + cc) * 4 + b];
        mod[b * 6144 + 32 * j + cc] = s + b_ada[32 * j + cc];
    }
}
__device__ __forceinline__ void p0_item_rope(const int* pos, float* R128, float* R64, int r, int lane) {
    const float f128 = powf(10000.f, -(float)lane / 64.f), f64 = powf(10000.f, -(float)(lane & 31) / 32.f);
    for (int tt = 0; tt < 16; ++tt) {
        const int t = 16 * r + tt;
        float sn, cs; sincosf((float)pos[t] * f128, &sn, &cs);
        *(f32x2*)(R128 + ((size_t)t * 64 + lane) * 2) = (f32x2){cs, sn};
    }
    for (int tt = 0; tt < 16; tt += 2) {
        const int t = 16 * r + tt + (lane >> 5);
        float sn, cs; sincosf((float)pos[t] * f64, &sn, &cs);
        *(f32x2*)(R64 + ((size_t)t * 32 + (lane & 31)) * 2) = (f32x2){cs, sn};
    }
}
template <int MODE> struct TrItem { const float* sp; int ldw, Kdim, n0, k0; bf16_t* WT; bool valid; };
template <int MODE> __device__ __forceinline__ void p0_tr_setup(TrItem<MODE>& it, const float* W, const float* W2, int ldw, int Kdim, bf16_t* WT, int n0, int k0, int lane) {
    const int nl = lane & 31, n = n0 + nl;
    int src = n; const float* Ws = W;
    if (MODE == 0) src = in_src_col(n);
    if (MODE == 2) { const int g = n >> 3, r = n & 7; src = 4 * g + (r & 3); Ws = (r < 4) ? W : W2; }
    it.sp = Ws + (size_t)(k0 + (lane >> 5)) * ldw + (src >= 0 ? src : 0); it.ldw = ldw; it.Kdim = Kdim; it.n0 = n0; it.k0 = k0; it.WT = WT; it.valid = (src >= 0);
}
template <int MODE> __device__ __forceinline__ void p0_tr_load(const TrItem<MODE>& it, float (&tv)[32]) {
#pragma unroll
    for (int i = 0; i < 32; ++i) tv[i] = it.sp[(size_t)(2 * i) * it.ldw];
}
template <int MODE> __device__ __forceinline__ void p0_tr_emit(const TrItem<MODE>& it, const float (&tv)[32], LAS float* scr, int lane) {
    const int nl = lane & 31;
#pragma unroll
    for (int i = 0; i < 32; ++i) scr[(2 * i + (lane >> 5)) * 33 + nl] = it.valid ? tv[i] : 0.f;
    asm volatile("s_waitcnt lgkmcnt(0)" ::: "memory");
    const int c = lane & 7;
#pragma unroll
    for (int j = 0; j < 4; ++j) {
        const int nn = (lane >> 3) + 8 * j; const LAS float* q = scr + (8 * c) * 33 + nn;
        u32x4 o; o.x = cvt_pk(q[0 * 33], q[1 * 33]); o.y = cvt_pk(q[2 * 33], q[3 * 33]); o.z = cvt_pk(q[4 * 33], q[5 * 33]); o.w = cvt_pk(q[6 * 33], q[7 * 33]);
        *(u32x4*)(it.WT + (size_t)(it.n0 + nn) * it.Kdim + it.k0 + 8 * c) = o;
    }
    asm volatile("s_waitcnt lgkmcnt(0)" ::: "memory");
}
template <int MODE> __device__ __forceinline__ void p0_tr_item(const float* W, const float* W2, int ldw, int Kdim, bf16_t* WT, int n0, int k0, LAS float* scr, int lane) {
    TrItem<MODE> it; p0_tr_setup<MODE>(it, W, W2, ldw, Kdim, WT, n0, k0, lane);
    float tv[32]; p0_tr_load<MODE>(it, tv); p0_tr_emit<MODE>(it, tv, scr, lane);
}
struct P0Args { const float *c, *w_ada, *b_ada, *w_in, *w_out, *w_gate, *w_up, *w_down; const int* pos; float *mod, *R128, *R64; bf16_t *WIN, *WOUT, *WGU, *WD; };
__device__ __forceinline__ void p0_prologue(LAS unsigned char* lds, const P0Args& a, int bid, int G, int tid) {
    const int lane = tid & 63, wave = tid >> 6;
    if (bid < 192) p0_item_ada(lds, a.c, a.w_ada, a.b_ada, a.mod, bid, tid);
    __syncthreads();
    LAS float* scr = (LAS float*)(lds + wave * 8448);
    constexpr int I_ROPE = 1024, I_WIN = 16 * (NPHYS / 32), I_WOUT = 16 * 32;
    for (int it = bid * NWAVES + wave; it < I_ROPE + I_WIN + I_WOUT; it += G * NWAVES) {
        int r = it;
        if (r < I_ROPE) { p0_item_rope(a.pos, a.R128, a.R64, r, lane); continue; } r -= I_ROPE;
        if (r < I_WIN) { const int kb = r / (NPHYS / 32), nb = r - kb * (NPHYS / 32); p0_tr_item<0>(a.w_in, nullptr, INW, 1024, a.WIN, 32 * nb, 64 * kb, scr, lane); continue; } r -= I_WIN;
        { const int kb = r >> 5, nb = r & 31; p0_tr_item<1>(a.w_out, nullptr, 1024, 1024, a.WOUT, 32 * nb, 64 * kb, scr, lane); }
    }
}
__device__ __forceinline__ void p0_expert_items(LAS unsigned char* lds, const P0Args& a, int gw, int ngw, int tid) {
    const int lane = tid & 63, wave = tid >> 6;
    LAS float* scr = (LAS float*)(lds + wave * 8448);
    constexpr int I_WGU = 32 * 256, I_WD = 32 * 128;
    {
        TrItem<2> cur, nxt; float tv[32], tn[32];
        int it = gw;
        if (it < I_WGU) { const int e = it >> 8, q = it & 255, kb = q >> 4, nb = q & 15;
            p0_tr_setup<2>(cur, a.w_gate + (size_t)e * 262144, a.w_up + (size_t)e * 262144, 256, 1024, a.WGU + (size_t)e * 524288, 32 * nb, 64 * kb, lane); p0_tr_load<2>(cur, tv); }
#pragma unroll 1
        for (; it < I_WGU; it += ngw) {
            const int i2 = it + ngw; const bool has = i2 < I_WGU;
            if (has) { const int e = i2 >> 8, q = i2 & 255, kb = q >> 4, nb = q & 15;
                p0_tr_setup<2>(nxt, a.w_gate + (size_t)e * 262144, a.w_up + (size_t)e * 262144, 256, 1024, a.WGU + (size_t)e * 524288, 32 * nb, 64 * kb, lane); p0_tr_load<2>(nxt, tn); }
            p0_tr_emit<2>(cur, tv, scr, lane);
            if (has) { cur = nxt;
#pragma unroll
                for (int i = 0; i < 32; ++i) tv[i] = tn[i]; }
        }
    }
    {
        TrItem<1> cur, nxt; float tv[32], tn[32];
        int it = gw;
        if (it < I_WD) { const int e = it >> 7, q = it & 127, kb = q >> 5, nb = q & 31;
            p0_tr_setup<1>(cur, a.w_down + (size_t)e * 262144, nullptr, 1024, 256, a.WD + (size_t)e * 262144, 32 * nb, 64 * kb, lane); p0_tr_load<1>(cur, tv); }
#pragma unroll 1
        for (; it < I_WD; it += ngw) {
            const int i2 = it + ngw; const bool has = i2 < I_WD;
            if (has) { const int e = i2 >> 7, q = i2 & 127, kb = q >> 5, nb = q & 31;
                p0_tr_setup<1>(nxt, a.w_down + (size_t)e * 262144, nullptr, 1024, 256, a.WD + (size_t)e * 262144, 32 * nb, 64 * kb, lane); p0_tr_load<1>(nxt, tn); }
            p0_tr_emit<1>(cur, tv, scr, lane);
            if (has) { cur = nxt;
#pragma unroll
                for (int i = 0; i < 32; ++i) tv[i] = tn[i]; }
        }
    }
}
__device__ __forceinline__ void p1_rows(const float* x, const float* g, const float* mod, bf16_t* H, int gw, int NGW, int lane) {
    for (int m = gw; m < T; m += NGW) {
        const int b = m / S;
        const f32x4* xr = (const f32x4*)(x + (size_t)m * D) + lane;
        f32x4 v[4]; float s = 0.f;
#pragma unroll
        for (int j = 0; j < 4; ++j) { v[j] = xr[64 * j]; s += (v[j].x * v[j].x + v[j].y * v[j].y) + (v[j].z * v[j].z + v[j].w * v[j].w); }
        const float rs = 1.0f / sqrtf(wave_sum(s) * (1.f / 1024.f) + 1e-6f);
        const float* sh = mod + b * 6144; const float* sc = sh + 1024;
        bf16_t* orow = H + (size_t)m * D;
#pragma unroll
        for (int j = 0; j < 4; ++j) {
            const int col = 4 * lane + 256 * j;
            const f32x4 gg = *(const f32x4*)(g + col), a = *(const f32x4*)(sc + col), bb = *(const f32x4*)(sh + col);
            const f32x4 o = v[j] * rs * gg * (a + 1.0f) + bb;
            u32x2 w; w.x = cvt_pk(o.x, o.y); w.y = cvt_pk(o.z, o.w);
            *(u32x2*)(orow + col) = w;
        }
    }
}
struct EpiInProj {
    static constexpr bool PERM = true, AFTER_DRAIN = false;
    bf16_t *QA, *KA, *VA, *QI, *KI, *QR, *KR, *VR, *GR; float* WI; const float* R64; const float* R128;
    template <int ROPE, int ACT> __device__ __forceinline__ void emit(const pg8::f32x4 (&acc)[2][2][4][2], bf16_t* dst, int ld, int segbase, float scale, int row0, int wc, int fq, int bjmask) const {
#pragma unroll
        for (int bj = 0; bj < 2; ++bj) {
            if (!((bjmask >> bj) & 1)) continue;
            const int cg = segbase + 128 * bj + 32 * wc + 8 * fq;
            const int fi = (ROPE == 1) ? ((cg & 63) >> 1) : ((cg & 127) >> 1);
#pragma unroll
            for (int ai = 0; ai < 2; ++ai)
#pragma unroll
                for (int m = 0; m < 4; ++m) {
                    const int row = row0 + ai * 128 + m * 16;
                    pg8::f32x4 v0 = acc[ai][bj][m][0], v1 = acc[ai][bj][m][1];
                    if (ROPE != 0) {
                        const float* tp = (ROPE == 1) ? (R64 + ((size_t)row * 32 + fi) * 2) : (R128 + ((size_t)row * 64 + fi) * 2);
                        const pg8::f32x4 t0 = *(const pg8::f32x4*)tp, t1 = *(const pg8::f32x4*)(tp + 4);
                        pg8::f32x4 o1, o2;
                        o1[0] = v0[0] * t0[0] - v1[0] * t0[1]; o2[0] = v1[0] * t0[0] + v0[0] * t0[1];
                        o1[1] = v0[1] * t0[2] - v1[1] * t0[3]; o2[1] = v1[1] * t0[2] + v0[1] * t0[3];
                        o1[2] = v0[2] * t1[0] - v1[2] * t1[1]; o2[2] = v1[2] * t1[0] + v0[2] * t1[1];
                        o1[3] = v0[3] * t1[2] - v1[3] * t1[3]; o2[3] = v1[3] * t1[2] + v0[3] * t1[3];
                        v0 = o1; v1 = o2;
                    }
                    if (ACT == 1) {
#pragma unroll
                        for (int e = 0; e < 4; ++e) { v0[e] = silu_f(v0[e]); v1[e] = silu_f(v1[e]); }
                    }
                    v0 = v0 * scale; v1 = v1 * scale;
                    u32x4 w; w.x = cvt_pk(v0[0], v0[1]); w.y = cvt_pk(v0[2], v0[3]); w.z = cvt_pk(v1[0], v1[1]); w.w = cvt_pk(v1[2], v1[3]);
                    *(u32x4*)(dst + (size_t)row * ld + cg) = w;
                }
        }
    }
    __device__ __forceinline__ void operator()(const pg8::f32x4 (&acc)[2][2][4][2], const pg8::Unit& u, int wr, int wc, int fr, int fq) const {
        const int row0 = u.pm * 256 + wr * 64 + fr;
        const int pn = u.pn;
        if (pn < 2) emit<1, 0>(acc, QA, 512, pn * 256, C2, row0, wc, fq, 3);
        else if (pn < 4) emit<1, 0>(acc, KA, 512, (pn - 2) * 256, 1.f, row0, wc, fq, 3);
        else if (pn < 6) emit<0, 0>(acc, VA, 512, (pn - 4) * 256, 1.f, row0, wc, fq, 3);
        else if (pn < 8) emit<1, 0>(acc, QI, 512, (pn - 6) * 256, 1.f, row0, wc, fq, 3);
        else if (pn == 8) {
            if (wc < 2) emit<1, 0>(acc, KI, 64, 0, 1.f, row0, wc, fq, 1);
            else if (wc == 2 && fq == 0) {
#pragma unroll
                for (int ai = 0; ai < 2; ++ai)
#pragma unroll
                    for (int m = 0; m < 4; ++m) {
                        const int row = row0 + ai * 128 + m * 16;
                        *(pg8::f32x4*)(WI + (size_t)row * 8) = acc[ai][0][m][0] * WI_SCALE;
                        *(pg8::f32x4*)(WI + (size_t)row * 8 + 4) = acc[ai][0][m][1] * WI_SCALE;
                    }
            }
        }
        else if (pn < 11) emit<2, 0>(acc, QR, 512, (pn - 9) * 256, 1.f, row0, wc, fq, 3);
        else if (pn < 13) emit<2, 0>(acc, KR, 512, (pn - 11) * 256, KR_SCALE, row0, wc, fq, 3);
        else if (pn < 15) emit<0, 0>(acc, VR, 512, (pn - 13) * 256, 1.f, row0, wc, fq, 3);
        else emit<0, 1>(acc, GR, 512, (pn - 15) * 256, 1.f, row0, wc, fq, 3);
    }
};
typedef short v4i16_t __attribute__((ext_vector_type(4)));
__device__ __forceinline__ unsigned off_b(unsigned row, unsigned ch) { return 256u * row + 16u * (ch ^ (((row & 3u) << 2) | ((row >> 2) & 3u))); }
__device__ __forceinline__ int crow(int r, int hi) { return (r & 3) + 8 * (r >> 2) + 4 * hi; }
__device__ __forceinline__ v4i16_t tr_rd(LAS unsigned char* p) { return __builtin_amdgcn_ds_read_tr16_b64_v4i16((LAS v4i16_t*)p); }
__device__ __forceinline__ bf16x8 tr_frag_nat(LAS unsigned char* img, int lane, int c, int ks) {
    const unsigned h = lane >> 5, blk = (lane >> 4) & 1, q = (lane & 15) >> 2, p = lane & 3;
    const v4i16_t lo = tr_rd(img + off_b(16 * ks + 8 * h + q, 4 * c + 2 * blk + (p >> 1)) + 8 * (p & 1));
    const v4i16_t hi = tr_rd(img + off_b(16 * ks + 8 * h + 4 + q, 4 * c + 2 * blk + (p >> 1)) + 8 * (p & 1));
    return (bf16x8){lo[0], lo[1], lo[2], lo[3], hi[0], hi[1], hi[2], hi[3]};
}
__device__ __forceinline__ bf16x8 tr_frag_acc(LAS unsigned char* img, int lane, int c, int rowbase) {
    const unsigned h = lane >> 5, blk = (lane >> 4) & 1, q = (lane & 15) >> 2, p = lane & 3;
    const v4i16_t lo = tr_rd(img + off_b(rowbase + 4 * h + q, 4 * c + 2 * blk + (p >> 1)) + 8 * (p & 1));
    const v4i16_t hi = tr_rd(img + off_b(rowbase + 8 + 4 * h + q, 4 * c + 2 * blk + (p >> 1)) + 8 * (p & 1));
    return (bf16x8){lo[0], lo[1], lo[2], lo[3], hi[0], hi[1], hi[2], hi[3]};
}
__device__ __forceinline__ float ret_lgam(int h) { return logf(1.0f - exp2f(-5.0f - (float)h)); }
template <bool SCALE> __device__ __forceinline__ void ret_stage(LAS unsigned char* img, const bf16_t* src  , float sc, int tl) {
#pragma unroll
    for (int it = 0; it < 8; ++it) {
        const int idx = tl + 256 * it, row = idx >> 4, ch = idx & 15;
        u32x4 v = *(const u32x4*)(src + (size_t)row * 512 + ch * 8);
        if (SCALE) {
            const float f = expf(sc * (float)row);
#pragma unroll
            for (int e = 0; e < 4; ++e) { const unsigned w = v[e]; v[e] = cvt_pk(__uint_as_float(w << 16) * f, __uint_as_float(w & 0xffff0000u) * f); }
        }
        *(LAS u32x4*)(img + off_b(row, ch)) = v;
    }
}
__device__ __forceinline__ void ret_kv_pair(LAS unsigned char* lds, const bf16_t* KR, const bf16_t* VR, float* KVS, int pair, int tid) {
    const int uh = tid >> 8, tl = tid & 255, lane = tid & 63, w4 = __builtin_amdgcn_readfirstlane((tid >> 6) & 3), hi = lane >> 5, r32 = lane & 31;
    const int unit = pair * 2 + uh, n = unit & 31, bh = unit >> 5, b = bh >> 2, h = bh & 3;
    const size_t tok0 = (size_t)b * S + (size_t)n * 128;
    LAS unsigned char* kimg = lds + uh * 65536; LAS unsigned char* vimg = kimg + 32768;
    const float lgam = ret_lgam(h);
    __syncthreads();
    ret_stage<false>(kimg, KR + tok0 * 512 + h * 128, 0.f, tl);
    ret_stage<true>(vimg, VR + tok0 * 512 + h * 128, -lgam, tl);
    __syncthreads();
    f32x16 acc[4];
#pragma unroll
    for (int c = 0; c < 4; ++c) acc[c] = (f32x16){};
#pragma unroll
    for (int ks = 0; ks < 8; ++ks) {
        const bf16x8 a = tr_frag_nat(vimg, lane, w4, ks);
#pragma unroll
        for (int nt = 0; nt < 4; ++nt) { const bf16x8 bb = tr_frag_nat(kimg, lane, nt, ks); acc[nt] = __builtin_amdgcn_mfma_f32_32x32x16_bf16(a, bb, acc[nt], 0, 0, 0); }
    }
    const float sc = expf(lgam * 127.f);
    float* o = KVS + (size_t)unit * 16384;
#pragma unroll
    for (int nt = 0; nt < 4; ++nt)
#pragma unroll
        for (int r = 0; r < 16; ++r) o[(32 * w4 + crow(r, hi)) * 128 + 32 * nt + r32] = acc[nt][r] * sc;
}
__device__ __forceinline__ void ret_scan(const float* __restrict__ KVS, bf16_t* __restrict__ RT, int gtid, int nthreads) {
    for (int idx = gtid; idx < 16 * 16384; idx += nthreads) {
        const int bh = idx >> 14, el = idx & 16383, h = bh & 3;
        const float g = 1.0f - exp2f(-5.0f - (float)h), g128 = expf(128.f * ret_lgam(h));
        const size_t o0 = ((size_t)(bh * 32) << 14) + el;
        float kv[31];
#pragma unroll
        for (int n = 0; n < 31; ++n) kv[n] = KVS[o0 + ((size_t)n << 14)];
        float R = 0.f;
#pragma unroll
        for (int n = 0; n < 32; ++n) {
            RT[o0 + ((size_t)n << 14)] = (bf16_t)(cvt_pk(g * R, 0.f) & 0xffffu);
            if (n < 31) R = g128 * R + kv[n];
        }
    }
}
__device__ __forceinline__ void ret_out_pair(LAS unsigned char* lds, const bf16_t* QR, const bf16_t* KR, const bf16_t* VR, const bf16_t* GR, const bf16_t* RT, bf16_t* MIXED, int pair, int tid) {
    const int uh = tid >> 8, tl = tid & 255, lane = tid & 63, w4 = __builtin_amdgcn_readfirstlane((tid >> 6) & 3), hi = lane >> 5, r32 = lane & 31;
    const int unit = pair * 2 + uh, n = unit & 31, bh = unit >> 5, b = bh >> 2, h = bh & 3;
    const size_t tok0 = (size_t)b * S + (size_t)n * 128;
    LAS unsigned char* vimg = lds + uh * 32768;
    const float lgam = ret_lgam(h);
    __syncthreads();
    ret_stage<true>(vimg, VR + tok0 * 512 + h * 128, -lgam, tl);
    __syncthreads();
    bf16x8 qf[8];
    {
        const bf16_t* qp = QR + (tok0 + 32 * w4 + r32) * 512 + h * 128 + 8 * hi;
#pragma unroll
        for (int ks = 0; ks < 8; ++ks) qf[ks] = *(const bf16x8*)(qp + 16 * ks);
    }
    f32x16 acc[4];
#pragma unroll
    for (int c = 0; c < 4; ++c) acc[c] = (f32x16){};
    if (n > 0) {
        const bf16_t* rp = RT + (size_t)unit * 16384 + r32 * 128 + 8 * hi;
#pragma unroll
        for (int c = 0; c < 4; ++c)
#pragma unroll
            for (int ks = 0; ks < 8; ++ks) { const bf16x8 a = *(const bf16x8*)(rp + c * 32 * 128 + 16 * ks); acc[c] = __builtin_amdgcn_mfma_f32_32x32x16_bf16(a, qf[ks], acc[c], 0, 0, 0); }
    }
    for (int jt = 0; jt <= w4; ++jt) {
        const bf16_t* kp = KR + (tok0 + 32 * jt + r32) * 512 + h * 128 + 8 * hi;
        f32x16 st = (f32x16){};
#pragma unroll
        for (int ks = 0; ks < 8; ++ks) { const bf16x8 kf = *(const bf16x8*)(kp + 16 * ks); st = __builtin_amdgcn_mfma_f32_32x32x16_bf16(kf, qf[ks], st, 0, 0, 0); }
        if (jt == w4) {
#pragma unroll
            for (int r = 0; r < 16; ++r) if (crow(r, hi) > r32) st[r] = 0.f;
        }
#pragma unroll
        for (int s = 0; s < 2; ++s) {
            u32x4 pw; pw.x = cvt_pk(st[8 * s + 0], st[8 * s + 1]); pw.y = cvt_pk(st[8 * s + 2], st[8 * s + 3]); pw.z = cvt_pk(st[8 * s + 4], st[8 * s + 5]); pw.w = cvt_pk(st[8 * s + 6], st[8 * s + 7]);
            const bf16x8 pb = __builtin_bit_cast(bf16x8, pw);
#pragma unroll
            for (int c = 0; c < 4; ++c) { const bf16x8 vf = tr_frag_acc(vimg, lane, c, 32 * jt + 16 * s); acc[c] = __builtin_amdgcn_mfma_f32_32x32x16_bf16(vf, pb, acc[c], 0, 0, 0); }
        }
    }
    float ss = 0.f;
#pragma unroll
    for (int c = 0; c < 4; ++c)
#pragma unroll
        for (int r = 0; r < 16; ++r) ss += acc[c][r] * acc[c][r];
    ss += __shfl_xor(ss, 32);
    const float gi = expf(lgam * (float)(32 * w4 + r32));
    const float fac = gi / sqrtf(gi * gi * ss * (1.0f / 128.f) + 1e-6f);
    const size_t tok = tok0 + 32 * w4 + r32;
    const bf16_t* gp = GR + tok * 512 + h * 128 + 4 * hi;
    bf16_t* op = MIXED + tok * 1024 + 512 + h * 128 + 4 * hi;
#pragma unroll
    for (int c = 0; c < 4; ++c)
#pragma unroll
        for (int g4 = 0; g4 < 4; ++g4) {
            const u32x2 gv = *(const u32x2*)(gp + 32 * c + 8 * g4);
            const float g0 = __uint_as_float(gv.x << 16), g1 = __uint_as_float(gv.x & 0xffff0000u), g2 = __uint_as_float(gv.y << 16), g3 = __uint_as_float(gv.y & 0xffff0000u);
            u32x2 w; w.x = cvt_pk(acc[c][4 * g4 + 0] * fac * g0, acc[c][4 * g4 + 1] * fac * g1); w.y = cvt_pk(acc[c][4 * g4 + 2] * fac * g2, acc[c][4 * g4 + 3] * fac * g3);
            *(u32x2*)(op + 32 * c + 8 * g4) = w;
        }
}
constexpr size_t WS_MIX = 17 * MiB;
constexpr size_t WS_H2 = 49 * MiB;
constexpr size_t WS_LIST = 81 * MiB;
constexpr size_t WS_HID = 85 * MiB;
constexpr size_t WS_Y = 105 * MiB;
constexpr size_t WS_HRES = 180 * MiB;
constexpr int CW_CNT = 12288;
constexpr int CW_TILE = 16384;
constexpr int TB_OFF = MISC_OFF + 64;

struct EpiStore {
    static constexpr bool PERM = true, AFTER_DRAIN = false;
    bf16_t* O; int ld;
    __device__ __forceinline__ void operator()(const pg8::f32x4 (&acc)[2][2][4][2], const pg8::Unit& u, int wr, int wc, int fr, int fq) const {
        const int row0 = u.pm * 256 + wr * 64 + fr, col0 = u.pn * 256 + wc * 32 + 8 * fq;
#pragma unroll
        for (int ai = 0; ai < 2; ++ai)
#pragma unroll
            for (int m = 0; m < 4; ++m)
#pragma unroll
                for (int bj = 0; bj < 2; ++bj) {
                    const pg8::f32x4 v0 = acc[ai][bj][m][0], v1 = acc[ai][bj][m][1];
                    u32x4 w; w.x = cvt_pk(v0[0], v0[1]); w.y = cvt_pk(v0[2], v0[3]); w.z = cvt_pk(v1[0], v1[1]); w.w = cvt_pk(v1[2], v1[3]);
                    *(u32x4*)(O + (size_t)(row0 + ai * 128 + m * 16) * ld + col0 + bj * 128) = w;
                }
    }
};
struct P6bArgs { const bf16_t* MIX; const float *x, *g_post, *g_pre2, *mod, *w_group, *b_group, *w_expert, *b_expert; float* HRES; bf16_t* H2; unsigned* cnt; u32x2* LIST; };
constexpr int P6B_NR = 4;
constexpr int RT_WL_OFF = 147456;
__device__ __forceinline__ void p6b_load_weights(LAS unsigned char* lds, const float* w_group, const float* w_expert, int tid) {
    __syncthreads();
    for (int idx = tid; idx < 1024 * 9; idx += NTHR) {
        const int d = idx / 9, cc = idx - 9 * d, pos = ((d >> 2) & 63) + 64 * ((d & 3) + 4 * (d >> 8));
        const f32x4 v = (cc == 0) ? *(const f32x4*)(w_group + d * 4) : *(const f32x4*)(w_expert + d * 32 + 4 * (cc - 1));
        *(LAS f32x4*)(lds + pos * 144 + 16 * cc) = v;
    }
    __syncthreads();
}
struct P6bIn { u32x2 mw[P6B_NR][4]; f32x4 xv[P6B_NR][4]; };
__device__ __forceinline__ void p6b_load(P6bIn& I, const P6bArgs& a, int gw, int lane) {
    const int m0 = gw * P6B_NR;
#pragma unroll
    for (int r = 0; r < P6B_NR; ++r)
#pragma unroll
        for (int j = 0; j < 4; ++j) I.mw[r][j] = *(const u32x2*)(a.MIX + (size_t)(m0 + r) * 1024 + 4 * lane + 256 * j);
#pragma unroll
    for (int r = 0; r < P6B_NR; ++r)
#pragma unroll
        for (int j = 0; j < 4; ++j) I.xv[r][j] = *(const f32x4*)(a.x + (size_t)(m0 + r) * 1024 + 4 * lane + 256 * j);
}
__device__ __forceinline__ void p6b_norm(const P6bArgs& a, const P6bIn& I, f32x2 (&hp)[P6B_NR][8], int gw, int lane) {
    const int m0 = gw * P6B_NR, b = m0 / S;
    const float* md = a.mod + b * 6144;
#pragma unroll
    for (int r = 0; r < P6B_NR; ++r) {
        const size_t row = (size_t)(m0 + r);
        float v[16]; float s = 0.f;
#pragma unroll
        for (int j = 0; j < 4; ++j) {
            const u32x2 w = I.mw[r][j];
            v[4 * j + 0] = __uint_as_float(w.x << 16); v[4 * j + 1] = __uint_as_float(w.x & 0xffff0000u); v[4 * j + 2] = __uint_as_float(w.y << 16); v[4 * j + 3] = __uint_as_float(w.y & 0xffff0000u);
#pragma unroll
            for (int k = 0; k < 4; ++k) s += v[4 * j + k] * v[4 * j + k];
        }
        const float rs = 1.0f / sqrtf(wave_sum(s) * (1.f / 1024.f) + 1e-6f);
        float s2 = 0.f;
#pragma unroll
        for (int j = 0; j < 4; ++j) {
            const int col = 4 * lane + 256 * j;
            const f32x4 xx = I.xv[r][j], gp = *(const f32x4*)(a.g_post + col), g1 = *(const f32x4*)(md + 2 * 1024 + col);
            f32x4 hr;
#pragma unroll
            for (int k = 0; k < 4; ++k) { hr[k] = xx[k] + g1[k] * (v[4 * j + k] * rs * gp[k]); v[4 * j + k] = hr[k]; s2 += hr[k] * hr[k]; }
        }
        const float rs2 = 1.0f / sqrtf(wave_sum(s2) * (1.f / 1024.f) + 1e-6f);
#pragma unroll
        for (int j = 0; j < 4; ++j) {
            const int col = 4 * lane + 256 * j;
            const f32x4 g2 = *(const f32x4*)(a.g_pre2 + col), sc = *(const f32x4*)(md + 4 * 1024 + col), sh = *(const f32x4*)(md + 3 * 1024 + col);
            float h[4];
#pragma unroll
            for (int k = 0; k < 4; ++k) h[k] = v[4 * j + k] * rs2 * g2[k] * (1.f + sc[k]) + sh[k];
            u32x2 w; w.x = cvt_pk(h[0], h[1]); w.y = cvt_pk(h[2], h[3]);
            *(u32x2*)(a.H2 + row * 1024 + col) = w;
            hp[r][2 * j + 0] = (f32x2){__uint_as_float(w.x << 16), __uint_as_float(w.x & 0xffff0000u)}; hp[r][2 * j + 1] = (f32x2){__uint_as_float(w.y << 16), __uint_as_float(w.y & 0xffff0000u)};
        }
    }
}
template <int HI> __device__ __forceinline__ void pk_fma_bcast(f32x2& acc, const f32x2 w, const f32x2 h) {
    if (HI) asm("v_pk_fma_f32 %0, %1, %2, %0 op_sel:[0,1,0] op_sel_hi:[1,1,1]" : "+v"(acc) : "v"(w), "v"(h));
    else    asm("v_pk_fma_f32 %0, %1, %2, %0 op_sel:[0,0,0] op_sel_hi:[1,0,1]" : "+v"(acc) : "v"(w), "v"(h));
}
__device__ __forceinline__ void p6b_router(const LAS unsigned char* wtab, LAS float* wl  , const f32x2 (&hp)[P6B_NR][8], int lane) {
#pragma unroll 1
    for (int c = 0; c < 9; ++c) {
        f32x2 acc[P6B_NR][2];
#pragma unroll
        for (int r = 0; r < P6B_NR; ++r) { acc[r][0] = (f32x2){0.f, 0.f}; acc[r][1] = (f32x2){0.f, 0.f}; }
#pragma unroll
        for (int j = 0; j < 4; ++j)
#pragma unroll
            for (int k = 0; k < 4; ++k) {
                const f32x4 w4 = *(const LAS f32x4*)(wtab + (lane + 64 * (k + 4 * j)) * 144 + 16 * c);
                const f32x2 wa = {w4[0], w4[1]}, wb = {w4[2], w4[3]};
#pragma unroll
                for (int r = 0; r < P6B_NR; ++r) {
                    if (k & 1) { pk_fma_bcast<1>(acc[r][0], wa, hp[r][2 * j + (k >> 1)]); pk_fma_bcast<1>(acc[r][1], wb, hp[r][2 * j + (k >> 1)]); }
                    else       { pk_fma_bcast<0>(acc[r][0], wa, hp[r][2 * j + (k >> 1)]); pk_fma_bcast<0>(acc[r][1], wb, hp[r][2 * j + (k >> 1)]); }
                }
            }
        asm volatile("s_nop 1" : "+v"(acc[0][0]), "+v"(acc[0][1]), "+v"(acc[1][0]), "+v"(acc[1][1]), "+v"(acc[2][0]), "+v"(acc[2][1]), "+v"(acc[3][0]), "+v"(acc[3][1]));
        float v[16];
#pragma unroll
        for (int r = 0; r < P6B_NR; ++r) { v[4 * r + 0] = acc[r][0][0]; v[4 * r + 1] = acc[r][0][1]; v[4 * r + 2] = acc[r][1][0]; v[4 * r + 3] = acc[r][1][1]; }
        float s8[8], t4[4];
#pragma unroll
        for (int i = 0; i < 8; ++i) { auto q = __builtin_amdgcn_permlane32_swap(__float_as_uint(v[i]), __float_as_uint(v[i + 8]), false, false); s8[i] = __uint_as_float(q[0]) + __uint_as_float(q[1]); }
#pragma unroll
        for (int i = 0; i < 4; ++i) { auto q = __builtin_amdgcn_permlane16_swap(__float_as_uint(s8[i]), __float_as_uint(s8[i + 4]), false, false); t4[i] = __uint_as_float(q[0]) + __uint_as_float(q[1]); }
#pragma unroll
        for (int i = 0; i < 4; ++i) MK_DPP_ADD(t4[i], 0x128);
        float u0 = (lane & 8) ? t4[1] : t4[0], u1 = (lane & 8) ? t4[3] : t4[2];
        MK_DPP_ADD(u0, 0x141); MK_DPP_ADD(u1, 0x141);
        float w = (lane & 4) ? u1 : u0;
        MK_DPP_ADD(w, 0x1B);
        MK_DPP_ADD(w, 0xB1);
        if ((lane & 3) == 0) wl[(lane >> 4) * 36 + 4 * c + 2 * ((lane >> 2) & 1) + ((lane >> 3) & 1)] = w;
    }
    asm volatile("s_waitcnt lgkmcnt(0)" ::: "memory");
}
__device__ __forceinline__ void p6b_route(const P6bArgs& a, const LAS float* wl, int gw, int lane) {
    const int m0 = gw * P6B_NR;
    if (lane < P6B_NR) {
        const LAS float* lg = wl + lane * 36;
        float gm = lg[0] + a.b_group[0]; int gs = 0; float l1 = lg[1] + a.b_group[1], l2 = lg[2] + a.b_group[2], l3 = lg[3] + a.b_group[3];
        const float l0 = gm;
        if (l1 > gm) { gm = l1; gs = 1; } if (l2 > gm) { gm = l2; gs = 2; } if (l3 > gm) { gm = l3; gs = 3; }
        const float gtop = 1.0f / (expf(l0 - gm) + expf(l1 - gm) + expf(l2 - gm) + expf(l3 - gm));
        float el[8];
#pragma unroll
        for (int i = 0; i < 8; ++i) el[i] = lg[4 + gs * 8 + i] + a.b_expert[gs * 8 + i];
        float b1 = el[0]; int i1 = 0;
#pragma unroll
        for (int i = 1; i < 8; ++i) if (el[i] > b1) { b1 = el[i]; i1 = i; }
        float b2 = -INFINITY; int i2 = 0;
#pragma unroll
        for (int i = 0; i < 8; ++i) if (i != i1 && el[i] > b2) { b2 = el[i]; i2 = i; }
        const float p2 = expf(b2 - b1), den = 1.0f + p2;
        const float w0 = gtop / den, w1 = gtop * p2 / den;
        const int e0 = gs * 8 + i1, e1 = gs * 8 + i2;
        const unsigned tok = (unsigned)(m0 + lane);
        const unsigned pos0 = atomicAdd(a.cnt + 64 * e0, 1u), pos1 = atomicAdd(a.cnt + 64 * e1, 1u);
        a.LIST[(size_t)e0 * 16384 + pos0] = (u32x2){tok, __float_as_uint(w0)};
        a.LIST[(size_t)e1 * 16384 + pos1] = (u32x2){tok | 0x80000000u, __float_as_uint(w1)};
    }
}
__device__ __forceinline__ void p6b_rows(const P6bArgs& a, const LAS unsigned char* wtab, LAS float* wl, int gw0, int stride, int lane, bool dry) {
    constexpr int NG = T / P6B_NR;
    if (gw0 >= NG) return;
    P6bIn I; f32x2 hp[P6B_NR][8];
    p6b_load(I, a, gw0, lane);
#pragma unroll 1
    for (int gw = gw0; gw < NG; gw += stride) {
        p6b_norm(a, I, hp, gw, lane);
        if (gw + stride < NG) p6b_load(I, a, gw + stride, lane);
        p6b_router(wtab, wl, hp, lane);
        if (!dry) p6b_route(a, wl, gw, lane);
    }
}
template <int ROLE> struct MoeSched {
    const u32x2* LIST; LAS int* tb; int G, c, NJ;
    unsigned* tilecnt;
    unsigned* tmo;
    int tlo, thi;
    __device__ __forceinline__ bool next(int i, pg8::Unit& u) const {
        if (c < 0) return false;
        const int L = i * G + c, TT = (thi < tb[32]) ? thi : tb[32];
        const int tg = tlo + L / NJ, j = L % NJ;
        if (tg >= TT) return false;
        int e = 0;
#pragma unroll 1
        for (int k = 1; k < 32; ++k) e += (tb[k] <= tg) ? 1 : 0;
        u.pm = tg; u.pn = e * NJ + j; return true;
    }
    __device__ __forceinline__ int arow(const pg8::Unit& u, int r) const {
        const int e = u.pn / NJ, idx = (u.pm - tb[e]) * 256 + r;
        return (idx < tb[33 + e]) ? (int)(LIST[(size_t)e * 16384 + idx].x & 0x7fffffffu) : 0;
    }
    __device__ __forceinline__ void a_ready(const pg8::Unit&) const {}
    __device__ __forceinline__ void done(const pg8::Unit& u) const {
        if (ROLE != 1) return;
        asm volatile("s_waitcnt vmcnt(0)" ::: "memory");
        if (mk_lane() == 0) __hip_atomic_fetch_add(tilecnt + 64 * u.pm, 1u, __ATOMIC_RELAXED, __HIP_MEMORY_SCOPE_AGENT);
    }
};
__device__ __forceinline__ void moe_wait(const MoeSched<2>& S) {
    if (mk_wave() == 0) {
        pg8::Unit u;
        for (int i = 0; S.next(i, u); ++i) {
            unsigned sp = 0;
            while ((unsigned)__builtin_amdgcn_readfirstlane(__hip_atomic_load(S.tilecnt + 64 * u.pm, __ATOMIC_RELAXED, __HIP_MEMORY_SCOPE_AGENT)) < 16u) {
                __builtin_amdgcn_s_sleep(2);
                if (++sp > (1u << 22)) { __hip_atomic_store(S.tmo, 1u, __ATOMIC_RELAXED, __HIP_MEMORY_SCOPE_AGENT); break; }
            }
        }
        __builtin_amdgcn_fence(__ATOMIC_ACQUIRE, "agent");
        asm volatile("s_waitcnt vmcnt(0)" ::: "memory");
    }
    __syncthreads();
}
__device__ __forceinline__ void moe_table(LAS int* tb, const unsigned* cnt, int tid) {
    __syncthreads();
    if (tid < 32) tb[33 + tid] = (int)__hip_atomic_load(cnt + 64 * tid, __ATOMIC_RELAXED, __HIP_MEMORY_SCOPE_AGENT);
    __syncthreads();
    if (tid == 0) { int s = 0; for (int e = 0; e < 32; ++e) { tb[e] = s; s += (tb[33 + e] + 255) >> 8; } tb[32] = s; }
    __syncthreads();
}
struct EpiGU {
    static constexpr bool PERM = true, AFTER_DRAIN = false;
    bf16_t* HID;
    __device__ __forceinline__ void operator()(const pg8::f32x4 (&acc)[2][2][4][2], const pg8::Unit& u, int wr, int wc, int fr, int fq) const {
        const int row0 = u.pm * 256 + wr * 64 + fr, hc0 = (u.pn & 1) * 128 + 16 * wc + 4 * fq;
#pragma unroll
        for (int ai = 0; ai < 2; ++ai)
#pragma unroll
            for (int m = 0; m < 4; ++m)
#pragma unroll
                for (int bj = 0; bj < 2; ++bj) {
                    const pg8::f32x4 g = acc[ai][bj][m][0], up = acc[ai][bj][m][1];
                    u32x2 w; w.x = cvt_pk(silu_f(g[0]) * up[0], silu_f(g[1]) * up[1]); w.y = cvt_pk(silu_f(g[2]) * up[2], silu_f(g[3]) * up[3]);
                    __hip_atomic_store((unsigned long long*)(HID + (size_t)(row0 + ai * 128 + m * 16) * 256 + hc0 + bj * 64), (unsigned long long)w.x | ((unsigned long long)w.y << 32), __ATOMIC_RELAXED, __HIP_MEMORY_SCOPE_AGENT);
                }
    }
};
struct EpiDown {
    static constexpr bool PERM = true, AFTER_DRAIN = false;
    bf16_t* Y; const u32x2* LIST; LAS int* tb;
    __device__ __forceinline__ void operator()(const pg8::f32x4 (&acc)[2][2][4][2], const pg8::Unit& u, int wr, int wc, int fr, int fq) const {
        const int e = u.pn >> 2, j = u.pn & 3, ti = u.pm - tb[e], cn = tb[33 + e];
        const int col0 = 256 * j + 32 * wc + 8 * fq;
        const int idx0 = ti * 256 + wr * 64 + fr;
#pragma unroll
        for (int ai = 0; ai < 2; ++ai) {
            u32x2 ent[4];
#pragma unroll
            for (int m = 0; m < 4; ++m) { const int idx = idx0 + ai * 128 + m * 16; ent[m] = (idx < cn) ? LIST[(size_t)e * 16384 + idx] : (u32x2){0xffffffffu, 0u}; }
#pragma unroll
            for (int m = 0; m < 4; ++m) {
                const u32x2 en = ent[m];
                if (en.x != 0xffffffffu) {
                    const float w = __uint_as_float(en.y);
                    bf16_t* dst = Y + ((size_t)(en.x >> 31) * T + (en.x & 0x7fffffffu)) * 1024 + col0;
#pragma unroll
                    for (int bj = 0; bj < 2; ++bj) {
                        const pg8::f32x4 v0 = acc[ai][bj][m][0] * w, v1 = acc[ai][bj][m][1] * w;
                        u32x4 o; o.x = cvt_pk(v0[0], v0[1]); o.y = cvt_pk(v0[2], v0[3]); o.z = cvt_pk(v1[0], v1[1]); o.w = cvt_pk(v1[2], v1[3]);
                        *(u32x4*)(dst + bj * 128) = o;
                    }
                }
            }
            asm volatile("" ::: "memory");
        }
    }
};
struct P8Row { u32x2 w0[4], w1[4], wm[4]; f32x4 xx[4]; };
__device__ __forceinline__ void p8_row_load(P8Row& R, const bf16_t* Y, const bf16_t* MIX, const float* x, int m, int lane) {
#pragma unroll
    for (int j = 0; j < 4; ++j) {
        R.w0[j] = *(const u32x2*)(Y + (size_t)m * 1024 + 4 * lane + 256 * j); R.w1[j] = *(const u32x2*)(Y + ((size_t)T + m) * 1024 + 4 * lane + 256 * j);
        R.wm[j] = *(const u32x2*)(MIX + (size_t)m * 1024 + 4 * lane + 256 * j);
    }
#pragma unroll
    for (int j = 0; j < 4; ++j) R.xx[j] = *(const f32x4*)(x + (size_t)m * 1024 + 4 * lane + 256 * j);
}
__device__ __forceinline__ void p8_rows(const bf16_t* Y, const bf16_t* MIX, const float* x, const float* g_post_mix, const float* g_post, const float* mod, float* out, int gw, int NGW, int lane) {
    if (gw >= T) return;
    P8Row R, Rn;
    p8_row_load(R, Y, MIX, x, gw, lane);
#pragma unroll 1
    for (int m = gw; m < T; m += NGW) {
        const bool has = m + NGW < T;
        if (has) p8_row_load(Rn, Y, MIX, x, m + NGW, lane);
        const int b = m / S;
        float v[16], mx[16]; float s = 0.f, sm = 0.f;
#pragma unroll
        for (int j = 0; j < 4; ++j) {
            const u32x2 w0 = R.w0[j], w1 = R.w1[j], wm = R.wm[j];
            v[4 * j + 0] = __uint_as_float(w0.x << 16) + __uint_as_float(w1.x << 16); v[4 * j + 1] = __uint_as_float(w0.x & 0xffff0000u) + __uint_as_float(w1.x & 0xffff0000u);
            v[4 * j + 2] = __uint_as_float(w0.y << 16) + __uint_as_float(w1.y << 16); v[4 * j + 3] = __uint_as_float(w0.y & 0xffff0000u) + __uint_as_float(w1.y & 0xffff0000u);
            mx[4 * j + 0] = __uint_as_float(wm.x << 16); mx[4 * j + 1] = __uint_as_float(wm.x & 0xffff0000u); mx[4 * j + 2] = __uint_as_float(wm.y << 16); mx[4 * j + 3] = __uint_as_float(wm.y & 0xffff0000u);
#pragma unroll
            for (int k = 0; k < 4; ++k) { s += v[4 * j + k] * v[4 * j + k]; sm += mx[4 * j + k] * mx[4 * j + k]; }
        }
        const float rs = 1.0f / sqrtf(wave_sum(s) * (1.f / 1024.f) + 1e-6f), rsm = 1.0f / sqrtf(wave_sum(sm) * (1.f / 1024.f) + 1e-6f);
        const float* md = mod + b * 6144;
#pragma unroll
        for (int j = 0; j < 4; ++j) {
            const int col = 4 * lane + 256 * j;
            const f32x4 xx = R.xx[j], gpm = *(const f32x4*)(g_post_mix + col), g1 = *(const f32x4*)(md + 2 * 1024 + col), gp = *(const f32x4*)(g_post + col), gg = *(const f32x4*)(md + 5 * 1024 + col);
            f32x4 o;
#pragma unroll
            for (int k = 0; k < 4; ++k) { const float hr = xx[k] + g1[k] * (mx[4 * j + k] * rsm * gpm[k]); o[k] = hr + gg[k] * (v[4 * j + k] * rs * gp[k]); }
            *(f32x4*)(out + (size_t)m * 1024 + col) = o;
        }
        if (has) R = Rn;
    }
}
constexpr size_t SC_BSTRIDE = (size_t)4096 * 64 * 65 / 2;
constexpr int SC_CHUNK = 8;
constexpr int SC_NUNITS = 4 * (1 * 8 + 2 * 8 + 3 * 8 + 4 * 8 + 5 * 8 + 6 * 8 + 7 * 8 + 8 * 8);
__device__ __forceinline__ size_t sc_off(int b, int qb) { return (size_t)b * SC_BSTRIDE + (size_t)4096 * (qb * (qb + 1) / 2); }
__device__ __forceinline__ void sc_build_units(unsigned* tab) {
    int n = 0;
    for (int pass = 0; pass < 2; ++pass)
        for (int sz = SC_CHUNK; sz >= 1; --sz)
            for (int b = 0; b < 4; ++b)
                for (int qb = 0; qb < 64; ++qb) {
                    const int nt = qb + 1, nc = (nt + SC_CHUNK - 1) / SC_CHUNK;
                    for (int c = 0; c < nc; ++c) {
                        const int t0 = c * SC_CHUNK, cnt = (nt - t0 < SC_CHUNK) ? nt - t0 : SC_CHUNK;
                        const bool full = (cnt == SC_CHUNK);
                        if ((pass == 0 && full && sz == SC_CHUNK) || (pass == 1 && !full && cnt == sz)) tab[n++] = (unsigned)b | ((unsigned)qb << 2) | ((unsigned)c << 8) | ((unsigned)cnt << 12);
                    }
                }
}
__device__ __forceinline__ unsigned key16_of(float sc) { sc += 0.0f; const unsigned u = __float_as_uint(sc); return ((u & 0x80000000u) ? ~u : (u | 0x80000000u)) >> 16; }
__device__ __forceinline__ void sc_decode(unsigned u, int& b, int& qb, int& c, int& nt) {
    b = u & 3; const int v = u >> 2;
    if (v < 232) { c = 0; int base = 0; while (v >= base + (57 - 8 * c)) { base += 57 - 8 * c; ++c; } qb = 8 * c + 7 + (v - base); nt = 8; }
    else { const int p = v - 232, size = 7 - (p >> 3); c = p & 7; qb = 8 * c + size - 1; nt = size; }
}
struct ScStage { u32x4 v[8]; };
__device__ __forceinline__ void sc_stage_load(ScStage& st, const bf16_t* KI, int b, int c, int nt, int tid) {
    const bf16_t* kbase = KI + ((size_t)b * S + (size_t)c * SC_CHUNK * 64 + (tid >> 3)) * 64 + (tid & 7) * 8;
#pragma unroll
    for (int t = 0; t < 8; ++t) if (t < nt) st.v[t] = *(const u32x4*)(kbase + (size_t)t * 64 * 64);
}
__device__ __forceinline__ void sc_stage_store(const ScStage& st, LAS unsigned char* buf, int nt, int tid) {
    const int skey = tid >> 3, sch = tid & 7;
    const unsigned st_off = (unsigned)(skey * 128 + ((sch ^ (skey & 7)) * 16));
#pragma unroll
    for (int t = 0; t < 8; ++t) if (t < nt) *(LAS u32x4*)(buf + t * 8192 + st_off) = st.v[t];
}
__device__ __forceinline__ void sc_compute(const LAS unsigned char* buf, const bf16_t* QI, const float* WI, unsigned short* SC, int b, int qb, int c, int ntile, int tid) {
    const int lane = tid & 63, w = __builtin_amdgcn_readfirstlane(tid >> 6), hh = lane >> 5, n32 = lane & 31;
    const int L = 64 * (qb + 1);
    const size_t tokq0 = (size_t)b * S + 64 * qb + 8 * w;
    bf16x8 af[2][4]; float wv[2][2][8];
    {
        const int u = 2 * ((n32 >> 2) & 1) + (n32 >> 4), h = (n32 & 3) + 4 * ((n32 >> 3) & 1);
#pragma unroll
        for (int mt = 0; mt < 2; ++mt) {
            const bf16_t* qp = QI + (tokq0 + 4 * mt + u) * 512 + h * 64 + 8 * hh;
#pragma unroll
            for (int ks = 0; ks < 4; ++ks) af[mt][ks] = *(const bf16x8*)(qp + 16 * ks);
#pragma unroll
            for (int j = 0; j < 2; ++j) {
                const float* wp = WI + (tokq0 + 4 * mt + 2 * hh + j) * 8;
                const f32x4 w0 = *(const f32x4*)wp, w1 = *(const f32x4*)(wp + 4);
                wv[mt][j][0] = w0[0]; wv[mt][j][1] = w0[1]; wv[mt][j][2] = w0[2]; wv[mt][j][3] = w0[3]; wv[mt][j][4] = w1[0]; wv[mt][j][5] = w1[1]; wv[mt][j][6] = w1[2]; wv[mt][j][7] = w1[3];
            }
        }
    }
    unsigned short* srow = SC + sc_off(b, qb) + (size_t)(8 * w) * L;
#pragma unroll 1
    for (int t = 0; t < ntile; ++t) {
        const LAS unsigned char* tb_ = buf + t * 8192;
        const int s0 = (c * SC_CHUNK + t) * 64;
#pragma unroll
        for (int nt = 0; nt < 2; ++nt) {
            bf16x8 bfr[4];
            const int key = 32 * nt + n32;
#pragma unroll
            for (int ks = 0; ks < 4; ++ks) bfr[ks] = *(const LAS bf16x8*)(tb_ + key * 128 + (((2 * ks + hh) ^ (key & 7)) * 16));
#pragma unroll
            for (int mt = 0; mt < 2; ++mt) {
                f32x16 acc = (f32x16){};
#pragma unroll
                for (int ks = 0; ks < 4; ++ks) acc = __builtin_amdgcn_mfma_f32_32x32x16_bf16(af[mt][ks], bfr[ks], acc, 0, 0, 0);
#pragma unroll
                for (int j = 0; j < 2; ++j) {
                    float sc = 0.f;
#pragma unroll
                    for (int h = 0; h < 8; ++h) { const int xi = (int)__float_as_uint(acc[8 * j + h]); sc = __builtin_fmaf(wv[mt][j][h], __uint_as_float((unsigned)(xi > 0 ? xi : 0)), sc); }
                    asm volatile("" : "+v"(sc));
                    srow[(size_t)(4 * mt + 2 * hh + j) * L + s0 + key] = (unsigned short)key16_of(sc);
                }
            }
        }
    }
}
__device__ __forceinline__ void sc_phase(LAS unsigned char* lds, volatile LAS unsigned* qslot, unsigned* qhead, const bf16_t* QI, const bf16_t* KI, const float* WI, unsigned short* SC, int tid) {
    __syncthreads();
    if (tid == 0) qslot[0] = atomicAdd(qhead, 1u);
    __syncthreads();
    unsigned ucur = qslot[0];
    if (ucur >= (unsigned)SC_NUNITS) return;
    int b, qb, c, nt; sc_decode(ucur, b, qb, c, nt);
    ScStage st;
    sc_stage_load(st, KI, b, c, nt, tid);
    sc_stage_store(st, lds, nt, tid);
    int p = 0;
    for (;;) {
        __syncthreads();
        if (tid == 0) qslot[0] = atomicAdd(qhead, 1u);
        __syncthreads();
        const unsigned unext = qslot[0];
        const bool has = unext < (unsigned)SC_NUNITS;
        int b2 = 0, qb2 = 0, c2 = 0, nt2 = 0;
        if (has) { sc_decode(unext, b2, qb2, c2, nt2); sc_stage_load(st, KI, b2, c2, nt2, tid); }
        sc_compute(lds + p * 65536, QI, WI, SC, b, qb, c, nt, tid);
        if (!has) break;
        sc_stage_store(st, lds + (p ^ 1) * 65536, nt2, tid);
        b = b2; qb = qb2; c = c2; nt = nt2; p ^= 1;
    }
}
__device__ __forceinline__ unsigned wave_sum_u32(unsigned x) {
    x += (unsigned)__builtin_amdgcn_update_dpp(0, (int)x, 0xB1, 0xf, 0xf, false);
    x += (unsigned)__builtin_amdgcn_update_dpp(0, (int)x, 0x4E, 0xf, 0xf, false);
    x += (unsigned)__builtin_amdgcn_update_dpp(0, (int)x, 0x141, 0xf, 0xf, false);
    x += (unsigned)__builtin_amdgcn_update_dpp(0, (int)x, 0x140, 0xf, 0xf, false);
    return (unsigned)__builtin_amdgcn_readlane((int)x, 0) + (unsigned)__builtin_amdgcn_readlane((int)x, 16) + (unsigned)__builtin_amdgcn_readlane((int)x, 32) + (unsigned)__builtin_amdgcn_readlane((int)x, 48);
}
__device__ __forceinline__ unsigned pk_subsat(unsigned w, unsigned c) { unsigned d; asm("v_pk_sub_u16 %0, %1, %2 clamp" : "=v"(d) : "v"(w), "v"(c)); return d; }
__device__ __forceinline__ unsigned pk_min(unsigned a, unsigned b) { unsigned d; asm("v_pk_min_u16 %0, %1, %2" : "=v"(d) : "v"(a), "v"(b)); return d; }
__device__ __forceinline__ unsigned pk_add(unsigned a, unsigned b) { unsigned d; asm("v_pk_add_u16 %0, %1, %2" : "=v"(d) : "v"(a), "v"(b)); return d; }
template <int NW> __device__ __forceinline__ unsigned cnt_ge(const unsigned (&kw)[32], unsigned cm1) {
    const unsigned one = 0x00010001u;
    unsigned a0 = 0u, a1 = 0u, a2 = 0u, a3 = 0u;
#pragma unroll
    for (int j = 0; j < NW; j += 4) {
        a0 = pk_add(a0, pk_min(pk_subsat(kw[j], cm1), one)); a1 = pk_add(a1, pk_min(pk_subsat(kw[j + 1], cm1), one));
        a2 = pk_add(a2, pk_min(pk_subsat(kw[j + 2], cm1), one)); a3 = pk_add(a3, pk_min(pk_subsat(kw[j + 3], cm1), one));
    }
    const unsigned a = pk_add(pk_add(a0, a1), pk_add(a2, a3));
    return wave_sum_u32((a & 0xffffu) + (a >> 16));
}
__device__ __forceinline__ unsigned pk_max(unsigned a, unsigned b) { unsigned d; asm("v_pk_max_u16 %0, %1, %2" : "=v"(d) : "v"(a), "v"(b)); return d; }
__device__ __forceinline__ unsigned wave_max_u32(unsigned x) {
    x = max(x, (unsigned)__builtin_amdgcn_update_dpp(0, (int)x, 0xB1, 0xf, 0xf, false));
    x = max(x, (unsigned)__builtin_amdgcn_update_dpp(0, (int)x, 0x4E, 0xf, 0xf, false));
    x = max(x, (unsigned)__builtin_amdgcn_update_dpp(0, (int)x, 0x141, 0xf, 0xf, false));
    x = max(x, (unsigned)__builtin_amdgcn_update_dpp(0, (int)x, 0x140, 0xf, 0xf, false));
    return max(max((unsigned)__builtin_amdgcn_readlane((int)x, 0), (unsigned)__builtin_amdgcn_readlane((int)x, 16)), max((unsigned)__builtin_amdgcn_readlane((int)x, 32), (unsigned)__builtin_amdgcn_readlane((int)x, 48)));
}
template <int NW> __device__ __forceinline__ unsigned sel_query(const unsigned (&kw)[32], int lane) {
    unsigned mx = 0u;
#pragma unroll
    for (int j = 0; j < NW; ++j) mx = pk_max(mx, kw[j]);
    unsigned hi = wave_max_u32(max(mx & 0xffffu, mx >> 16)) + 1u;
    unsigned width = 384u, lo = (hi > width) ? hi - width : 1u;
#pragma unroll 1
    while (cnt_ge<NW>(kw, (lo - 1u) * 0x00010001u) < 256u) { hi = lo; width *= 8u; lo = (hi > width) ? hi - width : 1u; }
#pragma unroll 1
    while (hi - lo > 1u) {
        const unsigned mid = (lo + hi) >> 1;
        if (cnt_ge<NW>(kw, (mid - 1u) * 0x00010001u) >= 256u) lo = mid; else hi = mid;
    }
    const unsigned T = lo;
    const unsigned need = 256u - cnt_ge<NW>(kw, T * 0x00010001u);
    unsigned run = 0u, cidx = 0xffffu; bool found = false;
#pragma unroll
    for (int j = 0; j < NW; ++j) {
        if (!found) {
            const bool e0 = (kw[j] & 0xffffu) == T, e1 = (kw[j] >> 16) == T;
            const unsigned long long m0 = __ballot(e0), m1 = __ballot(e1);
            const unsigned cm = (unsigned)__builtin_popcountll(m0) + (unsigned)__builtin_popcountll(m1);
            if (run + cm >= need) {
                const unsigned rank = __builtin_amdgcn_mbcnt_hi((unsigned)(m0 >> 32), __builtin_amdgcn_mbcnt_lo((unsigned)m0, 0u)) + __builtin_amdgcn_mbcnt_hi((unsigned)(m1 >> 32), __builtin_amdgcn_mbcnt_lo((unsigned)m1, 0u));
                const unsigned tg = need - run - 1u;
                const unsigned long long h0 = __ballot(e0 && rank == tg), h1 = __ballot(e1 && rank + (e0 ? 1u : 0u) == tg);
                cidx = (unsigned)(128 * j) + (h0 ? 2u * (unsigned)__builtin_ctzll(h0) : 2u * (unsigned)__builtin_ctzll(h1) + 1u);
                found = true;
            }
            run += cm;
        }
    }
    return T | (cidx << 16);
}
template <int NW> __device__ __forceinline__ unsigned sel_row(const unsigned* row32, int n, int lane) {
    unsigned kw[32];
#pragma unroll
    for (int j = 0; j < 32; ++j) {
        unsigned v = 0u;
        if (j < NW) { const int s = 128 * j + 2 * lane; v = (s < n) ? row32[64 * j + lane] : 0u; if (s + 1 >= n) v &= 0xffffu; }
        kw[j] = v;
    }
    return sel_query<NW>(kw, lane);
}
__device__ __forceinline__ void sel_block(LAS unsigned char* lds, const unsigned short* SC, unsigned* THR, unsigned* MASKT, int blk, int tid, int mode = 3) {
    const int b = blk >> 6, qb = blk & 63, lane = tid & 63, w = __builtin_amdgcn_readfirstlane(tid >> 6);
    const int L = 64 * (qb + 1);
    const unsigned short* slab = SC + sc_off(b, qb);
    LAS unsigned* thr_l = (LAS unsigned*)lds;
    __syncthreads();
    if (mode & 1)
#pragma unroll 1
    for (int qi = 0; qi < 8; ++qi) {
        const int ql = 8 * w + qi, tq = 64 * qb + ql, n = tq + 1;
        const unsigned short* row = slab + (size_t)ql * L;
        const int nw = (n + 127) >> 7;
        const unsigned* row32 = (const unsigned*)row;
        unsigned th = 0u;
        if (n > 256) { if (nw <= 8) th = sel_row<8>(row32, n, lane); else if (nw <= 16) th = sel_row<16>(row32, n, lane); else if (nw <= 24) th = sel_row<24>(row32, n, lane); else th = sel_row<32>(row32, n, lane); }
        if (lane == 0) { thr_l[ql] = th; THR[(size_t)b * S + tq] = th; }
    }
    __syncthreads();
    const int ntl = 4 * ((2 * qb) >> 3) + 4;
    if (mode & 2)
    for (int it = w; it < 2 * ntl; it += NWAVES) {
        const int g = it / ntl, t = it - g * ntl, qg = 2 * qb + g;
        unsigned W = 0u;
        if (t <= qb) {
            const int ii = lane & 15, cc = (lane >> 4) & 1, hh = lane >> 5;
            const int s = 64 * t + 32 * cc + (ii & 3) + 8 * (ii >> 2) + 4 * hh;
            unsigned kk[32];
#pragma unroll
            for (int q = 0; q < 32; ++q) kk[q] = (unsigned)slab[(size_t)(32 * g + q) * L + s];
#pragma unroll
            for (int q = 0; q < 32; ++q) {
                const int ql = 32 * g + q, tq = 64 * qb + ql;
                const unsigned th = thr_l[ql], T = th & 0xffffu, cidx = th >> 16;
                const unsigned k = kk[q];
                const bool p = (s <= tq) && (k > T || (k == T && (unsigned)s <= cidx));
                const unsigned long long m = __ballot(p);
                W = (lane == q) ? (unsigned)m : ((lane == 32 + q) ? (unsigned)(m >> 32) : W);
            }
        }
        MASKT[(((size_t)b * 128 + qg) * 64 + t) * 64 + lane] = W;
    }
}

__device__ __forceinline__ void sel_queries_balanced(const unsigned short* SC, unsigned* THR, int gw, int lane) {
#pragma unroll 1
    for (int k = 0; k < 8; ++k) {
        const int b = k >> 1, tq = (k & 1) ? (S - 1 - gw) : gw, n = tq + 1, qb = tq >> 6, L = 64 * (qb + 1);
        const unsigned* row32 = (const unsigned*)(SC + sc_off(b, qb) + (size_t)(tq & 63) * L);
        const int nw = (n + 127) >> 7;
        unsigned th = 0u;
        if (n > 256) { if (nw <= 8) th = sel_row<8>(row32, n, lane); else if (nw <= 16) th = sel_row<16>(row32, n, lane); else if (nw <= 24) th = sel_row<24>(row32, n, lane); else th = sel_row<32>(row32, n, lane); }
        if (lane == 0) THR[(size_t)b * S + tq] = th;
    }
}
constexpr int MSK_PER_B = 4352, MSK_UNITS = 4 * MSK_PER_B;
struct MskUnit { int b, qg, t; unsigned thv; unsigned kk[32]; };
__device__ __forceinline__ void mask_unit_load(MskUnit& m, const unsigned short* SC, const unsigned* THR, int u, int lane) {
    m.b = u / MSK_PER_B; const int v = u - m.b * MSK_PER_B;
    int g8 = 0;
#pragma unroll 1
    for (int j = 1; j < 16; ++j) g8 += (16 * j * (j + 1) <= v) ? 1 : 0;
    const int rem = v - 16 * g8 * (g8 + 1), per = 4 * g8 + 4, q7 = rem / per;
    m.t = rem - q7 * per; m.qg = 8 * g8 + q7;
    const int qb = m.qg >> 1, g = m.qg & 1;
    if (m.t <= qb) {
        const int L = 64 * (qb + 1);
        const unsigned short* slab = SC + sc_off(m.b, qb);
        const int ii = lane & 15, cc = (lane >> 4) & 1, hh = lane >> 5;
        const int s = 64 * m.t + 32 * cc + (ii & 3) + 8 * (ii >> 2) + 4 * hh;
        m.thv = THR[(size_t)m.b * S + 32 * m.qg + (lane & 31)];
#pragma unroll
        for (int q = 0; q < 32; ++q) m.kk[q] = (unsigned)slab[(size_t)(32 * g + q) * L + s];
    }
}
__device__ __forceinline__ void mask_unit_emit(const MskUnit& m, unsigned* MASKT, int lane) {
    const int qb = m.qg >> 1;
    unsigned W = 0u;
    if (m.t <= qb) {
        const int ii = lane & 15, cc = (lane >> 4) & 1, hh = lane >> 5;
        const int s = 64 * m.t + 32 * cc + (ii & 3) + 8 * (ii >> 2) + 4 * hh;
#pragma unroll
        for (int q = 0; q < 32; ++q) {
            const int tq = 32 * m.qg + q;
            const unsigned th = (unsigned)__builtin_amdgcn_readlane((int)m.thv, q), T = th & 0xffffu, cidx = th >> 16;
            const unsigned k = m.kk[q];
            const bool p = (s <= tq) && (k > T || (k == T && (unsigned)s <= cidx));
            const unsigned long long mm = __ballot(p);
            W = (lane == q) ? (unsigned)mm : ((lane == 32 + q) ? (unsigned)(mm >> 32) : W);
        }
    }
    MASKT[(((size_t)m.b * 128 + m.qg) * 64 + m.t) * 64 + lane] = W;
}
__device__ __forceinline__ void mask_units(const unsigned short* SC, const unsigned* THR, unsigned* MASKT, int u0, int stride, int lane) {
    if (u0 >= MSK_UNITS) return;
    MskUnit a, bnext;
    mask_unit_load(a, SC, THR, u0, lane);
#pragma unroll 1
    for (int u = u0; u < MSK_UNITS; u += stride) {
        const bool has = u + stride < MSK_UNITS;
        if (has) mask_unit_load(bnext, SC, THR, u + stride, lane);
        mask_unit_emit(a, MASKT, lane);
        if (has) a = bnext;
    }
}
struct Args { const void* in[18]; float* out; unsigned char* ws; int ph_lo, ph_hi, li, pad; };
constexpr int N_PHASES = 12;
__global__ void __launch_bounds__(NTHR, 2) mega(Args args) {
    extern __shared__ __attribute__((aligned(16))) unsigned char lds_raw[];
    LAS unsigned char* lds = (LAS unsigned char*)lds_raw;
    const int G = gridDim.x, bid = blockIdx.x;
#define MK_IDS() const int wave = mk_wave(), lane = mk_lane(), tid = wave * 64 + lane; (void)lane; (void)tid; (void)wave
    unsigned char* ws = args.ws;
    unsigned* ctl = (unsigned*)(ws + WS_CTL);
    volatile LAS unsigned* MISC = (volatile LAS unsigned*)(lds + MISC_OFF);
    { const int t0 = (int)threadIdx.x;
      for (int u = t0; u < (LDS_BYTES - RING_BYTES) / 4; u += NTHR) ((LAS unsigned*)(lds + RING_BYTES))[u] = 0u;
      __syncthreads();
      if ((t0 & 63) == 0) ((LAS unsigned char*)(lds + MK_SLOTMAP_OFF))[mk_hwslot()] = (unsigned char)(t0 >> 6); }
    __syncthreads();
    XcdBarrier bar = xcd_barrier_post(ctl + CW_BAR + args.li * XCD_BAR_WORDS, MISC + 8);
    const int lo = args.ph_lo, hi = args.ph_hi;
#ifndef DUP_MASK
#define DUP_MASK 0
#endif
#define REP(k) for (int rep_ = 0; rep_ < (((DUP_MASK) >> (k)) & 1) + 1; ++rep_)
#define IN(k) (lo <= (k) && (k) < hi)
#define BOTH(k) (IN(k) && IN((k) + 1))
    const float* x = (const float*)args.in[0];
    float* mod = (float*)(ws + WS_MOD);
    bf16_t* Hb = (bf16_t*)(ws + WS_H);
    bf16_t* WIN = (bf16_t*)(ws + WS_WIN);
    bf16_t* WOUT = (bf16_t*)(ws + WS_WOUT);
    float* R128 = (float*)(ws + WS_R128);
    float* R64 = (float*)(ws + WS_R64);
    bf16_t* WGU = (bf16_t*)args.out; bf16_t* WD = WGU + (size_t)32 * 512 * 1024;

    const P0Args p0a{(const float*)args.in[1], (const float*)args.in[4], (const float*)args.in[5], (const float*)args.in[6], (const float*)args.in[7], (const float*)args.in[14], (const float*)args.in[15], (const float*)args.in[16],
                 (const int*)args.in[2], mod, R128, R64, WIN, WOUT, WGU, WD};
    if (IN(0)) {
        MK_IDS();
        REP(0) p0_prologue(lds, p0a, bid, G, tid);
        if (BOTH(0)) xcd_barrier(bar);
    }
    if (IN(1)) {
        MK_IDS();
        REP(1) p1_rows(x, (const float*)args.in[3], mod, Hb, bid * NWAVES + wave, G * NWAVES, lane);
        if ((DUP_MASK >> 15) & 1) { for (int k = 0; k < 10; ++k) xcd_barrier(bar); }
        if (BOTH(1)) xcd_barrier(bar);
    }
    if (IN(2)) {
        MK_IDS();
#ifdef PROBE_SKIP_TILE8
        struct Skip8 : pg8::StaticOrder { __device__ bool next(int i, pg8::Unit& u) const { if (!pg8::StaticOrder::next(i, u)) return false; if (u.pn >= 8) ++u.pn; return true; } };
        pg8::Gemm g{Hb, WIN, T, NPHYS, 1024}; Skip8 So; So.init(T, NPHYS - 256, G, bid);
#define PG8_P2_SCHED Skip8
#else
        pg8::Gemm g{Hb, WIN, T, NPHYS, 1024}; pg8::StaticOrder So; So.init(T, NPHYS, G, bid);
#define PG8_P2_SCHED pg8::StaticOrder
#endif
        EpiInProj E{(bf16_t*)(ws + WS_QA), (bf16_t*)(ws + WS_KA), (bf16_t*)(ws + WS_VA), (bf16_t*)(ws + WS_QI), (bf16_t*)(ws + WS_KI), (bf16_t*)(ws + WS_QR), (bf16_t*)(ws + WS_KR),
                    (bf16_t*)(ws + WS_VR), (bf16_t*)(ws + WS_GR), (float*)(ws + WS_WI), R64, R128};
        pg8::gemm_phase<EpiInProj, PG8_P2_SCHED, true, true>(lds, g, So, E);
        if ((DUP_MASK >> 2) & 1) { __syncthreads(); pg8::gemm_phase<EpiInProj, PG8_P2_SCHED, true, true>(lds, g, So, E); }
        if (args.li != 0) {   }
        else if (G == 256) { if (bid >= 64) { __syncthreads(); p0_expert_items(lds, p0a, (bid - 64) * NWAVES + wave, 192 * NWAVES, tid); } }
        else { __syncthreads(); p0_expert_items(lds, p0a, bid * NWAVES + wave, G * NWAVES, tid); }
        if (BOTH(2)) xcd_barrier(bar);
    }
    bf16_t* QR = (bf16_t*)(ws + WS_QR); bf16_t* KR = (bf16_t*)(ws + WS_KR); bf16_t* VR = (bf16_t*)(ws + WS_VR); bf16_t* GR = (bf16_t*)(ws + WS_GR);
    const bf16_t* QI = (const bf16_t*)(ws + WS_QI); const bf16_t* KI = (const bf16_t*)(ws + WS_KI); const float* WI = (const float*)(ws + WS_WI);
    unsigned short* SCORES = (unsigned short*)(ws + WS_SCORES); unsigned* THR = (unsigned*)(ws + WS_THR); unsigned* MASKT = (unsigned*)(ws + WS_MASKT);
    float* KVS = (float*)(ws + WS_KVS); bf16_t* RT = WD + (size_t)32 * 1024 * 256;
    bf16_t* MIXED = (bf16_t*)(ws + WS_MIXED);
    if (IN(3)) {
        MK_IDS();
        REP(3) {
        for (int p = bid; p < 256; p += G) ret_kv_pair(lds, KR, VR, KVS, p, tid);
        sc_phase(lds, MISC + 16, ctl + CW_Q + 64 * rep_, QI, KI, WI, SCORES, tid);
        }
        if (BOTH(3)) xcd_barrier(bar);
    }
    if (IN(4)) {
        MK_IDS();
        ret_scan(KVS, RT, bid * NTHR + tid, G * NTHR);
        for (int gw = bid * NWAVES + wave; gw < 2048; gw += G * NWAVES) sel_queries_balanced(SCORES, THR, gw, lane);
        if ((DUP_MASK >> 12) & 1) for (int gw = bid * NWAVES + wave; gw < 2048; gw += G * NWAVES) sel_queries_balanced(SCORES, THR, gw, lane);
        if (BOTH(4)) xcd_barrier(bar);
    }
    if (IN(5)) {
        MK_IDS();
        mask_units(SCORES, THR, MASKT, bid * NWAVES + wave, G * NWAVES, lane);
        if ((DUP_MASK >> 13) & 1) mask_units(SCORES, THR, MASKT, bid * NWAVES + wave, G * NWAVES, lane);
        if (BOTH(5)) xcd_barrier(bar);
    }
    if (IN(6)) {
        MK_IDS();
        {
        for (int p = bid; p < 256; p += G) ret_out_pair(lds, QR, KR, VR, GR, RT, MIXED, p, tid);
        if ((DUP_MASK >> 14) & 1) for (int p = bid; p < 256; p += G) ret_out_pair(lds, QR, KR, VR, GR, RT, MIXED, p, tid);
        asm volatile("s_waitcnt vmcnt(0) lgkmcnt(0)" ::: "memory");
        __syncthreads();
        {
            const attn_body::AttnTensors AT{(const attn_body::bf16*)(ws + WS_QA), (const attn_body::bf16*)(ws + WS_KA), (const attn_body::bf16*)(ws + WS_VA), (attn_body::bf16*)MIXED, (const unsigned*)MASKT};
            const attn_body::StaticOrder So((int)G, (int)bid);
            attn_body::attn_phase<attn_body::StaticOrder>((char*)lds_raw, AT, So);
        }
        __syncthreads();
        }
        if ((DUP_MASK >> 5) & 1) {
        for (int p = bid; p < 256; p += G) ret_out_pair(lds, QR, KR, VR, GR, RT, MIXED, p, tid);
        asm volatile("s_waitcnt vmcnt(0) lgkmcnt(0)" ::: "memory");
        __syncthreads();
        {
            const attn_body::AttnTensors AT{(const attn_body::bf16*)(ws + WS_QA), (const attn_body::bf16*)(ws + WS_KA), (const attn_body::bf16*)(ws + WS_VA), (attn_body::bf16*)MIXED, (const unsigned*)MASKT};
            const attn_body::StaticOrder So((int)G, (int)bid);
            attn_body::attn_phase<attn_body::StaticOrder>((char*)lds_raw, AT, So);
        }
        __syncthreads();
        }
        if (BOTH(6)) xcd_barrier(bar);
    }
    bf16_t* MIX = (bf16_t*)(ws + WS_MIX); bf16_t* H2 = (bf16_t*)(ws + WS_H2); u32x2* LIST = (u32x2*)(ws + WS_LIST); bf16_t* HID = (bf16_t*)(ws + WS_HID);
    bf16_t* Y = (bf16_t*)(ws + WS_Y); float* HRES = (float*)(ws + WS_HRES);
    LAS int* tb = (LAS int*)(lds + TB_OFF);
    if (IN(7)) {
        MK_IDS();
        pg8::Gemm g{MIXED, WOUT, T, 1024, 1024}; pg8::StaticOrder So; So.init(T, 1024, G, bid);
        EpiStore E{MIX, 1024};
        pg8::gemm_phase<EpiStore, pg8::StaticOrder, true, true>(lds, g, So, E);
        if ((DUP_MASK >> 6) & 1) { __syncthreads(); pg8::gemm_phase<EpiStore, pg8::StaticOrder, true, true>(lds, g, So, E); }
        if (BOTH(7)) xcd_barrier(bar);
    }
    if (IN(8)) {
        MK_IDS();
        P6bArgs a{MIX, x, (const float*)args.in[8], (const float*)args.in[9], mod, (const float*)args.in[10], (const float*)args.in[11], (const float*)args.in[12], (const float*)args.in[13], HRES, H2, ctl + CW_CNT, LIST};
        p6b_load_weights(lds, a.w_group, a.w_expert, tid);
        REP(8) p6b_rows(a, lds, (LAS float*)(lds + RT_WL_OFF + wave * 576), bid * NWAVES + wave, G * NWAVES, lane, rep_ != 0);
        if (BOTH(8)) xcd_barrier(bar);
    }
    if (IN(9)) {
        MK_IDS();
        moe_table(tb, ctl + CW_CNT, tid);
        pg8::Gemm g{H2, WGU, T, 32 * 512, 1024}; MoeSched<1> So{LIST, tb, G, bid, 2, ctl + CW_TILE, ctl + CW_TMO, 0, 1 << 20};
        EpiGU E{HID};
        pg8::gemm_phase_ga<EpiGU, MoeSched<1>>(lds, g, So, E);
        if ((DUP_MASK >> 8) & 1) { __syncthreads(); pg8::gemm_phase_ga<EpiGU, MoeSched<1>>(lds, g, So, E); }
        __syncthreads();
    }
    if (IN(10)) {
        MK_IDS();
        moe_table(tb, ctl + CW_CNT, tid);
        const int n2 = (tb[32] * 2 > G && tb[32] * 2 < 2 * G) ? tb[32] * 2 - G : 0;
        const int t1 = G / 2;
        pg8::Gemm g{HID, WD, T, 32 * 1024, 256};
        EpiDown E{Y, LIST, tb};
        { MoeSched<2> So{LIST, tb, G - n2, bid - n2, 4, ctl + CW_TILE, ctl + CW_TMO, 0, t1}; moe_wait(So); pg8::gemm_phase<EpiDown, MoeSched<2>, true, true>(lds, g, So, E); }
        { MoeSched<2> So{LIST, tb, G - n2, bid - n2, 4, ctl + CW_TILE, ctl + CW_TMO, t1, 1 << 20}; moe_wait(So); pg8::gemm_phase<EpiDown, MoeSched<2>, true, true>(lds, g, So, E); }
        if (BOTH(10)) xcd_barrier(bar);
    }
    if (IN(11)) {
        MK_IDS();
        REP(11) p8_rows(Y, MIX, x, (const float*)args.in[8], (const float*)args.in[17], mod, args.out, bid * NWAVES + wave, G * NWAVES, lane);
    }
#undef IN
#undef BOTH
}
}
extern "C" void kernel_launch(void* const* d_in, const int* in_sizes, int n_in, void* d_out, int out_size, void* d_ws, size_t ws_size, hipStream_t stream) {
    using namespace mk;
    static int grid = 0;
    if (grid == 0) {
        int dev = 0, cus = 0, per_cu = 0;
        if (n_in != 18 || out_size != T * D || ws_size < (size_t)256 * MiB) { fprintf(stderr, "kernel_launch: unexpected problem shape (n_in %d, out %d, ws %zu)\n", n_in, out_size, ws_size); grid = -1; return; }
        if (hipGetDevice(&dev) != hipSuccess || hipDeviceGetAttribute(&cus, hipDeviceAttributeMultiprocessorCount, dev) != hipSuccess) { fprintf(stderr, "kernel_launch: device query failed\n"); grid = -1; return; }
        if (hipFuncSetAttribute((const void*)mega, hipFuncAttributeMaxDynamicSharedMemorySize, LDS_BYTES) != hipSuccess) { fprintf(stderr, "kernel_launch: hipFuncSetAttribute failed\n"); grid = -1; return; }
        if (hipOccupancyMaxActiveBlocksPerMultiprocessor(&per_cu, (const void*)mega, NTHR, LDS_BYTES) != hipSuccess || per_cu < 1) fprintf(stderr, "kernel_launch: occupancy query reports %d\n", per_cu);
        (void)hipGetLastError();
        grid = cus;
    }
    if (grid < 0) return;
    unsigned char* ws = (unsigned char*)d_ws;
    (void)hipMemsetAsync(ws + WS_CTL, 0, CTL_BYTES, stream);
    Args a{};
    for (int i = 0; i < 18; ++i) a.in[i] = d_in[i];
    a.out = (float*)d_out; a.ws = ws; a.ph_lo = 0; a.ph_hi = N_PHASES; a.li = 0; a.pad = 0;
    hipLaunchKernelGGL(mega, dim3(grid), dim3(NTHR), LDS_BYTES, stream, a);
#ifdef EXTRA_PHASE
#ifndef EXTRA_HI
#define EXTRA_HI (EXTRA_PHASE + 1)
#endif
    a.ph_lo = EXTRA_PHASE; a.ph_hi = EXTRA_HI; a.li = 1;
    hipLaunchKernelGGL(mega, dim3(grid), dim3(NTHR), LDS_BYTES, stream, a);
#endif
}
```

```cpp
#include <hip/hip_runtime.h>
#include <cstdio>
#include <cstdint>
#define DUP_MASK 0
#define MK_SLOTMAP_OFF (163840 - 256)
__device__ __forceinline__ unsigned mk_hwslot() { return (unsigned)__builtin_amdgcn_s_getreg((5 << 11) | 4) & 63u; }
__device__ __forceinline__ int mk_wave() { return __builtin_amdgcn_readfirstlane((int)((const __attribute__((address_space(3))) unsigned char*)(unsigned)MK_SLOTMAP_OFF)[mk_hwslot()]); }
__device__ __forceinline__ int mk_lane() { return (int)__builtin_amdgcn_mbcnt_hi(~0u, __builtin_amdgcn_mbcnt_lo(~0u, 0u)); }
__device__ __forceinline__ int mk_tidx() { return mk_wave() * 64 + mk_lane(); }
namespace pg8 {
#define PG8_LAS __attribute__((address_space(3)))
typedef unsigned short bf16_t;
typedef short bf16x8 __attribute__((ext_vector_type(8)));
typedef float f32x4 __attribute__((ext_vector_type(4)));
typedef unsigned u32x4 __attribute__((ext_vector_type(4)));
constexpr int BM = 256, BK = 64, HALF = 128, HTB = HALF * BK * 2  , STAGE_BYTES = 8 * HTB, NXCD = 8, WGM = 8;

__host__ __device__ __forceinline__ int lds_byte(int r, int c) { const int st = (r >> 4) * 2 + (c >> 5), rr = r & 15, cc = c & 31, ob = rr * 64 + cc * 2; return st * 1024 + (ob ^ (((ob >> 9) & 1) << 5)); }
__host__ __device__ __forceinline__ void stage_rc(int b, int& R, int& C) { const int st = b / 1024, sb = b % 1024, swz = sb ^ (((sb >> 9) & 1) << 5); R = (st >> 1) * 16 + swz / 64; C = (st & 1) * 32 + (swz % 64) / 2; }
__host__ __device__ __forceinline__ int perm32(int rho) { const int n = rho >> 4, i = rho & 15; return 8 * (i >> 2) + 4 * n + (i & 3); }

struct Unit { int pm, pn; };
struct Gemm { const bf16_t* A; const bf16_t* Bt; int M, N, K; };

struct StaticOrder {
    int nM, nN, nwg, G, c;
    __host__ __device__ void init(int M, int N, int G_, int c_) { nM = M / BM; nN = N / BM; nwg = nM * nN; G = G_; c = c_; }
    __host__ __device__ bool next(int i, Unit& u) const {
        const long L = (long)i * G + c; if (L >= nwg) return false;
        int wgid = (int)L; { const int q = nwg / NXCD, r = nwg % NXCD, xcd = wgid % NXCD, off = wgid / NXCD; wgid = (xcd < r ? xcd * (q + 1) : r * (q + 1) + (xcd - r) * q) + off; }
        const int nig = WGM * nN, gid = wgid / nig, fm = gid * WGM, gsz = (nM - fm) < WGM ? (nM - fm) : WGM;
        u.pm = fm + ((wgid % nig) % gsz); u.pn = (wgid % nig) / gsz; return true;
    }
    __device__ __forceinline__ void a_ready(const Unit&) const {}
    __device__ __forceinline__ void done(const Unit&) const {}
};
template <class Epi, class Sched, bool ALIGN_EPI = false, bool SP2 = false>
__device__ __forceinline__ void gemm_phase(PG8_LAS unsigned char* lds, const Gemm g, const Sched& S, const Epi& E) {
    const int tid = mk_tidx(), wid = __builtin_amdgcn_readfirstlane(tid >> 6), lane = tid & 63, wr = wid >> 2, wc = wid & 3, fr = lane & 15, fq = lane >> 4;
    const int K = g.K, nt = K / BK;
    unsigned voffA[2], voffB[2];
#pragma unroll
    for (int i = 0; i < 2; ++i) { int R, C; stage_rc(tid * 16 + i * 8192, R, C); const int Rb = Epi::PERM ? ((R & ~31) + perm32(R & 31)) : R;
        voffA[i] = (unsigned)(R * K + C) * 2u; voffB[i] = (unsigned)(Rb * K + C) * 2u; }
    const size_t kstep = (size_t)(BK * 2);
    const size_t hstep = (size_t)HALF * K * 2;
    const size_t tstep = 2 * hstep;
    const unsigned ldsw = (unsigned)wid * 1024u;
    const int aoff = lds_byte(wr * 64 + fr, fq * 8), boff = lds_byte(wc * 32 + fr, fq * 8);
#define PG8_SA(b, h) (((b) * 2 + (h)) * HTB)
#define PG8_SB(b, h) ((4 + (b) * 2 + (h)) * HTB)
#define PG8_STAGE(bufoff, gbase, voff) do { _Pragma("unroll") for (int _i = 0; _i < 2; ++_i) \
        __builtin_amdgcn_global_load_lds((const unsigned*)((const char*)(gbase) + (voff)[_i]), (PG8_LAS unsigned*)(lds + (bufoff) + ldsw + _i * 8192), 16, 0, 0); } while (0)
#define PG8_LDA(dst, b, h) do { _Pragma("unroll") for (int m = 0; m < 4; ++m) _Pragma("unroll") for (int k = 0; k < 2; ++k) dst[m][k] = *(const PG8_LAS bf16x8*)(lds + PG8_SA(b, h) + aoff + m * 2048 + k * 1024); } while (0)
#define PG8_LDB(dst, b, h) do { _Pragma("unroll") for (int n = 0; n < 2; ++n) _Pragma("unroll") for (int k = 0; k < 2; ++k) dst[n][k] = *(const PG8_LAS bf16x8*)(lds + PG8_SB(b, h) + boff + n * 2048 + k * 1024); } while (0)
#define PG8_MMA(ai, bj, At, Bt) do { __builtin_amdgcn_s_setprio(1); _Pragma("unroll") for (int m = 0; m < 4; ++m) _Pragma("unroll") for (int n = 0; n < 2; ++n) _Pragma("unroll") for (int k = 0; k < 2; ++k) \
        acc[ai][bj][m][n] = __builtin_amdgcn_mfma_f32_16x16x32_bf16(Bt[n][k], At[m][k], acc[ai][bj][m][n], 0, 0, 0); __builtin_amdgcn_s_setprio(0); } while (0)
#define PG8_WAIT_V(n) asm volatile("s_waitcnt vmcnt(" #n ")" ::: "memory")
#define PG8_WAIT_L(n) asm volatile("s_waitcnt lgkmcnt(" #n ")" ::: "memory")
#define PG8_BAR __builtin_amdgcn_s_barrier()
#define PG8_SCHED __builtin_amdgcn_sched_barrier(0)
    Unit cur, nxt; int ui = 0;
    if (!S.next(0, cur)) return;
    f32x4 acc[2][2][4][2];
#pragma unroll
    for (int a = 0; a < 2; ++a)
#pragma unroll
        for (int b = 0; b < 2; ++b)
#pragma unroll
            for (int m = 0; m < 4; ++m)
#pragma unroll
                for (int n = 0; n < 2; ++n) acc[a][b][m][n] = (f32x4){0.f, 0.f, 0.f, 0.f};
    bf16x8 At[4][2], B0[2][2], B1[2][2];
    const char* cA = (const char*)g.A + (size_t)cur.pm * tstep; const char* cB = (const char*)g.Bt + (size_t)cur.pn * tstep;
    S.a_ready(cur);
    if constexpr (SP2) {
        PG8_STAGE(PG8_SB(0, 0), cB, voffB); PG8_STAGE(PG8_SB(0, 1), cB + hstep, voffB); PG8_STAGE(PG8_SA(0, 0), cA, voffA); PG8_STAGE(PG8_SA(0, 1), cA + hstep, voffA);
        if (wr == 1) PG8_BAR;
        PG8_WAIT_V(2); PG8_BAR;
        PG8_STAGE(PG8_SB(1, 0), cB + kstep, voffB); PG8_STAGE(PG8_SA(1, 0), cA + kstep, voffA); PG8_STAGE(PG8_SB(1, 1), cB + hstep + kstep, voffB);
        PG8_WAIT_V(6); PG8_BAR;
    } else {
        PG8_STAGE(PG8_SB(0, 0), cB, voffB); PG8_STAGE(PG8_SA(0, 0), cA, voffA); PG8_STAGE(PG8_SB(0, 1), cB + hstep, voffB); PG8_STAGE(PG8_SA(0, 1), cA + hstep, voffA);
        if (wr == 1) PG8_BAR;
        PG8_WAIT_V(4); PG8_BAR;
        PG8_STAGE(PG8_SB(1, 0), cB + kstep, voffB); PG8_STAGE(PG8_SA(1, 0), cA + kstep, voffA); PG8_STAGE(PG8_SB(1, 1), cB + hstep + kstep, voffB);
        PG8_WAIT_V(6); PG8_BAR;
    }
    for (;;) {
        const bool has_next = S.next(ui + 1, nxt);
        const char* nA = has_next ? (const char*)g.A + (size_t)nxt.pm * tstep : cA; const char* nB = has_next ? (const char*)g.Bt + (size_t)nxt.pn * tstep : cB;
        for (int t = 0; t < nt; t += 2) {
            const bool last = (t == nt - 2);
            const char* a1 = cA + (size_t)(t + 1) * kstep;
            const char* a2 = last ? nA : cA + (size_t)(t + 2) * kstep; const char* b2 = last ? nB : cB + (size_t)(t + 2) * kstep;
            const char* a3 = a2 + kstep; const char* b3 = b2 + kstep;
            if (last && has_next) S.a_ready(nxt);
            if constexpr (SP2) {
            PG8_LDB(B0, 0, 0); PG8_LDB(B1, 0, 1); PG8_SCHED; PG8_LDA(At, 0, 0); PG8_STAGE(PG8_SA(1, 1), a1 + hstep, voffA);
            PG8_WAIT_V(8); PG8_WAIT_L(0); PG8_BAR; PG8_MMA(0, 0, At, B0); PG8_MMA(0, 1, At, B1); PG8_BAR; PG8_SCHED;
            PG8_LDA(At, 0, 1); PG8_STAGE(PG8_SB(0, 0), b2, voffB); PG8_STAGE(PG8_SB(0, 1), b2 + hstep, voffB); PG8_STAGE(PG8_SA(0, 0), a2, voffA);
            PG8_WAIT_V(8); PG8_WAIT_L(0); PG8_BAR; PG8_MMA(1, 0, At, B0); PG8_MMA(1, 1, At, B1); PG8_BAR; PG8_SCHED;
            PG8_LDB(B0, 1, 0); PG8_LDB(B1, 1, 1); PG8_SCHED; PG8_LDA(At, 1, 0); PG8_STAGE(PG8_SA(0, 1), a2 + hstep, voffA);
            PG8_WAIT_V(8); PG8_WAIT_L(0); PG8_BAR; PG8_MMA(0, 0, At, B0); PG8_MMA(0, 1, At, B1); PG8_BAR; PG8_SCHED;
            PG8_LDA(At, 1, 1); PG8_STAGE(PG8_SB(1, 0), b3, voffB); PG8_STAGE(PG8_SB(1, 1), b3 + hstep, voffB); PG8_STAGE(PG8_SA(1, 0), a3, voffA);
            PG8_WAIT_V(8); PG8_WAIT_L(0); PG8_BAR; PG8_MMA(1, 0, At, B0); PG8_MMA(1, 1, At, B1); PG8_BAR; PG8_SCHED;
            } else {
            PG8_LDB(B0, 0, 0); PG8_SCHED; PG8_LDA(At, 0, 0); PG8_STAGE(PG8_SA(1, 1), a1 + hstep, voffA);
            PG8_WAIT_L(8); PG8_BAR; PG8_WAIT_L(0); PG8_MMA(0, 0, At, B0); PG8_BAR; PG8_SCHED;
            PG8_LDB(B1, 0, 1); PG8_STAGE(PG8_SB(0, 0), b2, voffB);
            PG8_BAR; PG8_WAIT_L(0); PG8_MMA(0, 1, At, B1); PG8_BAR;
            PG8_LDA(At, 0, 1); PG8_STAGE(PG8_SA(0, 0), a2, voffA);
            PG8_BAR; PG8_WAIT_L(0); PG8_MMA(1, 0, At, B0); PG8_BAR; PG8_SCHED;
            PG8_STAGE(PG8_SB(0, 1), b2 + hstep, voffB);
            PG8_WAIT_V(6); PG8_BAR; PG8_MMA(1, 1, At, B1); PG8_BAR;
            PG8_LDB(B0, 1, 0); PG8_SCHED; PG8_LDA(At, 1, 0); PG8_STAGE(PG8_SA(0, 1), a2 + hstep, voffA);
            PG8_WAIT_L(8); PG8_BAR; PG8_WAIT_L(0); PG8_MMA(0, 0, At, B0); PG8_BAR; PG8_SCHED;
            PG8_LDB(B1, 1, 1); PG8_STAGE(PG8_SB(1, 0), b3, voffB);
            PG8_BAR; PG8_WAIT_L(0); PG8_MMA(0, 1, At, B1); PG8_BAR;
            PG8_LDA(At, 1, 1); PG8_STAGE(PG8_SA(1, 0), a3, voffA);
            PG8_BAR; PG8_WAIT_L(0); PG8_MMA(1, 0, At, B0); PG8_BAR; PG8_SCHED;
            PG8_STAGE(PG8_SB(1, 1), b3 + hstep, voffB);
            PG8_WAIT_V(6); PG8_BAR; PG8_MMA(1, 1, At, B1); PG8_BAR;
            }
        }
        if constexpr (ALIGN_EPI) { if (wr == 0) PG8_BAR; }
        if constexpr (!Epi::AFTER_DRAIN) { E(acc, cur, wr, wc, fr, fq); S.done(cur); }
        if (!has_next) break;
#pragma unroll
        for (int a = 0; a < 2; ++a)
#pragma unroll
            for (int b = 0; b < 2; ++b)
#pragma unroll
                for (int m = 0; m < 4; ++m)
#pragma unroll
                    for (int n = 0; n < 2; ++n) acc[a][b][m][n] = (f32x4){0.f, 0.f, 0.f, 0.f};
        cur = nxt; cA = nA; cB = nB; ++ui;
        if constexpr (ALIGN_EPI) { if (wr == 1) PG8_BAR; }
    }
    PG8_WAIT_V(0);
    if constexpr (!ALIGN_EPI) { if (wr == 0) PG8_BAR; }
    PG8_BAR;
    if constexpr (Epi::AFTER_DRAIN) { E.fused(acc, cur, wr, wc, fr, fq, lds, wid, lane); S.done(cur); }
#undef PG8_SA
#undef PG8_SB
#undef PG8_STAGE
#undef PG8_LDA
#undef PG8_LDB
#undef PG8_MMA
#undef PG8_WAIT_V
#undef PG8_WAIT_L
#undef PG8_BAR
#undef PG8_SCHED
}
}
#define XB_TMO      128
#define XB_XCNT(j)  (256  + 64 * (j))
#define XB_XSUB(j)  (1280 + 64 * (j))
#define XB_XGEN(j)  (2304 + 64 * (j))
#define XB_TOP      3328
#define XB_TOPGEN   3392
#define XCD_BAR_WORDS 3456
#define XB_SPIN_CAP (1u << 18)
#define LAS __attribute__((address_space(3)))

__device__ __forceinline__ unsigned xb_ld(unsigned* p)              { return __hip_atomic_load(p, __ATOMIC_RELAXED, __HIP_MEMORY_SCOPE_AGENT); }
__device__ __forceinline__ unsigned xb_add(unsigned* p, unsigned v) { return __hip_atomic_fetch_add(p, v, __ATOMIC_RELAXED, __HIP_MEMORY_SCOPE_AGENT); }
__device__ __forceinline__ unsigned xb_xcc_id() { return (unsigned)__builtin_amdgcn_s_getreg((3 << 11) | 20) & 0xFu; }
#define XB_SPIN(cond, bar) do { unsigned _sp = 0; while (cond) { __builtin_amdgcn_s_sleep(1); \
    if ((++_sp & 255u) == 0u) { if (xb_ld(&(bar)[XB_TMO])) break; if (_sp > XB_SPIN_CAP) { atomicAdd(&(bar)[XB_TMO], 1u); break; } } } } while (0)

struct XcdBarrier {
    unsigned* bar; unsigned x;
    volatile LAS unsigned* st;
};

__device__ __forceinline__ XcdBarrier xcd_barrier_post(unsigned* bar, volatile LAS unsigned* st) {
    XcdBarrier b; b.bar = bar; b.x = xb_xcc_id(); b.st = st;
    if (mk_tidx() == 0) (void)xb_add(&bar[XB_XCNT(b.x)], 1u);
    return b;
}
__device__ __forceinline__ void xcd_barrier_complete(unsigned* bar, unsigned x, unsigned& nloc, unsigned& nx) {
    const unsigned G = gridDim.x * gridDim.y * gridDim.z;
    unsigned sum, cnt, mine, sp = 0u;
    for (;;) {
        sum = 0u; cnt = 0u; mine = 0u;
#pragma unroll
        for (unsigned j = 0; j < 16; ++j) { const unsigned c = xb_ld(&bar[XB_XCNT(j)]); sum += c; cnt += (c > 0u) ? 1u : 0u; mine = (j == x) ? c : mine; }
        if (sum == G) break;
        __builtin_amdgcn_s_sleep(1);
        if ((++sp & 255u) == 0u) { if (xb_ld(&bar[XB_TMO])) break; if (sp > XB_SPIN_CAP) { atomicAdd(&bar[XB_TMO], 1u); break; } }
    }
    nloc = mine > 0u ? mine : 1u; nx = cnt > 0u ? cnt : 1u;
}

__device__ __forceinline__ void xcd_barrier(const XcdBarrier& b) {
    asm volatile("s_waitcnt vmcnt(0)" ::: "memory");
    __syncthreads();
    if (mk_tidx() == 0) {
        unsigned* bar = b.bar;
        __builtin_amdgcn_s_waitcnt(0);
        unsigned nloc = b.st[0], nx = b.st[1];
        if (nloc == 0u) { xcd_barrier_complete(bar, b.x, nloc, nx); b.st[0] = nloc; b.st[1] = nx; }
        const unsigned old = xb_add(&bar[XB_XSUB(b.x)], 1u);
        const unsigned gen = old / nloc;
        if (old + 1u == (gen + 1u) * nloc) {
            __builtin_amdgcn_fence(__ATOMIC_RELEASE, "agent");
            asm volatile("s_waitcnt vmcnt(0)" ::: "memory");
            const unsigned og = xb_add(&bar[XB_TOP], 1u);
            const unsigned tg = og / nx;
            if (og + 1u == (tg + 1u) * nx) xb_add(&bar[XB_TOPGEN], 1u);
            else XB_SPIN(xb_ld(&bar[XB_TOPGEN]) == tg, bar);
            __builtin_amdgcn_fence(__ATOMIC_ACQUIRE, "agent");
            xb_add(&bar[XB_XGEN(b.x)], 1u);
            asm volatile("s_waitcnt vmcnt(0)" ::: "memory");
        } else {
            XB_SPIN(xb_ld(&bar[XB_XGEN(b.x)]) == gen, bar);
            __builtin_amdgcn_fence(__ATOMIC_ACQUIRE, "agent");
            asm volatile("s_waitcnt vmcnt(0)" ::: "memory");
        }
    }
    __syncthreads();
}
namespace pg8 {
template <class Epi, class Sched>
__device__ __forceinline__ void gemm_phase_ga(PG8_LAS unsigned char* lds, const Gemm g, const Sched& S, const Epi& E) {
    const int tid = mk_tidx(), wid = __builtin_amdgcn_readfirstlane(tid >> 6), lane = tid & 63, wr = wid >> 2, wc = wid & 3, fr = lane & 15, fq = lane >> 4;
    const int K = g.K, nt = K / BK;
    unsigned voffB[2]; int RA[2], CA[2];
#pragma unroll
    for (int i = 0; i < 2; ++i) { int R, C; stage_rc(tid * 16 + i * 8192, R, C); const int Rb = Epi::PERM ? ((R & ~31) + perm32(R & 31)) : R;
        RA[i] = R; CA[i] = C; voffB[i] = (unsigned)(Rb * K + C) * 2u; }
    const size_t kstep = (size_t)(BK * 2);
    const size_t hstep = (size_t)HALF * K * 2;
    const size_t tstep = 2 * hstep;
    const unsigned ldsw = (unsigned)wid * 1024u;
    const int aoff = lds_byte(wr * 64 + fr, fq * 8), boff = lds_byte(wc * 32 + fr, fq * 8);
#define PG8_SA(b, h) (((b) * 2 + (h)) * HTB)
#define PG8_SB(b, h) ((4 + (b) * 2 + (h)) * HTB)
#define PG8_STAGE(bufoff, gbase, voff) do { _Pragma("unroll") for (int _i = 0; _i < 2; ++_i) \
        __builtin_amdgcn_global_load_lds((const unsigned*)((const char*)(gbase) + (voff)[_i]), (PG8_LAS unsigned*)(lds + (bufoff) + ldsw + _i * 8192), 16, 0, 0); } while (0)
#define PG8_LDA(dst, b, h) do { _Pragma("unroll") for (int m = 0; m < 4; ++m) _Pragma("unroll") for (int k = 0; k < 2; ++k) dst[m][k] = *(const PG8_LAS bf16x8*)(lds + PG8_SA(b, h) + aoff + m * 2048 + k * 1024); } while (0)
#define PG8_LDB(dst, b, h) do { _Pragma("unroll") for (int n = 0; n < 2; ++n) _Pragma("unroll") for (int k = 0; k < 2; ++k) dst[n][k] = *(const PG8_LAS bf16x8*)(lds + PG8_SB(b, h) + boff + n * 2048 + k * 1024); } while (0)
#define PG8_MMA(ai, bj, At, Bt) do { __builtin_amdgcn_s_setprio(1); _Pragma("unroll") for (int m = 0; m < 4; ++m) _Pragma("unroll") for (int n = 0; n < 2; ++n) _Pragma("unroll") for (int k = 0; k < 2; ++k) \
        acc[ai][bj][m][n] = __builtin_amdgcn_mfma_f32_16x16x32_bf16(Bt[n][k], At[m][k], acc[ai][bj][m][n], 0, 0, 0); __builtin_amdgcn_s_setprio(0); } while (0)
#define PG8_WAIT_V(n) asm volatile("s_waitcnt vmcnt(" #n ")" ::: "memory")
#define PG8_WAIT_L(n) asm volatile("s_waitcnt lgkmcnt(0)" ::: "memory")
#define PG8_BAR __builtin_amdgcn_s_barrier()
#define PG8_SCHED __builtin_amdgcn_sched_barrier(0)
#define PG8_AOFF(dst, u) do { _Pragma("unroll") for (int _h = 0; _h < 2; ++_h) _Pragma("unroll") for (int _i = 0; _i < 2; ++_i) \
        dst[_h][_i] = (unsigned)S.arow(u, _h * HALF + RA[_i]) * (unsigned)(K * 2) + (unsigned)(CA[_i] * 2); } while (0)
    Unit cur, nxt; int ui = 0;
    if (!S.next(0, cur)) return;
    f32x4 acc[2][2][4][2];
#pragma unroll
    for (int a = 0; a < 2; ++a)
#pragma unroll
        for (int b = 0; b < 2; ++b)
#pragma unroll
            for (int m = 0; m < 4; ++m)
#pragma unroll
                for (int n = 0; n < 2; ++n) acc[a][b][m][n] = (f32x4){0.f, 0.f, 0.f, 0.f};
    bf16x8 At[4][2], B0[2][2], B1[2][2];
    unsigned offC[2][2], offN[2][2];
    PG8_AOFF(offC, cur);
    const char* gA = (const char*)g.A;
    const char* cB = (const char*)g.Bt + (size_t)cur.pn * tstep;
    S.a_ready(cur);
    PG8_STAGE(PG8_SB(0, 0), cB, voffB); PG8_STAGE(PG8_SB(0, 1), cB + hstep, voffB); PG8_STAGE(PG8_SA(0, 0), gA, offC[0]); PG8_STAGE(PG8_SA(0, 1), gA, offC[1]);
    if (wr == 1) PG8_BAR;
    PG8_WAIT_V(2); PG8_BAR;
    PG8_STAGE(PG8_SB(1, 0), cB + kstep, voffB); PG8_STAGE(PG8_SA(1, 0), gA + kstep, offC[0]); PG8_STAGE(PG8_SB(1, 1), cB + hstep + kstep, voffB);
    PG8_WAIT_V(6); PG8_BAR;
    for (;;) {
        const bool has_next = S.next(ui + 1, nxt);
        if (has_next) { PG8_AOFF(offN, nxt); } else {
#pragma unroll
            for (int h_ = 0; h_ < 2; ++h_)
#pragma unroll
                for (int i_ = 0; i_ < 2; ++i_) offN[h_][i_] = offC[h_][i_]; }
        const char* nB = has_next ? (const char*)g.Bt + (size_t)nxt.pn * tstep : cB;
        for (int t = 0; t < nt; t += 2) {
            const bool last = (t == nt - 2);
            const char* a1 = gA + (size_t)(t + 1) * kstep;
            const char* a2 = last ? gA : gA + (size_t)(t + 2) * kstep; const char* b2 = last ? nB : cB + (size_t)(t + 2) * kstep;
            const char* a3 = a2 + kstep; const char* b3 = b2 + kstep;
            unsigned o2[2][2];
#pragma unroll
            for (int h_ = 0; h_ < 2; ++h_)
#pragma unroll
                for (int i_ = 0; i_ < 2; ++i_) o2[h_][i_] = last ? offN[h_][i_] : offC[h_][i_];
            if (last && has_next) S.a_ready(nxt);
            PG8_LDB(B0, 0, 0); PG8_LDB(B1, 0, 1); PG8_SCHED; PG8_LDA(At, 0, 0); PG8_STAGE(PG8_SA(1, 1), a1, offC[1]);
            PG8_WAIT_V(8); PG8_WAIT_L(0); PG8_BAR; PG8_MMA(0, 0, At, B0); PG8_MMA(0, 1, At, B1); PG8_BAR; PG8_SCHED;
            PG8_LDA(At, 0, 1); PG8_STAGE(PG8_SB(0, 0), b2, voffB); PG8_STAGE(PG8_SB(0, 1), b2 + hstep, voffB); PG8_STAGE(PG8_SA(0, 0), a2, o2[0]);
            PG8_WAIT_V(8); PG8_WAIT_L(0); PG8_BAR; PG8_MMA(1, 0, At, B0); PG8_MMA(1, 1, At, B1); PG8_BAR; PG8_SCHED;
            PG8_LDB(B0, 1, 0); PG8_LDB(B1, 1, 1); PG8_SCHED; PG8_LDA(At, 1, 0); PG8_STAGE(PG8_SA(0, 1), a2, o2[1]);
            PG8_WAIT_V(8); PG8_WAIT_L(0); PG8_BAR; PG8_MMA(0, 0, At, B0); PG8_MMA(0, 1, At, B1); PG8_BAR; PG8_SCHED;
            PG8_LDA(At, 1, 1); PG8_STAGE(PG8_SB(1, 0), b3, voffB); PG8_STAGE(PG8_SB(1, 1), b3 + hstep, voffB); PG8_STAGE(PG8_SA(1, 0), a3, o2[0]);
            PG8_WAIT_V(8); PG8_WAIT_L(0); PG8_BAR; PG8_MMA(1, 0, At, B0); PG8_MMA(1, 1, At, B1); PG8_BAR; PG8_SCHED;
        }
        if (wr == 0) PG8_BAR;
        E(acc, cur, wr, wc, fr, fq); S.done(cur);
        if (!has_next) break;
#pragma unroll
        for (int a = 0; a < 2; ++a)
#pragma unroll
            for (int b = 0; b < 2; ++b)
#pragma unroll
                for (int m = 0; m < 4; ++m)
#pragma unroll
                    for (int n = 0; n < 2; ++n) acc[a][b][m][n] = (f32x4){0.f, 0.f, 0.f, 0.f};
        cur = nxt; cB = nB; ++ui;
#pragma unroll
        for (int h_ = 0; h_ < 2; ++h_)
#pragma unroll
            for (int i_ = 0; i_ < 2; ++i_) offC[h_][i_] = offN[h_][i_];
        if (wr == 1) PG8_BAR;
    }
    PG8_WAIT_V(0);
    PG8_BAR;
#undef PG8_SA
#undef PG8_SB
#undef PG8_STAGE
#undef PG8_LDA
#undef PG8_LDB
#undef PG8_MMA
#undef PG8_WAIT_V
#undef PG8_WAIT_L
#undef PG8_BAR
#undef PG8_SCHED
#undef PG8_AOFF
}
}
namespace attn_body {
using bf16=unsigned short;
using bf16x8=__attribute__((ext_vector_type(8)))short;
using s16x4=__attribute__((ext_vector_type(4)))short;
using f32x16=__attribute__((ext_vector_type(16)))float;
using u32x4=__attribute__((ext_vector_type(4)))unsigned;
constexpr int BATCH=4,NHEAD=8,SEQ=4096,D=64,DM=NHEAD*D,ODM=1024;
constexpr int NW=8,QBLK=32,QB=QBLK*NW,KVBLK=64,NQB=SEQ/QB;
constexpr int ATTN_PITCH=DM, ATTN_UNIT_ROWS=QB;
__device__ __forceinline__ int crow(int r,int hi){return (r&3)+8*(r>>2)+4*hi;}
#define SBAR() __builtin_amdgcn_sched_barrier(0)
__device__ __forceinline__ void cmask(f32x16&p0,f32x16&p1,int jb,int qrel,int hi){
  const float NEG=-INFINITY; int kb=64*jb+4*hi;
  #pragma unroll
  for(int r=0;r<16;++r){int kv=kb+(r&3)+8*(r>>2); if(kv>qrel)p0[r]=NEG; if(kv+32>qrel)p1[r]=NEG;}
}

constexpr int NSLOT=3, SLOTB=8192;
constexpr int LDS_K=0, LDS_V=NSLOT*SLOTB, LDS_WS=2*NSLOT*SLOTB, LDS_OST=LDS_WS+NW*64*4, LDS_MSK=LDS_OST+NW*4096, LDS_BYTES=LDS_MSK+NW*768;
constexpr float C2=0.125f*1.4426950408889634f;
__device__ __forceinline__ void glds16(const void*gsrc,unsigned lds_dst){unsigned keep;
  asm volatile("s_mov_b32 %0, m0\n\ts_mov_b32 m0, %2\n\ts_nop 0\n\tglobal_load_lds_dwordx4 %1, off\n\ts_mov_b32 m0, %0":"=&s"(keep):"v"(gsrc),"s"(lds_dst):"memory");}
__device__ __forceinline__ void glds4(const void*gsrc,unsigned lds_dst){unsigned keep;
  asm volatile("s_mov_b32 %0, m0\n\ts_mov_b32 m0, %2\n\ts_nop 0\n\tglobal_load_lds_dword %1, off\n\ts_mov_b32 m0, %0":"=&s"(keep):"v"(gsrc),"s"(lds_dst):"memory");}
template<int BIT> __device__ __forceinline__ float mand(float x,unsigned w){ int m; asm("v_bfe_i32 %0, %1, %2, 1":"=v"(m):"v"(w),"n"(BIT)); return __uint_as_float(__float_as_uint(x)&(unsigned)m); }
__device__ __forceinline__ float max3f(float a,float b,float c){float r;asm("v_max3_f32 %0, %1, %2, %3":"=v"(r):"v"(a),"v"(b),"v"(c));return r;}
__device__ __forceinline__ float max2f(float a,float b){float r;asm("v_max_f32_e32 %0, %1, %2":"=v"(r):"v"(a),"v"(b));return r;}
__device__ __forceinline__ float fadd_s(float a,float b){float r;asm("v_add_f32_e32 %0, %1, %2":"=v"(r):"v"(a),"v"(b));return r;}
__device__ __forceinline__ float fsub_s(float a,float b){float r;asm("v_sub_f32_e32 %0, %1, %2":"=v"(r):"v"(a),"v"(b));return r;}
typedef float f32x2_t __attribute__((ext_vector_type(2))); typedef __bf16 bf16x2_t __attribute__((ext_vector_type(2)));
__device__ __forceinline__ unsigned cvtpk_s(float lo,float hi){f32x2_t v={lo,hi};bf16x2_t b=__builtin_convertvector(v,bf16x2_t);return __builtin_bit_cast(unsigned,b);}
#define WAIT_BAR(N) asm volatile("s_waitcnt vmcnt(" #N ") lgkmcnt(0)\n\ts_barrier":::"memory")

__device__ __forceinline__ void qkt(f32x16&p0,f32x16&p1,const char*Kslot,const bf16x8*qr,const f32x16&negm,int r32,int hi){
  const char*kb=Kslot+hi*1024+r32*16;
  #pragma unroll
  for(int d0=0;d0<4;++d0){
    const bf16x8 b0=*reinterpret_cast<const bf16x8*>(kb+d0*2048);
    const bf16x8 b1=*reinterpret_cast<const bf16x8*>(kb+d0*2048+512);
    if(d0==0){p0=__builtin_amdgcn_mfma_f32_32x32x16_bf16(b0,qr[0],negm,0,0,0);p1=__builtin_amdgcn_mfma_f32_32x32x16_bf16(b1,qr[0],negm,0,0,0);}
    else{p0=__builtin_amdgcn_mfma_f32_32x32x16_bf16(b0,qr[d0],p0,0,0,0);p1=__builtin_amdgcn_mfma_f32_32x32x16_bf16(b1,qr[d0],p1,0,0,0);}}
}
typedef __attribute__((address_space(3))) const char* lds_cptr;
typedef short v4i16_t __attribute__((ext_vector_type(4)));
__device__ __forceinline__ void kload8(bf16x8*kf,lds_cptr kp){
  kf[0]=*(const __attribute__((address_space(3))) bf16x8*)(kp);      kf[1]=*(const __attribute__((address_space(3))) bf16x8*)(kp+512);
  kf[2]=*(const __attribute__((address_space(3))) bf16x8*)(kp+2048); kf[3]=*(const __attribute__((address_space(3))) bf16x8*)(kp+2560);
  kf[4]=*(const __attribute__((address_space(3))) bf16x8*)(kp+4096); kf[5]=*(const __attribute__((address_space(3))) bf16x8*)(kp+4608);
  kf[6]=*(const __attribute__((address_space(3))) bf16x8*)(kp+6144); kf[7]=*(const __attribute__((address_space(3))) bf16x8*)(kp+6656);
}
__device__ __forceinline__ void kload2(bf16x8*kf,lds_cptr kp,int j){ kf[2*j]=*(const __attribute__((address_space(3))) bf16x8*)(kp+j*2048); kf[2*j+1]=*(const __attribute__((address_space(3))) bf16x8*)(kp+j*2048+512); }
__device__ __forceinline__ s16x4 vtr(lds_cptr p){ return __builtin_bit_cast(s16x4,__builtin_amdgcn_ds_read_tr16_b64_v4i16((__attribute__((address_space(3))) v4i16_t*)p)); }
__device__ __forceinline__ float rowmax(const f32x16&p0,const f32x16&p1){
  float a=max3f(p0[0],p0[1],p1[0]),b=max3f(p0[2],p0[3],p1[1]);a=max3f(a,p1[2],p1[3]);
  #pragma unroll
  for(int r=4;r<16;r+=4){a=max3f(a,p0[r],p0[r+1]);b=max3f(b,p0[r+2],p0[r+3]);a=max3f(a,p1[r],p1[r+1]);b=max3f(b,p1[r+2],p1[r+3]);}
  const float m=max2f(a,b);
  auto rr=__builtin_amdgcn_permlane32_swap(__float_as_uint(m),__float_as_uint(m),false,false);
  return max2f(__uint_as_float(rr[0]),__uint_as_float(rr[1]));
}
__device__ __forceinline__ void pv(f32x16*o,int vb,bf16x8 pa0,bf16x8 pa1,bf16x8 pa2,bf16x8 pa3){
  #pragma unroll
  for(int d0=0;d0<2;++d0){s16x4 lo[4],hi[4];
    #pragma unroll
    for(int ks=0;ks<4;++ks){
      asm volatile("ds_read_b64_tr_b16 %0,%1 offset:%c2":"=&v"(lo[ks]):"v"(vb),"i"(d0*4096+ks*1024):"memory");
      asm volatile("ds_read_b64_tr_b16 %0,%1 offset:%c2":"=&v"(hi[ks]):"v"(vb),"i"(d0*4096+ks*1024+512):"memory");}
    asm volatile("s_waitcnt lgkmcnt(0)":::"memory");SBAR();
    #define PK(k) (bf16x8){lo[k][0],lo[k][1],lo[k][2],lo[k][3],hi[k][0],hi[k][1],hi[k][2],hi[k][3]}
    o[d0]=__builtin_amdgcn_mfma_f32_32x32x16_bf16(pa0,PK(0),o[d0],0,0,0);
    o[d0]=__builtin_amdgcn_mfma_f32_32x32x16_bf16(pa1,PK(1),o[d0],0,0,0);
    o[d0]=__builtin_amdgcn_mfma_f32_32x32x16_bf16(pa2,PK(2),o[d0],0,0,0);
    o[d0]=__builtin_amdgcn_mfma_f32_32x32x16_bf16(pa3,PK(3),o[d0],0,0,0);
    #undef PK
  }
}

#ifndef ATTN_STORE16
#define ATTN_STORE16(p,v) (*(u32x4*)(p)=(v))
#endif
template<int THRL> __device__ __forceinline__ void attn_unit(int b,int h,int qb,const bf16*Q,const bf16*__restrict__ K,const bf16*__restrict__ V,bf16*O,const unsigned*__restrict__ MK,char*shm){
  const int tid=mk_tidx(),lane=tid&63,r32=lane&31,hi=lane>>5; const int wid=__builtin_amdgcn_readfirstlane(tid>>6);
  const long rowbase=(long)b*SEQ; const int q0=qb*QB;
  const bf16*Qw=Q+(rowbase+q0+wid*QBLK)*DM+h*D;
  const bf16*Kh=K+rowbase*DM+h*D,*Vh=V+rowbase*DM+h*D;
  const unsigned lds0=(unsigned)(uintptr_t)shm;
  float*wsf=(float*)(shm+LDS_WS)+wid*64;
  const bf16*ksrc=Kh+(long)lane*DM+wid*8;
  const bf16*vsrc=Vh+(long)(16*(wid&3)+(lane>>2))*DM+(wid>>2)*32+(lane&3)*8;
  const unsigned kdst=lds0+LDS_K+wid*1024, vdst=lds0+LDS_V+wid*1024;
  const unsigned*msrc=MK+((size_t)(b*128+8*qb+wid)*64)*64+lane; const unsigned mdst=lds0+LDS_MSK+wid*768;
  const __attribute__((address_space(3))) char*mrd=(__attribute__((address_space(3))) const char*)shm+LDS_MSK+wid*768+lane*4;
  int mq_cur=0,mq_n1=256,mq_n2=512;
  #define DMA_M(t,slot) glds4(msrc+(size_t)(t)*64,(unsigned)__builtin_amdgcn_readfirstlane(mdst+(slot)))
  #define MWORD() (*(const __attribute__((address_space(3))) unsigned*)(mrd+mq_cur))
  #define DMA_K(t,slot) glds16(ksrc+(long)(t)*KVBLK*DM,(unsigned)__builtin_amdgcn_readfirstlane(kdst+(slot)))
  #define DMA_V(t,slot) glds16(vsrc+(long)(t)*KVBLK*DM,(unsigned)__builtin_amdgcn_readfirstlane(vdst+(slot)))
  const int vb0=(int)(lds0+LDS_V)+((lane>>4)&1)*32+(lane&3)*8+(4*hi+((lane&15)>>2))*64;
  const char*Kbase=shm+LDS_K; bf16x8 kf[8];
  const lds_cptr shm3=(lds_cptr)shm; const lds_cptr kp0=shm3+LDS_K+hi*1024+r32*16; const lds_cptr vp0=shm3+LDS_V+((lane>>4)&1)*32+(lane&3)*8+(4*hi+((lane&15)>>2))*64;
  const int NT=(q0+QB)/KVBLK;
  DMA_M(0,0);DMA_M(1,256);DMA_K(0,0);DMA_V(0,0);DMA_K(1,SLOTB);
  bf16x8 qr[4];
  #pragma unroll
  for(int d0=0;d0<4;++d0)qr[d0]=*reinterpret_cast<const bf16x8*>(&Qw[(long)r32*DM+d0*16+hi*8]);
  float mhat=0.f,l_reg=0.f;f32x16 o[2];o[0]=f32x16{};o[1]=f32x16{};f32x16 negm=f32x16{};asm volatile("":"+v"(negm));
  const int qrel=wid*QBLK+r32;
  #define CMASK(P0,P1,t) do{}while(0)
  bool resc=false;
  #define START(P0,P1) do{ const float rm=rowmax(P0,P1); resc=false; \
    { const float dl=(rm>-1e30f)?rm:0.f; mhat=fadd_s(mhat,dl); \
      _Pragma("unroll") for(int r=0;r<16;++r){P0[r]=fsub_s(P0[r],dl);P1[r]=fsub_s(P1[r],dl);} \
      _Pragma("unroll") for(int r=0;r<16;++r)negm[r]=-mhat; asm volatile("":"+v"(negm)); } \
    _Pragma("unroll") for(int r=0;r<16;++r)P0[r]=__builtin_amdgcn_exp2f(P0[r]); }while(0)
  #define RESC() do{ if(resc){ asm volatile("s_waitcnt lgkmcnt(0)":::"memory"); \
      _Pragma("unroll") for(int d_=0;d_<2;++d_) _Pragma("unroll") for(int r=0;r<16;++r)o[d_][r]*=wsf[crow(r,hi)]; } }while(0)
  f32x16 pA0,pA1,pB0,pB1;
  int sl_prev=0,sl_cur=0,sl_next=SLOTB;
  #define ROT() do{sl_prev=sl_cur;sl_cur=sl_next;sl_next=(sl_next==(NSLOT-1)*SLOTB)?0:sl_next+SLOTB; const int mt_=mq_cur;mq_cur=mq_n1;mq_n1=mq_n2;mq_n2=mt_;}while(0)
  DMA_K(2,2*SLOTB);
  WAIT_BAR(3);
  qkt(pA0,pA1,Kbase,qr,negm,r32,hi);asm volatile("s_nop 15\n\ts_nop 7":"+v"(pA0),"+v"(pA1));CMASK(pA0,pA1,0);
  START(pA0,pA1);
  _Pragma("unroll") for(int r=0;r<16;++r)pA1[r]=__builtin_amdgcn_exp2f(pA1[r]);
  { const unsigned mw0=MWORD(); pA0[0]=mand<0>(pA0[0],mw0);pA1[0]=mand<16>(pA1[0],mw0);pA0[1]=mand<1>(pA0[1],mw0);pA1[1]=mand<17>(pA1[1],mw0);pA0[2]=mand<2>(pA0[2],mw0);pA1[2]=mand<18>(pA1[2],mw0);pA0[3]=mand<3>(pA0[3],mw0);pA1[3]=mand<19>(pA1[3],mw0);pA0[4]=mand<4>(pA0[4],mw0);pA1[4]=mand<20>(pA1[4],mw0);pA0[5]=mand<5>(pA0[5],mw0);pA1[5]=mand<21>(pA1[5],mw0);pA0[6]=mand<6>(pA0[6],mw0);pA1[6]=mand<22>(pA1[6],mw0);pA0[7]=mand<7>(pA0[7],mw0);pA1[7]=mand<23>(pA1[7],mw0);pA0[8]=mand<8>(pA0[8],mw0);pA1[8]=mand<24>(pA1[8],mw0);pA0[9]=mand<9>(pA0[9],mw0);pA1[9]=mand<25>(pA1[9],mw0);pA0[10]=mand<10>(pA0[10],mw0);pA1[10]=mand<26>(pA1[10],mw0);pA0[11]=mand<11>(pA0[11],mw0);pA1[11]=mand<27>(pA1[11],mw0);pA0[12]=mand<12>(pA0[12],mw0);pA1[12]=mand<28>(pA1[12],mw0);pA0[13]=mand<13>(pA0[13],mw0);pA1[13]=mand<29>(pA1[13],mw0);pA0[14]=mand<14>(pA0[14],mw0);pA1[14]=mand<30>(pA1[14],mw0);pA0[15]=mand<15>(pA0[15],mw0);pA1[15]=mand<31>(pA1[15],mw0); }
  WAIT_BAR(0);
  DMA_M(2,512);DMA_K(3,0);DMA_V(1,SLOTB);
  ROT();
  kload8(kf,kp0+sl_cur);
  WAIT_BAR(3);
  s16x4 vlo[8],vhi[8]; u32x4 pw0,pw1,pw2,pw3;
  #define PKW(P,B) cvtpk_s(P[B],P[B+1])
  #define PAF(k) __builtin_bit_cast(bf16x8,pw##k)
  #define VFR(i) (bf16x8){vlo[i][0],vlo[i][1],vlo[i][2],vlo[i][3],vhi[i][0],vhi[i][1],vhi[i][2],vhi[i][3]}
  #define PIN(x) asm volatile("":"+v"(x))
  #define MX3(a,b,c) __builtin_fmaxf(__builtin_fmaxf((a),(b)),(c))
  #define GAPA(MF,A0,A1,A2,A3,W0,W1,PW) do{ MF; sacc+=A0; sacc+=A1; sacc+=A2; sacc+=A3; PIN(sacc); W0; W1; PIN(PW); SBAR(); }while(0)
  #define EX(v) __builtin_amdgcn_exp2f(v)
  #define GAPB(MF,X,B,MO) do{ MF; X[B]=mand<MO+B>(EX(X[B]),mw_); X[B+1]=mand<MO+B+1>(EX(X[B+1]),mw_); X[B+2]=mand<MO+B+2>(EX(X[B+2]),mw_); X[B+3]=mand<MO+B+3>(EX(X[B+3]),mw_); PIN(X); SBAR(); }while(0)
  #define VRD(i) do{ vlo[i]=vtr(vp_+(((i)>>2)*4096+((i)&3)*1024)); vhi[i]=vtr(vp_+(((i)>>2)*4096+((i)&3)*1024+512)); }while(0)
  #define KRD(G,j) do{ if(G){ kload2(kf,kp0+sl_next,j); SBAR(); } }while(0)
  #define STEP(C0,C1,P0,P1,t,GK,GV,GL,GM) do{ SBAR(); \
    const lds_cptr vp_=vp0+sl_prev; \
    VRD(0); SBAR(); float sacc=(P0[0]+P0[1]); \
    GAPA(C0=__builtin_amdgcn_mfma_f32_32x32x16_bf16(kf[0],qr[0],negm,0,0,0), P0[2],P0[3],P0[4],P0[5],     pw0[0]=PKW(P0,0), pw0[1]=PKW(P0,2), pw0); \
    VRD(4); SBAR(); GAPA(C1=__builtin_amdgcn_mfma_f32_32x32x16_bf16(kf[1],qr[0],negm,0,0,0), P0[6],P0[7],P0[8],P0[9],     pw0[2]=PKW(P0,4), pw0[3]=PKW(P0,6), pw0); \
    VRD(1); SBAR(); GAPA(C0=__builtin_amdgcn_mfma_f32_32x32x16_bf16(kf[2],qr[1],C0,0,0,0),   P0[10],P0[11],P0[12],P0[13], pw1[0]=PKW(P0,8), pw1[1]=PKW(P0,10), pw1); \
    VRD(5); SBAR(); GAPA(C1=__builtin_amdgcn_mfma_f32_32x32x16_bf16(kf[3],qr[1],C1,0,0,0),   P0[14],P0[15],P1[0],P1[1],   pw1[2]=PKW(P0,12),pw1[3]=PKW(P0,14), pw1); \
    VRD(2); SBAR(); GAPA(C0=__builtin_amdgcn_mfma_f32_32x32x16_bf16(kf[4],qr[2],C0,0,0,0),   P1[2],P1[3],P1[4],P1[5],     pw2[0]=PKW(P1,0), pw2[1]=PKW(P1,2), pw2); \
    VRD(6); SBAR(); GAPA(C1=__builtin_amdgcn_mfma_f32_32x32x16_bf16(kf[5],qr[2],C1,0,0,0),   P1[6],P1[7],P1[8],P1[9],     pw2[2]=PKW(P1,4), pw2[3]=PKW(P1,6), pw2); \
    VRD(3); SBAR(); GAPA(C0=__builtin_amdgcn_mfma_f32_32x32x16_bf16(kf[6],qr[3],C0,0,0,0),   P1[10],P1[11],P1[12],P1[13], pw3[0]=PKW(P1,8), pw3[1]=PKW(P1,10), pw3); \
    VRD(7); SBAR(); GAPA(C1=__builtin_amdgcn_mfma_f32_32x32x16_bf16(kf[7],qr[3],C1,0,0,0),   P1[14],P1[15],0.f,0.f,       pw3[2]=PKW(P1,12),pw3[3]=PKW(P1,14), pw3); \
    l_reg+=sacc; \
    if(GM){DMA_M((t)+2,mq_n2);} if(GK){DMA_K((t)+3,sl_cur);} if(GV){DMA_V((t)+1,sl_next);} \
    const unsigned mw_=MWORD(); \
    CMASK(C0,C1,t); \
    { float a=MX3(C0[0],C0[1],C1[0]),b=MX3(C0[2],C0[3],C1[1]); a=MX3(a,C1[2],C1[3]); \
      _Pragma("unroll") for(int r=4;r<16;r+=4){a=MX3(a,C0[r],C0[r+1]);b=MX3(b,C0[r+2],C0[r+3]);a=MX3(a,C1[r],C1[r+1]);b=MX3(b,C1[r+2],C1[r+3]);} \
      float rm=__builtin_fmaxf(a,b); { auto rr=__builtin_amdgcn_permlane32_swap(__float_as_uint(rm),__float_as_uint(rm),false,false); rm=__builtin_fmaxf(__uint_as_float(rr[0]),__uint_as_float(rr[1])); } \
      resc=false; \
      if(__builtin_expect(__any(rm>(float)THRL),0)){ const float dl=__builtin_fmaxf(rm,0.f); mhat+=dl; \
        _Pragma("unroll") for(int r=0;r<16;++r){C0[r]-=dl;C1[r]-=dl;} \
        _Pragma("unroll") for(int r=0;r<16;++r)negm[r]=-mhat; asm volatile("":"+v"(negm)); \
        const float f=__builtin_amdgcn_exp2f(-dl); l_reg*=f; if(hi==0)wsf[r32]=f; resc=true; } } \
    SBAR(); \
    GAPB(o[0]=__builtin_amdgcn_mfma_f32_32x32x16_bf16(PAF(0),VFR(0),o[0],0,0,0), C0,0,0); \
    GAPB(o[1]=__builtin_amdgcn_mfma_f32_32x32x16_bf16(PAF(0),VFR(4),o[1],0,0,0), C0,4,0); \
    KRD(GL,0); GAPB(o[0]=__builtin_amdgcn_mfma_f32_32x32x16_bf16(PAF(1),VFR(1),o[0],0,0,0), C0,8,0); \
    KRD(GL,1); GAPB(o[1]=__builtin_amdgcn_mfma_f32_32x32x16_bf16(PAF(1),VFR(5),o[1],0,0,0), C0,12,0); \
    KRD(GL,2); GAPB(o[0]=__builtin_amdgcn_mfma_f32_32x32x16_bf16(PAF(2),VFR(2),o[0],0,0,0), C1,0,16); \
    KRD(GL,3); GAPB(o[1]=__builtin_amdgcn_mfma_f32_32x32x16_bf16(PAF(2),VFR(6),o[1],0,0,0), C1,4,16); \
    GAPB(o[0]=__builtin_amdgcn_mfma_f32_32x32x16_bf16(PAF(3),VFR(3),o[0],0,0,0), C1,8,16); \
    GAPB(o[1]=__builtin_amdgcn_mfma_f32_32x32x16_bf16(PAF(3),VFR(7),o[1],0,0,0), C1,12,16); \
    }while(0)
  int t=1;
  #undef CMASK
  #define CMASK(P0,P1,t) do{}while(0)
  for(;t+5<NT;t+=2){
    STEP(pB0,pB1,pA0,pA1,t,true,true,true,true);     WAIT_BAR(3); RESC(); ROT();
    STEP(pA0,pA1,pB0,pB1,t+1,true,true,true,true);   WAIT_BAR(3); RESC(); ROT();
  }
  #undef CMASK
  #define CMASK(P0,P1,t) do{}while(0)
  #define ENDW(tt) do{ if((tt)+3<NT){WAIT_BAR(3);} else if((tt)+2<NT){WAIT_BAR(2);} else {WAIT_BAR(0);} }while(0)
  for(;t+1<NT;t+=2){
    STEP(pB0,pB1,pA0,pA1,t,(t+3<NT),(t+1<NT),(t+1<NT),(t+2<NT));       ENDW(t);   RESC(); ROT();
    STEP(pA0,pA1,pB0,pB1,t+1,(t+4<NT),(t+2<NT),(t+2<NT),(t+3<NT));     ENDW(t+1); RESC(); ROT();
  }
  STEP(pB0,pB1,pA0,pA1,NT-1,false,false,false,false); RESC();
  { float sacc=pB0[0]+pB0[1]; _Pragma("unroll") for(int r=2;r<16;++r)sacc+=pB0[r]; _Pragma("unroll") for(int r=0;r<16;++r)sacc+=pB1[r]; l_reg+=sacc;
    pw0=(u32x4){PKW(pB0,0),PKW(pB0,2),PKW(pB0,4),PKW(pB0,6)};pw1=(u32x4){PKW(pB0,8),PKW(pB0,10),PKW(pB0,12),PKW(pB0,14)};pw2=(u32x4){PKW(pB1,0),PKW(pB1,2),PKW(pB1,4),PKW(pB1,6)};pw3=(u32x4){PKW(pB1,8),PKW(pB1,10),PKW(pB1,12),PKW(pB1,14)};
    SBAR(); pv(o,vb0+sl_cur,PAF(0),PAF(1),PAF(2),PAF(3)); }
  #undef PKW
  #undef PAF
  #undef VFR
  #undef PIN
  #undef MX3
  #undef GAPA
  #undef GAPB
  #undef EX
  #undef VRD
  #undef KRD
  #undef STEP
  #undef ENDW
  {auto rr=__builtin_amdgcn_permlane32_swap(__float_as_uint(l_reg),__float_as_uint(l_reg),false,false);l_reg=__uint_as_float(rr[0])+__uint_as_float(rr[1]);}
  if(hi==0)wsf[32+r32]=l_reg;asm volatile("s_waitcnt lgkmcnt(0)":::"memory");
  float rli[16];
  #pragma unroll
  for(int r=0;r<16;++r)rli[r]=__builtin_amdgcn_rcpf(wsf[32+crow(r,hi)]);
  bf16*Ow=O+(rowbase+q0+wid*QBLK)*ODM+h*D;
  { bf16*stg=(bf16*)(shm+LDS_OST)+wid*2048;
    #pragma unroll
    for(int r=0;r<16;++r){const int orow=crow(r,hi);
      #pragma unroll
      for(int d0=0;d0<2;++d0)stg[orow*64+d0*32+r32]=(bf16)(cvtpk_s(o[d0][r]*rli[r],0.f)&0xffffu);}
    asm volatile("s_waitcnt lgkmcnt(0)":::"memory");
    #pragma unroll
    for(int i=0;i<4;++i){const int row=i*8+(lane>>3),ch=lane&7; const u32x4 v=*(const u32x4*)(stg+row*64+ch*8); ATTN_STORE16(Ow+(long)row*ODM+ch*8,v);} }
  asm volatile("s_waitcnt lgkmcnt(0)\n\ts_barrier":::"memory");
  #undef DMA_K
  #undef DMA_V
  #undef DMA_M
  #undef MWORD
  #undef CMASK
  #undef START
  #undef RESC
  #undef ROT
}
constexpr int ATTN_LDS_BYTES=LDS_BYTES;
struct AttnTensors { const bf16* Q; const bf16* K; const bf16* V; bf16* O; const unsigned* MK; };
struct AttnUnit { int bh; int qb; };
struct StaticOrder {
  int vcu;
  __device__ __forceinline__ explicit StaticOrder(int grid,int block):vcu((block%8)*(grid/8)+block/8){}
  __device__ __forceinline__ bool next(int i,AttnUnit&u)const{ if(i>=2)return false; const int s=vcu&7; u.bh=vcu>>3; u.qb=(i==0)?15-s:s; return true; }
  __device__ __forceinline__ void a_ready(const AttnUnit&)const{}
  __device__ __forceinline__ void done(const AttnUnit&)const{}
};
template<class Sched,int THRL=8> __device__ __forceinline__ void attn_phase(char*lds,const AttnTensors&T,const Sched&S){
  AttnUnit u;
  for(int i=0;S.next(i,u);++i){ S.a_ready(u); attn_unit<THRL>(u.bh/NHEAD,u.bh%NHEAD,u.qb,T.Q,T.K,T.V,T.O,T.MK,lds); S.done(u); }
}
#undef SBAR
#undef WAIT_BAR
}
namespace mk {
#define GAS __attribute__((address_space(1)))
typedef unsigned short bf16_t;
typedef float f32x4 __attribute__((ext_vector_type(4)));
typedef float f32x2 __attribute__((ext_vector_type(2)));
typedef float f32x16 __attribute__((ext_vector_type(16)));
typedef unsigned u32x4 __attribute__((ext_vector_type(4)));
typedef unsigned u32x2 __attribute__((ext_vector_type(2)));
typedef short bf16x8 __attribute__((ext_vector_type(8)));
constexpr int NB = 4, S = 4096, T = NB * S, D = 1024;
constexpr int NWAVES = 8, NTHR = 512;
constexpr int INW = 4168;
constexpr int NPHYS = 4352;
constexpr float C2 = 0.125f * 1.4426950408889634f;
constexpr float WI_SCALE = 0.04419417382415922f;
constexpr float KR_SCALE = 0.08838834764831845f;
constexpr size_t MiB = 1u << 20;
#ifndef WS_RT_MIB
#define WS_RT_MIB 65
#endif
constexpr size_t WS_CTL = 0, CTL_BYTES = 131072;
constexpr size_t WS_MOD = 1 * MiB;
constexpr size_t WS_THR = 2 * MiB;
constexpr size_t WS_R128 = 3 * MiB;
constexpr size_t WS_R64 = 11 * MiB;
constexpr size_t WS_WOUT = 15 * MiB;
constexpr size_t WS_QA = 17 * MiB, WS_KA = 33 * MiB, WS_VA = 49 * MiB, WS_QI = 65 * MiB, WS_KI = 81 * MiB, WS_WI = 83 * MiB;
constexpr size_t WS_QR = 84 * MiB, WS_KR = 100 * MiB, WS_VR = 116 * MiB, WS_GR = 132 * MiB;
constexpr size_t WS_H = 148 * MiB;
constexpr size_t WS_WIN = 180 * MiB;
constexpr size_t WS_SCORES = 148 * MiB, WS_KVS = 214 * MiB, WS_MASKT = 246 * MiB, WS_RT = WS_RT_MIB * MiB, WS_MIXED = 148 * MiB;
constexpr int CW_BAR = 1024, CW_Q = 14400, CW_TMO = 14600;
constexpr int RING_BYTES = 131072;
constexpr int LDS_BYTES = 163840;
constexpr int MISC_OFF = LDS_BYTES - 1024;

typedef __bf16 bf16x2_t __attribute__((ext_vector_type(2)));
__device__ __forceinline__ unsigned cvt_pk(float lo, float hi) { const f32x2 v = {lo, hi}; const bf16x2_t b = __builtin_convertvector(v, bf16x2_t); return __builtin_bit_cast(unsigned, b); }
__device__ __forceinline__ float bf2f(bf16_t v) { return __uint_as_float((unsigned)v << 16); }
__device__ __forceinline__ float silu_f(float x) { return x / (1.f + __expf(-x)); }
#define MK_DPP_ADD(v, ctrl) v += __uint_as_float((unsigned)__builtin_amdgcn_update_dpp(0, (int)__float_as_uint(v), ctrl, 0xf, 0xf, false))
__device__ __forceinline__ float wave_sum(float v) {
    MK_DPP_ADD(v, 0xB1);
    MK_DPP_ADD(v, 0x4E);
    MK_DPP_ADD(v, 0x141);
    MK_DPP_ADD(v, 0x140);
    { const unsigned u = __float_as_uint(v); auto r = __builtin_amdgcn_permlane16_swap(u, u, false, false); v = __uint_as_float(r[0]) + __uint_as_float(r[1]); }
    { const unsigned u = __float_as_uint(v); auto r = __builtin_amdgcn_permlane32_swap(u, u, false, false); v = __uint_as_float(r[0]) + __uint_as_float(r[1]); }
    return v;
}
__host__ __device__ __forceinline__ int perm_fwd(int o, int half) { const int hi = o >= half ? 1 : 0, oo = o - hi * half; return 8 * (oo >> 2) + 4 * hi + (oo & 3); }
__host__ __device__ __forceinline__ int perm_inv(int p, int half) { const int g = p >> 3, r = p & 7; return (r < 4) ? 4 * g + r : half + 4 * g + (r - 4); }
__device__ __forceinline__ int in_src_col(int n) {
    const int tile = n >> 8;
    if (tile < 2) { const int s = n; return 0 + (s & ~63) + perm_inv(s & 63, 32); }
    if (tile < 4) { const int s = n - 512; return 512 + (s & ~63) + perm_inv(s & 63, 32); }
    if (tile < 6) return n;
    if (tile < 8) { const int s = n - 1536; return 1536 + (s & ~63) + perm_inv(s & 63, 32); }
    if (tile == 8) { const int s = n - 2048; if (s < 64) return 2048 + perm_inv(s, 32); if (s < 72) return 2112 + (s - 64); return -1; }
    const int s = n - 2304;
    if (tile < 11) return 2120 + (s & ~127) + perm_inv(s & 127, 64);
    if (tile < 13) { const int q = s - 512; return 2632 + (q & ~127) + perm_inv(q & 127, 64); }
    if (tile < 15) return 3144 + (s - 1024);
    return 3656 + (s - 1536);
}
__device__ __forceinline__ void p0_item_ada(LAS unsigned char* lds, const float* c, const float* w_ada, const float* b_ada, float* mod, int j, int tid) {
    LAS float* sc = (LAS float*)lds; LAS float* part = (LAS float*)(lds + 16384);
    __syncthreads();
    for (int i = tid; i < 4096; i += NTHR) sc[i] = silu_f(c[i]);
    __syncthreads();
    const int col = tid & 31, kg = tid >> 5;
    float a0 = 0.f, a1 = 0.f, a2 = 0.f, a3 = 0.f;
    const float* w = w_ada + 32 * j + col;
#pragma unroll 1
    for (int k0 = kg; k0 < 1024; k0 += 256) {
        float wv[16];
#pragma unroll
        for (int i = 0; i < 16; ++i) wv[i] = w[(size_t)(k0 + 16 * i) * 6144];
#pragma unroll
        for (int i = 0; i < 16; ++i) { const int k = k0 + 16 * i; a0 += sc[k] * wv[i]; a1 += sc[1024 + k] * wv[i]; a2 += sc[2048 + k] * wv[i]; a3 += sc[3072 + k] * wv[i]; }
    }
    part[(kg * 32 + col) * 4 + 0] = a0; part[(kg * 32 + col) * 4 + 1] = a1; part[(kg * 32 + col) * 4 + 2] = a2; part[(kg * 32 + col) * 4 + 3] = a3;
    __syncthreads();
    if (tid < 128) {
        const int cc = tid >> 2, b = tid & 3; float s = 0.f;
#pragma unroll
        for (int g = 0; g < 16; ++g) s += part[(g * 32 + cc) * 4 + b];
        mod[b * 6144 + 32 * j + cc] = s + b_ada[32 * j + cc];
    }
}
__device__ __forceinline__ void p0_item_rope(const int* pos, float* R128, float* R64, int r, int lane) {
    const float f128 = powf(10000.f, -(float)lane / 64.f), f64 = powf(10000.f, -(float)(lane & 31) / 32.f);
    for (int tt = 0; tt < 16; ++tt) {
        const int t = 16 * r + tt;
        float sn, cs; sincosf((float)pos[t] * f128, &sn, &cs);
        *(f32x2*)(R128 + ((size_t)t * 64 + lane) * 2) = (f32x2){cs, sn};
    }
    for (int tt = 0; tt < 16; tt += 2) {
        const int t = 16 * r + tt + (lane >> 5);
        float sn, cs; sincosf((float)pos[t] * f64, &sn, &cs);
        *(f32x2*)(R64 + ((size_t)t * 32 + (lane & 31)) * 2) = (f32x2){cs, sn};
    }
}
template <int MODE> struct TrItem { const float* sp; int ldw, Kdim, n0, k0; bf16_t* WT; bool valid; };
template <int MODE> __device__ __forceinline__ void p0_tr_setup(TrItem<MODE>& it, const float* W, const float* W2, int ldw, int Kdim, bf16_t* WT, int n0, int k0, int lane) {
    const int nl = lane & 31, n = n0 + nl;
    int src = n; const float* Ws = W;
    if (MODE == 0) src = in_src_col(n);
    if (MODE == 2) { const int g = n >> 3, r = n & 7; src = 4 * g + (r & 3); Ws = (r < 4) ? W : W2; }
    it.sp = Ws + (size_t)(k0 + (lane >> 5)) * ldw + (src >= 0 ? src : 0); it.ldw = ldw; it.Kdim = Kdim; it.n0 = n0; it.k0 = k0; it.WT = WT; it.valid = (src >= 0);
}
template <int MODE> __device__ __forceinline__ void p0_tr_load(const TrItem<MODE>& it, float (&tv)[32]) {
#pragma unroll
    for (int i = 0; i < 32; ++i) tv[i] = it.sp[(size_t)(2 * i) * it.ldw];
}
template <int MODE> __device__ __forceinline__ void p0_tr_emit(const TrItem<MODE>& it, const float (&tv)[32], LAS float* scr, int lane) {
    const int nl = lane & 31;
#pragma unroll
    for (int i = 0; i < 32; ++i) scr[(2 * i + (lane >> 5)) * 33 + nl] = it.valid ? tv[i] : 0.f;
    asm volatile("s_waitcnt lgkmcnt(0)" ::: "memory");
    const int c = lane & 7;
#pragma unroll
    for (int j = 0; j < 4; ++j) {
        const int nn = (lane >> 3) + 8 * j; const LAS float* q = scr + (8 * c) * 33 + nn;
        u32x4 o; o.x = cvt_pk(q[0 * 33], q[1 * 33]); o.y = cvt_pk(q[2 * 33], q[3 * 33]); o.z = cvt_pk(q[4 * 33], q[5 * 33]); o.w = cvt_pk(q[6 * 33], q[7 * 33]);
        *(u32x4*)(it.WT + (size_t)(it.n0 + nn) * it.Kdim + it.k0 + 8 * c) = o;
    }
    asm volatile("s_waitcnt lgkmcnt(0)" ::: "memory");
}
template <int MODE> __device__ __forceinline__ void p0_tr_item(const float* W, const float* W2, int ldw, int Kdim, bf16_t* WT, int n0, int k0, LAS float* scr, int lane) {
    TrItem<MODE> it; p0_tr_setup<MODE>(it, W, W2, ldw, Kdim, WT, n0, k0, lane);
    float tv[32]; p0_tr_load<MODE>(it, tv); p0_tr_emit<MODE>(it, tv, scr, lane);
}
struct P0Args { const float *c, *w_ada, *b_ada, *w_in, *w_out, *w_gate, *w_up, *w_down; const int* pos; float *mod, *R128, *R64; bf16_t *WIN, *WOUT, *WGU, *WD; };
__device__ __forceinline__ void p0_prologue(LAS unsigned char* lds, const P0Args& a, int bid, int G, int tid) {
    const int lane = tid & 63, wave = tid >> 6;
    if (bid < 192) p0_item_ada(lds, a.c, a.w_ada, a.b_ada, a.mod, bid, tid);
    __syncthreads();
    LAS float* scr = (LAS float*)(lds + wave * 8448);
    constexpr int I_ROPE = 1024, I_WIN = 16 * (NPHYS / 32), I_WOUT = 16 * 32;
    for (int it = bid * NWAVES + wave; it < I_ROPE + I_WIN + I_WOUT; it += G * NWAVES) {
        int r = it;
        if (r < I_ROPE) { p0_item_rope(a.pos, a.R128, a.R64, r, lane); continue; } r -= I_ROPE;
        if (r < I_WIN) { const int kb = r / (NPHYS / 32), nb = r - kb * (NPHYS / 32); p0_tr_item<0>(a.w_in, nullptr, INW, 1024, a.WIN, 32 * nb, 64 * kb, scr, lane); continue; } r -= I_WIN;
        { const int kb = r >> 5, nb = r & 31; p0_tr_item<1>(a.w_out, nullptr, 1024, 1024, a.WOUT, 32 * nb, 64 * kb, scr, lane); }
    }
}
__device__ __forceinline__ void p0_expert_items(LAS unsigned char* lds, const P0Args& a, int gw, int ngw, int tid) {
    const int lane = tid & 63, wave = tid >> 6;
    LAS float* scr = (LAS float*)(lds + wave * 8448);
    constexpr int I_WGU = 32 * 256, I_WD = 32 * 128;
    {
        TrItem<2> cur, nxt; float tv[32], tn[32];
        int it = gw;
        if (it < I_WGU) { const int e = it >> 8, q = it & 255, kb = q >> 4, nb = q & 15;
            p0_tr_setup<2>(cur, a.w_gate + (size_t)e * 262144, a.w_up + (size_t)e * 262144, 256, 1024, a.WGU + (size_t)e * 524288, 32 * nb, 64 * kb, lane); p0_tr_load<2>(cur, tv); }
#pragma unroll 1
        for (; it < I_WGU; it += ngw) {
            const int i2 = it + ngw; const bool has = i2 < I_WGU;
            if (has) { const int e = i2 >> 8, q = i2 & 255, kb = q >> 4, nb = q & 15;
                p0_tr_setup<2>(nxt, a.w_gate + (size_t)e * 262144, a.w_up + (size_t)e * 262144, 256, 1024, a.WGU + (size_t)e * 524288, 32 * nb, 64 * kb, lane); p0_tr_load<2>(nxt, tn); }
            p0_tr_emit<2>(cur, tv, scr, lane);
            if (has) { cur = nxt;
#pragma unroll
                for (int i = 0; i < 32; ++i) tv[i] = tn[i]; }
        }
    }
    {
        TrItem<1> cur, nxt; float tv[32], tn[32];
        int it = gw;
        if (it < I_WD) { const int e = it >> 7, q = it & 127, kb = q >> 5, nb = q & 31;
            p0_tr_setup<1>(cur, a.w_down + (size_t)e * 262144, nullptr, 1024, 256, a.WD + (size_t)e * 262144, 32 * nb, 64 * kb, lane); p0_tr_load<1>(cur, tv); }
#pragma unroll 1
        for (; it < I_WD; it += ngw) {
            const int i2 = it + ngw; const bool has = i2 < I_WD;
            if (has) { const int e = i2 >> 7, q = i2 & 127, kb = q >> 5, nb = q & 31;
                p0_tr_setup<1>(nxt, a.w_down + (size_t)e * 262144, nullptr, 1024, 256, a.WD + (size_t)e * 262144, 32 * nb, 64 * kb, lane); p0_tr_load<1>(nxt, tn); }
            p0_tr_emit<1>(cur, tv, scr, lane);
            if (has) { cur = nxt;
#pragma unroll
                for (int i = 0; i < 32; ++i) tv[i] = tn[i]; }
        }
    }
}
__device__ __forceinline__ void p1_row_load(f32x4 (&v)[4], const float* x, int m, int lane) {
    const f32x4* xr = (const f32x4*)(x + (size_t)m * D) + lane;
#pragma unroll
    for (int j = 0; j < 4; ++j) v[j] = xr[64 * j];
}
__device__ __forceinline__ void p1_rows(const float* x, const float* g, const float* mod, bf16_t* H, int gw, int NGW, int lane) {
#pragma unroll 1
    for (int m0 = gw * 8; m0 < T; m0 += NGW * 8) {
        f32x4 v[4][4];
        p1_row_load(v[0], x, m0, lane); p1_row_load(v[1], x, m0 + 1, lane); p1_row_load(v[2], x, m0 + 2, lane);
        const int b = m0 / S;
        const float* sh = mod + b * 6144; const float* sc = sh + 1024;
        f32x4 G[4], SH[4];
#pragma unroll
        for (int j = 0; j < 4; ++j) { const int col = 4 * lane + 256 * j; const f32x4 gg = *(const f32x4*)(g + col), a = *(const f32x4*)(sc + col); SH[j] = *(const f32x4*)(sh + col); G[j] = gg * (a + 1.0f); }
#pragma unroll
        for (int i = 0; i < 8; ++i) {
            if (i + 3 < 8) p1_row_load(v[(i + 3) & 3], x, m0 + i + 3, lane);
            const f32x4 (&c)[4] = v[i & 3];
            float s = 0.f;
#pragma unroll
            for (int j = 0; j < 4; ++j) s += (c[j].x * c[j].x + c[j].y * c[j].y) + (c[j].z * c[j].z + c[j].w * c[j].w);
            const float rs = 1.0f / sqrtf(wave_sum(s) * (1.f / 1024.f) + 1e-6f);
            bf16_t* orow = H + (size_t)(m0 + i) * D;
#pragma unroll
            for (int j = 0; j < 4; ++j) {
                const f32x4 o = c[j] * rs * G[j] + SH[j];
                u32x2 w; w.x = cvt_pk(o.x, o.y); w.y = cvt_pk(o.z, o.w);
                *(u32x2*)(orow + 4 * lane + 256 * j) = w;
            }
        }
    }
}
struct EpiInProj {
    static constexpr bool PERM = true, AFTER_DRAIN = false;
    bf16_t *QA, *KA, *VA, *QI, *KI, *QR, *KR, *VR, *GR; float* WI; const float* R64; const float* R128;
    template <int ROPE, int ACT> __device__ __forceinline__ void emit(const pg8::f32x4 (&acc)[2][2][4][2], bf16_t* dst, int ld, int segbase, float scale, int row0, int wc, int fq, int bjmask) const {
#pragma unroll
        for (int bj = 0; bj < 2; ++bj) {
            if (!((bjmask >> bj) & 1)) continue;
            const int cg = segbase + 128 * bj + 32 * wc + 8 * fq;
            const int fi = (ROPE == 1) ? ((cg & 63) >> 1) : ((cg & 127) >> 1);
#pragma unroll
            for (int ai = 0; ai < 2; ++ai)
#pragma unroll
                for (int m = 0; m < 4; ++m) {
                    const int row = row0 + ai * 128 + m * 16;
                    pg8::f32x4 v0 = acc[ai][bj][m][0], v1 = acc[ai][bj][m][1];
                    if (ROPE != 0) {
                        const float* tp = (ROPE == 1) ? (R64 + ((size_t)row * 32 + fi) * 2) : (R128 + ((size_t)row * 64 + fi) * 2);
                        const pg8::f32x4 t0 = *(const pg8::f32x4*)tp, t1 = *(const pg8::f32x4*)(tp + 4);
                        pg8::f32x4 o1, o2;
                        o1[0] = v0[0] * t0[0] - v1[0] * t0[1]; o2[0] = v1[0] * t0[0] + v0[0] * t0[1];
                        o1[1] = v0[1] * t0[2] - v1[1] * t0[3]; o2[1] = v1[1] * t0[2] + v0[1] * t0[3];
                        o1[2] = v0[2] * t1[0] - v1[2] * t1[1]; o2[2] = v1[2] * t1[0] + v0[2] * t1[1];
                        o1[3] = v0[3] * t1[2] - v1[3] * t1[3]; o2[3] = v1[3] * t1[2] + v0[3] * t1[3];
                        v0 = o1; v1 = o2;
                    }
                    if (ACT == 1) {
#pragma unroll
                        for (int e = 0; e < 4; ++e) { v0[e] = silu_f(v0[e]); v1[e] = silu_f(v1[e]); }
                    }
                    v0 = v0 * scale; v1 = v1 * scale;
                    u32x4 w; w.x = cvt_pk(v0[0], v0[1]); w.y = cvt_pk(v0[2], v0[3]); w.z = cvt_pk(v1[0], v1[1]); w.w = cvt_pk(v1[2], v1[3]);
                    *(u32x4*)(dst + (size_t)row * ld + cg) = w;
                }
        }
    }
    __device__ __forceinline__ void operator()(const pg8::f32x4 (&acc)[2][2][4][2], const pg8::Unit& u, int wr, int wc, int fr, int fq) const {
        const int row0 = u.pm * 256 + wr * 64 + fr;
        const int pn = u.pn;
        if (pn < 2) emit<1, 0>(acc, QA, 512, pn * 256, C2, row0, wc, fq, 3);
        else if (pn < 4) emit<1, 0>(acc, KA, 512, (pn - 2) * 256, 1.f, row0, wc, fq, 3);
        else if (pn < 6) emit<0, 0>(acc, VA, 512, (pn - 4) * 256, 1.f, row0, wc, fq, 3);
        else if (pn < 8) emit<1, 0>(acc, QI, 512, (pn - 6) * 256, 1.f, row0, wc, fq, 3);
        else if (pn == 8) {
            if (wc < 2) emit<1, 0>(acc, KI, 64, 0, 1.f, row0, wc, fq, 1);
            else if (wc == 2 && fq == 0) {
#pragma unroll
                for (int ai = 0; ai < 2; ++ai)
#pragma unroll
                    for (int m = 0; m < 4; ++m) {
                        const int row = row0 + ai * 128 + m * 16;
                        *(pg8::f32x4*)(WI + (size_t)row * 8) = acc[ai][0][m][0] * WI_SCALE;
                        *(pg8::f32x4*)(WI + (size_t)row * 8 + 4) = acc[ai][0][m][1] * WI_SCALE;
                    }
            }
        }
        else if (pn < 11) emit<2, 0>(acc, QR, 512, (pn - 9) * 256, 1.f, row0, wc, fq, 3);
        else if (pn < 13) emit<2, 0>(acc, KR, 512, (pn - 11) * 256, KR_SCALE, row0, wc, fq, 3);
        else if (pn < 15) emit<0, 0>(acc, VR, 512, (pn - 13) * 256, 1.f, row0, wc, fq, 3);
        else emit<0, 1>(acc, GR, 512, (pn - 15) * 256, 1.f, row0, wc, fq, 3);
    }
};
typedef short v4i16_t __attribute__((ext_vector_type(4)));
__device__ __forceinline__ unsigned off_b(unsigned row, unsigned ch) { return 256u * row + 16u * (ch ^ (((row & 3u) << 2) | ((row >> 2) & 3u))); }
__device__ __forceinline__ int crow(int r, int hi) { return (r & 3) + 8 * (r >> 2) + 4 * hi; }
__device__ __forceinline__ v4i16_t tr_rd(LAS unsigned char* p) { return __builtin_amdgcn_ds_read_tr16_b64_v4i16((LAS v4i16_t*)p); }
__device__ __forceinline__ bf16x8 tr_frag_nat(LAS unsigned char* img, int lane, int c, int ks) {
    const unsigned h = lane >> 5, blk = (lane >> 4) & 1, q = (lane & 15) >> 2, p = lane & 3;
    const v4i16_t lo = tr_rd(img + off_b(16 * ks + 8 * h + q, 4 * c + 2 * blk + (p >> 1)) + 8 * (p & 1));
    const v4i16_t hi = tr_rd(img + off_b(16 * ks + 8 * h + 4 + q, 4 * c + 2 * blk + (p >> 1)) + 8 * (p & 1));
    return (bf16x8){lo[0], lo[1], lo[2], lo[3], hi[0], hi[1], hi[2], hi[3]};
}
__device__ __forceinline__ bf16x8 tr_frag_acc(LAS unsigned char* img, int lane, int c, int rowbase) {
    const unsigned h = lane >> 5, blk = (lane >> 4) & 1, q = (lane & 15) >> 2, p = lane & 3;
    const v4i16_t lo = tr_rd(img + off_b(rowbase + 4 * h + q, 4 * c + 2 * blk + (p >> 1)) + 8 * (p & 1));
    const v4i16_t hi = tr_rd(img + off_b(rowbase + 8 + 4 * h + q, 4 * c + 2 * blk + (p >> 1)) + 8 * (p & 1));
    return (bf16x8){lo[0], lo[1], lo[2], lo[3], hi[0], hi[1], hi[2], hi[3]};
}
__device__ __forceinline__ float ret_lgam(int h) { return logf(1.0f - exp2f(-5.0f - (float)h)); }
template <bool SCALE> __device__ __forceinline__ void ret_stage(LAS unsigned char* img, const bf16_t* src  , float sc, int tl) {
#pragma unroll
    for (int it = 0; it < 8; ++it) {
        const int idx = tl + 256 * it, row = idx >> 4, ch = idx & 15;
        u32x4 v = *(const u32x4*)(src + (size_t)row * 512 + ch * 8);
        if (SCALE) {
            const float f = expf(sc * (float)row);
#pragma unroll
            for (int e = 0; e < 4; ++e) { const unsigned w = v[e]; v[e] = cvt_pk(__uint_as_float(w << 16) * f, __uint_as_float(w & 0xffff0000u) * f); }
        }
        *(LAS u32x4*)(img + off_b(row, ch)) = v;
    }
}
__device__ __forceinline__ void ret_kv_pair(LAS unsigned char* lds, const bf16_t* KR, const bf16_t* VR, float* KVS, int pair, int tid) {
    const int uh = tid >> 8, tl = tid & 255, lane = tid & 63, w4 = __builtin_amdgcn_readfirstlane((tid >> 6) & 3), hi = lane >> 5, r32 = lane & 31;
    const int unit = pair * 2 + uh, n = unit & 31, bh = unit >> 5, b = bh >> 2, h = bh & 3;
    const size_t tok0 = (size_t)b * S + (size_t)n * 128;
    LAS unsigned char* kimg = lds + uh * 65536; LAS unsigned char* vimg = kimg + 32768;
    const float lgam = ret_lgam(h);
    __syncthreads();
    ret_stage<false>(kimg, KR + tok0 * 512 + h * 128, 0.f, tl);
    ret_stage<true>(vimg, VR + tok0 * 512 + h * 128, -lgam, tl);
    __syncthreads();
    f32x16 acc[4];
#pragma unroll
    for (int c = 0; c < 4; ++c) acc[c] = (f32x16){};
#pragma unroll
    for (int ks = 0; ks < 8; ++ks) {
        const bf16x8 a = tr_frag_nat(vimg, lane, w4, ks);
#pragma unroll
        for (int nt = 0; nt < 4; ++nt) { const bf16x8 bb = tr_frag_nat(kimg, lane, nt, ks); acc[nt] = __builtin_amdgcn_mfma_f32_32x32x16_bf16(a, bb, acc[nt], 0, 0, 0); }
    }
    const float sc = expf(lgam * 127.f);
    float* o = KVS + (size_t)unit * 16384;
#pragma unroll
    for (int nt = 0; nt < 4; ++nt)
#pragma unroll
        for (int r = 0; r < 16; ++r) o[(32 * w4 + crow(r, hi)) * 128 + 32 * nt + r32] = acc[nt][r] * sc;
}
__device__ __forceinline__ void ret_scan(const float* __restrict__ KVS, bf16_t* __restrict__ RT, int gtid, int nthreads) {
    for (int idx = gtid; idx < 16 * 16384; idx += nthreads) {
        const int bh = idx >> 14, el = idx & 16383, h = bh & 3;
        const float g = 1.0f - exp2f(-5.0f - (float)h), g128 = expf(128.f * ret_lgam(h));
        const size_t o0 = ((size_t)(bh * 32) << 14) + el;
        float kv[31];
#pragma unroll
        for (int n = 0; n < 31; ++n) kv[n] = KVS[o0 + ((size_t)n << 14)];
        float R = 0.f;
#pragma unroll
        for (int n = 0; n < 32; ++n) {
            RT[o0 + ((size_t)n << 14)] = (bf16_t)(cvt_pk(g * R, 0.f) & 0xffffu);
            if (n < 31) R = g128 * R + kv[n];
        }
    }
}
__device__ __forceinline__ void ret_out_pair(LAS unsigned char* lds, const bf16_t* QR, const bf16_t* KR, const bf16_t* VR, const bf16_t* GR, const bf16_t* RT, bf16_t* MIXED, int pair, int tid) {
    const int uh = tid >> 8, tl = tid & 255, lane = tid & 63, w4 = __builtin_amdgcn_readfirstlane((tid >> 6) & 3), hi = lane >> 5, r32 = lane & 31;
    const int unit = pair * 2 + uh, n = unit & 31, bh = unit >> 5, b = bh >> 2, h = bh & 3;
    const size_t tok0 = (size_t)b * S + (size_t)n * 128;
    LAS unsigned char* vimg = lds + uh * 32768;
    const float lgam = ret_lgam(h);
    __syncthreads();
    ret_stage<true>(vimg, VR + tok0 * 512 + h * 128, -lgam, tl);
    __syncthreads();
    bf16x8 qf[8];
    {
        const bf16_t* qp = QR + (tok0 + 32 * w4 + r32) * 512 + h * 128 + 8 * hi;
#pragma unroll
        for (int ks = 0; ks < 8; ++ks) qf[ks] = *(const bf16x8*)(qp + 16 * ks);
    }
    f32x16 acc[4];
#pragma unroll
    for (int c = 0; c < 4; ++c) acc[c] = (f32x16){};
    if (n > 0) {
        const bf16_t* rp = RT + (size_t)unit * 16384 + r32 * 128 + 8 * hi;
#pragma unroll
        for (int c = 0; c < 4; ++c)
#pragma unroll
            for (int ks = 0; ks < 8; ++ks) { const bf16x8 a = *(const bf16x8*)(rp + c * 32 * 128 + 16 * ks); acc[c] = __builtin_amdgcn_mfma_f32_32x32x16_bf16(a, qf[ks], acc[c], 0, 0, 0); }
    }
    for (int jt = 0; jt <= w4; ++jt) {
        const bf16_t* kp = KR + (tok0 + 32 * jt + r32) * 512 + h * 128 + 8 * hi;
        f32x16 st = (f32x16){};
#pragma unroll
        for (int ks = 0; ks < 8; ++ks) { const bf16x8 kf = *(const bf16x8*)(kp + 16 * ks); st = __builtin_amdgcn_mfma_f32_32x32x16_bf16(kf, qf[ks], st, 0, 0, 0); }
        if (jt == w4) {
#pragma unroll
            for (int r = 0; r < 16; ++r) if (crow(r, hi) > r32) st[r] = 0.f;
        }
#pragma unroll
        for (int s = 0; s < 2; ++s) {
            u32x4 pw; pw.x = cvt_pk(st[8 * s + 0], st[8 * s + 1]); pw.y = cvt_pk(st[8 * s + 2], st[8 * s + 3]); pw.z = cvt_pk(st[8 * s + 4], st[8 * s + 5]); pw.w = cvt_pk(st[8 * s + 6], st[8 * s + 7]);
            const bf16x8 pb = __builtin_bit_cast(bf16x8, pw);
#pragma unroll
            for (int c = 0; c < 4; ++c) { const bf16x8 vf = tr_frag_acc(vimg, lane, c, 32 * jt + 16 * s); acc[c] = __builtin_amdgcn_mfma_f32_32x32x16_bf16(vf, pb, acc[c], 0, 0, 0); }
        }
    }
    float ss = 0.f;
#pragma unroll
    for (int c = 0; c < 4; ++c)
#pragma unroll
        for (int r = 0; r < 16; ++r) ss += acc[c][r] * acc[c][r];
    ss += __shfl_xor(ss, 32);
    const float gi = expf(lgam * (float)(32 * w4 + r32));
    const float fac = gi / sqrtf(gi * gi * ss * (1.0f / 128.f) + 1e-6f);
    const size_t tok = tok0 + 32 * w4 + r32;
    const bf16_t* gp = GR + tok * 512 + h * 128 + 4 * hi;
    bf16_t* op = MIXED + tok * 1024 + 512 + h * 128 + 4 * hi;
#pragma unroll
    for (int c = 0; c < 4; ++c)
#pragma unroll
        for (int g4 = 0; g4 < 4; ++g4) {
            const u32x2 gv = *(const u32x2*)(gp + 32 * c + 8 * g4);
            const float g0 = __uint_as_float(gv.x << 16), g1 = __uint_as_float(gv.x & 0xffff0000u), g2 = __uint_as_float(gv.y << 16), g3 = __uint_as_float(gv.y & 0xffff0000u);
            u32x2 w; w.x = cvt_pk(acc[c][4 * g4 + 0] * fac * g0, acc[c][4 * g4 + 1] * fac * g1); w.y = cvt_pk(acc[c][4 * g4 + 2] * fac * g2, acc[c][4 * g4 + 3] * fac * g3);
            *(u32x2*)(op + 32 * c + 8 * g4) = w;
        }
}
constexpr size_t WS_MIX = 17 * MiB;
constexpr size_t WS_H2 = 49 * MiB;
constexpr size_t WS_LIST = 81 * MiB;
constexpr size_t WS_HID = 85 * MiB;
constexpr size_t WS_Y = 105 * MiB;
constexpr size_t WS_HRES = 180 * MiB;
constexpr int CW_CNT = 12288;
constexpr int CW_TILE = 16384;
constexpr int TB_OFF = MISC_OFF + 64;

struct EpiStore {
    static constexpr bool PERM = true, AFTER_DRAIN = false;
    bf16_t* O; int ld;
    __device__ __forceinline__ void operator()(const pg8::f32x4 (&acc)[2][2][4][2], const pg8::Unit& u, int wr, int wc, int fr, int fq) const {
        const int row0 = u.pm * 256 + wr * 64 + fr, col0 = u.pn * 256 + wc * 32 + 8 * fq;
#pragma unroll
        for (int ai = 0; ai < 2; ++ai)
#pragma unroll
            for (int m = 0; m < 4; ++m)
#pragma unroll
                for (int bj = 0; bj < 2; ++bj) {
                    const pg8::f32x4 v0 = acc[ai][bj][m][0], v1 = acc[ai][bj][m][1];
                    u32x4 w; w.x = cvt_pk(v0[0], v0[1]); w.y = cvt_pk(v0[2], v0[3]); w.z = cvt_pk(v1[0], v1[1]); w.w = cvt_pk(v1[2], v1[3]);
                    *(u32x4*)(O + (size_t)(row0 + ai * 128 + m * 16) * ld + col0 + bj * 128) = w;
                }
    }
};
struct P6bArgs { const bf16_t* MIX; const float *x, *g_post, *g_pre2, *mod, *w_group, *b_group, *w_expert, *b_expert; float* HRES; bf16_t* H2; unsigned* cnt; u32x2* LIST; };
constexpr int P6B_NR = 4;
constexpr int RT_WL_OFF = 147456;
__device__ __forceinline__ void p6b_load_weights(LAS unsigned char* lds, const float* w_group, const float* w_expert, int tid) {
    __syncthreads();
    for (int idx = tid; idx < 1024 * 9; idx += NTHR) {
        const int d = idx / 9, cc = idx - 9 * d, pos = ((d >> 2) & 63) + 64 * ((d & 3) + 4 * (d >> 8));
        const f32x4 v = (cc == 0) ? *(const f32x4*)(w_group + d * 4) : *(const f32x4*)(w_expert + d * 32 + 4 * (cc - 1));
        *(LAS f32x4*)(lds + pos * 144 + 16 * cc) = v;
    }
    __syncthreads();
}
struct P6bIn { u32x2 mw[P6B_NR][4]; f32x4 xv[P6B_NR][4]; };
__device__ __forceinline__ void p6b_load(P6bIn& I, const P6bArgs& a, int gw, int lane) {
    const int m0 = gw * P6B_NR;
#pragma unroll
    for (int r = 0; r < P6B_NR; ++r)
#pragma unroll
        for (int j = 0; j < 4; ++j) I.mw[r][j] = *(const u32x2*)(a.MIX + (size_t)(m0 + r) * 1024 + 4 * lane + 256 * j);
#pragma unroll
    for (int r = 0; r < P6B_NR; ++r)
#pragma unroll
        for (int j = 0; j < 4; ++j) I.xv[r][j] = *(const f32x4*)(a.x + (size_t)(m0 + r) * 1024 + 4 * lane + 256 * j);
}
__device__ __forceinline__ void p6b_norm(const P6bArgs& a, const P6bIn& I, f32x2 (&hp)[P6B_NR][8], int gw, int lane) {
    const int m0 = gw * P6B_NR, b = m0 / S;
    const float* md = a.mod + b * 6144;
    f32x4 G1[4], G2[4], SH[4];
#pragma unroll
    for (int j = 0; j < 4; ++j) {
        const int col = 4 * lane + 256 * j;
        const f32x4 gp = *(const f32x4*)(a.g_post + col), g1 = *(const f32x4*)(md + 2 * 1024 + col), g2 = *(const f32x4*)(a.g_pre2 + col), sc = *(const f32x4*)(md + 4 * 1024 + col);
        SH[j] = *(const f32x4*)(md + 3 * 1024 + col); G1[j] = g1 * gp; G2[j] = g2 * (sc + 1.0f);
    }
#pragma unroll
    for (int r = 0; r < P6B_NR; ++r) {
        const size_t row = (size_t)(m0 + r);
        float v[16]; float s = 0.f;
#pragma unroll
        for (int j = 0; j < 4; ++j) {
            const u32x2 w = I.mw[r][j];
            v[4 * j + 0] = __uint_as_float(w.x << 16); v[4 * j + 1] = __uint_as_float(w.x & 0xffff0000u); v[4 * j + 2] = __uint_as_float(w.y << 16); v[4 * j + 3] = __uint_as_float(w.y & 0xffff0000u);
#pragma unroll
            for (int k = 0; k < 4; ++k) s += v[4 * j + k] * v[4 * j + k];
        }
        const float rs = 1.0f / sqrtf(wave_sum(s) * (1.f / 1024.f) + 1e-6f);
        float s2 = 0.f;
#pragma unroll
        for (int j = 0; j < 4; ++j) {
            const int col = 4 * lane + 256 * j;
            const f32x4 xx = I.xv[r][j];
            f32x4 hr;
#pragma unroll
            for (int k = 0; k < 4; ++k) { hr[k] = xx[k] + G1[j][k] * (v[4 * j + k] * rs); v[4 * j + k] = hr[k]; s2 += hr[k] * hr[k]; }
        }
        const float rs2 = 1.0f / sqrtf(wave_sum(s2) * (1.f / 1024.f) + 1e-6f);
#pragma unroll
        for (int j = 0; j < 4; ++j) {
            const int col = 4 * lane + 256 * j;
            float h[4];
#pragma unroll
            for (int k = 0; k < 4; ++k) h[k] = (v[4 * j + k] * rs2) * G2[j][k] + SH[j][k];
            u32x2 w; w.x = cvt_pk(h[0], h[1]); w.y = cvt_pk(h[2], h[3]);
            *(u32x2*)(a.H2 + row * 1024 + col) = w;
            hp[r][2 * j + 0] = (f32x2){__uint_as_float(w.x << 16), __uint_as_float(w.x & 0xffff0000u)}; hp[r][2 * j + 1] = (f32x2){__uint_as_float(w.y << 16), __uint_as_float(w.y & 0xffff0000u)};
        }
    }
}
template <int HI> __device__ __forceinline__ void pk_fma_bcast(f32x2& acc, const f32x2 w, const f32x2 h) {
    if (HI) asm("v_pk_fma_f32 %0, %1, %2, %0 op_sel:[0,1,0] op_sel_hi:[1,1,1]" : "+v"(acc) : "v"(w), "v"(h));
    else    asm("v_pk_fma_f32 %0, %1, %2, %0 op_sel:[0,0,0] op_sel_hi:[1,0,1]" : "+v"(acc) : "v"(w), "v"(h));
}
__device__ __forceinline__ void p6b_router(const LAS unsigned char* wtab, LAS float* wl  , const f32x2 (&hp)[P6B_NR][8], int lane) {
#pragma unroll 1
    for (int c = 0; c < 9; ++c) {
        f32x2 acc[P6B_NR][2];
#pragma unroll
        for (int r = 0; r < P6B_NR; ++r) { acc[r][0] = (f32x2){0.f, 0.f}; acc[r][1] = (f32x2){0.f, 0.f}; }
#pragma unroll
        for (int j = 0; j < 4; ++j)
#pragma unroll
            for (int k = 0; k < 4; ++k) {
                const f32x4 w4 = *(const LAS f32x4*)(wtab + (lane + 64 * (k + 4 * j)) * 144 + 16 * c);
                const f32x2 wa = {w4[0], w4[1]}, wb = {w4[2], w4[3]};
#pragma unroll
                for (int r = 0; r < P6B_NR; ++r) {
                    if (k & 1) { pk_fma_bcast<1>(acc[r][0], wa, hp[r][2 * j + (k >> 1)]); pk_fma_bcast<1>(acc[r][1], wb, hp[r][2 * j + (k >> 1)]); }
                    else       { pk_fma_bcast<0>(acc[r][0], wa, hp[r][2 * j + (k >> 1)]); pk_fma_bcast<0>(acc[r][1], wb, hp[r][2 * j + (k >> 1)]); }
                }
            }
        asm volatile("s_nop 1" : "+v"(acc[0][0]), "+v"(acc[0][1]), "+v"(acc[1][0]), "+v"(acc[1][1]), "+v"(acc[2][0]), "+v"(acc[2][1]), "+v"(acc[3][0]), "+v"(acc[3][1]));
        float v[16];
#pragma unroll
        for (int r = 0; r < P6B_NR; ++r) { v[4 * r + 0] = acc[r][0][0]; v[4 * r + 1] = acc[r][0][1]; v[4 * r + 2] = acc[r][1][0]; v[4 * r + 3] = acc[r][1][1]; }
        float s8[8], t4[4];
#pragma unroll
        for (int i = 0; i < 8; ++i) { auto q = __builtin_amdgcn_permlane32_swap(__float_as_uint(v[i]), __float_as_uint(v[i + 8]), false, false); s8[i] = __uint_as_float(q[0]) + __uint_as_float(q[1]); }
#pragma unroll
        for (int i = 0; i < 4; ++i) { auto q = __builtin_amdgcn_permlane16_swap(__float_as_uint(s8[i]), __float_as_uint(s8[i + 4]), false, false); t4[i] = __uint_as_float(q[0]) + __uint_as_float(q[1]); }
#pragma unroll
        for (int i = 0; i < 4; ++i) MK_DPP_ADD(t4[i], 0x128);
        float u0 = (lane & 8) ? t4[1] : t4[0], u1 = (lane & 8) ? t4[3] : t4[2];
        MK_DPP_ADD(u0, 0x141); MK_DPP_ADD(u1, 0x141);
        float w = (lane & 4) ? u1 : u0;
        MK_DPP_ADD(w, 0x1B);
        MK_DPP_ADD(w, 0xB1);
        if ((lane & 3) == 0) wl[(lane >> 4) * 36 + 4 * c + 2 * ((lane >> 2) & 1) + ((lane >> 3) & 1)] = w;
    }
    asm volatile("s_waitcnt lgkmcnt(0)" ::: "memory");
}
__device__ __forceinline__ void p6b_route(const P6bArgs& a, const LAS float* wl, int gw, int lane) {
    const int m0 = gw * P6B_NR;
    if (lane < P6B_NR) {
        const LAS float* lg = wl + lane * 36;
        float gm = lg[0] + a.b_group[0]; int gs = 0; float l1 = lg[1] + a.b_group[1], l2 = lg[2] + a.b_group[2], l3 = lg[3] + a.b_group[3];
        const float l0 = gm;
        if (l1 > gm) { gm = l1; gs = 1; } if (l2 > gm) { gm = l2; gs = 2; } if (l3 > gm) { gm = l3; gs = 3; }
        const float gtop = 1.0f / (expf(l0 - gm) + expf(l1 - gm) + expf(l2 - gm) + expf(l3 - gm));
        float el[8];
#pragma unroll
        for (int i = 0; i < 8; ++i) el[i] = lg[4 + gs * 8 + i] + a.b_expert[gs * 8 + i];
        float b1 = el[0]; int i1 = 0;
#pragma unroll
        for (int i = 1; i < 8; ++i) if (el[i] > b1) { b1 = el[i]; i1 = i; }
        float b2 = -INFINITY; int i2 = 0;
#pragma unroll
        for (int i = 0; i < 8; ++i) if (i != i1 && el[i] > b2) { b2 = el[i]; i2 = i; }
        const float p2 = expf(b2 - b1), den = 1.0f + p2;
        const float w0 = gtop / den, w1 = gtop * p2 / den;
        const int e0 = gs * 8 + i1, e1 = gs * 8 + i2;
        const unsigned tok = (unsigned)(m0 + lane);
        const unsigned pos0 = atomicAdd(a.cnt + 64 * e0, 1u), pos1 = atomicAdd(a.cnt + 64 * e1, 1u);
        a.LIST[(size_t)e0 * 16384 + pos0] = (u32x2){tok, __float_as_uint(w0)};
        a.LIST[(size_t)e1 * 16384 + pos1] = (u32x2){tok | 0x80000000u, __float_as_uint(w1)};
    }
}
__device__ __forceinline__ void p6b_rows(const P6bArgs& a, const LAS unsigned char* wtab, LAS float* wl, int gw0, int stride, int lane, bool dry) {
    constexpr int NG = T / P6B_NR;
    if (gw0 >= NG) return;
    P6bIn I; f32x2 hp[P6B_NR][8];
    p6b_load(I, a, gw0, lane);
#pragma unroll 1
    for (int gw = gw0; gw < NG; gw += stride) {
        p6b_norm(a, I, hp, gw, lane);
        if (gw + stride < NG) p6b_load(I, a, gw + stride, lane);
#ifdef P8_SKIP_ROUTER
        if (!dry)
#endif
        p6b_router(wtab, wl, hp, lane);
        if (!dry) p6b_route(a, wl, gw, lane);
    }
}
template <int ROLE> struct MoeSched {
    const u32x2* LIST; LAS int* tb; int G, c, NJ;
    unsigned* tilecnt;
    unsigned* tmo;
    int tlo, thi;
    __device__ __forceinline__ bool next(int i, pg8::Unit& u) const {
        if (c < 0) return false;
        const int L = i * G + c, TT = (thi < tb[32]) ? thi : tb[32];
        const int tg = tlo + L / NJ, j = L % NJ;
        if (tg >= TT) return false;
        int e = 0;
#pragma unroll 1
        for (int k = 1; k < 32; ++k) e += (tb[k] <= tg) ? 1 : 0;
        u.pm = tg; u.pn = e * NJ + j; return true;
    }
    __device__ __forceinline__ int arow(const pg8::Unit& u, int r) const {
        const int e = u.pn / NJ, idx = (u.pm - tb[e]) * 256 + r;
        return (idx < tb[33 + e]) ? (int)(LIST[(size_t)e * 16384 + idx].x & 0x7fffffffu) : 0;
    }
    __device__ __forceinline__ void a_ready(const pg8::Unit&) const {}
    __device__ __forceinline__ void done(const pg8::Unit& u) const {
        if (ROLE != 1) return;
        asm volatile("s_waitcnt vmcnt(0)" ::: "memory");
        if (mk_lane() == 0) __hip_atomic_fetch_add(tilecnt + 64 * u.pm, 1u, __ATOMIC_RELAXED, __HIP_MEMORY_SCOPE_AGENT);
    }
};
__device__ __forceinline__ void moe_wait(const MoeSched<2>& S) {
    if (mk_wave() == 0) {
        pg8::Unit u;
        for (int i = 0; S.next(i, u); ++i) {
            unsigned sp = 0;
            while ((unsigned)__builtin_amdgcn_readfirstlane(__hip_atomic_load(S.tilecnt + 64 * u.pm, __ATOMIC_RELAXED, __HIP_MEMORY_SCOPE_AGENT)) < 16u) {
                __builtin_amdgcn_s_sleep(2);
                if (++sp > (1u << 22)) { __hip_atomic_store(S.tmo, 1u, __ATOMIC_RELAXED, __HIP_MEMORY_SCOPE_AGENT); break; }
            }
        }
        __builtin_amdgcn_fence(__ATOMIC_ACQUIRE, "agent");
        asm volatile("s_waitcnt vmcnt(0)" ::: "memory");
    }
    __syncthreads();
}
__device__ __forceinline__ void moe_table(LAS int* tb, const unsigned* cnt, int tid) {
    __syncthreads();
    if (tid < 32) tb[33 + tid] = (int)__hip_atomic_load(cnt + 64 * tid, __ATOMIC_RELAXED, __HIP_MEMORY_SCOPE_AGENT);
    __syncthreads();
    if (tid == 0) { int s = 0; for (int e = 0; e < 32; ++e) { tb[e] = s; s += (tb[33 + e] + 255) >> 8; } tb[32] = s; }
    __syncthreads();
}
struct EpiGU {
    static constexpr bool PERM = true, AFTER_DRAIN = false;
    bf16_t* HID;
    __device__ __forceinline__ void operator()(const pg8::f32x4 (&acc)[2][2][4][2], const pg8::Unit& u, int wr, int wc, int fr, int fq) const {
        const int row0 = u.pm * 256 + wr * 64 + fr, hc0 = (u.pn & 1) * 128 + 16 * wc + 4 * fq;
#pragma unroll
        for (int ai = 0; ai < 2; ++ai)
#pragma unroll
            for (int m = 0; m < 4; ++m)
#pragma unroll
                for (int bj = 0; bj < 2; ++bj) {
                    const pg8::f32x4 g = acc[ai][bj][m][0], up = acc[ai][bj][m][1];
                    u32x2 w; w.x = cvt_pk(silu_f(g[0]) * up[0], silu_f(g[1]) * up[1]); w.y = cvt_pk(silu_f(g[2]) * up[2], silu_f(g[3]) * up[3]);
                    __hip_atomic_store((unsigned long long*)(HID + (size_t)(row0 + ai * 128 + m * 16) * 256 + hc0 + bj * 64), (unsigned long long)w.x | ((unsigned long long)w.y << 32), __ATOMIC_RELAXED, __HIP_MEMORY_SCOPE_AGENT);
                }
    }
};
struct EpiDown {
    static constexpr bool PERM = true, AFTER_DRAIN = false;
    bf16_t* Y; const u32x2* LIST; LAS int* tb;
    __device__ __forceinline__ void operator()(const pg8::f32x4 (&acc)[2][2][4][2], const pg8::Unit& u, int wr, int wc, int fr, int fq) const {
        const int e = u.pn >> 2, j = u.pn & 3, ti = u.pm - tb[e], cn = tb[33 + e];
        const int col0 = 256 * j + 32 * wc + 8 * fq;
        const int idx0 = ti * 256 + wr * 64 + fr;
#pragma unroll
        for (int ai = 0; ai < 2; ++ai) {
            u32x2 ent[4];
#pragma unroll
            for (int m = 0; m < 4; ++m) { const int idx = idx0 + ai * 128 + m * 16; ent[m] = (idx < cn) ? LIST[(size_t)e * 16384 + idx] : (u32x2){0xffffffffu, 0u}; }
#pragma unroll
            for (int m = 0; m < 4; ++m) {
                const u32x2 en = ent[m];
                if (en.x != 0xffffffffu) {
                    const float w = __uint_as_float(en.y);
                    bf16_t* dst = Y + ((size_t)(en.x >> 31) * T + (en.x & 0x7fffffffu)) * 1024 + col0;
#pragma unroll
                    for (int bj = 0; bj < 2; ++bj) {
                        const pg8::f32x4 v0 = acc[ai][bj][m][0] * w, v1 = acc[ai][bj][m][1] * w;
                        u32x4 o; o.x = cvt_pk(v0[0], v0[1]); o.y = cvt_pk(v0[2], v0[3]); o.z = cvt_pk(v1[0], v1[1]); o.w = cvt_pk(v1[2], v1[3]);
                        *(u32x4*)(dst + bj * 128) = o;
                    }
                }
            }
            asm volatile("" ::: "memory");
        }
    }
};
struct P8Row { u32x2 w0[4], w1[4], wm[4]; f32x4 xx[4]; };
__device__ __forceinline__ void p8_row_load(P8Row& R, const bf16_t* Y, const bf16_t* MIX, const float* x, int m, int lane) {
#pragma unroll
    for (int j = 0; j < 4; ++j) {
        R.w0[j] = *(const u32x2*)(Y + (size_t)m * 1024 + 4 * lane + 256 * j); R.w1[j] = *(const u32x2*)(Y + ((size_t)T + m) * 1024 + 4 * lane + 256 * j);
        R.wm[j] = *(const u32x2*)(MIX + (size_t)m * 1024 + 4 * lane + 256 * j);
    }
#pragma unroll
    for (int j = 0; j < 4; ++j) R.xx[j] = *(const f32x4*)(x + (size_t)m * 1024 + 4 * lane + 256 * j);
}
__device__ __forceinline__ void p8_rows(const bf16_t* Y, const bf16_t* MIX, const float* x, const float* g_post_mix, const float* g_post, const float* mod, float* out, int gw, int NGW, int lane) {
#pragma unroll 1
    for (int m0 = gw * 8; m0 < T; m0 += NGW * 8) {
        P8Row C, Rn;
        p8_row_load(C, Y, MIX, x, m0, lane);
        const float* md = mod + (m0 / S) * 6144;
        f32x4 GA[4], GB[4];
#pragma unroll
        for (int j = 0; j < 4; ++j) {
            const int col = 4 * lane + 256 * j;
            const f32x4 gpm = *(const f32x4*)(g_post_mix + col), g1 = *(const f32x4*)(md + 2 * 1024 + col), gp = *(const f32x4*)(g_post + col), gg = *(const f32x4*)(md + 5 * 1024 + col);
            GA[j] = g1 * gpm; GB[j] = gg * gp;
        }
#pragma unroll 1
        for (int i = 0; i < 8; ++i) {
            if (i + 1 < 8) p8_row_load(Rn, Y, MIX, x, m0 + i + 1, lane);
            const int m = m0 + i;
            float v[16], mx[16]; float s = 0.f, sm = 0.f;
#pragma unroll
            for (int j = 0; j < 4; ++j) {
                const u32x2 w0 = C.w0[j], w1 = C.w1[j], wm = C.wm[j];
                v[4 * j + 0] = __uint_as_float(w0.x << 16) + __uint_as_float(w1.x << 16); v[4 * j + 1] = __uint_as_float(w0.x & 0xffff0000u) + __uint_as_float(w1.x & 0xffff0000u);
                v[4 * j + 2] = __uint_as_float(w0.y << 16) + __uint_as_float(w1.y << 16); v[4 * j + 3] = __uint_as_float(w0.y & 0xffff0000u) + __uint_as_float(w1.y & 0xffff0000u);
                mx[4 * j + 0] = __uint_as_float(wm.x << 16); mx[4 * j + 1] = __uint_as_float(wm.x & 0xffff0000u); mx[4 * j + 2] = __uint_as_float(wm.y << 16); mx[4 * j + 3] = __uint_as_float(wm.y & 0xffff0000u);
#pragma unroll
                for (int k = 0; k < 4; ++k) { s += v[4 * j + k] * v[4 * j + k]; sm += mx[4 * j + k] * mx[4 * j + k]; }
            }
            const float rs = 1.0f / sqrtf(wave_sum(s) * (1.f / 1024.f) + 1e-6f), rsm = 1.0f / sqrtf(wave_sum(sm) * (1.f / 1024.f) + 1e-6f);
#pragma unroll
            for (int j = 0; j < 4; ++j) {
                const f32x4 xx = C.xx[j];
                f32x4 o;
#pragma unroll
                for (int k = 0; k < 4; ++k) { const float hr = xx[k] + GA[j][k] * (mx[4 * j + k] * rsm); o[k] = hr + GB[j][k] * (v[4 * j + k] * rs); }
                *(f32x4*)(out + (size_t)m * 1024 + 4 * lane + 256 * j) = o;
            }
            if (i + 1 < 8) C = Rn;
        }
    }
}
constexpr size_t SC_BSTRIDE = (size_t)4096 * 64 * 65 / 2;
constexpr int SC_CHUNK = 8;
constexpr int SC_NUNITS = 4 * (1 * 8 + 2 * 8 + 3 * 8 + 4 * 8 + 5 * 8 + 6 * 8 + 7 * 8 + 8 * 8);
__device__ __forceinline__ size_t sc_off(int b, int qb) { return (size_t)b * SC_BSTRIDE + (size_t)4096 * (qb * (qb + 1) / 2); }
__device__ __forceinline__ void sc_build_units(unsigned* tab) {
    int n = 0;
    for (int pass = 0; pass < 2; ++pass)
        for (int sz = SC_CHUNK; sz >= 1; --sz)
            for (int b = 0; b < 4; ++b)
                for (int qb = 0; qb < 64; ++qb) {
                    const int nt = qb + 1, nc = (nt + SC_CHUNK - 1) / SC_CHUNK;
                    for (int c = 0; c < nc; ++c) {
                        const int t0 = c * SC_CHUNK, cnt = (nt - t0 < SC_CHUNK) ? nt - t0 : SC_CHUNK;
                        const bool full = (cnt == SC_CHUNK);
                        if ((pass == 0 && full && sz == SC_CHUNK) || (pass == 1 && !full && cnt == sz)) tab[n++] = (unsigned)b | ((unsigned)qb << 2) | ((unsigned)c << 8) | ((unsigned)cnt << 12);
                    }
                }
}
__device__ __forceinline__ unsigned key16_of(float sc) { sc += 0.0f; const unsigned u = __float_as_uint(sc); return ((u & 0x80000000u) ? ~u : (u | 0x80000000u)) >> 16; }
__device__ __forceinline__ void sc_decode(unsigned u, int& b, int& qb, int& c, int& nt) {
    b = u & 3; const int v = u >> 2;
    if (v < 232) { c = 0; int base = 0; while (v >= base + (57 - 8 * c)) { base += 57 - 8 * c; ++c; } qb = 8 * c + 7 + (v - base); nt = 8; }
    else { const int p = v - 232, size = 7 - (p >> 3); c = p & 7; qb = 8 * c + size - 1; nt = size; }
}
struct ScStage { u32x4 v[8]; };
__device__ __forceinline__ void sc_stage_load(ScStage& st, const bf16_t* KI, int b, int c, int nt, int tid) {
    const bf16_t* kbase = KI + ((size_t)b * S + (size_t)c * SC_CHUNK * 64 + (tid >> 3)) * 64 + (tid & 7) * 8;
#pragma unroll
    for (int t = 0; t < 8; ++t) if (t < nt) st.v[t] = *(const u32x4*)(kbase + (size_t)t * 64 * 64);
}
__device__ __forceinline__ void sc_stage_store(const ScStage& st, LAS unsigned char* buf, int nt, int tid) {
    const int skey = tid >> 3, sch = tid & 7;
    const unsigned st_off = (unsigned)(skey * 128 + ((sch ^ (skey & 7)) * 16));
#pragma unroll
    for (int t = 0; t < 8; ++t) if (t < nt) *(LAS u32x4*)(buf + t * 8192 + st_off) = st.v[t];
}
__device__ __forceinline__ void sc_compute(const LAS unsigned char* buf, const bf16_t* QI, const float* WI, unsigned short* SC, int b, int qb, int c, int ntile, int tid) {
    const int lane = tid & 63, w = __builtin_amdgcn_readfirstlane(tid >> 6), hh = lane >> 5, n32 = lane & 31;
    const int L = 64 * (qb + 1);
    const size_t tokq0 = (size_t)b * S + 64 * qb + 8 * w;
    bf16x8 af[2][4]; float wv[2][2][8];
    {
        const int u = 2 * ((n32 >> 2) & 1) + (n32 >> 4), h = (n32 & 3) + 4 * ((n32 >> 3) & 1);
#pragma unroll
        for (int mt = 0; mt < 2; ++mt) {
            const bf16_t* qp = QI + (tokq0 + 4 * mt + u) * 512 + h * 64 + 8 * hh;
#pragma unroll
            for (int ks = 0; ks < 4; ++ks) af[mt][ks] = *(const bf16x8*)(qp + 16 * ks);
#pragma unroll
            for (int j = 0; j < 2; ++j) {
                const float* wp = WI + (tokq0 + 4 * mt + 2 * hh + j) * 8;
                const f32x4 w0 = *(const f32x4*)wp, w1 = *(const f32x4*)(wp + 4);
                wv[mt][j][0] = w0[0]; wv[mt][j][1] = w0[1]; wv[mt][j][2] = w0[2]; wv[mt][j][3] = w0[3]; wv[mt][j][4] = w1[0]; wv[mt][j][5] = w1[1]; wv[mt][j][6] = w1[2]; wv[mt][j][7] = w1[3];
            }
        }
    }
    unsigned short* srow = SC + sc_off(b, qb) + (size_t)(8 * w) * L;
#pragma unroll 1
    for (int t = 0; t < ntile; ++t) {
        const LAS unsigned char* tb_ = buf + t * 8192;
        const int s0 = (c * SC_CHUNK + t) * 64;
#pragma unroll
        for (int nt = 0; nt < 2; ++nt) {
            bf16x8 bfr[4];
            const int key = 32 * nt + n32;
#pragma unroll
            for (int ks = 0; ks < 4; ++ks) bfr[ks] = *(const LAS bf16x8*)(tb_ + key * 128 + (((2 * ks + hh) ^ (key & 7)) * 16));
#pragma unroll
            for (int mt = 0; mt < 2; ++mt) {
                f32x16 acc = (f32x16){};
#pragma unroll
                for (int ks = 0; ks < 4; ++ks) acc = __builtin_amdgcn_mfma_f32_32x32x16_bf16(af[mt][ks], bfr[ks], acc, 0, 0, 0);
#pragma unroll
                for (int j = 0; j < 2; ++j) {
                    float sc = 0.f;
#pragma unroll
                    for (int h = 0; h < 8; ++h) { const int xi = (int)__float_as_uint(acc[8 * j + h]); sc = __builtin_fmaf(wv[mt][j][h], __uint_as_float((unsigned)(xi > 0 ? xi : 0)), sc); }
                    asm volatile("" : "+v"(sc));
                    srow[(size_t)(4 * mt + 2 * hh + j) * L + s0 + key] = (unsigned short)key16_of(sc);
                }
            }
        }
    }
}
__device__ __forceinline__ void sc_phase(LAS unsigned char* lds, volatile LAS unsigned* qslot, unsigned* qhead, const bf16_t* QI, const bf16_t* KI, const float* WI, unsigned short* SC, int tid) {
    __syncthreads();
    if (tid == 0) qslot[0] = atomicAdd(qhead, 1u);
    __syncthreads();
    unsigned ucur = qslot[0];
    if (ucur >= (unsigned)SC_NUNITS) return;
    int b, qb, c, nt; sc_decode(ucur, b, qb, c, nt);
    ScStage st;
    sc_stage_load(st, KI, b, c, nt, tid);
    sc_stage_store(st, lds, nt, tid);
    int p = 0;
    for (;;) {
        __syncthreads();
        if (tid == 0) qslot[0] = atomicAdd(qhead, 1u);
        __syncthreads();
        const unsigned unext = qslot[0];
        const bool has = unext < (unsigned)SC_NUNITS;
        int b2 = 0, qb2 = 0, c2 = 0, nt2 = 0;
        if (has) { sc_decode(unext, b2, qb2, c2, nt2); sc_stage_load(st, KI, b2, c2, nt2, tid); }
        sc_compute(lds + p * 65536, QI, WI, SC, b, qb, c, nt, tid);
        if (!has) break;
        sc_stage_store(st, lds + (p ^ 1) * 65536, nt2, tid);
        b = b2; qb = qb2; c = c2; nt = nt2; p ^= 1;
    }
}
__device__ __forceinline__ unsigned wave_sum_u32(unsigned x) {
    x += (unsigned)__builtin_amdgcn_update_dpp(0, (int)x, 0xB1, 0xf, 0xf, false);
    x += (unsigned)__builtin_amdgcn_update_dpp(0, (int)x, 0x4E, 0xf, 0xf, false);
    x += (unsigned)__builtin_amdgcn_update_dpp(0, (int)x, 0x141, 0xf, 0xf, false);
    x += (unsigned)__builtin_amdgcn_update_dpp(0, (int)x, 0x140, 0xf, 0xf, false);
    return (unsigned)__builtin_amdgcn_readlane((int)x, 0) + (unsigned)__builtin_amdgcn_readlane((int)x, 16) + (unsigned)__builtin_amdgcn_readlane((int)x, 32) + (unsigned)__builtin_amdgcn_readlane((int)x, 48);
}
__device__ __forceinline__ unsigned pk_subsat(unsigned w, unsigned c) { unsigned d; asm("v_pk_sub_u16 %0, %1, %2 clamp" : "=v"(d) : "v"(w), "v"(c)); return d; }
__device__ __forceinline__ unsigned pk_min(unsigned a, unsigned b) { unsigned d; asm("v_pk_min_u16 %0, %1, %2" : "=v"(d) : "v"(a), "v"(b)); return d; }
__device__ __forceinline__ unsigned pk_add(unsigned a, unsigned b) { unsigned d; asm("v_pk_add_u16 %0, %1, %2" : "=v"(d) : "v"(a), "v"(b)); return d; }
template <int NW> __device__ __forceinline__ unsigned cnt_ge(const unsigned (&kw)[32], unsigned cm1) {
    const unsigned one = 0x00010001u;
    unsigned a0 = 0u, a1 = 0u, a2 = 0u, a3 = 0u;
#pragma unroll
    for (int j = 0; j < NW; j += 4) {
        a0 = pk_add(a0, pk_min(pk_subsat(kw[j], cm1), one)); a1 = pk_add(a1, pk_min(pk_subsat(kw[j + 1], cm1), one));
        a2 = pk_add(a2, pk_min(pk_subsat(kw[j + 2], cm1), one)); a3 = pk_add(a3, pk_min(pk_subsat(kw[j + 3], cm1), one));
    }
    const unsigned a = pk_add(pk_add(a0, a1), pk_add(a2, a3));
    return wave_sum_u32((a & 0xffffu) + (a >> 16));
}
__device__ __forceinline__ unsigned pk_max(unsigned a, unsigned b) { unsigned d; asm("v_pk_max_u16 %0, %1, %2" : "=v"(d) : "v"(a), "v"(b)); return d; }
__device__ __forceinline__ unsigned wave_max_u32(unsigned x) {
    x = max(x, (unsigned)__builtin_amdgcn_update_dpp(0, (int)x, 0xB1, 0xf, 0xf, false));
    x = max(x, (unsigned)__builtin_amdgcn_update_dpp(0, (int)x, 0x4E, 0xf, 0xf, false));
    x = max(x, (unsigned)__builtin_amdgcn_update_dpp(0, (int)x, 0x141, 0xf, 0xf, false));
    x = max(x, (unsigned)__builtin_amdgcn_update_dpp(0, (int)x, 0x140, 0xf, 0xf, false));
    return max(max((unsigned)__builtin_amdgcn_readlane((int)x, 0), (unsigned)__builtin_amdgcn_readlane((int)x, 16)), max((unsigned)__builtin_amdgcn_readlane((int)x, 32), (unsigned)__builtin_amdgcn_readlane((int)x, 48)));
}
template <int NW> __device__ __forceinline__ unsigned sel_query(const unsigned (&kw)[32], int lane) {
    unsigned mx = 0u;
#pragma unroll
    for (int j = 0; j < NW; ++j) mx = pk_max(mx, kw[j]);
    unsigned hi = wave_max_u32(max(mx & 0xffffu, mx >> 16)) + 1u;
    unsigned width = 384u, lo = (hi > width) ? hi - width : 1u;
#pragma unroll 1
    while (cnt_ge<NW>(kw, (lo - 1u) * 0x00010001u) < 256u) { hi = lo; width *= 8u; lo = (hi > width) ? hi - width : 1u; }
#pragma unroll 1
    while (hi - lo > 1u) {
        const unsigned mid = (lo + hi) >> 1;
        if (cnt_ge<NW>(kw, (mid - 1u) * 0x00010001u) >= 256u) lo = mid; else hi = mid;
    }
    const unsigned T = lo;
    const unsigned need = 256u - cnt_ge<NW>(kw, T * 0x00010001u);
    unsigned run = 0u, cidx = 0xffffu; bool found = false;
#pragma unroll
    for (int j = 0; j < NW; ++j) {
        if (!found) {
            const bool e0 = (kw[j] & 0xffffu) == T, e1 = (kw[j] >> 16) == T;
            const unsigned long long m0 = __ballot(e0), m1 = __ballot(e1);
            const unsigned cm = (unsigned)__builtin_popcountll(m0) + (unsigned)__builtin_popcountll(m1);
            if (run + cm >= need) {
                const unsigned rank = __builtin_amdgcn_mbcnt_hi((unsigned)(m0 >> 32), __builtin_amdgcn_mbcnt_lo((unsigned)m0, 0u)) + __builtin_amdgcn_mbcnt_hi((unsigned)(m1 >> 32), __builtin_amdgcn_mbcnt_lo((unsigned)m1, 0u));
                const unsigned tg = need - run - 1u;
                const unsigned long long h0 = __ballot(e0 && rank == tg), h1 = __ballot(e1 && rank + (e0 ? 1u : 0u) == tg);
                cidx = (unsigned)(128 * j) + (h0 ? 2u * (unsigned)__builtin_ctzll(h0) : 2u * (unsigned)__builtin_ctzll(h1) + 1u);
                found = true;
            }
            run += cm;
        }
    }
    return T | (cidx << 16);
}
template <int NW> __device__ __forceinline__ unsigned sel_row(const unsigned* row32, int n, int lane) {
    unsigned kw[32];
#pragma unroll
    for (int j = 0; j < 32; ++j) {
        unsigned v = 0u;
        if (j < NW) { const int s = 128 * j + 2 * lane; v = (s < n) ? row32[64 * j + lane] : 0u; if (s + 1 >= n) v &= 0xffffu; }
        kw[j] = v;
    }
    return sel_query<NW>(kw, lane);
}
__device__ __forceinline__ void sel_block(LAS unsigned char* lds, const unsigned short* SC, unsigned* THR, unsigned* MASKT, int blk, int tid, int mode = 3) {
    const int b = blk >> 6, qb = blk & 63, lane = tid & 63, w = __builtin_amdgcn_readfirstlane(tid >> 6);
    const int L = 64 * (qb + 1);
    const unsigned short* slab = SC + sc_off(b, qb);
    LAS unsigned* thr_l = (LAS unsigned*)lds;
    __syncthreads();
    if (mode & 1)
#pragma unroll 1
    for (int qi = 0; qi < 8; ++qi) {
        const int ql = 8 * w + qi, tq = 64 * qb + ql, n = tq + 1;
        const unsigned short* row = slab + (size_t)ql * L;
        const int nw = (n + 127) >> 7;
        const unsigned* row32 = (const unsigned*)row;
        unsigned th = 0u;
        if (n > 256) { if (nw <= 8) th = sel_row<8>(row32, n, lane); else if (nw <= 16) th = sel_row<16>(row32, n, lane); else if (nw <= 24) th = sel_row<24>(row32, n, lane); else th = sel_row<32>(row32, n, lane); }
        if (lane == 0) { thr_l[ql] = th; THR[(size_t)b * S + tq] = th; }
    }
    __syncthreads();
    const int ntl = 4 * ((2 * qb) >> 3) + 4;
    if (mode & 2)
    for (int it = w; it < 2 * ntl; it += NWAVES) {
        const int g = it / ntl, t = it - g * ntl, qg = 2 * qb + g;
        unsigned W = 0u;
        if (t <= qb) {
            const int ii = lane & 15, cc = (lane >> 4) & 1, hh = lane >> 5;
            const int s = 64 * t + 32 * cc + (ii & 3) + 8 * (ii >> 2) + 4 * hh;
            unsigned kk[32];
#pragma unroll
            for (int q = 0; q < 32; ++q) kk[q] = (unsigned)slab[(size_t)(32 * g + q) * L + s];
#pragma unroll
            for (int q = 0; q < 32; ++q) {
                const int ql = 32 * g + q, tq = 64 * qb + ql;
                const unsigned th = thr_l[ql], T = th & 0xffffu, cidx = th >> 16;
                const unsigned k = kk[q];
                const bool p = (s <= tq) && (k > T || (k == T && (unsigned)s <= cidx));
                const unsigned long long m = __ballot(p);
                W = (lane == q) ? (unsigned)m : ((lane == 32 + q) ? (unsigned)(m >> 32) : W);
            }
        }
        MASKT[(((size_t)b * 128 + qg) * 64 + t) * 64 + lane] = W;
    }
}

__device__ __forceinline__ void sel_queries_balanced(const unsigned short* SC, unsigned* THR, int gw, int lane) {
#pragma unroll 1
    for (int k = 0; k < 8; ++k) {
        const int b = k >> 1, tq = (k & 1) ? (S - 1 - gw) : gw, n = tq + 1, qb = tq >> 6, L = 64 * (qb + 1);
        const unsigned* row32 = (const unsigned*)(SC + sc_off(b, qb) + (size_t)(tq & 63) * L);
        const int nw = (n + 127) >> 7;
        unsigned th = 0u;
        if (n > 256) { if (nw <= 8) th = sel_row<8>(row32, n, lane); else if (nw <= 16) th = sel_row<16>(row32, n, lane); else if (nw <= 24) th = sel_row<24>(row32, n, lane); else th = sel_row<32>(row32, n, lane); }
        if (lane == 0) THR[(size_t)b * S + tq] = th;
    }
}
constexpr int MSK_PER_B = 4352, MSK_UNITS = 4 * MSK_PER_B;
struct MskUnit { int b, qg, t; unsigned thv; unsigned kk[32]; };
__device__ __forceinline__ void mask_unit_load(MskUnit& m, const unsigned short* SC, const unsigned* THR, int u, int lane) {
    m.b = u / MSK_PER_B; const int v = u - m.b * MSK_PER_B;
    int g8 = 0;
#pragma unroll 1
    for (int j = 1; j < 16; ++j) g8 += (16 * j * (j + 1) <= v) ? 1 : 0;
    const int rem = v - 16 * g8 * (g8 + 1), per = 4 * g8 + 4, q7 = rem / per;
    m.t = rem - q7 * per; m.qg = 8 * g8 + q7;
    const int qb = m.qg >> 1, g = m.qg & 1;
    if (m.t <= qb) {
        const int L = 64 * (qb + 1);
        const unsigned short* slab = SC + sc_off(m.b, qb);
        const int ii = lane & 15, cc = (lane >> 4) & 1, hh = lane >> 5;
        const int s = 64 * m.t + 32 * cc + (ii & 3) + 8 * (ii >> 2) + 4 * hh;
        m.thv = THR[(size_t)m.b * S + 32 * m.qg + (lane & 31)];
#pragma unroll
        for (int q = 0; q < 32; ++q) m.kk[q] = (unsigned)slab[(size_t)(32 * g + q) * L + s];
    }
}
__device__ __forceinline__ void mask_unit_emit(const MskUnit& m, unsigned* MASKT, int lane) {
    const int qb = m.qg >> 1;
    unsigned W = 0u;
    if (m.t <= qb) {
        const int ii = lane & 15, cc = (lane >> 4) & 1, hh = lane >> 5;
        const int s = 64 * m.t + 32 * cc + (ii & 3) + 8 * (ii >> 2) + 4 * hh;
#pragma unroll
        for (int q = 0; q < 32; ++q) {
            const int tq = 32 * m.qg + q;
            const unsigned th = (unsigned)__builtin_amdgcn_readlane((int)m.thv, q), T = th & 0xffffu, cidx = th >> 16;
            const unsigned k = m.kk[q];
            const bool p = (s <= tq) && (k > T || (k == T && (unsigned)s <= cidx));
            const unsigned long long mm = __ballot(p);
            W = (lane == q) ? (unsigned)mm : ((lane == 32 + q) ? (unsigned)(mm >> 32) : W);
        }
    }
    MASKT[(((size_t)m.b * 128 + m.qg) * 64 + m.t) * 64 + lane] = W;
}
__device__ __forceinline__ void mask_units(const unsigned short* SC, const unsigned* THR, unsigned* MASKT, int u0, int stride, int lane) {
    if (u0 >= MSK_UNITS) return;
    MskUnit a, bnext;
    mask_unit_load(a, SC, THR, u0, lane);
#pragma unroll 1
    for (int u = u0; u < MSK_UNITS; u += stride) {
        const bool has = u + stride < MSK_UNITS;
        if (has) mask_unit_load(bnext, SC, THR, u + stride, lane);
        mask_unit_emit(a, MASKT, lane);
        if (has) a = bnext;
    }
}
struct Args { const void* in[18]; float* out; unsigned char* ws; int ph_lo, ph_hi, li, pad; };
constexpr int N_PHASES = 12;
__global__ void __launch_bounds__(NTHR, 2) mega(Args args) {
    extern __shared__ __attribute__((aligned(16))) unsigned char lds_raw[];
    LAS unsigned char* lds = (LAS unsigned char*)lds_raw;
    const int G = gridDim.x, bid = blockIdx.x;
#define MK_IDS() const int wave = mk_wave(), lane = mk_lane(), tid = wave * 64 + lane; (void)lane; (void)tid; (void)wave
    unsigned char* ws = args.ws;
    unsigned* ctl = (unsigned*)(ws + WS_CTL);
    volatile LAS unsigned* MISC = (volatile LAS unsigned*)(lds + MISC_OFF);
    { const int t0 = (int)threadIdx.x;
      for (int u = t0; u < (LDS_BYTES - RING_BYTES) / 4; u += NTHR) ((LAS unsigned*)(lds + RING_BYTES))[u] = 0u;
      __syncthreads();
      if ((t0 & 63) == 0) ((LAS unsigned char*)(lds + MK_SLOTMAP_OFF))[mk_hwslot()] = (unsigned char)(t0 >> 6); }
    __syncthreads();
    XcdBarrier bar = xcd_barrier_post(ctl + CW_BAR + args.li * XCD_BAR_WORDS, MISC + 8);
    const int lo = args.ph_lo, hi = args.ph_hi;
#ifndef DUP_MASK
#define DUP_MASK 0
#endif
#define REP(k) for (int rep_ = 0; rep_ < (((DUP_MASK) >> (k)) & 1) + 1; ++rep_)
#define IN(k) (lo <= (k) && (k) < hi)
#define BOTH(k) (IN(k) && IN((k) + 1))
    const float* x = (const float*)args.in[0];
    float* mod = (float*)(ws + WS_MOD);
    bf16_t* Hb = (bf16_t*)(ws + WS_H);
    bf16_t* WIN = (bf16_t*)(ws + WS_WIN);
    bf16_t* WOUT = (bf16_t*)(ws + WS_WOUT);
    float* R128 = (float*)(ws + WS_R128);
    float* R64 = (float*)(ws + WS_R64);
    bf16_t* WGU = (bf16_t*)args.out; bf16_t* WD = WGU + (size_t)32 * 512 * 1024;

    const P0Args p0a{(const float*)args.in[1], (const float*)args.in[4], (const float*)args.in[5], (const float*)args.in[6], (const float*)args.in[7], (const float*)args.in[14], (const float*)args.in[15], (const float*)args.in[16],
                 (const int*)args.in[2], mod, R128, R64, WIN, WOUT, WGU, WD};
    if (IN(0)) {
        MK_IDS();
        REP(0) p0_prologue(lds, p0a, bid, G, tid);
        if (BOTH(0)) xcd_barrier(bar);
    }
    if (IN(1)) {
        MK_IDS();
        REP(1) p1_rows(x, (const float*)args.in[3], mod, Hb, bid * NWAVES + wave, G * NWAVES, lane);
        if ((DUP_MASK >> 15) & 1) { for (int k = 0; k < 10; ++k) xcd_barrier(bar); }
        if (BOTH(1)) xcd_barrier(bar);
    }
    if (IN(2)) {
        MK_IDS();
#ifdef PROBE_SKIP_TILE8
        struct Skip8 : pg8::StaticOrder { __device__ bool next(int i, pg8::Unit& u) const { if (!pg8::StaticOrder::next(i, u)) return false; if (u.pn >= 8) ++u.pn; return true; } };
        pg8::Gemm g{Hb, WIN, T, NPHYS, 1024}; Skip8 So; So.init(T, NPHYS - 256, G, bid);
#define PG8_P2_SCHED Skip8
#else
        pg8::Gemm g{Hb, WIN, T, NPHYS, 1024}; pg8::StaticOrder So; So.init(T, NPHYS, G, bid);
#define PG8_P2_SCHED pg8::StaticOrder
#endif
        EpiInProj E{(bf16_t*)(ws + WS_QA), (bf16_t*)(ws + WS_KA), (bf16_t*)(ws + WS_VA), (bf16_t*)(ws + WS_QI), (bf16_t*)(ws + WS_KI), (bf16_t*)(ws + WS_QR), (bf16_t*)(ws + WS_KR),
                    (bf16_t*)(ws + WS_VR), (bf16_t*)(ws + WS_GR), (float*)(ws + WS_WI), R64, R128};
        pg8::gemm_phase<EpiInProj, PG8_P2_SCHED, true, true>(lds, g, So, E);
        if ((DUP_MASK >> 2) & 1) { __syncthreads(); pg8::gemm_phase<EpiInProj, PG8_P2_SCHED, true, true>(lds, g, So, E); }
        if (args.li != 0) {   }
        else if (G == 256) { if (bid >= 64) { __syncthreads(); p0_expert_items(lds, p0a, (bid - 64) * NWAVES + wave, 192 * NWAVES, tid); } }
        else { __syncthreads(); p0_expert_items(lds, p0a, bid * NWAVES + wave, G * NWAVES, tid); }
        if (BOTH(2)) xcd_barrier(bar);
    }
    bf16_t* QR = (bf16_t*)(ws + WS_QR); bf16_t* KR = (bf16_t*)(ws + WS_KR); bf16_t* VR = (bf16_t*)(ws + WS_VR); bf16_t* GR = (bf16_t*)(ws + WS_GR);
    const bf16_t* QI = (const bf16_t*)(ws + WS_QI); const bf16_t* KI = (const bf16_t*)(ws + WS_KI); const float* WI = (const float*)(ws + WS_WI);
    unsigned short* SCORES = (unsigned short*)(ws + WS_SCORES); unsigned* THR = (unsigned*)(ws + WS_THR); unsigned* MASKT = (unsigned*)(ws + WS_MASKT);
    float* KVS = (float*)(ws + WS_KVS); bf16_t* RT = WD + (size_t)32 * 1024 * 256;
    bf16_t* MIXED = (bf16_t*)(ws + WS_MIXED);
    if (IN(3)) {
        MK_IDS();
        REP(3) {
        for (int p = bid; p < 256; p += G) ret_kv_pair(lds, KR, VR, KVS, p, tid);
        sc_phase(lds, MISC + 16, ctl + CW_Q + 64 * rep_, QI, KI, WI, SCORES, tid);
        }
        if (BOTH(3)) xcd_barrier(bar);
    }
    if (IN(4)) {
        MK_IDS();
        ret_scan(KVS, RT, bid * NTHR + tid, G * NTHR);
        for (int gw = bid * NWAVES + wave; gw < 2048; gw += G * NWAVES) sel_queries_balanced(SCORES, THR, gw, lane);
        if ((DUP_MASK >> 12) & 1) for (int gw = bid * NWAVES + wave; gw < 2048; gw += G * NWAVES) sel_queries_balanced(SCORES, THR, gw, lane);
        if (BOTH(4)) xcd_barrier(bar);
    }
    if (IN(5)) {
        MK_IDS();
        mask_units(SCORES, THR, MASKT, bid * NWAVES + wave, G * NWAVES, lane);
        if ((DUP_MASK >> 13) & 1) mask_units(SCORES, THR, MASKT, bid * NWAVES + wave, G * NWAVES, lane);
        if (BOTH(5)) xcd_barrier(bar);
    }
    if (IN(6)) {
        MK_IDS();
        {
        for (int p = bid; p < 256; p += G) ret_out_pair(lds, QR, KR, VR, GR, RT, MIXED, p, tid);
        if ((DUP_MASK >> 14) & 1) for (int p = bid; p < 256; p += G) ret_out_pair(lds, QR, KR, VR, GR, RT, MIXED, p, tid);
        asm volatile("s_waitcnt vmcnt(0) lgkmcnt(0)" ::: "memory");
        __syncthreads();
        {
            const attn_body::AttnTensors AT{(const attn_body::bf16*)(ws + WS_QA), (const attn_body::bf16*)(ws + WS_KA), (const attn_body::bf16*)(ws + WS_VA), (attn_body::bf16*)MIXED, (const unsigned*)MASKT};
            const attn_body::StaticOrder So((int)G, (int)bid);
            attn_body::attn_phase<attn_body::StaticOrder>((char*)lds_raw, AT, So);
        }
        __syncthreads();
        }
        if ((DUP_MASK >> 5) & 1) {
        for (int p = bid; p < 256; p += G) ret_out_pair(lds, QR, KR, VR, GR, RT, MIXED, p, tid);
        asm volatile("s_waitcnt vmcnt(0) lgkmcnt(0)" ::: "memory");
        __syncthreads();
        {
            const attn_body::AttnTensors AT{(const attn_body::bf16*)(ws + WS_QA), (const attn_body::bf16*)(ws + WS_KA), (const attn_body::bf16*)(ws + WS_VA), (attn_body::bf16*)MIXED, (const unsigned*)MASKT};
            const attn_body::StaticOrder So((int)G, (int)bid);
            attn_body::attn_phase<attn_body::StaticOrder>((char*)lds_raw, AT, So);
        }
        __syncthreads();
        }
        if (BOTH(6)) xcd_barrier(bar);
    }
    bf16_t* MIX = (bf16_t*)(ws + WS_MIX); bf16_t* H2 = (bf16_t*)(ws + WS_H2); u32x2* LIST = (u32x2*)(ws + WS_LIST); bf16_t* HID = (bf16_t*)(ws + WS_HID);
    bf16_t* Y = (bf16_t*)(ws + WS_Y); float* HRES = (float*)(ws + WS_HRES);
    LAS int* tb = (LAS int*)(lds + TB_OFF);
    if (IN(7)) {
        MK_IDS();
        pg8::Gemm g{MIXED, WOUT, T, 1024, 1024}; pg8::StaticOrder So; So.init(T, 1024, G, bid);
        EpiStore E{MIX, 1024};
        pg8::gemm_phase<EpiStore, pg8::StaticOrder, true, true>(lds, g, So, E);
        if ((DUP_MASK >> 6) & 1) { __syncthreads(); pg8::gemm_phase<EpiStore, pg8::StaticOrder, true, true>(lds, g, So, E); }
        if (BOTH(7)) xcd_barrier(bar);
    }
    if (IN(8)) {
        MK_IDS();
        P6bArgs a{MIX, x, (const float*)args.in[8], (const float*)args.in[9], mod, (const float*)args.in[10], (const float*)args.in[11], (const float*)args.in[12], (const float*)args.in[13], HRES, H2, ctl + CW_CNT, LIST};
        p6b_load_weights(lds, a.w_group, a.w_expert, tid);
        REP(8) p6b_rows(a, lds, (LAS float*)(lds + RT_WL_OFF + wave * 576), bid * NWAVES + wave, G * NWAVES, lane, rep_ != 0);
        if (BOTH(8)) xcd_barrier(bar);
    }
    if (IN(9)) {
        MK_IDS();
        moe_table(tb, ctl + CW_CNT, tid);
        pg8::Gemm g{H2, WGU, T, 32 * 512, 1024}; MoeSched<1> So{LIST, tb, G, bid, 2, ctl + CW_TILE, ctl + CW_TMO, 0, 1 << 20};
        EpiGU E{HID};
        pg8::gemm_phase_ga<EpiGU, MoeSched<1>>(lds, g, So, E);
        if ((DUP_MASK >> 8) & 1) { __syncthreads(); pg8::gemm_phase_ga<EpiGU, MoeSched<1>>(lds, g, So, E); }
        __syncthreads();
    }
    if (IN(10)) {
        MK_IDS();
        moe_table(tb, ctl + CW_CNT, tid);
        const int n2 = (tb[32] * 2 > G && tb[32] * 2 < 2 * G) ? tb[32] * 2 - G : 0;
        const int t1 = G / 2;
        pg8::Gemm g{HID, WD, T, 32 * 1024, 256};
        EpiDown E{Y, LIST, tb};
        { MoeSched<2> So{LIST, tb, G - n2, bid - n2, 4, ctl + CW_TILE, ctl + CW_TMO, 0, t1}; moe_wait(So); pg8::gemm_phase<EpiDown, MoeSched<2>, true, true>(lds, g, So, E); }
        { MoeSched<2> So{LIST, tb, G - n2, bid - n2, 4, ctl + CW_TILE, ctl + CW_TMO, t1, 1 << 20}; moe_wait(So); pg8::gemm_phase<EpiDown, MoeSched<2>, true, true>(lds, g, So, E); }
        if (BOTH(10)) xcd_barrier(bar);
    }
    if (IN(11)) {
        MK_IDS();
        REP(11) p8_rows(Y, MIX, x, (const float*)args.in[8], (const float*)args.in[17], mod, args.out, bid * NWAVES + wave, G * NWAVES, lane);
    }
#undef IN
#undef BOTH
}
}
extern "C" void kernel_launch(void* const* d_in, const int* in_sizes, int n_in, void* d_out, int out_size, void* d_ws, size_t ws_size, hipStream_t stream) {
    using namespace mk;
    static int grid = 0;
    if (grid == 0) {
        int dev = 0, cus = 0, per_cu = 0;
        if (n_in != 18 || out_size != T * D || ws_size < (size_t)256 * MiB) { fprintf(stderr, "kernel_launch: unexpected problem shape (n_in %d, out %d, ws %zu)\n", n_in, out_size, ws_size); grid = -1; return; }
        if (hipGetDevice(&dev) != hipSuccess || hipDeviceGetAttribute(&cus, hipDeviceAttributeMultiprocessorCount, dev) != hipSuccess) { fprintf(stderr, "kernel_launch: device query failed\n"); grid = -1; return; }
        if (hipFuncSetAttribute((const void*)mega, hipFuncAttributeMaxDynamicSharedMemorySize, LDS_BYTES) != hipSuccess) { fprintf(stderr, "kernel_launch: hipFuncSetAttribute failed\n"); grid = -1; return; }
        if (hipOccupancyMaxActiveBlocksPerMultiprocessor(&per_cu, (const void*)mega, NTHR, LDS_BYTES) != hipSuccess || per_cu < 1) fprintf(stderr, "kernel_launch: occupancy query reports %d\n", per_cu);
        (void)hipGetLastError();
        grid = cus;
    }
    if (grid < 0) return;
    unsigned char* ws = (unsigned char*)d_ws;
    (void)hipMemsetAsync(ws + WS_CTL, 0, CTL_BYTES, stream);
    Args a{};
    for (int i = 0; i < 18; ++i) a.in[i] = d_in[i];
    a.out = (float*)d_out; a.ws = ws; a.ph_lo = 0; a.ph_hi = N_PHASES; a.li = 0; a.pad = 0;
    hipLaunchKernelGGL(mega, dim3(grid), dim3(NTHR), LDS_BYTES, stream, a);
#ifdef EXTRA_PHASE
#ifndef EXTRA_HI
#define EXTRA_HI (EXTRA_PHASE + 1)
#endif
    a.ph_lo = EXTRA_PHASE; a.ph_hi = EXTRA_HI; a.li = 1;
    hipLaunchKernelGGL(mega, dim3(grid), dim3(NTHR), LDS_BYTES, stream, a);
#endif
}
```

```cpp
#include <hip/hip_runtime.h>
#include <cstdio>
#include <cstdint>
#define DUP_MASK 0
#define MK_SLOTMAP_OFF (163840 - 256)
__device__ __forceinline__ unsigned mk_hwslot() { return (unsigned)__builtin_amdgcn_s_getreg((5 << 11) | 4) & 63u; }
__device__ __forceinline__ int mk_wave() { return __builtin_amdgcn_readfirstlane((int)((const __attribute__((address_space(3))) unsigned char*)(unsigned)MK_SLOTMAP_OFF)[mk_hwslot()]); }
__device__ __forceinline__ int mk_lane() { return (int)__builtin_amdgcn_mbcnt_hi(~0u, __builtin_amdgcn_mbcnt_lo(~0u, 0u)); }
__device__ __forceinline__ int mk_tidx() { return mk_wave() * 64 + mk_lane(); }
namespace pg8 {
#define PG8_LAS __attribute__((address_space(3)))
typedef unsigned short bf16_t;
typedef short bf16x8 __attribute__((ext_vector_type(8)));
typedef float f32x4 __attribute__((ext_vector_type(4)));
typedef unsigned u32x4 __attribute__((ext_vector_type(4)));
constexpr int BM = 256, BK = 64, HALF = 128, HTB = HALF * BK * 2  , STAGE_BYTES = 8 * HTB, NXCD = 8, WGM = 8;

__host__ __device__ __forceinline__ int lds_byte(int r, int c) { const int st = (r >> 4) * 2 + (c >> 5), rr = r & 15, cc = c & 31, ob = rr * 64 + cc * 2; return st * 1024 + (ob ^ (((ob >> 9) & 1) << 5)); }
__host__ __device__ __forceinline__ void stage_rc(int b, int& R, int& C) { const int st = b / 1024, sb = b % 1024, swz = sb ^ (((sb >> 9) & 1) << 5); R = (st >> 1) * 16 + swz / 64; C = (st & 1) * 32 + (swz % 64) / 2; }
__host__ __device__ __forceinline__ int perm32(int rho) { const int n = rho >> 4, i = rho & 15; return 8 * (i >> 2) + 4 * n + (i & 3); }

struct Unit { int pm, pn; };
struct Gemm { const bf16_t* A; const bf16_t* Bt; int M, N, K; };

struct StaticOrder {
    int nM, nN, nwg, G, c;
    __host__ __device__ void init(int M, int N, int G_, int c_) { nM = M / BM; nN = N / BM; nwg = nM * nN; G = G_; c = c_; }
    __host__ __device__ bool next(int i, Unit& u) const {
        const long L = (long)i * G + c; if (L >= nwg) return false;
        int wgid = (int)L; { const int q = nwg / NXCD, r = nwg % NXCD, xcd = wgid % NXCD, off = wgid / NXCD; wgid = (xcd < r ? xcd * (q + 1) : r * (q + 1) + (xcd - r) * q) + off; }
        const int nig = WGM * nN, gid = wgid / nig, fm = gid * WGM, gsz = (nM - fm) < WGM ? (nM - fm) : WGM;
        u.pm = fm + ((wgid % nig) % gsz); u.pn = (wgid % nig) / gsz; return true;
    }
    __device__ __forceinline__ void a_ready(const Unit&) const {}
    __device__ __forceinline__ void done(const Unit&) const {}
};
template <class Epi, class Sched, bool ALIGN_EPI = false, bool SP2 = false>
__device__ __forceinline__ void gemm_phase(PG8_LAS unsigned char* lds, const Gemm g, const Sched& S, const Epi& E) {
    const int tid = mk_tidx(), wid = __builtin_amdgcn_readfirstlane(tid >> 6), lane = tid & 63, wr = wid >> 2, wc = wid & 3, fr = lane & 15, fq = lane >> 4;
    const int K = g.K, nt = K / BK;
    unsigned voffA[2], voffB[2];
#pragma unroll
    for (int i = 0; i < 2; ++i) { int R, C; stage_rc(tid * 16 + i * 8192, R, C); const int Rb = Epi::PERM ? ((R & ~31) + perm32(R & 31)) : R;
        voffA[i] = (unsigned)(R * K + C) * 2u; voffB[i] = (unsigned)(Rb * K + C) * 2u; }
    const size_t kstep = (size_t)(BK * 2);
    const size_t hstep = (size_t)HALF * K * 2;
    const size_t tstep = 2 * hstep;
    const unsigned ldsw = (unsigned)wid * 1024u;
    const int aoff = lds_byte(wr * 64 + fr, fq * 8), boff = lds_byte(wc * 32 + fr, fq * 8);
#define PG8_SA(b, h) (((b) * 2 + (h)) * HTB)
#define PG8_SB(b, h) ((4 + (b) * 2 + (h)) * HTB)
#define PG8_STAGE(bufoff, gbase, voff) do { _Pragma("unroll") for (int _i = 0; _i < 2; ++_i) \
        __builtin_amdgcn_global_load_lds((const unsigned*)((const char*)(gbase) + (voff)[_i]), (PG8_LAS unsigned*)(lds + (bufoff) + ldsw + _i * 8192), 16, 0, 0); } while (0)
#define PG8_LDA(dst, b, h) do { _Pragma("unroll") for (int m = 0; m < 4; ++m) _Pragma("unroll") for (int k = 0; k < 2; ++k) dst[m][k] = *(const PG8_LAS bf16x8*)(lds + PG8_SA(b, h) + aoff + m * 2048 + k * 1024); } while (0)
#define PG8_LDB(dst, b, h) do { _Pragma("unroll") for (int n = 0; n < 2; ++n) _Pragma("unroll") for (int k = 0; k < 2; ++k) dst[n][k] = *(const PG8_LAS bf16x8*)(lds + PG8_SB(b, h) + boff + n * 2048 + k * 1024); } while (0)
#define PG8_MMA(ai, bj, At, Bt) do { __builtin_amdgcn_s_setprio(1); _Pragma("unroll") for (int m = 0; m < 4; ++m) _Pragma("unroll") for (int n = 0; n < 2; ++n) _Pragma("unroll") for (int k = 0; k < 2; ++k) \
        acc[ai][bj][m][n] = __builtin_amdgcn_mfma_f32_16x16x32_bf16(Bt[n][k], At[m][k], acc[ai][bj][m][n], 0, 0, 0); __builtin_amdgcn_s_setprio(0); } while (0)
#define PG8_WAIT_V(n) asm volatile("s_waitcnt vmcnt(" #n ")" ::: "memory")
#define PG8_WAIT_L(n) asm volatile("s_waitcnt lgkmcnt(" #n ")" ::: "memory")
#define PG8_BAR __builtin_amdgcn_s_barrier()
#define PG8_SCHED __builtin_amdgcn_sched_barrier(0)
    Unit cur, nxt; int ui = 0;
    if (!S.next(0, cur)) return;
    f32x4 acc[2][2][4][2];
#pragma unroll
    for (int a = 0; a < 2; ++a)
#pragma unroll
        for (int b = 0; b < 2; ++b)
#pragma unroll
            for (int m = 0; m < 4; ++m)
#pragma unroll
                for (int n = 0; n < 2; ++n) acc[a][b][m][n] = (f32x4){0.f, 0.f, 0.f, 0.f};
    bf16x8 At[4][2], B0[2][2], B1[2][2];
    const char* cA = (const char*)g.A + (size_t)cur.pm * tstep; const char* cB = (const char*)g.Bt + (size_t)cur.pn * tstep;
    S.a_ready(cur);
    if constexpr (SP2) {
        PG8_STAGE(PG8_SB(0, 0), cB, voffB); PG8_STAGE(PG8_SB(0, 1), cB + hstep, voffB); PG8_STAGE(PG8_SA(0, 0), cA, voffA); PG8_STAGE(PG8_SA(0, 1), cA + hstep, voffA);
        if (wr == 1) PG8_BAR;
        PG8_WAIT_V(2); PG8_BAR;
        PG8_STAGE(PG8_SB(1, 0), cB + kstep, voffB); PG8_STAGE(PG8_SA(1, 0), cA + kstep, voffA); PG8_STAGE(PG8_SB(1, 1), cB + hstep + kstep, voffB);
        PG8_WAIT_V(6); PG8_BAR;
    } else {
        PG8_STAGE(PG8_SB(0, 0), cB, voffB); PG8_STAGE(PG8_SA(0, 0), cA, voffA); PG8_STAGE(PG8_SB(0, 1), cB + hstep, voffB); PG8_STAGE(PG8_SA(0, 1), cA + hstep, voffA);
        if (wr == 1) PG8_BAR;
        PG8_WAIT_V(4); PG8_BAR;
        PG8_STAGE(PG8_SB(1, 0), cB + kstep, voffB); PG8_STAGE(PG8_SA(1, 0), cA + kstep, voffA); PG8_STAGE(PG8_SB(1, 1), cB + hstep + kstep, voffB);
        PG8_WAIT_V(6); PG8_BAR;
    }
    for (;;) {
        const bool has_next = S.next(ui + 1, nxt);
        const char* nA = has_next ? (const char*)g.A + (size_t)nxt.pm * tstep : cA; const char* nB = has_next ? (const char*)g.Bt + (size_t)nxt.pn * tstep : cB;
        for (int t = 0; t < nt; t += 2) {
            const bool last = (t == nt - 2);
            const char* a1 = cA + (size_t)(t + 1) * kstep;
            const char* a2 = last ? nA : cA + (size_t)(t + 2) * kstep; const char* b2 = last ? nB : cB + (size_t)(t + 2) * kstep;
            const char* a3 = a2 + kstep; const char* b3 = b2 + kstep;
            if (last && has_next) S.a_ready(nxt);
            if constexpr (SP2) {
            PG8_LDB(B0, 0, 0); PG8_LDB(B1, 0, 1); PG8_SCHED; PG8_LDA(At, 0, 0); PG8_STAGE(PG8_SA(1, 1), a1 + hstep, voffA);
            PG8_WAIT_V(8); PG8_WAIT_L(0); PG8_BAR; PG8_MMA(0, 0, At, B0); PG8_MMA(0, 1, At, B1); PG8_BAR; PG8_SCHED;
            PG8_LDA(At, 0, 1); PG8_STAGE(PG8_SB(0, 0), b2, voffB); PG8_STAGE(PG8_SB(0, 1), b2 + hstep, voffB); PG8_STAGE(PG8_SA(0, 0), a2, voffA);
            PG8_WAIT_V(8); PG8_WAIT_L(0); PG8_BAR; PG8_MMA(1, 0, At, B0); PG8_MMA(1, 1, At, B1); PG8_BAR; PG8_SCHED;
            PG8_LDB(B0, 1, 0); PG8_LDB(B1, 1, 1); PG8_SCHED; PG8_LDA(At, 1, 0); PG8_STAGE(PG8_SA(0, 1), a2 + hstep, voffA);
            PG8_WAIT_V(8); PG8_WAIT_L(0); PG8_BAR; PG8_MMA(0, 0, At, B0); PG8_MMA(0, 1, At, B1); PG8_BAR; PG8_SCHED;
            PG8_LDA(At, 1, 1); PG8_STAGE(PG8_SB(1, 0), b3, voffB); PG8_STAGE(PG8_SB(1, 1), b3 + hstep, voffB); PG8_STAGE(PG8_SA(1, 0), a3, voffA);
            PG8_WAIT_V(8); PG8_WAIT_L(0); PG8_BAR; PG8_MMA(1, 0, At, B0); PG8_MMA(1, 1, At, B1); PG8_BAR; PG8_SCHED;
            } else {
            PG8_LDB(B0, 0, 0); PG8_SCHED; PG8_LDA(At, 0, 0); PG8_STAGE(PG8_SA(1, 1), a1 + hstep, voffA);
            PG8_WAIT_L(8); PG8_BAR; PG8_WAIT_L(0); PG8_MMA(0, 0, At, B0); PG8_BAR; PG8_SCHED;
            PG8_LDB(B1, 0, 1); PG8_STAGE(PG8_SB(0, 0), b2, voffB);
            PG8_BAR; PG8_WAIT_L(0); PG8_MMA(0, 1, At, B1); PG8_BAR;
            PG8_LDA(At, 0, 1); PG8_STAGE(PG8_SA(0, 0), a2, voffA);
            PG8_BAR; PG8_WAIT_L(0); PG8_MMA(1, 0, At, B0); PG8_BAR; PG8_SCHED;
            PG8_STAGE(PG8_SB(0, 1), b2 + hstep, voffB);
            PG8_WAIT_V(6); PG8_BAR; PG8_MMA(1, 1, At, B1); PG8_BAR;
            PG8_LDB(B0, 1, 0); PG8_SCHED; PG8_LDA(At, 1, 0); PG8_STAGE(PG8_SA(0, 1), a2 + hstep, voffA);
            PG8_WAIT_L(8); PG8_BAR; PG8_WAIT_L(0); PG8_MMA(0, 0, At, B0); PG8_BAR; PG8_SCHED;
            PG8_LDB(B1, 1, 1); PG8_STAGE(PG8_SB(1, 0), b3, voffB);
            PG8_BAR; PG8_WAIT_L(0); PG8_MMA(0, 1, At, B1); PG8_BAR;
            PG8_LDA(At, 1, 1); PG8_STAGE(PG8_SA(1, 0), a3, voffA);
            PG8_BAR; PG8_WAIT_L(0); PG8_MMA(1, 0, At, B0); PG8_BAR; PG8_SCHED;
            PG8_STAGE(PG8_SB(1, 1), b3 + hstep, voffB);
            PG8_WAIT_V(6); PG8_BAR; PG8_MMA(1, 1, At, B1); PG8_BAR;
            }
        }
        if constexpr (ALIGN_EPI) { if (wr == 0) PG8_BAR; }
        if constexpr (!Epi::AFTER_DRAIN) { E(acc, cur, wr, wc, fr, fq); S.done(cur); }
        if (!has_next) break;
#pragma unroll
        for (int a = 0; a < 2; ++a)
#pragma unroll
            for (int b = 0; b < 2; ++b)
#pragma unroll
                for (int m = 0; m < 4; ++m)
#pragma unroll
                    for (int n = 0; n < 2; ++n) acc[a][b][m][n] = (f32x4){0.f, 0.f, 0.f, 0.f};
        cur = nxt; cA = nA; cB = nB; ++ui;
        if constexpr (ALIGN_EPI) { if (wr == 1) PG8_BAR; }
    }
    PG8_WAIT_V(0);
    if constexpr (!ALIGN_EPI) { if (wr == 0) PG8_BAR; }
    PG8_BAR;
    if constexpr (Epi::AFTER_DRAIN) { E.fused(acc, cur, wr, wc, fr, fq, lds, wid, lane); S.done(cur); }
#undef PG8_SA
#undef PG8_SB
#undef PG8_STAGE
#undef PG8_LDA
#undef PG8_LDB
#undef PG8_MMA
#undef PG8_WAIT_V
#undef PG8_WAIT_L
#undef PG8_BAR
#undef PG8_SCHED
}
}
#define XB_TMO      128
#define XB_XCNT(j)  (256  + 64 * (j))
#define XB_XSUB(j)  (1280 + 64 * (j))
#define XB_XGEN(j)  (2304 + 64 * (j))
#define XB_TOP      3328
#define XB_TOPGEN   3392
#define XCD_BAR_WORDS 3456
#define XB_SPIN_CAP (1u << 18)
#define LAS __attribute__((address_space(3)))

__device__ __forceinline__ unsigned xb_ld(unsigned* p)              { return __hip_atomic_load(p, __ATOMIC_RELAXED, __HIP_MEMORY_SCOPE_AGENT); }
__device__ __forceinline__ unsigned xb_add(unsigned* p, unsigned v) { return __hip_atomic_fetch_add(p, v, __ATOMIC_RELAXED, __HIP_MEMORY_SCOPE_AGENT); }
__device__ __forceinline__ unsigned xb_xcc_id() { return (unsigned)__builtin_amdgcn_s_getreg((3 << 11) | 20) & 0xFu; }
#define XB_SPIN(cond, bar) do { unsigned _sp = 0; while (cond) { __builtin_amdgcn_s_sleep(1); \
    if ((++_sp & 255u) == 0u) { if (xb_ld(&(bar)[XB_TMO])) break; if (_sp > XB_SPIN_CAP) { atomicAdd(&(bar)[XB_TMO], 1u); break; } } } } while (0)

struct XcdBarrier {
    unsigned* bar; unsigned x;
    volatile LAS unsigned* st;
};

__device__ __forceinline__ XcdBarrier xcd_barrier_post(unsigned* bar, volatile LAS unsigned* st) {
    XcdBarrier b; b.bar = bar; b.x = xb_xcc_id(); b.st = st;
    if (mk_tidx() == 0) (void)xb_add(&bar[XB_XCNT(b.x)], 1u);
    return b;
}
__device__ __forceinline__ void xcd_barrier_complete(unsigned* bar, unsigned x, unsigned& nloc, unsigned& nx) {
    const unsigned G = gridDim.x * gridDim.y * gridDim.z;
    unsigned sum, cnt, mine, sp = 0u;
    for (;;) {
        sum = 0u; cnt = 0u; mine = 0u;
#pragma unroll
        for (unsigned j = 0; j < 16; ++j) { const unsigned c = xb_ld(&bar[XB_XCNT(j)]); sum += c; cnt += (c > 0u) ? 1u : 0u; mine = (j == x) ? c : mine; }
        if (sum == G) break;
        __builtin_amdgcn_s_sleep(1);
        if ((++sp & 255u) == 0u) { if (xb_ld(&bar[XB_TMO])) break; if (sp > XB_SPIN_CAP) { atomicAdd(&bar[XB_TMO], 1u); break; } }
    }
    nloc = mine > 0u ? mine : 1u; nx = cnt > 0u ? cnt : 1u;
}

__device__ __forceinline__ void xcd_barrier(const XcdBarrier& b) {
    asm volatile("s_waitcnt vmcnt(0)" ::: "memory");
    __syncthreads();
    if (mk_tidx() == 0) {
        unsigned* bar = b.bar;
        __builtin_amdgcn_s_waitcnt(0);
        unsigned nloc = b.st[0], nx = b.st[1];
        if (nloc == 0u) { xcd_barrier_complete(bar, b.x, nloc, nx); b.st[0] = nloc; b.st[1] = nx; }
        const unsigned old = xb_add(&bar[XB_XSUB(b.x)], 1u);
        const unsigned gen = old / nloc;
        if (old + 1u == (gen + 1u) * nloc) {
            __builtin_amdgcn_fence(__ATOMIC_RELEASE, "agent");
            asm volatile("s_waitcnt vmcnt(0)" ::: "memory");
            const unsigned og = xb_add(&bar[XB_TOP], 1u);
            const unsigned tg = og / nx;
            if (og + 1u == (tg + 1u) * nx) xb_add(&bar[XB_TOPGEN], 1u);
            else XB_SPIN(xb_ld(&bar[XB_TOPGEN]) == tg, bar);
            __builtin_amdgcn_fence(__ATOMIC_ACQUIRE, "agent");
            xb_add(&bar[XB_XGEN(b.x)], 1u);
            asm volatile("s_waitcnt vmcnt(0)" ::: "memory");
        } else {
            XB_SPIN(xb_ld(&bar[XB_XGEN(b.x)]) == gen, bar);
            __builtin_amdgcn_fence(__ATOMIC_ACQUIRE, "agent");
            asm volatile("s_waitcnt vmcnt(0)" ::: "memory");
        }
    }
    __syncthreads();
}
namespace pg8 {
template <class Epi, class Sched>
__device__ __forceinline__ void gemm_phase_ga(PG8_LAS unsigned char* lds, const Gemm g, const Sched& S, const Epi& E) {
    const int tid = mk_tidx(), wid = __builtin_amdgcn_readfirstlane(tid >> 6), lane = tid & 63, wr = wid >> 2, wc = wid & 3, fr = lane & 15, fq = lane >> 4;
    const int K = g.K, nt = K / BK;
    unsigned voffB[2]; int RA[2], CA[2];
#pragma unroll
    for (int i = 0; i < 2; ++i) { int R, C; stage_rc(tid * 16 + i * 8192, R, C); const int Rb = Epi::PERM ? ((R & ~31) + perm32(R & 31)) : R;
        RA[i] = R; CA[i] = C; voffB[i] = (unsigned)(Rb * K + C) * 2u; }
    const size_t kstep = (size_t)(BK * 2);
    const size_t hstep = (size_t)HALF * K * 2;
    const size_t tstep = 2 * hstep;
    const unsigned ldsw = (unsigned)wid * 1024u;
    const int aoff = lds_byte(wr * 64 + fr, fq * 8), boff = lds_byte(wc * 32 + fr, fq * 8);
#define PG8_SA(b, h) (((b) * 2 + (h)) * HTB)
#define PG8_SB(b, h) ((4 + (b) * 2 + (h)) * HTB)
#define PG8_STAGE(bufoff, gbase, voff) do { _Pragma("unroll") for (int _i = 0; _i < 2; ++_i) \
        __builtin_amdgcn_global_load_lds((const unsigned*)((const char*)(gbase) + (voff)[_i]), (PG8_LAS unsigned*)(lds + (bufoff) + ldsw + _i * 8192), 16, 0, 0); } while (0)
#define PG8_LDA(dst, b, h) do { _Pragma("unroll") for (int m = 0; m < 4; ++m) _Pragma("unroll") for (int k = 0; k < 2; ++k) dst[m][k] = *(const PG8_LAS bf16x8*)(lds + PG8_SA(b, h) + aoff + m * 2048 + k * 1024); } while (0)
#define PG8_LDB(dst, b, h) do { _Pragma("unroll") for (int n = 0; n < 2; ++n) _Pragma("unroll") for (int k = 0; k < 2; ++k) dst[n][k] = *(const PG8_LAS bf16x8*)(lds + PG8_SB(b, h) + boff + n * 2048 + k * 1024); } while (0)
#define PG8_MMA(ai, bj, At, Bt) do { __builtin_amdgcn_s_setprio(1); _Pragma("unroll") for (int m = 0; m < 4; ++m) _Pragma("unroll") for (int n = 0; n < 2; ++n) _Pragma("unroll") for (int k = 0; k < 2; ++k) \
        acc[ai][bj][m][n] = __builtin_amdgcn_mfma_f32_16x16x32_bf16(Bt[n][k], At[m][k], acc[ai][bj][m][n], 0, 0, 0); __builtin_amdgcn_s_setprio(0); } while (0)
#define PG8_WAIT_V(n) asm volatile("s_waitcnt vmcnt(" #n ")" ::: "memory")
#define PG8_WAIT_L(n) asm volatile("s_waitcnt lgkmcnt(0)" ::: "memory")
#define PG8_BAR __builtin_amdgcn_s_barrier()
#define PG8_SCHED __builtin_amdgcn_sched_barrier(0)
#define PG8_AOFF(dst, u) do { _Pragma("unroll") for (int _h = 0; _h < 2; ++_h) _Pragma("unroll") for (int _i = 0; _i < 2; ++_i) \
        dst[_h][_i] = (unsigned)S.arow(u, _h * HALF + RA[_i]) * (unsigned)(K * 2) + (unsigned)(CA[_i] * 2); } while (0)
    Unit cur, nxt; int ui = 0;
    if (!S.next(0, cur)) return;
    f32x4 acc[2][2][4][2];
#pragma unroll
    for (int a = 0; a < 2; ++a)
#pragma unroll
        for (int b = 0; b < 2; ++b)
#pragma unroll
            for (int m = 0; m < 4; ++m)
#pragma unroll
                for (int n = 0; n < 2; ++n) acc[a][b][m][n] = (f32x4){0.f, 0.f, 0.f, 0.f};
    bf16x8 At[4][2], B0[2][2], B1[2][2];
    unsigned offC[2][2], offN[2][2];
    PG8_AOFF(offC, cur);
    const char* gA = (const char*)g.A;
    const char* cB = (const char*)g.Bt + (size_t)cur.pn * tstep;
    S.a_ready(cur);
    PG8_STAGE(PG8_SB(0, 0), cB, voffB); PG8_STAGE(PG8_SB(0, 1), cB + hstep, voffB); PG8_STAGE(PG8_SA(0, 0), gA, offC[0]); PG8_STAGE(PG8_SA(0, 1), gA, offC[1]);
    if (wr == 1) PG8_BAR;
    PG8_WAIT_V(2); PG8_BAR;
    PG8_STAGE(PG8_SB(1, 0), cB + kstep, voffB); PG8_STAGE(PG8_SA(1, 0), gA + kstep, offC[0]); PG8_STAGE(PG8_SB(1, 1), cB + hstep + kstep, voffB);
    PG8_WAIT_V(6); PG8_BAR;
    for (;;) {
        const bool has_next = S.next(ui + 1, nxt);
        if (has_next) { PG8_AOFF(offN, nxt); } else {
#pragma unroll
            for (int h_ = 0; h_ < 2; ++h_)
#pragma unroll
                for (int i_ = 0; i_ < 2; ++i_) offN[h_][i_] = offC[h_][i_]; }
        const char* nB = has_next ? (const char*)g.Bt + (size_t)nxt.pn * tstep : cB;
        for (int t = 0; t < nt; t += 2) {
            const bool last = (t == nt - 2);
            const char* a1 = gA + (size_t)(t + 1) * kstep;
            const char* a2 = last ? gA : gA + (size_t)(t + 2) * kstep; const char* b2 = last ? nB : cB + (size_t)(t + 2) * kstep;
            const char* a3 = a2 + kstep; const char* b3 = b2 + kstep;
            unsigned o2[2][2];
#pragma unroll
            for (int h_ = 0; h_ < 2; ++h_)
#pragma unroll
                for (int i_ = 0; i_ < 2; ++i_) o2[h_][i_] = last ? offN[h_][i_] : offC[h_][i_];
            if (last && has_next) S.a_ready(nxt);
            PG8_LDB(B0, 0, 0); PG8_LDB(B1, 0, 1); PG8_SCHED; PG8_LDA(At, 0, 0); PG8_STAGE(PG8_SA(1, 1), a1, offC[1]);
            PG8_WAIT_V(8); PG8_WAIT_L(0); PG8_BAR; PG8_MMA(0, 0, At, B0); PG8_MMA(0, 1, At, B1); PG8_BAR; PG8_SCHED;
            PG8_LDA(At, 0, 1); PG8_STAGE(PG8_SB(0, 0), b2, voffB); PG8_STAGE(PG8_SB(0, 1), b2 + hstep, voffB); PG8_STAGE(PG8_SA(0, 0), a2, o2[0]);
            PG8_WAIT_V(8); PG8_WAIT_L(0); PG8_BAR; PG8_MMA(1, 0, At, B0); PG8_MMA(1, 1, At, B1); PG8_BAR; PG8_SCHED;
            PG8_LDB(B0, 1, 0); PG8_LDB(B1, 1, 1); PG8_SCHED; PG8_LDA(At, 1, 0); PG8_STAGE(PG8_SA(0, 1), a2, o2[1]);
            PG8_WAIT_V(8); PG8_WAIT_L(0); PG8_BAR; PG8_MMA(0, 0, At, B0); PG8_MMA(0, 1, At, B1); PG8_BAR; PG8_SCHED;
            PG8_LDA(At, 1, 1); PG8_STAGE(PG8_SB(1, 0), b3, voffB); PG8_STAGE(PG8_SB(1, 1), b3 + hstep, voffB); PG8_STAGE(PG8_SA(1, 0), a3, o2[0]);
            PG8_WAIT_V(8); PG8_WAIT_L(0); PG8_BAR; PG8_MMA(1, 0, At, B0); PG8_MMA(1, 1, At, B1); PG8_BAR; PG8_SCHED;
        }
        if (wr == 0) PG8_BAR;
        E(acc, cur, wr, wc, fr, fq); S.done(cur);
        if (!has_next) break;
#pragma unroll
        for (int a = 0; a < 2; ++a)
#pragma unroll
            for (int b = 0; b < 2; ++b)
#pragma unroll
                for (int m = 0; m < 4; ++m)
#pragma unroll
                    for (int n = 0; n < 2; ++n) acc[a][b][m][n] = (f32x4){0.f, 0.f, 0.f, 0.f};
        cur = nxt; cB = nB; ++ui;
#pragma unroll
        for (int h_ = 0; h_ < 2; ++h_)
#pragma unroll
            for (int i_ = 0; i_ < 2; ++i_) offC[h_][i_] = offN[h_][i_];
        if (wr == 1) PG8_BAR;
    }
    PG8_WAIT_V(0);
    PG8_BAR;
#undef PG8_SA
#undef PG8_SB
#undef PG8_STAGE
#undef PG8_LDA
#undef PG8_LDB
#undef PG8_MMA
#undef PG8_WAIT_V
#undef PG8_WAIT_L
#undef PG8_BAR
#undef PG8_SCHED
#undef PG8_AOFF
}
}
namespace attn_body {
using bf16=unsigned short;
using bf16x8=__attribute__((ext_vector_type(8)))short;
using s16x4=__attribute__((ext_vector_type(4)))short;
using f32x16=__attribute__((ext_vector_type(16)))float;
using u32x4=__attribute__((ext_vector_type(4)))unsigned;
constexpr int BATCH=4,NHEAD=8,SEQ=4096,D=64,DM=NHEAD*D,ODM=1024;
constexpr int NW=8,QBLK=32,QB=QBLK*NW,KVBLK=64,NQB=SEQ/QB;
constexpr int ATTN_PITCH=DM, ATTN_UNIT_ROWS=QB;
__device__ __forceinline__ int crow(int r,int hi){return (r&3)+8*(r>>2)+4*hi;}
#define SBAR() __builtin_amdgcn_sched_barrier(0)
__device__ __forceinline__ void cmask(f32x16&p0,f32x16&p1,int jb,int qrel,int hi){
  const float NEG=-INFINITY; int kb=64*jb+4*hi;
  #pragma unroll
  for(int r=0;r<16;++r){int kv=kb+(r&3)+8*(r>>2); if(kv>qrel)p0[r]=NEG; if(kv+32>qrel)p1[r]=NEG;}
}

constexpr int NSLOT=3, SLOTB=8192;
constexpr int LDS_K=0, LDS_V=NSLOT*SLOTB, LDS_WS=2*NSLOT*SLOTB, LDS_OST=LDS_WS+NW*64*4, LDS_MSK=LDS_OST+NW*4096, LDS_BYTES=LDS_MSK+NW*768;
constexpr float C2=0.125f*1.4426950408889634f;
__device__ __forceinline__ void glds16(const void*gsrc,unsigned lds_dst){unsigned keep;
  asm volatile("s_mov_b32 %0, m0\n\ts_mov_b32 m0, %2\n\ts_nop 0\n\tglobal_load_lds_dwordx4 %1, off\n\ts_mov_b32 m0, %0":"=&s"(keep):"v"(gsrc),"s"(lds_dst):"memory");}
__device__ __forceinline__ void glds4(const void*gsrc,unsigned lds_dst){unsigned keep;
  asm volatile("s_mov_b32 %0, m0\n\ts_mov_b32 m0, %2\n\ts_nop 0\n\tglobal_load_lds_dword %1, off\n\ts_mov_b32 m0, %0":"=&s"(keep):"v"(gsrc),"s"(lds_dst):"memory");}
template<int BIT> __device__ __forceinline__ float mand(float x,unsigned w){ int m; asm("v_bfe_i32 %0, %1, %2, 1":"=v"(m):"v"(w),"n"(BIT)); return __uint_as_float(__float_as_uint(x)&(unsigned)m); }
__device__ __forceinline__ float max3f(float a,float b,float c){float r;asm("v_max3_f32 %0, %1, %2, %3":"=v"(r):"v"(a),"v"(b),"v"(c));return r;}
__device__ __forceinline__ float max2f(float a,float b){float r;asm("v_max_f32_e32 %0, %1, %2":"=v"(r):"v"(a),"v"(b));return r;}
__device__ __forceinline__ float fadd_s(float a,float b){float r;asm("v_add_f32_e32 %0, %1, %2":"=v"(r):"v"(a),"v"(b));return r;}
__device__ __forceinline__ float fsub_s(float a,float b){float r;asm("v_sub_f32_e32 %0, %1, %2":"=v"(r):"v"(a),"v"(b));return r;}
typedef float f32x2_t __attribute__((ext_vector_type(2))); typedef __bf16 bf16x2_t __attribute__((ext_vector_type(2)));
__device__ __forceinline__ unsigned cvtpk_s(float lo,float hi){f32x2_t v={lo,hi};bf16x2_t b=__builtin_convertvector(v,bf16x2_t);return __builtin_bit_cast(unsigned,b);}
#define WAIT_BAR(N) asm volatile("s_waitcnt vmcnt(" #N ") lgkmcnt(0)\n\ts_barrier":::"memory")

__device__ __forceinline__ void qkt(f32x16&p0,f32x16&p1,const char*Kslot,const bf16x8*qr,const f32x16&negm,int r32,int hi){
  const char*kb=Kslot+hi*1024+r32*16;
  #pragma unroll
  for(int d0=0;d0<4;++d0){
    const bf16x8 b0=*reinterpret_cast<const bf16x8*>(kb+d0*2048);
    const bf16x8 b1=*reinterpret_cast<const bf16x8*>(kb+d0*2048+512);
    if(d0==0){p0=__builtin_amdgcn_mfma_f32_32x32x16_bf16(b0,qr[0],negm,0,0,0);p1=__builtin_amdgcn_mfma_f32_32x32x16_bf16(b1,qr[0],negm,0,0,0);}
    else{p0=__builtin_amdgcn_mfma_f32_32x32x16_bf16(b0,qr[d0],p0,0,0,0);p1=__builtin_amdgcn_mfma_f32_32x32x16_bf16(b1,qr[d0],p1,0,0,0);}}
}
typedef __attribute__((address_space(3))) const char* lds_cptr;
typedef short v4i16_t __attribute__((ext_vector_type(4)));
__device__ __forceinline__ void kload8(bf16x8*kf,lds_cptr kp){
  kf[0]=*(const __attribute__((address_space(3))) bf16x8*)(kp);      kf[1]=*(const __attribute__((address_space(3))) bf16x8*)(kp+512);
  kf[2]=*(const __attribute__((address_space(3))) bf16x8*)(kp+2048); kf[3]=*(const __attribute__((address_space(3))) bf16x8*)(kp+2560);
  kf[4]=*(const __attribute__((address_space(3))) bf16x8*)(kp+4096); kf[5]=*(const __attribute__((address_space(3))) bf16x8*)(kp+4608);
  kf[6]=*(const __attribute__((address_space(3))) bf16x8*)(kp+6144); kf[7]=*(const __attribute__((address_space(3))) bf16x8*)(kp+6656);
}
__device__ __forceinline__ void kload2(bf16x8*kf,lds_cptr kp,int j){ kf[2*j]=*(const __attribute__((address_space(3))) bf16x8*)(kp+j*2048); kf[2*j+1]=*(const __attribute__((address_space(3))) bf16x8*)(kp+j*2048+512); }
__device__ __forceinline__ s16x4 vtr(lds_cptr p){ return __builtin_bit_cast(s16x4,__builtin_amdgcn_ds_read_tr16_b64_v4i16((__attribute__((address_space(3))) v4i16_t*)p)); }
__device__ __forceinline__ float rowmax(const f32x16&p0,const f32x16&p1){
  float a=max3f(p0[0],p0[1],p1[0]),b=max3f(p0[2],p0[3],p1[1]);a=max3f(a,p1[2],p1[3]);
  #pragma unroll
  for(int r=4;r<16;r+=4){a=max3f(a,p0[r],p0[r+1]);b=max3f(b,p0[r+2],p0[r+3]);a=max3f(a,p1[r],p1[r+1]);b=max3f(b,p1[r+2],p1[r+3]);}
  const float m=max2f(a,b);
  auto rr=__builtin_amdgcn_permlane32_swap(__float_as_uint(m),__float_as_uint(m),false,false);
  return max2f(__uint_as_float(rr[0]),__uint_as_float(rr[1]));
}
__device__ __forceinline__ void pv(f32x16*o,int vb,bf16x8 pa0,bf16x8 pa1,bf16x8 pa2,bf16x8 pa3){
  #pragma unroll
  for(int d0=0;d0<2;++d0){s16x4 lo[4],hi[4];
    #pragma unroll
    for(int ks=0;ks<4;++ks){
      asm volatile("ds_read_b64_tr_b16 %0,%1 offset:%c2":"=&v"(lo[ks]):"v"(vb),"i"(d0*4096+ks*1024):"memory");
      asm volatile("ds_read_b64_tr_b16 %0,%1 offset:%c2":"=&v"(hi[ks]):"v"(vb),"i"(d0*4096+ks*1024+512):"memory");}
    asm volatile("s_waitcnt lgkmcnt(0)":::"memory");SBAR();
    #define PK(k) (bf16x8){lo[k][0],lo[k][1],lo[k][2],lo[k][3],hi[k][0],hi[k][1],hi[k][2],hi[k][3]}
    o[d0]=__builtin_amdgcn_mfma_f32_32x32x16_bf16(pa0,PK(0),o[d0],0,0,0);
    o[d0]=__builtin_amdgcn_mfma_f32_32x32x16_bf16(pa1,PK(1),o[d0],0,0,0);
    o[d0]=__builtin_amdgcn_mfma_f32_32x32x16_bf16(pa2,PK(2),o[d0],0,0,0);
    o[d0]=__builtin_amdgcn_mfma_f32_32x32x16_bf16(pa3,PK(3),o[d0],0,0,0);
    #undef PK
  }
}

#ifndef ATTN_STORE16
#define ATTN_STORE16(p,v) (*(u32x4*)(p)=(v))
#endif
template<int THRL> __device__ __forceinline__ void attn_unit(int b,int h,int qb,const bf16*Q,const bf16*__restrict__ K,const bf16*__restrict__ V,bf16*O,const unsigned*__restrict__ MK,char*shm){
  const int tid=mk_tidx(),lane=tid&63,r32=lane&31,hi=lane>>5; const int wid=__builtin_amdgcn_readfirstlane(tid>>6);
  const long rowbase=(long)b*SEQ; const int q0=qb*QB;
  const bf16*Qw=Q+(rowbase+q0+wid*QBLK)*DM+h*D;
  const bf16*Kh=K+rowbase*DM+h*D,*Vh=V+rowbase*DM+h*D;
  const unsigned lds0=(unsigned)(uintptr_t)shm;
  float*wsf=(float*)(shm+LDS_WS)+wid*64;
  const bf16*ksrc=Kh+(long)lane*DM+wid*8;
  const bf16*vsrc=Vh+(long)(16*(wid&3)+(lane>>2))*DM+(wid>>2)*32+(lane&3)*8;
  const unsigned kdst=lds0+LDS_K+wid*1024, vdst=lds0+LDS_V+wid*1024;
  const unsigned*msrc=MK+((size_t)(b*128+8*qb+wid)*64)*64+lane; const unsigned mdst=lds0+LDS_MSK+wid*768;
  const __attribute__((address_space(3))) char*mrd=(__attribute__((address_space(3))) const char*)shm+LDS_MSK+wid*768+lane*4;
  int mq_cur=0,mq_n1=256,mq_n2=512;
  #define DMA_M(t,slot) glds4(msrc+(size_t)(t)*64,(unsigned)__builtin_amdgcn_readfirstlane(mdst+(slot)))
  #define MWORD() (*(const __attribute__((address_space(3))) unsigned*)(mrd+mq_cur))
  #define DMA_K(t,slot) glds16(ksrc+(long)(t)*KVBLK*DM,(unsigned)__builtin_amdgcn_readfirstlane(kdst+(slot)))
  #define DMA_V(t,slot) glds16(vsrc+(long)(t)*KVBLK*DM,(unsigned)__builtin_amdgcn_readfirstlane(vdst+(slot)))
  const int vb0=(int)(lds0+LDS_V)+((lane>>4)&1)*32+(lane&3)*8+(4*hi+((lane&15)>>2))*64;
  const char*Kbase=shm+LDS_K; bf16x8 kf[8];
  const lds_cptr shm3=(lds_cptr)shm; const lds_cptr kp0=shm3+LDS_K+hi*1024+r32*16; const lds_cptr vp0=shm3+LDS_V+((lane>>4)&1)*32+(lane&3)*8+(4*hi+((lane&15)>>2))*64;
  const int NT=(q0+QB)/KVBLK;
  DMA_M(0,0);DMA_M(1,256);DMA_K(0,0);DMA_V(0,0);DMA_K(1,SLOTB);
  bf16x8 qr[4];
  #pragma unroll
  for(int d0=0;d0<4;++d0)qr[d0]=*reinterpret_cast<const bf16x8*>(&Qw[(long)r32*DM+d0*16+hi*8]);
  float mhat=0.f,l_reg=0.f;f32x16 o[2];o[0]=f32x16{};o[1]=f32x16{};f32x16 negm=f32x16{};asm volatile("":"+v"(negm));
  const int qrel=wid*QBLK+r32;
  #define CMASK(P0,P1,t) do{}while(0)
  bool resc=false;
  #define START(P0,P1) do{ const float rm=rowmax(P0,P1); resc=false; \
    { const float dl=(rm>-1e30f)?rm:0.f; mhat=fadd_s(mhat,dl); \
      _Pragma("unroll") for(int r=0;r<16;++r){P0[r]=fsub_s(P0[r],dl);P1[r]=fsub_s(P1[r],dl);} \
      _Pragma("unroll") for(int r=0;r<16;++r)negm[r]=-mhat; asm volatile("":"+v"(negm)); } \
    _Pragma("unroll") for(int r=0;r<16;++r)P0[r]=__builtin_amdgcn_exp2f(P0[r]); }while(0)
  #define RESC() do{ if(resc){ asm volatile("s_waitcnt lgkmcnt(0)":::"memory"); \
      _Pragma("unroll") for(int d_=0;d_<2;++d_) _Pragma("unroll") for(int r=0;r<16;++r)o[d_][r]*=wsf[crow(r,hi)]; } }while(0)
  f32x16 pA0,pA1,pB0,pB1;
  int sl_prev=0,sl_cur=0,sl_next=SLOTB;
  #define ROT() do{sl_prev=sl_cur;sl_cur=sl_next;sl_next=(sl_next==(NSLOT-1)*SLOTB)?0:sl_next+SLOTB; const int mt_=mq_cur;mq_cur=mq_n1;mq_n1=mq_n2;mq_n2=mt_;}while(0)
  DMA_K(2,2*SLOTB);
  WAIT_BAR(3);
  qkt(pA0,pA1,Kbase,qr,negm,r32,hi);asm volatile("s_nop 15\n\ts_nop 7":"+v"(pA0),"+v"(pA1));CMASK(pA0,pA1,0);
  START(pA0,pA1);
  _Pragma("unroll") for(int r=0;r<16;++r)pA1[r]=__builtin_amdgcn_exp2f(pA1[r]);
  { const unsigned mw0=MWORD(); pA0[0]=mand<0>(pA0[0],mw0);pA1[0]=mand<16>(pA1[0],mw0);pA0[1]=mand<1>(pA0[1],mw0);pA1[1]=mand<17>(pA1[1],mw0);pA0[2]=mand<2>(pA0[2],mw0);pA1[2]=mand<18>(pA1[2],mw0);pA0[3]=mand<3>(pA0[3],mw0);pA1[3]=mand<19>(pA1[3],mw0);pA0[4]=mand<4>(pA0[4],mw0);pA1[4]=mand<20>(pA1[4],mw0);pA0[5]=mand<5>(pA0[5],mw0);pA1[5]=mand<21>(pA1[5],mw0);pA0[6]=mand<6>(pA0[6],mw0);pA1[6]=mand<22>(pA1[6],mw0);pA0[7]=mand<7>(pA0[7],mw0);pA1[7]=mand<23>(pA1[7],mw0);pA0[8]=mand<8>(pA0[8],mw0);pA1[8]=mand<24>(pA1[8],mw0);pA0[9]=mand<9>(pA0[9],mw0);pA1[9]=mand<25>(pA1[9],mw0);pA0[10]=mand<10>(pA0[10],mw0);pA1[10]=mand<26>(pA1[10],mw0);pA0[11]=mand<11>(pA0[11],mw0);pA1[11]=mand<27>(pA1[11],mw0);pA0[12]=mand<12>(pA0[12],mw0);pA1[12]=mand<28>(pA1[12],mw0);pA0[13]=mand<13>(pA0[13],mw0);pA1[13]=mand<29>(pA1[13],mw0);pA0[14]=mand<14>(pA0[14],mw0);pA1[14]=mand<30>(pA1[14],mw0);pA0[15]=mand<15>(pA0[15],mw0);pA1[15]=mand<31>(pA1[15],mw0); }
  WAIT_BAR(0);
  DMA_M(2,512);DMA_K(3,0);DMA_V(1,SLOTB);
  ROT();
  kload8(kf,kp0+sl_cur);
  WAIT_BAR(3);
  s16x4 vlo[8],vhi[8]; u32x4 pw0,pw1,pw2,pw3;
  #define PKW(P,B) cvtpk_s(P[B],P[B+1])
  #define PAF(k) __builtin_bit_cast(bf16x8,pw##k)
  #define VFR(i) (bf16x8){vlo[i][0],vlo[i][1],vlo[i][2],vlo[i][3],vhi[i][0],vhi[i][1],vhi[i][2],vhi[i][3]}
  #define PIN(x) asm volatile("":"+v"(x))
  #define MX3(a,b,c) __builtin_fmaxf(__builtin_fmaxf((a),(b)),(c))
  #define GAPA(MF,A0,A1,A2,A3,W0,W1,PW) do{ MF; sacc+=A0; sacc+=A1; sacc+=A2; sacc+=A3; PIN(sacc); W0; W1; PIN(PW); SBAR(); }while(0)
  #define EX(v) __builtin_amdgcn_exp2f(v)
  #define GAPB(MF,X,B,MO) do{ MF; X[B]=mand<MO+B>(EX(X[B]),mw_); X[B+1]=mand<MO+B+1>(EX(X[B+1]),mw_); X[B+2]=mand<MO+B+2>(EX(X[B+2]),mw_); X[B+3]=mand<MO+B+3>(EX(X[B+3]),mw_); PIN(X); SBAR(); }while(0)
  #define VRD(i) do{ vlo[i]=vtr(vp_+(((i)>>2)*4096+((i)&3)*1024)); vhi[i]=vtr(vp_+(((i)>>2)*4096+((i)&3)*1024+512)); }while(0)
  #define KRD(G,j) do{ if(G){ kload2(kf,kp0+sl_next,j); SBAR(); } }while(0)
  #define STEP(C0,C1,P0,P1,t,GK,GV,GL,GM) do{ SBAR(); \
    const lds_cptr vp_=vp0+sl_prev; \
    VRD(0); SBAR(); float sacc=(P0[0]+P0[1]); \
    GAPA(C0=__builtin_amdgcn_mfma_f32_32x32x16_bf16(kf[0],qr[0],negm,0,0,0), P0[2],P0[3],P0[4],P0[5],     pw0[0]=PKW(P0,0), pw0[1]=PKW(P0,2), pw0); \
    VRD(4); SBAR(); GAPA(C1=__builtin_amdgcn_mfma_f32_32x32x16_bf16(kf[1],qr[0],negm,0,0,0), P0[6],P0[7],P0[8],P0[9],     pw0[2]=PKW(P0,4), pw0[3]=PKW(P0,6), pw0); \
    VRD(1); SBAR(); GAPA(C0=__builtin_amdgcn_mfma_f32_32x32x16_bf16(kf[2],qr[1],C0,0,0,0),   P0[10],P0[11],P0[12],P0[13], pw1[0]=PKW(P0,8), pw1[1]=PKW(P0,10), pw1); \
    VRD(5); SBAR(); GAPA(C1=__builtin_amdgcn_mfma_f32_32x32x16_bf16(kf[3],qr[1],C1,0,0,0),   P0[14],P0[15],P1[0],P1[1],   pw1[2]=PKW(P0,12),pw1[3]=PKW(P0,14), pw1); \
    VRD(2); SBAR(); GAPA(C0=__builtin_amdgcn_mfma_f32_32x32x16_bf16(kf[4],qr[2],C0,0,0,0),   P1[2],P1[3],P1[4],P1[5],     pw2[0]=PKW(P1,0), pw2[1]=PKW(P1,2), pw2); \
    VRD(6); SBAR(); GAPA(C1=__builtin_amdgcn_mfma_f32_32x32x16_bf16(kf[5],qr[2],C1,0,0,0),   P1[6],P1[7],P1[8],P1[9],     pw2[2]=PKW(P1,4), pw2[3]=PKW(P1,6), pw2); \
    VRD(3); SBAR(); GAPA(C0=__builtin_amdgcn_mfma_f32_32x32x16_bf16(kf[6],qr[3],C0,0,0,0),   P1[10],P1[11],P1[12],P1[13], pw3[0]=PKW(P1,8), pw3[1]=PKW(P1,10), pw3); \
    VRD(7); SBAR(); GAPA(C1=__builtin_amdgcn_mfma_f32_32x32x16_bf16(kf[7],qr[3],C1,0,0,0),   P1[14],P1[15],0.f,0.f,       pw3[2]=PKW(P1,12),pw3[3]=PKW(P1,14), pw3); \
    l_reg+=sacc; \
    if(GM){DMA_M((t)+2,mq_n2);} if(GK){DMA_K((t)+3,sl_cur);} if(GV){DMA_V((t)+1,sl_next);} \
    const unsigned mw_=MWORD(); \
    CMASK(C0,C1,t); \
    { float a=MX3(C0[0],C0[1],C1[0]),b=MX3(C0[2],C0[3],C1[1]); a=MX3(a,C1[2],C1[3]); \
      _Pragma("unroll") for(int r=4;r<16;r+=4){a=MX3(a,C0[r],C0[r+1]);b=MX3(b,C0[r+2],C0[r+3]);a=MX3(a,C1[r],C1[r+1]);b=MX3(b,C1[r+2],C1[r+3]);} \
      float rm=__builtin_fmaxf(a,b); { auto rr=__builtin_amdgcn_permlane32_swap(__float_as_uint(rm),__float_as_uint(rm),false,false); rm=__builtin_fmaxf(__uint_as_float(rr[0]),__uint_as_float(rr[1])); } \
      resc=false; \
      if(__builtin_expect(__any(rm>(float)THRL),0)){ const float dl=__builtin_fmaxf(rm,0.f); mhat+=dl; \
        _Pragma("unroll") for(int r=0;r<16;++r){C0[r]-=dl;C1[r]-=dl;} \
        _Pragma("unroll") for(int r=0;r<16;++r)negm[r]=-mhat; asm volatile("":"+v"(negm)); \
        const float f=__builtin_amdgcn_exp2f(-dl); l_reg*=f; if(hi==0)wsf[r32]=f; resc=true; } } \
    SBAR(); \
    GAPB(o[0]=__builtin_amdgcn_mfma_f32_32x32x16_bf16(PAF(0),VFR(0),o[0],0,0,0), C0,0,0); \
    GAPB(o[1]=__builtin_amdgcn_mfma_f32_32x32x16_bf16(PAF(0),VFR(4),o[1],0,0,0), C0,4,0); \
    KRD(GL,0); GAPB(o[0]=__builtin_amdgcn_mfma_f32_32x32x16_bf16(PAF(1),VFR(1),o[0],0,0,0), C0,8,0); \
    KRD(GL,1); GAPB(o[1]=__builtin_amdgcn_mfma_f32_32x32x16_bf16(PAF(1),VFR(5),o[1],0,0,0), C0,12,0); \
    KRD(GL,2); GAPB(o[0]=__builtin_amdgcn_mfma_f32_32x32x16_bf16(PAF(2),VFR(2),o[0],0,0,0), C1,0,16); \
    KRD(GL,3); GAPB(o[1]=__builtin_amdgcn_mfma_f32_32x32x16_bf16(PAF(2),VFR(6),o[1],0,0,0), C1,4,16); \
    GAPB(o[0]=__builtin_amdgcn_mfma_f32_32x32x16_bf16(PAF(3),VFR(3),o[0],0,0,0), C1,8,16); \
    GAPB(o[1]=__builtin_amdgcn_mfma_f32_32x32x16_bf16(PAF(3),VFR(7),o[1],0,0,0), C1,12,16); \
    }while(0)
  int t=1;
  #undef CMASK
  #define CMASK(P0,P1,t) do{}while(0)
  for(;t+5<NT;t+=2){
    STEP(pB0,pB1,pA0,pA1,t,true,true,true,true);     WAIT_BAR(3); RESC(); ROT();
    STEP(pA0,pA1,pB0,pB1,t+1,true,true,true,true);   WAIT_BAR(3); RESC(); ROT();
  }
  #undef CMASK
  #define CMASK(P0,P1,t) do{}while(0)
  #define ENDW(tt) do{ if((tt)+3<NT){WAIT_BAR(3);} else if((tt)+2<NT){WAIT_BAR(2);} else {WAIT_BAR(0);} }while(0)
  for(;t+1<NT;t+=2){
    STEP(pB0,pB1,pA0,pA1,t,(t+3<NT),(t+1<NT),(t+1<NT),(t+2<NT));       ENDW(t);   RESC(); ROT();
    STEP(pA0,pA1,pB0,pB1,t+1,(t+4<NT),(t+2<NT),(t+2<NT),(t+3<NT));     ENDW(t+1); RESC(); ROT();
  }
  STEP(pB0,pB1,pA0,pA1,NT-1,false,false,false,false); RESC();
  { float sacc=pB0[0]+pB0[1]; _Pragma("unroll") for(int r=2;r<16;++r)sacc+=pB0[r]; _Pragma("unroll") for(int r=0;r<16;++r)sacc+=pB1[r]; l_reg+=sacc;
    pw0=(u32x4){PKW(pB0,0),PKW(pB0,2),PKW(pB0,4),PKW(pB0,6)};pw1=(u32x4){PKW(pB0,8),PKW(pB0,10),PKW(pB0,12),PKW(pB0,14)};pw2=(u32x4){PKW(pB1,0),PKW(pB1,2),PKW(pB1,4),PKW(pB1,6)};pw3=(u32x4){PKW(pB1,8),PKW(pB1,10),PKW(pB1,12),PKW(pB1,14)};
    SBAR(); pv(o,vb0+sl_cur,PAF(0),PAF(1),PAF(2),PAF(3)); }
  #undef PKW
  #undef PAF
  #undef VFR
  #undef PIN
  #undef MX3
  #undef GAPA
  #undef GAPB
  #undef EX
  #undef VRD
  #undef KRD
  #undef STEP
  #undef ENDW
  {auto rr=__builtin_amdgcn_permlane32_swap(__float_as_uint(l_reg),__float_as_uint(l_reg),false,false);l_reg=__uint_as_float(rr[0])+__uint_as_float(rr[1]);}
  if(hi==0)wsf[32+r32]=l_reg;asm volatile("s_waitcnt lgkmcnt(0)":::"memory");
  float rli[16];
  #pragma unroll
  for(int r=0;r<16;++r)rli[r]=__builtin_amdgcn_rcpf(wsf[32+crow(r,hi)]);
  bf16*Ow=O+(rowbase+q0+wid*QBLK)*ODM+h*D;
  { bf16*stg=(bf16*)(shm+LDS_OST)+wid*2048;
    #pragma unroll
    for(int r=0;r<16;++r){const int orow=crow(r,hi);
      #pragma unroll
      for(int d0=0;d0<2;++d0)stg[orow*64+d0*32+r32]=(bf16)(cvtpk_s(o[d0][r]*rli[r],0.f)&0xffffu);}
    asm volatile("s_waitcnt lgkmcnt(0)":::"memory");
    #pragma unroll
    for(int i=0;i<4;++i){const int row=i*8+(lane>>3),ch=lane&7; const u32x4 v=*(const u32x4*)(stg+row*64+ch*8); ATTN_STORE16(Ow+(long)row*ODM+ch*8,v);} }
  asm volatile("s_waitcnt lgkmcnt(0)\n\ts_barrier":::"memory");
  #undef DMA_K
  #undef DMA_V
  #undef DMA_M
  #undef MWORD
  #undef CMASK
  #undef START
  #undef RESC
  #undef ROT
}
constexpr int ATTN_LDS_BYTES=LDS_BYTES;
struct AttnTensors { const bf16* Q; const bf16* K; const bf16* V; bf16* O; const unsigned* MK; };
struct AttnUnit { int bh; int qb; };
struct StaticOrder {
  int vcu;
  __device__ __forceinline__ explicit StaticOrder(int grid,int block):vcu((block%8)*(grid/8)+block/8){}
  __device__ __forceinline__ bool next(int i,AttnUnit&u)const{ if(i>=2)return false; const int s=vcu&7; u.bh=vcu>>3; u.qb=(i==0)?15-s:s; return true; }
  __device__ __forceinline__ void a_ready(const AttnUnit&)const{}
  __device__ __forceinline__ void done(const AttnUnit&)const{}
};
template<class Sched,int THRL=8> __device__ __forceinline__ void attn_phase(char*lds,const AttnTensors&T,const Sched&S){
  AttnUnit u;
  for(int i=0;S.next(i,u);++i){ S.a_ready(u); attn_unit<THRL>(u.bh/NHEAD,u.bh%NHEAD,u.qb,T.Q,T.K,T.V,T.O,T.MK,lds); S.done(u); }
}
#undef SBAR
#undef WAIT_BAR
}
namespace mk {
#define GAS __attribute__((address_space(1)))
typedef unsigned short bf16_t;
typedef float f32x4 __attribute__((ext_vector_type(4)));
typedef float f32x2 __attribute__((ext_vector_type(2)));
typedef float f32x16 __attribute__((ext_vector_type(16)));
typedef unsigned u32x4 __attribute__((ext_vector_type(4)));
typedef unsigned u32x2 __attribute__((ext_vector_type(2)));
typedef short bf16x8 __attribute__((ext_vector_type(8)));
constexpr int NB = 4, S = 4096, T = NB * S, D = 1024;
constexpr int NWAVES = 8, NTHR = 512;
constexpr int INW = 4168;
constexpr int NPHYS = 4352;
constexpr float C2 = 0.125f * 1.4426950408889634f;
constexpr float WI_SCALE = 0.04419417382415922f;
constexpr float KR_SCALE = 0.08838834764831845f;
constexpr size_t MiB = 1u << 20;
#ifndef WS_RT_MIB
#define WS_RT_MIB 65
#endif
constexpr size_t WS_CTL = 0, CTL_BYTES = 131072;
constexpr size_t WS_MOD = 1 * MiB;
constexpr size_t WS_THR = 2 * MiB;
constexpr size_t WS_R128 = 3 * MiB;
constexpr size_t WS_R64 = 11 * MiB;
constexpr size_t WS_WOUT = 15 * MiB;
constexpr size_t WS_QA = 17 * MiB, WS_KA = 33 * MiB, WS_VA = 49 * MiB, WS_QI = 65 * MiB, WS_KI = 81 * MiB, WS_WI = 83 * MiB;
constexpr size_t WS_QR = 84 * MiB, WS_KR = 100 * MiB, WS_VR = 116 * MiB, WS_GR = 132 * MiB;
constexpr size_t WS_H = 148 * MiB;
constexpr size_t WS_WIN = 180 * MiB;
constexpr size_t WS_SCORES = 148 * MiB, WS_KVS = 214 * MiB, WS_MASKT = 246 * MiB, WS_RT = WS_RT_MIB * MiB, WS_MIXED = 148 * MiB;
constexpr int CW_BAR = 1024, CW_Q = 14400, CW_TMO = 14600;
constexpr int RING_BYTES = 131072;
constexpr int LDS_BYTES = 163840;
constexpr int MISC_OFF = LDS_BYTES - 1024;

typedef __bf16 bf16x2_t __attribute__((ext_vector_type(2)));
__device__ __forceinline__ unsigned cvt_pk(float lo, float hi) { const f32x2 v = {lo, hi}; const bf16x2_t b = __builtin_convertvector(v, bf16x2_t); return __builtin_bit_cast(unsigned, b); }
__device__ __forceinline__ float bf2f(bf16_t v) { return __uint_as_float((unsigned)v << 16); }
__device__ __forceinline__ float silu_f(float x) { return x / (1.f + __expf(-x)); }
#define MK_DPP_ADD(v, ctrl) v += __uint_as_float((unsigned)__builtin_amdgcn_update_dpp(0, (int)__float_as_uint(v), ctrl, 0xf, 0xf, false))
__device__ __forceinline__ float wave_sum(float v) {
    MK_DPP_ADD(v, 0xB1);
    MK_DPP_ADD(v, 0x4E);
    MK_DPP_ADD(v, 0x141);
    MK_DPP_ADD(v, 0x140);
    { const unsigned u = __float_as_uint(v); auto r = __builtin_amdgcn_permlane16_swap(u, u, false, false); v = __uint_as_float(r[0]) + __uint_as_float(r[1]); }
    { const unsigned u = __float_as_uint(v); auto r = __builtin_amdgcn_permlane32_swap(u, u, false, false); v = __uint_as_float(r[0]) + __uint_as_float(r[1]); }
    return v;
}
__host__ __device__ __forceinline__ int perm_fwd(int o, int half) { const int hi = o >= half ? 1 : 0, oo = o - hi * half; return 8 * (oo >> 2) + 4 * hi + (oo & 3); }
__host__ __device__ __forceinline__ int perm_inv(int p, int half) { const int g = p >> 3, r = p & 7; return (r < 4) ? 4 * g + r : half + 4 * g + (r - 4); }
__device__ __forceinline__ int in_src_col(int n) {
    const int tile = n >> 8;
    if (tile < 2) { const int s = n; return 0 + (s & ~63) + perm_inv(s & 63, 32); }
    if (tile < 4) { const int s = n - 512; return 512 + (s & ~63) + perm_inv(s & 63, 32); }
    if (tile < 6) return n;
    if (tile < 8) { const int s = n - 1536; return 1536 + (s & ~63) + perm_inv(s & 63, 32); }
    if (tile == 8) { const int s = n - 2048; if (s < 64) return 2048 + perm_inv(s, 32); if (s < 72) return 2112 + (s - 64); return -1; }
    const int s = n - 2304;
    if (tile < 11) return 2120 + (s & ~127) + perm_inv(s & 127, 64);
    if (tile < 13) { const int q = s - 512; return 2632 + (q & ~127) + perm_inv(q & 127, 64); }
    if (tile < 15) return 3144 + (s - 1024);
    return 3656 + (s - 1536);
}
__device__ __forceinline__ void p0_item_ada(LAS unsigned char* lds, const float* c, const float* w_ada, const float* b_ada, float* mod, int j, int tid) {
    LAS float* sc = (LAS float*)lds; LAS float* part = (LAS float*)(lds + 16384);
    __syncthreads();
    for (int i = tid; i < 4096; i += NTHR) sc[i] = silu_f(c[i]);
    __syncthreads();
    const int col = tid & 31, kg = tid >> 5;
    float a0 = 0.f, a1 = 0.f, a2 = 0.f, a3 = 0.f;
    const float* w = w_ada + 32 * j + col;
#pragma unroll 1
    for (int k0 = kg; k0 < 1024; k0 += 256) {
        float wv[16];
#pragma unroll
        for (int i = 0; i < 16; ++i) wv[i] = w[(size_t)(k0 + 16 * i) * 6144];
#pragma unroll
        for (int i = 0; i < 16; ++i) { const int k = k0 + 16 * i; a0 += sc[k] * wv[i]; a1 += sc[1024 + k] * wv[i]; a2 += sc[2048 + k] * wv[i]; a3 += sc[3072 + k] * wv[i]; }
    }
    part[(kg * 32 + col) * 4 + 0] = a0; part[(kg * 32 + col) * 4 + 1] = a1; part[(kg * 32 + col) * 4 + 2] = a2; part[(kg * 32 + col) * 4 + 3] = a3;
    __syncthreads();
    if (tid < 128) {
        const int cc = tid >> 2, b = tid & 3; float s = 0.f;
#pragma unroll
        for (int g = 0; g < 16; ++g) s += part[(g * 32 + cc) * 4 + b];
        mod[b * 6144 + 32 * j + cc] = s + b_ada[32 * j + cc];
    }
}
__device__ __forceinline__ void p0_item_rope(const int* pos, float* R128, float* R64, int r, int lane) {
    const float f128 = powf(10000.f, -(float)lane / 64.f), f64 = powf(10000.f, -(float)(lane & 31) / 32.f);
    for (int tt = 0; tt < 16; ++tt) {
        const int t = 16 * r + tt;
        float sn, cs; sincosf((float)pos[t] * f128, &sn, &cs);
        *(f32x2*)(R128 + ((size_t)t * 64 + lane) * 2) = (f32x2){cs, sn};
    }
    for (int tt = 0; tt < 16; tt += 2) {
        const int t = 16 * r + tt + (lane >> 5);
        float sn, cs; sincosf((float)pos[t] * f64, &sn, &cs);
        *(f32x2*)(R64 + ((size_t)t * 32 + (lane & 31)) * 2) = (f32x2){cs, sn};
    }
}
template <int MODE> struct TrItem { const float* sp; int ldw, Kdim, n0, k0; bf16_t* WT; bool valid; };
template <int MODE> __device__ __forceinline__ void p0_tr_setup(TrItem<MODE>& it, const float* W, const float* W2, int ldw, int Kdim, bf16_t* WT, int n0, int k0, int lane) {
    const int nl = lane & 31, n = n0 + nl;
    int src = n; const float* Ws = W;
    if (MODE == 0) src = in_src_col(n);
    if (MODE == 2) { const int g = n >> 3, r = n & 7; src = 4 * g + (r & 3); Ws = (r < 4) ? W : W2; }
    it.sp = Ws + (size_t)(k0 + (lane >> 5)) * ldw + (src >= 0 ? src : 0); it.ldw = ldw; it.Kdim = Kdim; it.n0 = n0; it.k0 = k0; it.WT = WT; it.valid = (src >= 0);
}
template <int MODE> __device__ __forceinline__ void p0_tr_load(const TrItem<MODE>& it, float (&tv)[32]) {
#pragma unroll
    for (int i = 0; i < 32; ++i) tv[i] = it.sp[(size_t)(2 * i) * it.ldw];
}
template <int MODE> __device__ __forceinline__ void p0_tr_emit(const TrItem<MODE>& it, const float (&tv)[32], LAS float* scr, int lane) {
    const int nl = lane & 31;
#pragma unroll
    for (int i = 0; i < 32; ++i) scr[(2 * i + (lane >> 5)) * 33 + nl] = it.valid ? tv[i] : 0.f;
    asm volatile("s_waitcnt lgkmcnt(0)" ::: "memory");
    const int c = lane & 7;
#pragma unroll
    for (int j = 0; j < 4; ++j) {
        const int nn = (lane >> 3) + 8 * j; const LAS float* q = scr + (8 * c) * 33 + nn;
        u32x4 o; o.x = cvt_pk(q[0 * 33], q[1 * 33]); o.y = cvt_pk(q[2 * 33], q[3 * 33]); o.z = cvt_pk(q[4 * 33], q[5 * 33]); o.w = cvt_pk(q[6 * 33], q[7 * 33]);
        *(u32x4*)(it.WT + (size_t)(it.n0 + nn) * it.Kdim + it.k0 + 8 * c) = o;
    }
    asm volatile("s_waitcnt lgkmcnt(0)" ::: "memory");
}
template <int MODE> __device__ __forceinline__ void p0_tr_item(const float* W, const float* W2, int ldw, int Kdim, bf16_t* WT, int n0, int k0, LAS float* scr, int lane) {
    TrItem<MODE> it; p0_tr_setup<MODE>(it, W, W2, ldw, Kdim, WT, n0, k0, lane);
    float tv[32]; p0_tr_load<MODE>(it, tv); p0_tr_emit<MODE>(it, tv, scr, lane);
}
struct P0Args { const float *c, *w_ada, *b_ada, *w_in, *w_out, *w_gate, *w_up, *w_down; const int* pos; float *mod, *R128, *R64; bf16_t *WIN, *WOUT, *WGU, *WD; };
__device__ __forceinline__ void p0_prologue(LAS unsigned char* lds, const P0Args& a, int bid, int G, int tid) {
    const int lane = tid & 63, wave = tid >> 6;
    if (bid < 192) p0_item_ada(lds, a.c, a.w_ada, a.b_ada, a.mod, bid, tid);
    __syncthreads();
    LAS float* scr = (LAS float*)(lds + wave * 8448);
    constexpr int I_ROPE = 1024, I_WIN = 16 * (NPHYS / 32), I_WOUT = 16 * 32;
    for (int it = bid * NWAVES + wave; it < I_ROPE + I_WIN + I_WOUT; it += G * NWAVES) {
        int r = it;
        if (r < I_ROPE) { p0_item_rope(a.pos, a.R128, a.R64, r, lane); continue; } r -= I_ROPE;
        if (r < I_WIN) { const int kb = r / (NPHYS / 32), nb = r - kb * (NPHYS / 32); p0_tr_item<0>(a.w_in, nullptr, INW, 1024, a.WIN, 32 * nb, 64 * kb, scr, lane); continue; } r -= I_WIN;
        { const int kb = r >> 5, nb = r & 31; p0_tr_item<1>(a.w_out, nullptr, 1024, 1024, a.WOUT, 32 * nb, 64 * kb, scr, lane); }
    }
}
__device__ __forceinline__ void p0_expert_items(LAS unsigned char* lds, const P0Args& a, int gw, int ngw, int tid) {
    const int lane = tid & 63, wave = tid >> 6;
    LAS float* scr = (LAS float*)(lds + wave * 8448);
    constexpr int I_WGU = 32 * 256, I_WD = 32 * 128;
    {
        TrItem<2> cur, nxt; float tv[32], tn[32];
        int it = gw;
        if (it < I_WGU) { const int e = it >> 8, q = it & 255, kb = q >> 4, nb = q & 15;
            p0_tr_setup<2>(cur, a.w_gate + (size_t)e * 262144, a.w_up + (size_t)e * 262144, 256, 1024, a.WGU + (size_t)e * 524288, 32 * nb, 64 * kb, lane); p0_tr_load<2>(cur, tv); }
#pragma unroll 1
        for (; it < I_WGU; it += ngw) {
            const int i2 = it + ngw; const bool has = i2 < I_WGU;
            if (has) { const int e = i2 >> 8, q = i2 & 255, kb = q >> 4, nb = q & 15;
                p0_tr_setup<2>(nxt, a.w_gate + (size_t)e * 262144, a.w_up + (size_t)e * 262144, 256, 1024, a.WGU + (size_t)e * 524288, 32 * nb, 64 * kb, lane); p0_tr_load<2>(nxt, tn); }
            p0_tr_emit<2>(cur, tv, scr, lane);
            if (has) { cur = nxt;
#pragma unroll
                for (int i = 0; i < 32; ++i) tv[i] = tn[i]; }
        }
    }
    {
        TrItem<1> cur, nxt; float tv[32], tn[32];
        int it = gw;
        if (it < I_WD) { const int e = it >> 7, q = it & 127, kb = q >> 5, nb = q & 31;
            p0_tr_setup<1>(cur, a.w_down + (size_t)e * 262144, nullptr, 1024, 256, a.WD + (size_t)e * 262144, 32 * nb, 64 * kb, lane); p0_tr_load<1>(cur, tv); }
#pragma unroll 1
        for (; it < I_WD; it += ngw) {
            const int i2 = it + ngw; const bool has = i2 < I_WD;
            if (has) { const int e = i2 >> 7, q = i2 & 127, kb = q >> 5, nb = q & 31;
                p0_tr_setup<1>(nxt, a.w_down + (size_t)e * 262144, nullptr, 1024, 256, a.WD + (size_t)e * 262144, 32 * nb, 64 * kb, lane); p0_tr_load<1>(nxt, tn); }
            p0_tr_emit<1>(cur, tv, scr, lane);
            if (has) { cur = nxt;
#pragma unroll
                for (int i = 0; i < 32; ++i) tv[i] = tn[i]; }
        }
    }
}
__device__ __forceinline__ void p1_row_load(f32x4 (&v)[4], const float* x, int m, int lane) {
    const f32x4* xr = (const f32x4*)(x + (size_t)m * D) + lane;
#pragma unroll
    for (int j = 0; j < 4; ++j) v[j] = xr[64 * j];
}
__device__ __forceinline__ void p1_rows(const float* x, const float* g, const float* mod, bf16_t* H, int gw, int NGW, int lane) {
#pragma unroll 1
    for (int m0 = gw * 8; m0 < T; m0 += NGW * 8) {
        f32x4 v[4][4];
        p1_row_load(v[0], x, m0, lane); p1_row_load(v[1], x, m0 + 1, lane); p1_row_load(v[2], x, m0 + 2, lane);
        const int b = m0 / S;
        const float* sh = mod + b * 6144; const float* sc = sh + 1024;
        f32x4 G[4], SH[4];
#pragma unroll
        for (int j = 0; j < 4; ++j) { const int col = 4 * lane + 256 * j; const f32x4 gg = *(const f32x4*)(g + col), a = *(const f32x4*)(sc + col); SH[j] = *(const f32x4*)(sh + col); G[j] = gg * (a + 1.0f); }
#pragma unroll
        for (int i = 0; i < 8; ++i) {
            if (i + 3 < 8) p1_row_load(v[(i + 3) & 3], x, m0 + i + 3, lane);
            const f32x4 (&c)[4] = v[i & 3];
            float s = 0.f;
#pragma unroll
            for (int j = 0; j < 4; ++j) s += (c[j].x * c[j].x + c[j].y * c[j].y) + (c[j].z * c[j].z + c[j].w * c[j].w);
            const float rs = 1.0f / sqrtf(wave_sum(s) * (1.f / 1024.f) + 1e-6f);
            bf16_t* orow = H + (size_t)(m0 + i) * D;
#pragma unroll
            for (int j = 0; j < 4; ++j) {
                const f32x4 o = c[j] * rs * G[j] + SH[j];
                u32x2 w; w.x = cvt_pk(o.x, o.y); w.y = cvt_pk(o.z, o.w);
                *(u32x2*)(orow + 4 * lane + 256 * j) = w;
            }
        }
    }
}
struct EpiInProj {
    static constexpr bool PERM = true, AFTER_DRAIN = false;
    bf16_t *QA, *KA, *VA, *QI, *KI, *QR, *KR, *VR, *GR; float* WI; const float* R64; const float* R128;
    template <int ROPE, int ACT> __device__ __forceinline__ void emit(const pg8::f32x4 (&acc)[2][2][4][2], bf16_t* dst, int ld, int segbase, float scale, int row0, int wc, int fq, int bjmask) const {
#pragma unroll
        for (int bj = 0; bj < 2; ++bj) {
            if (!((bjmask >> bj) & 1)) continue;
            const int cg = segbase + 128 * bj + 32 * wc + 8 * fq;
            const int fi = (ROPE == 1) ? ((cg & 63) >> 1) : ((cg & 127) >> 1);
#pragma unroll
            for (int ai = 0; ai < 2; ++ai)
#pragma unroll
                for (int m = 0; m < 4; ++m) {
                    const int row = row0 + ai * 128 + m * 16;
                    pg8::f32x4 v0 = acc[ai][bj][m][0], v1 = acc[ai][bj][m][1];
                    if (ROPE != 0) {
                        const float* tp = (ROPE == 1) ? (R64 + ((size_t)row * 32 + fi) * 2) : (R128 + ((size_t)row * 64 + fi) * 2);
                        const pg8::f32x4 t0 = *(const pg8::f32x4*)tp, t1 = *(const pg8::f32x4*)(tp + 4);
                        pg8::f32x4 o1, o2;
                        o1[0] = v0[0] * t0[0] - v1[0] * t0[1]; o2[0] = v1[0] * t0[0] + v0[0] * t0[1];
                        o1[1] = v0[1] * t0[2] - v1[1] * t0[3]; o2[1] = v1[1] * t0[2] + v0[1] * t0[3];
                        o1[2] = v0[2] * t1[0] - v1[2] * t1[1]; o2[2] = v1[2] * t1[0] + v0[2] * t1[1];
                        o1[3] = v0[3] * t1[2] - v1[3] * t1[3]; o2[3] = v1[3] * t1[2] + v0[3] * t1[3];
                        v0 = o1; v1 = o2;
                    }
                    if (ACT == 1) {
#pragma unroll
                        for (int e = 0; e < 4; ++e) { v0[e] = silu_f(v0[e]); v1[e] = silu_f(v1[e]); }
                    }
                    v0 = v0 * scale; v1 = v1 * scale;
                    u32x4 w; w.x = cvt_pk(v0[0], v0[1]); w.y = cvt_pk(v0[2], v0[3]); w.z = cvt_pk(v1[0], v1[1]); w.w = cvt_pk(v1[2], v1[3]);
                    *(u32x4*)(dst + (size_t)row * ld + cg) = w;
                }
        }
    }
    __device__ __forceinline__ void operator()(const pg8::f32x4 (&acc)[2][2][4][2], const pg8::Unit& u, int wr, int wc, int fr, int fq) const {
        const int row0 = u.pm * 256 + wr * 64 + fr;
        const int pn = u.pn;
        if (pn < 2) emit<1, 0>(acc, QA, 512, pn * 256, C2, row0, wc, fq, 3);
        else if (pn < 4) emit<1, 0>(acc, KA, 512, (pn - 2) * 256, 1.f, row0, wc, fq, 3);
        else if (pn < 6) emit<0, 0>(acc, VA, 512, (pn - 4) * 256, 1.f, row0, wc, fq, 3);
        else if (pn < 8) emit<1, 0>(acc, QI, 512, (pn - 6) * 256, 1.f, row0, wc, fq, 3);
        else if (pn == 8) {
            if (wc < 2) emit<1, 0>(acc, KI, 64, 0, 1.f, row0, wc, fq, 1);
            else if (wc == 2 && fq == 0) {
#pragma unroll
                for (int ai = 0; ai < 2; ++ai)
#pragma unroll
                    for (int m = 0; m < 4; ++m) {
                        const int row = row0 + ai * 128 + m * 16;
                        *(pg8::f32x4*)(WI + (size_t)row * 8) = acc[ai][0][m][0] * WI_SCALE;
                        *(pg8::f32x4*)(WI + (size_t)row * 8 + 4) = acc[ai][0][m][1] * WI_SCALE;
                    }
            }
        }
        else if (pn < 11) emit<2, 0>(acc, QR, 512, (pn - 9) * 256, 1.f, row0, wc, fq, 3);
        else if (pn < 13) emit<2, 0>(acc, KR, 512, (pn - 11) * 256, KR_SCALE, row0, wc, fq, 3);
        else if (pn < 15) emit<0, 0>(acc, VR, 512, (pn - 13) * 256, 1.f, row0, wc, fq, 3);
        else emit<0, 1>(acc, GR, 512, (pn - 15) * 256, 1.f, row0, wc, fq, 3);
    }
};
typedef short v4i16_t __attribute__((ext_vector_type(4)));
__device__ __forceinline__ unsigned off_b(unsigned row, unsigned ch) { return 256u * row + 16u * (ch ^ (((row & 3u) << 2) | ((row >> 2) & 3u))); }
__device__ __forceinline__ int crow(int r, int hi) { return (r & 3) + 8 * (r >> 2) + 4 * hi; }
__device__ __forceinline__ v4i16_t tr_rd(LAS unsigned char* p) { return __builtin_amdgcn_ds_read_tr16_b64_v4i16((LAS v4i16_t*)p); }
__device__ __forceinline__ bf16x8 tr_frag_nat(LAS unsigned char* img, int lane, int c, int ks) {
    const unsigned h = lane >> 5, blk = (lane >> 4) & 1, q = (lane & 15) >> 2, p = lane & 3;
    const v4i16_t lo = tr_rd(img + off_b(16 * ks + 8 * h + q, 4 * c + 2 * blk + (p >> 1)) + 8 * (p & 1));
    const v4i16_t hi = tr_rd(img + off_b(16 * ks + 8 * h + 4 + q, 4 * c + 2 * blk + (p >> 1)) + 8 * (p & 1));
    return (bf16x8){lo[0], lo[1], lo[2], lo[3], hi[0], hi[1], hi[2], hi[3]};
}
__device__ __forceinline__ bf16x8 tr_frag_acc(LAS unsigned char* img, int lane, int c, int rowbase) {
    const unsigned h = lane >> 5, blk = (lane >> 4) & 1, q = (lane & 15) >> 2, p = lane & 3;
    const v4i16_t lo = tr_rd(img + off_b(rowbase + 4 * h + q, 4 * c + 2 * blk + (p >> 1)) + 8 * (p & 1));
    const v4i16_t hi = tr_rd(img + off_b(rowbase + 8 + 4 * h + q, 4 * c + 2 * blk + (p >> 1)) + 8 * (p & 1));
    return (bf16x8){lo[0], lo[1], lo[2], lo[3], hi[0], hi[1], hi[2], hi[3]};
}
__device__ __forceinline__ float ret_lgam(int h) { return logf(1.0f - exp2f(-5.0f - (float)h)); }
template <bool SCALE> __device__ __forceinline__ void ret_stage(LAS unsigned char* img, const bf16_t* src  , float sc, int tl) {
#pragma unroll
    for (int it = 0; it < 8; ++it) {
        const int idx = tl + 256 * it, row = idx >> 4, ch = idx & 15;
        u32x4 v = *(const u32x4*)(src + (size_t)row * 512 + ch * 8);
        if (SCALE) {
            const float f = expf(sc * (float)row);
#pragma unroll
            for (int e = 0; e < 4; ++e) { const unsigned w = v[e]; v[e] = cvt_pk(__uint_as_float(w << 16) * f, __uint_as_float(w & 0xffff0000u) * f); }
        }
        *(LAS u32x4*)(img + off_b(row, ch)) = v;
    }
}
__device__ __forceinline__ void ret_kv_pair(LAS unsigned char* lds, const bf16_t* KR, const bf16_t* VR, float* KVS, int pair, int tid) {
    const int uh = tid >> 8, tl = tid & 255, lane = tid & 63, w4 = __builtin_amdgcn_readfirstlane((tid >> 6) & 3), hi = lane >> 5, r32 = lane & 31;
    const int unit = pair * 2 + uh, n = unit & 31, bh = unit >> 5, b = bh >> 2, h = bh & 3;
    const size_t tok0 = (size_t)b * S + (size_t)n * 128;
    LAS unsigned char* kimg = lds + uh * 65536; LAS unsigned char* vimg = kimg + 32768;
    const float lgam = ret_lgam(h);
    __syncthreads();
    ret_stage<false>(kimg, KR + tok0 * 512 + h * 128, 0.f, tl);
    ret_stage<true>(vimg, VR + tok0 * 512 + h * 128, -lgam, tl);
    __syncthreads();
    f32x16 acc[4];
#pragma unroll
    for (int c = 0; c < 4; ++c) acc[c] = (f32x16){};
#pragma unroll
    for (int ks = 0; ks < 8; ++ks) {
        const bf16x8 a = tr_frag_nat(vimg, lane, w4, ks);
#pragma unroll
        for (int nt = 0; nt < 4; ++nt) { const bf16x8 bb = tr_frag_nat(kimg, lane, nt, ks); acc[nt] = __builtin_amdgcn_mfma_f32_32x32x16_bf16(a, bb, acc[nt], 0, 0, 0); }
    }
    const float sc = expf(lgam * 127.f);
    float* o = KVS + (size_t)unit * 16384;
#pragma unroll
    for (int nt = 0; nt < 4; ++nt)
#pragma unroll
        for (int r = 0; r < 16; ++r) o[(32 * w4 + crow(r, hi)) * 128 + 32 * nt + r32] = acc[nt][r] * sc;
}
__device__ __forceinline__ void ret_scan(const float* __restrict__ KVS, bf16_t* __restrict__ RT, int gtid, int nthreads) {
    for (int idx = gtid; idx < 16 * 16384; idx += nthreads) {
        const int bh = idx >> 14, el = idx & 16383, h = bh & 3;
        const float g = 1.0f - exp2f(-5.0f - (float)h), g128 = expf(128.f * ret_lgam(h));
        const size_t o0 = ((size_t)(bh * 32) << 14) + el;
        float kv[31];
#pragma unroll
        for (int n = 0; n < 31; ++n) kv[n] = KVS[o0 + ((size_t)n << 14)];
        float R = 0.f;
#pragma unroll
        for (int n = 0; n < 32; ++n) {
            RT[o0 + ((size_t)n << 14)] = (bf16_t)(cvt_pk(g * R, 0.f) & 0xffffu);
            if (n < 31) R = g128 * R + kv[n];
        }
    }
}
__device__ __forceinline__ void ret_out_pair(LAS unsigned char* lds, const bf16_t* QR, const bf16_t* KR, const bf16_t* VR, const bf16_t* GR, const bf16_t* RT, bf16_t* MIXED, int pair, int tid) {
    const int uh = tid >> 8, tl = tid & 255, lane = tid & 63, w4 = __builtin_amdgcn_readfirstlane((tid >> 6) & 3), hi = lane >> 5, r32 = lane & 31;
    const int unit = pair * 2 + uh, n = unit & 31, bh = unit >> 5, b = bh >> 2, h = bh & 3;
    const size_t tok0 = (size_t)b * S + (size_t)n * 128;
    LAS unsigned char* vimg = lds + uh * 32768;
    const float lgam = ret_lgam(h);
    __syncthreads();
    ret_stage<true>(vimg, VR + tok0 * 512 + h * 128, -lgam, tl);
    __syncthreads();
    bf16x8 qf[8];
    {
        const bf16_t* qp = QR + (tok0 + 32 * w4 + r32) * 512 + h * 128 + 8 * hi;
#pragma unroll
        for (int ks = 0; ks < 8; ++ks) qf[ks] = *(const bf16x8*)(qp + 16 * ks);
    }
    f32x16 acc[4];
#pragma unroll
    for (int c = 0; c < 4; ++c) acc[c] = (f32x16){};
    if (n > 0) {
        const bf16_t* rp = RT + (size_t)unit * 16384 + r32 * 128 + 8 * hi;
#pragma unroll
        for (int c = 0; c < 4; ++c)
#pragma unroll
            for (int ks = 0; ks < 8; ++ks) { const bf16x8 a = *(const bf16x8*)(rp + c * 32 * 128 + 16 * ks); acc[c] = __builtin_amdgcn_mfma_f32_32x32x16_bf16(a, qf[ks], acc[c], 0, 0, 0); }
    }
    for (int jt = 0; jt <= w4; ++jt) {
        const bf16_t* kp = KR + (tok0 + 32 * jt + r32) * 512 + h * 128 + 8 * hi;
        f32x16 st = (f32x16){};
#pragma unroll
        for (int ks = 0; ks < 8; ++ks) { const bf16x8 kf = *(const bf16x8*)(kp + 16 * ks); st = __builtin_amdgcn_mfma_f32_32x32x16_bf16(kf, qf[ks], st, 0, 0, 0); }
        if (jt == w4) {
#pragma unroll
            for (int r = 0; r < 16; ++r) if (crow(r, hi) > r32) st[r] = 0.f;
        }
#pragma unroll
        for (int s = 0; s < 2; ++s) {
            u32x4 pw; pw.x = cvt_pk(st[8 * s + 0], st[8 * s + 1]); pw.y = cvt_pk(st[8 * s + 2], st[8 * s + 3]); pw.z = cvt_pk(st[8 * s + 4], st[8 * s + 5]); pw.w = cvt_pk(st[8 * s + 6], st[8 * s + 7]);
            const bf16x8 pb = __builtin_bit_cast(bf16x8, pw);
#pragma unroll
            for (int c = 0; c < 4; ++c) { const bf16x8 vf = tr_frag_acc(vimg, lane, c, 32 * jt + 16 * s); acc[c] = __builtin_amdgcn_mfma_f32_32x32x16_bf16(vf, pb, acc[c], 0, 0, 0); }
        }
    }
    float ss = 0.f;
#pragma unroll
    for (int c = 0; c < 4; ++c)
#pragma unroll
        for (int r = 0; r < 16; ++r) ss += acc[c][r] * acc[c][r];
    ss += __shfl_xor(ss, 32);
    const float gi = expf(lgam * (float)(32 * w4 + r32));
    const float fac = gi / sqrtf(gi * gi * ss * (1.0f / 128.f) + 1e-6f);
    const size_t tok = tok0 + 32 * w4 + r32;
    const bf16_t* gp = GR + tok * 512 + h * 128 + 4 * hi;
    bf16_t* op = MIXED + tok * 1024 + 512 + h * 128 + 4 * hi;
#pragma unroll
    for (int c = 0; c < 4; ++c)
#pragma unroll
        for (int g4 = 0; g4 < 4; ++g4) {
            const u32x2 gv = *(const u32x2*)(gp + 32 * c + 8 * g4);
            const float g0 = __uint_as_float(gv.x << 16), g1 = __uint_as_float(gv.x & 0xffff0000u), g2 = __uint_as_float(gv.y << 16), g3 = __uint_as_float(gv.y & 0xffff0000u);
            u32x2 w; w.x = cvt_pk(acc[c][4 * g4 + 0] * fac * g0, acc[c][4 * g4 + 1] * fac * g1); w.y = cvt_pk(acc[c][4 * g4 + 2] * fac * g2, acc[c][4 * g4 + 3] * fac * g3);
            *(u32x2*)(op + 32 * c + 8 * g4) = w;
        }
}
constexpr size_t WS_MIX = 17 * MiB;
constexpr size_t WS_H2 = 49 * MiB;
constexpr size_t WS_LIST = 81 * MiB;
constexpr size_t WS_HID = 85 * MiB;
constexpr size_t WS_Y = 105 * MiB;
constexpr size_t WS_HRES = 180 * MiB;
constexpr int CW_CNT = 12288;
constexpr int CW_TILE = 16384;
constexpr int TB_OFF = MISC_OFF + 64;

struct EpiStore {
    static constexpr bool PERM = true, AFTER_DRAIN = false;
    bf16_t* O; int ld;
    __device__ __forceinline__ void operator()(const pg8::f32x4 (&acc)[2][2][4][2], const pg8::Unit& u, int wr, int wc, int fr, int fq) const {
        const int row0 = u.pm * 256 + wr * 64 + fr, col0 = u.pn * 256 + wc * 32 + 8 * fq;
#pragma unroll
        for (int ai = 0; ai < 2; ++ai)
#pragma unroll
            for (int m = 0; m < 4; ++m)
#pragma unroll
                for (int bj = 0; bj < 2; ++bj) {
                    const pg8::f32x4 v0 = acc[ai][bj][m][0], v1 = acc[ai][bj][m][1];
                    u32x4 w; w.x = cvt_pk(v0[0], v0[1]); w.y = cvt_pk(v0[2], v0[3]); w.z = cvt_pk(v1[0], v1[1]); w.w = cvt_pk(v1[2], v1[3]);
                    *(u32x4*)(O + (size_t)(row0 + ai * 128 + m * 16) * ld + col0 + bj * 128) = w;
                }
    }
};
struct P6bArgs { const bf16_t* MIX; const float *x, *g_post, *g_pre2, *mod, *w_group, *b_group, *w_expert, *b_expert; float* HRES; bf16_t* H2; unsigned* cnt; u32x2* LIST; };
constexpr int P6B_NR = 4;
constexpr int RT_WL_OFF = 147456;
struct P6bW { f32x4 v[18]; };
__device__ __forceinline__ void p6b_weights_fetch(P6bW& W, const float* w_group, const float* w_expert, int tid) {
#pragma unroll
    for (int i = 0; i < 18; ++i) {
        const int idx = tid + i * NTHR, d = idx / 9, cc = idx - 9 * d;
        W.v[i] = (cc == 0) ? *(const f32x4*)(w_group + d * 4) : *(const f32x4*)(w_expert + d * 32 + 4 * (cc - 1));
    }
}
__device__ __forceinline__ void p6b_weights_store(const P6bW& W, LAS unsigned char* lds, int tid) {
    __syncthreads();
#pragma unroll
    for (int i = 0; i < 18; ++i) {
        const int idx = tid + i * NTHR, d = idx / 9, cc = idx - 9 * d, pos = ((d >> 2) & 63) + 64 * ((d & 3) + 4 * (d >> 8));
        *(LAS f32x4*)(lds + pos * 144 + 16 * cc) = W.v[i];
    }
    __syncthreads();
}
struct P6bIn { u32x2 mw[P6B_NR][4]; f32x4 xv[P6B_NR][4]; };
__device__ __forceinline__ void p6b_load_mix(P6bIn& I, const bf16_t* MIX, int gw, int lane) {
    const int m0 = gw * P6B_NR;
#pragma unroll
    for (int r = 0; r < P6B_NR; ++r)
#pragma unroll
        for (int j = 0; j < 4; ++j) I.mw[r][j] = *(const u32x2*)(MIX + (size_t)(m0 + r) * 1024 + 4 * lane + 256 * j);
}
__device__ __forceinline__ void p6b_load_x(P6bIn& I, const float* x, int gw, int lane) {
    const int m0 = gw * P6B_NR;
#pragma unroll
    for (int r = 0; r < P6B_NR; ++r)
#pragma unroll
        for (int j = 0; j < 4; ++j) I.xv[r][j] = *(const f32x4*)(x + (size_t)(m0 + r) * 1024 + 4 * lane + 256 * j);
}
__device__ __forceinline__ void p6b_norm(const P6bArgs& a, const P6bIn& I, f32x2 (&hp)[P6B_NR][8], int gw, int lane) {
    const int m0 = gw * P6B_NR, b = m0 / S;
    const float* md = a.mod + b * 6144;
    f32x4 G1[4], G2[4], SH[4];
#pragma unroll
    for (int j = 0; j < 4; ++j) {
        const int col = 4 * lane + 256 * j;
        const f32x4 gp = *(const f32x4*)(a.g_post + col), g1 = *(const f32x4*)(md + 2 * 1024 + col), g2 = *(const f32x4*)(a.g_pre2 + col), sc = *(const f32x4*)(md + 4 * 1024 + col);
        SH[j] = *(const f32x4*)(md + 3 * 1024 + col); G1[j] = g1 * gp; G2[j] = g2 * (sc + 1.0f);
    }
#pragma unroll
    for (int r = 0; r < P6B_NR; ++r) {
        const size_t row = (size_t)(m0 + r);
        float v[16]; float s = 0.f;
#pragma unroll
        for (int j = 0; j < 4; ++j) {
            const u32x2 w = I.mw[r][j];
            v[4 * j + 0] = __uint_as_float(w.x << 16); v[4 * j + 1] = __uint_as_float(w.x & 0xffff0000u); v[4 * j + 2] = __uint_as_float(w.y << 16); v[4 * j + 3] = __uint_as_float(w.y & 0xffff0000u);
#pragma unroll
            for (int k = 0; k < 4; ++k) s += v[4 * j + k] * v[4 * j + k];
        }
        const float rs = 1.0f / sqrtf(wave_sum(s) * (1.f / 1024.f) + 1e-6f);
        float s2 = 0.f;
#pragma unroll
        for (int j = 0; j < 4; ++j) {
            const int col = 4 * lane + 256 * j;
            const f32x4 xx = I.xv[r][j];
            f32x4 hr;
#pragma unroll
            for (int k = 0; k < 4; ++k) { hr[k] = xx[k] + G1[j][k] * (v[4 * j + k] * rs); v[4 * j + k] = hr[k]; s2 += hr[k] * hr[k]; }
        }
        const float rs2 = 1.0f / sqrtf(wave_sum(s2) * (1.f / 1024.f) + 1e-6f);
#pragma unroll
        for (int j = 0; j < 4; ++j) {
            const int col = 4 * lane + 256 * j;
            float h[4];
#pragma unroll
            for (int k = 0; k < 4; ++k) h[k] = (v[4 * j + k] * rs2) * G2[j][k] + SH[j][k];
            u32x2 w; w.x = cvt_pk(h[0], h[1]); w.y = cvt_pk(h[2], h[3]);
            *(u32x2*)(a.H2 + row * 1024 + col) = w;
            hp[r][2 * j + 0] = (f32x2){__uint_as_float(w.x << 16), __uint_as_float(w.x & 0xffff0000u)}; hp[r][2 * j + 1] = (f32x2){__uint_as_float(w.y << 16), __uint_as_float(w.y & 0xffff0000u)};
        }
    }
}
template <int HI> __device__ __forceinline__ void pk_fma_bcast(f32x2& acc, const f32x2 w, const f32x2 h) {
    if (HI) asm("v_pk_fma_f32 %0, %1, %2, %0 op_sel:[0,1,0] op_sel_hi:[1,1,1]" : "+v"(acc) : "v"(w), "v"(h));
    else    asm("v_pk_fma_f32 %0, %1, %2, %0 op_sel:[0,0,0] op_sel_hi:[1,0,1]" : "+v"(acc) : "v"(w), "v"(h));
}
__device__ __forceinline__ void p6b_router(const LAS unsigned char* wtab, LAS float* wl  , const f32x2 (&hp)[P6B_NR][8], int lane) {
#pragma unroll 1
    for (int c = 0; c < 9; ++c) {
        f32x2 acc[P6B_NR][2];
#pragma unroll
        for (int r = 0; r < P6B_NR; ++r) { acc[r][0] = (f32x2){0.f, 0.f}; acc[r][1] = (f32x2){0.f, 0.f}; }
#pragma unroll
        for (int j = 0; j < 4; ++j)
#pragma unroll
            for (int k = 0; k < 4; ++k) {
                const f32x4 w4 = *(const LAS f32x4*)(wtab + (lane + 64 * (k + 4 * j)) * 144 + 16 * c);
                const f32x2 wa = {w4[0], w4[1]}, wb = {w4[2], w4[3]};
#pragma unroll
                for (int r = 0; r < P6B_NR; ++r) {
                    if (k & 1) { pk_fma_bcast<1>(acc[r][0], wa, hp[r][2 * j + (k >> 1)]); pk_fma_bcast<1>(acc[r][1], wb, hp[r][2 * j + (k >> 1)]); }
                    else       { pk_fma_bcast<0>(acc[r][0], wa, hp[r][2 * j + (k >> 1)]); pk_fma_bcast<0>(acc[r][1], wb, hp[r][2 * j + (k >> 1)]); }
                }
            }
        asm volatile("s_nop 1" : "+v"(acc[0][0]), "+v"(acc[0][1]), "+v"(acc[1][0]), "+v"(acc[1][1]), "+v"(acc[2][0]), "+v"(acc[2][1]), "+v"(acc[3][0]), "+v"(acc[3][1]));
        float v[16];
#pragma unroll
        for (int r = 0; r < P6B_NR; ++r) { v[4 * r + 0] = acc[r][0][0]; v[4 * r + 1] = acc[r][0][1]; v[4 * r + 2] = acc[r][1][0]; v[4 * r + 3] = acc[r][1][1]; }
        float s8[8], t4[4];
#pragma unroll
        for (int i = 0; i < 8; ++i) { auto q = __builtin_amdgcn_permlane32_swap(__float_as_uint(v[i]), __float_as_uint(v[i + 8]), false, false); s8[i] = __uint_as_float(q[0]) + __uint_as_float(q[1]); }
#pragma unroll
        for (int i = 0; i < 4; ++i) { auto q = __builtin_amdgcn_permlane16_swap(__float_as_uint(s8[i]), __float_as_uint(s8[i + 4]), false, false); t4[i] = __uint_as_float(q[0]) + __uint_as_float(q[1]); }
#pragma unroll
        for (int i = 0; i < 4; ++i) MK_DPP_ADD(t4[i], 0x128);
        float u0 = (lane & 8) ? t4[1] : t4[0], u1 = (lane & 8) ? t4[3] : t4[2];
        MK_DPP_ADD(u0, 0x141); MK_DPP_ADD(u1, 0x141);
        float w = (lane & 4) ? u1 : u0;
        MK_DPP_ADD(w, 0x1B);
        MK_DPP_ADD(w, 0xB1);
        if ((lane & 3) == 0) wl[(lane >> 4) * 36 + 4 * c + 2 * ((lane >> 2) & 1) + ((lane >> 3) & 1)] = w;
    }
    asm volatile("s_waitcnt lgkmcnt(0)" ::: "memory");
}
__device__ __forceinline__ void p6b_route(const P6bArgs& a, const LAS float* wl, int gw, int lane) {
    const int m0 = gw * P6B_NR;
    if (lane < P6B_NR) {
        const LAS float* lg = wl + lane * 36;
        float gm = lg[0] + a.b_group[0]; int gs = 0; float l1 = lg[1] + a.b_group[1], l2 = lg[2] + a.b_group[2], l3 = lg[3] + a.b_group[3];
        const float l0 = gm;
        if (l1 > gm) { gm = l1; gs = 1; } if (l2 > gm) { gm = l2; gs = 2; } if (l3 > gm) { gm = l3; gs = 3; }
        const float gtop = 1.0f / (expf(l0 - gm) + expf(l1 - gm) + expf(l2 - gm) + expf(l3 - gm));
        float el[8];
#pragma unroll
        for (int i = 0; i < 8; ++i) el[i] = lg[4 + gs * 8 + i] + a.b_expert[gs * 8 + i];
        float b1 = el[0]; int i1 = 0;
#pragma unroll
        for (int i = 1; i < 8; ++i) if (el[i] > b1) { b1 = el[i]; i1 = i; }
        float b2 = -INFINITY; int i2 = 0;
#pragma unroll
        for (int i = 0; i < 8; ++i) if (i != i1 && el[i] > b2) { b2 = el[i]; i2 = i; }
        const float p2 = expf(b2 - b1), den = 1.0f + p2;
        const float w0 = gtop / den, w1 = gtop * p2 / den;
        const int e0 = gs * 8 + i1, e1 = gs * 8 + i2;
        const unsigned tok = (unsigned)(m0 + lane);
        const unsigned pos0 = atomicAdd(a.cnt + 64 * e0, 1u), pos1 = atomicAdd(a.cnt + 64 * e1, 1u);
        a.LIST[(size_t)e0 * 16384 + pos0] = (u32x2){tok, __float_as_uint(w0)};
        a.LIST[(size_t)e1 * 16384 + pos1] = (u32x2){tok | 0x80000000u, __float_as_uint(w1)};
    }
}
__device__ __forceinline__ void p6b_rows(const P6bArgs& a, P6bIn& I, const LAS unsigned char* wtab, LAS float* wl, int gw0, int stride, int lane, bool dry) {
    constexpr int NG = T / P6B_NR;
    if (gw0 >= NG) return;
    f32x2 hp[P6B_NR][8];
#pragma unroll 1
    for (int gw = gw0; gw < NG; gw += stride) {
        p6b_norm(a, I, hp, gw, lane);
        if (gw + stride < NG) { p6b_load_mix(I, a.MIX, gw + stride, lane); p6b_load_x(I, a.x, gw + stride, lane); }
        p6b_router(wtab, wl, hp, lane);
        if (!dry) p6b_route(a, wl, gw, lane);
    }
}
template <int ROLE> struct MoeSched {
    const u32x2* LIST; LAS int* tb; int G, c, NJ;
    unsigned* tilecnt;
    unsigned* tmo;
    int tlo, thi;
    __device__ __forceinline__ bool next(int i, pg8::Unit& u) const {
        if (c < 0) return false;
        const int L = i * G + c, TT = (thi < tb[32]) ? thi : tb[32];
        const int tg = tlo + L / NJ, j = L % NJ;
        if (tg >= TT) return false;
        int e = 0;
#pragma unroll 1
        for (int k = 1; k < 32; ++k) e += (tb[k] <= tg) ? 1 : 0;
        u.pm = tg; u.pn = e * NJ + j; return true;
    }
    __device__ __forceinline__ int arow(const pg8::Unit& u, int r) const {
        const int e = u.pn / NJ, idx = (u.pm - tb[e]) * 256 + r;
        return (idx < tb[33 + e]) ? (int)(LIST[(size_t)e * 16384 + idx].x & 0x7fffffffu) : 0;
    }
    __device__ __forceinline__ void a_ready(const pg8::Unit&) const {}
    __device__ __forceinline__ void done(const pg8::Unit& u) const {
        if (ROLE != 1) return;
        asm volatile("s_waitcnt vmcnt(0)" ::: "memory");
        if (mk_lane() == 0) __hip_atomic_fetch_add(tilecnt + 64 * u.pm, 1u, __ATOMIC_RELAXED, __HIP_MEMORY_SCOPE_AGENT);
    }
};
__device__ __forceinline__ void moe_wait(const MoeSched<2>& S) {
    if (mk_wave() == 0) {
        pg8::Unit u;
        for (int i = 0; S.next(i, u); ++i) {
            unsigned sp = 0;
            while ((unsigned)__builtin_amdgcn_readfirstlane(__hip_atomic_load(S.tilecnt + 64 * u.pm, __ATOMIC_RELAXED, __HIP_MEMORY_SCOPE_AGENT)) < 16u) {
                __builtin_amdgcn_s_sleep(2);
                if (++sp > (1u << 22)) { __hip_atomic_store(S.tmo, 1u, __ATOMIC_RELAXED, __HIP_MEMORY_SCOPE_AGENT); break; }
            }
        }
        __builtin_amdgcn_fence(__ATOMIC_ACQUIRE, "agent");
        asm volatile("s_waitcnt vmcnt(0)" ::: "memory");
    }
    __syncthreads();
}
__device__ __forceinline__ void moe_table(LAS int* tb, const unsigned* cnt, int tid) {
    __syncthreads();
    if (tid < 32) tb[33 + tid] = (int)__hip_atomic_load(cnt + 64 * tid, __ATOMIC_RELAXED, __HIP_MEMORY_SCOPE_AGENT);
    __syncthreads();
    if (tid == 0) { int s = 0; for (int e = 0; e < 32; ++e) { tb[e] = s; s += (tb[33 + e] + 255) >> 8; } tb[32] = s; }
    __syncthreads();
}
struct EpiGU {
    static constexpr bool PERM = true, AFTER_DRAIN = false;
    bf16_t* HID;
    __device__ __forceinline__ void operator()(const pg8::f32x4 (&acc)[2][2][4][2], const pg8::Unit& u, int wr, int wc, int fr, int fq) const {
        const int row0 = u.pm * 256 + wr * 64 + fr, hc0 = (u.pn & 1) * 128 + 16 * wc + 4 * fq;
#pragma unroll
        for (int ai = 0; ai < 2; ++ai)
#pragma unroll
            for (int m = 0; m < 4; ++m)
#pragma unroll
                for (int bj = 0; bj < 2; ++bj) {
                    const pg8::f32x4 g = acc[ai][bj][m][0], up = acc[ai][bj][m][1];
                    u32x2 w; w.x = cvt_pk(silu_f(g[0]) * up[0], silu_f(g[1]) * up[1]); w.y = cvt_pk(silu_f(g[2]) * up[2], silu_f(g[3]) * up[3]);
                    __hip_atomic_store((unsigned long long*)(HID + (size_t)(row0 + ai * 128 + m * 16) * 256 + hc0 + bj * 64), (unsigned long long)w.x | ((unsigned long long)w.y << 32), __ATOMIC_RELAXED, __HIP_MEMORY_SCOPE_AGENT);
                }
    }
};
struct EpiDown {
    static constexpr bool PERM = true, AFTER_DRAIN = false;
    bf16_t* Y; const u32x2* LIST; LAS int* tb;
    __device__ __forceinline__ void operator()(const pg8::f32x4 (&acc)[2][2][4][2], const pg8::Unit& u, int wr, int wc, int fr, int fq) const {
        const int e = u.pn >> 2, j = u.pn & 3, ti = u.pm - tb[e], cn = tb[33 + e];
        const int col0 = 256 * j + 32 * wc + 8 * fq;
        const int idx0 = ti * 256 + wr * 64 + fr;
#pragma unroll
        for (int ai = 0; ai < 2; ++ai) {
            u32x2 ent[4];
#pragma unroll
            for (int m = 0; m < 4; ++m) { const int idx = idx0 + ai * 128 + m * 16; ent[m] = (idx < cn) ? LIST[(size_t)e * 16384 + idx] : (u32x2){0xffffffffu, 0u}; }
#pragma unroll
            for (int m = 0; m < 4; ++m) {
                const u32x2 en = ent[m];
                if (en.x != 0xffffffffu) {
                    const float w = __uint_as_float(en.y);
                    bf16_t* dst = Y + ((size_t)(en.x >> 31) * T + (en.x & 0x7fffffffu)) * 1024 + col0;
#pragma unroll
                    for (int bj = 0; bj < 2; ++bj) {
                        const pg8::f32x4 v0 = acc[ai][bj][m][0] * w, v1 = acc[ai][bj][m][1] * w;
                        u32x4 o; o.x = cvt_pk(v0[0], v0[1]); o.y = cvt_pk(v0[2], v0[3]); o.z = cvt_pk(v1[0], v1[1]); o.w = cvt_pk(v1[2], v1[3]);
                        *(u32x4*)(dst + bj * 128) = o;
                    }
                }
            }
            asm volatile("" ::: "memory");
        }
    }
};
struct P8Row { u32x2 w0[4], w1[4], wm[4]; f32x4 xx[4]; };
__device__ __forceinline__ void p8_row_load(P8Row& R, const bf16_t* Y, const bf16_t* MIX, const float* x, int m, int lane) {
#pragma unroll
    for (int j = 0; j < 4; ++j) {
        R.w0[j] = *(const u32x2*)(Y + (size_t)m * 1024 + 4 * lane + 256 * j); R.w1[j] = *(const u32x2*)(Y + ((size_t)T + m) * 1024 + 4 * lane + 256 * j);
        R.wm[j] = *(const u32x2*)(MIX + (size_t)m * 1024 + 4 * lane + 256 * j);
    }
#pragma unroll
    for (int j = 0; j < 4; ++j) R.xx[j] = *(const f32x4*)(x + (size_t)m * 1024 + 4 * lane + 256 * j);
}
__device__ __forceinline__ void p8_rows(const bf16_t* Y, const bf16_t* MIX, const float* x, const float* g_post_mix, const float* g_post, const float* mod, float* out, int gw, int NGW, int lane) {
#pragma unroll 1
    for (int m0 = gw * 8; m0 < T; m0 += NGW * 8) {
        P8Row C, Rn;
        p8_row_load(C, Y, MIX, x, m0, lane);
        const float* md = mod + (m0 / S) * 6144;
        f32x4 GA[4], GB[4];
#pragma unroll
        for (int j = 0; j < 4; ++j) {
            const int col = 4 * lane + 256 * j;
            const f32x4 gpm = *(const f32x4*)(g_post_mix + col), g1 = *(const f32x4*)(md + 2 * 1024 + col), gp = *(const f32x4*)(g_post + col), gg = *(const f32x4*)(md + 5 * 1024 + col);
            GA[j] = g1 * gpm; GB[j] = gg * gp;
        }
#pragma unroll 1
        for (int i = 0; i < 8; ++i) {
            if (i + 1 < 8) p8_row_load(Rn, Y, MIX, x, m0 + i + 1, lane);
            const int m = m0 + i;
            float v[16], mx[16]; float s = 0.f, sm = 0.f;
#pragma unroll
            for (int j = 0; j < 4; ++j) {
                const u32x2 w0 = C.w0[j], w1 = C.w1[j], wm = C.wm[j];
                v[4 * j + 0] = __uint_as_float(w0.x << 16) + __uint_as_float(w1.x << 16); v[4 * j + 1] = __uint_as_float(w0.x & 0xffff0000u) + __uint_as_float(w1.x & 0xffff0000u);
                v[4 * j + 2] = __uint_as_float(w0.y << 16) + __uint_as_float(w1.y << 16); v[4 * j + 3] = __uint_as_float(w0.y & 0xffff0000u) + __uint_as_float(w1.y & 0xffff0000u);
                mx[4 * j + 0] = __uint_as_float(wm.x << 16); mx[4 * j + 1] = __uint_as_float(wm.x & 0xffff0000u); mx[4 * j + 2] = __uint_as_float(wm.y << 16); mx[4 * j + 3] = __uint_as_float(wm.y & 0xffff0000u);
#pragma unroll
                for (int k = 0; k < 4; ++k) { s += v[4 * j + k] * v[4 * j + k]; sm += mx[4 * j + k] * mx[4 * j + k]; }
            }
            const float rs = 1.0f / sqrtf(wave_sum(s) * (1.f / 1024.f) + 1e-6f), rsm = 1.0f / sqrtf(wave_sum(sm) * (1.f / 1024.f) + 1e-6f);
#pragma unroll
            for (int j = 0; j < 4; ++j) {
                const f32x4 xx = C.xx[j];
                f32x4 o;
#pragma unroll
                for (int k = 0; k < 4; ++k) { const float hr = xx[k] + GA[j][k] * (mx[4 * j + k] * rsm); o[k] = hr + GB[j][k] * (v[4 * j + k] * rs); }
                *(f32x4*)(out + (size_t)m * 1024 + 4 * lane + 256 * j) = o;
            }
            if (i + 1 < 8) C = Rn;
        }
    }
}
constexpr size_t SC_BSTRIDE = (size_t)4096 * 64 * 65 / 2;
constexpr int SC_CHUNK = 8;
constexpr int SC_NUNITS = 4 * (1 * 8 + 2 * 8 + 3 * 8 + 4 * 8 + 5 * 8 + 6 * 8 + 7 * 8 + 8 * 8);
__device__ __forceinline__ size_t sc_off(int b, int qb) { return (size_t)b * SC_BSTRIDE + (size_t)4096 * (qb * (qb + 1) / 2); }
__device__ __forceinline__ void sc_build_units(unsigned* tab) {
    int n = 0;
    for (int pass = 0; pass < 2; ++pass)
        for (int sz = SC_CHUNK; sz >= 1; --sz)
            for (int b = 0; b < 4; ++b)
                for (int qb = 0; qb < 64; ++qb) {
                    const int nt = qb + 1, nc = (nt + SC_CHUNK - 1) / SC_CHUNK;
                    for (int c = 0; c < nc; ++c) {
                        const int t0 = c * SC_CHUNK, cnt = (nt - t0 < SC_CHUNK) ? nt - t0 : SC_CHUNK;
                        const bool full = (cnt == SC_CHUNK);
                        if ((pass == 0 && full && sz == SC_CHUNK) || (pass == 1 && !full && cnt == sz)) tab[n++] = (unsigned)b | ((unsigned)qb << 2) | ((unsigned)c << 8) | ((unsigned)cnt << 12);
                    }
                }
}
__device__ __forceinline__ unsigned key16_of(float sc) { sc += 0.0f; const unsigned u = __float_as_uint(sc); return ((u & 0x80000000u) ? ~u : (u | 0x80000000u)) >> 16; }
__device__ __forceinline__ void sc_decode(unsigned u, int& b, int& qb, int& c, int& nt) {
    b = u & 3; const int v = u >> 2;
    if (v < 232) { c = 0; int base = 0; while (v >= base + (57 - 8 * c)) { base += 57 - 8 * c; ++c; } qb = 8 * c + 7 + (v - base); nt = 8; }
    else { const int p = v - 232, size = 7 - (p >> 3); c = p & 7; qb = 8 * c + size - 1; nt = size; }
}
struct ScStage { u32x4 v[8]; };
__device__ __forceinline__ void sc_stage_load(ScStage& st, const bf16_t* KI, int b, int c, int nt, int tid) {
    const bf16_t* kbase = KI + ((size_t)b * S + (size_t)c * SC_CHUNK * 64 + (tid >> 3)) * 64 + (tid & 7) * 8;
#pragma unroll
    for (int t = 0; t < 8; ++t) if (t < nt) st.v[t] = *(const u32x4*)(kbase + (size_t)t * 64 * 64);
}
__device__ __forceinline__ void sc_stage_store(const ScStage& st, LAS unsigned char* buf, int nt, int tid) {
    const int skey = tid >> 3, sch = tid & 7;
    const unsigned st_off = (unsigned)(skey * 128 + ((sch ^ (skey & 7)) * 16));
#pragma unroll
    for (int t = 0; t < 8; ++t) if (t < nt) *(LAS u32x4*)(buf + t * 8192 + st_off) = st.v[t];
}
__device__ __forceinline__ void sc_compute(const LAS unsigned char* buf, const bf16_t* QI, const float* WI, unsigned short* SC, int b, int qb, int c, int ntile, int tid) {
    const int lane = tid & 63, w = __builtin_amdgcn_readfirstlane(tid >> 6), hh = lane >> 5, n32 = lane & 31;
    const int L = 64 * (qb + 1);
    const size_t tokq0 = (size_t)b * S + 64 * qb + 8 * w;
    bf16x8 af[2][4]; float wv[2][2][8];
    {
        const int u = 2 * ((n32 >> 2) & 1) + (n32 >> 4), h = (n32 & 3) + 4 * ((n32 >> 3) & 1);
#pragma unroll
        for (int mt = 0; mt < 2; ++mt) {
            const bf16_t* qp = QI + (tokq0 + 4 * mt + u) * 512 + h * 64 + 8 * hh;
#pragma unroll
            for (int ks = 0; ks < 4; ++ks) af[mt][ks] = *(const bf16x8*)(qp + 16 * ks);
#pragma unroll
            for (int j = 0; j < 2; ++j) {
                const float* wp = WI + (tokq0 + 4 * mt + 2 * hh + j) * 8;
                const f32x4 w0 = *(const f32x4*)wp, w1 = *(const f32x4*)(wp + 4);
                wv[mt][j][0] = w0[0]; wv[mt][j][1] = w0[1]; wv[mt][j][2] = w0[2]; wv[mt][j][3] = w0[3]; wv[mt][j][4] = w1[0]; wv[mt][j][5] = w1[1]; wv[mt][j][6] = w1[2]; wv[mt][j][7] = w1[3];
            }
        }
    }
    unsigned short* srow = SC + sc_off(b, qb) + (size_t)(8 * w) * L;
#pragma unroll 1
    for (int t = 0; t < ntile; ++t) {
        const LAS unsigned char* tb_ = buf + t * 8192;
        const int s0 = (c * SC_CHUNK + t) * 64;
#pragma unroll
        for (int nt = 0; nt < 2; ++nt) {
            bf16x8 bfr[4];
            const int key = 32 * nt + n32;
#pragma unroll
            for (int ks = 0; ks < 4; ++ks) bfr[ks] = *(const LAS bf16x8*)(tb_ + key * 128 + (((2 * ks + hh) ^ (key & 7)) * 16));
#pragma unroll
            for (int mt = 0; mt < 2; ++mt) {
                f32x16 acc = (f32x16){};
#pragma unroll
                for (int ks = 0; ks < 4; ++ks) acc = __builtin_amdgcn_mfma_f32_32x32x16_bf16(af[mt][ks], bfr[ks], acc, 0, 0, 0);
#pragma unroll
                for (int j = 0; j < 2; ++j) {
                    float sc = 0.f;
#pragma unroll
                    for (int h = 0; h < 8; ++h) { const int xi = (int)__float_as_uint(acc[8 * j + h]); sc = __builtin_fmaf(wv[mt][j][h], __uint_as_float((unsigned)(xi > 0 ? xi : 0)), sc); }
                    asm volatile("" : "+v"(sc));
                    srow[(size_t)(4 * mt + 2 * hh + j) * L + s0 + key] = (unsigned short)key16_of(sc);
                }
            }
        }
    }
}
__device__ __forceinline__ void sc_phase(LAS unsigned char* lds, volatile LAS unsigned* qslot, unsigned* qhead, const bf16_t* QI, const bf16_t* KI, const float* WI, unsigned short* SC, int tid) {
    __syncthreads();
    if (tid == 0) qslot[0] = atomicAdd(qhead, 1u);
    __syncthreads();
    unsigned ucur = qslot[0];
    if (ucur >= (unsigned)SC_NUNITS) return;
    int b, qb, c, nt; sc_decode(ucur, b, qb, c, nt);
    ScStage st;
    sc_stage_load(st, KI, b, c, nt, tid);
    sc_stage_store(st, lds, nt, tid);
    int p = 0;
    for (;;) {
        __syncthreads();
        if (tid == 0) qslot[0] = atomicAdd(qhead, 1u);
        __syncthreads();
        const unsigned unext = qslot[0];
        const bool has = unext < (unsigned)SC_NUNITS;
        int b2 = 0, qb2 = 0, c2 = 0, nt2 = 0;
        if (has) { sc_decode(unext, b2, qb2, c2, nt2); sc_stage_load(st, KI, b2, c2, nt2, tid); }
        sc_compute(lds + p * 65536, QI, WI, SC, b, qb, c, nt, tid);
        if (!has) break;
        sc_stage_store(st, lds + (p ^ 1) * 65536, nt2, tid);
        b = b2; qb = qb2; c = c2; nt = nt2; p ^= 1;
    }
}
__device__ __forceinline__ unsigned wave_sum_u32(unsigned x) {
    x += (unsigned)__builtin_amdgcn_update_dpp(0, (int)x, 0xB1, 0xf, 0xf, false);
    x += (unsigned)__builtin_amdgcn_update_dpp(0, (int)x, 0x4E, 0xf, 0xf, false);
    x += (unsigned)__builtin_amdgcn_update_dpp(0, (int)x, 0x141, 0xf, 0xf, false);
    x += (unsigned)__builtin_amdgcn_update_dpp(0, (int)x, 0x140, 0xf, 0xf, false);
    return (unsigned)__builtin_amdgcn_readlane((int)x, 0) + (unsigned)__builtin_amdgcn_readlane((int)x, 16) + (unsigned)__builtin_amdgcn_readlane((int)x, 32) + (unsigned)__builtin_amdgcn_readlane((int)x, 48);
}
__device__ __forceinline__ unsigned pk_subsat(unsigned w, unsigned c) { unsigned d; asm("v_pk_sub_u16 %0, %1, %2 clamp" : "=v"(d) : "v"(w), "v"(c)); return d; }
__device__ __forceinline__ unsigned pk_min(unsigned a, unsigned b) { unsigned d; asm("v_pk_min_u16 %0, %1, %2" : "=v"(d) : "v"(a), "v"(b)); return d; }
__device__ __forceinline__ unsigned pk_add(unsigned a, unsigned b) { unsigned d; asm("v_pk_add_u16 %0, %1, %2" : "=v"(d) : "v"(a), "v"(b)); return d; }
template <int NW> __device__ __forceinline__ unsigned cnt_ge(const unsigned (&kw)[32], unsigned cm1) {
    const unsigned one = 0x00010001u;
    unsigned a0 = 0u, a1 = 0u, a2 = 0u, a3 = 0u;
#pragma unroll
    for (int j = 0; j < NW; j += 4) {
        a0 = pk_add(a0, pk_min(pk_subsat(kw[j], cm1), one)); a1 = pk_add(a1, pk_min(pk_subsat(kw[j + 1], cm1), one));
        a2 = pk_add(a2, pk_min(pk_subsat(kw[j + 2], cm1), one)); a3 = pk_add(a3, pk_min(pk_subsat(kw[j + 3], cm1), one));
    }
    const unsigned a = pk_add(pk_add(a0, a1), pk_add(a2, a3));
    return wave_sum_u32((a & 0xffffu) + (a >> 16));
}
__device__ __forceinline__ unsigned pk_max(unsigned a, unsigned b) { unsigned d; asm("v_pk_max_u16 %0, %1, %2" : "=v"(d) : "v"(a), "v"(b)); return d; }
__device__ __forceinline__ unsigned wave_max_u32(unsigned x) {
    x = max(x, (unsigned)__builtin_amdgcn_update_dpp(0, (int)x, 0xB1, 0xf, 0xf, false));
    x = max(x, (unsigned)__builtin_amdgcn_update_dpp(0, (int)x, 0x4E, 0xf, 0xf, false));
    x = max(x, (unsigned)__builtin_amdgcn_update_dpp(0, (int)x, 0x141, 0xf, 0xf, false));
    x = max(x, (unsigned)__builtin_amdgcn_update_dpp(0, (int)x, 0x140, 0xf, 0xf, false));
    return max(max((unsigned)__builtin_amdgcn_readlane((int)x, 0), (unsigned)__builtin_amdgcn_readlane((int)x, 16)), max((unsigned)__builtin_amdgcn_readlane((int)x, 32), (unsigned)__builtin_amdgcn_readlane((int)x, 48)));
}
template <int NW> __device__ __forceinline__ unsigned sel_query(const unsigned (&kw)[32], int lane) {
    unsigned mx = 0u;
#pragma unroll
    for (int j = 0; j < NW; ++j) mx = pk_max(mx, kw[j]);
    unsigned hi = wave_max_u32(max(mx & 0xffffu, mx >> 16)) + 1u;
    unsigned width = 384u, lo = (hi > width) ? hi - width : 1u;
#pragma unroll 1
    while (cnt_ge<NW>(kw, (lo - 1u) * 0x00010001u) < 256u) { hi = lo; width *= 8u; lo = (hi > width) ? hi - width : 1u; }
#pragma unroll 1
    while (hi - lo > 1u) {
        const unsigned mid = (lo + hi) >> 1;
        if (cnt_ge<NW>(kw, (mid - 1u) * 0x00010001u) >= 256u) lo = mid; else hi = mid;
    }
    const unsigned T = lo;
    const unsigned need = 256u - cnt_ge<NW>(kw, T * 0x00010001u);
    unsigned run = 0u, cidx = 0xffffu; bool found = false;
#pragma unroll
    for (int j = 0; j < NW; ++j) {
        if (!found) {
            const bool e0 = (kw[j] & 0xffffu) == T, e1 = (kw[j] >> 16) == T;
            const unsigned long long m0 = __ballot(e0), m1 = __ballot(e1);
            const unsigned cm = (unsigned)__builtin_popcountll(m0) + (unsigned)__builtin_popcountll(m1);
            if (run + cm >= need) {
                const unsigned rank = __builtin_amdgcn_mbcnt_hi((unsigned)(m0 >> 32), __builtin_amdgcn_mbcnt_lo((unsigned)m0, 0u)) + __builtin_amdgcn_mbcnt_hi((unsigned)(m1 >> 32), __builtin_amdgcn_mbcnt_lo((unsigned)m1, 0u));
                const unsigned tg = need - run - 1u;
                const unsigned long long h0 = __ballot(e0 && rank == tg), h1 = __ballot(e1 && rank + (e0 ? 1u : 0u) == tg);
                cidx = (unsigned)(128 * j) + (h0 ? 2u * (unsigned)__builtin_ctzll(h0) : 2u * (unsigned)__builtin_ctzll(h1) + 1u);
                found = true;
            }
            run += cm;
        }
    }
    return T | (cidx << 16);
}
template <int NW> __device__ __forceinline__ unsigned sel_row(const unsigned* row32, int n, int lane) {
    unsigned kw[32];
#pragma unroll
    for (int j = 0; j < 32; ++j) {
        unsigned v = 0u;
        if (j < NW) { const int s = 128 * j + 2 * lane; v = (s < n) ? row32[64 * j + lane] : 0u; if (s + 1 >= n) v &= 0xffffu; }
        kw[j] = v;
    }
    return sel_query<NW>(kw, lane);
}
__device__ __forceinline__ void sel_block(LAS unsigned char* lds, const unsigned short* SC, unsigned* THR, unsigned* MASKT, int blk, int tid, int mode = 3) {
    const int b = blk >> 6, qb = blk & 63, lane = tid & 63, w = __builtin_amdgcn_readfirstlane(tid >> 6);
    const int L = 64 * (qb + 1);
    const unsigned short* slab = SC + sc_off(b, qb);
    LAS unsigned* thr_l = (LAS unsigned*)lds;
    __syncthreads();
    if (mode & 1)
#pragma unroll 1
    for (int qi = 0; qi < 8; ++qi) {
        const int ql = 8 * w + qi, tq = 64 * qb + ql, n = tq + 1;
        const unsigned short* row = slab + (size_t)ql * L;
        const int nw = (n + 127) >> 7;
        const unsigned* row32 = (const unsigned*)row;
        unsigned th = 0u;
        if (n > 256) { if (nw <= 8) th = sel_row<8>(row32, n, lane); else if (nw <= 16) th = sel_row<16>(row32, n, lane); else if (nw <= 24) th = sel_row<24>(row32, n, lane); else th = sel_row<32>(row32, n, lane); }
        if (lane == 0) { thr_l[ql] = th; THR[(size_t)b * S + tq] = th; }
    }
    __syncthreads();
    const int ntl = 4 * ((2 * qb) >> 3) + 4;
    if (mode & 2)
    for (int it = w; it < 2 * ntl; it += NWAVES) {
        const int g = it / ntl, t = it - g * ntl, qg = 2 * qb + g;
        unsigned W = 0u;
        if (t <= qb) {
            const int ii = lane & 15, cc = (lane >> 4) & 1, hh = lane >> 5;
            const int s = 64 * t + 32 * cc + (ii & 3) + 8 * (ii >> 2) + 4 * hh;
            unsigned kk[32];
#pragma unroll
            for (int q = 0; q < 32; ++q) kk[q] = (unsigned)slab[(size_t)(32 * g + q) * L + s];
#pragma unroll
            for (int q = 0; q < 32; ++q) {
                const int ql = 32 * g + q, tq = 64 * qb + ql;
                const unsigned th = thr_l[ql], T = th & 0xffffu, cidx = th >> 16;
                const unsigned k = kk[q];
                const bool p = (s <= tq) && (k > T || (k == T && (unsigned)s <= cidx));
                const unsigned long long m = __ballot(p);
                W = (lane == q) ? (unsigned)m : ((lane == 32 + q) ? (unsigned)(m >> 32) : W);
            }
        }
        MASKT[(((size_t)b * 128 + qg) * 64 + t) * 64 + lane] = W;
    }
}

__device__ __forceinline__ void sel_queries_balanced(const unsigned short* SC, unsigned* THR, int gw, int lane) {
#pragma unroll 1
    for (int k = 0; k < 8; ++k) {
        const int b = k >> 1, tq = (k & 1) ? (S - 1 - gw) : gw, n = tq + 1, qb = tq >> 6, L = 64 * (qb + 1);
        const unsigned* row32 = (const unsigned*)(SC + sc_off(b, qb) + (size_t)(tq & 63) * L);
        const int nw = (n + 127) >> 7;
        unsigned th = 0u;
        if (n > 256) { if (nw <= 8) th = sel_row<8>(row32, n, lane); else if (nw <= 16) th = sel_row<16>(row32, n, lane); else if (nw <= 24) th = sel_row<24>(row32, n, lane); else th = sel_row<32>(row32, n, lane); }
        if (lane == 0) THR[(size_t)b * S + tq] = th;
    }
}
constexpr int MSK_PER_B = 4352, MSK_UNITS = 4 * MSK_PER_B;
struct MskUnit { int b, qg, t; unsigned thv; unsigned kk[32]; };
__device__ __forceinline__ void mask_unit_load(MskUnit& m, const unsigned short* SC, const unsigned* THR, int u, int lane) {
    m.b = u / MSK_PER_B; const int v = u - m.b * MSK_PER_B;
    int g8 = 0;
#pragma unroll 1
    for (int j = 1; j < 16; ++j) g8 += (16 * j * (j + 1) <= v) ? 1 : 0;
    const int rem = v - 16 * g8 * (g8 + 1), per = 4 * g8 + 4, q7 = rem / per;
    m.t = rem - q7 * per; m.qg = 8 * g8 + q7;
    const int qb = m.qg >> 1, g = m.qg & 1;
    if (m.t <= qb) {
        const int L = 64 * (qb + 1);
        const unsigned short* slab = SC + sc_off(m.b, qb);
        const int ii = lane & 15, cc = (lane >> 4) & 1, hh = lane >> 5;
        const int s = 64 * m.t + 32 * cc + (ii & 3) + 8 * (ii >> 2) + 4 * hh;
        m.thv = THR[(size_t)m.b * S + 32 * m.qg + (lane & 31)];
#pragma unroll
        for (int q = 0; q < 32; ++q) m.kk[q] = (unsigned)slab[(size_t)(32 * g + q) * L + s];
    }
}
__device__ __forceinline__ void mask_unit_emit(const MskUnit& m, unsigned* MASKT, int lane) {
    const int qb = m.qg >> 1;
    unsigned W = 0u;
    if (m.t <= qb) {
        const int ii = lane & 15, cc = (lane >> 4) & 1, hh = lane >> 5;
        const int s = 64 * m.t + 32 * cc + (ii & 3) + 8 * (ii >> 2) + 4 * hh;
#pragma unroll
        for (int q = 0; q < 32; ++q) {
            const int tq = 32 * m.qg + q;
            const unsigned th = (unsigned)__builtin_amdgcn_readlane((int)m.thv, q), T = th & 0xffffu, cidx = th >> 16;
            const unsigned k = m.kk[q];
            const bool p = (s <= tq) && (k > T || (k == T && (unsigned)s <= cidx));
            const unsigned long long mm = __ballot(p);
            W = (lane == q) ? (unsigned)mm : ((lane == 32 + q) ? (unsigned)(mm >> 32) : W);
        }
    }
    MASKT[(((size_t)m.b * 128 + m.qg) * 64 + m.t) * 64 + lane] = W;
}
__device__ __forceinline__ void mask_units(const unsigned short* SC, const unsigned* THR, unsigned* MASKT, int u0, int stride, int lane) {
    if (u0 >= MSK_UNITS) return;
    MskUnit a, bnext;
    mask_unit_load(a, SC, THR, u0, lane);
#pragma unroll 1
    for (int u = u0; u < MSK_UNITS; u += stride) {
        const bool has = u + stride < MSK_UNITS;
        if (has) mask_unit_load(bnext, SC, THR, u + stride, lane);
        mask_unit_emit(a, MASKT, lane);
        if (has) a = bnext;
    }
}
struct Args { const void* in[18]; float* out; unsigned char* ws; int ph_lo, ph_hi, li, pad; };
constexpr int N_PHASES = 12;
__global__ void __launch_bounds__(NTHR, 2) mega(Args args) {
    extern __shared__ __attribute__((aligned(16))) unsigned char lds_raw[];
    LAS unsigned char* lds = (LAS unsigned char*)lds_raw;
    const int G = gridDim.x, bid = blockIdx.x;
#define MK_IDS() const int wave = mk_wave(), lane = mk_lane(), tid = wave * 64 + lane; (void)lane; (void)tid; (void)wave
    unsigned char* ws = args.ws;
    unsigned* ctl = (unsigned*)(ws + WS_CTL);
    volatile LAS unsigned* MISC = (volatile LAS unsigned*)(lds + MISC_OFF);
    { const int t0 = (int)threadIdx.x;
      for (int u = t0; u < (LDS_BYTES - RING_BYTES) / 4; u += NTHR) ((LAS unsigned*)(lds + RING_BYTES))[u] = 0u;
      __syncthreads();
      if ((t0 & 63) == 0) ((LAS unsigned char*)(lds + MK_SLOTMAP_OFF))[mk_hwslot()] = (unsigned char)(t0 >> 6); }
    __syncthreads();
    XcdBarrier bar = xcd_barrier_post(ctl + CW_BAR + args.li * XCD_BAR_WORDS, MISC + 8);
    const int lo = args.ph_lo, hi = args.ph_hi;
#ifndef DUP_MASK
#define DUP_MASK 0
#endif
#define REP(k) for (int rep_ = 0; rep_ < (((DUP_MASK) >> (k)) & 1) + 1; ++rep_)
#define IN(k) (lo <= (k) && (k) < hi)
#define BOTH(k) (IN(k) && IN((k) + 1))
    const float* x = (const float*)args.in[0];
    float* mod = (float*)(ws + WS_MOD);
    bf16_t* Hb = (bf16_t*)(ws + WS_H);
    bf16_t* WIN = (bf16_t*)(ws + WS_WIN);
    bf16_t* WOUT = (bf16_t*)(ws + WS_WOUT);
    float* R128 = (float*)(ws + WS_R128);
    float* R64 = (float*)(ws + WS_R64);
    bf16_t* WGU = (bf16_t*)args.out; bf16_t* WD = WGU + (size_t)32 * 512 * 1024;

    const P0Args p0a{(const float*)args.in[1], (const float*)args.in[4], (const float*)args.in[5], (const float*)args.in[6], (const float*)args.in[7], (const float*)args.in[14], (const float*)args.in[15], (const float*)args.in[16],
                 (const int*)args.in[2], mod, R128, R64, WIN, WOUT, WGU, WD};
    if (IN(0)) {
        MK_IDS();
        REP(0) p0_prologue(lds, p0a, bid, G, tid);
        if (BOTH(0)) xcd_barrier(bar);
    }
    if (IN(1)) {
        MK_IDS();
        REP(1) p1_rows(x, (const float*)args.in[3], mod, Hb, bid * NWAVES + wave, G * NWAVES, lane);
        if ((DUP_MASK >> 15) & 1) { for (int k = 0; k < 10; ++k) xcd_barrier(bar); }
        if (BOTH(1)) xcd_barrier(bar);
    }
    if (IN(2)) {
        MK_IDS();
#ifdef PROBE_SKIP_TILE8
        struct Skip8 : pg8::StaticOrder { __device__ bool next(int i, pg8::Unit& u) const { if (!pg8::StaticOrder::next(i, u)) return false; if (u.pn >= 8) ++u.pn; return true; } };
        pg8::Gemm g{Hb, WIN, T, NPHYS, 1024}; Skip8 So; So.init(T, NPHYS - 256, G, bid);
#define PG8_P2_SCHED Skip8
#else
        pg8::Gemm g{Hb, WIN, T, NPHYS, 1024}; pg8::StaticOrder So; So.init(T, NPHYS, G, bid);
#define PG8_P2_SCHED pg8::StaticOrder
#endif
        EpiInProj E{(bf16_t*)(ws + WS_QA), (bf16_t*)(ws + WS_KA), (bf16_t*)(ws + WS_VA), (bf16_t*)(ws + WS_QI), (bf16_t*)(ws + WS_KI), (bf16_t*)(ws + WS_QR), (bf16_t*)(ws + WS_KR),
                    (bf16_t*)(ws + WS_VR), (bf16_t*)(ws + WS_GR), (float*)(ws + WS_WI), R64, R128};
        pg8::gemm_phase<EpiInProj, PG8_P2_SCHED, true, true>(lds, g, So, E);
        if ((DUP_MASK >> 2) & 1) { __syncthreads(); pg8::gemm_phase<EpiInProj, PG8_P2_SCHED, true, true>(lds, g, So, E); }
        if (args.li != 0) {   }
        else if (G == 256) { if (bid >= 64) { __syncthreads(); p0_expert_items(lds, p0a, (bid - 64) * NWAVES + wave, 192 * NWAVES, tid); } }
        else { __syncthreads(); p0_expert_items(lds, p0a, bid * NWAVES + wave, G * NWAVES, tid); }
        if (BOTH(2)) xcd_barrier(bar);
    }
    bf16_t* QR = (bf16_t*)(ws + WS_QR); bf16_t* KR = (bf16_t*)(ws + WS_KR); bf16_t* VR = (bf16_t*)(ws + WS_VR); bf16_t* GR = (bf16_t*)(ws + WS_GR);
    const bf16_t* QI = (const bf16_t*)(ws + WS_QI); const bf16_t* KI = (const bf16_t*)(ws + WS_KI); const float* WI = (const float*)(ws + WS_WI);
    unsigned short* SCORES = (unsigned short*)(ws + WS_SCORES); unsigned* THR = (unsigned*)(ws + WS_THR); unsigned* MASKT = (unsigned*)(ws + WS_MASKT);
    float* KVS = (float*)(ws + WS_KVS); bf16_t* RT = WD + (size_t)32 * 1024 * 256;
    bf16_t* MIXED = (bf16_t*)(ws + WS_MIXED);
    if (IN(3)) {
        MK_IDS();
        REP(3) {
        for (int p = bid; p < 256; p += G) ret_kv_pair(lds, KR, VR, KVS, p, tid);
        sc_phase(lds, MISC + 16, ctl + CW_Q + 64 * rep_, QI, KI, WI, SCORES, tid);
        }
        if (BOTH(3)) xcd_barrier(bar);
    }
    if (IN(4)) {
        MK_IDS();
        ret_scan(KVS, RT, bid * NTHR + tid, G * NTHR);
        for (int gw = bid * NWAVES + wave; gw < 2048; gw += G * NWAVES) sel_queries_balanced(SCORES, THR, gw, lane);
        if ((DUP_MASK >> 12) & 1) for (int gw = bid * NWAVES + wave; gw < 2048; gw += G * NWAVES) sel_queries_balanced(SCORES, THR, gw, lane);
        if (BOTH(4)) xcd_barrier(bar);
    }
    if (IN(5)) {
        MK_IDS();
        mask_units(SCORES, THR, MASKT, bid * NWAVES + wave, G * NWAVES, lane);
        if ((DUP_MASK >> 13) & 1) mask_units(SCORES, THR, MASKT, bid * NWAVES + wave, G * NWAVES, lane);
        if (BOTH(5)) xcd_barrier(bar);
    }
    if (IN(6)) {
        MK_IDS();
        {
        for (int p = bid; p < 256; p += G) ret_out_pair(lds, QR, KR, VR, GR, RT, MIXED, p, tid);
        if ((DUP_MASK >> 14) & 1) for (int p = bid; p < 256; p += G) ret_out_pair(lds, QR, KR, VR, GR, RT, MIXED, p, tid);
        asm volatile("s_waitcnt vmcnt(0) lgkmcnt(0)" ::: "memory");
        __syncthreads();
        {
            const attn_body::AttnTensors AT{(const attn_body::bf16*)(ws + WS_QA), (const attn_body::bf16*)(ws + WS_KA), (const attn_body::bf16*)(ws + WS_VA), (attn_body::bf16*)MIXED, (const unsigned*)MASKT};
            const attn_body::StaticOrder So((int)G, (int)bid);
            attn_body::attn_phase<attn_body::StaticOrder>((char*)lds_raw, AT, So);
        }
        __syncthreads();
        }
        if ((DUP_MASK >> 5) & 1) {
        for (int p = bid; p < 256; p += G) ret_out_pair(lds, QR, KR, VR, GR, RT, MIXED, p, tid);
        asm volatile("s_waitcnt vmcnt(0) lgkmcnt(0)" ::: "memory");
        __syncthreads();
        {
            const attn_body::AttnTensors AT{(const attn_body::bf16*)(ws + WS_QA), (const attn_body::bf16*)(ws + WS_KA), (const attn_body::bf16*)(ws + WS_VA), (attn_body::bf16*)MIXED, (const unsigned*)MASKT};
            const attn_body::StaticOrder So((int)G, (int)bid);
            attn_body::attn_phase<attn_body::StaticOrder>((char*)lds_raw, AT, So);
        }
        __syncthreads();
        }
        if (BOTH(6)) xcd_barrier(bar);
    }
    bf16_t* MIX = (bf16_t*)(ws + WS_MIX); bf16_t* H2 = (bf16_t*)(ws + WS_H2); u32x2* LIST = (u32x2*)(ws + WS_LIST); bf16_t* HID = (bf16_t*)(ws + WS_HID);
    bf16_t* Y = (bf16_t*)(ws + WS_Y); float* HRES = (float*)(ws + WS_HRES);
    LAS int* tb = (LAS int*)(lds + TB_OFF);
    if (IN(7)) {
        MK_IDS();
        pg8::Gemm g{MIXED, WOUT, T, 1024, 1024}; pg8::StaticOrder So; So.init(T, 1024, G, bid);
        EpiStore E{MIX, 1024};
        pg8::gemm_phase<EpiStore, pg8::StaticOrder, true, true>(lds, g, So, E);
        if ((DUP_MASK >> 6) & 1) { __syncthreads(); pg8::gemm_phase<EpiStore, pg8::StaticOrder, true, true>(lds, g, So, E); }
        if (BOTH(7)) xcd_barrier(bar);
    }
    if (IN(8)) {
        MK_IDS();
        P6bArgs a{MIX, x, (const float*)args.in[8], (const float*)args.in[9], mod, (const float*)args.in[10], (const float*)args.in[11], (const float*)args.in[12], (const float*)args.in[13], HRES, H2, ctl + CW_CNT, LIST};
        const int gw0 = bid * NWAVES + wave;
        P6bIn I8;
        if (gw0 < T / P6B_NR) { p6b_load_x(I8, x, gw0, lane); p6b_load_mix(I8, MIX, gw0, lane); }
        { P6bW W8; p6b_weights_fetch(W8, a.w_group, a.w_expert, tid); p6b_weights_store(W8, lds, tid); }
        p6b_rows(a, I8, lds, (LAS float*)(lds + RT_WL_OFF + wave * 576), gw0, G * NWAVES, lane, false);
        if ((DUP_MASK >> 8) & 1) { if (gw0 < T / P6B_NR) { p6b_load_x(I8, x, gw0, lane); p6b_load_mix(I8, MIX, gw0, lane); } p6b_rows(a, I8, lds, (LAS float*)(lds + RT_WL_OFF + wave * 576), gw0, G * NWAVES, lane, true); }
        if (BOTH(8)) xcd_barrier(bar);
    }
    if (IN(9)) {
        MK_IDS();
        moe_table(tb, ctl + CW_CNT, tid);
        pg8::Gemm g{H2, WGU, T, 32 * 512, 1024}; MoeSched<1> So{LIST, tb, G, bid, 2, ctl + CW_TILE, ctl + CW_TMO, 0, 1 << 20};
        EpiGU E{HID};
        pg8::gemm_phase_ga<EpiGU, MoeSched<1>>(lds, g, So, E);
        if ((DUP_MASK >> 8) & 1) { __syncthreads(); pg8::gemm_phase_ga<EpiGU, MoeSched<1>>(lds, g, So, E); }
        __syncthreads();
    }
    if (IN(10)) {
        MK_IDS();
        moe_table(tb, ctl + CW_CNT, tid);
        const int n2 = (tb[32] * 2 > G && tb[32] * 2 < 2 * G) ? tb[32] * 2 - G : 0;
        const int t1 = G / 2;
        pg8::Gemm g{HID, WD, T, 32 * 1024, 256};
        EpiDown E{Y, LIST, tb};
        { MoeSched<2> So{LIST, tb, G - n2, bid - n2, 4, ctl + CW_TILE, ctl + CW_TMO, 0, t1}; moe_wait(So); pg8::gemm_phase<EpiDown, MoeSched<2>, true, true>(lds, g, So, E); }
        { MoeSched<2> So{LIST, tb, G - n2, bid - n2, 4, ctl + CW_TILE, ctl + CW_TMO, t1, 1 << 20}; moe_wait(So); pg8::gemm_phase<EpiDown, MoeSched<2>, true, true>(lds, g, So, E); }
        if (BOTH(10)) xcd_barrier(bar);
    }
    if (IN(11)) {
        MK_IDS();
        REP(11) p8_rows(Y, MIX, x, (const float*)args.in[8], (const float*)args.in[17], mod, args.out, bid * NWAVES + wave, G * NWAVES, lane);
    }
#undef IN
#undef BOTH
}
}
extern "C" void kernel_launch(void* const* d_in, const int* in_sizes, int n_in, void* d_out, int out_size, void* d_ws, size_t ws_size, hipStream_t stream) {
    using namespace mk;
    static int grid = 0;
    if (grid == 0) {
        int dev = 0, cus = 0, per_cu = 0;
        if (n_in != 18 || out_size != T * D || ws_size < (size_t)256 * MiB) { fprintf(stderr, "kernel_launch: unexpected problem shape (n_in %d, out %d, ws %zu)\n", n_in, out_size, ws_size); grid = -1; return; }
        if (hipGetDevice(&dev) != hipSuccess || hipDeviceGetAttribute(&cus, hipDeviceAttributeMultiprocessorCount, dev) != hipSuccess) { fprintf(stderr, "kernel_launch: device query failed\n"); grid = -1; return; }
        if (hipFuncSetAttribute((const void*)mega, hipFuncAttributeMaxDynamicSharedMemorySize, LDS_BYTES) != hipSuccess) { fprintf(stderr, "kernel_launch: hipFuncSetAttribute failed\n"); grid = -1; return; }
        if (hipOccupancyMaxActiveBlocksPerMultiprocessor(&per_cu, (const void*)mega, NTHR, LDS_BYTES) != hipSuccess || per_cu < 1) fprintf(stderr, "kernel_launch: occupancy query reports %d\n", per_cu);
        (void)hipGetLastError();
        grid = cus;
    }
    if (grid < 0) return;
    unsigned char* ws = (unsigned char*)d_ws;
    (void)hipMemsetAsync(ws + WS_CTL, 0, CTL_BYTES, stream);
    Args a{};
    for (int i = 0; i < 18; ++i) a.in[i] = d_in[i];
    a.out = (float*)d_out; a.ws = ws; a.ph_lo = 0; a.ph_hi = N_PHASES; a.li = 0; a.pad = 0;
    hipLaunchKernelGGL(mega, dim3(grid), dim3(NTHR), LDS_BYTES, stream, a);
#ifdef EXTRA_PHASE
#ifndef EXTRA_HI
#define EXTRA_HI (EXTRA_PHASE + 1)
#endif
    a.ph_lo = EXTRA_PHASE; a.ph_hi = EXTRA_HI; a.li = 1;
    hipLaunchKernelGGL(mega, dim3(grid), dim3(NTHR), LDS_BYTES, stream, a);
#endif
}
```

```cpp
#include <hip/hip_runtime.h>
#include <cstdio>
#include <cstdint>
#define DUP_MASK 0
#define MK_SLOTMAP_OFF (163840 - 256)
__device__ __forceinline__ unsigned mk_hwslot() { return (unsigned)__builtin_amdgcn_s_getreg((5 << 11) | 4) & 63u; }
__device__ __forceinline__ int mk_wave() { return __builtin_amdgcn_readfirstlane((int)((const __attribute__((address_space(3))) unsigned char*)(unsigned)MK_SLOTMAP_OFF)[mk_hwslot()]); }
__device__ __forceinline__ int mk_lane() { return (int)__builtin_amdgcn_mbcnt_hi(~0u, __builtin_amdgcn_mbcnt_lo(~0u, 0u)); }
__device__ __forceinline__ int mk_tidx() { return mk_wave() * 64 + mk_lane(); }
namespace pg8 {
#define PG8_LAS __attribute__((address_space(3)))
typedef unsigned short bf16_t;
typedef short bf16x8 __attribute__((ext_vector_type(8)));
typedef float f32x4 __attribute__((ext_vector_type(4)));
typedef unsigned u32x4 __attribute__((ext_vector_type(4)));
constexpr int BM = 256, BK = 64, HALF = 128, HTB = HALF * BK * 2  , STAGE_BYTES = 8 * HTB, NXCD = 8, WGM = 8;

__host__ __device__ __forceinline__ int lds_byte(int r, int c) { const int st = (r >> 4) * 2 + (c >> 5), rr = r & 15, cc = c & 31, ob = rr * 64 + cc * 2; return st * 1024 + (ob ^ (((ob >> 9) & 1) << 5)); }
__host__ __device__ __forceinline__ void stage_rc(int b, int& R, int& C) { const int st = b / 1024, sb = b % 1024, swz = sb ^ (((sb >> 9) & 1) << 5); R = (st >> 1) * 16 + swz / 64; C = (st & 1) * 32 + (swz % 64) / 2; }
__host__ __device__ __forceinline__ int perm32(int rho) { const int n = rho >> 4, i = rho & 15; return 8 * (i >> 2) + 4 * n + (i & 3); }

struct Unit { int pm, pn; };
struct Gemm { const bf16_t* A; const bf16_t* Bt; int M, N, K; };

struct StaticOrder {
    int nM, nN, nwg, G, c;
    __host__ __device__ void init(int M, int N, int G_, int c_) { nM = M / BM; nN = N / BM; nwg = nM * nN; G = G_; c = c_; }
    __host__ __device__ bool next(int i, Unit& u) const {
        const long L = (long)i * G + c; if (L >= nwg) return false;
        int wgid = (int)L; { const int q = nwg / NXCD, r = nwg % NXCD, xcd = wgid % NXCD, off = wgid / NXCD; wgid = (xcd < r ? xcd * (q + 1) : r * (q + 1) + (xcd - r) * q) + off; }
        const int nig = WGM * nN, gid = wgid / nig, fm = gid * WGM, gsz = (nM - fm) < WGM ? (nM - fm) : WGM;
        u.pm = fm + ((wgid % nig) % gsz); u.pn = (wgid % nig) / gsz; return true;
    }
    __device__ __forceinline__ void a_ready(const Unit&) const {}
    __device__ __forceinline__ void done(const Unit&) const {}
};
template <class Epi, class Sched, bool ALIGN_EPI = false, bool SP2 = false>
__device__ __forceinline__ void gemm_phase(PG8_LAS unsigned char* lds, const Gemm g, const Sched& S, const Epi& E) {
    const int tid = mk_tidx(), wid = __builtin_amdgcn_readfirstlane(tid >> 6), lane = tid & 63, wr = wid >> 2, wc = wid & 3, fr = lane & 15, fq = lane >> 4;
    const int K = g.K, nt = K / BK;
    unsigned voffA[2], voffB[2];
#pragma unroll
    for (int i = 0; i < 2; ++i) { int R, C; stage_rc(tid * 16 + i * 8192, R, C); const int Rb = Epi::PERM ? ((R & ~31) + perm32(R & 31)) : R;
        voffA[i] = (unsigned)(R * K + C) * 2u; voffB[i] = (unsigned)(Rb * K + C) * 2u; }
    const size_t kstep = (size_t)(BK * 2);
    const size_t hstep = (size_t)HALF * K * 2;
    const size_t tstep = 2 * hstep;
    const unsigned ldsw = (unsigned)wid * 1024u;
    const int aoff = lds_byte(wr * 64 + fr, fq * 8), boff = lds_byte(wc * 32 + fr, fq * 8);
#define PG8_SA(b, h) (((b) * 2 + (h)) * HTB)
#define PG8_SB(b, h) ((4 + (b) * 2 + (h)) * HTB)
#define PG8_STAGE(bufoff, gbase, voff) do { _Pragma("unroll") for (int _i = 0; _i < 2; ++_i) \
        __builtin_amdgcn_global_load_lds((const unsigned*)((const char*)(gbase) + (voff)[_i]), (PG8_LAS unsigned*)(lds + (bufoff) + ldsw + _i * 8192), 16, 0, 0); } while (0)
#define PG8_LDA(dst, b, h) do { _Pragma("unroll") for (int m = 0; m < 4; ++m) _Pragma("unroll") for (int k = 0; k < 2; ++k) dst[m][k] = *(const PG8_LAS bf16x8*)(lds + PG8_SA(b, h) + aoff + m * 2048 + k * 1024); } while (0)
#define PG8_LDB(dst, b, h) do { _Pragma("unroll") for (int n = 0; n < 2; ++n) _Pragma("unroll") for (int k = 0; k < 2; ++k) dst[n][k] = *(const PG8_LAS bf16x8*)(lds + PG8_SB(b, h) + boff + n * 2048 + k * 1024); } while (0)
#define PG8_MMA(ai, bj, At, Bt) do { __builtin_amdgcn_s_setprio(1); _Pragma("unroll") for (int m = 0; m < 4; ++m) _Pragma("unroll") for (int n = 0; n < 2; ++n) _Pragma("unroll") for (int k = 0; k < 2; ++k) \
        acc[ai][bj][m][n] = __builtin_amdgcn_mfma_f32_16x16x32_bf16(Bt[n][k], At[m][k], acc[ai][bj][m][n], 0, 0, 0); __builtin_amdgcn_s_setprio(0); } while (0)
#define PG8_WAIT_V(n) asm volatile("s_waitcnt vmcnt(" #n ")" ::: "memory")
#define PG8_WAIT_L(n) asm volatile("s_waitcnt lgkmcnt(" #n ")" ::: "memory")
#define PG8_BAR __builtin_amdgcn_s_barrier()
#define PG8_SCHED __builtin_amdgcn_sched_barrier(0)
    Unit cur, nxt; int ui = 0;
    if (!S.next(0, cur)) return;
    f32x4 acc[2][2][4][2];
#pragma unroll
    for (int a = 0; a < 2; ++a)
#pragma unroll
        for (int b = 0; b < 2; ++b)
#pragma unroll
            for (int m = 0; m < 4; ++m)
#pragma unroll
                for (int n = 0; n < 2; ++n) acc[a][b][m][n] = (f32x4){0.f, 0.f, 0.f, 0.f};
    bf16x8 At[4][2], B0[2][2], B1[2][2];
    const char* cA = (const char*)g.A + (size_t)cur.pm * tstep; const char* cB = (const char*)g.Bt + (size_t)cur.pn * tstep;
    S.a_ready(cur);
    if constexpr (SP2) {
        PG8_STAGE(PG8_SB(0, 0), cB, voffB); PG8_STAGE(PG8_SB(0, 1), cB + hstep, voffB); PG8_STAGE(PG8_SA(0, 0), cA, voffA); PG8_STAGE(PG8_SA(0, 1), cA + hstep, voffA);
        if (wr == 1) PG8_BAR;
        PG8_WAIT_V(2); PG8_BAR;
        PG8_STAGE(PG8_SB(1, 0), cB + kstep, voffB); PG8_STAGE(PG8_SA(1, 0), cA + kstep, voffA); PG8_STAGE(PG8_SB(1, 1), cB + hstep + kstep, voffB);
        PG8_WAIT_V(6); PG8_BAR;
    } else {
        PG8_STAGE(PG8_SB(0, 0), cB, voffB); PG8_STAGE(PG8_SA(0, 0), cA, voffA); PG8_STAGE(PG8_SB(0, 1), cB + hstep, voffB); PG8_STAGE(PG8_SA(0, 1), cA + hstep, voffA);
        if (wr == 1) PG8_BAR;
        PG8_WAIT_V(4); PG8_BAR;
        PG8_STAGE(PG8_SB(1, 0), cB + kstep, voffB); PG8_STAGE(PG8_SA(1, 0), cA + kstep, voffA); PG8_STAGE(PG8_SB(1, 1), cB + hstep + kstep, voffB);
        PG8_WAIT_V(6); PG8_BAR;
    }
    for (;;) {
        const bool has_next = S.next(ui + 1, nxt);
        const char* nA = has_next ? (const char*)g.A + (size_t)nxt.pm * tstep : cA; const char* nB = has_next ? (const char*)g.Bt + (size_t)nxt.pn * tstep : cB;
        for (int t = 0; t < nt; t += 2) {
            const bool last = (t == nt - 2);
            const char* a1 = cA + (size_t)(t + 1) * kstep;
            const char* a2 = last ? nA : cA + (size_t)(t + 2) * kstep; const char* b2 = last ? nB : cB + (size_t)(t + 2) * kstep;
            const char* a3 = a2 + kstep; const char* b3 = b2 + kstep;
            if (last && has_next) S.a_ready(nxt);
            if constexpr (SP2) {
            PG8_LDB(B0, 0, 0); PG8_LDB(B1, 0, 1); PG8_SCHED; PG8_LDA(At, 0, 0); PG8_STAGE(PG8_SA(1, 1), a1 + hstep, voffA);
            PG8_WAIT_V(8); PG8_WAIT_L(0); PG8_BAR; PG8_MMA(0, 0, At, B0); PG8_MMA(0, 1, At, B1); PG8_BAR; PG8_SCHED;
            PG8_LDA(At, 0, 1); PG8_STAGE(PG8_SB(0, 0), b2, voffB); PG8_STAGE(PG8_SB(0, 1), b2 + hstep, voffB); PG8_STAGE(PG8_SA(0, 0), a2, voffA);
            PG8_WAIT_V(8); PG8_WAIT_L(0); PG8_BAR; PG8_MMA(1, 0, At, B0); PG8_MMA(1, 1, At, B1); PG8_BAR; PG8_SCHED;
            PG8_LDB(B0, 1, 0); PG8_LDB(B1, 1, 1); PG8_SCHED; PG8_LDA(At, 1, 0); PG8_STAGE(PG8_SA(0, 1), a2 + hstep, voffA);
            PG8_WAIT_V(8); PG8_WAIT_L(0); PG8_BAR; PG8_MMA(0, 0, At, B0); PG8_MMA(0, 1, At, B1); PG8_BAR; PG8_SCHED;
            PG8_LDA(At, 1, 1); PG8_STAGE(PG8_SB(1, 0), b3, voffB); PG8_STAGE(PG8_SB(1, 1), b3 + hstep, voffB); PG8_STAGE(PG8_SA(1, 0), a3, voffA);
            PG8_WAIT_V(8); PG8_WAIT_L(0); PG8_BAR; PG8_MMA(1, 0, At, B0); PG8_MMA(1, 1, At, B1); PG8_BAR; PG8_SCHED;
            } else {
            PG8_LDB(B0, 0, 0); PG8_SCHED; PG8_LDA(At, 0, 0); PG8_STAGE(PG8_SA(1, 1), a1 + hstep, voffA);
            PG8_WAIT_L(8); PG8_BAR; PG8_WAIT_L(0); PG8_MMA(0, 0, At, B0); PG8_BAR; PG8_SCHED;
            PG8_LDB(B1, 0, 1); PG8_STAGE(PG8_SB(0, 0), b2, voffB);
            PG8_BAR; PG8_WAIT_L(0); PG8_MMA(0, 1, At, B1); PG8_BAR;
            PG8_LDA(At, 0, 1); PG8_STAGE(PG8_SA(0, 0), a2, voffA);
            PG8_BAR; PG8_WAIT_L(0); PG8_MMA(1, 0, At, B0); PG8_BAR; PG8_SCHED;
            PG8_STAGE(PG8_SB(0, 1), b2 + hstep, voffB);
            PG8_WAIT_V(6); PG8_BAR; PG8_MMA(1, 1, At, B1); PG8_BAR;
            PG8_LDB(B0, 1, 0); PG8_SCHED; PG8_LDA(At, 1, 0); PG8_STAGE(PG8_SA(0, 1), a2 + hstep, voffA);
            PG8_WAIT_L(8); PG8_BAR; PG8_WAIT_L(0); PG8_MMA(0, 0, At, B0); PG8_BAR; PG8_SCHED;
            PG8_LDB(B1, 1, 1); PG8_STAGE(PG8_SB(1, 0), b3, voffB);
            PG8_BAR; PG8_WAIT_L(0); PG8_MMA(0, 1, At, B1); PG8_BAR;
            PG8_LDA(At, 1, 1); PG8_STAGE(PG8_SA(1, 0), a3, voffA);
            PG8_BAR; PG8_WAIT_L(0); PG8_MMA(1, 0, At, B0); PG8_BAR; PG8_SCHED;
            PG8_STAGE(PG8_SB(1, 1), b3 + hstep, voffB);
            PG8_WAIT_V(6); PG8_BAR; PG8_MMA(1, 1, At, B1); PG8_BAR;
            }
        }
        if constexpr (ALIGN_EPI) { if (wr == 0) PG8_BAR; }
        if constexpr (!Epi::AFTER_DRAIN) { E(acc, cur, wr, wc, fr, fq); S.done(cur); }
        if (!has_next) break;
#pragma unroll
        for (int a = 0; a < 2; ++a)
#pragma unroll
            for (int b = 0; b < 2; ++b)
#pragma unroll
                for (int m = 0; m < 4; ++m)
#pragma unroll
                    for (int n = 0; n < 2; ++n) acc[a][b][m][n] = (f32x4){0.f, 0.f, 0.f, 0.f};
        cur = nxt; cA = nA; cB = nB; ++ui;
        if constexpr (ALIGN_EPI) { if (wr == 1) PG8_BAR; }
    }
    PG8_WAIT_V(0);
    if constexpr (!ALIGN_EPI) { if (wr == 0) PG8_BAR; }
    PG8_BAR;
    if constexpr (Epi::AFTER_DRAIN) { E.fused(acc, cur, wr, wc, fr, fq, lds, wid, lane); S.done(cur); }
#undef PG8_SA
#undef PG8_SB
#undef PG8_STAGE
#undef PG8_LDA
#undef PG8_LDB
#undef PG8_MMA
#undef PG8_WAIT_V
#undef PG8_WAIT_L
#undef PG8_BAR
#undef PG8_SCHED
}
}
#define XB_TMO      128
#define XB_XCNT(j)  (256  + 64 * (j))
#define XB_XSUB(j)  (1280 + 64 * (j))
#define XB_XGEN(j)  (2304 + 64 * (j))
#define XB_TOP      3328
#define XB_TOPGEN   3392
#define XCD_BAR_WORDS 3456
#define XB_SPIN_CAP (1u << 18)
#define LAS __attribute__((address_space(3)))

__device__ __forceinline__ unsigned xb_ld(unsigned* p)              { return __hip_atomic_load(p, __ATOMIC_RELAXED, __HIP_MEMORY_SCOPE_AGENT); }
__device__ __forceinline__ unsigned xb_add(unsigned* p, unsigned v) { return __hip_atomic_fetch_add(p, v, __ATOMIC_RELAXED, __HIP_MEMORY_SCOPE_AGENT); }
__device__ __forceinline__ unsigned xb_xcc_id() { return (unsigned)__builtin_amdgcn_s_getreg((3 << 11) | 20) & 0xFu; }
#define XB_SPIN(cond, bar) do { unsigned _sp = 0; while (cond) { __builtin_amdgcn_s_sleep(1); \
    if ((++_sp & 255u) == 0u) { if (xb_ld(&(bar)[XB_TMO])) break; if (_sp > XB_SPIN_CAP) { atomicAdd(&(bar)[XB_TMO], 1u); break; } } } } while (0)

struct XcdBarrier {
    unsigned* bar; unsigned x;
    volatile LAS unsigned* st;
};

__device__ __forceinline__ XcdBarrier xcd_barrier_post(unsigned* bar, volatile LAS unsigned* st) {
    XcdBarrier b; b.bar = bar; b.x = xb_xcc_id(); b.st = st;
    if (mk_tidx() == 0) (void)xb_add(&bar[XB_XCNT(b.x)], 1u);
    return b;
}
__device__ __forceinline__ void xcd_barrier_complete(unsigned* bar, unsigned x, unsigned& nloc, unsigned& nx) {
    const unsigned G = gridDim.x * gridDim.y * gridDim.z;
    unsigned sum, cnt, mine, sp = 0u;
    for (;;) {
        sum = 0u; cnt = 0u; mine = 0u;
#pragma unroll
        for (unsigned j = 0; j < 16; ++j) { const unsigned c = xb_ld(&bar[XB_XCNT(j)]); sum += c; cnt += (c > 0u) ? 1u : 0u; mine = (j == x) ? c : mine; }
        if (sum == G) break;
        __builtin_amdgcn_s_sleep(1);
        if ((++sp & 255u) == 0u) { if (xb_ld(&bar[XB_TMO])) break; if (sp > XB_SPIN_CAP) { atomicAdd(&bar[XB_TMO], 1u); break; } }
    }
    nloc = mine > 0u ? mine : 1u; nx = cnt > 0u ? cnt : 1u;
}

__device__ __forceinline__ void xcd_barrier(const XcdBarrier& b) {
    asm volatile("s_waitcnt vmcnt(0)" ::: "memory");
    __syncthreads();
    if (mk_tidx() == 0) {
        unsigned* bar = b.bar;
        __builtin_amdgcn_s_waitcnt(0);
        unsigned nloc = b.st[0], nx = b.st[1];
        if (nloc == 0u) { xcd_barrier_complete(bar, b.x, nloc, nx); b.st[0] = nloc; b.st[1] = nx; }
        const unsigned old = xb_add(&bar[XB_XSUB(b.x)], 1u);
        const unsigned gen = old / nloc;
        if (old + 1u == (gen + 1u) * nloc) {
            __builtin_amdgcn_fence(__ATOMIC_RELEASE, "agent");
            asm volatile("s_waitcnt vmcnt(0)" ::: "memory");
            const unsigned og = xb_add(&bar[XB_TOP], 1u);
            const unsigned tg = og / nx;
            if (og + 1u == (tg + 1u) * nx) xb_add(&bar[XB_TOPGEN], 1u);
            else XB_SPIN(xb_ld(&bar[XB_TOPGEN]) == tg, bar);
            __builtin_amdgcn_fence(__ATOMIC_ACQUIRE, "agent");
            xb_add(&bar[XB_XGEN(b.x)], 1u);
            asm volatile("s_waitcnt vmcnt(0)" ::: "memory");
        } else {
            XB_SPIN(xb_ld(&bar[XB_XGEN(b.x)]) == gen, bar);
            __builtin_amdgcn_fence(__ATOMIC_ACQUIRE, "agent");
            asm volatile("s_waitcnt vmcnt(0)" ::: "memory");
        }
    }
    __syncthreads();
}
namespace pg8 {
template <class Epi, class Sched>
__device__ __forceinline__ void gemm_phase_ga(PG8_LAS unsigned char* lds, const Gemm g, const Sched& S, const Epi& E) {
    const int tid = mk_tidx(), wid = __builtin_amdgcn_readfirstlane(tid >> 6), lane = tid & 63, wr = wid >> 2, wc = wid & 3, fr = lane & 15, fq = lane >> 4;
    const int K = g.K, nt = K / BK;
    unsigned voffB[2]; int RA[2], CA[2];
#pragma unroll
    for (int i = 0; i < 2; ++i) { int R, C; stage_rc(tid * 16 + i * 8192, R, C); const int Rb = Epi::PERM ? ((R & ~31) + perm32(R & 31)) : R;
        RA[i] = R; CA[i] = C; voffB[i] = (unsigned)(Rb * K + C) * 2u; }
    const size_t kstep = (size_t)(BK * 2);
    const size_t hstep = (size_t)HALF * K * 2;
    const size_t tstep = 2 * hstep;
    const unsigned ldsw = (unsigned)wid * 1024u;
    const int aoff = lds_byte(wr * 64 + fr, fq * 8), boff = lds_byte(wc * 32 + fr, fq * 8);
#define PG8_SA(b, h) (((b) * 2 + (h)) * HTB)
#define PG8_SB(b, h) ((4 + (b) * 2 + (h)) * HTB)
#define PG8_STAGE(bufoff, gbase, voff) do { _Pragma("unroll") for (int _i = 0; _i < 2; ++_i) \
        __builtin_amdgcn_global_load_lds((const unsigned*)((const char*)(gbase) + (voff)[_i]), (PG8_LAS unsigned*)(lds + (bufoff) + ldsw + _i * 8192), 16, 0, 0); } while (0)
#define PG8_LDA(dst, b, h) do { _Pragma("unroll") for (int m = 0; m < 4; ++m) _Pragma("unroll") for (int k = 0; k < 2; ++k) dst[m][k] = *(const PG8_LAS bf16x8*)(lds + PG8_SA(b, h) + aoff + m * 2048 + k * 1024); } while (0)
#define PG8_LDB(dst, b, h) do { _Pragma("unroll") for (int n = 0; n < 2; ++n) _Pragma("unroll") for (int k = 0; k < 2; ++k) dst[n][k] = *(const PG8_LAS bf16x8*)(lds + PG8_SB(b, h) + boff + n * 2048 + k * 1024); } while (0)
#define PG8_MMA(ai, bj, At, Bt) do { __builtin_amdgcn_s_setprio(1); _Pragma("unroll") for (int m = 0; m < 4; ++m) _Pragma("unroll") for (int n = 0; n < 2; ++n) _Pragma("unroll") for (int k = 0; k < 2; ++k) \
        acc[ai][bj][m][n] = __builtin_amdgcn_mfma_f32_16x16x32_bf16(Bt[n][k], At[m][k], acc[ai][bj][m][n], 0, 0, 0); __builtin_amdgcn_s_setprio(0); } while (0)
#define PG8_WAIT_V(n) asm volatile("s_waitcnt vmcnt(" #n ")" ::: "memory")
#define PG8_WAIT_L(n) asm volatile("s_waitcnt lgkmcnt(0)" ::: "memory")
#define PG8_BAR __builtin_amdgcn_s_barrier()
#define PG8_SCHED __builtin_amdgcn_sched_barrier(0)
#define PG8_AOFF(dst, u) do { _Pragma("unroll") for (int _h = 0; _h < 2; ++_h) _Pragma("unroll") for (int _i = 0; _i < 2; ++_i) \
        dst[_h][_i] = (unsigned)S.arow(u, _h * HALF + RA[_i]) * (unsigned)(K * 2) + (unsigned)(CA[_i] * 2); } while (0)
    Unit cur, nxt; int ui = 0;
    if (!S.next(0, cur)) return;
    f32x4 acc[2][2][4][2];
#pragma unroll
    for (int a = 0; a < 2; ++a)
#pragma unroll
        for (int b = 0; b < 2; ++b)
#pragma unroll
            for (int m = 0; m < 4; ++m)
#pragma unroll
                for (int n = 0; n < 2; ++n) acc[a][b][m][n] = (f32x4){0.f, 0.f, 0.f, 0.f};
    bf16x8 At[4][2], B0[2][2], B1[2][2];
    unsigned offC[2][2], offN[2][2];
    PG8_AOFF(offC, cur);
    const char* gA = (const char*)g.A;
    const char* cB = (const char*)g.Bt + (size_t)cur.pn * tstep;
    S.a_ready(cur);
    PG8_STAGE(PG8_SB(0, 0), cB, voffB); PG8_STAGE(PG8_SB(0, 1), cB + hstep, voffB); PG8_STAGE(PG8_SA(0, 0), gA, offC[0]); PG8_STAGE(PG8_SA(0, 1), gA, offC[1]);
    if (wr == 1) PG8_BAR;
    PG8_WAIT_V(2); PG8_BAR;
    PG8_STAGE(PG8_SB(1, 0), cB + kstep, voffB); PG8_STAGE(PG8_SA(1, 0), gA + kstep, offC[0]); PG8_STAGE(PG8_SB(1, 1), cB + hstep + kstep, voffB);
    PG8_WAIT_V(6); PG8_BAR;
    for (;;) {
        const bool has_next = S.next(ui + 1, nxt);
        if (has_next) { PG8_AOFF(offN, nxt); } else {
#pragma unroll
            for (int h_ = 0; h_ < 2; ++h_)
#pragma unroll
                for (int i_ = 0; i_ < 2; ++i_) offN[h_][i_] = offC[h_][i_]; }
        const char* nB = has_next ? (const char*)g.Bt + (size_t)nxt.pn * tstep : cB;
        for (int t = 0; t < nt; t += 2) {
            const bool last = (t == nt - 2);
            const char* a1 = gA + (size_t)(t + 1) * kstep;
            const char* a2 = last ? gA : gA + (size_t)(t + 2) * kstep; const char* b2 = last ? nB : cB + (size_t)(t + 2) * kstep;
            const char* a3 = a2 + kstep; const char* b3 = b2 + kstep;
            unsigned o2[2][2];
#pragma unroll
            for (int h_ = 0; h_ < 2; ++h_)
#pragma unroll
                for (int i_ = 0; i_ < 2; ++i_) o2[h_][i_] = last ? offN[h_][i_] : offC[h_][i_];
            if (last && has_next) S.a_ready(nxt);
            PG8_LDB(B0, 0, 0); PG8_LDB(B1, 0, 1); PG8_SCHED; PG8_LDA(At, 0, 0); PG8_STAGE(PG8_SA(1, 1), a1, offC[1]);
            PG8_WAIT_V(8); PG8_WAIT_L(0); PG8_BAR; PG8_MMA(0, 0, At, B0); PG8_MMA(0, 1, At, B1); PG8_BAR; PG8_SCHED;
            PG8_LDA(At, 0, 1); PG8_STAGE(PG8_SB(0, 0), b2, voffB); PG8_STAGE(PG8_SB(0, 1), b2 + hstep, voffB); PG8_STAGE(PG8_SA(0, 0), a2, o2[0]);
            PG8_WAIT_V(8); PG8_WAIT_L(0); PG8_BAR; PG8_MMA(1, 0, At, B0); PG8_MMA(1, 1, At, B1); PG8_BAR; PG8_SCHED;
            PG8_LDB(B0, 1, 0); PG8_LDB(B1, 1, 1); PG8_SCHED; PG8_LDA(At, 1, 0); PG8_STAGE(PG8_SA(0, 1), a2, o2[1]);
            PG8_WAIT_V(8); PG8_WAIT_L(0); PG8_BAR; PG8_MMA(0, 0, At, B0); PG8_MMA(0, 1, At, B1); PG8_BAR; PG8_SCHED;
            PG8_LDA(At, 1, 1); PG8_STAGE(PG8_SB(1, 0), b3, voffB); PG8_STAGE(PG8_SB(1, 1), b3 + hstep, voffB); PG8_STAGE(PG8_SA(1, 0), a3, o2[0]);
            PG8_WAIT_V(8); PG8_WAIT_L(0); PG8_BAR; PG8_MMA(1, 0, At, B0); PG8_MMA(1, 1, At, B1); PG8_BAR; PG8_SCHED;
        }
        if (wr == 0) PG8_BAR;
        E(acc, cur, wr, wc, fr, fq); S.done(cur);
        if (!has_next) break;
#pragma unroll
        for (int a = 0; a < 2; ++a)
#pragma unroll
            for (int b = 0; b < 2; ++b)
#pragma unroll
                for (int m = 0; m < 4; ++m)
#pragma unroll
                    for (int n = 0; n < 2; ++n) acc[a][b][m][n] = (f32x4){0.f, 0.f, 0.f, 0.f};
        cur = nxt; cB = nB; ++ui;
#pragma unroll
        for (int h_ = 0; h_ < 2; ++h_)
#pragma unroll
            for (int i_ = 0; i_ < 2; ++i_) offC[h_][i_] = offN[h_][i_];
        if (wr == 1) PG8_BAR;
    }
    PG8_WAIT_V(0);
    PG8_BAR;
#undef PG8_SA
#undef PG8_SB
#undef PG8_STAGE
#undef PG8_LDA
#undef PG8_LDB
#undef PG8_MMA
#undef PG8_WAIT_V
#undef PG8_WAIT_L
#undef PG8_BAR
#undef PG8_SCHED
#undef PG8_AOFF
}
}
namespace attn_body {
using bf16=unsigned short;
using bf16x8=__attribute__((ext_vector_type(8)))short;
using s16x4=__attribute__((ext_vector_type(4)))short;
using f32x16=__attribute__((ext_vector_type(16)))float;
using u32x4=__attribute__((ext_vector_type(4)))unsigned;
constexpr int BATCH=4,NHEAD=8,SEQ=4096,D=64,DM=NHEAD*D,ODM=1024;
constexpr int NW=8,QBLK=32,QB=QBLK*NW,KVBLK=64,NQB=SEQ/QB;
constexpr int ATTN_PITCH=DM, ATTN_UNIT_ROWS=QB;
__device__ __forceinline__ int crow(int r,int hi){return (r&3)+8*(r>>2)+4*hi;}
#define SBAR() __builtin_amdgcn_sched_barrier(0)
__device__ __forceinline__ void cmask(f32x16&p0,f32x16&p1,int jb,int qrel,int hi){
  const float NEG=-INFINITY; int kb=64*jb+4*hi;
  #pragma unroll
  for(int r=0;r<16;++r){int kv=kb+(r&3)+8*(r>>2); if(kv>qrel)p0[r]=NEG; if(kv+32>qrel)p1[r]=NEG;}
}

constexpr int NSLOT=3, SLOTB=8192;
constexpr int LDS_K=0, LDS_V=NSLOT*SLOTB, LDS_WS=2*NSLOT*SLOTB, LDS_OST=LDS_WS+NW*64*4, LDS_MSK=LDS_OST+NW*4096, LDS_BYTES=LDS_MSK+NW*768;
constexpr float C2=0.125f*1.4426950408889634f;
__device__ __forceinline__ void glds16(const void*gsrc,unsigned lds_dst){unsigned keep;
  asm volatile("s_mov_b32 %0, m0\n\ts_mov_b32 m0, %2\n\ts_nop 0\n\tglobal_load_lds_dwordx4 %1, off\n\ts_mov_b32 m0, %0":"=&s"(keep):"v"(gsrc),"s"(lds_dst):"memory");}
__device__ __forceinline__ void glds4(const void*gsrc,unsigned lds_dst){unsigned keep;
  asm volatile("s_mov_b32 %0, m0\n\ts_mov_b32 m0, %2\n\ts_nop 0\n\tglobal_load_lds_dword %1, off\n\ts_mov_b32 m0, %0":"=&s"(keep):"v"(gsrc),"s"(lds_dst):"memory");}
template<int BIT> __device__ __forceinline__ float mand(float x,unsigned w){ int m; asm("v_bfe_i32 %0, %1, %2, 1":"=v"(m):"v"(w),"n"((BIT&~3)|((BIT&1)<<1)|((BIT>>1)&1))); return __uint_as_float(__float_as_uint(x)&(unsigned)m); }
__device__ __forceinline__ float max3f(float a,float b,float c){float r;asm("v_max3_f32 %0, %1, %2, %3":"=v"(r):"v"(a),"v"(b),"v"(c));return r;}
__device__ __forceinline__ float max2f(float a,float b){float r;asm("v_max_f32_e32 %0, %1, %2":"=v"(r):"v"(a),"v"(b));return r;}
__device__ __forceinline__ float fadd_s(float a,float b){float r;asm("v_add_f32_e32 %0, %1, %2":"=v"(r):"v"(a),"v"(b));return r;}
__device__ __forceinline__ float fsub_s(float a,float b){float r;asm("v_sub_f32_e32 %0, %1, %2":"=v"(r):"v"(a),"v"(b));return r;}
typedef float f32x2_t __attribute__((ext_vector_type(2))); typedef __bf16 bf16x2_t __attribute__((ext_vector_type(2)));
__device__ __forceinline__ unsigned cvtpk_s(float lo,float hi){f32x2_t v={lo,hi};bf16x2_t b=__builtin_convertvector(v,bf16x2_t);return __builtin_bit_cast(unsigned,b);}
#define WAIT_BAR(N) asm volatile("s_waitcnt vmcnt(" #N ") lgkmcnt(0)\n\ts_barrier":::"memory")

__device__ __forceinline__ void qkt(f32x16&p0,f32x16&p1,const char*Kslot,const bf16x8*qr,const f32x16&negm,int r32,int hi){
  const char*kb=Kslot+hi*1024+r32*16;
  #pragma unroll
  for(int d0=0;d0<4;++d0){
    const bf16x8 b0=*reinterpret_cast<const bf16x8*>(kb+d0*2048);
    const bf16x8 b1=*reinterpret_cast<const bf16x8*>(kb+d0*2048+512);
    if(d0==0){p0=__builtin_amdgcn_mfma_f32_32x32x16_bf16(b0,qr[0],negm,0,0,0);p1=__builtin_amdgcn_mfma_f32_32x32x16_bf16(b1,qr[0],negm,0,0,0);}
    else{p0=__builtin_amdgcn_mfma_f32_32x32x16_bf16(b0,qr[d0],p0,0,0,0);p1=__builtin_amdgcn_mfma_f32_32x32x16_bf16(b1,qr[d0],p1,0,0,0);}}
}
typedef __attribute__((address_space(3))) const char* lds_cptr;
typedef short v4i16_t __attribute__((ext_vector_type(4)));
__device__ __forceinline__ void kload8(bf16x8*kf,lds_cptr kp){
  kf[0]=*(const __attribute__((address_space(3))) bf16x8*)(kp);      kf[1]=*(const __attribute__((address_space(3))) bf16x8*)(kp+512);
  kf[2]=*(const __attribute__((address_space(3))) bf16x8*)(kp+2048); kf[3]=*(const __attribute__((address_space(3))) bf16x8*)(kp+2560);
  kf[4]=*(const __attribute__((address_space(3))) bf16x8*)(kp+4096); kf[5]=*(const __attribute__((address_space(3))) bf16x8*)(kp+4608);
  kf[6]=*(const __attribute__((address_space(3))) bf16x8*)(kp+6144); kf[7]=*(const __attribute__((address_space(3))) bf16x8*)(kp+6656);
}
__device__ __forceinline__ void kload2(bf16x8*kf,lds_cptr kp,int j){ kf[2*j]=*(const __attribute__((address_space(3))) bf16x8*)(kp+j*2048); kf[2*j+1]=*(const __attribute__((address_space(3))) bf16x8*)(kp+j*2048+512); }
__device__ __forceinline__ s16x4 vtr(lds_cptr p){ return __builtin_bit_cast(s16x4,__builtin_amdgcn_ds_read_tr16_b64_v4i16((__attribute__((address_space(3))) v4i16_t*)p)); }
__device__ __forceinline__ float rowmax(const f32x16&p0,const f32x16&p1){
  float a=max3f(p0[0],p0[1],p1[0]),b=max3f(p0[2],p0[3],p1[1]);a=max3f(a,p1[2],p1[3]);
  #pragma unroll
  for(int r=4;r<16;r+=4){a=max3f(a,p0[r],p0[r+1]);b=max3f(b,p0[r+2],p0[r+3]);a=max3f(a,p1[r],p1[r+1]);b=max3f(b,p1[r+2],p1[r+3]);}
  const float m=max2f(a,b);
  auto rr=__builtin_amdgcn_permlane32_swap(__float_as_uint(m),__float_as_uint(m),false,false);
  return max2f(__uint_as_float(rr[0]),__uint_as_float(rr[1]));
}
__device__ __forceinline__ void pv(f32x16*o,int vb,bf16x8 pa0,bf16x8 pa1,bf16x8 pa2,bf16x8 pa3){
  #pragma unroll
  for(int d0=0;d0<2;++d0){s16x4 lo[4],hi[4];
    #pragma unroll
    for(int ks=0;ks<4;++ks){
      asm volatile("ds_read_b64_tr_b16 %0,%1 offset:%c2":"=&v"(lo[ks]):"v"(vb),"i"(d0*4096+ks*1024):"memory");
      asm volatile("ds_read_b64_tr_b16 %0,%1 offset:%c2":"=&v"(hi[ks]):"v"(vb),"i"(d0*4096+ks*1024+512):"memory");}
    asm volatile("s_waitcnt lgkmcnt(0)":::"memory");SBAR();
    #define PK(k) (bf16x8){lo[k][0],lo[k][1],lo[k][2],lo[k][3],hi[k][0],hi[k][1],hi[k][2],hi[k][3]}
    o[d0]=__builtin_amdgcn_mfma_f32_32x32x16_bf16(pa0,PK(0),o[d0],0,0,0);
    o[d0]=__builtin_amdgcn_mfma_f32_32x32x16_bf16(pa1,PK(1),o[d0],0,0,0);
    o[d0]=__builtin_amdgcn_mfma_f32_32x32x16_bf16(pa2,PK(2),o[d0],0,0,0);
    o[d0]=__builtin_amdgcn_mfma_f32_32x32x16_bf16(pa3,PK(3),o[d0],0,0,0);
    #undef PK
  }
}

#ifndef ATTN_STORE16
#define ATTN_STORE16(p,v) (*(u32x4*)(p)=(v))
#endif
template<int THRL> __device__ __forceinline__ void attn_unit(int b,int h,int qb,const bf16*Q,const bf16*__restrict__ K,const bf16*__restrict__ V,bf16*O,const unsigned*__restrict__ MK,char*shm){
  const int tid=mk_tidx(),lane=tid&63,r32=lane&31,hi=lane>>5; const int wid=__builtin_amdgcn_readfirstlane(tid>>6);
  const long rowbase=(long)b*SEQ; const int q0=qb*QB;
  const bf16*Qw=Q+(rowbase+q0+wid*QBLK)*DM+h*D;
  const bf16*Kh=K+rowbase*DM+h*D,*Vh=V+rowbase*DM+h*D;
  const unsigned lds0=(unsigned)(uintptr_t)shm;
  float*wsf=(float*)(shm+LDS_WS)+wid*64;
  const bf16*ksrc=Kh+(long)lane*DM+wid*8;
  const bf16*vsrc=Vh+(long)(16*(wid&3)+(lane>>2))*DM+(wid>>2)*32+(lane&3)*8;
  const unsigned kdst=lds0+LDS_K+wid*1024, vdst=lds0+LDS_V+wid*1024;
  const unsigned*msrc=MK+((size_t)(b*SEQ+32*(8*qb+wid)+(lane&31))*64)*2+(lane>>5);     const unsigned mdst=lds0+LDS_MSK+wid*768;
  const __attribute__((address_space(3))) char*mrd=(__attribute__((address_space(3))) const char*)shm+LDS_MSK+wid*768+lane*4;
  int mq_cur=0,mq_n1=256,mq_n2=512;
  #define DMA_M(t,slot) glds4(msrc+(size_t)(t)*2,(unsigned)__builtin_amdgcn_readfirstlane(mdst+(slot)))
  #define MWORD() (*(const __attribute__((address_space(3))) unsigned*)(mrd+mq_cur))
  #define DMA_K(t,slot) glds16(ksrc+(long)(t)*KVBLK*DM,(unsigned)__builtin_amdgcn_readfirstlane(kdst+(slot)))
  #define DMA_V(t,slot) glds16(vsrc+(long)(t)*KVBLK*DM,(unsigned)__builtin_amdgcn_readfirstlane(vdst+(slot)))
  const int vb0=(int)(lds0+LDS_V)+((lane>>4)&1)*32+(lane&3)*8+(4*hi+((lane&15)>>2))*64;
  const char*Kbase=shm+LDS_K; bf16x8 kf[8];
  const lds_cptr shm3=(lds_cptr)shm; const lds_cptr kp0=shm3+LDS_K+hi*1024+r32*16; const lds_cptr vp0=shm3+LDS_V+((lane>>4)&1)*32+(lane&3)*8+(4*hi+((lane&15)>>2))*64;
  const int NT=(q0+QB)/KVBLK;
  DMA_M(0,0);DMA_M(1,256);DMA_K(0,0);DMA_V(0,0);DMA_K(1,SLOTB);
  bf16x8 qr[4];
  #pragma unroll
  for(int d0=0;d0<4;++d0)qr[d0]=*reinterpret_cast<const bf16x8*>(&Qw[(long)r32*DM+d0*16+hi*8]);
  float mhat=0.f,l_reg=0.f;f32x16 o[2];o[0]=f32x16{};o[1]=f32x16{};f32x16 negm=f32x16{};asm volatile("":"+v"(negm));
  const int qrel=wid*QBLK+r32;
  #define CMASK(P0,P1,t) do{}while(0)
  bool resc=false;
  #define START(P0,P1) do{ const float rm=rowmax(P0,P1); resc=false; \
    { const float dl=(rm>-1e30f)?rm:0.f; mhat=fadd_s(mhat,dl); \
      _Pragma("unroll") for(int r=0;r<16;++r){P0[r]=fsub_s(P0[r],dl);P1[r]=fsub_s(P1[r],dl);} \
      _Pragma("unroll") for(int r=0;r<16;++r)negm[r]=-mhat; asm volatile("":"+v"(negm)); } \
    _Pragma("unroll") for(int r=0;r<16;++r)P0[r]=__builtin_amdgcn_exp2f(P0[r]); }while(0)
  #define RESC() do{ if(resc){ asm volatile("s_waitcnt lgkmcnt(0)":::"memory"); \
      _Pragma("unroll") for(int d_=0;d_<2;++d_) _Pragma("unroll") for(int r=0;r<16;++r)o[d_][r]*=wsf[crow(r,hi)]; } }while(0)
  f32x16 pA0,pA1,pB0,pB1;
  int sl_prev=0,sl_cur=0,sl_next=SLOTB;
  #define ROT() do{sl_prev=sl_cur;sl_cur=sl_next;sl_next=(sl_next==(NSLOT-1)*SLOTB)?0:sl_next+SLOTB; const int mt_=mq_cur;mq_cur=mq_n1;mq_n1=mq_n2;mq_n2=mt_;}while(0)
  DMA_K(2,2*SLOTB);
  WAIT_BAR(3);
  qkt(pA0,pA1,Kbase,qr,negm,r32,hi);asm volatile("s_nop 15\n\ts_nop 7":"+v"(pA0),"+v"(pA1));CMASK(pA0,pA1,0);
  START(pA0,pA1);
  _Pragma("unroll") for(int r=0;r<16;++r)pA1[r]=__builtin_amdgcn_exp2f(pA1[r]);
  { const unsigned mw0=MWORD(); pA0[0]=mand<0>(pA0[0],mw0);pA1[0]=mand<16>(pA1[0],mw0);pA0[1]=mand<1>(pA0[1],mw0);pA1[1]=mand<17>(pA1[1],mw0);pA0[2]=mand<2>(pA0[2],mw0);pA1[2]=mand<18>(pA1[2],mw0);pA0[3]=mand<3>(pA0[3],mw0);pA1[3]=mand<19>(pA1[3],mw0);pA0[4]=mand<4>(pA0[4],mw0);pA1[4]=mand<20>(pA1[4],mw0);pA0[5]=mand<5>(pA0[5],mw0);pA1[5]=mand<21>(pA1[5],mw0);pA0[6]=mand<6>(pA0[6],mw0);pA1[6]=mand<22>(pA1[6],mw0);pA0[7]=mand<7>(pA0[7],mw0);pA1[7]=mand<23>(pA1[7],mw0);pA0[8]=mand<8>(pA0[8],mw0);pA1[8]=mand<24>(pA1[8],mw0);pA0[9]=mand<9>(pA0[9],mw0);pA1[9]=mand<25>(pA1[9],mw0);pA0[10]=mand<10>(pA0[10],mw0);pA1[10]=mand<26>(pA1[10],mw0);pA0[11]=mand<11>(pA0[11],mw0);pA1[11]=mand<27>(pA1[11],mw0);pA0[12]=mand<12>(pA0[12],mw0);pA1[12]=mand<28>(pA1[12],mw0);pA0[13]=mand<13>(pA0[13],mw0);pA1[13]=mand<29>(pA1[13],mw0);pA0[14]=mand<14>(pA0[14],mw0);pA1[14]=mand<30>(pA1[14],mw0);pA0[15]=mand<15>(pA0[15],mw0);pA1[15]=mand<31>(pA1[15],mw0); }
  WAIT_BAR(0);
  DMA_M(2,512);DMA_K(3,0);DMA_V(1,SLOTB);
  ROT();
  kload8(kf,kp0+sl_cur);
  WAIT_BAR(3);
  s16x4 vlo[8],vhi[8]; u32x4 pw0,pw1,pw2,pw3;
  #define PKW(P,B) cvtpk_s(P[B],P[B+1])
  #define PAF(k) __builtin_bit_cast(bf16x8,pw##k)
  #define VFR(i) (bf16x8){vlo[i][0],vlo[i][1],vlo[i][2],vlo[i][3],vhi[i][0],vhi[i][1],vhi[i][2],vhi[i][3]}
  #define PIN(x) asm volatile("":"+v"(x))
  #define MX3(a,b,c) __builtin_fmaxf(__builtin_fmaxf((a),(b)),(c))
  #define GAPA(MF,A0,A1,A2,A3,W0,W1,PW) do{ MF; sacc+=A0; sacc+=A1; sacc+=A2; sacc+=A3; PIN(sacc); W0; W1; PIN(PW); SBAR(); }while(0)
  #define EX(v) __builtin_amdgcn_exp2f(v)
  #define GAPB(MF,X,B,MO) do{ MF; X[B]=mand<MO+B>(EX(X[B]),mw_); X[B+1]=mand<MO+B+1>(EX(X[B+1]),mw_); X[B+2]=mand<MO+B+2>(EX(X[B+2]),mw_); X[B+3]=mand<MO+B+3>(EX(X[B+3]),mw_); PIN(X); SBAR(); }while(0)
  #define VRD(i) do{ vlo[i]=vtr(vp_+(((i)>>2)*4096+((i)&3)*1024)); vhi[i]=vtr(vp_+(((i)>>2)*4096+((i)&3)*1024+512)); }while(0)
  #define KRD(G,j) do{ if(G){ kload2(kf,kp0+sl_next,j); SBAR(); } }while(0)
  #define STEP(C0,C1,P0,P1,t,GK,GV,GL,GM) do{ SBAR(); \
    const lds_cptr vp_=vp0+sl_prev; \
    VRD(0); SBAR(); float sacc=(P0[0]+P0[1]); \
    GAPA(C0=__builtin_amdgcn_mfma_f32_32x32x16_bf16(kf[0],qr[0],negm,0,0,0), P0[2],P0[3],P0[4],P0[5],     pw0[0]=PKW(P0,0), pw0[1]=PKW(P0,2), pw0); \
    VRD(4); SBAR(); GAPA(C1=__builtin_amdgcn_mfma_f32_32x32x16_bf16(kf[1],qr[0],negm,0,0,0), P0[6],P0[7],P0[8],P0[9],     pw0[2]=PKW(P0,4), pw0[3]=PKW(P0,6), pw0); \
    VRD(1); SBAR(); GAPA(C0=__builtin_amdgcn_mfma_f32_32x32x16_bf16(kf[2],qr[1],C0,0,0,0),   P0[10],P0[11],P0[12],P0[13], pw1[0]=PKW(P0,8), pw1[1]=PKW(P0,10), pw1); \
    VRD(5); SBAR(); GAPA(C1=__builtin_amdgcn_mfma_f32_32x32x16_bf16(kf[3],qr[1],C1,0,0,0),   P0[14],P0[15],P1[0],P1[1],   pw1[2]=PKW(P0,12),pw1[3]=PKW(P0,14), pw1); \
    VRD(2); SBAR(); GAPA(C0=__builtin_amdgcn_mfma_f32_32x32x16_bf16(kf[4],qr[2],C0,0,0,0),   P1[2],P1[3],P1[4],P1[5],     pw2[0]=PKW(P1,0), pw2[1]=PKW(P1,2), pw2); \
    VRD(6); SBAR(); GAPA(C1=__builtin_amdgcn_mfma_f32_32x32x16_bf16(kf[5],qr[2],C1,0,0,0),   P1[6],P1[7],P1[8],P1[9],     pw2[2]=PKW(P1,4), pw2[3]=PKW(P1,6), pw2); \
    VRD(3); SBAR(); GAPA(C0=__builtin_amdgcn_mfma_f32_32x32x16_bf16(kf[6],qr[3],C0,0,0,0),   P1[10],P1[11],P1[12],P1[13], pw3[0]=PKW(P1,8), pw3[1]=PKW(P1,10), pw3); \
    VRD(7); SBAR(); GAPA(C1=__builtin_amdgcn_mfma_f32_32x32x16_bf16(kf[7],qr[3],C1,0,0,0),   P1[14],P1[15],0.f,0.f,       pw3[2]=PKW(P1,12),pw3[3]=PKW(P1,14), pw3); \
    l_reg+=sacc; \
    if(GM){DMA_M((t)+2,mq_n2);} if(GK){DMA_K((t)+3,sl_cur);} if(GV){DMA_V((t)+1,sl_next);} \
    const unsigned mw_=MWORD(); \
    CMASK(C0,C1,t); \
    { float a=MX3(C0[0],C0[1],C1[0]),b=MX3(C0[2],C0[3],C1[1]); a=MX3(a,C1[2],C1[3]); \
      _Pragma("unroll") for(int r=4;r<16;r+=4){a=MX3(a,C0[r],C0[r+1]);b=MX3(b,C0[r+2],C0[r+3]);a=MX3(a,C1[r],C1[r+1]);b=MX3(b,C1[r+2],C1[r+3]);} \
      float rm=__builtin_fmaxf(a,b); { auto rr=__builtin_amdgcn_permlane32_swap(__float_as_uint(rm),__float_as_uint(rm),false,false); rm=__builtin_fmaxf(__uint_as_float(rr[0]),__uint_as_float(rr[1])); } \
      resc=false; \
      if(__builtin_expect(__any(rm>(float)THRL),0)){ const float dl=__builtin_fmaxf(rm,0.f); mhat+=dl; \
        _Pragma("unroll") for(int r=0;r<16;++r){C0[r]-=dl;C1[r]-=dl;} \
        _Pragma("unroll") for(int r=0;r<16;++r)negm[r]=-mhat; asm volatile("":"+v"(negm)); \
        const float f=__builtin_amdgcn_exp2f(-dl); l_reg*=f; if(hi==0)wsf[r32]=f; resc=true; } } \
    SBAR(); \
    GAPB(o[0]=__builtin_amdgcn_mfma_f32_32x32x16_bf16(PAF(0),VFR(0),o[0],0,0,0), C0,0,0); \
    GAPB(o[1]=__builtin_amdgcn_mfma_f32_32x32x16_bf16(PAF(0),VFR(4),o[1],0,0,0), C0,4,0); \
    KRD(GL,0); GAPB(o[0]=__builtin_amdgcn_mfma_f32_32x32x16_bf16(PAF(1),VFR(1),o[0],0,0,0), C0,8,0); \
    KRD(GL,1); GAPB(o[1]=__builtin_amdgcn_mfma_f32_32x32x16_bf16(PAF(1),VFR(5),o[1],0,0,0), C0,12,0); \
    KRD(GL,2); GAPB(o[0]=__builtin_amdgcn_mfma_f32_32x32x16_bf16(PAF(2),VFR(2),o[0],0,0,0), C1,0,16); \
    KRD(GL,3); GAPB(o[1]=__builtin_amdgcn_mfma_f32_32x32x16_bf16(PAF(2),VFR(6),o[1],0,0,0), C1,4,16); \
    GAPB(o[0]=__builtin_amdgcn_mfma_f32_32x32x16_bf16(PAF(3),VFR(3),o[0],0,0,0), C1,8,16); \
    GAPB(o[1]=__builtin_amdgcn_mfma_f32_32x32x16_bf16(PAF(3),VFR(7),o[1],0,0,0), C1,12,16); \
    }while(0)
  int t=1;
  #undef CMASK
  #define CMASK(P0,P1,t) do{}while(0)
  for(;t+5<NT;t+=2){
    STEP(pB0,pB1,pA0,pA1,t,true,true,true,true);     WAIT_BAR(3); RESC(); ROT();
    STEP(pA0,pA1,pB0,pB1,t+1,true,true,true,true);   WAIT_BAR(3); RESC(); ROT();
  }
  #undef CMASK
  #define CMASK(P0,P1,t) do{}while(0)
  #define ENDW(tt) do{ if((tt)+3<NT){WAIT_BAR(3);} else if((tt)+2<NT){WAIT_BAR(2);} else {WAIT_BAR(0);} }while(0)
  for(;t+1<NT;t+=2){
    STEP(pB0,pB1,pA0,pA1,t,(t+3<NT),(t+1<NT),(t+1<NT),(t+2<NT));       ENDW(t);   RESC(); ROT();
    STEP(pA0,pA1,pB0,pB1,t+1,(t+4<NT),(t+2<NT),(t+2<NT),(t+3<NT));     ENDW(t+1); RESC(); ROT();
  }
  STEP(pB0,pB1,pA0,pA1,NT-1,false,false,false,false); RESC();
  { float sacc=pB0[0]+pB0[1]; _Pragma("unroll") for(int r=2;r<16;++r)sacc+=pB0[r]; _Pragma("unroll") for(int r=0;r<16;++r)sacc+=pB1[r]; l_reg+=sacc;
    pw0=(u32x4){PKW(pB0,0),PKW(pB0,2),PKW(pB0,4),PKW(pB0,6)};pw1=(u32x4){PKW(pB0,8),PKW(pB0,10),PKW(pB0,12),PKW(pB0,14)};pw2=(u32x4){PKW(pB1,0),PKW(pB1,2),PKW(pB1,4),PKW(pB1,6)};pw3=(u32x4){PKW(pB1,8),PKW(pB1,10),PKW(pB1,12),PKW(pB1,14)};
    SBAR(); pv(o,vb0+sl_cur,PAF(0),PAF(1),PAF(2),PAF(3)); }
  #undef PKW
  #undef PAF
  #undef VFR
  #undef PIN
  #undef MX3
  #undef GAPA
  #undef GAPB
  #undef EX
  #undef VRD
  #undef KRD
  #undef STEP
  #undef ENDW
  {auto rr=__builtin_amdgcn_permlane32_swap(__float_as_uint(l_reg),__float_as_uint(l_reg),false,false);l_reg=__uint_as_float(rr[0])+__uint_as_float(rr[1]);}
  if(hi==0)wsf[32+r32]=l_reg;asm volatile("s_waitcnt lgkmcnt(0)":::"memory");
  float rli[16];
  #pragma unroll
  for(int r=0;r<16;++r)rli[r]=__builtin_amdgcn_rcpf(wsf[32+crow(r,hi)]);
  bf16*Ow=O+(rowbase+q0+wid*QBLK)*ODM+h*D;
  { bf16*stg=(bf16*)(shm+LDS_OST)+wid*2048;
    #pragma unroll
    for(int r=0;r<16;++r){const int orow=crow(r,hi);
      #pragma unroll
      for(int d0=0;d0<2;++d0)stg[orow*64+d0*32+r32]=(bf16)(cvtpk_s(o[d0][r]*rli[r],0.f)&0xffffu);}
    asm volatile("s_waitcnt lgkmcnt(0)":::"memory");
    #pragma unroll
    for(int i=0;i<4;++i){const int row=i*8+(lane>>3),ch=lane&7; const u32x4 v=*(const u32x4*)(stg+row*64+ch*8); ATTN_STORE16(Ow+(long)row*ODM+ch*8,v);} }
  asm volatile("s_waitcnt lgkmcnt(0)\n\ts_barrier":::"memory");
  #undef DMA_K
  #undef DMA_V
  #undef DMA_M
  #undef MWORD
  #undef CMASK
  #undef START
  #undef RESC
  #undef ROT
}
constexpr int ATTN_LDS_BYTES=LDS_BYTES;
struct AttnTensors { const bf16* Q; const bf16* K; const bf16* V; bf16* O; const unsigned* MK; };
struct AttnUnit { int bh; int qb; };
struct StaticOrder {
  int vcu;
  __device__ __forceinline__ explicit StaticOrder(int grid,int block):vcu((block%8)*(grid/8)+block/8){}
  __device__ __forceinline__ bool next(int i,AttnUnit&u)const{ if(i>=2)return false; const int s=vcu&7; u.bh=vcu>>3; u.qb=(i==0)?15-s:s; return true; }
  __device__ __forceinline__ void a_ready(const AttnUnit&)const{}
  __device__ __forceinline__ void done(const AttnUnit&)const{}
};
template<class Sched,int THRL=8> __device__ __forceinline__ void attn_phase(char*lds,const AttnTensors&T,const Sched&S){
  AttnUnit u;
  for(int i=0;S.next(i,u);++i){ S.a_ready(u); attn_unit<THRL>(u.bh/NHEAD,u.bh%NHEAD,u.qb,T.Q,T.K,T.V,T.O,T.MK,lds); S.done(u); }
}
#undef SBAR
#undef WAIT_BAR
}
namespace mk {
#define GAS __attribute__((address_space(1)))
typedef unsigned short bf16_t;
typedef float f32x4 __attribute__((ext_vector_type(4)));
typedef float f32x2 __attribute__((ext_vector_type(2)));
typedef float f32x16 __attribute__((ext_vector_type(16)));
typedef unsigned u32x4 __attribute__((ext_vector_type(4)));
typedef unsigned u32x2 __attribute__((ext_vector_type(2)));
typedef short bf16x8 __attribute__((ext_vector_type(8)));
constexpr int NB = 4, S = 4096, T = NB * S, D = 1024;
constexpr int NWAVES = 8, NTHR = 512;
constexpr int INW = 4168;
constexpr int NPHYS = 4352;
constexpr float C2 = 0.125f * 1.4426950408889634f;
constexpr float WI_SCALE = 0.04419417382415922f;
constexpr float KR_SCALE = 0.08838834764831845f;
constexpr size_t MiB = 1u << 20;
#ifndef WS_RT_MIB
#define WS_RT_MIB 65
#endif
constexpr size_t WS_CTL = 0, CTL_BYTES = 131072;
constexpr size_t WS_MOD = 1 * MiB;
constexpr size_t WS_THR = 2 * MiB;
constexpr size_t WS_R128 = 3 * MiB;
constexpr size_t WS_R64 = 11 * MiB;
constexpr size_t WS_WOUT = 15 * MiB;
constexpr size_t WS_QA = 17 * MiB, WS_KA = 33 * MiB, WS_VA = 49 * MiB, WS_QI = 65 * MiB, WS_KI = 81 * MiB, WS_WI = 83 * MiB;
constexpr size_t WS_QR = 84 * MiB, WS_KR = 100 * MiB, WS_VR = 116 * MiB, WS_GR = 132 * MiB;
constexpr size_t WS_H = 148 * MiB;
constexpr size_t WS_WIN = 180 * MiB;
constexpr size_t WS_SCORES = 148 * MiB, WS_KVS = 214 * MiB, WS_MASKT = 246 * MiB, WS_RT = WS_RT_MIB * MiB, WS_MIXED = 148 * MiB;
constexpr int CW_BAR = 1024, CW_Q = 14400, CW_TMO = 14600;
constexpr int RING_BYTES = 131072;
constexpr int LDS_BYTES = 163840;
constexpr int MISC_OFF = LDS_BYTES - 1024;

typedef __bf16 bf16x2_t __attribute__((ext_vector_type(2)));
__device__ __forceinline__ unsigned cvt_pk(float lo, float hi) { const f32x2 v = {lo, hi}; const bf16x2_t b = __builtin_convertvector(v, bf16x2_t); return __builtin_bit_cast(unsigned, b); }
__device__ __forceinline__ float bf2f(bf16_t v) { return __uint_as_float((unsigned)v << 16); }
__device__ __forceinline__ float silu_f(float x) { return x / (1.f + __expf(-x)); }
#define MK_DPP_ADD(v, ctrl) v += __uint_as_float((unsigned)__builtin_amdgcn_update_dpp(0, (int)__float_as_uint(v), ctrl, 0xf, 0xf, false))
__device__ __forceinline__ float wave_sum(float v) {
    MK_DPP_ADD(v, 0xB1);
    MK_DPP_ADD(v, 0x4E);
    MK_DPP_ADD(v, 0x141);
    MK_DPP_ADD(v, 0x140);
    { const unsigned u = __float_as_uint(v); auto r = __builtin_amdgcn_permlane16_swap(u, u, false, false); v = __uint_as_float(r[0]) + __uint_as_float(r[1]); }
    { const unsigned u = __float_as_uint(v); auto r = __builtin_amdgcn_permlane32_swap(u, u, false, false); v = __uint_as_float(r[0]) + __uint_as_float(r[1]); }
    return v;
}
__host__ __device__ __forceinline__ int perm_fwd(int o, int half) { const int hi = o >= half ? 1 : 0, oo = o - hi * half; return 8 * (oo >> 2) + 4 * hi + (oo & 3); }
__host__ __device__ __forceinline__ int perm_inv(int p, int half) { const int g = p >> 3, r = p & 7; return (r < 4) ? 4 * g + r : half + 4 * g + (r - 4); }
__device__ __forceinline__ int in_src_col(int n) {
    const int tile = n >> 8;
    if (tile < 2) { const int s = n; return 0 + (s & ~63) + perm_inv(s & 63, 32); }
    if (tile < 4) { const int s = n - 512; return 512 + (s & ~63) + perm_inv(s & 63, 32); }
    if (tile < 6) return n;
    if (tile < 8) { const int s = n - 1536; return 1536 + (s & ~63) + perm_inv(s & 63, 32); }
    if (tile == 8) { const int s = n - 2048; if (s < 64) return 2048 + perm_inv(s, 32); if (s < 72) return 2112 + (s - 64); return -1; }
    const int s = n - 2304;
    if (tile < 11) return 2120 + (s & ~127) + perm_inv(s & 127, 64);
    if (tile < 13) { const int q = s - 512; return 2632 + (q & ~127) + perm_inv(q & 127, 64); }
    if (tile < 15) return 3144 + (s - 1024);
    return 3656 + (s - 1536);
}
__device__ __forceinline__ void p0_item_ada(LAS unsigned char* lds, const float* c, const float* w_ada, const float* b_ada, float* mod, int j, int tid) {
    LAS float* sc = (LAS float*)lds; LAS float* part = (LAS float*)(lds + 16384);
    __syncthreads();
    for (int i = tid; i < 4096; i += NTHR) sc[i] = silu_f(c[i]);
    __syncthreads();
    const int col = tid & 31, kg = tid >> 5;
    float a0 = 0.f, a1 = 0.f, a2 = 0.f, a3 = 0.f;
    const float* w = w_ada + 32 * j + col;
#pragma unroll 1
    for (int k0 = kg; k0 < 1024; k0 += 256) {
        float wv[16];
#pragma unroll
        for (int i = 0; i < 16; ++i) wv[i] = w[(size_t)(k0 + 16 * i) * 6144];
#pragma unroll
        for (int i = 0; i < 16; ++i) { const int k = k0 + 16 * i; a0 += sc[k] * wv[i]; a1 += sc[1024 + k] * wv[i]; a2 += sc[2048 + k] * wv[i]; a3 += sc[3072 + k] * wv[i]; }
    }
    part[(kg * 32 + col) * 4 + 0] = a0; part[(kg * 32 + col) * 4 + 1] = a1; part[(kg * 32 + col) * 4 + 2] = a2; part[(kg * 32 + col) * 4 + 3] = a3;
    __syncthreads();
    if (tid < 128) {
        const int cc = tid >> 2, b = tid & 3; float s = 0.f;
#pragma unroll
        for (int g = 0; g < 16; ++g) s += part[(g * 32 + cc) * 4 + b];
        mod[b * 6144 + 32 * j + cc] = s + b_ada[32 * j + cc];
    }
}
__device__ __forceinline__ void p0_item_rope(const int* pos, float* R128, float* R64, int r, int lane) {
    const float f128 = powf(10000.f, -(float)lane / 64.f), f64 = powf(10000.f, -(float)(lane & 31) / 32.f);
    for (int tt = 0; tt < 16; ++tt) {
        const int t = 16 * r + tt;
        float sn, cs; sincosf((float)pos[t] * f128, &sn, &cs);
        *(f32x2*)(R128 + ((size_t)t * 64 + lane) * 2) = (f32x2){cs, sn};
    }
    for (int tt = 0; tt < 16; tt += 2) {
        const int t = 16 * r + tt + (lane >> 5);
        float sn, cs; sincosf((float)pos[t] * f64, &sn, &cs);
        *(f32x2*)(R64 + ((size_t)t * 32 + (lane & 31)) * 2) = (f32x2){cs, sn};
    }
}
template <int MODE> struct TrItem { const float* sp; int ldw, Kdim, n0, k0; bf16_t* WT; bool valid; };
template <int MODE> __device__ __forceinline__ void p0_tr_setup(TrItem<MODE>& it, const float* W, const float* W2, int ldw, int Kdim, bf16_t* WT, int n0, int k0, int lane) {
    const int nl = lane & 31, n = n0 + nl;
    int src = n; const float* Ws = W;
    if (MODE == 0) src = in_src_col(n);
    if (MODE == 2) { const int g = n >> 3, r = n & 7; src = 4 * g + (r & 3); Ws = (r < 4) ? W : W2; }
    it.sp = Ws + (size_t)(k0 + (lane >> 5)) * ldw + (src >= 0 ? src : 0); it.ldw = ldw; it.Kdim = Kdim; it.n0 = n0; it.k0 = k0; it.WT = WT; it.valid = (src >= 0);
}
template <int MODE> __device__ __forceinline__ void p0_tr_load(const TrItem<MODE>& it, float (&tv)[32]) {
#pragma unroll
    for (int i = 0; i < 32; ++i) tv[i] = it.sp[(size_t)(2 * i) * it.ldw];
}
template <int MODE> __device__ __forceinline__ void p0_tr_emit(const TrItem<MODE>& it, const float (&tv)[32], LAS float* scr, int lane) {
    const int nl = lane & 31;
#pragma unroll
    for (int i = 0; i < 32; ++i) scr[(2 * i + (lane >> 5)) * 33 + nl] = it.valid ? tv[i] : 0.f;
    asm volatile("s_waitcnt lgkmcnt(0)" ::: "memory");
    const int c = lane & 7;
#pragma unroll
    for (int j = 0; j < 4; ++j) {
        const int nn = (lane >> 3) + 8 * j; const LAS float* q = scr + (8 * c) * 33 + nn;
        u32x4 o; o.x = cvt_pk(q[0 * 33], q[1 * 33]); o.y = cvt_pk(q[2 * 33], q[3 * 33]); o.z = cvt_pk(q[4 * 33], q[5 * 33]); o.w = cvt_pk(q[6 * 33], q[7 * 33]);
        *(u32x4*)(it.WT + (size_t)(it.n0 + nn) * it.Kdim + it.k0 + 8 * c) = o;
    }
    asm volatile("s_waitcnt lgkmcnt(0)" ::: "memory");
}
template <int MODE> __device__ __forceinline__ void p0_tr_item(const float* W, const float* W2, int ldw, int Kdim, bf16_t* WT, int n0, int k0, LAS float* scr, int lane) {
    TrItem<MODE> it; p0_tr_setup<MODE>(it, W, W2, ldw, Kdim, WT, n0, k0, lane);
    float tv[32]; p0_tr_load<MODE>(it, tv); p0_tr_emit<MODE>(it, tv, scr, lane);
}
struct P0Args { const float *c, *w_ada, *b_ada, *w_in, *w_out, *w_gate, *w_up, *w_down; const int* pos; float *mod, *R128, *R64; bf16_t *WIN, *WOUT, *WGU, *WD; };
__device__ __forceinline__ void p0_prologue(LAS unsigned char* lds, const P0Args& a, int bid, int G, int tid) {
    const int lane = tid & 63, wave = tid >> 6;
    if (bid < 192) p0_item_ada(lds, a.c, a.w_ada, a.b_ada, a.mod, bid, tid);
    __syncthreads();
    LAS float* scr = (LAS float*)(lds + wave * 8448);
    constexpr int I_ROPE = 1024, I_WIN = 16 * (NPHYS / 32), I_WOUT = 16 * 32;
    for (int it = bid * NWAVES + wave; it < I_ROPE + I_WIN + I_WOUT; it += G * NWAVES) {
        int r = it;
        if (r < I_ROPE) { p0_item_rope(a.pos, a.R128, a.R64, r, lane); continue; } r -= I_ROPE;
        if (r < I_WIN) { const int kb = r / (NPHYS / 32), nb = r - kb * (NPHYS / 32); p0_tr_item<0>(a.w_in, nullptr, INW, 1024, a.WIN, 32 * nb, 64 * kb, scr, lane); continue; } r -= I_WIN;
        { const int kb = r >> 5, nb = r & 31; p0_tr_item<1>(a.w_out, nullptr, 1024, 1024, a.WOUT, 32 * nb, 64 * kb, scr, lane); }
    }
}
__device__ __forceinline__ void p0_expert_items(LAS unsigned char* lds, const P0Args& a, int gw, int ngw, int tid) {
    const int lane = tid & 63, wave = tid >> 6;
    LAS float* scr = (LAS float*)(lds + wave * 8448);
    constexpr int I_WGU = 32 * 256, I_WD = 32 * 128;
    {
        TrItem<2> cur, nxt; float tv[32], tn[32];
        int it = gw;
        if (it < I_WGU) { const int e = it >> 8, q = it & 255, kb = q >> 4, nb = q & 15;
            p0_tr_setup<2>(cur, a.w_gate + (size_t)e * 262144, a.w_up + (size_t)e * 262144, 256, 1024, a.WGU + (size_t)e * 524288, 32 * nb, 64 * kb, lane); p0_tr_load<2>(cur, tv); }
#pragma unroll 1
        for (; it < I_WGU; it += ngw) {
            const int i2 = it + ngw; const bool has = i2 < I_WGU;
            if (has) { const int e = i2 >> 8, q = i2 & 255, kb = q >> 4, nb = q & 15;
                p0_tr_setup<2>(nxt, a.w_gate + (size_t)e * 262144, a.w_up + (size_t)e * 262144, 256, 1024, a.WGU + (size_t)e * 524288, 32 * nb, 64 * kb, lane); p0_tr_load<2>(nxt, tn); }
            p0_tr_emit<2>(cur, tv, scr, lane);
            if (has) { cur = nxt;
#pragma unroll
                for (int i = 0; i < 32; ++i) tv[i] = tn[i]; }
        }
    }
    {
        TrItem<1> cur, nxt; float tv[32], tn[32];
        int it = gw;
        if (it < I_WD) { const int e = it >> 7, q = it & 127, kb = q >> 5, nb = q & 31;
            p0_tr_setup<1>(cur, a.w_down + (size_t)e * 262144, nullptr, 1024, 256, a.WD + (size_t)e * 262144, 32 * nb, 64 * kb, lane); p0_tr_load<1>(cur, tv); }
#pragma unroll 1
        for (; it < I_WD; it += ngw) {
            const int i2 = it + ngw; const bool has = i2 < I_WD;
            if (has) { const int e = i2 >> 7, q = i2 & 127, kb = q >> 5, nb = q & 31;
                p0_tr_setup<1>(nxt, a.w_down + (size_t)e * 262144, nullptr, 1024, 256, a.WD + (size_t)e * 262144, 32 * nb, 64 * kb, lane); p0_tr_load<1>(nxt, tn); }
            p0_tr_emit<1>(cur, tv, scr, lane);
            if (has) { cur = nxt;
#pragma unroll
                for (int i = 0; i < 32; ++i) tv[i] = tn[i]; }
        }
    }
}
__device__ __forceinline__ void p1_row_load(f32x4 (&v)[4], const float* x, int m, int lane) {
    const f32x4* xr = (const f32x4*)(x + (size_t)m * D) + lane;
#pragma unroll
    for (int j = 0; j < 4; ++j) v[j] = xr[64 * j];
}
__device__ __forceinline__ void p1_rows(const float* x, const float* g, const float* mod, bf16_t* H, int gw, int NGW, int lane) {
#pragma unroll 1
    for (int m0 = gw * 8; m0 < T; m0 += NGW * 8) {
        f32x4 v[4][4];
        p1_row_load(v[0], x, m0, lane); p1_row_load(v[1], x, m0 + 1, lane); p1_row_load(v[2], x, m0 + 2, lane);
        const int b = m0 / S;
        const float* sh = mod + b * 6144; const float* sc = sh + 1024;
        f32x4 G[4], SH[4];
#pragma unroll
        for (int j = 0; j < 4; ++j) { const int col = 4 * lane + 256 * j; const f32x4 gg = *(const f32x4*)(g + col), a = *(const f32x4*)(sc + col); SH[j] = *(const f32x4*)(sh + col); G[j] = gg * (a + 1.0f); }
#pragma unroll
        for (int i = 0; i < 8; ++i) {
            if (i + 3 < 8) p1_row_load(v[(i + 3) & 3], x, m0 + i + 3, lane);
            const f32x4 (&c)[4] = v[i & 3];
            float s = 0.f;
#pragma unroll
            for (int j = 0; j < 4; ++j) s += (c[j].x * c[j].x + c[j].y * c[j].y) + (c[j].z * c[j].z + c[j].w * c[j].w);
            const float rs = 1.0f / sqrtf(wave_sum(s) * (1.f / 1024.f) + 1e-6f);
            bf16_t* orow = H + (size_t)(m0 + i) * D;
#pragma unroll
            for (int j = 0; j < 4; ++j) {
                const f32x4 o = c[j] * rs * G[j] + SH[j];
                u32x2 w; w.x = cvt_pk(o.x, o.y); w.y = cvt_pk(o.z, o.w);
                *(u32x2*)(orow + 4 * lane + 256 * j) = w;
            }
        }
    }
}
struct EpiInProj {
    static constexpr bool PERM = true, AFTER_DRAIN = false;
    bf16_t *QA, *KA, *VA, *QI, *KI, *QR, *KR, *VR, *GR; float* WI; const float* R64; const float* R128;
    template <int ROPE, int ACT> __device__ __forceinline__ void emit(const pg8::f32x4 (&acc)[2][2][4][2], bf16_t* dst, int ld, int segbase, float scale, int row0, int wc, int fq, int bjmask) const {
#pragma unroll
        for (int bj = 0; bj < 2; ++bj) {
            if (!((bjmask >> bj) & 1)) continue;
            const int cg = segbase + 128 * bj + 32 * wc + 8 * fq;
            const int fi = (ROPE == 1) ? ((cg & 63) >> 1) : ((cg & 127) >> 1);
#pragma unroll
            for (int ai = 0; ai < 2; ++ai)
#pragma unroll
                for (int m = 0; m < 4; ++m) {
                    const int row = row0 + ai * 128 + m * 16;
                    pg8::f32x4 v0 = acc[ai][bj][m][0], v1 = acc[ai][bj][m][1];
                    if (ROPE != 0) {
                        const float* tp = (ROPE == 1) ? (R64 + ((size_t)row * 32 + fi) * 2) : (R128 + ((size_t)row * 64 + fi) * 2);
                        const pg8::f32x4 t0 = *(const pg8::f32x4*)tp, t1 = *(const pg8::f32x4*)(tp + 4);
                        pg8::f32x4 o1, o2;
                        o1[0] = v0[0] * t0[0] - v1[0] * t0[1]; o2[0] = v1[0] * t0[0] + v0[0] * t0[1];
                        o1[1] = v0[1] * t0[2] - v1[1] * t0[3]; o2[1] = v1[1] * t0[2] + v0[1] * t0[3];
                        o1[2] = v0[2] * t1[0] - v1[2] * t1[1]; o2[2] = v1[2] * t1[0] + v0[2] * t1[1];
                        o1[3] = v0[3] * t1[2] - v1[3] * t1[3]; o2[3] = v1[3] * t1[2] + v0[3] * t1[3];
                        v0 = o1; v1 = o2;
                    }
                    if (ACT == 1) {
#pragma unroll
                        for (int e = 0; e < 4; ++e) { v0[e] = silu_f(v0[e]); v1[e] = silu_f(v1[e]); }
                    }
                    v0 = v0 * scale; v1 = v1 * scale;
                    u32x4 w; w.x = cvt_pk(v0[0], v0[1]); w.y = cvt_pk(v0[2], v0[3]); w.z = cvt_pk(v1[0], v1[1]); w.w = cvt_pk(v1[2], v1[3]);
                    *(u32x4*)(dst + (size_t)row * ld + cg) = w;
                }
        }
    }
    __device__ __forceinline__ void operator()(const pg8::f32x4 (&acc)[2][2][4][2], const pg8::Unit& u, int wr, int wc, int fr, int fq) const {
        const int row0 = u.pm * 256 + wr * 64 + fr;
        const int pn = u.pn;
        if (pn < 2) emit<1, 0>(acc, QA, 512, pn * 256, C2, row0, wc, fq, 3);
        else if (pn < 4) emit<1, 0>(acc, KA, 512, (pn - 2) * 256, 1.f, row0, wc, fq, 3);
        else if (pn < 6) emit<0, 0>(acc, VA, 512, (pn - 4) * 256, 1.f, row0, wc, fq, 3);
        else if (pn < 8) emit<1, 0>(acc, QI, 512, (pn - 6) * 256, 1.f, row0, wc, fq, 3);
        else if (pn == 8) {
            if (wc < 2) emit<1, 0>(acc, KI, 64, 0, 1.f, row0, wc, fq, 1);
            else if (wc == 2 && fq == 0) {
#pragma unroll
                for (int ai = 0; ai < 2; ++ai)
#pragma unroll
                    for (int m = 0; m < 4; ++m) {
                        const int row = row0 + ai * 128 + m * 16;
                        *(pg8::f32x4*)(WI + (size_t)row * 8) = acc[ai][0][m][0] * WI_SCALE;
                        *(pg8::f32x4*)(WI + (size_t)row * 8 + 4) = acc[ai][0][m][1] * WI_SCALE;
                    }
            }
        }
        else if (pn < 11) emit<2, 0>(acc, QR, 512, (pn - 9) * 256, 1.f, row0, wc, fq, 3);
        else if (pn < 13) emit<2, 0>(acc, KR, 512, (pn - 11) * 256, KR_SCALE, row0, wc, fq, 3);
        else if (pn < 15) emit<0, 0>(acc, VR, 512, (pn - 13) * 256, 1.f, row0, wc, fq, 3);
        else emit<0, 1>(acc, GR, 512, (pn - 15) * 256, 1.f, row0, wc, fq, 3);
    }
};
typedef short v4i16_t __attribute__((ext_vector_type(4)));
__device__ __forceinline__ unsigned off_b(unsigned row, unsigned ch) { return 256u * row + 16u * (ch ^ (((row & 3u) << 2) | ((row >> 2) & 3u))); }
__device__ __forceinline__ int crow(int r, int hi) { return (r & 3) + 8 * (r >> 2) + 4 * hi; }
__device__ __forceinline__ v4i16_t tr_rd(LAS unsigned char* p) { return __builtin_amdgcn_ds_read_tr16_b64_v4i16((LAS v4i16_t*)p); }
__device__ __forceinline__ bf16x8 tr_frag_nat(LAS unsigned char* img, int lane, int c, int ks) {
    const unsigned h = lane >> 5, blk = (lane >> 4) & 1, q = (lane & 15) >> 2, p = lane & 3;
    const v4i16_t lo = tr_rd(img + off_b(16 * ks + 8 * h + q, 4 * c + 2 * blk + (p >> 1)) + 8 * (p & 1));
    const v4i16_t hi = tr_rd(img + off_b(16 * ks + 8 * h + 4 + q, 4 * c + 2 * blk + (p >> 1)) + 8 * (p & 1));
    return (bf16x8){lo[0], lo[1], lo[2], lo[3], hi[0], hi[1], hi[2], hi[3]};
}
__device__ __forceinline__ bf16x8 tr_frag_acc(LAS unsigned char* img, int lane, int c, int rowbase) {
    const unsigned h = lane >> 5, blk = (lane >> 4) & 1, q = (lane & 15) >> 2, p = lane & 3;
    const v4i16_t lo = tr_rd(img + off_b(rowbase + 4 * h + q, 4 * c + 2 * blk + (p >> 1)) + 8 * (p & 1));
    const v4i16_t hi = tr_rd(img + off_b(rowbase + 8 + 4 * h + q, 4 * c + 2 * blk + (p >> 1)) + 8 * (p & 1));
    return (bf16x8){lo[0], lo[1], lo[2], lo[3], hi[0], hi[1], hi[2], hi[3]};
}
__device__ __forceinline__ float ret_lgam(int h) { return logf(1.0f - exp2f(-5.0f - (float)h)); }
template <bool SCALE> __device__ __forceinline__ void ret_stage(LAS unsigned char* img, const bf16_t* src  , float sc, int tl) {
#pragma unroll
    for (int it = 0; it < 8; ++it) {
        const int idx = tl + 256 * it, row = idx >> 4, ch = idx & 15;
        u32x4 v = *(const u32x4*)(src + (size_t)row * 512 + ch * 8);
        if (SCALE) {
            const float f = expf(sc * (float)row);
#pragma unroll
            for (int e = 0; e < 4; ++e) { const unsigned w = v[e]; v[e] = cvt_pk(__uint_as_float(w << 16) * f, __uint_as_float(w & 0xffff0000u) * f); }
        }
        *(LAS u32x4*)(img + off_b(row, ch)) = v;
    }
}
__device__ __forceinline__ void ret_kv_pair(LAS unsigned char* lds, const bf16_t* KR, const bf16_t* VR, float* KVS, int pair, int tid) {
    const int uh = tid >> 8, tl = tid & 255, lane = tid & 63, w4 = __builtin_amdgcn_readfirstlane((tid >> 6) & 3), hi = lane >> 5, r32 = lane & 31;
    const int unit = pair * 2 + uh, n = unit & 31, bh = unit >> 5, b = bh >> 2, h = bh & 3;
    const size_t tok0 = (size_t)b * S + (size_t)n * 128;
    LAS unsigned char* kimg = lds + uh * 65536; LAS unsigned char* vimg = kimg + 32768;
    const float lgam = ret_lgam(h);
    __syncthreads();
    ret_stage<false>(kimg, KR + tok0 * 512 + h * 128, 0.f, tl);
    ret_stage<true>(vimg, VR + tok0 * 512 + h * 128, -lgam, tl);
    __syncthreads();
    f32x16 acc[4];
#pragma unroll
    for (int c = 0; c < 4; ++c) acc[c] = (f32x16){};
#pragma unroll
    for (int ks = 0; ks < 8; ++ks) {
        const bf16x8 a = tr_frag_nat(vimg, lane, w4, ks);
#pragma unroll
        for (int nt = 0; nt < 4; ++nt) { const bf16x8 bb = tr_frag_nat(kimg, lane, nt, ks); acc[nt] = __builtin_amdgcn_mfma_f32_32x32x16_bf16(a, bb, acc[nt], 0, 0, 0); }
    }
    const float sc = expf(lgam * 127.f);
    float* o = KVS + (size_t)unit * 16384;
#pragma unroll
    for (int nt = 0; nt < 4; ++nt)
#pragma unroll
        for (int r = 0; r < 16; ++r) o[(32 * w4 + crow(r, hi)) * 128 + 32 * nt + r32] = acc[nt][r] * sc;
}
__device__ __forceinline__ void ret_scan(const float* __restrict__ KVS, bf16_t* __restrict__ RT, int gtid, int nthreads) {
    for (int idx = gtid; idx < 16 * 16384; idx += nthreads) {
        const int bh = idx >> 14, el = idx & 16383, h = bh & 3;
        const float g = 1.0f - exp2f(-5.0f - (float)h), g128 = expf(128.f * ret_lgam(h));
        const size_t o0 = ((size_t)(bh * 32) << 14) + el;
        float kv[31];
#pragma unroll
        for (int n = 0; n < 31; ++n) kv[n] = KVS[o0 + ((size_t)n << 14)];
        float R = 0.f;
#pragma unroll
        for (int n = 0; n < 32; ++n) {
            RT[o0 + ((size_t)n << 14)] = (bf16_t)(cvt_pk(g * R, 0.f) & 0xffffu);
            if (n < 31) R = g128 * R + kv[n];
        }
    }
}
__device__ __forceinline__ void ret_out_pair(LAS unsigned char* lds, const bf16_t* QR, const bf16_t* KR, const bf16_t* VR, const bf16_t* GR, const bf16_t* RT, bf16_t* MIXED, int pair, int tid) {
    const int uh = tid >> 8, tl = tid & 255, lane = tid & 63, w4 = __builtin_amdgcn_readfirstlane((tid >> 6) & 3), hi = lane >> 5, r32 = lane & 31;
    const int unit = pair * 2 + uh, n = unit & 31, bh = unit >> 5, b = bh >> 2, h = bh & 3;
    const size_t tok0 = (size_t)b * S + (size_t)n * 128;
    LAS unsigned char* vimg = lds + uh * 32768;
    const float lgam = ret_lgam(h);
    __syncthreads();
    ret_stage<true>(vimg, VR + tok0 * 512 + h * 128, -lgam, tl);
    __syncthreads();
    bf16x8 qf[8];
    {
        const bf16_t* qp = QR + (tok0 + 32 * w4 + r32) * 512 + h * 128 + 8 * hi;
#pragma unroll
        for (int ks = 0; ks < 8; ++ks) qf[ks] = *(const bf16x8*)(qp + 16 * ks);
    }
    f32x16 acc[4];
#pragma unroll
    for (int c = 0; c < 4; ++c) acc[c] = (f32x16){};
    if (n > 0) {
        const bf16_t* rp = RT + (size_t)unit * 16384 + r32 * 128 + 8 * hi;
#pragma unroll
        for (int c = 0; c < 4; ++c)
#pragma unroll
            for (int ks = 0; ks < 8; ++ks) { const bf16x8 a = *(const bf16x8*)(rp + c * 32 * 128 + 16 * ks); acc[c] = __builtin_amdgcn_mfma_f32_32x32x16_bf16(a, qf[ks], acc[c], 0, 0, 0); }
    }
    for (int jt = 0; jt <= w4; ++jt) {
        const bf16_t* kp = KR + (tok0 + 32 * jt + r32) * 512 + h * 128 + 8 * hi;
        f32x16 st = (f32x16){};
#pragma unroll
        for (int ks = 0; ks < 8; ++ks) { const bf16x8 kf = *(const bf16x8*)(kp + 16 * ks); st = __builtin_amdgcn_mfma_f32_32x32x16_bf16(kf, qf[ks], st, 0, 0, 0); }
        if (jt == w4) {
#pragma unroll
            for (int r = 0; r < 16; ++r) if (crow(r, hi) > r32) st[r] = 0.f;
        }
#pragma unroll
        for (int s = 0; s < 2; ++s) {
            u32x4 pw; pw.x = cvt_pk(st[8 * s + 0], st[8 * s + 1]); pw.y = cvt_pk(st[8 * s + 2], st[8 * s + 3]); pw.z = cvt_pk(st[8 * s + 4], st[8 * s + 5]); pw.w = cvt_pk(st[8 * s + 6], st[8 * s + 7]);
            const bf16x8 pb = __builtin_bit_cast(bf16x8, pw);
#pragma unroll
            for (int c = 0; c < 4; ++c) { const bf16x8 vf = tr_frag_acc(vimg, lane, c, 32 * jt + 16 * s); acc[c] = __builtin_amdgcn_mfma_f32_32x32x16_bf16(vf, pb, acc[c], 0, 0, 0); }
        }
    }
    float ss = 0.f;
#pragma unroll
    for (int c = 0; c < 4; ++c)
#pragma unroll
        for (int r = 0; r < 16; ++r) ss += acc[c][r] * acc[c][r];
    ss += __shfl_xor(ss, 32);
    const float gi = expf(lgam * (float)(32 * w4 + r32));
    const float fac = gi / sqrtf(gi * gi * ss * (1.0f / 128.f) + 1e-6f);
    const size_t tok = tok0 + 32 * w4 + r32;
    const bf16_t* gp = GR + tok * 512 + h * 128 + 4 * hi;
    bf16_t* op = MIXED + tok * 1024 + 512 + h * 128 + 4 * hi;
#pragma unroll
    for (int c = 0; c < 4; ++c)
#pragma unroll
        for (int g4 = 0; g4 < 4; ++g4) {
            const u32x2 gv = *(const u32x2*)(gp + 32 * c + 8 * g4);
            const float g0 = __uint_as_float(gv.x << 16), g1 = __uint_as_float(gv.x & 0xffff0000u), g2 = __uint_as_float(gv.y << 16), g3 = __uint_as_float(gv.y & 0xffff0000u);
            u32x2 w; w.x = cvt_pk(acc[c][4 * g4 + 0] * fac * g0, acc[c][4 * g4 + 1] * fac * g1); w.y = cvt_pk(acc[c][4 * g4 + 2] * fac * g2, acc[c][4 * g4 + 3] * fac * g3);
            *(u32x2*)(op + 32 * c + 8 * g4) = w;
        }
}
constexpr size_t WS_MIX = 17 * MiB;
constexpr size_t WS_H2 = 49 * MiB;
constexpr size_t WS_LIST = 81 * MiB;
constexpr size_t WS_HID = 85 * MiB;
constexpr size_t WS_Y = 105 * MiB;
constexpr size_t WS_HRES = 180 * MiB;
constexpr int CW_CNT = 12288;
constexpr int CW_TILE = 16384;
constexpr int TB_OFF = MISC_OFF + 64;

struct EpiStore {
    static constexpr bool PERM = true, AFTER_DRAIN = false;
    bf16_t* O; int ld;
    __device__ __forceinline__ void operator()(const pg8::f32x4 (&acc)[2][2][4][2], const pg8::Unit& u, int wr, int wc, int fr, int fq) const {
        const int row0 = u.pm * 256 + wr * 64 + fr, col0 = u.pn * 256 + wc * 32 + 8 * fq;
#pragma unroll
        for (int ai = 0; ai < 2; ++ai)
#pragma unroll
            for (int m = 0; m < 4; ++m)
#pragma unroll
                for (int bj = 0; bj < 2; ++bj) {
                    const pg8::f32x4 v0 = acc[ai][bj][m][0], v1 = acc[ai][bj][m][1];
                    u32x4 w; w.x = cvt_pk(v0[0], v0[1]); w.y = cvt_pk(v0[2], v0[3]); w.z = cvt_pk(v1[0], v1[1]); w.w = cvt_pk(v1[2], v1[3]);
                    *(u32x4*)(O + (size_t)(row0 + ai * 128 + m * 16) * ld + col0 + bj * 128) = w;
                }
    }
};
struct P6bArgs { const bf16_t* MIX; const float *x, *g_post, *g_pre2, *mod, *w_group, *b_group, *w_expert, *b_expert; float* HRES; bf16_t* H2; unsigned* cnt; u32x2* LIST; };
constexpr int P6B_NR = 4;
constexpr int RT_WL_OFF = 147456;
struct P6bW { f32x4 v[18]; };
__device__ __forceinline__ void p6b_weights_fetch(P6bW& W, const float* w_group, const float* w_expert, int tid) {
#pragma unroll
    for (int i = 0; i < 18; ++i) {
        const int idx = tid + i * NTHR, d = idx / 9, cc = idx - 9 * d;
        W.v[i] = (cc == 0) ? *(const f32x4*)(w_group + d * 4) : *(const f32x4*)(w_expert + d * 32 + 4 * (cc - 1));
    }
}
__device__ __forceinline__ void p6b_weights_store(const P6bW& W, LAS unsigned char* lds, int tid) {
    __syncthreads();
#pragma unroll
    for (int i = 0; i < 18; ++i) {
        const int idx = tid + i * NTHR, d = idx / 9, cc = idx - 9 * d, pos = ((d >> 2) & 63) + 64 * ((d & 3) + 4 * (d >> 8));
        *(LAS f32x4*)(lds + pos * 144 + 16 * cc) = W.v[i];
    }
    __syncthreads();
}
struct P6bIn { u32x2 mw[P6B_NR][4]; f32x4 xv[P6B_NR][4]; };
__device__ __forceinline__ void p6b_load_mix(P6bIn& I, const bf16_t* MIX, int gw, int lane) {
    const int m0 = gw * P6B_NR;
#pragma unroll
    for (int r = 0; r < P6B_NR; ++r)
#pragma unroll
        for (int j = 0; j < 4; ++j) I.mw[r][j] = *(const u32x2*)(MIX + (size_t)(m0 + r) * 1024 + 4 * lane + 256 * j);
}
__device__ __forceinline__ void p6b_load_x(P6bIn& I, const float* x, int gw, int lane) {
    const int m0 = gw * P6B_NR;
#pragma unroll
    for (int r = 0; r < P6B_NR; ++r)
#pragma unroll
        for (int j = 0; j < 4; ++j) I.xv[r][j] = *(const f32x4*)(x + (size_t)(m0 + r) * 1024 + 4 * lane + 256 * j);
}
__device__ __forceinline__ void p6b_norm(const P6bArgs& a, const P6bIn& I, f32x2 (&hp)[P6B_NR][8], int gw, int lane) {
    const int m0 = gw * P6B_NR, b = m0 / S;
    const float* md = a.mod + b * 6144;
    f32x4 G1[4], G2[4], SH[4];
#pragma unroll
    for (int j = 0; j < 4; ++j) {
        const int col = 4 * lane + 256 * j;
        const f32x4 gp = *(const f32x4*)(a.g_post + col), g1 = *(const f32x4*)(md + 2 * 1024 + col), g2 = *(const f32x4*)(a.g_pre2 + col), sc = *(const f32x4*)(md + 4 * 1024 + col);
        SH[j] = *(const f32x4*)(md + 3 * 1024 + col); G1[j] = g1 * gp; G2[j] = g2 * (sc + 1.0f);
    }
#pragma unroll
    for (int r = 0; r < P6B_NR; ++r) {
        const size_t row = (size_t)(m0 + r);
        float v[16]; float s = 0.f;
#pragma unroll
        for (int j = 0; j < 4; ++j) {
            const u32x2 w = I.mw[r][j];
            v[4 * j + 0] = __uint_as_float(w.x << 16); v[4 * j + 1] = __uint_as_float(w.x & 0xffff0000u); v[4 * j + 2] = __uint_as_float(w.y << 16); v[4 * j + 3] = __uint_as_float(w.y & 0xffff0000u);
#pragma unroll
            for (int k = 0; k < 4; ++k) s += v[4 * j + k] * v[4 * j + k];
        }
        const float rs = 1.0f / sqrtf(wave_sum(s) * (1.f / 1024.f) + 1e-6f);
        float s2 = 0.f;
#pragma unroll
        for (int j = 0; j < 4; ++j) {
            const int col = 4 * lane + 256 * j;
            const f32x4 xx = I.xv[r][j];
            f32x4 hr;
#pragma unroll
            for (int k = 0; k < 4; ++k) { hr[k] = xx[k] + G1[j][k] * (v[4 * j + k] * rs); v[4 * j + k] = hr[k]; s2 += hr[k] * hr[k]; }
        }
        const float rs2 = 1.0f / sqrtf(wave_sum(s2) * (1.f / 1024.f) + 1e-6f);
#pragma unroll
        for (int j = 0; j < 4; ++j) {
            const int col = 4 * lane + 256 * j;
            float h[4];
#pragma unroll
            for (int k = 0; k < 4; ++k) h[k] = (v[4 * j + k] * rs2) * G2[j][k] + SH[j][k];
            u32x2 w; w.x = cvt_pk(h[0], h[1]); w.y = cvt_pk(h[2], h[3]);
            *(u32x2*)(a.H2 + row * 1024 + col) = w;
            hp[r][2 * j + 0] = (f32x2){__uint_as_float(w.x << 16), __uint_as_float(w.x & 0xffff0000u)}; hp[r][2 * j + 1] = (f32x2){__uint_as_float(w.y << 16), __uint_as_float(w.y & 0xffff0000u)};
        }
    }
}
template <int HI> __device__ __forceinline__ void pk_fma_bcast(f32x2& acc, const f32x2 w, const f32x2 h) {
    if (HI) asm("v_pk_fma_f32 %0, %1, %2, %0 op_sel:[0,1,0] op_sel_hi:[1,1,1]" : "+v"(acc) : "v"(w), "v"(h));
    else    asm("v_pk_fma_f32 %0, %1, %2, %0 op_sel:[0,0,0] op_sel_hi:[1,0,1]" : "+v"(acc) : "v"(w), "v"(h));
}
__device__ __forceinline__ void p6b_router(const LAS unsigned char* wtab, LAS float* wl  , const f32x2 (&hp)[P6B_NR][8], int lane) {
#pragma unroll 1
    for (int c = 0; c < 9; ++c) {
        f32x2 acc[P6B_NR][2];
#pragma unroll
        for (int r = 0; r < P6B_NR; ++r) { acc[r][0] = (f32x2){0.f, 0.f}; acc[r][1] = (f32x2){0.f, 0.f}; }
#pragma unroll
        for (int j = 0; j < 4; ++j)
#pragma unroll
            for (int k = 0; k < 4; ++k) {
                const f32x4 w4 = *(const LAS f32x4*)(wtab + (lane + 64 * (k + 4 * j)) * 144 + 16 * c);
                const f32x2 wa = {w4[0], w4[1]}, wb = {w4[2], w4[3]};
#pragma unroll
                for (int r = 0; r < P6B_NR; ++r) {
                    if (k & 1) { pk_fma_bcast<1>(acc[r][0], wa, hp[r][2 * j + (k >> 1)]); pk_fma_bcast<1>(acc[r][1], wb, hp[r][2 * j + (k >> 1)]); }
                    else       { pk_fma_bcast<0>(acc[r][0], wa, hp[r][2 * j + (k >> 1)]); pk_fma_bcast<0>(acc[r][1], wb, hp[r][2 * j + (k >> 1)]); }
                }
            }
        asm volatile("s_nop 1" : "+v"(acc[0][0]), "+v"(acc[0][1]), "+v"(acc[1][0]), "+v"(acc[1][1]), "+v"(acc[2][0]), "+v"(acc[2][1]), "+v"(acc[3][0]), "+v"(acc[3][1]));
        float v[16];
#pragma unroll
        for (int r = 0; r < P6B_NR; ++r) { v[4 * r + 0] = acc[r][0][0]; v[4 * r + 1] = acc[r][0][1]; v[4 * r + 2] = acc[r][1][0]; v[4 * r + 3] = acc[r][1][1]; }
        float s8[8], t4[4];
#pragma unroll
        for (int i = 0; i < 8; ++i) { auto q = __builtin_amdgcn_permlane32_swap(__float_as_uint(v[i]), __float_as_uint(v[i + 8]), false, false); s8[i] = __uint_as_float(q[0]) + __uint_as_float(q[1]); }
#pragma unroll
        for (int i = 0; i < 4; ++i) { auto q = __builtin_amdgcn_permlane16_swap(__float_as_uint(s8[i]), __float_as_uint(s8[i + 4]), false, false); t4[i] = __uint_as_float(q[0]) + __uint_as_float(q[1]); }
#pragma unroll
        for (int i = 0; i < 4; ++i) MK_DPP_ADD(t4[i], 0x128);
        float u0 = (lane & 8) ? t4[1] : t4[0], u1 = (lane & 8) ? t4[3] : t4[2];
        MK_DPP_ADD(u0, 0x141); MK_DPP_ADD(u1, 0x141);
        float w = (lane & 4) ? u1 : u0;
        MK_DPP_ADD(w, 0x1B);
        MK_DPP_ADD(w, 0xB1);
        if ((lane & 3) == 0) wl[(lane >> 4) * 36 + 4 * c + 2 * ((lane >> 2) & 1) + ((lane >> 3) & 1)] = w;
    }
    asm volatile("s_waitcnt lgkmcnt(0)" ::: "memory");
}
__device__ __forceinline__ void p6b_route(const P6bArgs& a, const LAS float* wl, int gw, int lane) {
    const int m0 = gw * P6B_NR;
    if (lane < P6B_NR) {
        const LAS float* lg = wl + lane * 36;
        float gm = lg[0] + a.b_group[0]; int gs = 0; float l1 = lg[1] + a.b_group[1], l2 = lg[2] + a.b_group[2], l3 = lg[3] + a.b_group[3];
        const float l0 = gm;
        if (l1 > gm) { gm = l1; gs = 1; } if (l2 > gm) { gm = l2; gs = 2; } if (l3 > gm) { gm = l3; gs = 3; }
        const float gtop = 1.0f / (expf(l0 - gm) + expf(l1 - gm) + expf(l2 - gm) + expf(l3 - gm));
        float el[8];
#pragma unroll
        for (int i = 0; i < 8; ++i) el[i] = lg[4 + gs * 8 + i] + a.b_expert[gs * 8 + i];
        float b1 = el[0]; int i1 = 0;
#pragma unroll
        for (int i = 1; i < 8; ++i) if (el[i] > b1) { b1 = el[i]; i1 = i; }
        float b2 = -INFINITY; int i2 = 0;
#pragma unroll
        for (int i = 0; i < 8; ++i) if (i != i1 && el[i] > b2) { b2 = el[i]; i2 = i; }
        const float p2 = expf(b2 - b1), den = 1.0f + p2;
        const float w0 = gtop / den, w1 = gtop * p2 / den;
        const int e0 = gs * 8 + i1, e1 = gs * 8 + i2;
        const unsigned tok = (unsigned)(m0 + lane);
        const unsigned pos0 = atomicAdd(a.cnt + 64 * e0, 1u), pos1 = atomicAdd(a.cnt + 64 * e1, 1u);
        a.LIST[(size_t)e0 * 16384 + pos0] = (u32x2){tok, __float_as_uint(w0)};
        a.LIST[(size_t)e1 * 16384 + pos1] = (u32x2){tok | 0x80000000u, __float_as_uint(w1)};
    }
}
__device__ __forceinline__ void p6b_rows(const P6bArgs& a, P6bIn& I, const LAS unsigned char* wtab, LAS float* wl, int gw0, int stride, int lane, bool dry) {
    constexpr int NG = T / P6B_NR;
    if (gw0 >= NG) return;
    f32x2 hp[P6B_NR][8];
#pragma unroll 1
    for (int gw = gw0; gw < NG; gw += stride) {
        p6b_norm(a, I, hp, gw, lane);
        if (gw + stride < NG) { p6b_load_mix(I, a.MIX, gw + stride, lane); p6b_load_x(I, a.x, gw + stride, lane); }
        p6b_router(wtab, wl, hp, lane);
        if (!dry) p6b_route(a, wl, gw, lane);
    }
}
template <int ROLE> struct MoeSched {
    const u32x2* LIST; LAS int* tb; int G, c, NJ;
    unsigned* tilecnt;
    unsigned* tmo;
    int tlo, thi;
    __device__ __forceinline__ bool next(int i, pg8::Unit& u) const {
        if (c < 0) return false;
        const int L = i * G + c, TT = (thi < tb[32]) ? thi : tb[32];
        const int tg = tlo + L / NJ, j = L % NJ;
        if (tg >= TT) return false;
        int e = 0;
#pragma unroll 1
        for (int k = 1; k < 32; ++k) e += (tb[k] <= tg) ? 1 : 0;
        u.pm = tg; u.pn = e * NJ + j; return true;
    }
    __device__ __forceinline__ int arow(const pg8::Unit& u, int r) const {
        const int e = u.pn / NJ, idx = (u.pm - tb[e]) * 256 + r;
        return (idx < tb[33 + e]) ? (int)(LIST[(size_t)e * 16384 + idx].x & 0x7fffffffu) : 0;
    }
    __device__ __forceinline__ void a_ready(const pg8::Unit&) const {}
    __device__ __forceinline__ void done(const pg8::Unit& u) const {
        if (ROLE != 1) return;
        asm volatile("s_waitcnt vmcnt(0)" ::: "memory");
        if (mk_lane() == 0) __hip_atomic_fetch_add(tilecnt + 64 * u.pm, 1u, __ATOMIC_RELAXED, __HIP_MEMORY_SCOPE_AGENT);
    }
};
__device__ __forceinline__ void moe_wait(const MoeSched<2>& S) {
    if (mk_wave() == 0) {
        pg8::Unit u;
        for (int i = 0; S.next(i, u); ++i) {
            unsigned sp = 0;
            while ((unsigned)__builtin_amdgcn_readfirstlane(__hip_atomic_load(S.tilecnt + 64 * u.pm, __ATOMIC_RELAXED, __HIP_MEMORY_SCOPE_AGENT)) < 16u) {
                __builtin_amdgcn_s_sleep(2);
                if (++sp > (1u << 22)) { __hip_atomic_store(S.tmo, 1u, __ATOMIC_RELAXED, __HIP_MEMORY_SCOPE_AGENT); break; }
            }
        }
        __builtin_amdgcn_fence(__ATOMIC_ACQUIRE, "agent");
        asm volatile("s_waitcnt vmcnt(0)" ::: "memory");
    }
    __syncthreads();
}
__device__ __forceinline__ void moe_table(LAS int* tb, const unsigned* cnt, int tid) {
    __syncthreads();
    if (tid < 32) tb[33 + tid] = (int)__hip_atomic_load(cnt + 64 * tid, __ATOMIC_RELAXED, __HIP_MEMORY_SCOPE_AGENT);
    __syncthreads();
    if (tid == 0) { int s = 0; for (int e = 0; e < 32; ++e) { tb[e] = s; s += (tb[33 + e] + 255) >> 8; } tb[32] = s; }
    __syncthreads();
}
struct EpiGU {
    static constexpr bool PERM = true, AFTER_DRAIN = false;
    bf16_t* HID;
    __device__ __forceinline__ void operator()(const pg8::f32x4 (&acc)[2][2][4][2], const pg8::Unit& u, int wr, int wc, int fr, int fq) const {
        const int row0 = u.pm * 256 + wr * 64 + fr, hc0 = (u.pn & 1) * 128 + 16 * wc + 4 * fq;
#pragma unroll
        for (int ai = 0; ai < 2; ++ai)
#pragma unroll
            for (int m = 0; m < 4; ++m)
#pragma unroll
                for (int bj = 0; bj < 2; ++bj) {
                    const pg8::f32x4 g = acc[ai][bj][m][0], up = acc[ai][bj][m][1];
                    u32x2 w; w.x = cvt_pk(silu_f(g[0]) * up[0], silu_f(g[1]) * up[1]); w.y = cvt_pk(silu_f(g[2]) * up[2], silu_f(g[3]) * up[3]);
                    __hip_atomic_store((unsigned long long*)(HID + (size_t)(row0 + ai * 128 + m * 16) * 256 + hc0 + bj * 64), (unsigned long long)w.x | ((unsigned long long)w.y << 32), __ATOMIC_RELAXED, __HIP_MEMORY_SCOPE_AGENT);
                }
    }
};
struct EpiDown {
    static constexpr bool PERM = true, AFTER_DRAIN = false;
    bf16_t* Y; const u32x2* LIST; LAS int* tb;
    __device__ __forceinline__ void operator()(const pg8::f32x4 (&acc)[2][2][4][2], const pg8::Unit& u, int wr, int wc, int fr, int fq) const {
        const int e = u.pn >> 2, j = u.pn & 3, ti = u.pm - tb[e], cn = tb[33 + e];
        const int col0 = 256 * j + 32 * wc + 8 * fq;
        const int idx0 = ti * 256 + wr * 64 + fr;
#pragma unroll
        for (int ai = 0; ai < 2; ++ai) {
            u32x2 ent[4];
#pragma unroll
            for (int m = 0; m < 4; ++m) { const int idx = idx0 + ai * 128 + m * 16; ent[m] = (idx < cn) ? LIST[(size_t)e * 16384 + idx] : (u32x2){0xffffffffu, 0u}; }
#pragma unroll
            for (int m = 0; m < 4; ++m) {
                const u32x2 en = ent[m];
                if (en.x != 0xffffffffu) {
                    const float w = __uint_as_float(en.y);
                    bf16_t* dst = Y + ((size_t)(en.x >> 31) * T + (en.x & 0x7fffffffu)) * 1024 + col0;
#pragma unroll
                    for (int bj = 0; bj < 2; ++bj) {
                        const pg8::f32x4 v0 = acc[ai][bj][m][0] * w, v1 = acc[ai][bj][m][1] * w;
                        u32x4 o; o.x = cvt_pk(v0[0], v0[1]); o.y = cvt_pk(v0[2], v0[3]); o.z = cvt_pk(v1[0], v1[1]); o.w = cvt_pk(v1[2], v1[3]);
                        *(u32x4*)(dst + bj * 128) = o;
                    }
                }
            }
            asm volatile("" ::: "memory");
        }
    }
};
struct P8Row { u32x2 w0[4], w1[4], wm[4]; f32x4 xx[4]; };
__device__ __forceinline__ void p8_row_load(P8Row& R, const bf16_t* Y, const bf16_t* MIX, const float* x, int m, int lane) {
#pragma unroll
    for (int j = 0; j < 4; ++j) {
        R.w0[j] = *(const u32x2*)(Y + (size_t)m * 1024 + 4 * lane + 256 * j); R.w1[j] = *(const u32x2*)(Y + ((size_t)T + m) * 1024 + 4 * lane + 256 * j);
        R.wm[j] = *(const u32x2*)(MIX + (size_t)m * 1024 + 4 * lane + 256 * j);
    }
#pragma unroll
    for (int j = 0; j < 4; ++j) R.xx[j] = *(const f32x4*)(x + (size_t)m * 1024 + 4 * lane + 256 * j);
}
__device__ __forceinline__ void p8_rows(const bf16_t* Y, const bf16_t* MIX, const float* x, const float* g_post_mix, const float* g_post, const float* mod, float* out, int gw, int NGW, int lane) {
#pragma unroll 1
    for (int m0 = gw * 8; m0 < T; m0 += NGW * 8) {
        P8Row C, Rn;
        p8_row_load(C, Y, MIX, x, m0, lane);
        const float* md = mod + (m0 / S) * 6144;
        f32x4 GA[4], GB[4];
#pragma unroll
        for (int j = 0; j < 4; ++j) {
            const int col = 4 * lane + 256 * j;
            const f32x4 gpm = *(const f32x4*)(g_post_mix + col), g1 = *(const f32x4*)(md + 2 * 1024 + col), gp = *(const f32x4*)(g_post + col), gg = *(const f32x4*)(md + 5 * 1024 + col);
            GA[j] = g1 * gpm; GB[j] = gg * gp;
        }
#pragma unroll 1
        for (int i = 0; i < 8; ++i) {
            if (i + 1 < 8) p8_row_load(Rn, Y, MIX, x, m0 + i + 1, lane);
            const int m = m0 + i;
            float v[16], mx[16]; float s = 0.f, sm = 0.f;
#pragma unroll
            for (int j = 0; j < 4; ++j) {
                const u32x2 w0 = C.w0[j], w1 = C.w1[j], wm = C.wm[j];
                v[4 * j + 0] = __uint_as_float(w0.x << 16) + __uint_as_float(w1.x << 16); v[4 * j + 1] = __uint_as_float(w0.x & 0xffff0000u) + __uint_as_float(w1.x & 0xffff0000u);
                v[4 * j + 2] = __uint_as_float(w0.y << 16) + __uint_as_float(w1.y << 16); v[4 * j + 3] = __uint_as_float(w0.y & 0xffff0000u) + __uint_as_float(w1.y & 0xffff0000u);
                mx[4 * j + 0] = __uint_as_float(wm.x << 16); mx[4 * j + 1] = __uint_as_float(wm.x & 0xffff0000u); mx[4 * j + 2] = __uint_as_float(wm.y << 16); mx[4 * j + 3] = __uint_as_float(wm.y & 0xffff0000u);
#pragma unroll
                for (int k = 0; k < 4; ++k) { s += v[4 * j + k] * v[4 * j + k]; sm += mx[4 * j + k] * mx[4 * j + k]; }
            }
            const float rs = 1.0f / sqrtf(wave_sum(s) * (1.f / 1024.f) + 1e-6f), rsm = 1.0f / sqrtf(wave_sum(sm) * (1.f / 1024.f) + 1e-6f);
#pragma unroll
            for (int j = 0; j < 4; ++j) {
                const f32x4 xx = C.xx[j];
                f32x4 o;
#pragma unroll
                for (int k = 0; k < 4; ++k) { const float hr = xx[k] + GA[j][k] * (mx[4 * j + k] * rsm); o[k] = hr + GB[j][k] * (v[4 * j + k] * rs); }
                *(f32x4*)(out + (size_t)m * 1024 + 4 * lane + 256 * j) = o;
            }
            if (i + 1 < 8) C = Rn;
        }
    }
}
constexpr size_t SC_BSTRIDE = (size_t)4096 * 64 * 65 / 2;
constexpr int SC_CHUNK = 8;
constexpr int SC_NUNITS = 4 * (1 * 8 + 2 * 8 + 3 * 8 + 4 * 8 + 5 * 8 + 6 * 8 + 7 * 8 + 8 * 8);
__device__ __forceinline__ size_t sc_off(int b, int qb) { return (size_t)b * SC_BSTRIDE + (size_t)4096 * (qb * (qb + 1) / 2); }
__device__ __forceinline__ void sc_build_units(unsigned* tab) {
    int n = 0;
    for (int pass = 0; pass < 2; ++pass)
        for (int sz = SC_CHUNK; sz >= 1; --sz)
            for (int b = 0; b < 4; ++b)
                for (int qb = 0; qb < 64; ++qb) {
                    const int nt = qb + 1, nc = (nt + SC_CHUNK - 1) / SC_CHUNK;
                    for (int c = 0; c < nc; ++c) {
                        const int t0 = c * SC_CHUNK, cnt = (nt - t0 < SC_CHUNK) ? nt - t0 : SC_CHUNK;
                        const bool full = (cnt == SC_CHUNK);
                        if ((pass == 0 && full && sz == SC_CHUNK) || (pass == 1 && !full && cnt == sz)) tab[n++] = (unsigned)b | ((unsigned)qb << 2) | ((unsigned)c << 8) | ((unsigned)cnt << 12);
                    }
                }
}
__device__ __forceinline__ unsigned key16_of(float sc) { sc += 0.0f; const unsigned u = __float_as_uint(sc); return ((u & 0x80000000u) ? ~u : (u | 0x80000000u)) >> 16; }
__device__ __forceinline__ void sc_decode(unsigned u, int& b, int& qb, int& c, int& nt) {
    b = u & 3; const int v = u >> 2;
    if (v < 232) { c = 0; int base = 0; while (v >= base + (57 - 8 * c)) { base += 57 - 8 * c; ++c; } qb = 8 * c + 7 + (v - base); nt = 8; }
    else { const int p = v - 232, size = 7 - (p >> 3); c = p & 7; qb = 8 * c + size - 1; nt = size; }
}
struct ScStage { u32x4 v[8]; };
__device__ __forceinline__ void sc_stage_load(ScStage& st, const bf16_t* KI, int b, int c, int nt, int tid) {
    const bf16_t* kbase = KI + ((size_t)b * S + (size_t)c * SC_CHUNK * 64 + (tid >> 3)) * 64 + (tid & 7) * 8;
#pragma unroll
    for (int t = 0; t < 8; ++t) if (t < nt) st.v[t] = *(const u32x4*)(kbase + (size_t)t * 64 * 64);
}
__device__ __forceinline__ void sc_stage_store(const ScStage& st, LAS unsigned char* buf, int nt, int tid) {
    const int skey = tid >> 3, sch = tid & 7;
    const unsigned st_off = (unsigned)(skey * 128 + ((sch ^ (skey & 7)) * 16));
#pragma unroll
    for (int t = 0; t < 8; ++t) if (t < nt) *(LAS u32x4*)(buf + t * 8192 + st_off) = st.v[t];
}
__device__ __forceinline__ void sc_compute(const LAS unsigned char* buf, const bf16_t* QI, const float* WI, unsigned short* SC, int b, int qb, int c, int ntile, int tid) {
    const int lane = tid & 63, w = __builtin_amdgcn_readfirstlane(tid >> 6), hh = lane >> 5, n32 = lane & 31;
    const int L = 64 * (qb + 1);
    const size_t tokq0 = (size_t)b * S + 64 * qb + 8 * w;
    bf16x8 af[2][4]; float wv[2][2][8];
    {
        const int u = 2 * ((n32 >> 2) & 1) + (n32 >> 4), h = (n32 & 3) + 4 * ((n32 >> 3) & 1);
#pragma unroll
        for (int mt = 0; mt < 2; ++mt) {
            const bf16_t* qp = QI + (tokq0 + 4 * mt + u) * 512 + h * 64 + 8 * hh;
#pragma unroll
            for (int ks = 0; ks < 4; ++ks) af[mt][ks] = *(const bf16x8*)(qp + 16 * ks);
#pragma unroll
            for (int j = 0; j < 2; ++j) {
                const float* wp = WI + (tokq0 + 4 * mt + 2 * hh + j) * 8;
                const f32x4 w0 = *(const f32x4*)wp, w1 = *(const f32x4*)(wp + 4);
                wv[mt][j][0] = w0[0]; wv[mt][j][1] = w0[1]; wv[mt][j][2] = w0[2]; wv[mt][j][3] = w0[3]; wv[mt][j][4] = w1[0]; wv[mt][j][5] = w1[1]; wv[mt][j][6] = w1[2]; wv[mt][j][7] = w1[3];
            }
        }
    }
    unsigned short* srow = SC + sc_off(b, qb) + (size_t)(8 * w) * L;
#pragma unroll 1
    for (int t = 0; t < ntile; ++t) {
        const LAS unsigned char* tb_ = buf + t * 8192;
        const int s0 = (c * SC_CHUNK + t) * 64;
#pragma unroll
        for (int nt = 0; nt < 2; ++nt) {
            bf16x8 bfr[4];
            const int key = 32 * nt + n32;
#pragma unroll
            for (int ks = 0; ks < 4; ++ks) bfr[ks] = *(const LAS bf16x8*)(tb_ + key * 128 + (((2 * ks + hh) ^ (key & 7)) * 16));
#pragma unroll
            for (int mt = 0; mt < 2; ++mt) {
                f32x16 acc = (f32x16){};
#pragma unroll
                for (int ks = 0; ks < 4; ++ks) acc = __builtin_amdgcn_mfma_f32_32x32x16_bf16(af[mt][ks], bfr[ks], acc, 0, 0, 0);
#pragma unroll
                for (int j = 0; j < 2; ++j) {
                    float sc = 0.f;
#pragma unroll
                    for (int h = 0; h < 8; ++h) { const int xi = (int)__float_as_uint(acc[8 * j + h]); sc = __builtin_fmaf(wv[mt][j][h], __uint_as_float((unsigned)(xi > 0 ? xi : 0)), sc); }
                    asm volatile("" : "+v"(sc));
                    srow[(size_t)(4 * mt + 2 * hh + j) * L + s0 + key] = (unsigned short)key16_of(sc);
                }
            }
        }
    }
}
__device__ __forceinline__ void sc_phase(LAS unsigned char* lds, volatile LAS unsigned* qslot, unsigned* qhead, const bf16_t* QI, const bf16_t* KI, const float* WI, unsigned short* SC, int tid) {
    __syncthreads();
    if (tid == 0) qslot[0] = atomicAdd(qhead, 1u);
    __syncthreads();
    unsigned ucur = qslot[0];
    if (ucur >= (unsigned)SC_NUNITS) return;
    int b, qb, c, nt; sc_decode(ucur, b, qb, c, nt);
    ScStage st;
    sc_stage_load(st, KI, b, c, nt, tid);
    sc_stage_store(st, lds, nt, tid);
    int p = 0;
    for (;;) {
        __syncthreads();
        if (tid == 0) qslot[0] = atomicAdd(qhead, 1u);
        __syncthreads();
        const unsigned unext = qslot[0];
        const bool has = unext < (unsigned)SC_NUNITS;
        int b2 = 0, qb2 = 0, c2 = 0, nt2 = 0;
        if (has) { sc_decode(unext, b2, qb2, c2, nt2); sc_stage_load(st, KI, b2, c2, nt2, tid); }
        sc_compute(lds + p * 65536, QI, WI, SC, b, qb, c, nt, tid);
        if (!has) break;
        sc_stage_store(st, lds + (p ^ 1) * 65536, nt2, tid);
        b = b2; qb = qb2; c = c2; nt = nt2; p ^= 1;
    }
}
__device__ __forceinline__ unsigned wave_sum_u32(unsigned x) {
    x += (unsigned)__builtin_amdgcn_update_dpp(0, (int)x, 0xB1, 0xf, 0xf, false);
    x += (unsigned)__builtin_amdgcn_update_dpp(0, (int)x, 0x4E, 0xf, 0xf, false);
    x += (unsigned)__builtin_amdgcn_update_dpp(0, (int)x, 0x141, 0xf, 0xf, false);
    x += (unsigned)__builtin_amdgcn_update_dpp(0, (int)x, 0x140, 0xf, 0xf, false);
    return (unsigned)__builtin_amdgcn_readlane((int)x, 0) + (unsigned)__builtin_amdgcn_readlane((int)x, 16) + (unsigned)__builtin_amdgcn_readlane((int)x, 32) + (unsigned)__builtin_amdgcn_readlane((int)x, 48);
}
__device__ __forceinline__ unsigned pk_subsat(unsigned w, unsigned c) { unsigned d; asm("v_pk_sub_u16 %0, %1, %2 clamp" : "=v"(d) : "v"(w), "v"(c)); return d; }
__device__ __forceinline__ unsigned pk_min(unsigned a, unsigned b) { unsigned d; asm("v_pk_min_u16 %0, %1, %2" : "=v"(d) : "v"(a), "v"(b)); return d; }
__device__ __forceinline__ unsigned pk_add(unsigned a, unsigned b) { unsigned d; asm("v_pk_add_u16 %0, %1, %2" : "=v"(d) : "v"(a), "v"(b)); return d; }
template <int NW> __device__ __forceinline__ unsigned cnt_ge(const unsigned (&kw)[32], unsigned cm1) {
    const unsigned one = 0x00010001u;
    unsigned a0 = 0u, a1 = 0u, a2 = 0u, a3 = 0u;
#pragma unroll
    for (int j = 0; j < NW; j += 4) {
        a0 = pk_add(a0, pk_min(pk_subsat(kw[j], cm1), one)); a1 = pk_add(a1, pk_min(pk_subsat(kw[j + 1], cm1), one));
        a2 = pk_add(a2, pk_min(pk_subsat(kw[j + 2], cm1), one)); a3 = pk_add(a3, pk_min(pk_subsat(kw[j + 3], cm1), one));
    }
    const unsigned a = pk_add(pk_add(a0, a1), pk_add(a2, a3));
    return wave_sum_u32((a & 0xffffu) + (a >> 16));
}
__device__ __forceinline__ unsigned pk_max(unsigned a, unsigned b) { unsigned d; asm("v_pk_max_u16 %0, %1, %2" : "=v"(d) : "v"(a), "v"(b)); return d; }
__device__ __forceinline__ unsigned wave_max_u32(unsigned x) {
    x = max(x, (unsigned)__builtin_amdgcn_update_dpp(0, (int)x, 0xB1, 0xf, 0xf, false));
    x = max(x, (unsigned)__builtin_amdgcn_update_dpp(0, (int)x, 0x4E, 0xf, 0xf, false));
    x = max(x, (unsigned)__builtin_amdgcn_update_dpp(0, (int)x, 0x141, 0xf, 0xf, false));
    x = max(x, (unsigned)__builtin_amdgcn_update_dpp(0, (int)x, 0x140, 0xf, 0xf, false));
    return max(max((unsigned)__builtin_amdgcn_readlane((int)x, 0), (unsigned)__builtin_amdgcn_readlane((int)x, 16)), max((unsigned)__builtin_amdgcn_readlane((int)x, 32), (unsigned)__builtin_amdgcn_readlane((int)x, 48)));
}
template <int NW> __device__ __forceinline__ unsigned sel_query(const unsigned (&kw)[32], int lane) {
    unsigned mx = 0u;
#pragma unroll
    for (int j = 0; j < NW; ++j) mx = pk_max(mx, kw[j]);
    unsigned hi = wave_max_u32(max(mx & 0xffffu, mx >> 16)) + 1u;
    unsigned width = 384u, lo = (hi > width) ? hi - width : 1u;
#pragma unroll 1
    while (cnt_ge<NW>(kw, (lo - 1u) * 0x00010001u) < 256u) { hi = lo; width *= 8u; lo = (hi > width) ? hi - width : 1u; }
#pragma unroll 1
    while (hi - lo > 1u) {
        const unsigned mid = (lo + hi) >> 1;
        if (cnt_ge<NW>(kw, (mid - 1u) * 0x00010001u) >= 256u) lo = mid; else hi = mid;
    }
    const unsigned T = lo;
    const unsigned need = 256u - cnt_ge<NW>(kw, T * 0x00010001u);
    unsigned run = 0u, cidx = 0xffffu; bool found = false;
#pragma unroll
    for (int j = 0; j < NW; ++j) {
        if (!found) {
            const bool e0 = (kw[j] & 0xffffu) == T, e1 = (kw[j] >> 16) == T;
            const unsigned long long m0 = __ballot(e0), m1 = __ballot(e1);
            const unsigned cm = (unsigned)__builtin_popcountll(m0) + (unsigned)__builtin_popcountll(m1);
            if (run + cm >= need) {
                const unsigned rank = __builtin_amdgcn_mbcnt_hi((unsigned)(m0 >> 32), __builtin_amdgcn_mbcnt_lo((unsigned)m0, 0u)) + __builtin_amdgcn_mbcnt_hi((unsigned)(m1 >> 32), __builtin_amdgcn_mbcnt_lo((unsigned)m1, 0u));
                const unsigned tg = need - run - 1u;
                const unsigned long long h0 = __ballot(e0 && rank == tg), h1 = __ballot(e1 && rank + (e0 ? 1u : 0u) == tg);
                cidx = (unsigned)(128 * j) + (h0 ? 2u * (unsigned)__builtin_ctzll(h0) : 2u * (unsigned)__builtin_ctzll(h1) + 1u);
                found = true;
            }
            run += cm;
        }
    }
    return T | (cidx << 16);
}
__host__ __device__ constexpr int msk_pos(int r) { return (r & ~3) | ((r & 1) << 1) | ((r >> 1) & 1); }
template <int NW> __device__ __forceinline__ void sel_emit(const unsigned (&kw)[32], unsigned th, unsigned* MROW, int b, int tq, int lane) {
    const unsigned thresh = ((th & 0xffffu) << 16) | (0xFFFFu - (th >> 16));
    const unsigned ib = 0xFFFFu - 2u * (unsigned)lane;
    unsigned W0 = 0u, W1 = 0u;
#pragma unroll
    for (int j = 0; j < NW; ++j) {
        const unsigned il = ib - 128u * j;
        const unsigned c_lo = (kw[j] << 16) | il, c_hi = (kw[j] & 0xFFFF0000u) | (il - 1u);
        const unsigned long long m_lo = __ballot(c_lo >= thresh), m_hi = __ballot(c_hi >= thresh);
        const unsigned long long w0 = (m_lo & 0x3333333333333333ull) | ((m_hi & 0x3333333333333333ull) << 2);
        const unsigned long long w1 = ((m_lo & 0xCCCCCCCCCCCCCCCCull) >> 2) | (m_hi & 0xCCCCCCCCCCCCCCCCull);
        asm("v_writelane_b32 %0, %1, %2" : "+v"(W0) : "s"((unsigned)w0), "n"(2 * j));
        asm("v_writelane_b32 %0, %1, %2" : "+v"(W0) : "s"((unsigned)(w0 >> 32)), "n"(2 * j + 1));
        asm("v_writelane_b32 %0, %1, %2" : "+v"(W1) : "s"((unsigned)w1), "n"(2 * j));
        asm("v_writelane_b32 %0, %1, %2" : "+v"(W1) : "s"((unsigned)(w1 >> 32)), "n"(2 * j + 1));
    }
    *(u32x2*)(MROW + (((size_t)b * S + tq) * 64 + lane) * 2) = (u32x2){W0, W1};
}
template <int NW> __device__ __forceinline__ void sel_row(const unsigned* row32, int n, unsigned* MROW, int b, int tq, int lane) {
    unsigned kw[32];
#pragma unroll
    for (int j = 0; j < 32; ++j) {
        unsigned v = 0u;
        if (j < NW) { const int s = 128 * j + 2 * lane; v = (s < n) ? row32[64 * j + lane] : 0u; if (s + 1 >= n) v &= 0xffffu; }
        kw[j] = v;
    }
    const unsigned th = sel_query<NW>(kw, lane);
    sel_emit<NW>(kw, th, MROW, b, tq, lane);
}
__device__ __forceinline__ void sel_row_all(int n, unsigned* MROW, int b, int tq, int lane) {
    unsigned kw[32];
#pragma unroll
    for (int j = 0; j < 32; ++j) { const int s = 128 * j + 2 * lane; kw[j] = (j < 8) ? ((s < n ? 1u : 0u) | (s + 1 < n ? 0x10000u : 0u)) : 0u; }
    sel_emit<8>(kw, 0u, MROW, b, tq, lane);
}
__device__ __forceinline__ void sel_queries_balanced(const unsigned short* SC, unsigned* MROW, int gw, int lane) {
#pragma unroll 1
    for (int k = 0; k < 8; ++k) {
        const int b = k >> 1, tq = (k & 1) ? (S - 1 - gw) : gw, n = tq + 1, qb = tq >> 6, L = 64 * (qb + 1);
        const unsigned* row32 = (const unsigned*)(SC + sc_off(b, qb) + (size_t)(tq & 63) * L);
        const int nw = (n + 127) >> 7;
        if (n <= 256) sel_row_all(n, MROW, b, tq, lane);
        else if (nw <= 8) sel_row<8>(row32, n, MROW, b, tq, lane); else if (nw <= 16) sel_row<16>(row32, n, MROW, b, tq, lane); else if (nw <= 24) sel_row<24>(row32, n, MROW, b, tq, lane); else sel_row<32>(row32, n, MROW, b, tq, lane);
    }
}
struct Args { const void* in[18]; float* out; unsigned char* ws; int ph_lo, ph_hi, li, pad; };
constexpr int N_PHASES = 12;
__global__ void __launch_bounds__(NTHR, 2) mega(Args args) {
    extern __shared__ __attribute__((aligned(16))) unsigned char lds_raw[];
    LAS unsigned char* lds = (LAS unsigned char*)lds_raw;
    const int G = gridDim.x, bid = blockIdx.x;
#define MK_IDS() const int wave = mk_wave(), lane = mk_lane(), tid = wave * 64 + lane; (void)lane; (void)tid; (void)wave
    unsigned char* ws = args.ws;
    unsigned* ctl = (unsigned*)(ws + WS_CTL);
    volatile LAS unsigned* MISC = (volatile LAS unsigned*)(lds + MISC_OFF);
    { const int t0 = (int)threadIdx.x;
      for (int u = t0; u < (LDS_BYTES - RING_BYTES) / 4; u += NTHR) ((LAS unsigned*)(lds + RING_BYTES))[u] = 0u;
      __syncthreads();
      if ((t0 & 63) == 0) ((LAS unsigned char*)(lds + MK_SLOTMAP_OFF))[mk_hwslot()] = (unsigned char)(t0 >> 6); }
    __syncthreads();
    XcdBarrier bar = xcd_barrier_post(ctl + CW_BAR + args.li * XCD_BAR_WORDS, MISC + 8);
    const int lo = args.ph_lo, hi = args.ph_hi;
#ifndef DUP_MASK
#define DUP_MASK 0
#endif
#define REP(k) for (int rep_ = 0; rep_ < (((DUP_MASK) >> (k)) & 1) + 1; ++rep_)
#define IN(k) (lo <= (k) && (k) < hi)
#define BOTH(k) (IN(k) && IN((k) + 1))
    const float* x = (const float*)args.in[0];
    float* mod = (float*)(ws + WS_MOD);
    bf16_t* Hb = (bf16_t*)(ws + WS_H);
    bf16_t* WIN = (bf16_t*)(ws + WS_WIN);
    bf16_t* WOUT = (bf16_t*)(ws + WS_WOUT);
    float* R128 = (float*)(ws + WS_R128);
    float* R64 = (float*)(ws + WS_R64);
    bf16_t* WGU = (bf16_t*)args.out; bf16_t* WD = WGU + (size_t)32 * 512 * 1024;

    const P0Args p0a{(const float*)args.in[1], (const float*)args.in[4], (const float*)args.in[5], (const float*)args.in[6], (const float*)args.in[7], (const float*)args.in[14], (const float*)args.in[15], (const float*)args.in[16],
                 (const int*)args.in[2], mod, R128, R64, WIN, WOUT, WGU, WD};
    if (IN(0)) {
        MK_IDS();
        REP(0) p0_prologue(lds, p0a, bid, G, tid);
        if (BOTH(0)) xcd_barrier(bar);
    }
    if (IN(1)) {
        MK_IDS();
        REP(1) p1_rows(x, (const float*)args.in[3], mod, Hb, bid * NWAVES + wave, G * NWAVES, lane);
        if ((DUP_MASK >> 15) & 1) { for (int k = 0; k < 10; ++k) xcd_barrier(bar); }
        if (BOTH(1)) xcd_barrier(bar);
    }
    if (IN(2)) {
        MK_IDS();
#ifdef PROBE_SKIP_TILE8
        struct Skip8 : pg8::StaticOrder { __device__ bool next(int i, pg8::Unit& u) const { if (!pg8::StaticOrder::next(i, u)) return false; if (u.pn >= 8) ++u.pn; return true; } };
        pg8::Gemm g{Hb, WIN, T, NPHYS, 1024}; Skip8 So; So.init(T, NPHYS - 256, G, bid);
#define PG8_P2_SCHED Skip8
#else
        pg8::Gemm g{Hb, WIN, T, NPHYS, 1024}; pg8::StaticOrder So; So.init(T, NPHYS, G, bid);
#define PG8_P2_SCHED pg8::StaticOrder
#endif
        EpiInProj E{(bf16_t*)(ws + WS_QA), (bf16_t*)(ws + WS_KA), (bf16_t*)(ws + WS_VA), (bf16_t*)(ws + WS_QI), (bf16_t*)(ws + WS_KI), (bf16_t*)(ws + WS_QR), (bf16_t*)(ws + WS_KR),
                    (bf16_t*)(ws + WS_VR), (bf16_t*)(ws + WS_GR), (float*)(ws + WS_WI), R64, R128};
        pg8::gemm_phase<EpiInProj, PG8_P2_SCHED, true, true>(lds, g, So, E);
        if ((DUP_MASK >> 2) & 1) { __syncthreads(); pg8::gemm_phase<EpiInProj, PG8_P2_SCHED, true, true>(lds, g, So, E); }
        if (args.li != 0) {   }
        else if (G == 256) { if (bid >= 64) { __syncthreads(); p0_expert_items(lds, p0a, (bid - 64) * NWAVES + wave, 192 * NWAVES, tid); } }
        else { __syncthreads(); p0_expert_items(lds, p0a, bid * NWAVES + wave, G * NWAVES, tid); }
        if (BOTH(2)) xcd_barrier(bar);
    }
    bf16_t* QR = (bf16_t*)(ws + WS_QR); bf16_t* KR = (bf16_t*)(ws + WS_KR); bf16_t* VR = (bf16_t*)(ws + WS_VR); bf16_t* GR = (bf16_t*)(ws + WS_GR);
    const bf16_t* QI = (const bf16_t*)(ws + WS_QI); const bf16_t* KI = (const bf16_t*)(ws + WS_KI); const float* WI = (const float*)(ws + WS_WI);
    unsigned short* SCORES = (unsigned short*)(ws + WS_SCORES); unsigned* THR = (unsigned*)(ws + WS_THR); unsigned* MASKT = (unsigned*)(ws + WS_MASKT);
    float* KVS = (float*)(ws + WS_KVS); bf16_t* RT = WD + (size_t)32 * 1024 * 256;
    bf16_t* MIXED = (bf16_t*)(ws + WS_MIXED);
    if (IN(3)) {
        MK_IDS();
        REP(3) {
        for (int p = bid; p < 256; p += G) ret_kv_pair(lds, KR, VR, KVS, p, tid);
        sc_phase(lds, MISC + 16, ctl + CW_Q + 64 * rep_, QI, KI, WI, SCORES, tid);
        }
        if (BOTH(3)) xcd_barrier(bar);
    }
    if (IN(4)) {
        MK_IDS();
        ret_scan(KVS, RT, bid * NTHR + tid, G * NTHR);
        for (int gw = bid * NWAVES + wave; gw < 2048; gw += G * NWAVES) sel_queries_balanced(SCORES, MASKT, gw, lane);
        if ((DUP_MASK >> 12) & 1) for (int gw = bid * NWAVES + wave; gw < 2048; gw += G * NWAVES) sel_queries_balanced(SCORES, MASKT, gw, lane);
        if (IN(4) && IN(6)) xcd_barrier(bar);
    }
    if (IN(6)) {
        MK_IDS();
        {
        for (int p = bid; p < 256; p += G) ret_out_pair(lds, QR, KR, VR, GR, RT, MIXED, p, tid);
        if ((DUP_MASK >> 14) & 1) for (int p = bid; p < 256; p += G) ret_out_pair(lds, QR, KR, VR, GR, RT, MIXED, p, tid);
        asm volatile("s_waitcnt vmcnt(0) lgkmcnt(0)" ::: "memory");
        __syncthreads();
        {
            const attn_body::AttnTensors AT{(const attn_body::bf16*)(ws + WS_QA), (const attn_body::bf16*)(ws + WS_KA), (const attn_body::bf16*)(ws + WS_VA), (attn_body::bf16*)MIXED, (const unsigned*)MASKT};
            const attn_body::StaticOrder So((int)G, (int)bid);
            attn_body::attn_phase<attn_body::StaticOrder>((char*)lds_raw, AT, So);
        }
        __syncthreads();
        }
        if ((DUP_MASK >> 5) & 1) {
        for (int p = bid; p < 256; p += G) ret_out_pair(lds, QR, KR, VR, GR, RT, MIXED, p, tid);
        asm volatile("s_waitcnt vmcnt(0) lgkmcnt(0)" ::: "memory");
        __syncthreads();
        {
            const attn_body::AttnTensors AT{(const attn_body::bf16*)(ws + WS_QA), (const attn_body::bf16*)(ws + WS_KA), (const attn_body::bf16*)(ws + WS_VA), (attn_body::bf16*)MIXED, (const unsigned*)MASKT};
            const attn_body::StaticOrder So((int)G, (int)bid);
            attn_body::attn_phase<attn_body::StaticOrder>((char*)lds_raw, AT, So);
        }
        __syncthreads();
        }
        if (BOTH(6)) xcd_barrier(bar);
    }
    bf16_t* MIX = (bf16_t*)(ws + WS_MIX); bf16_t* H2 = (bf16_t*)(ws + WS_H2); u32x2* LIST = (u32x2*)(ws + WS_LIST); bf16_t* HID = (bf16_t*)(ws + WS_HID);
    bf16_t* Y = (bf16_t*)(ws + WS_Y); float* HRES = (float*)(ws + WS_HRES);
    LAS int* tb = (LAS int*)(lds + TB_OFF);
    if (IN(7)) {
        MK_IDS();
        pg8::Gemm g{MIXED, WOUT, T, 1024, 1024}; pg8::StaticOrder So; So.init(T, 1024, G, bid);
        EpiStore E{MIX, 1024};
        pg8::gemm_phase<EpiStore, pg8::StaticOrder, true, true>(lds, g, So, E);
        if ((DUP_MASK >> 6) & 1) { __syncthreads(); pg8::gemm_phase<EpiStore, pg8::StaticOrder, true, true>(lds, g, So, E); }
        if (BOTH(7)) xcd_barrier(bar);
    }
    if (IN(8)) {
        MK_IDS();
        P6bArgs a{MIX, x, (const float*)args.in[8], (const float*)args.in[9], mod, (const float*)args.in[10], (const float*)args.in[11], (const float*)args.in[12], (const float*)args.in[13], HRES, H2, ctl + CW_CNT, LIST};
        const int gw0 = bid * NWAVES + wave;
        P6bIn I8;
        if (gw0 < T / P6B_NR) { p6b_load_x(I8, x, gw0, lane); p6b_load_mix(I8, MIX, gw0, lane); }
        { P6bW W8; p6b_weights_fetch(W8, a.w_group, a.w_expert, tid); p6b_weights_store(W8, lds, tid); }
        p6b_rows(a, I8, lds, (LAS float*)(lds + RT_WL_OFF + wave * 576), gw0, G * NWAVES, lane, false);
        if ((DUP_MASK >> 8) & 1) { if (gw0 < T / P6B_NR) { p6b_load_x(I8, x, gw0, lane); p6b_load_mix(I8, MIX, gw0, lane); } p6b_rows(a, I8, lds, (LAS float*)(lds + RT_WL_OFF + wave * 576), gw0, G * NWAVES, lane, true); }
        if (BOTH(8)) xcd_barrier(bar);
    }
    if (IN(9)) {
        MK_IDS();
        moe_table(tb, ctl + CW_CNT, tid);
        pg8::Gemm g{H2, WGU, T, 32 * 512, 1024}; MoeSched<1> So{LIST, tb, G, bid, 2, ctl + CW_TILE, ctl + CW_TMO, 0, 1 << 20};
        EpiGU E{HID};
        pg8::gemm_phase_ga<EpiGU, MoeSched<1>>(lds, g, So, E);
        if ((DUP_MASK >> 8) & 1) { __syncthreads(); pg8::gemm_phase_ga<EpiGU, MoeSched<1>>(lds, g, So, E); }
        __syncthreads();
    }
    if (IN(10)) {
        MK_IDS();
        moe_table(tb, ctl + CW_CNT, tid);
        const int n2 = (tb[32] * 2 > G && tb[32] * 2 < 2 * G) ? tb[32] * 2 - G : 0;
        const int t1 = G / 2;
        pg8::Gemm g{HID, WD, T, 32 * 1024, 256};
        EpiDown E{Y, LIST, tb};
        { MoeSched<2> So{LIST, tb, G - n2, bid - n2, 4, ctl + CW_TILE, ctl + CW_TMO, 0, t1}; moe_wait(So); pg8::gemm_phase<EpiDown, MoeSched<2>, true, true>(lds, g, So, E); }
        { MoeSched<2> So{LIST, tb, G - n2, bid - n2, 4, ctl + CW_TILE, ctl + CW_TMO, t1, 1 << 20}; moe_wait(So); pg8::gemm_phase<EpiDown, MoeSched<2>, true, true>(lds, g, So, E); }
        if (BOTH(10)) xcd_barrier(bar);
    }
    if (IN(11)) {
        MK_IDS();
        REP(11) p8_rows(Y, MIX, x, (const float*)args.in[8], (const float*)args.in[17], mod, args.out, bid * NWAVES + wave, G * NWAVES, lane);
    }
#undef IN
#undef BOTH
}
}
extern "C" void kernel_launch(void* const* d_in, const int* in_sizes, int n_in, void* d_out, int out_size, void* d_ws, size_t ws_size, hipStream_t stream) {
    using namespace mk;
    static int grid = 0;
    if (grid == 0) {
        int dev = 0, cus = 0, per_cu = 0;
        if (n_in != 18 || out_size != T * D || ws_size < (size_t)256 * MiB) { fprintf(stderr, "kernel_launch: unexpected problem shape (n_in %d, out %d, ws %zu)\n", n_in, out_size, ws_size); grid = -1; return; }
        if (hipGetDevice(&dev) != hipSuccess || hipDeviceGetAttribute(&cus, hipDeviceAttributeMultiprocessorCount, dev) != hipSuccess) { fprintf(stderr, "kernel_launch: device query failed\n"); grid = -1; return; }
        if (hipFuncSetAttribute((const void*)mega, hipFuncAttributeMaxDynamicSharedMemorySize, LDS_BYTES) != hipSuccess) { fprintf(stderr, "kernel_launch: hipFuncSetAttribute failed\n"); grid = -1; return; }
        if (hipOccupancyMaxActiveBlocksPerMultiprocessor(&per_cu, (const void*)mega, NTHR, LDS_BYTES) != hipSuccess || per_cu < 1) fprintf(stderr, "kernel_launch: occupancy query reports %d\n", per_cu);
        (void)hipGetLastError();
        grid = cus;
    }
    if (grid < 0) return;
    unsigned char* ws = (unsigned char*)d_ws;
    (void)hipMemsetAsync(ws + WS_CTL, 0, CTL_BYTES, stream);
    Args a{};
    for (int i = 0; i < 18; ++i) a.in[i] = d_in[i];
    a.out = (float*)d_out; a.ws = ws; a.ph_lo = 0; a.ph_hi = N_PHASES; a.li = 0; a.pad = 0;
    hipLaunchKernelGGL(mega, dim3(grid), dim3(NTHR), LDS_BYTES, stream, a);
#ifdef EXTRA_PHASE
#ifndef EXTRA_HI
#define EXTRA_HI (EXTRA_PHASE + 1)
#endif
    a.ph_lo = EXTRA_PHASE; a.ph_hi = EXTRA_HI; a.li = 1;
    hipLaunchKernelGGL(mega, dim3(grid), dim3(NTHR), LDS_BYTES, stream, a);
#endif
}
```

```cpp
#include <hip/hip_runtime.h>
#include <cstdio>
#include <cstdint>
#define DUP_MASK 0
#define MK_SLOTMAP_OFF (163840 - 256)
__device__ __forceinline__ unsigned mk_hwslot() { return (unsigned)__builtin_amdgcn_s_getreg((5 << 11) | 4) & 63u; }
__device__ __forceinline__ int mk_wave() { return __builtin_amdgcn_readfirstlane((int)((const __attribute__((address_space(3))) unsigned char*)(unsigned)MK_SLOTMAP_OFF)[mk_hwslot()]); }
__device__ __forceinline__ int mk_lane() { return (int)__builtin_amdgcn_mbcnt_hi(~0u, __builtin_amdgcn_mbcnt_lo(~0u, 0u)); }
__device__ __forceinline__ int mk_tidx() { return mk_wave() * 64 + mk_lane(); }
namespace pg8 {
#define PG8_LAS __attribute__((address_space(3)))
typedef unsigned short bf16_t;
typedef short bf16x8 __attribute__((ext_vector_type(8)));
typedef float f32x4 __attribute__((ext_vector_type(4)));
typedef unsigned u32x4 __attribute__((ext_vector_type(4)));
constexpr int BM = 256, BK = 64, HALF = 128, HTB = HALF * BK * 2  , STAGE_BYTES = 8 * HTB, NXCD = 8, WGM = 8;

__host__ __device__ __forceinline__ int lds_byte(int r, int c) { const int st = (r >> 4) * 2 + (c >> 5), rr = r & 15, cc = c & 31, ob = rr * 64 + cc * 2; return st * 1024 + (ob ^ (((ob >> 9) & 1) << 5)); }
__host__ __device__ __forceinline__ void stage_rc(int b, int& R, int& C) { const int st = b / 1024, sb = b % 1024, swz = sb ^ (((sb >> 9) & 1) << 5); R = (st >> 1) * 16 + swz / 64; C = (st & 1) * 32 + (swz % 64) / 2; }
__host__ __device__ __forceinline__ int perm32(int rho) { const int n = rho >> 4, i = rho & 15; return 8 * (i >> 2) + 4 * n + (i & 3); }

struct Unit { int pm, pn; };
struct Gemm { const bf16_t* A; const bf16_t* Bt; int M, N, K; };

struct StaticOrder {
    int nM, nN, nwg, G, c;
    __host__ __device__ void init(int M, int N, int G_, int c_) { nM = M / BM; nN = N / BM; nwg = nM * nN; G = G_; c = c_; }
    __host__ __device__ bool next(int i, Unit& u) const {
        const long L = (long)i * G + c; if (L >= nwg) return false;
        int wgid = (int)L; { const int q = nwg / NXCD, r = nwg % NXCD, xcd = wgid % NXCD, off = wgid / NXCD; wgid = (xcd < r ? xcd * (q + 1) : r * (q + 1) + (xcd - r) * q) + off; }
        const int nig = WGM * nN, gid = wgid / nig, fm = gid * WGM, gsz = (nM - fm) < WGM ? (nM - fm) : WGM;
        u.pm = fm + ((wgid % nig) % gsz); u.pn = (wgid % nig) / gsz; return true;
    }
    __device__ __forceinline__ void a_ready(const Unit&) const {}
    __device__ __forceinline__ void done(const Unit&) const {}
};
template <class Epi, class Sched, bool ALIGN_EPI = false, bool SP2 = false>
__device__ __forceinline__ void gemm_phase(PG8_LAS unsigned char* lds, const Gemm g, const Sched& S, const Epi& E) {
    const int tid = mk_tidx(), wid = __builtin_amdgcn_readfirstlane(tid >> 6), lane = tid & 63, wr = wid >> 2, wc = wid & 3, fr = lane & 15, fq = lane >> 4;
    const int K = g.K, nt = K / BK;
    unsigned voffA[2], voffB[2];
#pragma unroll
    for (int i = 0; i < 2; ++i) { int R, C; stage_rc(tid * 16 + i * 8192, R, C); const int Rb = Epi::PERM ? ((R & ~31) + perm32(R & 31)) : R;
        voffA[i] = (unsigned)(R * K + C) * 2u; voffB[i] = (unsigned)(Rb * K + C) * 2u; }
    const size_t kstep = (size_t)(BK * 2);
    const size_t hstep = (size_t)HALF * K * 2;
    const size_t tstep = 2 * hstep;
    const unsigned ldsw = (unsigned)wid * 1024u;
    const int aoff = lds_byte(wr * 64 + fr, fq * 8), boff = lds_byte(wc * 32 + fr, fq * 8);
#define PG8_SA(b, h) (((b) * 2 + (h)) * HTB)
#define PG8_SB(b, h) ((4 + (b) * 2 + (h)) * HTB)
#define PG8_STAGE(bufoff, gbase, voff) do { _Pragma("unroll") for (int _i = 0; _i < 2; ++_i) \
        __builtin_amdgcn_global_load_lds((const unsigned*)((const char*)(gbase) + (voff)[_i]), (PG8_LAS unsigned*)(lds + (bufoff) + ldsw + _i * 8192), 16, 0, 0); } while (0)
#define PG8_LDA(dst, b, h) do { _Pragma("unroll") for (int m = 0; m < 4; ++m) _Pragma("unroll") for (int k = 0; k < 2; ++k) dst[m][k] = *(const PG8_LAS bf16x8*)(lds + PG8_SA(b, h) + aoff + m * 2048 + k * 1024); } while (0)
#define PG8_LDB(dst, b, h) do { _Pragma("unroll") for (int n = 0; n < 2; ++n) _Pragma("unroll") for (int k = 0; k < 2; ++k) dst[n][k] = *(const PG8_LAS bf16x8*)(lds + PG8_SB(b, h) + boff + n * 2048 + k * 1024); } while (0)
#define PG8_MMA(ai, bj, At, Bt) do { __builtin_amdgcn_s_setprio(1); _Pragma("unroll") for (int m = 0; m < 4; ++m) _Pragma("unroll") for (int n = 0; n < 2; ++n) _Pragma("unroll") for (int k = 0; k < 2; ++k) \
        acc[ai][bj][m][n] = __builtin_amdgcn_mfma_f32_16x16x32_bf16(Bt[n][k], At[m][k], acc[ai][bj][m][n], 0, 0, 0); __builtin_amdgcn_s_setprio(0); } while (0)
#define PG8_WAIT_V(n) asm volatile("s_waitcnt vmcnt(" #n ")" ::: "memory")
#define PG8_WAIT_L(n) asm volatile("s_waitcnt lgkmcnt(" #n ")" ::: "memory")
#define PG8_BAR __builtin_amdgcn_s_barrier()
#define PG8_SCHED __builtin_amdgcn_sched_barrier(0)
    Unit cur, nxt; int ui = 0;
    if (!S.next(0, cur)) return;
    f32x4 acc[2][2][4][2];
#pragma unroll
    for (int a = 0; a < 2; ++a)
#pragma unroll
        for (int b = 0; b < 2; ++b)
#pragma unroll
            for (int m = 0; m < 4; ++m)
#pragma unroll
                for (int n = 0; n < 2; ++n) acc[a][b][m][n] = (f32x4){0.f, 0.f, 0.f, 0.f};
    bf16x8 At[4][2], B0[2][2], B1[2][2];
    const char* cA = (const char*)g.A + (size_t)cur.pm * tstep; const char* cB = (const char*)g.Bt + (size_t)cur.pn * tstep;
    S.a_ready(cur);
    if constexpr (SP2) {
        PG8_STAGE(PG8_SB(0, 0), cB, voffB); PG8_STAGE(PG8_SB(0, 1), cB + hstep, voffB); PG8_STAGE(PG8_SA(0, 0), cA, voffA); PG8_STAGE(PG8_SA(0, 1), cA + hstep, voffA);
        if (wr == 1) PG8_BAR;
        PG8_WAIT_V(2); PG8_BAR;
        PG8_STAGE(PG8_SB(1, 0), cB + kstep, voffB); PG8_STAGE(PG8_SA(1, 0), cA + kstep, voffA); PG8_STAGE(PG8_SB(1, 1), cB + hstep + kstep, voffB);
        PG8_WAIT_V(6); PG8_BAR;
    } else {
        PG8_STAGE(PG8_SB(0, 0), cB, voffB); PG8_STAGE(PG8_SA(0, 0), cA, voffA); PG8_STAGE(PG8_SB(0, 1), cB + hstep, voffB); PG8_STAGE(PG8_SA(0, 1), cA + hstep, voffA);
        if (wr == 1) PG8_BAR;
        PG8_WAIT_V(4); PG8_BAR;
        PG8_STAGE(PG8_SB(1, 0), cB + kstep, voffB); PG8_STAGE(PG8_SA(1, 0), cA + kstep, voffA); PG8_STAGE(PG8_SB(1, 1), cB + hstep + kstep, voffB);
        PG8_WAIT_V(6); PG8_BAR;
    }
    for (;;) {
        const bool has_next = S.next(ui + 1, nxt);
        const char* nA = has_next ? (const char*)g.A + (size_t)nxt.pm * tstep : cA; const char* nB = has_next ? (const char*)g.Bt + (size_t)nxt.pn * tstep : cB;
        for (int t = 0; t < nt; t += 2) {
            const bool last = (t == nt - 2);
            const char* a1 = cA + (size_t)(t + 1) * kstep;
            const char* a2 = last ? nA : cA + (size_t)(t + 2) * kstep; const char* b2 = last ? nB : cB + (size_t)(t + 2) * kstep;
            const char* a3 = a2 + kstep; const char* b3 = b2 + kstep;
            if (last && has_next) S.a_ready(nxt);
            if constexpr (SP2) {
            PG8_LDB(B0, 0, 0); PG8_LDB(B1, 0, 1); PG8_SCHED; PG8_LDA(At, 0, 0); PG8_STAGE(PG8_SA(1, 1), a1 + hstep, voffA);
            PG8_WAIT_V(8); PG8_WAIT_L(0); PG8_BAR; PG8_MMA(0, 0, At, B0); PG8_MMA(0, 1, At, B1); PG8_BAR; PG8_SCHED;
            PG8_LDA(At, 0, 1); PG8_STAGE(PG8_SB(0, 0), b2, voffB); PG8_STAGE(PG8_SB(0, 1), b2 + hstep, voffB); PG8_STAGE(PG8_SA(0, 0), a2, voffA);
            PG8_WAIT_V(8); PG8_WAIT_L(0); PG8_BAR; PG8_MMA(1, 0, At, B0); PG8_MMA(1, 1, At, B1); PG8_BAR; PG8_SCHED;
            PG8_LDB(B0, 1, 0); PG8_LDB(B1, 1, 1); PG8_SCHED; PG8_LDA(At, 1, 0); PG8_STAGE(PG8_SA(0, 1), a2 + hstep, voffA);
            PG8_WAIT_V(8); PG8_WAIT_L(0); PG8_BAR; PG8_MMA(0, 0, At, B0); PG8_MMA(0, 1, At, B1); PG8_BAR; PG8_SCHED;
            PG8_LDA(At, 1, 1); PG8_STAGE(PG8_SB(1, 0), b3, voffB); PG8_STAGE(PG8_SB(1, 1), b3 + hstep, voffB); PG8_STAGE(PG8_SA(1, 0), a3, voffA);
            PG8_WAIT_V(8); PG8_WAIT_L(0); PG8_BAR; PG8_MMA(1, 0, At, B0); PG8_MMA(1, 1, At, B1); PG8_BAR; PG8_SCHED;
            } else {
            PG8_LDB(B0, 0, 0); PG8_SCHED; PG8_LDA(At, 0, 0); PG8_STAGE(PG8_SA(1, 1), a1 + hstep, voffA);
            PG8_WAIT_L(8); PG8_BAR; PG8_WAIT_L(0); PG8_MMA(0, 0, At, B0); PG8_BAR; PG8_SCHED;
            PG8_LDB(B1, 0, 1); PG8_STAGE(PG8_SB(0, 0), b2, voffB);
            PG8_BAR; PG8_WAIT_L(0); PG8_MMA(0, 1, At, B1); PG8_BAR;
            PG8_LDA(At, 0, 1); PG8_STAGE(PG8_SA(0, 0), a2, voffA);
            PG8_BAR; PG8_WAIT_L(0); PG8_MMA(1, 0, At, B0); PG8_BAR; PG8_SCHED;
            PG8_STAGE(PG8_SB(0, 1), b2 + hstep, voffB);
            PG8_WAIT_V(6); PG8_BAR; PG8_MMA(1, 1, At, B1); PG8_BAR;
            PG8_LDB(B0, 1, 0); PG8_SCHED; PG8_LDA(At, 1, 0); PG8_STAGE(PG8_SA(0, 1), a2 + hstep, voffA);
            PG8_WAIT_L(8); PG8_BAR; PG8_WAIT_L(0); PG8_MMA(0, 0, At, B0); PG8_BAR; PG8_SCHED;
            PG8_LDB(B1, 1, 1); PG8_STAGE(PG8_SB(1, 0), b3, voffB);
            PG8_BAR; PG8_WAIT_L(0); PG8_MMA(0, 1, At, B1); PG8_BAR;
            PG8_LDA(At, 1, 1); PG8_STAGE(PG8_SA(1, 0), a3, voffA);
            PG8_BAR; PG8_WAIT_L(0); PG8_MMA(1, 0, At, B0); PG8_BAR; PG8_SCHED;
            PG8_STAGE(PG8_SB(1, 1), b3 + hstep, voffB);
            PG8_WAIT_V(6); PG8_BAR; PG8_MMA(1, 1, At, B1); PG8_BAR;
            }
        }
        if constexpr (ALIGN_EPI) { if (wr == 0) PG8_BAR; }
        if constexpr (!Epi::AFTER_DRAIN) { E(acc, cur, wr, wc, fr, fq); S.done(cur); }
        if (!has_next) break;
#pragma unroll
        for (int a = 0; a < 2; ++a)
#pragma unroll
            for (int b = 0; b < 2; ++b)
#pragma unroll
                for (int m = 0; m < 4; ++m)
#pragma unroll
                    for (int n = 0; n < 2; ++n) acc[a][b][m][n] = (f32x4){0.f, 0.f, 0.f, 0.f};
        cur = nxt; cA = nA; cB = nB; ++ui;
        if constexpr (ALIGN_EPI) { if (wr == 1) PG8_BAR; }
    }
    PG8_WAIT_V(0);
    if constexpr (!ALIGN_EPI) { if (wr == 0) PG8_BAR; }
    PG8_BAR;
    if constexpr (Epi::AFTER_DRAIN) { E.fused(acc, cur, wr, wc, fr, fq, lds, wid, lane); S.done(cur); }
#undef PG8_SA
#undef PG8_SB
#undef PG8_STAGE
#undef PG8_LDA
#undef PG8_LDB
#undef PG8_MMA
#undef PG8_WAIT_V
#undef PG8_WAIT_L
#undef PG8_BAR
#undef PG8_SCHED
}
}
#define XB_TMO      128
#define XB_XCNT(j)  (256  + 64 * (j))
#define XB_XSUB(j)  (1280 + 64 * (j))
#define XB_XGEN(j)  (2304 + 64 * (j))
#define XB_TOP      3328
#define XB_TOPGEN   3392
#define XCD_BAR_WORDS 3456
#define XB_SPIN_CAP (1u << 18)
#define LAS __attribute__((address_space(3)))

__device__ __forceinline__ unsigned xb_ld(unsigned* p)              { return __hip_atomic_load(p, __ATOMIC_RELAXED, __HIP_MEMORY_SCOPE_AGENT); }
__device__ __forceinline__ unsigned xb_add(unsigned* p, unsigned v) { return __hip_atomic_fetch_add(p, v, __ATOMIC_RELAXED, __HIP_MEMORY_SCOPE_AGENT); }
__device__ __forceinline__ unsigned xb_xcc_id() { return (unsigned)__builtin_amdgcn_s_getreg((3 << 11) | 20) & 0xFu; }
#define XB_SPIN(cond, bar) do { unsigned _sp = 0; while (cond) { __builtin_amdgcn_s_sleep(1); \
    if ((++_sp & 255u) == 0u) { if (xb_ld(&(bar)[XB_TMO])) break; if (_sp > XB_SPIN_CAP) { atomicAdd(&(bar)[XB_TMO], 1u); break; } } } } while (0)

struct XcdBarrier {
    unsigned* bar; unsigned x;
    volatile LAS unsigned* st;
};

__device__ __forceinline__ XcdBarrier xcd_barrier_post(unsigned* bar, volatile LAS unsigned* st) {
    XcdBarrier b; b.bar = bar; b.x = xb_xcc_id(); b.st = st;
    if (mk_tidx() == 0) (void)xb_add(&bar[XB_XCNT(b.x)], 1u);
    return b;
}
__device__ __forceinline__ void xcd_barrier_complete(unsigned* bar, unsigned x, unsigned& nloc, unsigned& nx) {
    const unsigned G = gridDim.x * gridDim.y * gridDim.z;
    unsigned sum, cnt, mine, sp = 0u;
    for (;;) {
        sum = 0u; cnt = 0u; mine = 0u;
#pragma unroll
        for (unsigned j = 0; j < 16; ++j) { const unsigned c = xb_ld(&bar[XB_XCNT(j)]); sum += c; cnt += (c > 0u) ? 1u : 0u; mine = (j == x) ? c : mine; }
        if (sum == G) break;
        __builtin_amdgcn_s_sleep(1);
        if ((++sp & 255u) == 0u) { if (xb_ld(&bar[XB_TMO])) break; if (sp > XB_SPIN_CAP) { atomicAdd(&bar[XB_TMO], 1u); break; } }
    }
    nloc = mine > 0u ? mine : 1u; nx = cnt > 0u ? cnt : 1u;
}

__device__ __forceinline__ void xcd_barrier(const XcdBarrier& b) {
    asm volatile("s_waitcnt vmcnt(0)" ::: "memory");
    __syncthreads();
    if (mk_tidx() == 0) {
        unsigned* bar = b.bar;
        __builtin_amdgcn_s_waitcnt(0);
        unsigned nloc = b.st[0], nx = b.st[1];
        if (nloc == 0u) { xcd_barrier_complete(bar, b.x, nloc, nx); b.st[0] = nloc; b.st[1] = nx; }
        const unsigned old = xb_add(&bar[XB_XSUB(b.x)], 1u);
        const unsigned gen = old / nloc;
        if (old + 1u == (gen + 1u) * nloc) {
            __builtin_amdgcn_fence(__ATOMIC_RELEASE, "agent");
            asm volatile("s_waitcnt vmcnt(0)" ::: "memory");
            const unsigned og = xb_add(&bar[XB_TOP], 1u);
            const unsigned tg = og / nx;
            if (og + 1u == (tg + 1u) * nx) xb_add(&bar[XB_TOPGEN], 1u);
            else XB_SPIN(xb_ld(&bar[XB_TOPGEN]) == tg, bar);
            __builtin_amdgcn_fence(__ATOMIC_ACQUIRE, "agent");
            xb_add(&bar[XB_XGEN(b.x)], 1u);
            asm volatile("s_waitcnt vmcnt(0)" ::: "memory");
        } else {
            XB_SPIN(xb_ld(&bar[XB_XGEN(b.x)]) == gen, bar);
            __builtin_amdgcn_fence(__ATOMIC_ACQUIRE, "agent");
            asm volatile("s_waitcnt vmcnt(0)" ::: "memory");
        }
    }
    __syncthreads();
}
namespace pg8 {
template <class Epi, class Sched>
__device__ __forceinline__ void gemm_phase_ga(PG8_LAS unsigned char* lds, const Gemm g, const Sched& S, const Epi& E) {
    const int tid = mk_tidx(), wid = __builtin_amdgcn_readfirstlane(tid >> 6), lane = tid & 63, wr = wid >> 2, wc = wid & 3, fr = lane & 15, fq = lane >> 4;
    const int K = g.K, nt = K / BK;
    unsigned voffB[2]; int RA[2], CA[2];
#pragma unroll
    for (int i = 0; i < 2; ++i) { int R, C; stage_rc(tid * 16 + i * 8192, R, C); const int Rb = Epi::PERM ? ((R & ~31) + perm32(R & 31)) : R;
        RA[i] = R; CA[i] = C; voffB[i] = (unsigned)(Rb * K + C) * 2u; }
    const size_t kstep = (size_t)(BK * 2);
    const size_t hstep = (size_t)HALF * K * 2;
    const size_t tstep = 2 * hstep;
    const unsigned ldsw = (unsigned)wid * 1024u;
    const int aoff = lds_byte(wr * 64 + fr, fq * 8), boff = lds_byte(wc * 32 + fr, fq * 8);
#define PG8_SA(b, h) (((b) * 2 + (h)) * HTB)
#define PG8_SB(b, h) ((4 + (b) * 2 + (h)) * HTB)
#define PG8_STAGE(bufoff, gbase, voff) do { _Pragma("unroll") for (int _i = 0; _i < 2; ++_i) \
        __builtin_amdgcn_global_load_lds((const unsigned*)((const char*)(gbase) + (voff)[_i]), (PG8_LAS unsigned*)(lds + (bufoff) + ldsw + _i * 8192), 16, 0, 0); } while (0)
#define PG8_LDA(dst, b, h) do { _Pragma("unroll") for (int m = 0; m < 4; ++m) _Pragma("unroll") for (int k = 0; k < 2; ++k) dst[m][k] = *(const PG8_LAS bf16x8*)(lds + PG8_SA(b, h) + aoff + m * 2048 + k * 1024); } while (0)
#define PG8_LDB(dst, b, h) do { _Pragma("unroll") for (int n = 0; n < 2; ++n) _Pragma("unroll") for (int k = 0; k < 2; ++k) dst[n][k] = *(const PG8_LAS bf16x8*)(lds + PG8_SB(b, h) + boff + n * 2048 + k * 1024); } while (0)
#define PG8_MMA(ai, bj, At, Bt) do { __builtin_amdgcn_s_setprio(1); _Pragma("unroll") for (int m = 0; m < 4; ++m) _Pragma("unroll") for (int n = 0; n < 2; ++n) _Pragma("unroll") for (int k = 0; k < 2; ++k) \
        acc[ai][bj][m][n] = __builtin_amdgcn_mfma_f32_16x16x32_bf16(Bt[n][k], At[m][k], acc[ai][bj][m][n], 0, 0, 0); __builtin_amdgcn_s_setprio(0); } while (0)
#define PG8_WAIT_V(n) asm volatile("s_waitcnt vmcnt(" #n ")" ::: "memory")
#define PG8_WAIT_L(n) asm volatile("s_waitcnt lgkmcnt(0)" ::: "memory")
#define PG8_BAR __builtin_amdgcn_s_barrier()
#define PG8_SCHED __builtin_amdgcn_sched_barrier(0)
#define PG8_AOFF(dst, u) do { _Pragma("unroll") for (int _h = 0; _h < 2; ++_h) _Pragma("unroll") for (int _i = 0; _i < 2; ++_i) \
        dst[_h][_i] = (unsigned)S.arow(u, _h * HALF + RA[_i]) * (unsigned)(K * 2) + (unsigned)(CA[_i] * 2); } while (0)
    Unit cur, nxt; int ui = 0;
    if (!S.next(0, cur)) return;
    f32x4 acc[2][2][4][2];
#pragma unroll
    for (int a = 0; a < 2; ++a)
#pragma unroll
        for (int b = 0; b < 2; ++b)
#pragma unroll
            for (int m = 0; m < 4; ++m)
#pragma unroll
                for (int n = 0; n < 2; ++n) acc[a][b][m][n] = (f32x4){0.f, 0.f, 0.f, 0.f};
    bf16x8 At[4][2], B0[2][2], B1[2][2];
    unsigned offC[2][2], offN[2][2];
    PG8_AOFF(offC, cur);
    const char* gA = (const char*)g.A;
    const char* cB = (const char*)g.Bt + (size_t)cur.pn * tstep;
    S.a_ready(cur);
    PG8_STAGE(PG8_SB(0, 0), cB, voffB); PG8_STAGE(PG8_SB(0, 1), cB + hstep, voffB); PG8_STAGE(PG8_SA(0, 0), gA, offC[0]); PG8_STAGE(PG8_SA(0, 1), gA, offC[1]);
    if (wr == 1) PG8_BAR;
    PG8_WAIT_V(2); PG8_BAR;
    PG8_STAGE(PG8_SB(1, 0), cB + kstep, voffB); PG8_STAGE(PG8_SA(1, 0), gA + kstep, offC[0]); PG8_STAGE(PG8_SB(1, 1), cB + hstep + kstep, voffB);
    PG8_WAIT_V(6); PG8_BAR;
    for (;;) {
        const bool has_next = S.next(ui + 1, nxt);
        if (has_next) { PG8_AOFF(offN, nxt); } else {
#pragma unroll
            for (int h_ = 0; h_ < 2; ++h_)
#pragma unroll
                for (int i_ = 0; i_ < 2; ++i_) offN[h_][i_] = offC[h_][i_]; }
        const char* nB = has_next ? (const char*)g.Bt + (size_t)nxt.pn * tstep : cB;
        for (int t = 0; t < nt; t += 2) {
            const bool last = (t == nt - 2);
            const char* a1 = gA + (size_t)(t + 1) * kstep;
            const char* a2 = last ? gA : gA + (size_t)(t + 2) * kstep; const char* b2 = last ? nB : cB + (size_t)(t + 2) * kstep;
            const char* a3 = a2 + kstep; const char* b3 = b2 + kstep;
            unsigned o2[2][2];
#pragma unroll
            for (int h_ = 0; h_ < 2; ++h_)
#pragma unroll
                for (int i_ = 0; i_ < 2; ++i_) o2[h_][i_] = last ? offN[h_][i_] : offC[h_][i_];
            if (last && has_next) S.a_ready(nxt);
            PG8_LDB(B0, 0, 0); PG8_LDB(B1, 0, 1); PG8_SCHED; PG8_LDA(At, 0, 0); PG8_STAGE(PG8_SA(1, 1), a1, offC[1]);
            PG8_WAIT_V(8); PG8_WAIT_L(0); PG8_BAR; PG8_MMA(0, 0, At, B0); PG8_MMA(0, 1, At, B1); PG8_BAR; PG8_SCHED;
            PG8_LDA(At, 0, 1); PG8_STAGE(PG8_SB(0, 0), b2, voffB); PG8_STAGE(PG8_SB(0, 1), b2 + hstep, voffB); PG8_STAGE(PG8_SA(0, 0), a2, o2[0]);
            PG8_WAIT_V(8); PG8_WAIT_L(0); PG8_BAR; PG8_MMA(1, 0, At, B0); PG8_MMA(1, 1, At, B1); PG8_BAR; PG8_SCHED;
            PG8_LDB(B0, 1, 0); PG8_LDB(B1, 1, 1); PG8_SCHED; PG8_LDA(At, 1, 0); PG8_STAGE(PG8_SA(0, 1), a2, o2[1]);
            PG8_WAIT_V(8); PG8_WAIT_L(0); PG8_BAR; PG8_MMA(0, 0, At, B0); PG8_MMA(0, 1, At, B1); PG8_BAR; PG8_SCHED;
            PG8_LDA(At, 1, 1); PG8_STAGE(PG8_SB(1, 0), b3, voffB); PG8_STAGE(PG8_SB(1, 1), b3 + hstep, voffB); PG8_STAGE(PG8_SA(1, 0), a3, o2[0]);
            PG8_WAIT_V(8); PG8_WAIT_L(0); PG8_BAR; PG8_MMA(1, 0, At, B0); PG8_MMA(1, 1, At, B1); PG8_BAR; PG8_SCHED;
        }
        if (wr == 0) PG8_BAR;
        E(acc, cur, wr, wc, fr, fq); S.done(cur);
        if (!has_next) break;
#pragma unroll
        for (int a = 0; a < 2; ++a)
#pragma unroll
            for (int b = 0; b < 2; ++b)
#pragma unroll
                for (int m = 0; m < 4; ++m)
#pragma unroll
                    for (int n = 0; n < 2; ++n) acc[a][b][m][n] = (f32x4){0.f, 0.f, 0.f, 0.f};
        cur = nxt; cB = nB; ++ui;
#pragma unroll
        for (int h_ = 0; h_ < 2; ++h_)
#pragma unroll
            for (int i_ = 0; i_ < 2; ++i_) offC[h_][i_] = offN[h_][i_];
        if (wr == 1) PG8_BAR;
    }
    PG8_WAIT_V(0);
    PG8_BAR;
#undef PG8_SA
#undef PG8_SB
#undef PG8_STAGE
#undef PG8_LDA
#undef PG8_LDB
#undef PG8_MMA
#undef PG8_WAIT_V
#undef PG8_WAIT_L
#undef PG8_BAR
#undef PG8_SCHED
#undef PG8_AOFF
}
}
namespace attn_body {
using bf16=unsigned short;
using bf16x8=__attribute__((ext_vector_type(8)))short;
using s16x4=__attribute__((ext_vector_type(4)))short;
using f32x16=__attribute__((ext_vector_type(16)))float;
using u32x4=__attribute__((ext_vector_type(4)))unsigned;
constexpr int BATCH=4,NHEAD=8,SEQ=4096,D=64,DM=NHEAD*D,ODM=1024;
constexpr int NW=8,QBLK=32,QB=QBLK*NW,KVBLK=64,NQB=SEQ/QB;
constexpr int ATTN_PITCH=DM, ATTN_UNIT_ROWS=QB;
__device__ __forceinline__ int crow(int r,int hi){return (r&3)+8*(r>>2)+4*hi;}
#define SBAR() __builtin_amdgcn_sched_barrier(0)
__device__ __forceinline__ void cmask(f32x16&p0,f32x16&p1,int jb,int qrel,int hi){
  const float NEG=-INFINITY; int kb=64*jb+4*hi;
  #pragma unroll
  for(int r=0;r<16;++r){int kv=kb+(r&3)+8*(r>>2); if(kv>qrel)p0[r]=NEG; if(kv+32>qrel)p1[r]=NEG;}
}

constexpr int NSLOT=3, SLOTB=8192;
constexpr int LDS_K=0, LDS_V=NSLOT*SLOTB, LDS_WS=2*NSLOT*SLOTB, LDS_OST=LDS_WS+NW*64*4, LDS_MSK=LDS_OST+NW*4096, LDS_BYTES=LDS_MSK+NW*768;
constexpr float C2=0.125f*1.4426950408889634f;
__device__ __forceinline__ void glds16(const void*gsrc,unsigned lds_dst){unsigned keep;
  asm volatile("s_mov_b32 %0, m0\n\ts_mov_b32 m0, %2\n\ts_nop 0\n\tglobal_load_lds_dwordx4 %1, off\n\ts_mov_b32 m0, %0":"=&s"(keep):"v"(gsrc),"s"(lds_dst):"memory");}
__device__ __forceinline__ void glds4(const void*gsrc,unsigned lds_dst){unsigned keep;
  asm volatile("s_mov_b32 %0, m0\n\ts_mov_b32 m0, %2\n\ts_nop 0\n\tglobal_load_lds_dword %1, off\n\ts_mov_b32 m0, %0":"=&s"(keep):"v"(gsrc),"s"(lds_dst):"memory");}
template<int BIT> __device__ __forceinline__ float mand(float x,unsigned w){ int m; asm("v_bfe_i32 %0, %1, %2, 1":"=v"(m):"v"(w),"n"((BIT&~3)|((BIT&1)<<1)|((BIT>>1)&1))); return __uint_as_float(__float_as_uint(x)&(unsigned)m); }
__device__ __forceinline__ float max3f(float a,float b,float c){float r;asm("v_max3_f32 %0, %1, %2, %3":"=v"(r):"v"(a),"v"(b),"v"(c));return r;}
__device__ __forceinline__ float max2f(float a,float b){float r;asm("v_max_f32_e32 %0, %1, %2":"=v"(r):"v"(a),"v"(b));return r;}
__device__ __forceinline__ float fadd_s(float a,float b){float r;asm("v_add_f32_e32 %0, %1, %2":"=v"(r):"v"(a),"v"(b));return r;}
__device__ __forceinline__ float fsub_s(float a,float b){float r;asm("v_sub_f32_e32 %0, %1, %2":"=v"(r):"v"(a),"v"(b));return r;}
typedef float f32x2_t __attribute__((ext_vector_type(2))); typedef __bf16 bf16x2_t __attribute__((ext_vector_type(2)));
__device__ __forceinline__ unsigned cvtpk_s(float lo,float hi){f32x2_t v={lo,hi};bf16x2_t b=__builtin_convertvector(v,bf16x2_t);return __builtin_bit_cast(unsigned,b);}
#define WAIT_BAR(N) asm volatile("s_waitcnt vmcnt(" #N ") lgkmcnt(0)\n\ts_barrier":::"memory")

__device__ __forceinline__ void qkt(f32x16&p0,f32x16&p1,const char*Kslot,const bf16x8*qr,const f32x16&negm,int r32,int hi){
  const char*kb=Kslot+hi*1024+r32*16;
  #pragma unroll
  for(int d0=0;d0<4;++d0){
    const bf16x8 b0=*reinterpret_cast<const bf16x8*>(kb+d0*2048);
    const bf16x8 b1=*reinterpret_cast<const bf16x8*>(kb+d0*2048+512);
    if(d0==0){p0=__builtin_amdgcn_mfma_f32_32x32x16_bf16(b0,qr[0],negm,0,0,0);p1=__builtin_amdgcn_mfma_f32_32x32x16_bf16(b1,qr[0],negm,0,0,0);}
    else{p0=__builtin_amdgcn_mfma_f32_32x32x16_bf16(b0,qr[d0],p0,0,0,0);p1=__builtin_amdgcn_mfma_f32_32x32x16_bf16(b1,qr[d0],p1,0,0,0);}}
}
typedef __attribute__((address_space(3))) const char* lds_cptr;
typedef short v4i16_t __attribute__((ext_vector_type(4)));
__device__ __forceinline__ void kload8(bf16x8*kf,lds_cptr kp){
  kf[0]=*(const __attribute__((address_space(3))) bf16x8*)(kp);      kf[1]=*(const __attribute__((address_space(3))) bf16x8*)(kp+512);
  kf[2]=*(const __attribute__((address_space(3))) bf16x8*)(kp+2048); kf[3]=*(const __attribute__((address_space(3))) bf16x8*)(kp+2560);
  kf[4]=*(const __attribute__((address_space(3))) bf16x8*)(kp+4096); kf[5]=*(const __attribute__((address_space(3))) bf16x8*)(kp+4608);
  kf[6]=*(const __attribute__((address_space(3))) bf16x8*)(kp+6144); kf[7]=*(const __attribute__((address_space(3))) bf16x8*)(kp+6656);
}
__device__ __forceinline__ void kload2(bf16x8*kf,lds_cptr kp,int j){ kf[2*j]=*(const __attribute__((address_space(3))) bf16x8*)(kp+j*2048); kf[2*j+1]=*(const __attribute__((address_space(3))) bf16x8*)(kp+j*2048+512); }
__device__ __forceinline__ s16x4 vtr(lds_cptr p){ return __builtin_bit_cast(s16x4,__builtin_amdgcn_ds_read_tr16_b64_v4i16((__attribute__((address_space(3))) v4i16_t*)p)); }
__device__ __forceinline__ float rowmax(const f32x16&p0,const f32x16&p1){
  float a=max3f(p0[0],p0[1],p1[0]),b=max3f(p0[2],p0[3],p1[1]);a=max3f(a,p1[2],p1[3]);
  #pragma unroll
  for(int r=4;r<16;r+=4){a=max3f(a,p0[r],p0[r+1]);b=max3f(b,p0[r+2],p0[r+3]);a=max3f(a,p1[r],p1[r+1]);b=max3f(b,p1[r+2],p1[r+3]);}
  const float m=max2f(a,b);
  auto rr=__builtin_amdgcn_permlane32_swap(__float_as_uint(m),__float_as_uint(m),false,false);
  return max2f(__uint_as_float(rr[0]),__uint_as_float(rr[1]));
}
__device__ __forceinline__ void pv(f32x16*o,int vb,bf16x8 pa0,bf16x8 pa1,bf16x8 pa2,bf16x8 pa3){
  #pragma unroll
  for(int d0=0;d0<2;++d0){s16x4 lo[4],hi[4];
    #pragma unroll
    for(int ks=0;ks<4;++ks){
      asm volatile("ds_read_b64_tr_b16 %0,%1 offset:%c2":"=&v"(lo[ks]):"v"(vb),"i"(d0*4096+ks*1024):"memory");
      asm volatile("ds_read_b64_tr_b16 %0,%1 offset:%c2":"=&v"(hi[ks]):"v"(vb),"i"(d0*4096+ks*1024+512):"memory");}
    asm volatile("s_waitcnt lgkmcnt(0)":::"memory");SBAR();
    #define PK(k) (bf16x8){lo[k][0],lo[k][1],lo[k][2],lo[k][3],hi[k][0],hi[k][1],hi[k][2],hi[k][3]}
    o[d0]=__builtin_amdgcn_mfma_f32_32x32x16_bf16(pa0,PK(0),o[d0],0,0,0);
    o[d0]=__builtin_amdgcn_mfma_f32_32x32x16_bf16(pa1,PK(1),o[d0],0,0,0);
    o[d0]=__builtin_amdgcn_mfma_f32_32x32x16_bf16(pa2,PK(2),o[d0],0,0,0);
    o[d0]=__builtin_amdgcn_mfma_f32_32x32x16_bf16(pa3,PK(3),o[d0],0,0,0);
    #undef PK
  }
}

#ifndef ATTN_STORE16
#define ATTN_STORE16(p,v) (*(u32x4*)(p)=(v))
#endif
template<int THRL> __device__ __forceinline__ void attn_unit(int b,int h,int qb,const bf16*Q,const bf16*__restrict__ K,const bf16*__restrict__ V,bf16*O,const unsigned*__restrict__ MK,char*shm){
  const int tid=mk_tidx(),lane=tid&63,r32=lane&31,hi=lane>>5; const int wid=__builtin_amdgcn_readfirstlane(tid>>6);
  const long rowbase=(long)b*SEQ; const int q0=qb*QB;
  const bf16*Qw=Q+(rowbase+q0+wid*QBLK)*DM+h*D;
  const bf16*Kh=K+rowbase*DM+h*D,*Vh=V+rowbase*DM+h*D;
  const unsigned lds0=(unsigned)(uintptr_t)shm;
  float*wsf=(float*)(shm+LDS_WS)+wid*64;
  const bf16*ksrc=Kh+(long)lane*DM+wid*8;
  const bf16*vsrc=Vh+(long)(16*(wid&3)+(lane>>2))*DM+(wid>>2)*32+(lane&3)*8;
  const unsigned kdst=lds0+LDS_K+wid*1024, vdst=lds0+LDS_V+wid*1024;
  const unsigned*msrc=MK+((size_t)(b*SEQ+32*(8*qb+wid)+(lane&31))*64)*2+(lane>>5);     const unsigned mdst=lds0+LDS_MSK+wid*768;
  const __attribute__((address_space(3))) char*mrd=(__attribute__((address_space(3))) const char*)shm+LDS_MSK+wid*768+lane*4;
  int mq_cur=0,mq_n1=256,mq_n2=512;
  #define DMA_M(t,slot) glds4(msrc+(size_t)(t)*2,(unsigned)__builtin_amdgcn_readfirstlane(mdst+(slot)))
  #define MWORD() (*(const __attribute__((address_space(3))) unsigned*)(mrd+mq_cur))
  #define DMA_K(t,slot) glds16(ksrc+(long)(t)*KVBLK*DM,(unsigned)__builtin_amdgcn_readfirstlane(kdst+(slot)))
  #define DMA_V(t,slot) glds16(vsrc+(long)(t)*KVBLK*DM,(unsigned)__builtin_amdgcn_readfirstlane(vdst+(slot)))
  const int vb0=(int)(lds0+LDS_V)+((lane>>4)&1)*32+(lane&3)*8+(4*hi+((lane&15)>>2))*64;
  const char*Kbase=shm+LDS_K; bf16x8 kf[8];
  const lds_cptr shm3=(lds_cptr)shm; const lds_cptr kp0=shm3+LDS_K+hi*1024+r32*16; const lds_cptr vp0=shm3+LDS_V+((lane>>4)&1)*32+(lane&3)*8+(4*hi+((lane&15)>>2))*64;
  const int NT=(q0+QB)/KVBLK;
  DMA_M(0,0);DMA_M(1,256);DMA_K(0,0);DMA_V(0,0);DMA_K(1,SLOTB);
  bf16x8 qr[4];
  #pragma unroll
  for(int d0=0;d0<4;++d0)qr[d0]=*reinterpret_cast<const bf16x8*>(&Qw[(long)r32*DM+d0*16+hi*8]);
  float mhat=0.f,l_reg=0.f;f32x16 o[2];o[0]=f32x16{};o[1]=f32x16{};f32x16 negm=f32x16{};asm volatile("":"+v"(negm));
  const int qrel=wid*QBLK+r32;
  #define CMASK(P0,P1,t) do{}while(0)
  bool resc=false;
  #define START(P0,P1) do{ const float rm=rowmax(P0,P1); resc=false; \
    { const float dl=(rm>-1e30f)?rm:0.f; mhat=fadd_s(mhat,dl); \
      _Pragma("unroll") for(int r=0;r<16;++r){P0[r]=fsub_s(P0[r],dl);P1[r]=fsub_s(P1[r],dl);} \
      _Pragma("unroll") for(int r=0;r<16;++r)negm[r]=-mhat; asm volatile("":"+v"(negm)); } \
    _Pragma("unroll") for(int r=0;r<16;++r)P0[r]=__builtin_amdgcn_exp2f(P0[r]); }while(0)
  #define RESC() do{ if(resc){ asm volatile("s_waitcnt lgkmcnt(0)":::"memory"); \
      _Pragma("unroll") for(int d_=0;d_<2;++d_) _Pragma("unroll") for(int r=0;r<16;++r)o[d_][r]*=wsf[crow(r,hi)]; } }while(0)
  f32x16 pA0,pA1,pB0,pB1;
  int sl_prev=0,sl_cur=0,sl_next=SLOTB;
  #define ROT() do{sl_prev=sl_cur;sl_cur=sl_next;sl_next=(sl_next==(NSLOT-1)*SLOTB)?0:sl_next+SLOTB; const int mt_=mq_cur;mq_cur=mq_n1;mq_n1=mq_n2;mq_n2=mt_;}while(0)
  DMA_K(2,2*SLOTB);
  WAIT_BAR(3);
  qkt(pA0,pA1,Kbase,qr,negm,r32,hi);asm volatile("s_nop 15\n\ts_nop 7":"+v"(pA0),"+v"(pA1));CMASK(pA0,pA1,0);
  START(pA0,pA1);
  _Pragma("unroll") for(int r=0;r<16;++r)pA1[r]=__builtin_amdgcn_exp2f(pA1[r]);
  { const unsigned mw0=MWORD(); pA0[0]=mand<0>(pA0[0],mw0);pA1[0]=mand<16>(pA1[0],mw0);pA0[1]=mand<1>(pA0[1],mw0);pA1[1]=mand<17>(pA1[1],mw0);pA0[2]=mand<2>(pA0[2],mw0);pA1[2]=mand<18>(pA1[2],mw0);pA0[3]=mand<3>(pA0[3],mw0);pA1[3]=mand<19>(pA1[3],mw0);pA0[4]=mand<4>(pA0[4],mw0);pA1[4]=mand<20>(pA1[4],mw0);pA0[5]=mand<5>(pA0[5],mw0);pA1[5]=mand<21>(pA1[5],mw0);pA0[6]=mand<6>(pA0[6],mw0);pA1[6]=mand<22>(pA1[6],mw0);pA0[7]=mand<7>(pA0[7],mw0);pA1[7]=mand<23>(pA1[7],mw0);pA0[8]=mand<8>(pA0[8],mw0);pA1[8]=mand<24>(pA1[8],mw0);pA0[9]=mand<9>(pA0[9],mw0);pA1[9]=mand<25>(pA1[9],mw0);pA0[10]=mand<10>(pA0[10],mw0);pA1[10]=mand<26>(pA1[10],mw0);pA0[11]=mand<11>(pA0[11],mw0);pA1[11]=mand<27>(pA1[11],mw0);pA0[12]=mand<12>(pA0[12],mw0);pA1[12]=mand<28>(pA1[12],mw0);pA0[13]=mand<13>(pA0[13],mw0);pA1[13]=mand<29>(pA1[13],mw0);pA0[14]=mand<14>(pA0[14],mw0);pA1[14]=mand<30>(pA1[14],mw0);pA0[15]=mand<15>(pA0[15],mw0);pA1[15]=mand<31>(pA1[15],mw0); }
  WAIT_BAR(0);
  DMA_M(2,512);DMA_K(3,0);DMA_V(1,SLOTB);
  ROT();
  kload8(kf,kp0+sl_cur);
  WAIT_BAR(3);
  s16x4 vlo[8],vhi[8]; u32x4 pw0,pw1,pw2,pw3;
  #define PKW(P,B) cvtpk_s(P[B],P[B+1])
  #define PAF(k) __builtin_bit_cast(bf16x8,pw##k)
  #define VFR(i) (bf16x8){vlo[i][0],vlo[i][1],vlo[i][2],vlo[i][3],vhi[i][0],vhi[i][1],vhi[i][2],vhi[i][3]}
  #define PIN(x) asm volatile("":"+v"(x))
  #define MX3(a,b,c) __builtin_fmaxf(__builtin_fmaxf((a),(b)),(c))
  #define GAPA(MF,A0,A1,A2,A3,W0,W1,PW) do{ MF; sacc+=A0; sacc+=A1; sacc+=A2; sacc+=A3; PIN(sacc); W0; W1; PIN(PW); SBAR(); }while(0)
  #define EX(v) __builtin_amdgcn_exp2f(v)
  #define GAPB(MF,X,B,MO) do{ MF; X[B]=mand<MO+B>(EX(X[B]),mw_); X[B+1]=mand<MO+B+1>(EX(X[B+1]),mw_); X[B+2]=mand<MO+B+2>(EX(X[B+2]),mw_); X[B+3]=mand<MO+B+3>(EX(X[B+3]),mw_); PIN(X); SBAR(); }while(0)
  #define VRD(i) do{ vlo[i]=vtr(vp_+(((i)>>2)*4096+((i)&3)*1024)); vhi[i]=vtr(vp_+(((i)>>2)*4096+((i)&3)*1024+512)); }while(0)
  #define KRD(G,j) do{ if(G){ kload2(kf,kp0+sl_next,j); SBAR(); } }while(0)
  #define STEP(C0,C1,P0,P1,t,GK,GV,GL,GM) do{ SBAR(); \
    const lds_cptr vp_=vp0+sl_prev; \
    VRD(0); SBAR(); float sacc=(P0[0]+P0[1]); \
    GAPA(C0=__builtin_amdgcn_mfma_f32_32x32x16_bf16(kf[0],qr[0],negm,0,0,0), P0[2],P0[3],P0[4],P0[5],     pw0[0]=PKW(P0,0), pw0[1]=PKW(P0,2), pw0); \
    VRD(4); SBAR(); GAPA(C1=__builtin_amdgcn_mfma_f32_32x32x16_bf16(kf[1],qr[0],negm,0,0,0), P0[6],P0[7],P0[8],P0[9],     pw0[2]=PKW(P0,4), pw0[3]=PKW(P0,6), pw0); \
    VRD(1); SBAR(); GAPA(C0=__builtin_amdgcn_mfma_f32_32x32x16_bf16(kf[2],qr[1],C0,0,0,0),   P0[10],P0[11],P0[12],P0[13], pw1[0]=PKW(P0,8), pw1[1]=PKW(P0,10), pw1); \
    VRD(5); SBAR(); GAPA(C1=__builtin_amdgcn_mfma_f32_32x32x16_bf16(kf[3],qr[1],C1,0,0,0),   P0[14],P0[15],P1[0],P1[1],   pw1[2]=PKW(P0,12),pw1[3]=PKW(P0,14), pw1); \
    VRD(2); SBAR(); GAPA(C0=__builtin_amdgcn_mfma_f32_32x32x16_bf16(kf[4],qr[2],C0,0,0,0),   P1[2],P1[3],P1[4],P1[5],     pw2[0]=PKW(P1,0), pw2[1]=PKW(P1,2), pw2); \
    VRD(6); SBAR(); GAPA(C1=__builtin_amdgcn_mfma_f32_32x32x16_bf16(kf[5],qr[2],C1,0,0,0),   P1[6],P1[7],P1[8],P1[9],     pw2[2]=PKW(P1,4), pw2[3]=PKW(P1,6), pw2); \
    VRD(3); SBAR(); GAPA(C0=__builtin_amdgcn_mfma_f32_32x32x16_bf16(kf[6],qr[3],C0,0,0,0),   P1[10],P1[11],P1[12],P1[13], pw3[0]=PKW(P1,8), pw3[1]=PKW(P1,10), pw3); \
    VRD(7); SBAR(); GAPA(C1=__builtin_amdgcn_mfma_f32_32x32x16_bf16(kf[7],qr[3],C1,0,0,0),   P1[14],P1[15],0.f,0.f,       pw3[2]=PKW(P1,12),pw3[3]=PKW(P1,14), pw3); \
    l_reg+=sacc; \
    if(GM){DMA_M((t)+2,mq_n2);} if(GK){DMA_K((t)+3,sl_cur);} if(GV){DMA_V((t)+1,sl_next);} \
    const unsigned mw_=MWORD(); \
    CMASK(C0,C1,t); \
    { float a=MX3(C0[0],C0[1],C1[0]),b=MX3(C0[2],C0[3],C1[1]); a=MX3(a,C1[2],C1[3]); \
      _Pragma("unroll") for(int r=4;r<16;r+=4){a=MX3(a,C0[r],C0[r+1]);b=MX3(b,C0[r+2],C0[r+3]);a=MX3(a,C1[r],C1[r+1]);b=MX3(b,C1[r+2],C1[r+3]);} \
      float rm=__builtin_fmaxf(a,b); { auto rr=__builtin_amdgcn_permlane32_swap(__float_as_uint(rm),__float_as_uint(rm),false,false); rm=__builtin_fmaxf(__uint_as_float(rr[0]),__uint_as_float(rr[1])); } \
      resc=false; \
      if(__builtin_expect(__any(rm>(float)THRL),0)){ const float dl=__builtin_fmaxf(rm,0.f); mhat+=dl; \
        _Pragma("unroll") for(int r=0;r<16;++r){C0[r]-=dl;C1[r]-=dl;} \
        _Pragma("unroll") for(int r=0;r<16;++r)negm[r]=-mhat; asm volatile("":"+v"(negm)); \
        const float f=__builtin_amdgcn_exp2f(-dl); l_reg*=f; if(hi==0)wsf[r32]=f; resc=true; } } \
    SBAR(); \
    GAPB(o[0]=__builtin_amdgcn_mfma_f32_32x32x16_bf16(PAF(0),VFR(0),o[0],0,0,0), C0,0,0); \
    GAPB(o[1]=__builtin_amdgcn_mfma_f32_32x32x16_bf16(PAF(0),VFR(4),o[1],0,0,0), C0,4,0); \
    KRD(GL,0); GAPB(o[0]=__builtin_amdgcn_mfma_f32_32x32x16_bf16(PAF(1),VFR(1),o[0],0,0,0), C0,8,0); \
    KRD(GL,1); GAPB(o[1]=__builtin_amdgcn_mfma_f32_32x32x16_bf16(PAF(1),VFR(5),o[1],0,0,0), C0,12,0); \
    KRD(GL,2); GAPB(o[0]=__builtin_amdgcn_mfma_f32_32x32x16_bf16(PAF(2),VFR(2),o[0],0,0,0), C1,0,16); \
    KRD(GL,3); GAPB(o[1]=__builtin_amdgcn_mfma_f32_32x32x16_bf16(PAF(2),VFR(6),o[1],0,0,0), C1,4,16); \
    GAPB(o[0]=__builtin_amdgcn_mfma_f32_32x32x16_bf16(PAF(3),VFR(3),o[0],0,0,0), C1,8,16); \
    GAPB(o[1]=__builtin_amdgcn_mfma_f32_32x32x16_bf16(PAF(3),VFR(7),o[1],0,0,0), C1,12,16); \
    }while(0)
  int t=1;
  #undef CMASK
  #define CMASK(P0,P1,t) do{}while(0)
  for(;t+5<NT;t+=2){
    STEP(pB0,pB1,pA0,pA1,t,true,true,true,true);     WAIT_BAR(3); RESC(); ROT();
    STEP(pA0,pA1,pB0,pB1,t+1,true,true,true,true);   WAIT_BAR(3); RESC(); ROT();
  }
  #undef CMASK
  #define CMASK(P0,P1,t) do{}while(0)
  #define ENDW(tt) do{ if((tt)+3<NT){WAIT_BAR(3);} else if((tt)+2<NT){WAIT_BAR(2);} else {WAIT_BAR(0);} }while(0)
  for(;t+1<NT;t+=2){
    STEP(pB0,pB1,pA0,pA1,t,(t+3<NT),(t+1<NT),(t+1<NT),(t+2<NT));       ENDW(t);   RESC(); ROT();
    STEP(pA0,pA1,pB0,pB1,t+1,(t+4<NT),(t+2<NT),(t+2<NT),(t+3<NT));     ENDW(t+1); RESC(); ROT();
  }
  STEP(pB0,pB1,pA0,pA1,NT-1,false,false,false,false); RESC();
  { float sacc=pB0[0]+pB0[1]; _Pragma("unroll") for(int r=2;r<16;++r)sacc+=pB0[r]; _Pragma("unroll") for(int r=0;r<16;++r)sacc+=pB1[r]; l_reg+=sacc;
    pw0=(u32x4){PKW(pB0,0),PKW(pB0,2),PKW(pB0,4),PKW(pB0,6)};pw1=(u32x4){PKW(pB0,8),PKW(pB0,10),PKW(pB0,12),PKW(pB0,14)};pw2=(u32x4){PKW(pB1,0),PKW(pB1,2),PKW(pB1,4),PKW(pB1,6)};pw3=(u32x4){PKW(pB1,8),PKW(pB1,10),PKW(pB1,12),PKW(pB1,14)};
    SBAR(); pv(o,vb0+sl_cur,PAF(0),PAF(1),PAF(2),PAF(3)); }
  #undef PKW
  #undef PAF
  #undef VFR
  #undef PIN
  #undef MX3
  #undef GAPA
  #undef GAPB
  #undef EX
  #undef VRD
  #undef KRD
  #undef STEP
  #undef ENDW
  {auto rr=__builtin_amdgcn_permlane32_swap(__float_as_uint(l_reg),__float_as_uint(l_reg),false,false);l_reg=__uint_as_float(rr[0])+__uint_as_float(rr[1]);}
  if(hi==0)wsf[32+r32]=l_reg;asm volatile("s_waitcnt lgkmcnt(0)":::"memory");
  float rli[16];
  #pragma unroll
  for(int r=0;r<16;++r)rli[r]=__builtin_amdgcn_rcpf(wsf[32+crow(r,hi)]);
  bf16*Ow=O+(rowbase+q0+wid*QBLK)*ODM+h*D;
  { bf16*stg=(bf16*)(shm+LDS_OST)+wid*2048;
    #pragma unroll
    for(int r=0;r<16;++r){const int orow=crow(r,hi);
      #pragma unroll
      for(int d0=0;d0<2;++d0)stg[orow*64+d0*32+r32]=(bf16)(cvtpk_s(o[d0][r]*rli[r],0.f)&0xffffu);}
    asm volatile("s_waitcnt lgkmcnt(0)":::"memory");
    #pragma unroll
    for(int i=0;i<4;++i){const int row=i*8+(lane>>3),ch=lane&7; const u32x4 v=*(const u32x4*)(stg+row*64+ch*8); ATTN_STORE16(Ow+(long)row*ODM+ch*8,v);} }
  asm volatile("s_waitcnt lgkmcnt(0)\n\ts_barrier":::"memory");
  #undef DMA_K
  #undef DMA_V
  #undef DMA_M
  #undef MWORD
  #undef CMASK
  #undef START
  #undef RESC
  #undef ROT
}
constexpr int ATTN_LDS_BYTES=LDS_BYTES;
struct AttnTensors { const bf16* Q; const bf16* K; const bf16* V; bf16* O; const unsigned* MK; };
struct AttnUnit { int bh; int qb; };
struct StaticOrder {
  int vcu;
  __device__ __forceinline__ explicit StaticOrder(int grid,int block):vcu((block%8)*(grid/8)+block/8){}
  __device__ __forceinline__ bool next(int i,AttnUnit&u)const{ if(i>=2)return false; const int s=vcu&7; u.bh=vcu>>3; u.qb=(i==0)?15-s:s; return true; }
  __device__ __forceinline__ void a_ready(const AttnUnit&)const{}
  __device__ __forceinline__ void done(const AttnUnit&)const{}
};
template<class Sched,int THRL=8> __device__ __forceinline__ void attn_phase(char*lds,const AttnTensors&T,const Sched&S){
  AttnUnit u;
  for(int i=0;S.next(i,u);++i){ S.a_ready(u); attn_unit<THRL>(u.bh/NHEAD,u.bh%NHEAD,u.qb,T.Q,T.K,T.V,T.O,T.MK,lds); S.done(u); }
}
#undef SBAR
#undef WAIT_BAR
}
namespace mk {
#define GAS __attribute__((address_space(1)))
typedef unsigned short bf16_t;
typedef float f32x4 __attribute__((ext_vector_type(4)));
typedef float f32x2 __attribute__((ext_vector_type(2)));
typedef float f32x16 __attribute__((ext_vector_type(16)));
typedef unsigned u32x4 __attribute__((ext_vector_type(4)));
typedef unsigned u32x2 __attribute__((ext_vector_type(2)));
typedef short bf16x8 __attribute__((ext_vector_type(8)));
constexpr int NB = 4, S = 4096, T = NB * S, D = 1024;
constexpr int NWAVES = 8, NTHR = 512;
constexpr int INW = 4168;
constexpr int NPHYS = 4352;
constexpr float C2 = 0.125f * 1.4426950408889634f;
constexpr float WI_SCALE = 0.04419417382415922f;
constexpr float KR_SCALE = 0.08838834764831845f;
constexpr size_t MiB = 1u << 20;
#ifndef WS_RT_MIB
#define WS_RT_MIB 65
#endif
constexpr size_t WS_CTL = 0, CTL_BYTES = 131072;
constexpr size_t WS_MOD = 1 * MiB;
constexpr size_t WS_THR = 2 * MiB;
constexpr size_t WS_R128 = 3 * MiB;
constexpr size_t WS_R64 = 11 * MiB;
constexpr size_t WS_WOUT = 15 * MiB;
constexpr size_t WS_QA = 17 * MiB, WS_KA = 33 * MiB, WS_VA = 49 * MiB, WS_QI = 65 * MiB, WS_KI = 81 * MiB, WS_WI = 83 * MiB;
constexpr size_t WS_QR = 84 * MiB, WS_KR = 100 * MiB, WS_VR = 116 * MiB, WS_GR = 132 * MiB;
constexpr size_t WS_H = 148 * MiB;
constexpr size_t WS_WIN = 180 * MiB;
constexpr size_t WS_SCORES = 148 * MiB, WS_KVS = 214 * MiB, WS_MASKT = 246 * MiB, WS_RT = WS_RT_MIB * MiB, WS_MIXED = 148 * MiB;
constexpr int CW_BAR = 1024, CW_Q = 14400, CW_TMO = 14600;
constexpr int RING_BYTES = 131072;
constexpr int LDS_BYTES = 163840;
constexpr int MISC_OFF = LDS_BYTES - 1024;

typedef __bf16 bf16x2_t __attribute__((ext_vector_type(2)));
__device__ __forceinline__ unsigned cvt_pk(float lo, float hi) { const f32x2 v = {lo, hi}; const bf16x2_t b = __builtin_convertvector(v, bf16x2_t); return __builtin_bit_cast(unsigned, b); }
__device__ __forceinline__ float bf2f(bf16_t v) { return __uint_as_float((unsigned)v << 16); }
__device__ __forceinline__ float silu_f(float x) { return x / (1.f + __expf(-x)); }
#define MK_DPP_ADD(v, ctrl) v += __uint_as_float((unsigned)__builtin_amdgcn_update_dpp(0, (int)__float_as_uint(v), ctrl, 0xf, 0xf, false))
__device__ __forceinline__ float wave_sum(float v) {
    MK_DPP_ADD(v, 0xB1);
    MK_DPP_ADD(v, 0x4E);
    MK_DPP_ADD(v, 0x141);
    MK_DPP_ADD(v, 0x140);
    { const unsigned u = __float_as_uint(v); auto r = __builtin_amdgcn_permlane16_swap(u, u, false, false); v = __uint_as_float(r[0]) + __uint_as_float(r[1]); }
    { const unsigned u = __float_as_uint(v); auto r = __builtin_amdgcn_permlane32_swap(u, u, false, false); v = __uint_as_float(r[0]) + __uint_as_float(r[1]); }
    return v;
}
__host__ __device__ __forceinline__ int perm_fwd(int o, int half) { const int hi = o >= half ? 1 : 0, oo = o - hi * half; return 8 * (oo >> 2) + 4 * hi + (oo & 3); }
__host__ __device__ __forceinline__ int perm_inv(int p, int half) { const int g = p >> 3, r = p & 7; return (r < 4) ? 4 * g + r : half + 4 * g + (r - 4); }
__device__ __forceinline__ int in_src_col(int n) {
    const int tile = n >> 8;
    if (tile < 2) { const int s = n; return 0 + (s & ~63) + perm_inv(s & 63, 32); }
    if (tile < 4) { const int s = n - 512; return 512 + (s & ~63) + perm_inv(s & 63, 32); }
    if (tile < 6) return n;
    if (tile < 8) { const int s = n - 1536; return 1536 + (s & ~63) + perm_inv(s & 63, 32); }
    if (tile == 8) { const int s = n - 2048; if (s < 64) return 2048 + perm_inv(s, 32); if (s < 72) return 2112 + (s - 64); return -1; }
    const int s = n - 2304;
    if (tile < 11) return 2120 + (s & ~127) + perm_inv(s & 127, 64);
    if (tile < 13) { const int q = s - 512; return 2632 + (q & ~127) + perm_inv(q & 127, 64); }
    if (tile < 15) return 3144 + (s - 1024);
    return 3656 + (s - 1536);
}
__device__ __forceinline__ void p0_item_ada(LAS unsigned char* lds, const float* c, const float* w_ada, const float* b_ada, float* mod, int j, int tid) {
    LAS float* sc = (LAS float*)lds; LAS float* part = (LAS float*)(lds + 16384);
    __syncthreads();
    for (int i = tid; i < 4096; i += NTHR) sc[i] = silu_f(c[i]);
    __syncthreads();
    const int col = tid & 31, kg = tid >> 5;
    float a0 = 0.f, a1 = 0.f, a2 = 0.f, a3 = 0.f;
    const float* w = w_ada + 32 * j + col;
#pragma unroll 1
    for (int k0 = kg; k0 < 1024; k0 += 256) {
        float wv[16];
#pragma unroll
        for (int i = 0; i < 16; ++i) wv[i] = w[(size_t)(k0 + 16 * i) * 6144];
#pragma unroll
        for (int i = 0; i < 16; ++i) { const int k = k0 + 16 * i; a0 += sc[k] * wv[i]; a1 += sc[1024 + k] * wv[i]; a2 += sc[2048 + k] * wv[i]; a3 += sc[3072 + k] * wv[i]; }
    }
    part[(kg * 32 + col) * 4 + 0] = a0; part[(kg * 32 + col) * 4 + 1] = a1; part[(kg * 32 + col) * 4 + 2] = a2; part[(kg * 32 + col) * 4 + 3] = a3;
    __syncthreads();
    if (tid < 128) {
        const int cc = tid >> 2, b = tid & 3; float s = 0.f;
#pragma unroll
        for (int g = 0; g < 16; ++g) s += part[(g * 32 + cc) * 4 + b];
        mod[b * 6144 + 32 * j + cc] = s + b_ada[32 * j + cc];
    }
}
__device__ __forceinline__ void p0_item_rope(const int* pos, float* R128, float* R64, int r, int lane) {
    const float f128 = powf(10000.f, -(float)lane / 64.f), f64 = powf(10000.f, -(float)(lane & 31) / 32.f);
    for (int tt = 0; tt < 16; ++tt) {
        const int t = 16 * r + tt;
        float sn, cs; sincosf((float)pos[t] * f128, &sn, &cs);
        *(f32x2*)(R128 + ((size_t)t * 64 + lane) * 2) = (f32x2){cs, sn};
    }
    for (int tt = 0; tt < 16; tt += 2) {
        const int t = 16 * r + tt + (lane >> 5);
        float sn, cs; sincosf((float)pos[t] * f64, &sn, &cs);
        *(f32x2*)(R64 + ((size_t)t * 32 + (lane & 31)) * 2) = (f32x2){cs, sn};
    }
}
template <int MODE> struct TrItem { const float* sp; int ldw, Kdim, n0, k0; bf16_t* WT; bool valid; };
template <int MODE> __device__ __forceinline__ void p0_tr_setup(TrItem<MODE>& it, const float* W, const float* W2, int ldw, int Kdim, bf16_t* WT, int n0, int k0, int lane) {
    const int nl = lane & 31, n = n0 + nl;
    int src = n; const float* Ws = W;
    if (MODE == 0) src = in_src_col(n);
    if (MODE == 2) { const int g = n >> 3, r = n & 7; src = 4 * g + (r & 3); Ws = (r < 4) ? W : W2; }
    it.sp = Ws + (size_t)(k0 + (lane >> 5)) * ldw + (src >= 0 ? src : 0); it.ldw = ldw; it.Kdim = Kdim; it.n0 = n0; it.k0 = k0; it.WT = WT; it.valid = (src >= 0);
}
template <int MODE> __device__ __forceinline__ void p0_tr_load(const TrItem<MODE>& it, float (&tv)[32]) {
#pragma unroll
    for (int i = 0; i < 32; ++i) tv[i] = it.sp[(size_t)(2 * i) * it.ldw];
}
template <int MODE> __device__ __forceinline__ void p0_tr_emit(const TrItem<MODE>& it, const float (&tv)[32], LAS float* scr, int lane) {
    const int nl = lane & 31;
#pragma unroll
    for (int i = 0; i < 32; ++i) scr[(2 * i + (lane >> 5)) * 33 + nl] = it.valid ? tv[i] : 0.f;
    asm volatile("s_waitcnt lgkmcnt(0)" ::: "memory");
    const int c = lane & 7;
#pragma unroll
    for (int j = 0; j < 4; ++j) {
        const int nn = (lane >> 3) + 8 * j; const LAS float* q = scr + (8 * c) * 33 + nn;
        u32x4 o; o.x = cvt_pk(q[0 * 33], q[1 * 33]); o.y = cvt_pk(q[2 * 33], q[3 * 33]); o.z = cvt_pk(q[4 * 33], q[5 * 33]); o.w = cvt_pk(q[6 * 33], q[7 * 33]);
        *(u32x4*)(it.WT + (size_t)(it.n0 + nn) * it.Kdim + it.k0 + 8 * c) = o;
    }
    asm volatile("s_waitcnt lgkmcnt(0)" ::: "memory");
}
template <int MODE> __device__ __forceinline__ void p0_tr_item(const float* W, const float* W2, int ldw, int Kdim, bf16_t* WT, int n0, int k0, LAS float* scr, int lane) {
    TrItem<MODE> it; p0_tr_setup<MODE>(it, W, W2, ldw, Kdim, WT, n0, k0, lane);
    float tv[32]; p0_tr_load<MODE>(it, tv); p0_tr_emit<MODE>(it, tv, scr, lane);
}
struct P0Args { const float *c, *w_ada, *b_ada, *w_in, *w_out, *w_gate, *w_up, *w_down; const int* pos; float *mod, *R128, *R64; bf16_t *WIN, *WOUT, *WGU, *WD; };
__device__ __forceinline__ void p0_prologue(LAS unsigned char* lds, const P0Args& a, int bid, int G, int tid) {
    const int lane = tid & 63, wave = tid >> 6;
    if (bid < 192) p0_item_ada(lds, a.c, a.w_ada, a.b_ada, a.mod, bid, tid);
    __syncthreads();
    LAS float* scr = (LAS float*)(lds + wave * 8448);
    constexpr int I_ROPE = 1024, I_WIN = 16 * (NPHYS / 32), I_WOUT = 16 * 32;
    for (int it = bid * NWAVES + wave; it < I_ROPE + I_WIN + I_WOUT; it += G * NWAVES) {
        int r = it;
        if (r < I_ROPE) { p0_item_rope(a.pos, a.R128, a.R64, r, lane); continue; } r -= I_ROPE;
        if (r < I_WIN) { const int kb = r / (NPHYS / 32), nb = r - kb * (NPHYS / 32); p0_tr_item<0>(a.w_in, nullptr, INW, 1024, a.WIN, 32 * nb, 64 * kb, scr, lane); continue; } r -= I_WIN;
        { const int kb = r >> 5, nb = r & 31; p0_tr_item<1>(a.w_out, nullptr, 1024, 1024, a.WOUT, 32 * nb, 64 * kb, scr, lane); }
    }
}
__device__ __forceinline__ void p0_expert_items(LAS unsigned char* lds, const P0Args& a, int gw, int ngw, int tid) {
    const int lane = tid & 63, wave = tid >> 6;
    LAS float* scr = (LAS float*)(lds + wave * 8448);
    constexpr int I_WGU = 32 * 256, I_WD = 32 * 128;
    {
        TrItem<2> cur, nxt; float tv[32], tn[32];
        int it = gw;
        if (it < I_WGU) { const int e = it >> 8, q = it & 255, kb = q >> 4, nb = q & 15;
            p0_tr_setup<2>(cur, a.w_gate + (size_t)e * 262144, a.w_up + (size_t)e * 262144, 256, 1024, a.WGU + (size_t)e * 524288, 32 * nb, 64 * kb, lane); p0_tr_load<2>(cur, tv); }
#pragma unroll 1
        for (; it < I_WGU; it += ngw) {
            const int i2 = it + ngw; const bool has = i2 < I_WGU;
            if (has) { const int e = i2 >> 8, q = i2 & 255, kb = q >> 4, nb = q & 15;
                p0_tr_setup<2>(nxt, a.w_gate + (size_t)e * 262144, a.w_up + (size_t)e * 262144, 256, 1024, a.WGU + (size_t)e * 524288, 32 * nb, 64 * kb, lane); p0_tr_load<2>(nxt, tn); }
            p0_tr_emit<2>(cur, tv, scr, lane);
            if (has) { cur = nxt;
#pragma unroll
                for (int i = 0; i < 32; ++i) tv[i] = tn[i]; }
        }
    }
    {
        TrItem<1> cur, nxt; float tv[32], tn[32];
        int it = gw;
        if (it < I_WD) { const int e = it >> 7, q = it & 127, kb = q >> 5, nb = q & 31;
            p0_tr_setup<1>(cur, a.w_down + (size_t)e * 262144, nullptr, 1024, 256, a.WD + (size_t)e * 262144, 32 * nb, 64 * kb, lane); p0_tr_load<1>(cur, tv); }
#pragma unroll 1
        for (; it < I_WD; it += ngw) {
            const int i2 = it + ngw; const bool has = i2 < I_WD;
            if (has) { const int e = i2 >> 7, q = i2 & 127, kb = q >> 5, nb = q & 31;
                p0_tr_setup<1>(nxt, a.w_down + (size_t)e * 262144, nullptr, 1024, 256, a.WD + (size_t)e * 262144, 32 * nb, 64 * kb, lane); p0_tr_load<1>(nxt, tn); }
            p0_tr_emit<1>(cur, tv, scr, lane);
            if (has) { cur = nxt;
#pragma unroll
                for (int i = 0; i < 32; ++i) tv[i] = tn[i]; }
        }
    }
}
__device__ __forceinline__ void p1_row_load(f32x4 (&v)[4], const float* x, int m, int lane) {
    const f32x4* xr = (const f32x4*)(x + (size_t)m * D) + lane;
#pragma unroll
    for (int j = 0; j < 4; ++j) v[j] = xr[64 * j];
}
__device__ __forceinline__ void p1_rows(const float* x, const float* g, const float* mod, bf16_t* H, int gw, int NGW, int lane) {
#pragma unroll 1
    for (int m0 = gw * 8; m0 < T; m0 += NGW * 8) {
        f32x4 v[4][4];
        p1_row_load(v[0], x, m0, lane); p1_row_load(v[1], x, m0 + 1, lane); p1_row_load(v[2], x, m0 + 2, lane);
        const int b = m0 / S;
        const float* sh = mod + b * 6144; const float* sc = sh + 1024;
        f32x4 G[4], SH[4];
#pragma unroll
        for (int j = 0; j < 4; ++j) { const int col = 4 * lane + 256 * j; const f32x4 gg = *(const f32x4*)(g + col), a = *(const f32x4*)(sc + col); SH[j] = *(const f32x4*)(sh + col); G[j] = gg * (a + 1.0f); }
#pragma unroll
        for (int i = 0; i < 8; ++i) {
            if (i + 3 < 8) p1_row_load(v[(i + 3) & 3], x, m0 + i + 3, lane);
            const f32x4 (&c)[4] = v[i & 3];
            float s = 0.f;
#pragma unroll
            for (int j = 0; j < 4; ++j) s += (c[j].x * c[j].x + c[j].y * c[j].y) + (c[j].z * c[j].z + c[j].w * c[j].w);
            const float rs = 1.0f / sqrtf(wave_sum(s) * (1.f / 1024.f) + 1e-6f);
            bf16_t* orow = H + (size_t)(m0 + i) * D;
#pragma unroll
            for (int j = 0; j < 4; ++j) {
                const f32x4 o = c[j] * rs * G[j] + SH[j];
                u32x2 w; w.x = cvt_pk(o.x, o.y); w.y = cvt_pk(o.z, o.w);
                *(u32x2*)(orow + 4 * lane + 256 * j) = w;
            }
        }
    }
}
struct EpiInProj {
    static constexpr bool PERM = true, AFTER_DRAIN = false;
    bf16_t *QA, *KA, *VA, *QI, *KI, *QR, *KR, *VR, *GR; float* WI; const float* R64; const float* R128;
    template <int ROPE, int ACT> __device__ __forceinline__ void emit(const pg8::f32x4 (&acc)[2][2][4][2], bf16_t* dst, int ld, int segbase, float scale, int row0, int wc, int fq, int bjmask) const {
#pragma unroll
        for (int bj = 0; bj < 2; ++bj) {
            if (!((bjmask >> bj) & 1)) continue;
            const int cg = segbase + 128 * bj + 32 * wc + 8 * fq;
            const int fi = (ROPE == 1) ? ((cg & 63) >> 1) : ((cg & 127) >> 1);
#pragma unroll
            for (int ai = 0; ai < 2; ++ai)
#pragma unroll
                for (int m = 0; m < 4; ++m) {
                    const int row = row0 + ai * 128 + m * 16;
                    pg8::f32x4 v0 = acc[ai][bj][m][0], v1 = acc[ai][bj][m][1];
                    if (ROPE != 0) {
                        const float* tp = (ROPE == 1) ? (R64 + ((size_t)row * 32 + fi) * 2) : (R128 + ((size_t)row * 64 + fi) * 2);
                        const pg8::f32x4 t0 = *(const pg8::f32x4*)tp, t1 = *(const pg8::f32x4*)(tp + 4);
                        pg8::f32x4 o1, o2;
                        o1[0] = v0[0] * t0[0] - v1[0] * t0[1]; o2[0] = v1[0] * t0[0] + v0[0] * t0[1];
                        o1[1] = v0[1] * t0[2] - v1[1] * t0[3]; o2[1] = v1[1] * t0[2] + v0[1] * t0[3];
                        o1[2] = v0[2] * t1[0] - v1[2] * t1[1]; o2[2] = v1[2] * t1[0] + v0[2] * t1[1];
                        o1[3] = v0[3] * t1[2] - v1[3] * t1[3]; o2[3] = v1[3] * t1[2] + v0[3] * t1[3];
                        v0 = o1; v1 = o2;
                    }
                    if (ACT == 1) {
#pragma unroll
                        for (int e = 0; e < 4; ++e) { v0[e] = silu_f(v0[e]); v1[e] = silu_f(v1[e]); }
                    }
                    v0 = v0 * scale; v1 = v1 * scale;
                    u32x4 w; w.x = cvt_pk(v0[0], v0[1]); w.y = cvt_pk(v0[2], v0[3]); w.z = cvt_pk(v1[0], v1[1]); w.w = cvt_pk(v1[2], v1[3]);
                    *(u32x4*)(dst + (size_t)row * ld + cg) = w;
                }
        }
    }
    __device__ __forceinline__ void operator()(const pg8::f32x4 (&acc)[2][2][4][2], const pg8::Unit& u, int wr, int wc, int fr, int fq) const {
        const int row0 = u.pm * 256 + wr * 64 + fr;
        const int pn = u.pn;
        if (pn < 2) emit<1, 0>(acc, QA, 512, pn * 256, C2, row0, wc, fq, 3);
        else if (pn < 4) emit<1, 0>(acc, KA, 512, (pn - 2) * 256, 1.f, row0, wc, fq, 3);
        else if (pn < 6) emit<0, 0>(acc, VA, 512, (pn - 4) * 256, 1.f, row0, wc, fq, 3);
        else if (pn < 8) emit<1, 0>(acc, QI, 512, (pn - 6) * 256, 1.f, row0, wc, fq, 3);
        else if (pn == 8) {
            if (wc < 2) emit<1, 0>(acc, KI, 64, 0, 1.f, row0, wc, fq, 1);
            else if (wc == 2 && fq == 0) {
#pragma unroll
                for (int ai = 0; ai < 2; ++ai)
#pragma unroll
                    for (int m = 0; m < 4; ++m) {
                        const int row = row0 + ai * 128 + m * 16;
                        *(pg8::f32x4*)(WI + (size_t)row * 8) = acc[ai][0][m][0] * WI_SCALE;
                        *(pg8::f32x4*)(WI + (size_t)row * 8 + 4) = acc[ai][0][m][1] * WI_SCALE;
                    }
            }
        }
        else if (pn < 11) emit<2, 0>(acc, QR, 512, (pn - 9) * 256, 1.f, row0, wc, fq, 3);
        else if (pn < 13) emit<2, 0>(acc, KR, 512, (pn - 11) * 256, KR_SCALE, row0, wc, fq, 3);
        else if (pn < 15) emit<0, 0>(acc, VR, 512, (pn - 13) * 256, 1.f, row0, wc, fq, 3);
        else emit<0, 1>(acc, GR, 512, (pn - 15) * 256, 1.f, row0, wc, fq, 3);
    }
};
typedef short v4i16_t __attribute__((ext_vector_type(4)));
__device__ __forceinline__ unsigned off_b(unsigned row, unsigned ch) { return 256u * row + 16u * (ch ^ (((row & 3u) << 2) | ((row >> 2) & 3u))); }
__device__ __forceinline__ int crow(int r, int hi) { return (r & 3) + 8 * (r >> 2) + 4 * hi; }
__device__ __forceinline__ v4i16_t tr_rd(LAS unsigned char* p) { return __builtin_amdgcn_ds_read_tr16_b64_v4i16((LAS v4i16_t*)p); }
__device__ __forceinline__ bf16x8 tr_frag_nat(LAS unsigned char* img, int lane, int c, int ks) {
    const unsigned h = lane >> 5, blk = (lane >> 4) & 1, q = (lane & 15) >> 2, p = lane & 3;
    const v4i16_t lo = tr_rd(img + off_b(16 * ks + 8 * h + q, 4 * c + 2 * blk + (p >> 1)) + 8 * (p & 1));
    const v4i16_t hi = tr_rd(img + off_b(16 * ks + 8 * h + 4 + q, 4 * c + 2 * blk + (p >> 1)) + 8 * (p & 1));
    return (bf16x8){lo[0], lo[1], lo[2], lo[3], hi[0], hi[1], hi[2], hi[3]};
}
__device__ __forceinline__ bf16x8 tr_frag_acc(LAS unsigned char* img, int lane, int c, int rowbase) {
    const unsigned h = lane >> 5, blk = (lane >> 4) & 1, q = (lane & 15) >> 2, p = lane & 3;
    const v4i16_t lo = tr_rd(img + off_b(rowbase + 4 * h + q, 4 * c + 2 * blk + (p >> 1)) + 8 * (p & 1));
    const v4i16_t hi = tr_rd(img + off_b(rowbase + 8 + 4 * h + q, 4 * c + 2 * blk + (p >> 1)) + 8 * (p & 1));
    return (bf16x8){lo[0], lo[1], lo[2], lo[3], hi[0], hi[1], hi[2], hi[3]};
}
__device__ __forceinline__ float ret_lgam(int h) { return logf(1.0f - exp2f(-5.0f - (float)h)); }
template <bool SCALE> __device__ __forceinline__ void ret_stage(LAS unsigned char* img, const bf16_t* src  , float sc, int tl) {
#pragma unroll
    for (int it = 0; it < 8; ++it) {
        const int idx = tl + 256 * it, row = idx >> 4, ch = idx & 15;
        u32x4 v = *(const u32x4*)(src + (size_t)row * 512 + ch * 8);
        if (SCALE) {
            const float f = expf(sc * (float)row);
#pragma unroll
            for (int e = 0; e < 4; ++e) { const unsigned w = v[e]; v[e] = cvt_pk(__uint_as_float(w << 16) * f, __uint_as_float(w & 0xffff0000u) * f); }
        }
        *(LAS u32x4*)(img + off_b(row, ch)) = v;
    }
}
__device__ __forceinline__ void ret_kv_pair(LAS unsigned char* lds, const bf16_t* KR, const bf16_t* VR, float* KVS, int pair, int tid) {
    const int uh = tid >> 8, tl = tid & 255, lane = tid & 63, w4 = __builtin_amdgcn_readfirstlane((tid >> 6) & 3), hi = lane >> 5, r32 = lane & 31;
    const int unit = pair * 2 + uh, n = unit & 31, bh = unit >> 5, b = bh >> 2, h = bh & 3;
    const size_t tok0 = (size_t)b * S + (size_t)n * 128;
    LAS unsigned char* kimg = lds + uh * 65536; LAS unsigned char* vimg = kimg + 32768;
    const float lgam = ret_lgam(h);
    __syncthreads();
    ret_stage<false>(kimg, KR + tok0 * 512 + h * 128, 0.f, tl);
    ret_stage<true>(vimg, VR + tok0 * 512 + h * 128, -lgam, tl);
    __syncthreads();
    f32x16 acc[4];
#pragma unroll
    for (int c = 0; c < 4; ++c) acc[c] = (f32x16){};
#pragma unroll
    for (int ks = 0; ks < 8; ++ks) {
        const bf16x8 a = tr_frag_nat(vimg, lane, w4, ks);
#pragma unroll
        for (int nt = 0; nt < 4; ++nt) { const bf16x8 bb = tr_frag_nat(kimg, lane, nt, ks); acc[nt] = __builtin_amdgcn_mfma_f32_32x32x16_bf16(a, bb, acc[nt], 0, 0, 0); }
    }
    const float sc = expf(lgam * 127.f);
    float* o = KVS + (size_t)unit * 16384;
#pragma unroll
    for (int nt = 0; nt < 4; ++nt)
#pragma unroll
        for (int r = 0; r < 16; ++r) o[(32 * w4 + crow(r, hi)) * 128 + 32 * nt + r32] = acc[nt][r] * sc;
}
__device__ __forceinline__ void ret_scan(const float* __restrict__ KVS, bf16_t* __restrict__ RT, int gtid, int nthreads) {
    for (int idx = gtid; idx < 16 * 16384; idx += nthreads) {
        const int bh = idx >> 14, el = idx & 16383, h = bh & 3;
        const float g = 1.0f - exp2f(-5.0f - (float)h), g128 = expf(128.f * ret_lgam(h));
        const size_t o0 = ((size_t)(bh * 32) << 14) + el;
        float kv[31];
#pragma unroll
        for (int n = 0; n < 31; ++n) kv[n] = KVS[o0 + ((size_t)n << 14)];
        float R = 0.f;
#pragma unroll
        for (int n = 0; n < 32; ++n) {
            RT[o0 + ((size_t)n << 14)] = (bf16_t)(cvt_pk(g * R, 0.f) & 0xffffu);
            if (n < 31) R = g128 * R + kv[n];
        }
    }
}
__device__ __forceinline__ void ret_out_pair(LAS unsigned char* lds, const bf16_t* QR, const bf16_t* KR, const bf16_t* VR, const bf16_t* GR, const bf16_t* RT, bf16_t* MIXED, int pair, int tid) {
    const int uh = tid >> 8, tl = tid & 255, lane = tid & 63, w4 = __builtin_amdgcn_readfirstlane((tid >> 6) & 3), hi = lane >> 5, r32 = lane & 31;
    const int unit = pair * 2 + uh, n = unit & 31, bh = unit >> 5, b = bh >> 2, h = bh & 3;
    const size_t tok0 = (size_t)b * S + (size_t)n * 128;
    LAS unsigned char* vimg = lds + uh * 32768;
    const float lgam = ret_lgam(h);
    __syncthreads();
    ret_stage<true>(vimg, VR + tok0 * 512 + h * 128, -lgam, tl);
    __syncthreads();
    bf16x8 qf[8];
    {
        const bf16_t* qp = QR + (tok0 + 32 * w4 + r32) * 512 + h * 128 + 8 * hi;
#pragma unroll
        for (int ks = 0; ks < 8; ++ks) qf[ks] = *(const bf16x8*)(qp + 16 * ks);
    }
    f32x16 acc[4];
#pragma unroll
    for (int c = 0; c < 4; ++c) acc[c] = (f32x16){};
    if (n > 0) {
        const bf16_t* rp = RT + (size_t)unit * 16384 + r32 * 128 + 8 * hi;
#pragma unroll
        for (int c = 0; c < 4; ++c)
#pragma unroll
            for (int ks = 0; ks < 8; ++ks) { const bf16x8 a = *(const bf16x8*)(rp + c * 32 * 128 + 16 * ks); acc[c] = __builtin_amdgcn_mfma_f32_32x32x16_bf16(a, qf[ks], acc[c], 0, 0, 0); }
    }
    for (int jt = 0; jt <= w4; ++jt) {
        const bf16_t* kp = KR + (tok0 + 32 * jt + r32) * 512 + h * 128 + 8 * hi;
        f32x16 st = (f32x16){};
#pragma unroll
        for (int ks = 0; ks < 8; ++ks) { const bf16x8 kf = *(const bf16x8*)(kp + 16 * ks); st = __builtin_amdgcn_mfma_f32_32x32x16_bf16(kf, qf[ks], st, 0, 0, 0); }
        if (jt == w4) {
#pragma unroll
            for (int r = 0; r < 16; ++r) if (crow(r, hi) > r32) st[r] = 0.f;
        }
#pragma unroll
        for (int s = 0; s < 2; ++s) {
            u32x4 pw; pw.x = cvt_pk(st[8 * s + 0], st[8 * s + 1]); pw.y = cvt_pk(st[8 * s + 2], st[8 * s + 3]); pw.z = cvt_pk(st[8 * s + 4], st[8 * s + 5]); pw.w = cvt_pk(st[8 * s + 6], st[8 * s + 7]);
            const bf16x8 pb = __builtin_bit_cast(bf16x8, pw);
#pragma unroll
            for (int c = 0; c < 4; ++c) { const bf16x8 vf = tr_frag_acc(vimg, lane, c, 32 * jt + 16 * s); acc[c] = __builtin_amdgcn_mfma_f32_32x32x16_bf16(vf, pb, acc[c], 0, 0, 0); }
        }
    }
    float ss = 0.f;
#pragma unroll
    for (int c = 0; c < 4; ++c)
#pragma unroll
        for (int r = 0; r < 16; ++r) ss += acc[c][r] * acc[c][r];
    ss += __shfl_xor(ss, 32);
    const float gi = expf(lgam * (float)(32 * w4 + r32));
    const float fac = gi / sqrtf(gi * gi * ss * (1.0f / 128.f) + 1e-6f);
    const size_t tok = tok0 + 32 * w4 + r32;
    const bf16_t* gp = GR + tok * 512 + h * 128 + 4 * hi;
    bf16_t* op = MIXED + tok * 1024 + 512 + h * 128 + 4 * hi;
#pragma unroll
    for (int c = 0; c < 4; ++c)
#pragma unroll
        for (int g4 = 0; g4 < 4; ++g4) {
            const u32x2 gv = *(const u32x2*)(gp + 32 * c + 8 * g4);
            const float g0 = __uint_as_float(gv.x << 16), g1 = __uint_as_float(gv.x & 0xffff0000u), g2 = __uint_as_float(gv.y << 16), g3 = __uint_as_float(gv.y & 0xffff0000u);
            u32x2 w; w.x = cvt_pk(acc[c][4 * g4 + 0] * fac * g0, acc[c][4 * g4 + 1] * fac * g1); w.y = cvt_pk(acc[c][4 * g4 + 2] * fac * g2, acc[c][4 * g4 + 3] * fac * g3);
            *(u32x2*)(op + 32 * c + 8 * g4) = w;
        }
}
constexpr size_t WS_MIX = 17 * MiB;
constexpr size_t WS_H2 = 49 * MiB;
constexpr size_t WS_LIST = 81 * MiB;
constexpr size_t WS_HID = 85 * MiB;
constexpr size_t WS_Y = 105 * MiB;
constexpr size_t WS_HRES = 180 * MiB;
constexpr int CW_CNT = 12288;
constexpr int CW_TILE = 16384;
constexpr int TB_OFF = MISC_OFF + 64;

struct EpiStore {
    static constexpr bool PERM = true, AFTER_DRAIN = false;
    bf16_t* O; int ld;
    __device__ __forceinline__ void operator()(const pg8::f32x4 (&acc)[2][2][4][2], const pg8::Unit& u, int wr, int wc, int fr, int fq) const {
        const int row0 = u.pm * 256 + wr * 64 + fr, col0 = u.pn * 256 + wc * 32 + 8 * fq;
#pragma unroll
        for (int ai = 0; ai < 2; ++ai)
#pragma unroll
            for (int m = 0; m < 4; ++m)
#pragma unroll
                for (int bj = 0; bj < 2; ++bj) {
                    const pg8::f32x4 v0 = acc[ai][bj][m][0], v1 = acc[ai][bj][m][1];
                    u32x4 w; w.x = cvt_pk(v0[0], v0[1]); w.y = cvt_pk(v0[2], v0[3]); w.z = cvt_pk(v1[0], v1[1]); w.w = cvt_pk(v1[2], v1[3]);
                    *(u32x4*)(O + (size_t)(row0 + ai * 128 + m * 16) * ld + col0 + bj * 128) = w;
                }
    }
};
struct P6bArgs { const bf16_t* MIX; const float *x, *g_post, *g_pre2, *mod, *w_group, *b_group, *w_expert, *b_expert; float* HRES; bf16_t* H2; unsigned* cnt; u32x2* LIST; };
constexpr int P6B_NR = 4;
constexpr int RT_WL_OFF = 147456;
struct P6bW { f32x4 v[18]; };
__device__ __forceinline__ void p6b_weights_fetch(P6bW& W, const float* w_group, const float* w_expert, int tid) {
#pragma unroll
    for (int i = 0; i < 18; ++i) {
        const int idx = tid + i * NTHR, d = idx / 9, cc = idx - 9 * d;
        W.v[i] = (cc == 0) ? *(const f32x4*)(w_group + d * 4) : *(const f32x4*)(w_expert + d * 32 + 4 * (cc - 1));
    }
}
__device__ __forceinline__ void p6b_weights_store(const P6bW& W, LAS unsigned char* lds, int tid) {
    __syncthreads();
#pragma unroll
    for (int i = 0; i < 18; ++i) {
        const int idx = tid + i * NTHR, d = idx / 9, cc = idx - 9 * d, pos = ((d >> 2) & 63) + 64 * ((d & 3) + 4 * (d >> 8));
        *(LAS f32x4*)(lds + pos * 144 + 16 * cc) = W.v[i];
    }
    __syncthreads();
}
struct P6bIn { u32x2 mw[P6B_NR][4]; f32x4 xv[P6B_NR][4]; };
__device__ __forceinline__ void p6b_load_mix(P6bIn& I, const bf16_t* MIX, int gw, int lane) {
    const int m0 = gw * P6B_NR;
#pragma unroll
    for (int r = 0; r < P6B_NR; ++r)
#pragma unroll
        for (int j = 0; j < 4; ++j) I.mw[r][j] = *(const u32x2*)(MIX + (size_t)(m0 + r) * 1024 + 4 * lane + 256 * j);
}
__device__ __forceinline__ void p6b_load_x(P6bIn& I, const float* x, int gw, int lane) {
    const int m0 = gw * P6B_NR;
#pragma unroll
    for (int r = 0; r < P6B_NR; ++r)
#pragma unroll
        for (int j = 0; j < 4; ++j) I.xv[r][j] = *(const f32x4*)(x + (size_t)(m0 + r) * 1024 + 4 * lane + 256 * j);
}
__device__ __forceinline__ void p6b_norm(const P6bArgs& a, const P6bIn& I, f32x2 (&hp)[P6B_NR][8], int gw, int lane) {
    const int m0 = gw * P6B_NR, b = m0 / S;
    const float* md = a.mod + b * 6144;
    f32x4 G1[4], G2[4], SH[4];
#pragma unroll
    for (int j = 0; j < 4; ++j) {
        const int col = 4 * lane + 256 * j;
        const f32x4 gp = *(const f32x4*)(a.g_post + col), g1 = *(const f32x4*)(md + 2 * 1024 + col), g2 = *(const f32x4*)(a.g_pre2 + col), sc = *(const f32x4*)(md + 4 * 1024 + col);
        SH[j] = *(const f32x4*)(md + 3 * 1024 + col); G1[j] = g1 * gp; G2[j] = g2 * (sc + 1.0f);
    }
#pragma unroll
    for (int r = 0; r < P6B_NR; ++r) {
        const size_t row = (size_t)(m0 + r);
        float v[16]; float s = 0.f;
#pragma unroll
        for (int j = 0; j < 4; ++j) {
            const u32x2 w = I.mw[r][j];
            v[4 * j + 0] = __uint_as_float(w.x << 16); v[4 * j + 1] = __uint_as_float(w.x & 0xffff0000u); v[4 * j + 2] = __uint_as_float(w.y << 16); v[4 * j + 3] = __uint_as_float(w.y & 0xffff0000u);
#pragma unroll
            for (int k = 0; k < 4; ++k) s += v[4 * j + k] * v[4 * j + k];
        }
        const float rs = 1.0f / sqrtf(wave_sum(s) * (1.f / 1024.f) + 1e-6f);
        float s2 = 0.f;
#pragma unroll
        for (int j = 0; j < 4; ++j) {
            const int col = 4 * lane + 256 * j;
            const f32x4 xx = I.xv[r][j];
            f32x4 hr;
#pragma unroll
            for (int k = 0; k < 4; ++k) { hr[k] = xx[k] + G1[j][k] * (v[4 * j + k] * rs); v[4 * j + k] = hr[k]; s2 += hr[k] * hr[k]; }
        }
        const float rs2 = 1.0f / sqrtf(wave_sum(s2) * (1.f / 1024.f) + 1e-6f);
#pragma unroll
        for (int j = 0; j < 4; ++j) {
            const int col = 4 * lane + 256 * j;
            float h[4];
#pragma unroll
            for (int k = 0; k < 4; ++k) h[k] = (v[4 * j + k] * rs2) * G2[j][k] + SH[j][k];
            u32x2 w; w.x = cvt_pk(h[0], h[1]); w.y = cvt_pk(h[2], h[3]);
            *(u32x2*)(a.H2 + row * 1024 + col) = w;
            hp[r][2 * j + 0] = (f32x2){__uint_as_float(w.x << 16), __uint_as_float(w.x & 0xffff0000u)}; hp[r][2 * j + 1] = (f32x2){__uint_as_float(w.y << 16), __uint_as_float(w.y & 0xffff0000u)};
        }
    }
}
template <int HI> __device__ __forceinline__ void pk_fma_bcast(f32x2& acc, const f32x2 w, const f32x2 h) {
    if (HI) asm("v_pk_fma_f32 %0, %1, %2, %0 op_sel:[0,1,0] op_sel_hi:[1,1,1]" : "+v"(acc) : "v"(w), "v"(h));
    else    asm("v_pk_fma_f32 %0, %1, %2, %0 op_sel:[0,0,0] op_sel_hi:[1,0,1]" : "+v"(acc) : "v"(w), "v"(h));
}
__device__ __forceinline__ void p6b_router(const LAS unsigned char* wtab, LAS float* wl  , const f32x2 (&hp)[P6B_NR][8], int lane) {
#pragma unroll 1
    for (int c = 0; c < 9; ++c) {
        f32x2 acc[P6B_NR][2];
#pragma unroll
        for (int r = 0; r < P6B_NR; ++r) { acc[r][0] = (f32x2){0.f, 0.f}; acc[r][1] = (f32x2){0.f, 0.f}; }
#pragma unroll
        for (int j = 0; j < 4; ++j)
#pragma unroll
            for (int k = 0; k < 4; ++k) {
                const f32x4 w4 = *(const LAS f32x4*)(wtab + (lane + 64 * (k + 4 * j)) * 144 + 16 * c);
                const f32x2 wa = {w4[0], w4[1]}, wb = {w4[2], w4[3]};
#pragma unroll
                for (int r = 0; r < P6B_NR; ++r) {
                    if (k & 1) { pk_fma_bcast<1>(acc[r][0], wa, hp[r][2 * j + (k >> 1)]); pk_fma_bcast<1>(acc[r][1], wb, hp[r][2 * j + (k >> 1)]); }
                    else       { pk_fma_bcast<0>(acc[r][0], wa, hp[r][2 * j + (k >> 1)]); pk_fma_bcast<0>(acc[r][1], wb, hp[r][2 * j + (k >> 1)]); }
                }
            }
        asm volatile("s_nop 1" : "+v"(acc[0][0]), "+v"(acc[0][1]), "+v"(acc[1][0]), "+v"(acc[1][1]), "+v"(acc[2][0]), "+v"(acc[2][1]), "+v"(acc[3][0]), "+v"(acc[3][1]));
        float v[16];
#pragma unroll
        for (int r = 0; r < P6B_NR; ++r) { v[4 * r + 0] = acc[r][0][0]; v[4 * r + 1] = acc[r][0][1]; v[4 * r + 2] = acc[r][1][0]; v[4 * r + 3] = acc[r][1][1]; }
        float s8[8], t4[4];
#pragma unroll
        for (int i = 0; i < 8; ++i) { auto q = __builtin_amdgcn_permlane32_swap(__float_as_uint(v[i]), __float_as_uint(v[i + 8]), false, false); s8[i] = __uint_as_float(q[0]) + __uint_as_float(q[1]); }
#pragma unroll
        for (int i = 0; i < 4; ++i) { auto q = __builtin_amdgcn_permlane16_swap(__float_as_uint(s8[i]), __float_as_uint(s8[i + 4]), false, false); t4[i] = __uint_as_float(q[0]) + __uint_as_float(q[1]); }
#pragma unroll
        for (int i = 0; i < 4; ++i) MK_DPP_ADD(t4[i], 0x128);
        float u0 = (lane & 8) ? t4[1] : t4[0], u1 = (lane & 8) ? t4[3] : t4[2];
        MK_DPP_ADD(u0, 0x141); MK_DPP_ADD(u1, 0x141);
        float w = (lane & 4) ? u1 : u0;
        MK_DPP_ADD(w, 0x1B);
        MK_DPP_ADD(w, 0xB1);
        if ((lane & 3) == 0) wl[(lane >> 4) * 36 + 4 * c + 2 * ((lane >> 2) & 1) + ((lane >> 3) & 1)] = w;
    }
    asm volatile("s_waitcnt lgkmcnt(0)" ::: "memory");
}
__device__ __forceinline__ void p6b_route(const P6bArgs& a, const LAS float* wl, int gw, int lane) {
    const int m0 = gw * P6B_NR;
    if (lane < P6B_NR) {
        const LAS float* lg = wl + lane * 36;
        float gm = lg[0] + a.b_group[0]; int gs = 0; float l1 = lg[1] + a.b_group[1], l2 = lg[2] + a.b_group[2], l3 = lg[3] + a.b_group[3];
        const float l0 = gm;
        if (l1 > gm) { gm = l1; gs = 1; } if (l2 > gm) { gm = l2; gs = 2; } if (l3 > gm) { gm = l3; gs = 3; }
        const float gtop = 1.0f / (expf(l0 - gm) + expf(l1 - gm) + expf(l2 - gm) + expf(l3 - gm));
        float el[8];
#pragma unroll
        for (int i = 0; i < 8; ++i) el[i] = lg[4 + gs * 8 + i] + a.b_expert[gs * 8 + i];
        float b1 = el[0]; int i1 = 0;
#pragma unroll
        for (int i = 1; i < 8; ++i) if (el[i] > b1) { b1 = el[i]; i1 = i; }
        float b2 = -INFINITY; int i2 = 0;
#pragma unroll
        for (int i = 0; i < 8; ++i) if (i != i1 && el[i] > b2) { b2 = el[i]; i2 = i; }
        const float p2 = expf(b2 - b1), den = 1.0f + p2;
        const float w0 = gtop / den, w1 = gtop * p2 / den;
        const int e0 = gs * 8 + i1, e1 = gs * 8 + i2;
        const unsigned tok = (unsigned)(m0 + lane);
        const unsigned pos0 = atomicAdd(a.cnt + 64 * e0, 1u), pos1 = atomicAdd(a.cnt + 64 * e1, 1u);
        a.LIST[(size_t)e0 * 16384 + pos0] = (u32x2){tok, __float_as_uint(w0)};
        a.LIST[(size_t)e1 * 16384 + pos1] = (u32x2){tok | 0x80000000u, __float_as_uint(w1)};
    }
}
__device__ __forceinline__ void p6b_rows(const P6bArgs& a, P6bIn& I, const LAS unsigned char* wtab, LAS float* wl, int gw0, int stride, int lane, bool dry) {
    constexpr int NG = T / P6B_NR;
    if (gw0 >= NG) return;
    f32x2 hp[P6B_NR][8];
#pragma unroll 1
    for (int gw = gw0; gw < NG; gw += stride) {
        p6b_norm(a, I, hp, gw, lane);
        if (gw + stride < NG) { p6b_load_mix(I, a.MIX, gw + stride, lane); p6b_load_x(I, a.x, gw + stride, lane); }
        p6b_router(wtab, wl, hp, lane);
        if (!dry) p6b_route(a, wl, gw, lane);
    }
}
template <int ROLE> struct MoeSched {
    const u32x2* LIST; LAS int* tb; int G, c, NJ;
    unsigned* tilecnt;
    unsigned* tmo;
    int tlo, thi;
    __device__ __forceinline__ bool next(int i, pg8::Unit& u) const {
        if (c < 0) return false;
        const int L = i * G + c, TT = (thi < tb[32]) ? thi : tb[32];
        const int tg = tlo + L / NJ, j = L % NJ;
        if (tg >= TT) return false;
        int e = 0;
#pragma unroll 1
        for (int k = 1; k < 32; ++k) e += (tb[k] <= tg) ? 1 : 0;
        u.pm = tg; u.pn = e * NJ + j; return true;
    }
    __device__ __forceinline__ int arow(const pg8::Unit& u, int r) const {
        const int e = u.pn / NJ, idx = (u.pm - tb[e]) * 256 + r;
        return (idx < tb[33 + e]) ? (int)(LIST[(size_t)e * 16384 + idx].x & 0x7fffffffu) : 0;
    }
    __device__ __forceinline__ void a_ready(const pg8::Unit&) const {}
    __device__ __forceinline__ void done(const pg8::Unit& u) const {
        if (ROLE != 1) return;
        asm volatile("s_waitcnt vmcnt(0)" ::: "memory");
        if (mk_lane() == 0) __hip_atomic_fetch_add(tilecnt + 64 * u.pm, 1u, __ATOMIC_RELAXED, __HIP_MEMORY_SCOPE_AGENT);
    }
};
__device__ __forceinline__ void moe_wait(const MoeSched<2>& S) {
    if (mk_wave() == 0) {
        pg8::Unit u;
        for (int i = 0; S.next(i, u); ++i) {
            unsigned sp = 0;
            while ((unsigned)__builtin_amdgcn_readfirstlane(__hip_atomic_load(S.tilecnt + 64 * u.pm, __ATOMIC_RELAXED, __HIP_MEMORY_SCOPE_AGENT)) < 16u) {
                __builtin_amdgcn_s_sleep(2);
                if (++sp > (1u << 22)) { __hip_atomic_store(S.tmo, 1u, __ATOMIC_RELAXED, __HIP_MEMORY_SCOPE_AGENT); break; }
            }
        }
        __builtin_amdgcn_fence(__ATOMIC_ACQUIRE, "agent");
        asm volatile("s_waitcnt vmcnt(0)" ::: "memory");
    }
    __syncthreads();
}
__device__ __forceinline__ void moe_table(LAS int* tb, const unsigned* cnt, int tid) {
    __syncthreads();
    if (tid < 32) tb[33 + tid] = (int)__hip_atomic_load(cnt + 64 * tid, __ATOMIC_RELAXED, __HIP_MEMORY_SCOPE_AGENT);
    __syncthreads();
    if (tid == 0) { int s = 0; for (int e = 0; e < 32; ++e) { tb[e] = s; s += (tb[33 + e] + 255) >> 8; } tb[32] = s; }
    __syncthreads();
}
struct EpiGU {
    static constexpr bool PERM = true, AFTER_DRAIN = false;
    bf16_t* HID;
    __device__ __forceinline__ void operator()(const pg8::f32x4 (&acc)[2][2][4][2], const pg8::Unit& u, int wr, int wc, int fr, int fq) const {
        const int row0 = u.pm * 256 + wr * 64 + fr, hc0 = (u.pn & 1) * 128 + 16 * wc + 4 * fq;
#pragma unroll
        for (int ai = 0; ai < 2; ++ai)
#pragma unroll
            for (int m = 0; m < 4; ++m)
#pragma unroll
                for (int bj = 0; bj < 2; ++bj) {
                    const pg8::f32x4 g = acc[ai][bj][m][0], up = acc[ai][bj][m][1];
                    u32x2 w; w.x = cvt_pk(silu_f(g[0]) * up[0], silu_f(g[1]) * up[1]); w.y = cvt_pk(silu_f(g[2]) * up[2], silu_f(g[3]) * up[3]);
                    __hip_atomic_store((unsigned long long*)(HID + (size_t)(row0 + ai * 128 + m * 16) * 256 + hc0 + bj * 64), (unsigned long long)w.x | ((unsigned long long)w.y << 32), __ATOMIC_RELAXED, __HIP_MEMORY_SCOPE_AGENT);
                }
    }
};
struct EpiDown {
    static constexpr bool PERM = true, AFTER_DRAIN = false;
    bf16_t* Y; const u32x2* LIST; LAS int* tb;
    __device__ __forceinline__ void operator()(const pg8::f32x4 (&acc)[2][2][4][2], const pg8::Unit& u, int wr, int wc, int fr, int fq) const {
        const int e = u.pn >> 2, j = u.pn & 3, ti = u.pm - tb[e], cn = tb[33 + e];
        const int col0 = 256 * j + 32 * wc + 8 * fq;
        const int idx0 = ti * 256 + wr * 64 + fr;
#pragma unroll
        for (int ai = 0; ai < 2; ++ai) {
            u32x2 ent[4];
#pragma unroll
            for (int m = 0; m < 4; ++m) { const int idx = idx0 + ai * 128 + m * 16; ent[m] = (idx < cn) ? LIST[(size_t)e * 16384 + idx] : (u32x2){0xffffffffu, 0u}; }
#pragma unroll
            for (int m = 0; m < 4; ++m) {
                const u32x2 en = ent[m];
                if (en.x != 0xffffffffu) {
                    const float w = __uint_as_float(en.y);
                    bf16_t* dst = Y + ((size_t)(en.x >> 31) * T + (en.x & 0x7fffffffu)) * 1024 + col0;
#pragma unroll
                    for (int bj = 0; bj < 2; ++bj) {
                        const pg8::f32x4 v0 = acc[ai][bj][m][0] * w, v1 = acc[ai][bj][m][1] * w;
                        u32x4 o; o.x = cvt_pk(v0[0], v0[1]); o.y = cvt_pk(v0[2], v0[3]); o.z = cvt_pk(v1[0], v1[1]); o.w = cvt_pk(v1[2], v1[3]);
                        *(u32x4*)(dst + bj * 128) = o;
                    }
                }
            }
            asm volatile("" ::: "memory");
        }
    }
};
struct P8Row { u32x2 w0[4], w1[4], wm[4]; f32x4 xx[4]; };
__device__ __forceinline__ void p8_row_load(P8Row& R, const bf16_t* Y, const bf16_t* MIX, const float* x, int m, int lane) {
#pragma unroll
    for (int j = 0; j < 4; ++j) {
        R.w0[j] = *(const u32x2*)(Y + (size_t)m * 1024 + 4 * lane + 256 * j); R.w1[j] = *(const u32x2*)(Y + ((size_t)T + m) * 1024 + 4 * lane + 256 * j);
        R.wm[j] = *(const u32x2*)(MIX + (size_t)m * 1024 + 4 * lane + 256 * j);
    }
#pragma unroll
    for (int j = 0; j < 4; ++j) R.xx[j] = *(const f32x4*)(x + (size_t)m * 1024 + 4 * lane + 256 * j);
}
__device__ __forceinline__ void p8_rows(const bf16_t* Y, const bf16_t* MIX, const float* x, const float* g_post_mix, const float* g_post, const float* mod, float* out, int gw, int NGW, int lane) {
#pragma unroll 1
    for (int m0 = gw * 8; m0 < T; m0 += NGW * 8) {
        P8Row C, Rn;
        p8_row_load(C, Y, MIX, x, m0, lane);
        const float* md = mod + (m0 / S) * 6144;
        f32x4 GA[4], GB[4];
#pragma unroll
        for (int j = 0; j < 4; ++j) {
            const int col = 4 * lane + 256 * j;
            const f32x4 gpm = *(const f32x4*)(g_post_mix + col), g1 = *(const f32x4*)(md + 2 * 1024 + col), gp = *(const f32x4*)(g_post + col), gg = *(const f32x4*)(md + 5 * 1024 + col);
            GA[j] = g1 * gpm; GB[j] = gg * gp;
        }
#pragma unroll 1
        for (int i = 0; i < 8; ++i) {
            if (i + 1 < 8) p8_row_load(Rn, Y, MIX, x, m0 + i + 1, lane);
            const int m = m0 + i;
            float v[16], mx[16]; float s = 0.f, sm = 0.f;
#pragma unroll
            for (int j = 0; j < 4; ++j) {
                const u32x2 w0 = C.w0[j], w1 = C.w1[j], wm = C.wm[j];
                v[4 * j + 0] = __uint_as_float(w0.x << 16) + __uint_as_float(w1.x << 16); v[4 * j + 1] = __uint_as_float(w0.x & 0xffff0000u) + __uint_as_float(w1.x & 0xffff0000u);
                v[4 * j + 2] = __uint_as_float(w0.y << 16) + __uint_as_float(w1.y << 16); v[4 * j + 3] = __uint_as_float(w0.y & 0xffff0000u) + __uint_as_float(w1.y & 0xffff0000u);
                mx[4 * j + 0] = __uint_as_float(wm.x << 16); mx[4 * j + 1] = __uint_as_float(wm.x & 0xffff0000u); mx[4 * j + 2] = __uint_as_float(wm.y << 16); mx[4 * j + 3] = __uint_as_float(wm.y & 0xffff0000u);
#pragma unroll
                for (int k = 0; k < 4; ++k) { s += v[4 * j + k] * v[4 * j + k]; sm += mx[4 * j + k] * mx[4 * j + k]; }
            }
            const float rs = 1.0f / sqrtf(wave_sum(s) * (1.f / 1024.f) + 1e-6f), rsm = 1.0f / sqrtf(wave_sum(sm) * (1.f / 1024.f) + 1e-6f);
#pragma unroll
            for (int j = 0; j < 4; ++j) {
                const f32x4 xx = C.xx[j];
                f32x4 o;
#pragma unroll
                for (int k = 0; k < 4; ++k) { const float hr = xx[k] + GA[j][k] * (mx[4 * j + k] * rsm); o[k] = hr + GB[j][k] * (v[4 * j + k] * rs); }
                *(f32x4*)(out + (size_t)m * 1024 + 4 * lane + 256 * j) = o;
            }
            if (i + 1 < 8) C = Rn;
        }
    }
}
constexpr size_t SC_BSTRIDE = (size_t)4096 * 64 * 65 / 2;
constexpr int SC_CHUNK = 8;
constexpr int SC_NUNITS = 4 * (1 * 8 + 2 * 8 + 3 * 8 + 4 * 8 + 5 * 8 + 6 * 8 + 7 * 8 + 8 * 8);
__device__ __forceinline__ size_t sc_off(int b, int qb) { return (size_t)b * SC_BSTRIDE + (size_t)4096 * (qb * (qb + 1) / 2); }
__device__ __forceinline__ void sc_build_units(unsigned* tab) {
    int n = 0;
    for (int pass = 0; pass < 2; ++pass)
        for (int sz = SC_CHUNK; sz >= 1; --sz)
            for (int b = 0; b < 4; ++b)
                for (int qb = 0; qb < 64; ++qb) {
                    const int nt = qb + 1, nc = (nt + SC_CHUNK - 1) / SC_CHUNK;
                    for (int c = 0; c < nc; ++c) {
                        const int t0 = c * SC_CHUNK, cnt = (nt - t0 < SC_CHUNK) ? nt - t0 : SC_CHUNK;
                        const bool full = (cnt == SC_CHUNK);
                        if ((pass == 0 && full && sz == SC_CHUNK) || (pass == 1 && !full && cnt == sz)) tab[n++] = (unsigned)b | ((unsigned)qb << 2) | ((unsigned)c << 8) | ((unsigned)cnt << 12);
                    }
                }
}
__device__ __forceinline__ unsigned key16_of(float sc) { sc += 0.0f; const unsigned u = __float_as_uint(sc); return ((u & 0x80000000u) ? ~u : (u | 0x80000000u)) >> 16; }
__device__ __forceinline__ void sc_decode(unsigned u, int& b, int& qb, int& c, int& nt) {
    b = u & 3; const int v = u >> 2;
    if (v < 232) { c = 0; int base = 0; while (v >= base + (57 - 8 * c)) { base += 57 - 8 * c; ++c; } qb = 8 * c + 7 + (v - base); nt = 8; }
    else { const int p = v - 232, size = 7 - (p >> 3); c = p & 7; qb = 8 * c + size - 1; nt = size; }
}
struct ScStage { u32x4 v[8]; };
__device__ __forceinline__ void sc_stage_load(ScStage& st, const bf16_t* KI, int b, int c, int nt, int tid) {
    const bf16_t* kbase = KI + ((size_t)b * S + (size_t)c * SC_CHUNK * 64 + (tid >> 3)) * 64 + (tid & 7) * 8;
#pragma unroll
    for (int t = 0; t < 8; ++t) if (t < nt) st.v[t] = *(const u32x4*)(kbase + (size_t)t * 64 * 64);
}
__device__ __forceinline__ void sc_stage_store(const ScStage& st, LAS unsigned char* buf, int nt, int tid) {
    const int skey = tid >> 3, sch = tid & 7;
    const unsigned st_off = (unsigned)(skey * 128 + ((sch ^ (skey & 7)) * 16));
#pragma unroll
    for (int t = 0; t < 8; ++t) if (t < nt) *(LAS u32x4*)(buf + t * 8192 + st_off) = st.v[t];
}
struct ScQ { bf16x8 af[2][4]; float wv[2][2][8]; };
__device__ __forceinline__ void sc_load_q(ScQ& q, const bf16_t* QI, const float* WI, int b, int qb, int tid) {
    const int lane = tid & 63, w = __builtin_amdgcn_readfirstlane(tid >> 6), hh = lane >> 5, n32 = lane & 31;
    const size_t tokq0 = (size_t)b * S + 64 * qb + 8 * w;
    bf16x8 (&af)[2][4] = q.af; float (&wv)[2][2][8] = q.wv;
    {
        const int u = 2 * ((n32 >> 2) & 1) + (n32 >> 4), h = (n32 & 3) + 4 * ((n32 >> 3) & 1);
#pragma unroll
        for (int mt = 0; mt < 2; ++mt) {
            const bf16_t* qp = QI + (tokq0 + 4 * mt + u) * 512 + h * 64 + 8 * hh;
#pragma unroll
            for (int ks = 0; ks < 4; ++ks) af[mt][ks] = *(const bf16x8*)(qp + 16 * ks);
#pragma unroll
            for (int j = 0; j < 2; ++j) {
                const float* wp = WI + (tokq0 + 4 * mt + 2 * hh + j) * 8;
                const f32x4 w0 = *(const f32x4*)wp, w1 = *(const f32x4*)(wp + 4);
                wv[mt][j][0] = w0[0]; wv[mt][j][1] = w0[1]; wv[mt][j][2] = w0[2]; wv[mt][j][3] = w0[3]; wv[mt][j][4] = w1[0]; wv[mt][j][5] = w1[1]; wv[mt][j][6] = w1[2]; wv[mt][j][7] = w1[3];
            }
        }
    }
}
__device__ __forceinline__ void sc_compute(const LAS unsigned char* buf, const ScQ& q, unsigned short* SC, int b, int qb, int c, int ntile, int tid) {
    const int lane = tid & 63, w = __builtin_amdgcn_readfirstlane(tid >> 6), hh = lane >> 5, n32 = lane & 31;
    const int L = 64 * (qb + 1);
    const bf16x8 (&af)[2][4] = q.af; const float (&wv)[2][2][8] = q.wv;
    unsigned short* srow = SC + sc_off(b, qb) + (size_t)(8 * w) * L;
#pragma unroll 1
    for (int t = 0; t < ntile; ++t) {
        const LAS unsigned char* tb_ = buf + t * 8192;
        const int s0 = (c * SC_CHUNK + t) * 64;
#pragma unroll
        for (int nt = 0; nt < 2; ++nt) {
            bf16x8 bfr[4];
            const int key = 32 * nt + n32;
#pragma unroll
            for (int ks = 0; ks < 4; ++ks) bfr[ks] = *(const LAS bf16x8*)(tb_ + key * 128 + (((2 * ks + hh) ^ (key & 7)) * 16));
#pragma unroll
            for (int mt = 0; mt < 2; ++mt) {
                f32x16 acc = (f32x16){};
#pragma unroll
                for (int ks = 0; ks < 4; ++ks) acc = __builtin_amdgcn_mfma_f32_32x32x16_bf16(af[mt][ks], bfr[ks], acc, 0, 0, 0);
#pragma unroll
                for (int j = 0; j < 2; ++j) {
                    float sc = 0.f;
#pragma unroll
                    for (int h = 0; h < 8; ++h) { const int xi = (int)__float_as_uint(acc[8 * j + h]); sc = __builtin_fmaf(wv[mt][j][h], __uint_as_float((unsigned)(xi > 0 ? xi : 0)), sc); }
                    asm volatile("" : "+v"(sc));
                    srow[(size_t)(4 * mt + 2 * hh + j) * L + s0 + key] = (unsigned short)key16_of(sc);
                }
            }
        }
    }
}
__device__ __forceinline__ void sc_phase(LAS unsigned char* lds, volatile LAS unsigned* qslot, unsigned* qhead, const bf16_t* QI, const bf16_t* KI, const float* WI, unsigned short* SC, int tid) {
    __syncthreads();
    if (tid == 0) { const unsigned t = atomicAdd(qhead, 2u); qslot[0] = t; qslot[1] = t + 1u; }
    __syncthreads();
    unsigned ucur = qslot[0], unext = qslot[1];
    if (ucur >= (unsigned)SC_NUNITS) return;
    int b, qb, c, nt; sc_decode(ucur, b, qb, c, nt);
    ScStage st;
    sc_stage_load(st, KI, b, c, nt, tid);
    sc_stage_store(st, lds, nt, tid);
    int p = 0, it = 0;
    __syncthreads();
    for (;;) {
        ScQ q;
        sc_load_q(q, QI, WI, b, qb, tid);
        const bool has = unext < (unsigned)SC_NUNITS;
        int b2 = 0, qb2 = 0, c2 = 0, nt2 = 0;
        if (has) { sc_decode(unext, b2, qb2, c2, nt2); sc_stage_load(st, KI, b2, c2, nt2, tid); }
        unsigned tnn = 0u;
        if (tid == 0 && has) tnn = atomicAdd(qhead, 1u);
        sc_compute(lds + p * 65536, q, SC, b, qb, c, nt, tid);
        if (!has) break;
        if (tid == 0) qslot[it & 1] = tnn;
        sc_stage_store(st, lds + (p ^ 1) * 65536, nt2, tid);
        __syncthreads();
        b = b2; qb = qb2; c = c2; nt = nt2; p ^= 1;
        unext = qslot[it & 1]; ++it;
    }
}
__device__ __forceinline__ unsigned wave_sum_u32(unsigned x) {
    x += (unsigned)__builtin_amdgcn_update_dpp(0, (int)x, 0xB1, 0xf, 0xf, false);
    x += (unsigned)__builtin_amdgcn_update_dpp(0, (int)x, 0x4E, 0xf, 0xf, false);
    x += (unsigned)__builtin_amdgcn_update_dpp(0, (int)x, 0x141, 0xf, 0xf, false);
    x += (unsigned)__builtin_amdgcn_update_dpp(0, (int)x, 0x140, 0xf, 0xf, false);
    return (unsigned)__builtin_amdgcn_readlane((int)x, 0) + (unsigned)__builtin_amdgcn_readlane((int)x, 16) + (unsigned)__builtin_amdgcn_readlane((int)x, 32) + (unsigned)__builtin_amdgcn_readlane((int)x, 48);
}
__device__ __forceinline__ unsigned pk_subsat(unsigned w, unsigned c) { unsigned d; asm("v_pk_sub_u16 %0, %1, %2 clamp" : "=v"(d) : "v"(w), "v"(c)); return d; }
__device__ __forceinline__ unsigned pk_min(unsigned a, unsigned b) { unsigned d; asm("v_pk_min_u16 %0, %1, %2" : "=v"(d) : "v"(a), "v"(b)); return d; }
__device__ __forceinline__ unsigned pk_add(unsigned a, unsigned b) { unsigned d; asm("v_pk_add_u16 %0, %1, %2" : "=v"(d) : "v"(a), "v"(b)); return d; }
template <int NW> __device__ __forceinline__ unsigned cnt_ge(const unsigned (&kw)[32], unsigned cm1) {
    const unsigned one = 0x00010001u;
    unsigned a0 = 0u, a1 = 0u, a2 = 0u, a3 = 0u;
#pragma unroll
    for (int j = 0; j < NW; j += 4) {
        a0 = pk_add(a0, pk_min(pk_subsat(kw[j], cm1), one)); a1 = pk_add(a1, pk_min(pk_subsat(kw[j + 1], cm1), one));
        a2 = pk_add(a2, pk_min(pk_subsat(kw[j + 2], cm1), one)); a3 = pk_add(a3, pk_min(pk_subsat(kw[j + 3], cm1), one));
    }
    const unsigned a = pk_add(pk_add(a0, a1), pk_add(a2, a3));
    return wave_sum_u32((a & 0xffffu) + (a >> 16));
}
__device__ __forceinline__ unsigned pk_max(unsigned a, unsigned b) { unsigned d; asm("v_pk_max_u16 %0, %1, %2" : "=v"(d) : "v"(a), "v"(b)); return d; }
__device__ __forceinline__ unsigned wave_max_u32(unsigned x) {
    x = max(x, (unsigned)__builtin_amdgcn_update_dpp(0, (int)x, 0xB1, 0xf, 0xf, false));
    x = max(x, (unsigned)__builtin_amdgcn_update_dpp(0, (int)x, 0x4E, 0xf, 0xf, false));
    x = max(x, (unsigned)__builtin_amdgcn_update_dpp(0, (int)x, 0x141, 0xf, 0xf, false));
    x = max(x, (unsigned)__builtin_amdgcn_update_dpp(0, (int)x, 0x140, 0xf, 0xf, false));
    return max(max((unsigned)__builtin_amdgcn_readlane((int)x, 0), (unsigned)__builtin_amdgcn_readlane((int)x, 16)), max((unsigned)__builtin_amdgcn_readlane((int)x, 32), (unsigned)__builtin_amdgcn_readlane((int)x, 48)));
}
template <int NW> __device__ __forceinline__ unsigned sel_query(const unsigned (&kw)[32], int lane) {
    unsigned mx = 0u;
#pragma unroll
    for (int j = 0; j < NW; ++j) mx = pk_max(mx, kw[j]);
    unsigned hi = wave_max_u32(max(mx & 0xffffu, mx >> 16)) + 1u;
    unsigned width = 384u, lo = (hi > width) ? hi - width : 1u;
#pragma unroll 1
    while (cnt_ge<NW>(kw, (lo - 1u) * 0x00010001u) < 256u) { hi = lo; width *= 8u; lo = (hi > width) ? hi - width : 1u; }
#pragma unroll 1
    while (hi - lo > 1u) {
        const unsigned mid = (lo + hi) >> 1;
        if (cnt_ge<NW>(kw, (mid - 1u) * 0x00010001u) >= 256u) lo = mid; else hi = mid;
    }
    const unsigned T = lo;
    const unsigned need = 256u - cnt_ge<NW>(kw, T * 0x00010001u);
    unsigned run = 0u, cidx = 0xffffu; bool found = false;
#pragma unroll
    for (int j = 0; j < NW; ++j) {
        if (!found) {
            const bool e0 = (kw[j] & 0xffffu) == T, e1 = (kw[j] >> 16) == T;
            const unsigned long long m0 = __ballot(e0), m1 = __ballot(e1);
            const unsigned cm = (unsigned)__builtin_popcountll(m0) + (unsigned)__builtin_popcountll(m1);
            if (run + cm >= need) {
                const unsigned rank = __builtin_amdgcn_mbcnt_hi((unsigned)(m0 >> 32), __builtin_amdgcn_mbcnt_lo((unsigned)m0, 0u)) + __builtin_amdgcn_mbcnt_hi((unsigned)(m1 >> 32), __builtin_amdgcn_mbcnt_lo((unsigned)m1, 0u));
                const unsigned tg = need - run - 1u;
                const unsigned long long h0 = __ballot(e0 && rank == tg), h1 = __ballot(e1 && rank + (e0 ? 1u : 0u) == tg);
                cidx = (unsigned)(128 * j) + (h0 ? 2u * (unsigned)__builtin_ctzll(h0) : 2u * (unsigned)__builtin_ctzll(h1) + 1u);
                found = true;
            }
            run += cm;
        }
    }
    return T | (cidx << 16);
}
__host__ __device__ constexpr int msk_pos(int r) { return (r & ~3) | ((r & 1) << 1) | ((r >> 1) & 1); }
template <int NW> __device__ __forceinline__ void sel_emit(const unsigned (&kw)[32], unsigned th, unsigned* MROW, int b, int tq, int lane) {
    const unsigned thresh = ((th & 0xffffu) << 16) | (0xFFFFu - (th >> 16));
    const unsigned ib = 0xFFFFu - 2u * (unsigned)lane;
    unsigned W0 = 0u, W1 = 0u;
#pragma unroll
    for (int j = 0; j < NW; ++j) {
        const unsigned il = ib - 128u * j;
        const unsigned c_lo = (kw[j] << 16) | il, c_hi = (kw[j] & 0xFFFF0000u) | (il - 1u);
        const unsigned long long m_lo = __ballot(c_lo >= thresh), m_hi = __ballot(c_hi >= thresh);
        const unsigned long long w0 = (m_lo & 0x3333333333333333ull) | ((m_hi & 0x3333333333333333ull) << 2);
        const unsigned long long w1 = ((m_lo & 0xCCCCCCCCCCCCCCCCull) >> 2) | (m_hi & 0xCCCCCCCCCCCCCCCCull);
        asm("v_writelane_b32 %0, %1, %2" : "+v"(W0) : "s"((unsigned)w0), "n"(2 * j));
        asm("v_writelane_b32 %0, %1, %2" : "+v"(W0) : "s"((unsigned)(w0 >> 32)), "n"(2 * j + 1));
        asm("v_writelane_b32 %0, %1, %2" : "+v"(W1) : "s"((unsigned)w1), "n"(2 * j));
        asm("v_writelane_b32 %0, %1, %2" : "+v"(W1) : "s"((unsigned)(w1 >> 32)), "n"(2 * j + 1));
    }
    *(u32x2*)(MROW + (((size_t)b * S + tq) * 64 + lane) * 2) = (u32x2){W0, W1};
}
template <int NW> __device__ __forceinline__ void sel_row(const unsigned* row32, int n, unsigned* MROW, int b, int tq, int lane) {
    unsigned kw[32];
#pragma unroll
    for (int j = 0; j < 32; ++j) {
        unsigned v = 0u;
        if (j < NW) { const int s = 128 * j + 2 * lane; v = (s < n) ? row32[64 * j + lane] : 0u; if (s + 1 >= n) v &= 0xffffu; }
        kw[j] = v;
    }
    const unsigned th = sel_query<NW>(kw, lane);
    sel_emit<NW>(kw, th, MROW, b, tq, lane);
}
__device__ __forceinline__ void sel_row_all(int n, unsigned* MROW, int b, int tq, int lane) {
    unsigned kw[32];
#pragma unroll
    for (int j = 0; j < 32; ++j) { const int s = 128 * j + 2 * lane; kw[j] = (j < 8) ? ((s < n ? 1u : 0u) | (s + 1 < n ? 0x10000u : 0u)) : 0u; }
    sel_emit<8>(kw, 0u, MROW, b, tq, lane);
}
__device__ __forceinline__ void sel_queries_balanced(const unsigned short* SC, unsigned* MROW, int gw, int lane) {
#pragma unroll 1
    for (int k = 0; k < 8; ++k) {
        const int b = k >> 1, tq = (k & 1) ? (S - 1 - gw) : gw, n = tq + 1, qb = tq >> 6, L = 64 * (qb + 1);
        const unsigned* row32 = (const unsigned*)(SC + sc_off(b, qb) + (size_t)(tq & 63) * L);
        const int nw = (n + 127) >> 7;
        if (n <= 256) sel_row_all(n, MROW, b, tq, lane);
        else if (nw <= 8) sel_row<8>(row32, n, MROW, b, tq, lane); else if (nw <= 16) sel_row<16>(row32, n, MROW, b, tq, lane); else if (nw <= 24) sel_row<24>(row32, n, MROW, b, tq, lane); else sel_row<32>(row32, n, MROW, b, tq, lane);
    }
}
struct Args { const void* in[18]; float* out; unsigned char* ws; int ph_lo, ph_hi, li, pad; };
constexpr int N_PHASES = 12;
__global__ void __launch_bounds__(NTHR, 2) mega(Args args) {
    extern __shared__ __attribute__((aligned(16))) unsigned char lds_raw[];
    LAS unsigned char* lds = (LAS unsigned char*)lds_raw;
    const int G = gridDim.x, bid = blockIdx.x;
#define MK_IDS() const int wave = mk_wave(), lane = mk_lane(), tid = wave * 64 + lane; (void)lane; (void)tid; (void)wave
    unsigned char* ws = args.ws;
    unsigned* ctl = (unsigned*)(ws + WS_CTL);
    volatile LAS unsigned* MISC = (volatile LAS unsigned*)(lds + MISC_OFF);
    { const int t0 = (int)threadIdx.x;
      for (int u = t0; u < (LDS_BYTES - RING_BYTES) / 4; u += NTHR) ((LAS unsigned*)(lds + RING_BYTES))[u] = 0u;
      __syncthreads();
      if ((t0 & 63) == 0) ((LAS unsigned char*)(lds + MK_SLOTMAP_OFF))[mk_hwslot()] = (unsigned char)(t0 >> 6); }
    __syncthreads();
    XcdBarrier bar = xcd_barrier_post(ctl + CW_BAR + args.li * XCD_BAR_WORDS, MISC + 8);
    const int lo = args.ph_lo, hi = args.ph_hi;
#ifndef DUP_MASK
#define DUP_MASK 0
#endif
#define REP(k) for (int rep_ = 0; rep_ < (((DUP_MASK) >> (k)) & 1) + 1; ++rep_)
#define IN(k) (lo <= (k) && (k) < hi)
#define BOTH(k) (IN(k) && IN((k) + 1))
    const float* x = (const float*)args.in[0];
    float* mod = (float*)(ws + WS_MOD);
    bf16_t* Hb = (bf16_t*)(ws + WS_H);
    bf16_t* WIN = (bf16_t*)(ws + WS_WIN);
    bf16_t* WOUT = (bf16_t*)(ws + WS_WOUT);
    float* R128 = (float*)(ws + WS_R128);
    float* R64 = (float*)(ws + WS_R64);
    bf16_t* WGU = (bf16_t*)args.out; bf16_t* WD = WGU + (size_t)32 * 512 * 1024;

    const P0Args p0a{(const float*)args.in[1], (const float*)args.in[4], (const float*)args.in[5], (const float*)args.in[6], (const float*)args.in[7], (const float*)args.in[14], (const float*)args.in[15], (const float*)args.in[16],
                 (const int*)args.in[2], mod, R128, R64, WIN, WOUT, WGU, WD};
    if (IN(0)) {
        MK_IDS();
        REP(0) p0_prologue(lds, p0a, bid, G, tid);
        if (BOTH(0)) xcd_barrier(bar);
    }
    if (IN(1)) {
        MK_IDS();
        REP(1) p1_rows(x, (const float*)args.in[3], mod, Hb, bid * NWAVES + wave, G * NWAVES, lane);
        if ((DUP_MASK >> 15) & 1) { for (int k = 0; k < 10; ++k) xcd_barrier(bar); }
        if (BOTH(1)) xcd_barrier(bar);
    }
    if (IN(2)) {
        MK_IDS();
#ifdef PROBE_SKIP_TILE8
        struct Skip8 : pg8::StaticOrder { __device__ bool next(int i, pg8::Unit& u) const { if (!pg8::StaticOrder::next(i, u)) return false; if (u.pn >= 8) ++u.pn; return true; } };
        pg8::Gemm g{Hb, WIN, T, NPHYS, 1024}; Skip8 So; So.init(T, NPHYS - 256, G, bid);
#define PG8_P2_SCHED Skip8
#else
        pg8::Gemm g{Hb, WIN, T, NPHYS, 1024}; pg8::StaticOrder So; So.init(T, NPHYS, G, bid);
#define PG8_P2_SCHED pg8::StaticOrder
#endif
        EpiInProj E{(bf16_t*)(ws + WS_QA), (bf16_t*)(ws + WS_KA), (bf16_t*)(ws + WS_VA), (bf16_t*)(ws + WS_QI), (bf16_t*)(ws + WS_KI), (bf16_t*)(ws + WS_QR), (bf16_t*)(ws + WS_KR),
                    (bf16_t*)(ws + WS_VR), (bf16_t*)(ws + WS_GR), (float*)(ws + WS_WI), R64, R128};
        pg8::gemm_phase<EpiInProj, PG8_P2_SCHED, true, true>(lds, g, So, E);
        if ((DUP_MASK >> 2) & 1) { __syncthreads(); pg8::gemm_phase<EpiInProj, PG8_P2_SCHED, true, true>(lds, g, So, E); }
        if (args.li != 0) {   }
        else if (G == 256) { if (bid >= 64) { __syncthreads(); p0_expert_items(lds, p0a, (bid - 64) * NWAVES + wave, 192 * NWAVES, tid); } }
        else { __syncthreads(); p0_expert_items(lds, p0a, bid * NWAVES + wave, G * NWAVES, tid); }
        if (BOTH(2)) xcd_barrier(bar);
    }
    bf16_t* QR = (bf16_t*)(ws + WS_QR); bf16_t* KR = (bf16_t*)(ws + WS_KR); bf16_t* VR = (bf16_t*)(ws + WS_VR); bf16_t* GR = (bf16_t*)(ws + WS_GR);
    const bf16_t* QI = (const bf16_t*)(ws + WS_QI); const bf16_t* KI = (const bf16_t*)(ws + WS_KI); const float* WI = (const float*)(ws + WS_WI);
    unsigned short* SCORES = (unsigned short*)(ws + WS_SCORES); unsigned* THR = (unsigned*)(ws + WS_THR); unsigned* MASKT = (unsigned*)(ws + WS_MASKT);
    float* KVS = (float*)(ws + WS_KVS); bf16_t* RT = WD + (size_t)32 * 1024 * 256;
    bf16_t* MIXED = (bf16_t*)(ws + WS_MIXED);
    if (IN(3)) {
        MK_IDS();
        REP(3) {
        for (int p = bid; p < 256; p += G) ret_kv_pair(lds, KR, VR, KVS, p, tid);
        sc_phase(lds, MISC + 16, ctl + CW_Q + 64 * rep_, QI, KI, WI, SCORES, tid);
        }
        if (BOTH(3)) xcd_barrier(bar);
    }
    if (IN(4)) {
        MK_IDS();
        ret_scan(KVS, RT, bid * NTHR + tid, G * NTHR);
        for (int gw = bid * NWAVES + wave; gw < 2048; gw += G * NWAVES) sel_queries_balanced(SCORES, MASKT, gw, lane);
        if ((DUP_MASK >> 12) & 1) for (int gw = bid * NWAVES + wave; gw < 2048; gw += G * NWAVES) sel_queries_balanced(SCORES, MASKT, gw, lane);
        if (IN(4) && IN(6)) xcd_barrier(bar);
    }
    if (IN(6)) {
        MK_IDS();
        {
        for (int p = bid; p < 256; p += G) ret_out_pair(lds, QR, KR, VR, GR, RT, MIXED, p, tid);
        if ((DUP_MASK >> 14) & 1) for (int p = bid; p < 256; p += G) ret_out_pair(lds, QR, KR, VR, GR, RT, MIXED, p, tid);
        asm volatile("s_waitcnt vmcnt(0) lgkmcnt(0)" ::: "memory");
        __syncthreads();
        {
            const attn_body::AttnTensors AT{(const attn_body::bf16*)(ws + WS_QA), (const attn_body::bf16*)(ws + WS_KA), (const attn_body::bf16*)(ws + WS_VA), (attn_body::bf16*)MIXED, (const unsigned*)MASKT};
            const attn_body::StaticOrder So((int)G, (int)bid);
            attn_body::attn_phase<attn_body::StaticOrder>((char*)lds_raw, AT, So);
        }
        __syncthreads();
        }
        if ((DUP_MASK >> 5) & 1) {
        for (int p = bid; p < 256; p += G) ret_out_pair(lds, QR, KR, VR, GR, RT, MIXED, p, tid);
        asm volatile("s_waitcnt vmcnt(0) lgkmcnt(0)" ::: "memory");
        __syncthreads();
        {
            const attn_body::AttnTensors AT{(const attn_body::bf16*)(ws + WS_QA), (const attn_body::bf16*)(ws + WS_KA), (const attn_body::bf16*)(ws + WS_VA), (attn_body::bf16*)MIXED, (const unsigned*)MASKT};
            const attn_body::StaticOrder So((int)G, (int)bid);
            attn_body::attn_phase<attn_body::StaticOrder>((char*)lds_raw, AT, So);
        }
        __syncthreads();
        }
        if (BOTH(6)) xcd_barrier(bar);
    }
    bf16_t* MIX = (bf16_t*)(ws + WS_MIX); bf16_t* H2 = (bf16_t*)(ws + WS_H2); u32x2* LIST = (u32x2*)(ws + WS_LIST); bf16_t* HID = (bf16_t*)(ws + WS_HID);
    bf16_t* Y = (bf16_t*)(ws + WS_Y); float* HRES = (float*)(ws + WS_HRES);
    LAS int* tb = (LAS int*)(lds + TB_OFF);
    if (IN(7)) {
        MK_IDS();
        pg8::Gemm g{MIXED, WOUT, T, 1024, 1024}; pg8::StaticOrder So; So.init(T, 1024, G, bid);
        EpiStore E{MIX, 1024};
        pg8::gemm_phase<EpiStore, pg8::StaticOrder, true, true>(lds, g, So, E);
        if ((DUP_MASK >> 6) & 1) { __syncthreads(); pg8::gemm_phase<EpiStore, pg8::StaticOrder, true, true>(lds, g, So, E); }
        if (BOTH(7)) xcd_barrier(bar);
    }
    if (IN(8)) {
        MK_IDS();
        P6bArgs a{MIX, x, (const float*)args.in[8], (const float*)args.in[9], mod, (const float*)args.in[10], (const float*)args.in[11], (const float*)args.in[12], (const float*)args.in[13], HRES, H2, ctl + CW_CNT, LIST};
        const int gw0 = bid * NWAVES + wave;
        P6bIn I8;
        if (gw0 < T / P6B_NR) { p6b_load_x(I8, x, gw0, lane); p6b_load_mix(I8, MIX, gw0, lane); }
        { P6bW W8; p6b_weights_fetch(W8, a.w_group, a.w_expert, tid); p6b_weights_store(W8, lds, tid); }
        p6b_rows(a, I8, lds, (LAS float*)(lds + RT_WL_OFF + wave * 576), gw0, G * NWAVES, lane, false);
        if ((DUP_MASK >> 8) & 1) { if (gw0 < T / P6B_NR) { p6b_load_x(I8, x, gw0, lane); p6b_load_mix(I8, MIX, gw0, lane); } p6b_rows(a, I8, lds, (LAS float*)(lds + RT_WL_OFF + wave * 576), gw0, G * NWAVES, lane, true); }
        if (BOTH(8)) xcd_barrier(bar);
    }
    if (IN(9)) {
        MK_IDS();
        moe_table(tb, ctl + CW_CNT, tid);
        pg8::Gemm g{H2, WGU, T, 32 * 512, 1024}; MoeSched<1> So{LIST, tb, G, bid, 2, ctl + CW_TILE, ctl + CW_TMO, 0, 1 << 20};
        EpiGU E{HID};
        pg8::gemm_phase_ga<EpiGU, MoeSched<1>>(lds, g, So, E);
        if ((DUP_MASK >> 8) & 1) { __syncthreads(); pg8::gemm_phase_ga<EpiGU, MoeSched<1>>(lds, g, So, E); }
        __syncthreads();
    }
    if (IN(10)) {
        MK_IDS();
        moe_table(tb, ctl + CW_CNT, tid);
        const int n2 = (tb[32] * 2 > G && tb[32] * 2 < 2 * G) ? tb[32] * 2 - G : 0;
        const int t1 = G / 2;
        pg8::Gemm g{HID, WD, T, 32 * 1024, 256};
        EpiDown E{Y, LIST, tb};
        { MoeSched<2> So{LIST, tb, G - n2, bid - n2, 4, ctl + CW_TILE, ctl + CW_TMO, 0, t1}; moe_wait(So); pg8::gemm_phase<EpiDown, MoeSched<2>, true, true>(lds, g, So, E); }
        { MoeSched<2> So{LIST, tb, G - n2, bid - n2, 4, ctl + CW_TILE, ctl + CW_TMO, t1, 1 << 20}; moe_wait(So); pg8::gemm_phase<EpiDown, MoeSched<2>, true, true>(lds, g, So, E); }
        if (BOTH(10)) xcd_barrier(bar);
    }
    if (IN(11)) {
        MK_IDS();
        REP(11) p8_rows(Y, MIX, x, (const float*)args.in[8], (const float*)args.in[17], mod, args.out, bid * NWAVES + wave, G * NWAVES, lane);
    }
#undef IN
#undef BOTH
}
}
extern "C" void kernel_launch(void* const* d_in, const int* in_sizes, int n_in, void* d_out, int out_size, void* d_ws, size_t ws_size, hipStream_t stream) {
    using namespace mk;
    static int grid = 0;
    if (grid == 0) {
        int dev = 0, cus = 0, per_cu = 0;
        if (n_in != 18 || out_size != T * D || ws_size < (size_t)256 * MiB) { fprintf(stderr, "kernel_launch: unexpected problem shape (n_in %d, out %d, ws %zu)\n", n_in, out_size, ws_size); grid = -1; return; }
        if (hipGetDevice(&dev) != hipSuccess || hipDeviceGetAttribute(&cus, hipDeviceAttributeMultiprocessorCount, dev) != hipSuccess) { fprintf(stderr, "kernel_launch: device query failed\n"); grid = -1; return; }
        if (hipFuncSetAttribute((const void*)mega, hipFuncAttributeMaxDynamicSharedMemorySize, LDS_BYTES) != hipSuccess) { fprintf(stderr, "kernel_launch: hipFuncSetAttribute failed\n"); grid = -1; return; }
        if (hipOccupancyMaxActiveBlocksPerMultiprocessor(&per_cu, (const void*)mega, NTHR, LDS_BYTES) != hipSuccess || per_cu < 1) fprintf(stderr, "kernel_launch: occupancy query reports %d\n", per_cu);
        (void)hipGetLastError();
        grid = cus;
    }
    if (grid < 0) return;
    unsigned char* ws = (unsigned char*)d_ws;
    (void)hipMemsetAsync(ws + WS_CTL, 0, CTL_BYTES, stream);
    Args a{};
    for (int i = 0; i < 18; ++i) a.in[i] = d_in[i];
    a.out = (float*)d_out; a.ws = ws; a.ph_lo = 0; a.ph_hi = N_PHASES; a.li = 0; a.pad = 0;
    hipLaunchKernelGGL(mega, dim3(grid), dim3(NTHR), LDS_BYTES, stream, a);
#ifdef EXTRA_PHASE
#ifndef EXTRA_HI
#define EXTRA_HI (EXTRA_PHASE + 1)
#endif
    a.ph_lo = EXTRA_PHASE; a.ph_hi = EXTRA_HI; a.li = 1;
    hipLaunchKernelGGL(mega, dim3(grid), dim3(NTHR), LDS_BYTES, stream, a);
#endif
}
```
